# Optimizing an MI355X kernel written in HIP

```python
import jax
import jax.numpy as jnp
from jax import lax
import numpy as np


D_MODEL = 1024
BATCH = 8
SEQ = 4096
DEPTH = 1

HEAD_DIM = 64
ROPE_THETA = 10000.0
RMS_EPS = 1e-6
NEG_INF = -1e30
Q_BLOCK = 64

A_HEADS = 8
IDX_HEADS = 8
IDX_DIM = 32
DSA_TOPK_MAX = 256

B_HEADS = 8
B_KV_HEADS = 2
B_GROUP = B_HEADS // B_KV_HEADS
CMP_LEN = 32
CMP_STRIDE = 16
CMP_HIDDEN = 128
SLC_LEN = 64
SLC_TOPN = 16
WINDOW = 512

N_GROUPS = 4
EXPERTS_PER_GROUP = 8
N_EXPERTS = N_GROUPS * EXPERTS_PER_GROUP
TOP_K_INNER = 2
D_EXPERT = 256
MOE_BLOCK = 256

IN_SPLITS = (A_HEADS * HEAD_DIM, HEAD_DIM, HEAD_DIM, IDX_HEADS * IDX_DIM, IDX_DIM, IDX_HEADS,
             B_HEADS * HEAD_DIM, 6 * B_KV_HEADS * HEAD_DIM, 3 * B_HEADS, D_MODEL, D_MODEL)
IN_WIDTH = sum(IN_SPLITS)
SPLIT_POINTS = tuple(int(v) for v in np.cumsum(IN_SPLITS)[:-1])

kernel_name = "hybrid_dsa_nsa_hmoe_block"


def rmsnorm(x, g):
    xf = x.astype(jnp.float32)
    y = xf * lax.rsqrt(jnp.mean(xf * xf, axis=-1, keepdims=True) + RMS_EPS)
    return (y * g.astype(jnp.float32)).astype(x.dtype)


def rope(x, pos):
    half = x.shape[-1] // 2
    inv_freq = ROPE_THETA ** (-jnp.arange(half, dtype=jnp.float32) / half)
    ang = pos.astype(jnp.float32)[:, :, None] * inv_freq
    cos = jnp.cos(ang)[:, :, None, :]
    sin = jnp.sin(ang)[:, :, None, :]
    xf = x.astype(jnp.float32)
    x1, x2 = xf[..., :half], xf[..., half:]
    return jnp.concatenate([x1 * cos - x2 * sin, x1 * sin + x2 * cos], axis=-1).astype(x.dtype)


def masked_softmax(s, mask):
    p = jax.nn.softmax(jnp.where(mask, s.astype(jnp.float32), NEG_INF), axis=-1)
    return jnp.where(mask, p, 0.0)


def _rows(a, t0):
    return lax.dynamic_slice_in_dim(a, t0, Q_BLOCK, axis=1)


def dsa_attention(q, k, v, qi, ki, wi):
    bsz, L = q.shape[0], q.shape[1]
    k_sel = min(DSA_TOPK_MAX, L // 4)
    key_pos = jnp.arange(L)
    b_ix = jnp.arange(bsz)[:, None, None]
    scale = HEAD_DIM ** -0.5

    def block(i):
        t0 = i * Q_BLOCK
        qpos = t0 + jnp.arange(Q_BLOCK)
        causal = (key_pos[None, :] <= qpos[:, None])[None]
        idx_logit = jax.nn.relu(jnp.einsum('bthd,bsd->bths', _rows(qi, t0), ki))
        score = jnp.einsum('bth,bths->bts', _rows(wi, t0), idx_logit).astype(jnp.float32)
        score = jnp.where(causal, score, -jnp.inf)
        _, sel = lax.top_k(score, k_sel)
        ks = k[b_ix, sel]
        vs = v[b_ix, sel]
        s = jnp.einsum('bthd,btkd->bthk', _rows(q, t0), ks) * scale
        mask = (sel <= qpos[None, :, None])[:, :, None, :]
        p = masked_softmax(s, mask).astype(vs.dtype)
        return jnp.einsum('bthk,btkd->bthd', p, vs)

    out = lax.map(block, jnp.arange(L // Q_BLOCK))
    return out.transpose(1, 0, 2, 3, 4).reshape(bsz, L, A_HEADS * HEAD_DIM)


def compress_tokens(kv, pe, w1, w2):
    bsz, L, hk, dh = kv.shape
    n_cmp = (L - CMP_LEN) // CMP_STRIDE + 1
    idx = np.arange(n_cmp)[:, None] * CMP_STRIDE + np.arange(CMP_LEN)[None, :]
    blocks = kv[:, idx] + pe[:, None, :]
    z = blocks.transpose(0, 1, 3, 2, 4).reshape(bsz, n_cmp, hk, CMP_LEN * dh)
    return jax.nn.silu(z @ w1) @ w2


def nsa_attention(q_nope, q_rope, k_cmp, v_cmp, k_slc, v_slc, k_win, v_win, gates,
                  pe_k, w1_k, w2_k, pe_v, w1_v, w2_v):
    bsz, L = q_nope.shape[0], q_nope.shape[1]
    scale = HEAD_DIM ** -0.5
    kc = compress_tokens(k_cmp, pe_k, w1_k, w2_k)
    vc = compress_tokens(v_cmp, pe_v, w1_v, w2_v)
    n_cmp = kc.shape[1]
    cmp_start = np.arange(n_cmp) * CMP_STRIDE
    cmp_end = jnp.asarray(cmp_start + CMP_LEN - 1)
    n_slc = L // SLC_LEN
    n_sel = min(SLC_TOPN, n_slc)
    slc_start = np.arange(n_slc) * SLC_LEN
    overlap = (cmp_start[:, None] < slc_start[None, :] + SLC_LEN) & (cmp_start[:, None] + CMP_LEN > slc_start[None, :])
    cmp_to_slc = jnp.asarray(overlap.astype(np.float32))
    k_blk = k_slc.reshape(bsz, n_slc, SLC_LEN, B_KV_HEADS, HEAD_DIM).transpose(0, 3, 1, 2, 4)
    v_blk = v_slc.reshape(bsz, n_slc, SLC_LEN, B_KV_HEADS, HEAD_DIM).transpose(0, 3, 1, 2, 4)
    k_pad = jnp.pad(k_win, ((0, 0), (WINDOW, 0), (0, 0), (0, 0)))
    v_pad = jnp.pad(v_win, ((0, 0), (WINDOW, 0), (0, 0), (0, 0)))
    b_ix = jnp.arange(bsz)[:, None, None, None]
    h_ix = jnp.arange(B_KV_HEADS)[None, None, :, None]
    j_ix = jnp.arange(n_slc)

    def block(i):
        t0 = i * Q_BLOCK
        qpos = t0 + jnp.arange(Q_BLOCK)
        qn = _rows(q_nope, t0).reshape(bsz, Q_BLOCK, B_KV_HEADS, B_GROUP, HEAD_DIM)
        qr = _rows(q_rope, t0).reshape(bsz, Q_BLOCK, B_KV_HEADS, B_GROUP, HEAD_DIM)
        g = _rows(gates, t0)
        s = jnp.einsum('btkgd,bnkd->btkgn', qn, kc) * scale
        m_cmp = (cmp_end[None, :] <= qpos[:, None])[None, :, None, None, :]
        p_cmp = masked_softmax(s, m_cmp)
        o_cmp = jnp.einsum('btkgn,bnkd->btkgd', p_cmp.astype(vc.dtype), vc)
        imp = jnp.einsum('btkgn,nj->btkj', p_cmp, cmp_to_slc)
        admiss = j_ix[None, :] * SLC_LEN <= qpos[:, None]
        cur = qpos[:, None] // SLC_LEN
        forced = admiss & ((j_ix[None, :] == 0) | (j_ix[None, :] == cur) | (j_ix[None, :] == cur - 1))
        score = jnp.where(admiss[None, :, None, :], imp, -jnp.inf)
        score = jnp.where(forced[None, :, None, :], jnp.inf, score)
        _, sel = lax.top_k(score, n_sel)
        ks = k_blk[b_ix, h_ix, sel].reshape(bsz, Q_BLOCK, B_KV_HEADS, n_sel * SLC_LEN, HEAD_DIM)
        vs = v_blk[b_ix, h_ix, sel].reshape(bsz, Q_BLOCK, B_KV_HEADS, n_sel * SLC_LEN, HEAD_DIM)
        tok = (sel[..., None] * SLC_LEN + jnp.arange(SLC_LEN)).reshape(bsz, Q_BLOCK, B_KV_HEADS, n_sel * SLC_LEN)
        m_sel = (tok <= qpos[None, :, None, None])[:, :, :, None, :]
        s = jnp.einsum('btkgd,btksd->btkgs', qr, ks) * scale
        p = masked_softmax(s, m_sel).astype(vs.dtype)
        o_slc = jnp.einsum('btkgs,btksd->btkgd', p, vs)
        kw = lax.dynamic_slice_in_dim(k_pad, t0, WINDOW + Q_BLOCK, axis=1)
        vw = lax.dynamic_slice_in_dim(v_pad, t0, WINDOW + Q_BLOCK, axis=1)
        kpos = t0 - WINDOW + jnp.arange(WINDOW + Q_BLOCK)
        rel = qpos[:, None] - kpos[None, :]
        m_win = ((rel >= 0) & (rel < WINDOW) & (kpos[None, :] >= 0))[None, :, None, None, :]
        s = jnp.einsum('btkgd,bskd->btkgs', qr, kw) * scale
        p = masked_softmax(s, m_win).astype(vw.dtype)
        o_win = jnp.einsum('btkgs,bskd->btkgd', p, vw)
        gc = g[:, :, 0].reshape(bsz, Q_BLOCK, B_KV_HEADS, B_GROUP, 1)
        gs = g[:, :, 1].reshape(bsz, Q_BLOCK, B_KV_HEADS, B_GROUP, 1)
        gw = g[:, :, 2].reshape(bsz, Q_BLOCK, B_KV_HEADS, B_GROUP, 1)
        o = gc * o_cmp + gs * o_slc + gw * o_win
        return o.reshape(bsz, Q_BLOCK, B_HEADS * HEAD_DIM)

    out = lax.map(block, jnp.arange(L // Q_BLOCK))
    return out.transpose(1, 0, 2, 3).reshape(bsz, L, B_HEADS * HEAD_DIM)


def mixer_layer(h, positions, w_in, pe_k, w1_k, w2_k, pe_v, w1_v, w2_v, w_br_a, w_br_b, w_out):
    bsz, L, _ = h.shape
    proj = jnp.einsum('bsd,dc->bsc', h, w_in)
    qa, ka, va, qi, ki, wi, qb, kvb, gb, gate_a, gate_b = jnp.split(proj, SPLIT_POINTS, axis=-1)
    qa = rope(qa.reshape(bsz, L, A_HEADS, HEAD_DIM), positions)
    ka = rope(ka[:, :, None, :], positions)[:, :, 0]
    qi = rope(qi.reshape(bsz, L, IDX_HEADS, IDX_DIM), positions)
    ki = rope(ki[:, :, None, :], positions)[:, :, 0]
    o_a = dsa_attention(qa, ka, va, qi, ki, wi)
    qb = qb.reshape(bsz, L, B_HEADS, HEAD_DIM)
    kvb = kvb.reshape(bsz, L, 6, B_KV_HEADS, HEAD_DIM)
    k_cmp, v_cmp = kvb[:, :, 0], kvb[:, :, 1]
    k_slc, v_slc = rope(kvb[:, :, 2], positions), kvb[:, :, 3]
    k_win, v_win = rope(kvb[:, :, 4], positions), kvb[:, :, 5]
    nsa_gates = jax.nn.sigmoid(gb.reshape(bsz, L, 3, B_HEADS))
    o_b = nsa_attention(qb, rope(qb, positions), k_cmp, v_cmp, k_slc, v_slc, k_win, v_win, nsa_gates,
                        pe_k, w1_k, w2_k, pe_v, w1_v, w2_v)
    merged = jax.nn.sigmoid(gate_a) * (o_a @ w_br_a) + jax.nn.sigmoid(gate_b) * (o_b @ w_br_b)
    return merged @ w_out


def hier_moe(h, w_group, b_group, w_expert, b_expert, w_gate_up, w_down):
    bsz, L, d = h.shape
    n_tok = bsz * L
    tok = h.reshape(n_tok, d)
    g_logit = jnp.einsum('nd,dg->ng', tok, w_group).astype(jnp.float32) + b_group.astype(jnp.float32)
    g_prob = jax.nn.softmax(g_logit, axis=-1)
    g_sel = jnp.argmax(g_logit, axis=-1)
    e_logit = jnp.einsum('nd,de->ne', tok, w_expert).astype(jnp.float32) + b_expert.astype(jnp.float32)
    e_in = jnp.take_along_axis(e_logit.reshape(n_tok, N_GROUPS, EXPERTS_PER_GROUP), g_sel[:, None, None], axis=1)[:, 0]
    top_val, top_idx = lax.top_k(e_in, TOP_K_INNER)
    weight = jnp.take_along_axis(g_prob, g_sel[:, None], axis=1) * jax.nn.softmax(top_val, axis=-1)
    expert = g_sel[:, None] * EXPERTS_PER_GROUP + top_idx
    n_asg = n_tok * TOP_K_INNER
    e_flat = expert.reshape(n_asg)
    tok_flat = jnp.repeat(jnp.arange(n_tok), TOP_K_INNER)
    w_flat = weight.reshape(n_asg)
    order = jnp.argsort(e_flat)
    e_s, tok_s, w_s = e_flat[order], tok_flat[order], w_flat[order]
    counts = jnp.bincount(e_flat, length=N_EXPERTS)
    starts = jnp.cumsum(counts) - counts
    padded = (counts + MOE_BLOCK - 1) // MOE_BLOCK * MOE_BLOCK
    pad_end = jnp.cumsum(padded)
    pad_start = pad_end - padded
    dest = pad_start[e_s] + jnp.arange(n_asg) - starts[e_s]
    n_blocks = -(-n_asg // MOE_BLOCK) + N_EXPERTS
    buf = jnp.zeros((n_blocks * MOE_BLOCK, d), h.dtype).at[dest].set(tok[tok_s])
    blk_expert = jnp.minimum(jnp.searchsorted(pad_end, jnp.arange(n_blocks) * MOE_BLOCK, side='right'), N_EXPERTS - 1)

    def run(args):
        xb, e = args
        gate, up = jnp.split(xb @ w_gate_up[e], 2, axis=-1)
        return (jax.nn.silu(gate) * up) @ w_down[e]

    y_buf = lax.map(run, (buf.reshape(n_blocks, MOE_BLOCK, d), blk_expert)).reshape(n_blocks * MOE_BLOCK, d)
    y = jax.ops.segment_sum(y_buf[dest] * w_s[:, None].astype(h.dtype), tok_s, num_segments=n_tok)
    return y.reshape(bsz, L, d)


def setup_inputs(seed: int = 0) -> dict:
    key = jax.random.key(seed)
    ks = jax.random.split(key, 24)

    def nrm(k, shape, scale):
        return jax.random.normal(k, shape, jnp.float32) * scale

    cmp_in = CMP_LEN * HEAD_DIM
    a_w = A_HEADS * HEAD_DIM
    b_w = B_HEADS * HEAD_DIM
    offs = jax.random.randint(ks[1], (BATCH, 1), 0, 1024, dtype=jnp.int32)
    return {
        "x": nrm(ks[0], (BATCH, SEQ, D_MODEL), 1.0),
        "positions": offs + jnp.arange(SEQ, dtype=jnp.int32)[None, :],
        "norm_mix": 1.0 + nrm(ks[2], (DEPTH, D_MODEL), 0.02),
        "w_in": nrm(ks[3], (DEPTH, D_MODEL, IN_WIDTH), D_MODEL ** -0.5),
        "pe_k": nrm(ks[4], (DEPTH, CMP_LEN, HEAD_DIM), 0.1),
        "w1_k": nrm(ks[5], (DEPTH, cmp_in, CMP_HIDDEN), cmp_in ** -0.5),
        "w2_k": nrm(ks[6], (DEPTH, CMP_HIDDEN, HEAD_DIM), CMP_HIDDEN ** -0.5),
        "pe_v": nrm(ks[7], (DEPTH, CMP_LEN, HEAD_DIM), 0.1),
        "w1_v": nrm(ks[8], (DEPTH, cmp_in, CMP_HIDDEN), cmp_in ** -0.5),
        "w2_v": nrm(ks[9], (DEPTH, CMP_HIDDEN, HEAD_DIM), CMP_HIDDEN ** -0.5),
        "w_br_a": nrm(ks[10], (DEPTH, a_w, D_MODEL), a_w ** -0.5),
        "w_br_b": nrm(ks[11], (DEPTH, b_w, D_MODEL), b_w ** -0.5),
        "w_out": nrm(ks[12], (DEPTH, D_MODEL, D_MODEL), D_MODEL ** -0.5),
        "norm_ffn": 1.0 + nrm(ks[13], (DEPTH, D_MODEL), 0.02),
        "w_group": nrm(ks[14], (DEPTH, D_MODEL, N_GROUPS), D_MODEL ** -0.5),
        "b_group": nrm(ks[15], (DEPTH, N_GROUPS), 0.01),
        "w_expert": nrm(ks[16], (DEPTH, D_MODEL, N_EXPERTS), D_MODEL ** -0.5),
        "b_expert": nrm(ks[17], (DEPTH, N_EXPERTS), 0.01),
        "w_gate_up": nrm(ks[18], (DEPTH, N_EXPERTS, D_MODEL, 2 * D_EXPERT), D_MODEL ** -0.5),
        "w_down": nrm(ks[19], (DEPTH, N_EXPERTS, D_EXPERT, D_MODEL), D_EXPERT ** -0.5),
        "norm_final": 1.0 + nrm(ks[20], (D_MODEL,), 0.02),
    }


def reference(x, positions, norm_mix, w_in, pe_k, w1_k, w2_k, pe_v, w1_v, w2_v, w_br_a, w_br_b,
              w_out, norm_ffn, w_group, b_group, w_expert, b_expert, w_gate_up, w_down, norm_final):
    for l in range(DEPTH):
        h = rmsnorm(x, norm_mix[l])
        x = x + mixer_layer(h, positions, w_in[l], pe_k[l], w1_k[l], w2_k[l], pe_v[l], w1_v[l], w2_v[l],
                            w_br_a[l], w_br_b[l], w_out[l])
        h = rmsnorm(x, norm_ffn[l])
        x = x + hier_moe(h, w_group[l], b_group[l], w_expert[l], b_expert[l], w_gate_up[l], w_down[l])
    return rmsnorm(x, norm_final)
```

```cpp
#include <hip/hip_runtime.h>
#include <hip/hip_cooperative_groups.h>
#include <cstdint>
#include <cstdio>
#include <cmath>
namespace cg = cooperative_groups;

#define DEVI __device__ __forceinline__
typedef unsigned short bf16_t;
typedef short bf16x8 __attribute__((ext_vector_type(8)));
typedef short s16x4 __attribute__((ext_vector_type(4)));
typedef float f32x4 __attribute__((ext_vector_type(4)));
typedef float f32x2 __attribute__((ext_vector_type(2)));
typedef unsigned u32x4 __attribute__((ext_vector_type(4)));
typedef unsigned u32x2 __attribute__((ext_vector_type(2)));
#define LAS __attribute__((address_space(3)))

constexpr int NB = 8, SL = 4096, DM = 1024, NTOK = NB * SL;
constexpr int INW = 4288;
constexpr int NTHREADS = 256;
constexpr int LDS_BYTES = 81920;
constexpr float RMS_EPS = 1e-6f;
constexpr float LOG2E = 1.4426950408889634f;

constexpr int WIN_ROWS = 4352;
constexpr int G1_COLS = 4352;

constexpr size_t al256(size_t x) { return (x + 255) & ~(size_t)255; }
constexpr size_t OFF_CTL   = 0;
constexpr size_t OFF_WIN_T = 4096;
constexpr size_t OFF_WBRA  = OFF_WIN_T + (size_t)WIN_ROWS * 1024 * 2;
constexpr size_t OFF_WBRB  = OFF_WBRA + (size_t)1024 * 512 * 2;
constexpr size_t OFF_WOUT  = OFF_WBRB + (size_t)1024 * 512 * 2;
constexpr size_t OFF_W1K   = OFF_WOUT + (size_t)1024 * 1024 * 2;
constexpr size_t OFF_W1V   = OFF_W1K + (size_t)128 * 2048 * 2;
constexpr size_t OFF_W2K   = OFF_W1V + (size_t)128 * 2048 * 2;
constexpr size_t OFF_W2V   = OFF_W2K + (size_t)64 * 128 * 2;
constexpr size_t OFF_WGU   = OFF_W2V + (size_t)64 * 128 * 2;
constexpr size_t OFF_WDN   = OFF_WGU + (size_t)32 * 512 * 1024 * 2;
constexpr size_t OFF_BIAS1 = OFF_WDN + (size_t)32 * 1024 * 256 * 2;
constexpr size_t OFF_CS    = OFF_BIAS1 + 1024;
constexpr size_t OFF_HN    = OFF_CS + (size_t)NTOK * 32 * 8;
constexpr size_t OFF_QA    = OFF_HN + (size_t)NTOK * 1024 * 2;
constexpr size_t OFF_KA    = OFF_QA + (size_t)NTOK * 512 * 2;
constexpr size_t OFF_VA    = OFF_KA + (size_t)NTOK * 64 * 2;
constexpr size_t OFF_QI    = OFF_VA + (size_t)NTOK * 64 * 2;
constexpr size_t OFF_KI    = OFF_QI + (size_t)NTOK * 256 * 2;
constexpr size_t OFF_WI    = OFF_KI + (size_t)NTOK * 32 * 2;
constexpr size_t OFF_QBN   = OFF_WI + (size_t)NTOK * 8 * 4;
constexpr size_t OFF_QBR   = OFF_QBN + (size_t)NTOK * 512 * 2;
constexpr size_t KV_STRIDE = (size_t)NTOK * 128 * 2 + 65536 * 4;
constexpr size_t OFF_KV    = OFF_QBR + (size_t)NTOK * 512 * 2;
constexpr size_t OFF_GATES = OFF_KV + 6 * KV_STRIDE;
constexpr size_t OFF_QKV_END = OFF_GATES + (size_t)NTOK * 24 * 4;
constexpr size_t OFF_KC    = al256(OFF_QKV_END);
constexpr size_t OFF_VCT   = OFF_KC + (size_t)16 * 256 * 64 * 2;
constexpr size_t OFF_SEL   = OFF_VCT + (size_t)16 * 256 * 64 * 2;
constexpr size_t OFF_OA    = OFF_HN;
constexpr size_t OFF_OB    = OFF_OA + (size_t)NTOK * 512 * 2;
constexpr size_t OFF_GA    = OFF_SEL + (size_t)NTOK * 256 * 2;
constexpr size_t OFF_GB    = OFF_GA + (size_t)NTOK * 1024 * 2;
constexpr size_t OFF_MASK  = OFF_GB + (size_t)NTOK * 1024 * 2;
constexpr size_t OFF_LIST  = OFF_MASK + (size_t)16 * 4096 * 8;
constexpr size_t OFF_WT    = OFF_LIST + (size_t)32 * NTOK * 4;
constexpr size_t WS_END    = OFF_WT + (size_t)NTOK * 2 * 4;
constexpr size_t OFF_MERGED = OFF_QA;
constexpr size_t OFF_ACT    = OFF_QA;
constexpr size_t OFF_Y      = OFF_QA + (size_t)40 * 1024 * 1024;
static_assert(OFF_Y + (size_t)2 * NTOK * 1024 * 2 <= OFF_QKV_END, "Y overlay");
static_assert((size_t)544 * 128 * 256 * 2 <= (size_t)40 * 1024 * 1024, "ACT overlay");

struct Params {
    const float* in[21];
    const int* pos;
    float* out;
    unsigned char* ws;
    double inv_freq[32];
    int ph_lo, ph_hi;
};

DEVI unsigned f2bf(float f) { unsigned u = __float_as_uint(f); return (u + 0x7fffu + ((u >> 16) & 1u)) >> 16; }
DEVI unsigned pk2(float lo, float hi) { return f2bf(lo) | (f2bf(hi) << 16); }
DEVI float bf2f(unsigned h) { return __uint_as_float(h << 16); }
DEVI float sigmoidf_(float x) { return __builtin_amdgcn_rcpf(1.0f + __builtin_amdgcn_exp2f(-x * 1.4426950408889634f)); }
DEVI float wave_sum(float v) {
#pragma unroll
    for (int o = 32; o > 0; o >>= 1) v += __shfl_xor(v, o);
    return v;
}
DEVI bf16x8 pack8(const f32x4& a, const f32x4& b) {
    u32x4 w; w.x = pk2(a[0], a[1]); w.y = pk2(a[2], a[3]); w.z = pk2(b[0], b[1]); w.w = pk2(b[2], b[3]);
    return __builtin_bit_cast(bf16x8, w);
}
#define MFMA16(a, b, c) __builtin_amdgcn_mfma_f32_16x16x32_bf16((a), (b), (c), 0, 0, 0)

typedef __amdgpu_buffer_rsrc_t rsrc_t;
DEVI u32x4 bload16(rsrc_t r, unsigned voff, unsigned soff) { return __builtin_bit_cast(u32x4, __builtin_amdgcn_raw_buffer_load_b128(r, (int)voff, (int)soff, 0)); }
template <class FA, class FB>
DEVI void gemm128(f32x4 (&acc)[4][4], rsrc_t rs, unsigned sA, const FA& offA, unsigned sB, const FB& offB, int nk, unsigned char* lds, int tid) {
    const int lane = tid & 63, wid = __builtin_amdgcn_readfirstlane(tid >> 6), wr = wid >> 1, wc = wid & 1;
    const int lr = tid >> 3, lc = tid & 7;
    unsigned oa[4], ob[4];
#pragma unroll
    for (int i = 0; i < 4; ++i) { oa[i] = offA(lr + 32 * i) + lc * 16; ob[i] = offB(lr + 32 * i) + lc * 16; }
#pragma unroll
    for (int m = 0; m < 4; ++m)
#pragma unroll
        for (int n = 0; n < 4; ++n) acc[m][n] = (f32x4){0.f, 0.f, 0.f, 0.f};
    const int woff = lr * 128 + ((lc ^ (lr & 7)) << 4);
    const int q = lane >> 4, r16 = lane & 15;
    const int roffA0 = (wr * 64 + r16) * 128 + (((0 + q) ^ (lane & 7)) << 4);
    const int roffA1 = (wr * 64 + r16) * 128 + (((4 + q) ^ (lane & 7)) << 4);
    const int roffB0 = 16384 + (wc * 64 + r16) * 128 + (((0 + q) ^ (lane & 7)) << 4);
    const int roffB1 = 16384 + (wc * 64 + r16) * 128 + (((4 + q) ^ (lane & 7)) << 4);
    u32x4 ra[4], rb[4];
#pragma unroll
    for (int i = 0; i < 4; ++i) { ra[i] = bload16(rs, oa[i], sA); rb[i] = bload16(rs, ob[i], sB); }
#pragma unroll
    for (int i = 0; i < 4; ++i) { *(u32x4*)(lds + woff + i * 4096) = ra[i]; *(u32x4*)(lds + 16384 + woff + i * 4096) = rb[i]; }
    __syncthreads();
    for (int kt = 0; kt < nk; ++kt) {
        unsigned char* cur = lds + (kt & 1) * 32768;
        unsigned char* nxt = lds + ((kt + 1) & 1) * 32768;
        const bool more = (kt + 1 < nk);
        if (more) {
#pragma unroll
            for (int i = 0; i < 4; ++i) { ra[i] = bload16(rs, oa[i], sA + (kt + 1) * 128); rb[i] = bload16(rs, ob[i], sB + (kt + 1) * 128); }
        }
#pragma unroll
        for (int ks = 0; ks < 2; ++ks) {
            bf16x8 a[4], b[4];
#pragma unroll
            for (int m = 0; m < 4; ++m) a[m] = *(const bf16x8*)(cur + (ks ? roffA1 : roffA0) + m * 2048);
#pragma unroll
            for (int n = 0; n < 4; ++n) b[n] = *(const bf16x8*)(cur + (ks ? roffB1 : roffB0) + n * 2048);
#pragma unroll
            for (int m = 0; m < 4; ++m)
#pragma unroll
                for (int n = 0; n < 4; ++n) acc[m][n] = MFMA16(a[m], b[n], acc[m][n]);
        }
        if (more) {
#pragma unroll
            for (int i = 0; i < 4; ++i) { *(u32x4*)(nxt + woff + i * 4096) = ra[i]; *(u32x4*)(nxt + 16384 + woff + i * 4096) = rb[i]; }
        }
        __syncthreads();
    }
}

struct RowLin { unsigned ldb; DEVI unsigned operator()(int r) const { return (unsigned)r * ldb; } };

DEVI int win_map(int j) {
    if (j < 896) return j;
    if (j < 1408) return j - 896 + 936;
    if (j < 2176) return j - 1408 + 1448;
    if (j < 2208) return j - 2176 + 896;
    if (j < 2216) return j - 2208 + 928;
    if (j < 2240) return j;
    if (j < 2304) return -1;
    return j - 64;
}

struct TJob { const float* src; bf16_t* dst; int K, ld, nrows, perm, nb; size_t sb, db; };
DEVI TJob get_tjob(const Params& P, int j) {
    unsigned char* ws = P.ws;
    switch (j) {
        case 0: return TJob{P.in[3], (bf16_t*)(ws + OFF_WIN_T), 1024, INW, WIN_ROWS, 1, 1, 0, 0};
        case 1: return TJob{P.in[10], (bf16_t*)(ws + OFF_WBRA), 512, 1024, 1024, 0, 1, 0, 0};
        case 2: return TJob{P.in[11], (bf16_t*)(ws + OFF_WBRB), 512, 1024, 1024, 0, 1, 0, 0};
        case 3: return TJob{P.in[12], (bf16_t*)(ws + OFF_WOUT), 1024, 1024, 1024, 0, 1, 0, 0};
        case 4: return TJob{P.in[5], (bf16_t*)(ws + OFF_W1K), 2048, 128, 128, 0, 1, 0, 0};
        case 5: return TJob{P.in[8], (bf16_t*)(ws + OFF_W1V), 2048, 128, 128, 0, 1, 0, 0};
        case 6: return TJob{P.in[6], (bf16_t*)(ws + OFF_W2K), 128, 64, 64, 0, 1, 0, 0};
        case 7: return TJob{P.in[9], (bf16_t*)(ws + OFF_W2V), 128, 64, 64, 0, 1, 0, 0};
        case 8: return TJob{P.in[18], (bf16_t*)(ws + OFF_WGU), 1024, 512, 512, 0, 32, (size_t)1024 * 512, (size_t)512 * 1024};
        default: return TJob{P.in[19], (bf16_t*)(ws + OFF_WDN), 256, 1024, 1024, 0, 32, (size_t)256 * 1024, (size_t)1024 * 256};
    }
}
DEVI int tjob_tiles(int j) {
    switch (j) {
        case 0: return (WIN_ROWS / 64) * 16;
        case 1: case 2: return 16 * 8;
        case 3: return 16 * 16;
        case 4: case 5: return 2 * 32;
        case 6: case 7: return 1 * 2;
        case 8: return 32 * 8 * 16;
        default: return 32 * 16 * 4;
    }
}

DEVI void transpose_tile(const TJob& J, int tile, unsigned char* lds, int tid) {
    float* T = (float*)lds;
    const int kt = J.K / 64, rt = J.nrows / 64;
    const int b = tile / (kt * rt), rem = tile % (kt * rt);
    const int r0 = (rem / kt) * 64, k0 = (rem % kt) * 64;
    const float* src = J.src + (size_t)b * J.sb;
    bf16_t* dst = J.dst + (size_t)b * J.db;
    const int rr = tid & 63;
    int col = r0 + rr; if (J.perm) col = win_map(col);
#pragma unroll
    for (int i = 0; i < 16; ++i) {
        const int kk = i * 4 + (tid >> 6);
        T[kk * 65 + rr] = (col >= 0) ? src[(size_t)(k0 + kk) * J.ld + col] : 0.f;
    }
    __syncthreads();
    const int r2 = tid >> 2, ks = (tid & 3) * 16;
    u32x4 w0, w1;
    w0.x = pk2(T[(ks + 0) * 65 + r2], T[(ks + 1) * 65 + r2]); w0.y = pk2(T[(ks + 2) * 65 + r2], T[(ks + 3) * 65 + r2]);
    w0.z = pk2(T[(ks + 4) * 65 + r2], T[(ks + 5) * 65 + r2]); w0.w = pk2(T[(ks + 6) * 65 + r2], T[(ks + 7) * 65 + r2]);
    w1.x = pk2(T[(ks + 8) * 65 + r2], T[(ks + 9) * 65 + r2]); w1.y = pk2(T[(ks + 10) * 65 + r2], T[(ks + 11) * 65 + r2]);
    w1.z = pk2(T[(ks + 12) * 65 + r2], T[(ks + 13) * 65 + r2]); w1.w = pk2(T[(ks + 14) * 65 + r2], T[(ks + 15) * 65 + r2]);
    bf16_t* d = dst + (size_t)(r0 + r2) * J.K + k0 + ks;
    *(u32x4*)d = w0; *(u32x4*)(d + 8) = w1;
    __syncthreads();
}

DEVI void rms_row_bf16(const float* xr, const float* g, bf16_t* o, int lane) {
    f32x4 v[4]; float ss = 0.f;
#pragma unroll
    for (int i = 0; i < 4; ++i) { v[i] = *(const f32x4*)(xr + i * 256 + lane * 4); ss += v[i][0] * v[i][0] + v[i][1] * v[i][1] + v[i][2] * v[i][2] + v[i][3] * v[i][3]; }
    ss = wave_sum(ss);
    const float rs = rsqrtf(ss * (1.0f / 1024.0f) + RMS_EPS);
#pragma unroll
    for (int i = 0; i < 4; ++i) {
        const f32x4 gg = *(const f32x4*)(g + i * 256 + lane * 4);
        u32x2 w; w.x = pk2(v[i][0] * rs * gg[0], v[i][1] * rs * gg[1]); w.y = pk2(v[i][2] * rs * gg[2], v[i][3] * rs * gg[3]);
        *(u32x2*)(o + i * 256 + lane * 4) = w;
    }
}

DEVI void phase_prep(const Params& P, unsigned char* lds, int tid) {
    unsigned char* ws = P.ws;
    const int lane = tid & 63, wid = __builtin_amdgcn_readfirstlane(tid >> 6);
    if (blockIdx.x == 0 && tid < 64) ((unsigned*)(ws + OFF_CTL))[tid] = 0u;
    int base = 0;
    for (int j = 0; j < 10; ++j) {
        const int nt = tjob_tiles(j);
        const TJob J = get_tjob(P, j);
        for (int t = blockIdx.x; t < nt; t += gridDim.x) transpose_tile(J, t, lds, tid);
        base += nt;
    }
    {
        const float* x = P.in[0]; const float* g = P.in[2]; bf16_t* hn = (bf16_t*)(ws + OFF_HN);
        for (int r = blockIdx.x * 4 + wid; r < NTOK; r += gridDim.x * 4) rms_row_bf16(x + (size_t)r * 1024, g, hn + (size_t)r * 1024, lane);
    }
    {
        f32x2* cs = (f32x2*)(ws + OFF_CS);
        for (int e = blockIdx.x * NTHREADS + tid; e < NTOK * 32; e += gridDim.x * NTHREADS) {
            const int tok = e >> 5, i = e & 31;
            const double a = (double)P.pos[tok] * P.inv_freq[i];
            double t = a * 0.15915494309189535;
            t -= floor(t);
            const float tf = (float)t;
            cs[e] = (f32x2){__builtin_amdgcn_cosf(tf), __builtin_amdgcn_sinf(tf)};
        }
    }
    {
        float* red = (float*)lds;
        for (int job = blockIdx.x; job < 32; job += gridDim.x) {
            const int kv = job >> 4, cg8 = job & 15;
            const float* pe = P.in[kv ? 7 : 4]; const float* w1 = P.in[kv ? 8 : 5];
            const int cc = tid & 7, jj = tid >> 3;
            float s = 0.f;
            for (int j = jj; j < 2048; j += 32) s += pe[j] * w1[(size_t)j * 128 + cg8 * 8 + cc];
            red[tid] = s;
            __syncthreads();
            if (tid < 8) { float t = 0.f; for (int u = 0; u < 32; ++u) t += red[u * 8 + tid]; ((float*)(ws + OFF_BIAS1))[kv * 128 + cg8 * 8 + tid] = t; }
            __syncthreads();
        }
    }
}

DEVI void st_bf16(bf16_t* p, float v) { *p = (bf16_t)f2bf(v); }

DEVI void phase_gemm1(const Params& P, unsigned char* lds, int tid) {
    unsigned char* ws = P.ws;
    const rsrc_t rs = __builtin_amdgcn_make_buffer_rsrc((void*)P.ws, (short)0, (int)0x7fffffff, 0x00020000);
    const bf16_t* hn = (const bf16_t*)(ws + OFF_HN);
    const bf16_t* wt = (const bf16_t*)(ws + OFF_WIN_T);
    const f32x2* cs = (const f32x2*)(ws + OFF_CS);
    const int lane = tid & 63, wid = __builtin_amdgcn_readfirstlane(tid >> 6), wr = wid >> 1, wc = wid & 1, q = lane >> 4, cl = lane & 15;
    constexpr int NT_N = G1_COLS / 128;
    for (int u = blockIdx.x; u < (NTOK / 128) * NT_N; u += gridDim.x) {
        const int mt = u / NT_N, nt = u % NT_N;
        f32x4 acc[4][4];
        gemm128(acc, rs, (unsigned)(OFF_HN + (size_t)mt * 128 * 2048), RowLin{2048}, (unsigned)(OFF_WIN_T + (size_t)nt * 128 * 2048), RowLin{2048}, 16, lds, tid);
        const int c64 = nt * 2 + wc;
        const int tok0 = mt * 128 + wr * 64;
        if (c64 < 10 || (c64 >= 14 && c64 < 22) || (c64 >= 22 && c64 < 34)) {
            bool do_rope; float scale = 1.f; int kind;
            int g = 0, hk = 0;
            if (c64 < 8) { kind = 0; do_rope = true; scale = 0.125f; }
            else if (c64 == 8) { kind = 1; do_rope = true; }
            else if (c64 == 9) { kind = 2; do_rope = false; }
            else if (c64 < 22) { kind = 3; do_rope = true; scale = 0.125f; }
            else { kind = 4; g = (c64 - 22) >> 1; hk = (c64 - 22) & 1; do_rope = (g == 2 || g == 4); }
#pragma unroll
            for (int m = 0; m < 4; ++m) {
                float o[4][4];
                float nr[4][4];
#pragma unroll
                for (int n = 0; n < 4; ++n)
#pragma unroll
                    for (int j = 0; j < 4; ++j) { nr[n][j] = acc[m][n][j] * scale; o[n][j] = nr[n][j]; }
                if (do_rope) {
#pragma unroll
                    for (int j = 0; j < 4; ++j) {
                        const int tok = tok0 + m * 16 + q * 4 + j;
#pragma unroll
                        for (int n = 0; n < 2; ++n) {
                            const f32x2 c = cs[(size_t)tok * 32 + n * 16 + cl];
                            const float x1 = nr[n][j], x2 = nr[n + 2][j];
                            o[n][j] = x1 * c.x - x2 * c.y; o[n + 2][j] = x1 * c.y + x2 * c.x;
                        }
                    }
                }
                const int tokb = tok0 + m * 16 + q * 4;
                if (kind == 0) {
                    bf16_t* d = (bf16_t*)(ws + OFF_QA);
#pragma unroll
                    for (int n = 0; n < 4; ++n)
#pragma unroll
                        for (int j = 0; j < 4; ++j) st_bf16(d + (size_t)(tokb + j) * 512 + c64 * 64 + n * 16 + cl, o[n][j]);
                } else if (kind == 1 || kind == 2) {
                    bf16_t* d = (bf16_t*)(ws + (kind == 1 ? OFF_KA : OFF_VA));
#pragma unroll
                    for (int n = 0; n < 4; ++n)
#pragma unroll
                        for (int j = 0; j < 4; ++j) st_bf16(d + (size_t)(tokb + j) * 64 + n * 16 + cl, o[n][j]);
                } else if (kind == 3) {
                    bf16_t* dn = (bf16_t*)(ws + OFF_QBN); bf16_t* dr = (bf16_t*)(ws + OFF_QBR);
                    const int h = c64 - 14;
#pragma unroll
                    for (int n = 0; n < 4; ++n)
#pragma unroll
                        for (int j = 0; j < 4; ++j) {
                            st_bf16(dn + (size_t)(tokb + j) * 512 + h * 64 + n * 16 + cl, nr[n][j]);
                            st_bf16(dr + (size_t)(tokb + j) * 512 + h * 64 + n * 16 + cl, o[n][j]);
                        }
                } else {
                    bf16_t* d = (bf16_t*)(ws + OFF_KV + (size_t)g * KV_STRIDE);
                    const int b = tokb >> 12, tl = tokb & 4095;
                    if (g == 3 || g == 5) {
#pragma unroll
                        for (int n = 0; n < 4; ++n) {
                            u32x2 w; w.x = pk2(o[n][0], o[n][1]); w.y = pk2(o[n][2], o[n][3]);
                            *(u32x2*)(d + ((size_t)((b * 2 + hk) * 64 + n * 16 + cl)) * 4096 + tl) = w;
                        }
                    } else {
#pragma unroll
                        for (int n = 0; n < 4; ++n)
#pragma unroll
                            for (int j = 0; j < 4; ++j) st_bf16(d + ((size_t)((b * 2 + hk) * 4096 + tl + j)) * 64 + n * 16 + cl, o[n][j]);
                    }
                }
            }
        } else if (c64 >= 10 && c64 < 14) {
            bf16_t* d = (bf16_t*)(ws + OFF_QI);
#pragma unroll
            for (int m = 0; m < 4; ++m)
#pragma unroll
                for (int j = 0; j < 4; ++j) {
                    const int tok = tok0 + m * 16 + q * 4 + j;
                    const f32x2 c = cs[(size_t)tok * 32 + 2 * cl];
#pragma unroll
                    for (int hh = 0; hh < 2; ++hh) {
                        const float x1 = acc[m][2 * hh][j], x2 = acc[m][2 * hh + 1][j];
                        const int head = 2 * (c64 - 10) + hh;
                        st_bf16(d + (size_t)tok * 256 + head * 32 + cl, x1 * c.x - x2 * c.y);
                        st_bf16(d + (size_t)tok * 256 + head * 32 + 16 + cl, x1 * c.y + x2 * c.x);
                    }
                }
        } else if (c64 >= 36) {
            bf16_t* d = (bf16_t*)(ws + (c64 < 52 ? OFF_GA : OFF_GB));
            const int cb = (c64 < 52 ? c64 - 36 : c64 - 52) * 64;
#pragma unroll
            for (int m = 0; m < 4; ++m)
#pragma unroll
                for (int n = 0; n < 4; ++n)
#pragma unroll
                    for (int j = 0; j < 4; ++j) st_bf16(d + (size_t)(tok0 + m * 16 + q * 4 + j) * 1024 + cb + n * 16 + cl, sigmoidf_(acc[m][n][j]));
        } else if (c64 == 34) {
            bf16_t* dki = (bf16_t*)(ws + OFF_KI); float* dwi = (float*)(ws + OFF_WI); float* dg = (float*)(ws + OFF_GATES);
#pragma unroll
            for (int m = 0; m < 4; ++m)
#pragma unroll
                for (int j = 0; j < 4; ++j) {
                    const int tok = tok0 + m * 16 + q * 4 + j;
                    const f32x2 c = cs[(size_t)tok * 32 + 2 * cl];
                    const float x1 = acc[m][0][j], x2 = acc[m][1][j];
                    st_bf16(dki + (size_t)tok * 32 + cl, x1 * c.x - x2 * c.y);
                    st_bf16(dki + (size_t)tok * 32 + 16 + cl, x1 * c.y + x2 * c.x);
                    const float v2 = acc[m][2][j], v3 = acc[m][3][j];
                    if (cl < 8) dwi[(size_t)tok * 8 + cl] = v2; else dg[(size_t)tok * 24 + (cl - 8)] = sigmoidf_(v2);
                    dg[(size_t)tok * 24 + 8 + cl] = sigmoidf_(v3);
                }
        }
    }
}

DEVI float siluf_(float x) { return x * __builtin_amdgcn_rcpf(1.0f + __builtin_amdgcn_exp2f(-x * 1.4426950408889634f)); }

DEVI void phase_compress(const Params& P, unsigned char* lds, int tid) {
    unsigned char* ws = P.ws;
    const rsrc_t rs = __builtin_amdgcn_make_buffer_rsrc((void*)P.ws, (short)0, (int)0x7fffffff, 0x00020000);
    const int lane = tid & 63, wid = __builtin_amdgcn_readfirstlane(tid >> 6), wr = wid >> 1, wc = wid & 1, q = lane >> 4, cl = lane & 15;
    for (int u = blockIdx.x; u < 64; u += gridDim.x) {
        const int kv = u >> 5, mt = u & 31;
        const bf16_t* A = (const bf16_t*)(ws + OFF_KV + (size_t)kv * KV_STRIDE) + (size_t)mt * 128 * 1024;
        const bf16_t* W1 = (const bf16_t*)(ws + (kv ? OFF_W1V : OFF_W1K));
        const bf16_t* W2 = (const bf16_t*)(ws + (kv ? OFF_W2V : OFF_W2K));
        const float* bias = (const float*)(ws + OFF_BIAS1) + kv * 128;
        f32x4 acc[4][4];
        gemm128(acc, rs, (unsigned)(OFF_KV + (size_t)kv * KV_STRIDE + (size_t)mt * 128 * 2048), RowLin{2048}, (unsigned)(kv ? OFF_W1V : OFF_W1K), RowLin{4096}, 32, lds, tid);
#pragma unroll
        for (int m = 0; m < 4; ++m)
#pragma unroll
            for (int n = 0; n < 4; ++n) {
                const int col = wc * 64 + n * 16 + cl;
                const float bb = bias[col];
#pragma unroll
                for (int j = 0; j < 4; ++j) {
                    const int row = wr * 64 + m * 16 + q * 4 + j;
                    const int ktile = col >> 6, ch = (col & 63) >> 3, wi = col & 7;
                    *(bf16_t*)(lds + ktile * 16384 + row * 128 + ((ch ^ (row & 7)) << 4) + wi * 2) = (bf16_t)f2bf(siluf_(acc[m][n][j] + bb));
                }
            }
#pragma unroll
        for (int i = 0; i < 4; ++i) {
            const int idx = tid + 256 * i;
            const int row = idx >> 4, ch16 = idx & 15, ktile = ch16 >> 3, ch = ch16 & 7;
            *(u32x4*)(lds + 32768 + ktile * 8192 + row * 128 + ((ch ^ (row & 7)) << 4)) = *(const u32x4*)(W2 + (size_t)row * 128 + ch16 * 8);
        }
        __syncthreads();
        f32x4 a2[4][2];
#pragma unroll
        for (int m = 0; m < 4; ++m) { a2[m][0] = (f32x4){0.f, 0.f, 0.f, 0.f}; a2[m][1] = (f32x4){0.f, 0.f, 0.f, 0.f}; }
#pragma unroll
        for (int kk = 0; kk < 4; ++kk) {
            const int ktile = kk >> 1, ks = kk & 1;
            bf16x8 a[4], b[2];
#pragma unroll
            for (int m = 0; m < 4; ++m) { const int row = wr * 64 + m * 16 + cl; a[m] = *(const bf16x8*)(lds + ktile * 16384 + row * 128 + (((ks * 4 + q) ^ (row & 7)) << 4)); }
#pragma unroll
            for (int n = 0; n < 2; ++n) { const int row = wc * 32 + n * 16 + cl; b[n] = *(const bf16x8*)(lds + 32768 + ktile * 8192 + row * 128 + (((ks * 4 + q) ^ (row & 7)) << 4)); }
#pragma unroll
            for (int m = 0; m < 4; ++m)
#pragma unroll
                for (int n = 0; n < 2; ++n) a2[m][n] = MFMA16(a[m], b[n], a2[m][n]);
        }
#pragma unroll
        for (int m = 0; m < 4; ++m)
#pragma unroll
            for (int n = 0; n < 2; ++n) {
                const int d = wc * 32 + n * 16 + cl;
                const int r0 = mt * 128 + wr * 64 + m * 16 + q * 4;
                float v[4];
#pragma unroll
                for (int j = 0; j < 4; ++j) v[j] = (((r0 + j) & 255) == 255) ? 0.f : a2[m][n][j];
                if (kv == 0) {
                    bf16_t* kc = (bf16_t*)(ws + OFF_KC);
#pragma unroll
                    for (int j = 0; j < 4; ++j) st_bf16(kc + (size_t)(r0 + j) * 64 + d, v[j]);
                } else {
                    bf16_t* vct = (bf16_t*)(ws + OFF_VCT);
                    u32x2 w; w.x = pk2(v[0], v[1]); w.y = pk2(v[2], v[3]);
                    *(u32x2*)(vct + ((size_t)((r0 >> 8) * 64 + d)) * 256 + (r0 & 255)) = w;
                }
            }
        __syncthreads();
    }
}

DEVI void phase_index(const Params& P, unsigned char* lds, int tid) {
    unsigned char* ws = P.ws;
    const bf16_t* QI = (const bf16_t*)(ws + OFF_QI);
    const bf16_t* KI = (const bf16_t*)(ws + OFF_KI);
    const float* WI = (const float*)(ws + OFF_WI);
    bf16_t* SEL = (bf16_t*)(ws + OFF_SEL);
    float* S = (float*)lds;
    const int lane = tid & 63, wid = __builtin_amdgcn_readfirstlane(tid >> 6), q = lane >> 4, cl = lane & 15;
    for (int u = blockIdx.x; u < NTOK / 4; u += gridDim.x) {
        const int tok0 = u * 4, b = tok0 >> 12, t0 = tok0 & 4095;
        const int t = t0 + wid;
        const int tok = tok0 + wid;
        if (t0 + 3 < 256) {
            for (int i = lane; i < 256; i += 64) SEL[(size_t)tok * 256 + i] = (bf16_t)(i <= t ? i : 0);
            continue;
        }
        {
            bf16x8 a[2];
#pragma unroll
            for (int hg = 0; hg < 2; ++hg) a[hg] = *(const bf16x8*)(QI + (size_t)(tok0 + (cl >> 2)) * 256 + (4 * hg + (cl & 3)) * 32 + q * 8);
            const f32x4 w0 = *(const f32x4*)(WI + (size_t)(tok0 + q) * 8), w1 = *(const f32x4*)(WI + (size_t)(tok0 + q) * 8 + 4);
            const int ktmax = (t0 + 3) >> 4;
            const bf16_t* kb = KI + (size_t)b * 4096 * 32 + cl * 32 + q * 8;
            for (int kt = wid; kt <= ktmax; kt += 4) {
                const bf16x8 bk = *(const bf16x8*)(kb + (size_t)kt * 16 * 32);
                f32x4 c0 = {0.f, 0.f, 0.f, 0.f}, c1 = {0.f, 0.f, 0.f, 0.f};
                c0 = MFMA16(a[0], bk, c0); c1 = MFMA16(a[1], bk, c1);
                float s = 0.f;
#pragma unroll
                for (int j = 0; j < 4; ++j) { s += w0[j] * fmaxf(c0[j], 0.f); s += w1[j] * fmaxf(c1[j], 0.f); }
                S[q * 4096 + kt * 16 + cl] = s;
            }
        }
        __syncthreads();
        {
            const int n = t + 1;
            const float* Sq = S + wid * 4096;
            if (n <= 256) {
                for (int i = lane; i < 256; i += 64) SEL[(size_t)tok * 256 + i] = (bf16_t)(i <= t ? i : 0);
            } else {
                const int nr = (n + 63) >> 6;
                float x[64];
                const float NINF = -__builtin_inff();
                float mx = NINF, mn = __builtin_inff();
#pragma unroll
                for (int r = 0; r < 64; ++r) {
                    const int key = r * 64 + lane;
                    const float v = Sq[key];
                    x[r] = (key < n) ? v : NINF;
                    mn = fminf(mn, (key < n) ? v : __builtin_inff());
                    mx = fmaxf(mx, x[r]);
                }
#pragma unroll
                for (int o = 32; o > 0; o >>= 1) { mx = fmaxf(mx, __shfl_xor(mx, o)); mn = fminf(mn, __shfl_xor(mn, o)); }
                float lo = mn, hi = mx, T; int need;
                int chi;
                {
                    int c = 0;
#pragma unroll
                    for (int g8 = 0; g8 < 8; ++g8) if (g8 * 8 < nr) {
#pragma unroll
                        for (int r = g8 * 8; r < g8 * 8 + 8; ++r) c += (x[r] >= hi) ? 1 : 0;
                    }
#pragma unroll
                    for (int o = 32; o > 0; o >>= 1) c += __shfl_xor(c, o);
                    chi = c;
                }
                if (chi >= 256) { T = hi; need = 256;   }
                else {
                    bool found = false; float thr = 0.f;
                    for (int it = 0; it < 64; ++it) {
                        const float mid = 0.5f * lo + 0.5f * hi;
                        if (!(mid > lo && mid < hi)) break;
                        int c = 0;
#pragma unroll
                        for (int g8 = 0; g8 < 8; ++g8) if (g8 * 8 < nr) {
#pragma unroll
                            for (int r = g8 * 8; r < g8 * 8 + 8; ++r) c += (x[r] >= mid) ? 1 : 0;
                        }
#pragma unroll
                        for (int o = 32; o > 0; o >>= 1) c += __shfl_xor(c, o);
                        if (c == 256) { found = true; thr = mid; break; }
                        if (c > 256) lo = mid; else { hi = mid; chi = c; }
                    }
                    if (found) { T = thr; need = -1; }
                    else { T = lo; need = 256 - chi; }
                }
                int base = 0, eqc = 0;
                const unsigned long long lt = (1ull << lane) - 1ull;
#pragma unroll
                for (int g8 = 0; g8 < 8; ++g8) if (g8 * 8 < nr) {
#pragma unroll
                    for (int r = g8 * 8; r < g8 * 8 + 8; ++r) {
                        bool sel;
                        if (need < 0) sel = x[r] >= T;
                        else {
                            const bool eq = (x[r] == T);
                            const unsigned long long em = __ballot(eq);
                            sel = (x[r] > T) || (eq && (eqc + __popcll(em & lt) < need));
                            eqc += __popcll(em);
                        }
                        const unsigned long long sm = __ballot(sel);
                        if (sel) { const int pp = base + __popcll(sm & lt); if (pp < 256) SEL[(size_t)tok * 256 + pp] = (bf16_t)(r * 64 + lane); }
                        base += __popcll(sm);
                    }
                }
            }
        }
        __syncthreads();
    }
}

DEVI void phase_dsa(const Params& P, unsigned char* lds, int tid) {
    unsigned char* ws = P.ws;
    const bf16_t* QA = (const bf16_t*)(ws + OFF_QA);
    const bf16_t* KA = (const bf16_t*)(ws + OFF_KA);
    const bf16_t* VA = (const bf16_t*)(ws + OFF_VA);
    const bf16_t* SEL = (const bf16_t*)(ws + OFF_SEL);
    bf16_t* OA = (bf16_t*)(ws + OFF_OA);
    const int lane = tid & 63, wid = __builtin_amdgcn_readfirstlane(tid >> 6), q = lane >> 4, cl = lane & 15;
    unsigned char* vl = lds + wid * 8192;
    const float NINF = -__builtin_inff();
    for (int tok = blockIdx.x * 4 + wid; tok < NTOK; tok += gridDim.x * 4) {
        const int b = tok >> 12, t = tok & 4095;
        const int cnt = (t + 1 < 256) ? t + 1 : 256;
        const int nc64 = (cnt + 63) >> 6;
        const bf16_t* sel = SEL + (size_t)tok * 256;
        const bf16_t* kb = KA + (size_t)b * 4096 * 64;
        const bf16_t* vb = VA + (size_t)b * 4096 * 64;
        bf16x8 bq[2];
#pragma unroll
        for (int ks = 0; ks < 2; ++ks) {
            bq[ks] = (bf16x8){0, 0, 0, 0, 0, 0, 0, 0};
            if (cl < 8) bq[ks] = *(const bf16x8*)(QA + (size_t)tok * 512 + cl * 64 + ks * 32 + q * 8);
        }
        f32x4 s[16];
#pragma unroll
        for (int rf = 0; rf < 16; ++rf) {
            s[rf] = (f32x4){0.f, 0.f, 0.f, 0.f};
            if ((rf >> 2) < nc64) {
                const int p = 32 * (rf >> 1) + 8 * (cl >> 2) + 4 * (rf & 1) + (cl & 3);
                const int key = sel[p];
                const bf16_t* kr = kb + (size_t)key * 64 + q * 8;
                const bf16x8 a0 = *(const bf16x8*)(kr), a1 = *(const bf16x8*)(kr + 32);
                s[rf] = MFMA16(a0, bq[0], s[rf]); s[rf] = MFMA16(a1, bq[1], s[rf]);
            }
        }
        float mx = NINF;
#pragma unroll
        for (int rf = 0; rf < 16; ++rf)
#pragma unroll
            for (int j = 0; j < 4; ++j) {
                const int p = 32 * (rf >> 1) + 8 * q + 4 * (rf & 1) + j;
                if (p >= cnt) s[rf][j] = NINF;
                mx = fmaxf(mx, s[rf][j]);
            }
        mx = fmaxf(mx, __shfl_xor(mx, 16)); mx = fmaxf(mx, __shfl_xor(mx, 32));
        float ls = 0.f;
#pragma unroll
        for (int rf = 0; rf < 16; ++rf)
#pragma unroll
            for (int j = 0; j < 4; ++j) { const float pv = __builtin_amdgcn_exp2f((s[rf][j] - mx) * LOG2E); s[rf][j] = pv; ls += pv; }
        ls += __shfl_xor(ls, 16); ls += __shfl_xor(ls, 32);
        const float inv = 1.0f / ls;
        f32x4 o[4];
#pragma unroll
        for (int d = 0; d < 4; ++d) o[d] = (f32x4){0.f, 0.f, 0.f, 0.f};
#pragma unroll
        for (int cc = 0; cc < 4; ++cc) {
            if (cc < nc64) {
                const int mykey = sel[cc * 64 + lane];
                __builtin_amdgcn_wave_barrier();
#pragma unroll
                for (int i = 0; i < 8; ++i) {
                    const int row = (lane >> 3) + 8 * i;
                    const int key = __shfl(mykey, row);
                    *(u32x4*)(vl + row * 128 + (lane & 7) * 16) = *(const u32x4*)(vb + (size_t)key * 64 + (lane & 7) * 8);
                }
                __builtin_amdgcn_wave_barrier();
#pragma unroll
                for (int c2 = 0; c2 < 2; ++c2) {
                    const bf16x8 pb = pack8(s[cc * 4 + c2 * 2], s[cc * 4 + c2 * 2 + 1]);
#pragma unroll
                    for (int d = 0; d < 4; ++d) {
                        LAS unsigned char* a0addr = (LAS unsigned char*)(vl) + (c2 * 32 + 8 * q + (cl >> 2)) * 128 + (d * 16 + 4 * (cl & 3)) * 2;
                        const s16x4 lo4 = __builtin_amdgcn_ds_read_tr16_b64_v4i16((LAS s16x4*)(a0addr));
                        const s16x4 hi4 = __builtin_amdgcn_ds_read_tr16_b64_v4i16((LAS s16x4*)(a0addr + 4 * 128));
                        const bf16x8 av = {lo4[0], lo4[1], lo4[2], lo4[3], hi4[0], hi4[1], hi4[2], hi4[3]};
                        o[d] = MFMA16(av, pb, o[d]);
                    }
                }
            }
        }
        if (cl < 8) {
#pragma unroll
            for (int d = 0; d < 4; ++d) {
                u32x2 w; w.x = pk2(o[d][0] * inv, o[d][1] * inv); w.y = pk2(o[d][2] * inv, o[d][3] * inv);
                *(u32x2*)(OA + (size_t)tok * 512 + cl * 64 + d * 16 + q * 4) = w;
            }
        }
    }
}

DEVI int fK(int row) { return (row & 3) | (((row >> 3) & 1) << 2); }

struct AttnState { f32x4 O[4][4]; float m[4]; float l[4]; };

template <int MODE>
DEVI void attn_blocks(rsrc_t rs, unsigned sK, unsigned sV, int ldv, int jb0, int jb1, const bf16x8 (&qf)[4][2], AttnState& st,
                      int tq, unsigned long long selmask, unsigned char* lds, int tid) {
    const int lane = tid & 63, q = lane >> 4, cl = lane & 15;
    const float NINF = -__builtin_inff();
#pragma unroll
    for (int cf = 0; cf < 4; ++cf) { st.m[cf] = NINF; st.l[cf] = 0.f;
#pragma unroll
        for (int d = 0; d < 4; ++d) st.O[d][cf] = (f32x4){0.f, 0.f, 0.f, 0.f}; }
    if (jb1 < jb0) return;
    unsigned kro[2], vro[2]; int kwo[2], vwo[2];
#pragma unroll
    for (int i = 0; i < 2; ++i) {
        const int idx = tid + 256 * i, row = idx >> 3, ch = idx & 7;
        kro[i] = (unsigned)(row * 64 + ch * 8) * 2u; kwo[i] = row * 128 + ((ch ^ fK(row)) << 4);
        vro[i] = (unsigned)(row * ldv + ch * 8) * 2u; vwo[i] = 8192 + row * 128 + ((ch ^ (row & 7)) << 4);
    }
    u32x4 rk[2], rv[2];
#pragma unroll
    for (int i = 0; i < 2; ++i) { rk[i] = bload16(rs, kro[i], sK + (unsigned)jb0 * 8192u); rv[i] = bload16(rs, vro[i], sV + (unsigned)jb0 * 128u); }
#pragma unroll
    for (int i = 0; i < 2; ++i) { *(u32x4*)(lds + kwo[i]) = rk[i]; *(u32x4*)(lds + vwo[i]) = rv[i]; }
    __syncthreads();
    const int nmax = (tq >= 31) ? ((tq - 31) >> 4) : -1;
    for (int jb = jb0; jb <= jb1; ++jb) {
        unsigned char* cur = lds + ((jb - jb0) & 1) * 16384;
        unsigned char* nxt = lds + ((jb - jb0 + 1) & 1) * 16384;
        const bool more = jb < jb1;
        if (more) {
#pragma unroll
            for (int i = 0; i < 2; ++i) { rk[i] = bload16(rs, kro[i], sK + (unsigned)(jb + 1) * 8192u); rv[i] = bload16(rs, vro[i], sV + (unsigned)(jb + 1) * 128u); }
        }
        bool lane_on = true;
        if (MODE == 1) lane_on = ((selmask >> jb) & 1ull) != 0ull;
        if (MODE == 0) lane_on = (jb * 64 <= nmax);
        if (MODE == 2) lane_on = (jb * 64 + 63 > tq - 512);
        if (__ballot(lane_on) != 0ull) {
#pragma unroll
            for (int c = 0; c < 2; ++c) {
                f32x4 S[2][4];
#pragma unroll
                for (int r2 = 0; r2 < 2; ++r2)
#pragma unroll
                    for (int cf = 0; cf < 4; ++cf) S[r2][cf] = (f32x4){0.f, 0.f, 0.f, 0.f};
#pragma unroll
                for (int r2 = 0; r2 < 2; ++r2) {
                    const int kl = 32 * c + 8 * (cl >> 2) + 4 * r2 + (cl & 3);
#pragma unroll
                    for (int ks = 0; ks < 2; ++ks) {
                        const bf16x8 a = *(const bf16x8*)(cur + kl * 128 + (((ks * 4 + q) ^ (cl & 7)) << 4));
#pragma unroll
                        for (int cf = 0; cf < 4; ++cf) S[r2][cf] = MFMA16(a, qf[cf][ks], S[r2][cf]);
                    }
                }
                bf16x8 pb[4];
#pragma unroll
                for (int cf = 0; cf < 4; ++cf) {
                    float bm = NINF;
#pragma unroll
                    for (int r2 = 0; r2 < 2; ++r2)
#pragma unroll
                        for (int j = 0; j < 4; ++j) {
                            const int key = jb * 64 + 32 * c + 8 * q + 4 * r2 + j;
                            bool v;
                            if (MODE == 0) v = key <= nmax;
                            else if (MODE == 1) v = lane_on && key <= tq;
                            else v = key <= tq && key > tq - 512;
                            if (!v) S[r2][cf][j] = NINF;
                            bm = fmaxf(bm, S[r2][cf][j]);
                        }
                    bm = fmaxf(bm, __shfl_xor(bm, 16)); bm = fmaxf(bm, __shfl_xor(bm, 32));
                    const float mnew = fmaxf(st.m[cf], bm);
                    const float mref = (mnew == NINF) ? 0.f : mnew;
                    const float alpha = __builtin_amdgcn_exp2f((st.m[cf] - mref) * LOG2E);
                    st.m[cf] = mnew;
                    float ps = 0.f;
#pragma unroll
                    for (int r2 = 0; r2 < 2; ++r2)
#pragma unroll
                        for (int j = 0; j < 4; ++j) { const float pv = __builtin_amdgcn_exp2f((S[r2][cf][j] - mref) * LOG2E); S[r2][cf][j] = pv; ps += pv; }
                    st.l[cf] = st.l[cf] * alpha + ps;
#pragma unroll
                    for (int d = 0; d < 4; ++d) st.O[d][cf] *= alpha;
                    pb[cf] = pack8(S[0][cf], S[1][cf]);
                }
#pragma unroll
                for (int d = 0; d < 4; ++d) {
                    const int row = d * 16 + cl;
                    const bf16x8 av = *(const bf16x8*)(cur + 8192 + row * 128 + (((c * 4 + q) ^ (row & 7)) << 4));
#pragma unroll
                    for (int cf = 0; cf < 4; ++cf) st.O[d][cf] = MFMA16(av, pb[cf], st.O[d][cf]);
                }
            }
        }
        if (more) {
#pragma unroll
            for (int i = 0; i < 2; ++i) { *(u32x4*)(nxt + kwo[i]) = rk[i]; *(u32x4*)(nxt + vwo[i]) = rv[i]; }
        }
        __syncthreads();
    }
}

DEVI f32x4 bload16f(rsrc_t r, unsigned voff, unsigned soff) { return __builtin_bit_cast(f32x4, __builtin_amdgcn_raw_buffer_load_b128(r, (int)voff, (int)soff, 0)); }
DEVI void bstore16f(rsrc_t r, f32x4 v, unsigned voff, unsigned soff) { __builtin_amdgcn_raw_buffer_store_b128(__builtin_bit_cast(u32x4, v), r, (int)voff, (int)soff, 0); }
DEVI float bload4f(rsrc_t r, unsigned voff, unsigned soff) { return __builtin_bit_cast(float, __builtin_amdgcn_raw_buffer_load_b32(r, (int)voff, (int)soff, 0)); }

struct NsaUnit { int i, b, k, t0, tq; unsigned tokw, tokb, qoff, goff, ooff, sQ, sG, sO; };
DEVI NsaUnit nsa_unit(int uu, int tid) {
    NsaUnit U;
    const int lane = tid & 63, wid = __builtin_amdgcn_readfirstlane(tid >> 6), q = lane >> 4, cl = lane & 15;
    const int half = uu >> 9, r = uu & 511, bk = r & 15, ii = r >> 4;
    U.i = half ? ii : 63 - ii; U.b = bk >> 1; U.k = bk & 1;
    U.t0 = U.i * 64; U.tq = U.t0 + wid * 16 + cl;
    U.tokw = (unsigned)(wid * 16 + cl);
    U.tokb = (unsigned)(U.b * 4096 + U.t0);
    U.qoff = U.tokw * 1024u + (unsigned)q * 16u;
    U.goff = U.tokw * 96u;
    U.ooff = U.tokw * 1024u + (unsigned)q * 8u;
    U.sQ = U.tokb * 1024u + (unsigned)U.k * 512u;
    U.sG = (unsigned)OFF_GATES + U.tokb * 96u + (unsigned)U.k * 16u;
    U.sO = (unsigned)OFF_OB + U.tokb * 1024u + (unsigned)U.k * 512u;
    return U;
}

DEVI void nsa_cmp_unit(const Params& P, rsrc_t rs, int uu, unsigned char* lds, int tid) {
    const int lane = tid & 63, wid = __builtin_amdgcn_readfirstlane(tid >> 6), q = lane >> 4, cl = lane & 15;
    const NsaUnit U = nsa_unit(uu, tid);
    const int i = U.i, b = U.b, k = U.k, tq = U.tq;
    AttnState st;
    bf16x8 qf[4][2];
#pragma unroll
    for (int cf = 0; cf < 4; ++cf)
#pragma unroll
        for (int ks = 0; ks < 2; ++ks) qf[cf][ks] = __builtin_bit_cast(bf16x8, bload16(rs, U.qoff, (unsigned)OFF_QBN + U.sQ + cf * 128 + ks * 64));
    const unsigned sKC = (unsigned)OFF_KC + (unsigned)(b * 2 + k) * 256u * 128u;
    const unsigned sVC = (unsigned)OFF_VCT + (unsigned)(b * 2 + k) * 64u * 512u;
    const int nmax_blk = (U.t0 + 63 - 31) >> 4;
    const int jbc = (nmax_blk >> 6) < 3 ? (nmax_blk >> 6) : 3;
    attn_blocks<0>(rs, sKC, sVC, 256, 0, jbc, qf, st, tq, 0ull, lds, tid);
    float linv[4], mfin[4];
#pragma unroll
    for (int cf = 0; cf < 4; ++cf) {
        float l = st.l[cf]; l += __shfl_xor(l, 16); l += __shfl_xor(l, 32);
        linv[cf] = (l > 0.f) ? __builtin_amdgcn_rcpf(l) : 0.f; mfin[cf] = st.m[cf];
        const float sc = linv[cf] * bload4f(rs, U.goff, U.sG + cf * 4);
#pragma unroll
        for (int d = 0; d < 4; ++d) { const f32x4 v = st.O[d][cf] * sc; u32x2 w; w.x = pk2(v[0], v[1]); w.y = pk2(v[2], v[3]);
            __builtin_amdgcn_raw_buffer_store_b64(w, rs, (int)U.ooff, (int)(U.sO + cf * 128 + d * 32), 0); }
    }
    unsigned long long* MSKG = (unsigned long long*)(P.ws + OFF_MASK);
    if (i < 16) {
        if (q == 0) MSKG[((size_t)(b * 2 + k)) * 4096 + tq] = (2ull << i) - 1ull;
        return;
    }
    float* SUM4 = (float*)(lds + 16384);
    float* LAST = (float*)(lds + 32768);
    float* IMP2 = (float*)(lds + 49152);
    const int nmax = (tq >= 31) ? ((tq - 31) >> 4) : -1;
    for (int kb = 0; kb <= jbc; ++kb) {
#pragma unroll
        for (int ii = 0; ii < 2; ++ii) {
            const int idx = tid + 256 * ii, row = idx >> 3, ch = idx & 7;
            *(u32x4*)(lds + row * 128 + ((ch ^ fK(row)) << 4)) = bload16(rs, (unsigned)(row * 64 + ch * 8) * 2u, sKC + (unsigned)kb * 8192u);
        }
        __syncthreads();
#pragma unroll
        for (int rf = 0; rf < 4; ++rf) {
            f32x4 S[4];
#pragma unroll
            for (int cf = 0; cf < 4; ++cf) S[cf] = (f32x4){0.f, 0.f, 0.f, 0.f};
            const int kl = 32 * (rf >> 1) + 8 * (cl >> 2) + 4 * (rf & 1) + (cl & 3);
#pragma unroll
            for (int ks = 0; ks < 2; ++ks) {
                const bf16x8 a = *(const bf16x8*)(lds + kl * 128 + (((ks * 4 + q) ^ (cl & 7)) << 4));
#pragma unroll
                for (int cf = 0; cf < 4; ++cf) S[cf] = MFMA16(a, qf[cf][ks], S[cf]);
            }
            float acc4 = 0.f, accl = 0.f;
#pragma unroll
            for (int j = 0; j < 4; ++j) {
                const int key = kb * 64 + 32 * (rf >> 1) + 8 * q + 4 * (rf & 1) + j;
                float pj = 0.f;
#pragma unroll
                for (int cf = 0; cf < 4; ++cf) pj += __builtin_amdgcn_exp2f((S[cf][j] - mfin[cf]) * LOG2E) * linv[cf];
                pj = (key <= nmax) ? pj : 0.f;
                acc4 += pj; if (j == 3) accl = pj;
            }
            const int jblk = kb * 16 + 8 * (rf >> 1) + 2 * q + (rf & 1);
            SUM4[(wid * 16 + cl) * 64 + jblk] = acc4; LAST[(wid * 16 + cl) * 64 + jblk] = accl;
        }
        __syncthreads();
    }
    {
        const int qi = tid >> 2, jg = tid & 3;
        const int jlim = (jbc + 1) * 16;
        for (int jj = 0; jj < 16; ++jj) {
            const int j = jg * 16 + jj;
            float v = (j < jlim) ? SUM4[qi * 64 + j] : 0.f;
            if (j >= 1 && j - 1 < jlim) v += LAST[qi * 64 + j - 1];
            IMP2[qi * 64 + j] = v;
        }
    }
    __syncthreads();
    {
        const int qi = tid >> 2, jg = tid & 3;
        const float* row = IMP2 + qi * 64;
        unsigned lo = 0u;
        for (int jj = 0; jj < 16; ++jj) {
            const int j = jg * 16 + jj;
            if (j <= i) {
                const bool forced = (j == 0) || (j == i) || (j == i - 1);
                const float kj = forced ? __builtin_inff() : row[j];
                int rank = 0;
                for (int j2 = 0; j2 <= i; ++j2) {
                    const bool f2 = (j2 == 0) || (j2 == i) || (j2 == i - 1);
                    const float k2 = f2 ? __builtin_inff() : row[j2];
                    rank += (k2 > kj || (k2 == kj && j2 < j)) ? 1 : 0;
                }
                if (rank < 16) lo |= (1u << jj);
            }
        }
        unsigned long long bits = (unsigned long long)lo << (jg * 16);
        bits |= __shfl_xor(bits, 1); bits |= __shfl_xor(bits, 2);
        if (jg == 0) MSKG[((size_t)(b * 2 + k)) * 4096 + U.t0 + qi] = bits;
    }
    __syncthreads();
}

template <int MODE>
DEVI void nsa_kv_unit(const Params& P, rsrc_t rs, int uu, unsigned char* lds, int tid) {
    const int lane = tid & 63, q = lane >> 4;
    const NsaUnit U = nsa_unit(uu, tid);
    const int i = U.i, b = U.b, k = U.k, tq = U.tq;
    AttnState st;
    bf16x8 qf[4][2];
#pragma unroll
    for (int cf = 0; cf < 4; ++cf)
#pragma unroll
        for (int ks = 0; ks < 2; ++ks) qf[cf][ks] = __builtin_bit_cast(bf16x8, bload16(rs, U.qoff, (unsigned)OFF_QBR + U.sQ + cf * 128 + ks * 64));
    const unsigned sK = (unsigned)(OFF_KV + (MODE == 1 ? 2 : 4) * KV_STRIDE) + (unsigned)(b * 2 + k) * 4096u * 128u;
    const unsigned sV = (unsigned)(OFF_KV + (MODE == 1 ? 3 : 5) * KV_STRIDE) + (unsigned)(b * 2 + k) * 64u * 8192u;
    unsigned long long mymask = 0ull;
    int j0 = 0;
    if (MODE == 1) mymask = ((const unsigned long long*)(P.ws + OFF_MASK))[((size_t)(b * 2 + k)) * 4096 + tq];
    else j0 = (i >= 8) ? i - 8 : 0;
    attn_blocks<MODE>(rs, sK, sV, 4096, j0, i, qf, st, tq, mymask, lds, tid);
#pragma unroll
    for (int cf = 0; cf < 4; ++cf) {
        float l = st.l[cf]; l += __shfl_xor(l, 16); l += __shfl_xor(l, 32);
        const float sc = ((l > 0.f) ? __builtin_amdgcn_rcpf(l) : 0.f) * bload4f(rs, U.goff, U.sG + (MODE == 1 ? 32 : 64) + cf * 4);
#pragma unroll
        for (int d = 0; d < 4; ++d) {
            const u32x2 pw = __builtin_bit_cast(u32x2, __builtin_amdgcn_raw_buffer_load_b64(rs, (int)U.ooff, (int)(U.sO + cf * 128 + d * 32), 0));
            f32x4 v = st.O[d][cf] * sc;
            v[0] += bf2f(pw.x & 0xffffu); v[1] += bf2f(pw.x >> 16); v[2] += bf2f(pw.y & 0xffffu); v[3] += bf2f(pw.y >> 16);
            u32x2 w; w.x = pk2(v[0], v[1]); w.y = pk2(v[2], v[3]);
            __builtin_amdgcn_raw_buffer_store_b64(w, rs, (int)U.ooff, (int)(U.sO + cf * 128 + d * 32), 0);
        }
    }
}

DEVI void phase_nsa(const Params& P, unsigned char* lds, int tid) {
    const rsrc_t rs = __builtin_amdgcn_make_buffer_rsrc((void*)P.ws, (short)0, (int)0x7fffffff, 0x00020000);
    for (int uu = blockIdx.x; uu < 1024; uu += gridDim.x) { int t = tid; asm volatile("" : "+v"(t)); nsa_cmp_unit(P, rs, uu, lds, t); }
    __syncthreads();
    for (int uu = blockIdx.x; uu < 1024; uu += gridDim.x) { int t = tid; asm volatile("" : "+v"(t)); nsa_kv_unit<1>(P, rs, uu, lds, t); }
    __syncthreads();
    for (int uu = blockIdx.x; uu < 1024; uu += gridDim.x) { int t = tid; asm volatile("" : "+v"(t)); nsa_kv_unit<2>(P, rs, uu, lds, t); }
}

DEVI void phase_merge(const Params& P, unsigned char* lds, int tid) {
    unsigned char* ws = P.ws;
    const rsrc_t rs = __builtin_amdgcn_make_buffer_rsrc((void*)P.ws, (short)0, (int)0x7fffffff, 0x00020000);
    const bf16_t* ga = (const bf16_t*)(ws + OFF_GA);
    const bf16_t* gb = (const bf16_t*)(ws + OFF_GB);
    bf16_t* mg = (bf16_t*)(ws + OFF_MERGED);
    const int lane = tid & 63, wid = __builtin_amdgcn_readfirstlane(tid >> 6), wr = wid >> 1, wc = wid & 1, q = lane >> 4, cl = lane & 15;
    for (int u = blockIdx.x; u < 256 * 8; u += gridDim.x) {
        const int mt = u >> 3, nt = u & 7;
        f32x4 acc[4][4];
        unsigned t[4][4][2];
        gemm128(acc, rs, (unsigned)(OFF_OA + (size_t)mt * 128 * 1024), RowLin{1024}, (unsigned)(OFF_WBRA + (size_t)nt * 128 * 1024), RowLin{1024}, 8, lds, tid);
        const size_t e0 = (size_t)(mt * 128 + wr * 64 + q * 4) * 1024 + nt * 128 + wc * 64 + cl;
#pragma unroll
        for (int m = 0; m < 4; ++m)
#pragma unroll
            for (int n = 0; n < 4; ++n)
#pragma unroll
                for (int jp = 0; jp < 2; ++jp)
                    t[m][n][jp] = pk2(acc[m][n][2 * jp] * bf2f(ga[e0 + (size_t)(m * 16 + 2 * jp) * 1024 + n * 16]),
                                      acc[m][n][2 * jp + 1] * bf2f(ga[e0 + (size_t)(m * 16 + 2 * jp + 1) * 1024 + n * 16]));
        gemm128(acc, rs, (unsigned)(OFF_OB + (size_t)mt * 128 * 1024), RowLin{1024}, (unsigned)(OFF_WBRB + (size_t)nt * 128 * 1024), RowLin{1024}, 8, lds, tid);
#pragma unroll
        for (int m = 0; m < 4; ++m)
#pragma unroll
            for (int n = 0; n < 4; ++n)
#pragma unroll
                for (int j = 0; j < 4; ++j) {
                    const size_t o = e0 + (size_t)(m * 16 + j) * 1024 + n * 16;
                    const float tv = (j & 1) ? bf2f(t[m][n][j >> 1] >> 16) : bf2f(t[m][n][j >> 1] & 0xffffu);
                    st_bf16(mg + o, tv + acc[m][n][j] * bf2f(gb[o]));
                }
    }
}

DEVI void phase_outproj(const Params& P, unsigned char* lds, int tid) {
    unsigned char* ws = P.ws;
    const rsrc_t rs = __builtin_amdgcn_make_buffer_rsrc((void*)P.ws, (short)0, (int)0x7fffffff, 0x00020000);
    const bf16_t* mg = (const bf16_t*)(ws + OFF_MERGED);
    const bf16_t* wo = (const bf16_t*)(ws + OFF_WOUT);
    const float* x = P.in[0];
    float* x1 = P.out;
    const int lane = tid & 63, wid = __builtin_amdgcn_readfirstlane(tid >> 6), wr = wid >> 1, wc = wid & 1, q = lane >> 4, cl = lane & 15;
    for (int u = blockIdx.x; u < 256 * 8; u += gridDim.x) {
        const int mt = u >> 3, nt = u & 7;
        f32x4 acc[4][4];
        gemm128(acc, rs, (unsigned)(OFF_MERGED + (size_t)mt * 128 * 2048), RowLin{2048}, (unsigned)(OFF_WOUT + (size_t)nt * 128 * 2048), RowLin{2048}, 16, lds, tid);
#pragma unroll
        for (int m = 0; m < 4; ++m)
#pragma unroll
            for (int n = 0; n < 4; ++n)
#pragma unroll
                for (int j = 0; j < 4; ++j) {
                    const size_t o = (size_t)(mt * 128 + wr * 64 + m * 16 + q * 4 + j) * 1024 + nt * 128 + wc * 64 + n * 16 + cl;
                    x1[o] = x[o] + acc[m][n][j];
                }
    }
}

DEVI void phase_router(const Params& P, unsigned char* lds, int tid) {
    unsigned char* ws = P.ws;
    const int lane = tid & 63, wid = __builtin_amdgcn_readfirstlane(tid >> 6);
    const float* x1 = P.out; const float* g = P.in[13];
    const float* wg = P.in[14]; const float* bg = P.in[15]; const float* we = P.in[16]; const float* be = P.in[17];
    bf16_t* h2 = (bf16_t*)(ws + OFF_HN);
    unsigned* cnt = (unsigned*)(ws + OFF_CTL);
    int* list = (int*)(ws + OFF_LIST);
    float* wt = (float*)(ws + OFF_WT);
    for (int r = blockIdx.x * 4 + wid; r < NTOK; r += gridDim.x * 4) {
        const float* xr = x1 + (size_t)r * 1024;
        float ss = 0.f;
#pragma unroll
        for (int i = 0; i < 4; ++i) { const f32x4 v = *(const f32x4*)(xr + i * 256 + lane * 4); ss += v[0] * v[0] + v[1] * v[1] + v[2] * v[2] + v[3] * v[3]; }
        ss = wave_sum(ss);
        const float rs = rsqrtf(ss * (1.0f / 1024.0f) + RMS_EPS);
        float lg[36];
#pragma unroll
        for (int e = 0; e < 36; ++e) lg[e] = 0.f;
#pragma unroll 1
        for (int i = 0; i < 4; ++i) {
            const int k0 = i * 256 + lane * 4;
            const f32x4 v = *(const f32x4*)(xr + k0);
            const f32x4 gg = *(const f32x4*)(g + k0);
            float h[4];
#pragma unroll
            for (int c = 0; c < 4; ++c) h[c] = v[c] * rs * gg[c];
            u32x2 w; w.x = pk2(h[0], h[1]); w.y = pk2(h[2], h[3]);
            *(u32x2*)(h2 + (size_t)r * 1024 + k0) = w;
            const float* wgp = wg + (size_t)k0 * 4;
            const float* wep = we + (size_t)k0 * 32;
#pragma unroll
            for (int c = 0; c < 4; ++c) {
                const f32x4 wgv = *(const f32x4*)(wgp + c * 4);
#pragma unroll
                for (int e = 0; e < 4; ++e) lg[e] += h[c] * wgv[e];
#pragma unroll
                for (int e4 = 0; e4 < 8; ++e4) {
                    const f32x4 wev = *(const f32x4*)(wep + c * 32 + e4 * 4);
#pragma unroll
                    for (int e = 0; e < 4; ++e) lg[4 + e4 * 4 + e] += h[c] * wev[e];
                }
            }
        }
#pragma unroll
        for (int e = 0; e < 36; ++e) lg[e] = wave_sum(lg[e]);
        float gl[4];
#pragma unroll
        for (int e = 0; e < 4; ++e) gl[e] = lg[e] + bg[e];
        int gs = 0; float gm = gl[0];
#pragma unroll
        for (int e = 1; e < 4; ++e) if (gl[e] > gm) { gm = gl[e]; gs = e; }
        float den = 0.f;
#pragma unroll
        for (int e = 0; e < 4; ++e) den += __expf(gl[e] - gm);
        const float gp = 1.0f / den;
        float el[8];
#pragma unroll
        for (int e = 0; e < 8; ++e) {
            float vsel = lg[4 + e] + be[e];
            if (gs == 1) vsel = lg[12 + e] + be[8 + e];
            if (gs == 2) vsel = lg[20 + e] + be[16 + e];
            if (gs == 3) vsel = lg[28 + e] + be[24 + e];
            el[e] = vsel;
        }
        int i0 = 0; float v0 = el[0];
#pragma unroll
        for (int e = 1; e < 8; ++e) if (el[e] > v0) { v0 = el[e]; i0 = e; }
        int i1 = -1; float v1 = -__builtin_inff();
#pragma unroll
        for (int e = 0; e < 8; ++e) if (e != i0 && el[e] > v1) { v1 = el[e]; i1 = e; }
        const float e1 = __expf(v1 - v0);
        const float w0 = gp / (1.0f + e1), w1 = gp * e1 / (1.0f + e1);
        if (lane == 0) {
            const int ex0 = gs * 8 + i0, ex1 = gs * 8 + i1;
            const unsigned p0 = atomicAdd(&cnt[ex0], 1u);
            list[(size_t)ex0 * NTOK + p0] = r * 2 + 0;
            const unsigned p1 = atomicAdd(&cnt[ex1], 1u);
            list[(size_t)ex1 * NTOK + p1] = r * 2 + 1;
            wt[(size_t)r * 2 + 0] = w0; wt[(size_t)r * 2 + 1] = w1;
        }
    }
}

struct RowGather { const int* idx; DEVI unsigned operator()(int r) const { return (unsigned)idx[r] * 2048u; } };
struct RowGU { int c0; DEVI unsigned operator()(int r) const {
    const int wcx = r >> 6, w = r & 63; const int col = (w < 32) ? (c0 + wcx * 32 + w) : (256 + c0 + wcx * 32 + (w - 32)); return (unsigned)col * 2048u; } };

DEVI void phase_moe(const Params& P, unsigned char* lds, int tid) {
    unsigned char* ws = P.ws;
    const rsrc_t rs = __builtin_amdgcn_make_buffer_rsrc((void*)P.ws, (short)0, (int)0x7fffffff, 0x00020000);
    const int lane = tid & 63, wid = __builtin_amdgcn_readfirstlane(tid >> 6), wr = wid >> 1, wc = wid & 1, q = lane >> 4, cl = lane & 15;
    const unsigned* cnt = (const unsigned*)(ws + OFF_CTL);
    const int* list = (const int*)(ws + OFF_LIST);
    const bf16_t* h2 = (const bf16_t*)(ws + OFF_HN);
    const bf16_t* wgu = (const bf16_t*)(ws + OFF_WGU);
    const bf16_t* wdn = (const bf16_t*)(ws + OFF_WDN);
    bf16_t* act = (bf16_t*)(ws + OFF_ACT);
    bf16_t* Y = (bf16_t*)(ws + OFF_Y);
    int* rowtok = (int*)(lds + 65536);
    int* rowas = (int*)(lds + 65536 + 512);
    int total = 0;
    for (int e = 0; e < 32; ++e) total += ((int)cnt[e] + 127) >> 7;
    for (int u = blockIdx.x; u < total; u += gridDim.x) {
        int e = 0, tl = u;
        for (; e < 32; ++e) { const int nt = ((int)cnt[e] + 127) >> 7; if (tl < nt) break; tl -= nt; }
        const int ce = (int)cnt[e];
        if (tid < 128) {
            const int r = tl * 128 + tid;
            const int as = (r < ce) ? list[(size_t)e * NTOK + r] : -1;
            rowas[tid] = as; rowtok[tid] = (as >= 0) ? (as >> 1) : 0;
        }
        __syncthreads();
        bf16_t* au = act + (size_t)u * 128 * 256;
        for (int nt = 0; nt < 4; ++nt) {
            f32x4 acc[4][4];
            gemm128(acc, rs, (unsigned)OFF_HN, RowGather{rowtok}, (unsigned)(OFF_WGU + (size_t)e * 512 * 2048), RowGU{nt * 64}, 16, lds, tid);
#pragma unroll
            for (int m = 0; m < 4; ++m)
#pragma unroll
                for (int n = 0; n < 2; ++n)
#pragma unroll
                    for (int j = 0; j < 4; ++j) {
                        const float gt = acc[m][n][j], up = acc[m][n + 2][j];
                        const int row = wr * 64 + m * 16 + q * 4 + j, col = nt * 64 + wc * 32 + n * 16 + cl;
                        st_bf16(au + (size_t)row * 256 + col, siluf_(gt) * up);
                    }
        }
        __syncthreads();
        for (int nt = 0; nt < 8; ++nt) {
            f32x4 acc[4][4];
            gemm128(acc, rs, (unsigned)(OFF_ACT + (size_t)u * 128 * 512), RowLin{512}, (unsigned)(OFF_WDN + (size_t)e * 1024 * 512 + (size_t)nt * 128 * 512), RowLin{512}, 4, lds, tid);
#pragma unroll
            for (int m = 0; m < 4; ++m)
#pragma unroll
                for (int j = 0; j < 4; ++j) {
                    const int row = wr * 64 + m * 16 + q * 4 + j;
                    const int as = rowas[row];
                    if (as >= 0) {
                        bf16_t* yr = Y + ((size_t)(as & 1) * NTOK + (as >> 1)) * 1024 + nt * 128 + wc * 64 + cl;
#pragma unroll
                        for (int n = 0; n < 4; ++n) st_bf16(yr + n * 16, acc[m][n][j]);
                    }
                }
        }
        __syncthreads();
    }
}

DEVI void phase_final(const Params& P, int tid, bool with_moe) {
    unsigned char* ws = P.ws;
    const int lane = tid & 63, wid = __builtin_amdgcn_readfirstlane(tid >> 6);
    const bf16_t* Y = (const bf16_t*)(ws + OFF_Y);
    const float* wt = (const float*)(ws + OFF_WT);
    const float* g = P.in[20];
    float* out = P.out;
    for (int r = blockIdx.x * 4 + wid; r < NTOK; r += gridDim.x * 4) {
        float* xr = out + (size_t)r * 1024;
        const float w0 = with_moe ? wt[(size_t)r * 2] : 0.f, w1 = with_moe ? wt[(size_t)r * 2 + 1] : 0.f;
        f32x4 v[4]; float ss = 0.f;
#pragma unroll
        for (int i = 0; i < 4; ++i) {
            v[i] = *(const f32x4*)(xr + i * 256 + lane * 4);
            if (with_moe) {
                const u32x2 a = *(const u32x2*)(Y + (size_t)r * 1024 + i * 256 + lane * 4);
                const u32x2 b = *(const u32x2*)(Y + ((size_t)NTOK + r) * 1024 + i * 256 + lane * 4);
                v[i][0] += w0 * bf2f(a.x & 0xffffu) + w1 * bf2f(b.x & 0xffffu); v[i][1] += w0 * bf2f(a.x >> 16) + w1 * bf2f(b.x >> 16);
                v[i][2] += w0 * bf2f(a.y & 0xffffu) + w1 * bf2f(b.y & 0xffffu); v[i][3] += w0 * bf2f(a.y >> 16) + w1 * bf2f(b.y >> 16);
            }
            ss += v[i][0] * v[i][0] + v[i][1] * v[i][1] + v[i][2] * v[i][2] + v[i][3] * v[i][3];
        }
        ss = wave_sum(ss);
        const float rs = rsqrtf(ss * (1.0f / 1024.0f) + RMS_EPS);
#pragma unroll
        for (int i = 0; i < 4; ++i) {
            const f32x4 gg = *(const f32x4*)(g + i * 256 + lane * 4);
            f32x4 o; o[0] = v[i][0] * rs * gg[0]; o[1] = v[i][1] * rs * gg[1]; o[2] = v[i][2] * rs * gg[2]; o[3] = v[i][3] * rs * gg[3];
            *(f32x4*)(xr + i * 256 + lane * 4) = o;
        }
    }
}

#define LAUNDER_TID() do { tid = threadIdx.x; asm volatile("" : "+v"(tid)); } while (0)
__global__ void __launch_bounds__(NTHREADS, 2) fwd_megakernel(Params P) {
    extern __shared__ __attribute__((aligned(16))) unsigned char lds[];
    cg::grid_group grid = cg::this_grid();
    int tid;
    LAUNDER_TID(); phase_prep(P, lds, tid);
    grid.sync();
    LAUNDER_TID(); phase_gemm1(P, lds, tid);
    grid.sync();
    LAUNDER_TID(); phase_compress(P, lds, tid);
    __syncthreads();
    LAUNDER_TID(); phase_index(P, lds, tid);
    grid.sync();
    LAUNDER_TID(); phase_dsa(P, lds, tid);
    __syncthreads();
    LAUNDER_TID(); phase_nsa(P, lds, tid);
    grid.sync();
    LAUNDER_TID(); phase_merge(P, lds, tid);
    grid.sync();
    LAUNDER_TID(); phase_outproj(P, lds, tid);
    grid.sync();
    LAUNDER_TID(); phase_router(P, lds, tid);
    grid.sync();
    LAUNDER_TID(); phase_moe(P, lds, tid);
    grid.sync();
    LAUNDER_TID(); phase_final(P, tid, true);
}

extern "C" void kernel_launch(void* const* d_in, const int* in_sizes, int n_in, void* d_out, int out_size, void* d_ws, size_t ws_size,
                              hipStream_t stream) {
    static int grid_blocks = 0;
    if (!grid_blocks) {
        int dev = 0, cus = 0, per_cu = 0;
        hipGetDevice(&dev);
        hipDeviceGetAttribute(&cus, hipDeviceAttributeMultiprocessorCount, dev);
        hipFuncSetAttribute((const void*)fwd_megakernel, hipFuncAttributeMaxDynamicSharedMemorySize, LDS_BYTES);
        hipOccupancyMaxActiveBlocksPerMultiprocessor(&per_cu, (const void*)fwd_megakernel, NTHREADS, LDS_BYTES);
        if (per_cu < 1) per_cu = 1;
        if (per_cu > 2) per_cu = 2;
        grid_blocks = cus * per_cu;
        if (ws_size < WS_END) fprintf(stderr, "kernel_launch: workspace too small: %zu < %zu\n", ws_size, (size_t)WS_END);
    }
    Params p{};
    for (int i = 0; i < 21; ++i) p.in[i] = (const float*)d_in[i];
    p.pos = (const int*)d_in[1];
    p.out = (float*)d_out;
    p.ws = (unsigned char*)d_ws;
    for (int i = 0; i < 32; ++i) p.inv_freq[i] = (double)powf(10000.0f, -(float)i / 32.0f);
    p.ph_lo = 0; p.ph_hi = 0;
    void* args[] = {&p};
    hipError_t e = hipLaunchCooperativeKernel((const void*)fwd_megakernel, dim3(grid_blocks), dim3(NTHREADS), args, LDS_BYTES, stream);
    if (e != hipSuccess) fprintf(stderr, "cooperative launch failed: %s (grid %d)\n", hipGetErrorString(e), grid_blocks);
}
```

```cpp
#include <hip/hip_runtime.h>
#include <hip/hip_cooperative_groups.h>
#include <cstdint>
#include <cstdio>
#include <cmath>
namespace cg = cooperative_groups;

#define DEVI __device__ __forceinline__
typedef unsigned short bf16_t;
typedef short bf16x8 __attribute__((ext_vector_type(8)));
typedef short s16x4 __attribute__((ext_vector_type(4)));
typedef float f32x4 __attribute__((ext_vector_type(4)));
typedef float f32x2 __attribute__((ext_vector_type(2)));
typedef unsigned u32x4 __attribute__((ext_vector_type(4)));
typedef unsigned u32x2 __attribute__((ext_vector_type(2)));
#define LAS __attribute__((address_space(3)))

constexpr int NB = 8, SL = 4096, DM = 1024, NTOK = NB * SL;
constexpr int INW = 4288;
constexpr int NTHREADS = 256;
constexpr int LDS_BYTES = 81920;
constexpr float RMS_EPS = 1e-6f;
constexpr float LOG2E = 1.4426950408889634f;

constexpr int WIN_ROWS = 4352;
constexpr int G1_COLS = 4352;

constexpr size_t al256(size_t x) { return (x + 255) & ~(size_t)255; }
constexpr size_t OFF_CTL   = 0;
constexpr size_t OFF_BAR   = 4096;
constexpr size_t OFF_WIN_T = 32768;
constexpr size_t OFF_WBRA  = OFF_WIN_T + (size_t)WIN_ROWS * 1024 * 2;
constexpr size_t OFF_WBRB  = OFF_WBRA + (size_t)1024 * 512 * 2;
constexpr size_t OFF_WOUT  = OFF_WBRB + (size_t)1024 * 512 * 2;
constexpr size_t OFF_W1K   = OFF_WOUT + (size_t)1024 * 1024 * 2;
constexpr size_t OFF_W1V   = OFF_W1K + (size_t)128 * 2048 * 2;
constexpr size_t OFF_W2K   = OFF_W1V + (size_t)128 * 2048 * 2;
constexpr size_t OFF_W2V   = OFF_W2K + (size_t)64 * 128 * 2;
constexpr size_t OFF_WGU   = OFF_W2V + (size_t)64 * 128 * 2;
constexpr size_t OFF_WDN   = OFF_WGU + (size_t)32 * 512 * 1024 * 2;
constexpr size_t OFF_BIAS1 = OFF_WDN + (size_t)32 * 1024 * 256 * 2;
constexpr size_t OFF_CS    = OFF_BIAS1 + 1024;
constexpr size_t OFF_HN    = OFF_CS + (size_t)NTOK * 32 * 8;
constexpr size_t OFF_QA    = OFF_HN + (size_t)NTOK * 1024 * 2;
constexpr size_t OFF_KA    = OFF_QA + (size_t)NTOK * 512 * 2;
constexpr size_t OFF_VA    = OFF_KA + (size_t)NTOK * 64 * 2;
constexpr size_t OFF_QI    = OFF_VA + (size_t)NTOK * 64 * 2;
constexpr size_t OFF_KI    = OFF_QI + (size_t)NTOK * 256 * 2;
constexpr size_t OFF_WI    = OFF_KI + (size_t)NTOK * 32 * 2;
constexpr size_t OFF_QBN   = OFF_WI + (size_t)NTOK * 8 * 4;
constexpr size_t OFF_QBR   = OFF_QBN + (size_t)NTOK * 512 * 2;
constexpr size_t KV_STRIDE = (size_t)NTOK * 128 * 2 + 65536 * 4;
constexpr size_t OFF_KV    = OFF_QBR + (size_t)NTOK * 512 * 2;
constexpr size_t OFF_GATES = OFF_KV + 6 * KV_STRIDE;
constexpr size_t OFF_QKV_END = OFF_GATES + (size_t)NTOK * 24 * 4;
constexpr size_t OFF_KC    = al256(OFF_QKV_END);
constexpr size_t OFF_VCT   = OFF_KC + (size_t)16 * 256 * 64 * 2;
constexpr size_t OFF_SEL   = OFF_VCT + (size_t)16 * 256 * 64 * 2;
constexpr size_t OFF_OA    = OFF_HN;
constexpr size_t OFF_OB    = OFF_OA + (size_t)NTOK * 512 * 2;
constexpr size_t OFF_GA    = OFF_SEL + (size_t)NTOK * 256 * 2;
constexpr size_t OFF_GB    = OFF_GA + (size_t)NTOK * 1024 * 2;
constexpr size_t OFF_MASK  = OFF_GB + (size_t)NTOK * 1024 * 2;
constexpr size_t OFF_LIST  = OFF_MASK + (size_t)16 * 4096 * 8;
constexpr size_t OFF_WT    = OFF_LIST + (size_t)32 * NTOK * 4;
constexpr size_t WS_END    = OFF_WT + (size_t)NTOK * 2 * 4;
constexpr size_t OFF_MERGED = OFF_QA;
constexpr size_t OFF_ACT    = OFF_QA;
constexpr size_t OFF_Y      = OFF_QA + (size_t)40 * 1024 * 1024;
static_assert(OFF_Y + (size_t)2 * NTOK * 1024 * 2 <= OFF_QKV_END, "Y overlay");
static_assert((size_t)544 * 128 * 256 * 2 <= (size_t)40 * 1024 * 1024, "ACT overlay");

struct Params {
    const float* in[21];
    const int* pos;
    float* out;
    unsigned char* ws;
    double inv_freq[32];
    int ph_lo, ph_hi;
};

DEVI unsigned f2bf(float f) { unsigned u = __float_as_uint(f); return (u + 0x7fffu + ((u >> 16) & 1u)) >> 16; }
DEVI unsigned pk2(float lo, float hi) { return f2bf(lo) | (f2bf(hi) << 16); }
DEVI float bf2f(unsigned h) { return __uint_as_float(h << 16); }
DEVI float sigmoidf_(float x) { return __builtin_amdgcn_rcpf(1.0f + __builtin_amdgcn_exp2f(-x * 1.4426950408889634f)); }
DEVI float wave_sum(float v) {
#pragma unroll
    for (int o = 32; o > 0; o >>= 1) v += __shfl_xor(v, o);
    return v;
}
DEVI bf16x8 pack8(const f32x4& a, const f32x4& b) {
    u32x4 w; w.x = pk2(a[0], a[1]); w.y = pk2(a[2], a[3]); w.z = pk2(b[0], b[1]); w.w = pk2(b[2], b[3]);
    return __builtin_bit_cast(bf16x8, w);
}
#define MFMA16(a, b, c) __builtin_amdgcn_mfma_f32_16x16x32_bf16((a), (b), (c), 0, 0, 0)


#define XB_TMO      128
#define XB_XCNT(j)  (256  + 64 * (j))
#define XB_XSUB(j)  (1280 + 64 * (j))
#define XB_XGEN(j)  (2304 + 64 * (j))
#define XB_TOP      3328
#define XB_TOPGEN   3392
#define XCD_BAR_WORDS 3456
#define XB_SPIN_CAP (1u << 22)
DEVI unsigned xb_ld(unsigned* p)              { return __hip_atomic_load(p, __ATOMIC_RELAXED, __HIP_MEMORY_SCOPE_AGENT); }
DEVI unsigned xb_add(unsigned* p, unsigned v) { return __hip_atomic_fetch_add(p, v, __ATOMIC_RELAXED, __HIP_MEMORY_SCOPE_AGENT); }
DEVI unsigned xb_xcc_id() { return (unsigned)__builtin_amdgcn_s_getreg((3 << 11) | 20) & 0xFu; }
#define XB_SPIN(cond, bar) do { unsigned _sp = 0; while (cond) { __builtin_amdgcn_s_sleep(1); \
    if ((++_sp & 255u) == 0u) { if (xb_ld(&(bar)[XB_TMO])) break; if (_sp > XB_SPIN_CAP) { atomicAdd(&(bar)[XB_TMO], 1u); break; } } } } while (0)
struct XcdBarrier { unsigned* bar; unsigned x; volatile LAS unsigned* st; };
DEVI XcdBarrier xcd_barrier_post(unsigned* bar, volatile LAS unsigned* st) {
    XcdBarrier b; b.bar = bar; b.x = xb_xcc_id(); b.st = st;
    if (threadIdx.x == 0) (void)xb_add(&bar[XB_XCNT(b.x)], 1u);
    return b;
}
DEVI void xcd_barrier_complete(unsigned* bar, unsigned x, unsigned& nloc, unsigned& nx) {
    const unsigned G = gridDim.x * gridDim.y * gridDim.z;
    unsigned sum, cnt, mine, sp = 0u;
    for (;;) {
        sum = 0u; cnt = 0u; mine = 0u;
#pragma unroll
        for (unsigned j = 0; j < 16; ++j) { const unsigned c = xb_ld(&bar[XB_XCNT(j)]); sum += c; cnt += (c > 0u) ? 1u : 0u; mine = (j == x) ? c : mine; }
        if (sum == G) break;
        __builtin_amdgcn_s_sleep(1);
        if ((++sp & 255u) == 0u) { if (xb_ld(&bar[XB_TMO])) break; if (sp > XB_SPIN_CAP) { atomicAdd(&bar[XB_TMO], 1u); break; } }
    }
    nloc = mine > 0u ? mine : 1u; nx = cnt > 0u ? cnt : 1u;
}
DEVI void xcd_barrier(const XcdBarrier& b) {
    asm volatile("s_waitcnt vmcnt(0)" ::: "memory");
    __syncthreads();
    if (threadIdx.x == 0) {
        unsigned* bar = b.bar;
        __builtin_amdgcn_s_waitcnt(0);
        unsigned nloc = b.st[0], nx = b.st[1];
        if (nloc == 0u) { xcd_barrier_complete(bar, b.x, nloc, nx); b.st[0] = nloc; b.st[1] = nx; }
        const unsigned old = xb_add(&bar[XB_XSUB(b.x)], 1u);
        const unsigned gen = old / nloc;
        if (old + 1u == (gen + 1u) * nloc) {
            __builtin_amdgcn_fence(__ATOMIC_RELEASE, "agent");
            asm volatile("s_waitcnt vmcnt(0)" ::: "memory");
            const unsigned og = xb_add(&bar[XB_TOP], 1u);
            const unsigned tg = og / nx;
            if (og + 1u == (tg + 1u) * nx) xb_add(&bar[XB_TOPGEN], 1u);
            else XB_SPIN(xb_ld(&bar[XB_TOPGEN]) == tg, bar);
            __builtin_amdgcn_fence(__ATOMIC_ACQUIRE, "agent");
            xb_add(&bar[XB_XGEN(b.x)], 1u);
            asm volatile("s_waitcnt vmcnt(0)" ::: "memory");
        } else {
            XB_SPIN(xb_ld(&bar[XB_XGEN(b.x)]) == gen, bar);
            __builtin_amdgcn_fence(__ATOMIC_ACQUIRE, "agent");
            asm volatile("s_waitcnt vmcnt(0)" ::: "memory");
        }
    }
    __syncthreads();
}

typedef __amdgpu_buffer_rsrc_t rsrc_t;
DEVI u32x4 bload16(rsrc_t r, unsigned voff, unsigned soff) { return __builtin_bit_cast(u32x4, __builtin_amdgcn_raw_buffer_load_b128(r, (int)voff, (int)soff, 0)); }
template <class FA, class FB>
DEVI void gemm128(f32x4 (&acc)[4][4], rsrc_t rs, unsigned sA, const FA& offA, unsigned sB, const FB& offB, int nk, unsigned char* lds, int tid) {
    const int lane = tid & 63, wid = __builtin_amdgcn_readfirstlane(tid >> 6), wr = wid >> 1, wc = wid & 1;
    const int lr = tid >> 3, lc = tid & 7;
    unsigned oa[4], ob[4];
#pragma unroll
    for (int i = 0; i < 4; ++i) { oa[i] = offA(lr + 32 * i) + lc * 16; ob[i] = offB(lr + 32 * i) + lc * 16; }
#pragma unroll
    for (int m = 0; m < 4; ++m)
#pragma unroll
        for (int n = 0; n < 4; ++n) acc[m][n] = (f32x4){0.f, 0.f, 0.f, 0.f};
    const int woff = lr * 128 + ((lc ^ (lr & 7)) << 4);
    const int q = lane >> 4, r16 = lane & 15;
    const int roffA0 = (wr * 64 + r16) * 128 + (((0 + q) ^ (lane & 7)) << 4);
    const int roffA1 = (wr * 64 + r16) * 128 + (((4 + q) ^ (lane & 7)) << 4);
    const int roffB0 = 16384 + (wc * 64 + r16) * 128 + (((0 + q) ^ (lane & 7)) << 4);
    const int roffB1 = 16384 + (wc * 64 + r16) * 128 + (((4 + q) ^ (lane & 7)) << 4);
    u32x4 ra[4], rb[4];
#pragma unroll
    for (int i = 0; i < 4; ++i) { ra[i] = bload16(rs, oa[i], sA); rb[i] = bload16(rs, ob[i], sB); }
#pragma unroll
    for (int i = 0; i < 4; ++i) { *(u32x4*)(lds + woff + i * 4096) = ra[i]; *(u32x4*)(lds + 16384 + woff + i * 4096) = rb[i]; }
    __syncthreads();
    for (int kt = 0; kt < nk; ++kt) {
        unsigned char* cur = lds + (kt & 1) * 32768;
        unsigned char* nxt = lds + ((kt + 1) & 1) * 32768;
        const bool more = (kt + 1 < nk);
        if (more) {
#pragma unroll
            for (int i = 0; i < 4; ++i) { ra[i] = bload16(rs, oa[i], sA + (kt + 1) * 128); rb[i] = bload16(rs, ob[i], sB + (kt + 1) * 128); }
        }
#pragma unroll
        for (int ks = 0; ks < 2; ++ks) {
            bf16x8 a[4], b[4];
#pragma unroll
            for (int m = 0; m < 4; ++m) a[m] = *(const bf16x8*)(cur + (ks ? roffA1 : roffA0) + m * 2048);
#pragma unroll
            for (int n = 0; n < 4; ++n) b[n] = *(const bf16x8*)(cur + (ks ? roffB1 : roffB0) + n * 2048);
#pragma unroll
            for (int m = 0; m < 4; ++m)
#pragma unroll
                for (int n = 0; n < 4; ++n) acc[m][n] = MFMA16(a[m], b[n], acc[m][n]);
        }
        if (more) {
#pragma unroll
            for (int i = 0; i < 4; ++i) { *(u32x4*)(nxt + woff + i * 4096) = ra[i]; *(u32x4*)(nxt + 16384 + woff + i * 4096) = rb[i]; }
        }
        __syncthreads();
    }
}

struct RowLin { unsigned ldb; DEVI unsigned operator()(int r) const { return (unsigned)r * ldb; } };

DEVI int win_map(int j) {
    if (j < 896) return j;
    if (j < 1408) return j - 896 + 936;
    if (j < 2176) return j - 1408 + 1448;
    if (j < 2208) return j - 2176 + 896;
    if (j < 2216) return j - 2208 + 928;
    if (j < 2240) return j;
    if (j < 2304) return -1;
    return j - 64;
}

struct TJob { const float* src; bf16_t* dst; int K, ld, nrows, perm, nb; size_t sb, db; };
DEVI TJob get_tjob(const Params& P, int j) {
    unsigned char* ws = P.ws;
    switch (j) {
        case 0: return TJob{P.in[3], (bf16_t*)(ws + OFF_WIN_T), 1024, INW, WIN_ROWS, 1, 1, 0, 0};
        case 1: return TJob{P.in[10], (bf16_t*)(ws + OFF_WBRA), 512, 1024, 1024, 0, 1, 0, 0};
        case 2: return TJob{P.in[11], (bf16_t*)(ws + OFF_WBRB), 512, 1024, 1024, 0, 1, 0, 0};
        case 3: return TJob{P.in[12], (bf16_t*)(ws + OFF_WOUT), 1024, 1024, 1024, 0, 1, 0, 0};
        case 4: return TJob{P.in[5], (bf16_t*)(ws + OFF_W1K), 2048, 128, 128, 0, 1, 0, 0};
        case 5: return TJob{P.in[8], (bf16_t*)(ws + OFF_W1V), 2048, 128, 128, 0, 1, 0, 0};
        case 6: return TJob{P.in[6], (bf16_t*)(ws + OFF_W2K), 128, 64, 64, 0, 1, 0, 0};
        case 7: return TJob{P.in[9], (bf16_t*)(ws + OFF_W2V), 128, 64, 64, 0, 1, 0, 0};
        case 8: return TJob{P.in[18], (bf16_t*)(ws + OFF_WGU), 1024, 512, 512, 0, 32, (size_t)1024 * 512, (size_t)512 * 1024};
        default: return TJob{P.in[19], (bf16_t*)(ws + OFF_WDN), 256, 1024, 1024, 0, 32, (size_t)256 * 1024, (size_t)1024 * 256};
    }
}
DEVI int tjob_tiles(int j) {
    switch (j) {
        case 0: return (WIN_ROWS / 64) * 16;
        case 1: case 2: return 16 * 8;
        case 3: return 16 * 16;
        case 4: case 5: return 2 * 32;
        case 6: case 7: return 1 * 2;
        case 8: return 32 * 8 * 16;
        default: return 32 * 16 * 4;
    }
}

DEVI void transpose_tile(const TJob& J, int tile, unsigned char* lds, int tid) {
    float* T = (float*)lds;
    const int kt = J.K / 64, rt = J.nrows / 64;
    const int b = tile / (kt * rt), rem = tile % (kt * rt);
    const int r0 = (rem / kt) * 64, k0 = (rem % kt) * 64;
    const float* src = J.src + (size_t)b * J.sb;
    bf16_t* dst = J.dst + (size_t)b * J.db;
    const int rr = tid & 63;
    int col = r0 + rr; if (J.perm) col = win_map(col);
#pragma unroll
    for (int i = 0; i < 16; ++i) {
        const int kk = i * 4 + (tid >> 6);
        T[kk * 65 + rr] = (col >= 0) ? src[(size_t)(k0 + kk) * J.ld + col] : 0.f;
    }
    __syncthreads();
    const int r2 = tid >> 2, ks = (tid & 3) * 16;
    u32x4 w0, w1;
    w0.x = pk2(T[(ks + 0) * 65 + r2], T[(ks + 1) * 65 + r2]); w0.y = pk2(T[(ks + 2) * 65 + r2], T[(ks + 3) * 65 + r2]);
    w0.z = pk2(T[(ks + 4) * 65 + r2], T[(ks + 5) * 65 + r2]); w0.w = pk2(T[(ks + 6) * 65 + r2], T[(ks + 7) * 65 + r2]);
    w1.x = pk2(T[(ks + 8) * 65 + r2], T[(ks + 9) * 65 + r2]); w1.y = pk2(T[(ks + 10) * 65 + r2], T[(ks + 11) * 65 + r2]);
    w1.z = pk2(T[(ks + 12) * 65 + r2], T[(ks + 13) * 65 + r2]); w1.w = pk2(T[(ks + 14) * 65 + r2], T[(ks + 15) * 65 + r2]);
    bf16_t* d = dst + (size_t)(r0 + r2) * J.K + k0 + ks;
    *(u32x4*)d = w0; *(u32x4*)(d + 8) = w1;
    __syncthreads();
}

DEVI void rms_row_bf16(const float* xr, const float* g, bf16_t* o, int lane) {
    f32x4 v[4]; float ss = 0.f;
#pragma unroll
    for (int i = 0; i < 4; ++i) { v[i] = *(const f32x4*)(xr + i * 256 + lane * 4); ss += v[i][0] * v[i][0] + v[i][1] * v[i][1] + v[i][2] * v[i][2] + v[i][3] * v[i][3]; }
    ss = wave_sum(ss);
    const float rs = rsqrtf(ss * (1.0f / 1024.0f) + RMS_EPS);
#pragma unroll
    for (int i = 0; i < 4; ++i) {
        const f32x4 gg = *(const f32x4*)(g + i * 256 + lane * 4);
        u32x2 w; w.x = pk2(v[i][0] * rs * gg[0], v[i][1] * rs * gg[1]); w.y = pk2(v[i][2] * rs * gg[2], v[i][3] * rs * gg[3]);
        *(u32x2*)(o + i * 256 + lane * 4) = w;
    }
}

DEVI void phase_prep(const Params& P, unsigned char* lds, int tid) {
    unsigned char* ws = P.ws;
    const int lane = tid & 63, wid = __builtin_amdgcn_readfirstlane(tid >> 6);
    if (blockIdx.x == 0) {
        if (tid < 64) ((unsigned*)(ws + OFF_CTL))[tid] = 0u;
        for (int i = tid; i < XCD_BAR_WORDS; i += NTHREADS) ((unsigned*)(ws + OFF_BAR))[i] = 0u;
    }
    int base = 0;
    for (int j = 0; j < 10; ++j) {
        const int nt = tjob_tiles(j);
        const TJob J = get_tjob(P, j);
        for (int t = blockIdx.x; t < nt; t += gridDim.x) transpose_tile(J, t, lds, tid);
        base += nt;
    }
    {
        const float* x = P.in[0]; const float* g = P.in[2]; bf16_t* hn = (bf16_t*)(ws + OFF_HN);
        for (int r = blockIdx.x * 4 + wid; r < NTOK; r += gridDim.x * 4) rms_row_bf16(x + (size_t)r * 1024, g, hn + (size_t)r * 1024, lane);
    }
    {
        f32x2* cs = (f32x2*)(ws + OFF_CS);
        for (int e = blockIdx.x * NTHREADS + tid; e < NTOK * 32; e += gridDim.x * NTHREADS) {
            const int tok = e >> 5, i = e & 31;
            const double a = (double)P.pos[tok] * P.inv_freq[i];
            double t = a * 0.15915494309189535;
            t -= floor(t);
            const float tf = (float)t;
            cs[e] = (f32x2){__builtin_amdgcn_cosf(tf), __builtin_amdgcn_sinf(tf)};
        }
    }
    {
        float* red = (float*)lds;
        for (int job = blockIdx.x; job < 32; job += gridDim.x) {
            const int kv = job >> 4, cg8 = job & 15;
            const float* pe = P.in[kv ? 7 : 4]; const float* w1 = P.in[kv ? 8 : 5];
            const int cc = tid & 7, jj = tid >> 3;
            float s = 0.f;
            for (int j = jj; j < 2048; j += 32) s += pe[j] * w1[(size_t)j * 128 + cg8 * 8 + cc];
            red[tid] = s;
            __syncthreads();
            if (tid < 8) { float t = 0.f; for (int u = 0; u < 32; ++u) t += red[u * 8 + tid]; ((float*)(ws + OFF_BIAS1))[kv * 128 + cg8 * 8 + tid] = t; }
            __syncthreads();
        }
    }
}

DEVI void st_bf16(bf16_t* p, float v) { *p = (bf16_t)f2bf(v); }

DEVI void phase_gemm1(const Params& P, unsigned char* lds, int tid) {
    unsigned char* ws = P.ws;
    const rsrc_t rs = __builtin_amdgcn_make_buffer_rsrc((void*)P.ws, (short)0, (int)0x7fffffff, 0x00020000);
    const bf16_t* hn = (const bf16_t*)(ws + OFF_HN);
    const bf16_t* wt = (const bf16_t*)(ws + OFF_WIN_T);
    const f32x2* cs = (const f32x2*)(ws + OFF_CS);
    const int lane = tid & 63, wid = __builtin_amdgcn_readfirstlane(tid >> 6), wr = wid >> 1, wc = wid & 1, q = lane >> 4, cl = lane & 15;
    constexpr int NT_N = G1_COLS / 128;
    for (int u = blockIdx.x; u < (NTOK / 128) * NT_N; u += gridDim.x) {
        const int mt = u / NT_N, nt = u % NT_N;
        f32x4 acc[4][4];
        gemm128(acc, rs, (unsigned)(OFF_HN + (size_t)mt * 128 * 2048), RowLin{2048}, (unsigned)(OFF_WIN_T + (size_t)nt * 128 * 2048), RowLin{2048}, 16, lds, tid);
        const int c64 = nt * 2 + wc;
        const int tok0 = mt * 128 + wr * 64;
        if (c64 < 10 || (c64 >= 14 && c64 < 22) || (c64 >= 22 && c64 < 34)) {
            bool do_rope; float scale = 1.f; int kind;
            int g = 0, hk = 0;
            if (c64 < 8) { kind = 0; do_rope = true; scale = 0.125f; }
            else if (c64 == 8) { kind = 1; do_rope = true; }
            else if (c64 == 9) { kind = 2; do_rope = false; }
            else if (c64 < 22) { kind = 3; do_rope = true; scale = 0.125f; }
            else { kind = 4; g = (c64 - 22) >> 1; hk = (c64 - 22) & 1; do_rope = (g == 2 || g == 4); }
#pragma unroll
            for (int m = 0; m < 4; ++m) {
                float o[4][4];
                float nr[4][4];
#pragma unroll
                for (int n = 0; n < 4; ++n)
#pragma unroll
                    for (int j = 0; j < 4; ++j) { nr[n][j] = acc[m][n][j] * scale; o[n][j] = nr[n][j]; }
                if (do_rope) {
#pragma unroll
                    for (int j = 0; j < 4; ++j) {
                        const int tok = tok0 + m * 16 + q * 4 + j;
#pragma unroll
                        for (int n = 0; n < 2; ++n) {
                            const f32x2 c = cs[(size_t)tok * 32 + n * 16 + cl];
                            const float x1 = nr[n][j], x2 = nr[n + 2][j];
                            o[n][j] = x1 * c.x - x2 * c.y; o[n + 2][j] = x1 * c.y + x2 * c.x;
                        }
                    }
                }
                const int tokb = tok0 + m * 16 + q * 4;
                if (kind == 0) {
                    bf16_t* d = (bf16_t*)(ws + OFF_QA);
#pragma unroll
                    for (int n = 0; n < 4; ++n)
#pragma unroll
                        for (int j = 0; j < 4; ++j) st_bf16(d + (size_t)(tokb + j) * 512 + c64 * 64 + n * 16 + cl, o[n][j]);
                } else if (kind == 1 || kind == 2) {
                    bf16_t* d = (bf16_t*)(ws + (kind == 1 ? OFF_KA : OFF_VA));
#pragma unroll
                    for (int n = 0; n < 4; ++n)
#pragma unroll
                        for (int j = 0; j < 4; ++j) st_bf16(d + (size_t)(tokb + j) * 64 + n * 16 + cl, o[n][j]);
                } else if (kind == 3) {
                    bf16_t* dn = (bf16_t*)(ws + OFF_QBN); bf16_t* dr = (bf16_t*)(ws + OFF_QBR);
                    const int h = c64 - 14;
#pragma unroll
                    for (int n = 0; n < 4; ++n)
#pragma unroll
                        for (int j = 0; j < 4; ++j) {
                            st_bf16(dn + (size_t)(tokb + j) * 512 + h * 64 + n * 16 + cl, nr[n][j]);
                            st_bf16(dr + (size_t)(tokb + j) * 512 + h * 64 + n * 16 + cl, o[n][j]);
                        }
                } else {
                    bf16_t* d = (bf16_t*)(ws + OFF_KV + (size_t)g * KV_STRIDE);
                    const int b = tokb >> 12, tl = tokb & 4095;
                    if (g == 3 || g == 5) {
#pragma unroll
                        for (int n = 0; n < 4; ++n) {
                            u32x2 w; w.x = pk2(o[n][0], o[n][1]); w.y = pk2(o[n][2], o[n][3]);
                            *(u32x2*)(d + ((size_t)((b * 2 + hk) * 64 + n * 16 + cl)) * 4096 + tl) = w;
                        }
                    } else {
#pragma unroll
                        for (int n = 0; n < 4; ++n)
#pragma unroll
                            for (int j = 0; j < 4; ++j) st_bf16(d + ((size_t)((b * 2 + hk) * 4096 + tl + j)) * 64 + n * 16 + cl, o[n][j]);
                    }
                }
            }
        } else if (c64 >= 10 && c64 < 14) {
            bf16_t* d = (bf16_t*)(ws + OFF_QI);
#pragma unroll
            for (int m = 0; m < 4; ++m)
#pragma unroll
                for (int j = 0; j < 4; ++j) {
                    const int tok = tok0 + m * 16 + q * 4 + j;
                    const f32x2 c = cs[(size_t)tok * 32 + 2 * cl];
#pragma unroll
                    for (int hh = 0; hh < 2; ++hh) {
                        const float x1 = acc[m][2 * hh][j], x2 = acc[m][2 * hh + 1][j];
                        const int head = 2 * (c64 - 10) + hh;
                        st_bf16(d + (size_t)tok * 256 + head * 32 + cl, x1 * c.x - x2 * c.y);
                        st_bf16(d + (size_t)tok * 256 + head * 32 + 16 + cl, x1 * c.y + x2 * c.x);
                    }
                }
        } else if (c64 >= 36) {
            bf16_t* d = (bf16_t*)(ws + (c64 < 52 ? OFF_GA : OFF_GB));
            const int cb = (c64 < 52 ? c64 - 36 : c64 - 52) * 64;
#pragma unroll
            for (int m = 0; m < 4; ++m)
#pragma unroll
                for (int n = 0; n < 4; ++n)
#pragma unroll
                    for (int j = 0; j < 4; ++j) st_bf16(d + (size_t)(tok0 + m * 16 + q * 4 + j) * 1024 + cb + n * 16 + cl, sigmoidf_(acc[m][n][j]));
        } else if (c64 == 34) {
            bf16_t* dki = (bf16_t*)(ws + OFF_KI); float* dwi = (float*)(ws + OFF_WI); float* dg = (float*)(ws + OFF_GATES);
#pragma unroll
            for (int m = 0; m < 4; ++m)
#pragma unroll
                for (int j = 0; j < 4; ++j) {
                    const int tok = tok0 + m * 16 + q * 4 + j;
                    const f32x2 c = cs[(size_t)tok * 32 + 2 * cl];
                    const float x1 = acc[m][0][j], x2 = acc[m][1][j];
                    st_bf16(dki + (size_t)tok * 32 + cl, x1 * c.x - x2 * c.y);
                    st_bf16(dki + (size_t)tok * 32 + 16 + cl, x1 * c.y + x2 * c.x);
                    const float v2 = acc[m][2][j], v3 = acc[m][3][j];
                    if (cl < 8) dwi[(size_t)tok * 8 + cl] = v2; else dg[(size_t)tok * 24 + (cl - 8)] = sigmoidf_(v2);
                    dg[(size_t)tok * 24 + 8 + cl] = sigmoidf_(v3);
                }
        }
    }
}

DEVI float siluf_(float x) { return x * __builtin_amdgcn_rcpf(1.0f + __builtin_amdgcn_exp2f(-x * 1.4426950408889634f)); }

DEVI void phase_compress(const Params& P, unsigned char* lds, int tid) {
    unsigned char* ws = P.ws;
    const rsrc_t rs = __builtin_amdgcn_make_buffer_rsrc((void*)P.ws, (short)0, (int)0x7fffffff, 0x00020000);
    const int lane = tid & 63, wid = __builtin_amdgcn_readfirstlane(tid >> 6), wr = wid >> 1, wc = wid & 1, q = lane >> 4, cl = lane & 15;
    for (int u = blockIdx.x; u < 64; u += gridDim.x) {
        const int kv = u >> 5, mt = u & 31;
        const bf16_t* A = (const bf16_t*)(ws + OFF_KV + (size_t)kv * KV_STRIDE) + (size_t)mt * 128 * 1024;
        const bf16_t* W1 = (const bf16_t*)(ws + (kv ? OFF_W1V : OFF_W1K));
        const bf16_t* W2 = (const bf16_t*)(ws + (kv ? OFF_W2V : OFF_W2K));
        const float* bias = (const float*)(ws + OFF_BIAS1) + kv * 128;
        f32x4 acc[4][4];
        gemm128(acc, rs, (unsigned)(OFF_KV + (size_t)kv * KV_STRIDE + (size_t)mt * 128 * 2048), RowLin{2048}, (unsigned)(kv ? OFF_W1V : OFF_W1K), RowLin{4096}, 32, lds, tid);
#pragma unroll
        for (int m = 0; m < 4; ++m)
#pragma unroll
            for (int n = 0; n < 4; ++n) {
                const int col = wc * 64 + n * 16 + cl;
                const float bb = bias[col];
#pragma unroll
                for (int j = 0; j < 4; ++j) {
                    const int row = wr * 64 + m * 16 + q * 4 + j;
                    const int ktile = col >> 6, ch = (col & 63) >> 3, wi = col & 7;
                    *(bf16_t*)(lds + ktile * 16384 + row * 128 + ((ch ^ (row & 7)) << 4) + wi * 2) = (bf16_t)f2bf(siluf_(acc[m][n][j] + bb));
                }
            }
#pragma unroll
        for (int i = 0; i < 4; ++i) {
            const int idx = tid + 256 * i;
            const int row = idx >> 4, ch16 = idx & 15, ktile = ch16 >> 3, ch = ch16 & 7;
            *(u32x4*)(lds + 32768 + ktile * 8192 + row * 128 + ((ch ^ (row & 7)) << 4)) = *(const u32x4*)(W2 + (size_t)row * 128 + ch16 * 8);
        }
        __syncthreads();
        f32x4 a2[4][2];
#pragma unroll
        for (int m = 0; m < 4; ++m) { a2[m][0] = (f32x4){0.f, 0.f, 0.f, 0.f}; a2[m][1] = (f32x4){0.f, 0.f, 0.f, 0.f}; }
#pragma unroll
        for (int kk = 0; kk < 4; ++kk) {
            const int ktile = kk >> 1, ks = kk & 1;
            bf16x8 a[4], b[2];
#pragma unroll
            for (int m = 0; m < 4; ++m) { const int row = wr * 64 + m * 16 + cl; a[m] = *(const bf16x8*)(lds + ktile * 16384 + row * 128 + (((ks * 4 + q) ^ (row & 7)) << 4)); }
#pragma unroll
            for (int n = 0; n < 2; ++n) { const int row = wc * 32 + n * 16 + cl; b[n] = *(const bf16x8*)(lds + 32768 + ktile * 8192 + row * 128 + (((ks * 4 + q) ^ (row & 7)) << 4)); }
#pragma unroll
            for (int m = 0; m < 4; ++m)
#pragma unroll
                for (int n = 0; n < 2; ++n) a2[m][n] = MFMA16(a[m], b[n], a2[m][n]);
        }
#pragma unroll
        for (int m = 0; m < 4; ++m)
#pragma unroll
            for (int n = 0; n < 2; ++n) {
                const int d = wc * 32 + n * 16 + cl;
                const int r0 = mt * 128 + wr * 64 + m * 16 + q * 4;
                float v[4];
#pragma unroll
                for (int j = 0; j < 4; ++j) v[j] = (((r0 + j) & 255) == 255) ? 0.f : a2[m][n][j];
                if (kv == 0) {
                    bf16_t* kc = (bf16_t*)(ws + OFF_KC);
#pragma unroll
                    for (int j = 0; j < 4; ++j) st_bf16(kc + (size_t)(r0 + j) * 64 + d, v[j]);
                } else {
                    bf16_t* vct = (bf16_t*)(ws + OFF_VCT);
                    u32x2 w; w.x = pk2(v[0], v[1]); w.y = pk2(v[2], v[3]);
                    *(u32x2*)(vct + ((size_t)((r0 >> 8) * 64 + d)) * 256 + (r0 & 255)) = w;
                }
            }
        __syncthreads();
    }
}

DEVI void phase_index(const Params& P, unsigned char* lds, int tid) {
    unsigned char* ws = P.ws;
    const bf16_t* QI = (const bf16_t*)(ws + OFF_QI);
    const bf16_t* KI = (const bf16_t*)(ws + OFF_KI);
    const float* WI = (const float*)(ws + OFF_WI);
    bf16_t* SEL = (bf16_t*)(ws + OFF_SEL);
    float* S = (float*)lds;
    const int lane = tid & 63, wid = __builtin_amdgcn_readfirstlane(tid >> 6), q = lane >> 4, cl = lane & 15;
    for (int u = blockIdx.x; u < NTOK / 4; u += gridDim.x) {
        const int b = u >> 10, w10 = u & 1023, s10 = (w10 < 512) ? w10 : 1535 - w10;
        const int t0 = s10 * 4, tok0 = b * 4096 + t0;
        const int t = t0 + wid;
        const int tok = tok0 + wid;
        if (t0 + 3 < 256) {
            for (int i = lane; i < 256; i += 64) SEL[(size_t)tok * 256 + i] = (bf16_t)(i <= t ? i : 0);
            continue;
        }
        {
            bf16x8 a[2];
#pragma unroll
            for (int hg = 0; hg < 2; ++hg) a[hg] = *(const bf16x8*)(QI + (size_t)(tok0 + (cl >> 2)) * 256 + (4 * hg + (cl & 3)) * 32 + q * 8);
            const f32x4 w0 = *(const f32x4*)(WI + (size_t)(tok0 + q) * 8), w1 = *(const f32x4*)(WI + (size_t)(tok0 + q) * 8 + 4);
            const int ktmax = (t0 + 3) >> 4;
            const bf16_t* kb = KI + (size_t)b * 4096 * 32 + cl * 32 + q * 8;
            for (int kt0 = wid; kt0 <= ktmax; kt0 += 16) {
                bf16x8 bk[4];
#pragma unroll
                for (int uu = 0; uu < 4; ++uu) { const int kt = (kt0 + 4 * uu <= ktmax) ? kt0 + 4 * uu : kt0; bk[uu] = *(const bf16x8*)(kb + (size_t)kt * 16 * 32); }
#pragma unroll
                for (int uu = 0; uu < 4; ++uu) {
                    const int kt = kt0 + 4 * uu;
                    f32x4 c0 = {0.f, 0.f, 0.f, 0.f}, c1 = {0.f, 0.f, 0.f, 0.f};
                    c0 = MFMA16(a[0], bk[uu], c0); c1 = MFMA16(a[1], bk[uu], c1);
                    float sc = 0.f;
#pragma unroll
                    for (int j = 0; j < 4; ++j) { sc += w0[j] * fmaxf(c0[j], 0.f); sc += w1[j] * fmaxf(c1[j], 0.f); }
                    if (kt <= ktmax) S[q * 4096 + kt * 16 + cl] = sc;
                }
            }
        }
        __syncthreads();
        {
            const int n = t + 1;
            const float* Sq = S + wid * 4096;
            if (n <= 256) {
                for (int i = lane; i < 256; i += 64) SEL[(size_t)tok * 256 + i] = (bf16_t)(i <= t ? i : 0);
            } else {
                const int nr = (n + 63) >> 6;
                float x[64];
                const float NINF = -__builtin_inff();
                float mx = NINF, mn = __builtin_inff();
#pragma unroll
                for (int r = 0; r < 64; ++r) {
                    const int key = r * 64 + lane;
                    const float v = Sq[key];
                    x[r] = (key < n) ? v : NINF;
                    mn = fminf(mn, (key < n) ? v : __builtin_inff());
                    mx = fmaxf(mx, x[r]);
                }
#pragma unroll
                for (int o = 32; o > 0; o >>= 1) { mx = fmaxf(mx, __shfl_xor(mx, o)); mn = fminf(mn, __shfl_xor(mn, o)); }
                float lo = mn, hi = mx, T; int need;
                int chi;
                {
                    int c = 0;
#pragma unroll
                    for (int g8 = 0; g8 < 8; ++g8) if (g8 * 8 < nr) {
#pragma unroll
                        for (int r = g8 * 8; r < g8 * 8 + 8; ++r) c += (x[r] >= hi) ? 1 : 0;
                    }
#pragma unroll
                    for (int o = 32; o > 0; o >>= 1) c += __shfl_xor(c, o);
                    chi = c;
                }
                if (chi >= 256) { T = hi; need = 256;   }
                else {
                    bool found = false; float thr = 0.f;
                    for (int it = 0; it < 64; ++it) {
                        const float mid = 0.5f * lo + 0.5f * hi;
                        if (!(mid > lo && mid < hi)) break;
                        int c = 0;
#pragma unroll
                        for (int g8 = 0; g8 < 8; ++g8) if (g8 * 8 < nr) {
#pragma unroll
                            for (int r = g8 * 8; r < g8 * 8 + 8; ++r) c += (x[r] >= mid) ? 1 : 0;
                        }
#pragma unroll
                        for (int o = 32; o > 0; o >>= 1) c += __shfl_xor(c, o);
                        if (c == 256) { found = true; thr = mid; break; }
                        if (c > 256) lo = mid; else { hi = mid; chi = c; }
                    }
                    if (found) { T = thr; need = -1; }
                    else { T = lo; need = 256 - chi; }
                }
                int base = 0, eqc = 0;
                const unsigned long long lt = (1ull << lane) - 1ull;
#pragma unroll
                for (int g8 = 0; g8 < 8; ++g8) if (g8 * 8 < nr) {
#pragma unroll
                    for (int r = g8 * 8; r < g8 * 8 + 8; ++r) {
                        bool sel;
                        if (need < 0) sel = x[r] >= T;
                        else {
                            const bool eq = (x[r] == T);
                            const unsigned long long em = __ballot(eq);
                            sel = (x[r] > T) || (eq && (eqc + __popcll(em & lt) < need));
                            eqc += __popcll(em);
                        }
                        const unsigned long long sm = __ballot(sel);
                        if (sel) { const int pp = base + __popcll(sm & lt); if (pp < 256) SEL[(size_t)tok * 256 + pp] = (bf16_t)(r * 64 + lane); }
                        base += __popcll(sm);
                    }
                }
            }
        }
        __syncthreads();
    }
}

DEVI void phase_dsa(const Params& P, unsigned char* lds, int tid) {
    unsigned char* ws = P.ws;
    const bf16_t* QA = (const bf16_t*)(ws + OFF_QA);
    const bf16_t* KA = (const bf16_t*)(ws + OFF_KA);
    const bf16_t* VA = (const bf16_t*)(ws + OFF_VA);
    const bf16_t* SEL = (const bf16_t*)(ws + OFF_SEL);
    bf16_t* OA = (bf16_t*)(ws + OFF_OA);
    const int lane = tid & 63, wid = __builtin_amdgcn_readfirstlane(tid >> 6), q = lane >> 4, cl = lane & 15;
    unsigned char* vl = lds + wid * 8192;
    const float NINF = -__builtin_inff();
    for (int tok = blockIdx.x * 4 + wid; tok < NTOK; tok += gridDim.x * 4) {
        const int b = tok >> 12, t = tok & 4095;
        const int cnt = (t + 1 < 256) ? t + 1 : 256;
        const int nc64 = (cnt + 63) >> 6;
        const bf16_t* sel = SEL + (size_t)tok * 256;
        const bf16_t* kb = KA + (size_t)b * 4096 * 64;
        const bf16_t* vb = VA + (size_t)b * 4096 * 64;
        bf16x8 bq[2];
#pragma unroll
        for (int ks = 0; ks < 2; ++ks) {
            bq[ks] = (bf16x8){0, 0, 0, 0, 0, 0, 0, 0};
            if (cl < 8) bq[ks] = *(const bf16x8*)(QA + (size_t)tok * 512 + cl * 64 + ks * 32 + q * 8);
        }
        f32x4 s[16];
#pragma unroll
        for (int rf = 0; rf < 16; ++rf) {
            s[rf] = (f32x4){0.f, 0.f, 0.f, 0.f};
            if ((rf >> 2) < nc64) {
                const int p = 32 * (rf >> 1) + 8 * (cl >> 2) + 4 * (rf & 1) + (cl & 3);
                const int key = sel[p];
                const bf16_t* kr = kb + (size_t)key * 64 + q * 8;
                const bf16x8 a0 = *(const bf16x8*)(kr), a1 = *(const bf16x8*)(kr + 32);
                s[rf] = MFMA16(a0, bq[0], s[rf]); s[rf] = MFMA16(a1, bq[1], s[rf]);
            }
        }
        float mx = NINF;
#pragma unroll
        for (int rf = 0; rf < 16; ++rf)
#pragma unroll
            for (int j = 0; j < 4; ++j) {
                const int p = 32 * (rf >> 1) + 8 * q + 4 * (rf & 1) + j;
                if (p >= cnt) s[rf][j] = NINF;
                mx = fmaxf(mx, s[rf][j]);
            }
        mx = fmaxf(mx, __shfl_xor(mx, 16)); mx = fmaxf(mx, __shfl_xor(mx, 32));
        float ls = 0.f;
#pragma unroll
        for (int rf = 0; rf < 16; ++rf)
#pragma unroll
            for (int j = 0; j < 4; ++j) { const float pv = __builtin_amdgcn_exp2f((s[rf][j] - mx) * LOG2E); s[rf][j] = pv; ls += pv; }
        ls += __shfl_xor(ls, 16); ls += __shfl_xor(ls, 32);
        const float inv = 1.0f / ls;
        f32x4 o[4];
#pragma unroll
        for (int d = 0; d < 4; ++d) o[d] = (f32x4){0.f, 0.f, 0.f, 0.f};
#pragma unroll
        for (int cc = 0; cc < 4; ++cc) {
            if (cc < nc64) {
                const int mykey = sel[cc * 64 + lane];
                __builtin_amdgcn_wave_barrier();
#pragma unroll
                for (int i = 0; i < 8; ++i) {
                    const int row = (lane >> 3) + 8 * i;
                    const int key = __shfl(mykey, row);
                    *(u32x4*)(vl + row * 128 + (lane & 7) * 16) = *(const u32x4*)(vb + (size_t)key * 64 + (lane & 7) * 8);
                }
                __builtin_amdgcn_wave_barrier();
#pragma unroll
                for (int c2 = 0; c2 < 2; ++c2) {
                    const bf16x8 pb = pack8(s[cc * 4 + c2 * 2], s[cc * 4 + c2 * 2 + 1]);
#pragma unroll
                    for (int d = 0; d < 4; ++d) {
                        LAS unsigned char* a0addr = (LAS unsigned char*)(vl) + (c2 * 32 + 8 * q + (cl >> 2)) * 128 + (d * 16 + 4 * (cl & 3)) * 2;
                        const s16x4 lo4 = __builtin_amdgcn_ds_read_tr16_b64_v4i16((LAS s16x4*)(a0addr));
                        const s16x4 hi4 = __builtin_amdgcn_ds_read_tr16_b64_v4i16((LAS s16x4*)(a0addr + 4 * 128));
                        const bf16x8 av = {lo4[0], lo4[1], lo4[2], lo4[3], hi4[0], hi4[1], hi4[2], hi4[3]};
                        o[d] = MFMA16(av, pb, o[d]);
                    }
                }
            }
        }
        if (cl < 8) {
#pragma unroll
            for (int d = 0; d < 4; ++d) {
                u32x2 w; w.x = pk2(o[d][0] * inv, o[d][1] * inv); w.y = pk2(o[d][2] * inv, o[d][3] * inv);
                *(u32x2*)(OA + (size_t)tok * 512 + cl * 64 + d * 16 + q * 4) = w;
            }
        }
    }
}

DEVI int fK(int row) { return (row & 3) | (((row >> 3) & 1) << 2); }

struct AttnState { f32x4 O[4][4]; float m[4]; float l[4]; };

template <int MODE>
DEVI void attn_blocks(rsrc_t rs, unsigned sK, unsigned sV, int ldv, int jb0, int jb1, const bf16x8 (&qf)[4][2], AttnState& st,
                      int tq, unsigned long long selmask, unsigned char* lds, int tid) {
    const int lane = tid & 63, q = lane >> 4, cl = lane & 15;
    const float NINF = -__builtin_inff();
#pragma unroll
    for (int cf = 0; cf < 4; ++cf) { st.m[cf] = NINF; st.l[cf] = 0.f;
#pragma unroll
        for (int d = 0; d < 4; ++d) st.O[d][cf] = (f32x4){0.f, 0.f, 0.f, 0.f}; }
    if (jb1 < jb0) return;
    unsigned kro[2], vro[2]; int kwo[2], vwo[2];
#pragma unroll
    for (int i = 0; i < 2; ++i) {
        const int idx = tid + 256 * i, row = idx >> 3, ch = idx & 7;
        kro[i] = (unsigned)(row * 64 + ch * 8) * 2u; kwo[i] = row * 128 + ((ch ^ fK(row)) << 4);
        vro[i] = (unsigned)(row * ldv + ch * 8) * 2u; vwo[i] = 8192 + row * 128 + ((ch ^ (row & 7)) << 4);
    }
    u32x4 rk[2], rv[2];
#pragma unroll
    for (int i = 0; i < 2; ++i) { rk[i] = bload16(rs, kro[i], sK + (unsigned)jb0 * 8192u); rv[i] = bload16(rs, vro[i], sV + (unsigned)jb0 * 128u); }
#pragma unroll
    for (int i = 0; i < 2; ++i) { *(u32x4*)(lds + kwo[i]) = rk[i]; *(u32x4*)(lds + vwo[i]) = rv[i]; }
    __syncthreads();
    const int nmax = (tq >= 31) ? ((tq - 31) >> 4) : -1;
    for (int jb = jb0; jb <= jb1; ++jb) {
        unsigned char* cur = lds + ((jb - jb0) & 1) * 16384;
        unsigned char* nxt = lds + ((jb - jb0 + 1) & 1) * 16384;
        const bool more = jb < jb1;
        if (more) {
#pragma unroll
            for (int i = 0; i < 2; ++i) { rk[i] = bload16(rs, kro[i], sK + (unsigned)(jb + 1) * 8192u); rv[i] = bload16(rs, vro[i], sV + (unsigned)(jb + 1) * 128u); }
        }
        bool lane_on = true;
        if (MODE == 1) lane_on = ((selmask >> jb) & 1ull) != 0ull;
        if (MODE == 0) lane_on = (jb * 64 <= nmax);
        if (MODE == 2) lane_on = (jb * 64 + 63 > tq - 512);
        if (__ballot(lane_on) != 0ull) {
#pragma unroll
            for (int c = 0; c < 2; ++c) {
                f32x4 S[2][4];
#pragma unroll
                for (int r2 = 0; r2 < 2; ++r2)
#pragma unroll
                    for (int cf = 0; cf < 4; ++cf) S[r2][cf] = (f32x4){0.f, 0.f, 0.f, 0.f};
#pragma unroll
                for (int r2 = 0; r2 < 2; ++r2) {
                    const int kl = 32 * c + 8 * (cl >> 2) + 4 * r2 + (cl & 3);
#pragma unroll
                    for (int ks = 0; ks < 2; ++ks) {
                        const bf16x8 a = *(const bf16x8*)(cur + kl * 128 + (((ks * 4 + q) ^ (cl & 7)) << 4));
#pragma unroll
                        for (int cf = 0; cf < 4; ++cf) S[r2][cf] = MFMA16(a, qf[cf][ks], S[r2][cf]);
                    }
                }
                bf16x8 pb[4];
#pragma unroll
                for (int cf = 0; cf < 4; ++cf) {
                    float bm = NINF;
#pragma unroll
                    for (int r2 = 0; r2 < 2; ++r2)
#pragma unroll
                        for (int j = 0; j < 4; ++j) {
                            const int key = jb * 64 + 32 * c + 8 * q + 4 * r2 + j;
                            bool v;
                            if (MODE == 0) v = key <= nmax;
                            else if (MODE == 1) v = lane_on && key <= tq;
                            else v = key <= tq && key > tq - 512;
                            if (!v) S[r2][cf][j] = NINF;
                            bm = fmaxf(bm, S[r2][cf][j]);
                        }
                    bm = fmaxf(bm, __shfl_xor(bm, 16)); bm = fmaxf(bm, __shfl_xor(bm, 32));
                    const float mnew = fmaxf(st.m[cf], bm);
                    const float mref = (mnew == NINF) ? 0.f : mnew;
                    const float alpha = __builtin_amdgcn_exp2f((st.m[cf] - mref) * LOG2E);
                    st.m[cf] = mnew;
                    float ps = 0.f;
#pragma unroll
                    for (int r2 = 0; r2 < 2; ++r2)
#pragma unroll
                        for (int j = 0; j < 4; ++j) { const float pv = __builtin_amdgcn_exp2f((S[r2][cf][j] - mref) * LOG2E); S[r2][cf][j] = pv; ps += pv; }
                    st.l[cf] = st.l[cf] * alpha + ps;
#pragma unroll
                    for (int d = 0; d < 4; ++d) st.O[d][cf] *= alpha;
                    pb[cf] = pack8(S[0][cf], S[1][cf]);
                }
#pragma unroll
                for (int d = 0; d < 4; ++d) {
                    const int row = d * 16 + cl;
                    const bf16x8 av = *(const bf16x8*)(cur + 8192 + row * 128 + (((c * 4 + q) ^ (row & 7)) << 4));
#pragma unroll
                    for (int cf = 0; cf < 4; ++cf) st.O[d][cf] = MFMA16(av, pb[cf], st.O[d][cf]);
                }
            }
        }
        if (more) {
#pragma unroll
            for (int i = 0; i < 2; ++i) { *(u32x4*)(nxt + kwo[i]) = rk[i]; *(u32x4*)(nxt + vwo[i]) = rv[i]; }
        }
        __syncthreads();
    }
}

DEVI f32x4 bload16f(rsrc_t r, unsigned voff, unsigned soff) { return __builtin_bit_cast(f32x4, __builtin_amdgcn_raw_buffer_load_b128(r, (int)voff, (int)soff, 0)); }
DEVI void bstore16f(rsrc_t r, f32x4 v, unsigned voff, unsigned soff) { __builtin_amdgcn_raw_buffer_store_b128(__builtin_bit_cast(u32x4, v), r, (int)voff, (int)soff, 0); }
DEVI float bload4f(rsrc_t r, unsigned voff, unsigned soff) { return __builtin_bit_cast(float, __builtin_amdgcn_raw_buffer_load_b32(r, (int)voff, (int)soff, 0)); }

struct NsaUnit { int i, b, k, t0, tq; unsigned tokw, tokb, qoff, goff, ooff, sQ, sG, sO; };
DEVI NsaUnit nsa_unit(int uu, int tid) {
    NsaUnit U;
    const int lane = tid & 63, wid = __builtin_amdgcn_readfirstlane(tid >> 6), q = lane >> 4, cl = lane & 15;
    const int half = uu >> 9, r = uu & 511, bk = r & 15, ii = r >> 4;
    U.i = half ? ii : 63 - ii; U.b = bk >> 1; U.k = bk & 1;
    U.t0 = U.i * 64; U.tq = U.t0 + wid * 16 + cl;
    U.tokw = (unsigned)(wid * 16 + cl);
    U.tokb = (unsigned)(U.b * 4096 + U.t0);
    U.qoff = U.tokw * 1024u + (unsigned)q * 16u;
    U.goff = U.tokw * 96u;
    U.ooff = U.tokw * 1024u + (unsigned)q * 8u;
    U.sQ = U.tokb * 1024u + (unsigned)U.k * 512u;
    U.sG = (unsigned)OFF_GATES + U.tokb * 96u + (unsigned)U.k * 16u;
    U.sO = (unsigned)OFF_OB + U.tokb * 1024u + (unsigned)U.k * 512u;
    return U;
}

DEVI void nsa_cmp_unit(const Params& P, rsrc_t rs, int uu, unsigned char* lds, int tid) {
    const int lane = tid & 63, wid = __builtin_amdgcn_readfirstlane(tid >> 6), q = lane >> 4, cl = lane & 15;
    const NsaUnit U = nsa_unit(uu, tid);
    const int i = U.i, b = U.b, k = U.k, tq = U.tq;
    AttnState st;
    bf16x8 qf[4][2];
#pragma unroll
    for (int cf = 0; cf < 4; ++cf)
#pragma unroll
        for (int ks = 0; ks < 2; ++ks) qf[cf][ks] = __builtin_bit_cast(bf16x8, bload16(rs, U.qoff, (unsigned)OFF_QBN + U.sQ + cf * 128 + ks * 64));
    const unsigned sKC = (unsigned)OFF_KC + (unsigned)(b * 2 + k) * 256u * 128u;
    const unsigned sVC = (unsigned)OFF_VCT + (unsigned)(b * 2 + k) * 64u * 512u;
    const int nmax_blk = (U.t0 + 63 - 31) >> 4;
    const int jbc = (nmax_blk >> 6) < 3 ? (nmax_blk >> 6) : 3;
    attn_blocks<0>(rs, sKC, sVC, 256, 0, jbc, qf, st, tq, 0ull, lds, tid);
    float linv[4], mfin[4];
#pragma unroll
    for (int cf = 0; cf < 4; ++cf) {
        float l = st.l[cf]; l += __shfl_xor(l, 16); l += __shfl_xor(l, 32);
        linv[cf] = (l > 0.f) ? __builtin_amdgcn_rcpf(l) : 0.f; mfin[cf] = st.m[cf];
        const float sc = linv[cf] * bload4f(rs, U.goff, U.sG + cf * 4);
#pragma unroll
        for (int d = 0; d < 4; ++d) { const f32x4 v = st.O[d][cf] * sc; u32x2 w; w.x = pk2(v[0], v[1]); w.y = pk2(v[2], v[3]);
            __builtin_amdgcn_raw_buffer_store_b64(w, rs, (int)U.ooff, (int)(U.sO + cf * 128 + d * 32), 0); }
    }
    unsigned long long* MSKG = (unsigned long long*)(P.ws + OFF_MASK);
    if (i < 16) {
        if (q == 0) MSKG[((size_t)(b * 2 + k)) * 4096 + tq] = (2ull << i) - 1ull;
        return;
    }
    float* SUM4 = (float*)(lds + 16384);
    float* LAST = (float*)(lds + 32768);
    float* IMP2 = (float*)(lds + 49152);
    const int nmax = (tq >= 31) ? ((tq - 31) >> 4) : -1;
    for (int kb = 0; kb <= jbc; ++kb) {
#pragma unroll
        for (int ii = 0; ii < 2; ++ii) {
            const int idx = tid + 256 * ii, row = idx >> 3, ch = idx & 7;
            *(u32x4*)(lds + row * 128 + ((ch ^ fK(row)) << 4)) = bload16(rs, (unsigned)(row * 64 + ch * 8) * 2u, sKC + (unsigned)kb * 8192u);
        }
        __syncthreads();
#pragma unroll
        for (int rf = 0; rf < 4; ++rf) {
            f32x4 S[4];
#pragma unroll
            for (int cf = 0; cf < 4; ++cf) S[cf] = (f32x4){0.f, 0.f, 0.f, 0.f};
            const int kl = 32 * (rf >> 1) + 8 * (cl >> 2) + 4 * (rf & 1) + (cl & 3);
#pragma unroll
            for (int ks = 0; ks < 2; ++ks) {
                const bf16x8 a = *(const bf16x8*)(lds + kl * 128 + (((ks * 4 + q) ^ (cl & 7)) << 4));
#pragma unroll
                for (int cf = 0; cf < 4; ++cf) S[cf] = MFMA16(a, qf[cf][ks], S[cf]);
            }
            float acc4 = 0.f, accl = 0.f;
#pragma unroll
            for (int j = 0; j < 4; ++j) {
                const int key = kb * 64 + 32 * (rf >> 1) + 8 * q + 4 * (rf & 1) + j;
                float pj = 0.f;
#pragma unroll
                for (int cf = 0; cf < 4; ++cf) pj += __builtin_amdgcn_exp2f((S[cf][j] - mfin[cf]) * LOG2E) * linv[cf];
                pj = (key <= nmax) ? pj : 0.f;
                acc4 += pj; if (j == 3) accl = pj;
            }
            const int jblk = kb * 16 + 8 * (rf >> 1) + 2 * q + (rf & 1);
            SUM4[(wid * 16 + cl) * 64 + jblk] = acc4; LAST[(wid * 16 + cl) * 64 + jblk] = accl;
        }
        __syncthreads();
    }
    {
        const int qi = tid >> 2, jg = tid & 3;
        const int jlim = (jbc + 1) * 16;
        for (int jj = 0; jj < 16; ++jj) {
            const int j = jg * 16 + jj;
            float v = (j < jlim) ? SUM4[qi * 64 + j] : 0.f;
            if (j >= 1 && j - 1 < jlim) v += LAST[qi * 64 + j - 1];
            IMP2[qi * 64 + j] = v;
        }
    }
    __syncthreads();
    {
        const int qi = tid >> 2, jg = tid & 3;
        const float* row = IMP2 + qi * 64;
        unsigned lo = 0u;
        for (int jj = 0; jj < 16; ++jj) {
            const int j = jg * 16 + jj;
            if (j <= i) {
                const bool forced = (j == 0) || (j == i) || (j == i - 1);
                const float kj = forced ? __builtin_inff() : row[j];
                int rank = 0;
                for (int j2 = 0; j2 <= i; ++j2) {
                    const bool f2 = (j2 == 0) || (j2 == i) || (j2 == i - 1);
                    const float k2 = f2 ? __builtin_inff() : row[j2];
                    rank += (k2 > kj || (k2 == kj && j2 < j)) ? 1 : 0;
                }
                if (rank < 16) lo |= (1u << jj);
            }
        }
        unsigned long long bits = (unsigned long long)lo << (jg * 16);
        bits |= __shfl_xor(bits, 1); bits |= __shfl_xor(bits, 2);
        if (jg == 0) MSKG[((size_t)(b * 2 + k)) * 4096 + U.t0 + qi] = bits;
    }
    __syncthreads();
}

template <int MODE>
DEVI void nsa_kv_unit(const Params& P, rsrc_t rs, int uu, unsigned char* lds, int tid) {
    const int lane = tid & 63, q = lane >> 4;
    const NsaUnit U = nsa_unit(uu, tid);
    const int i = U.i, b = U.b, k = U.k, tq = U.tq;
    AttnState st;
    bf16x8 qf[4][2];
#pragma unroll
    for (int cf = 0; cf < 4; ++cf)
#pragma unroll
        for (int ks = 0; ks < 2; ++ks) qf[cf][ks] = __builtin_bit_cast(bf16x8, bload16(rs, U.qoff, (unsigned)OFF_QBR + U.sQ + cf * 128 + ks * 64));
    const unsigned sK = (unsigned)(OFF_KV + (MODE == 1 ? 2 : 4) * KV_STRIDE) + (unsigned)(b * 2 + k) * 4096u * 128u;
    const unsigned sV = (unsigned)(OFF_KV + (MODE == 1 ? 3 : 5) * KV_STRIDE) + (unsigned)(b * 2 + k) * 64u * 8192u;
    unsigned long long mymask = 0ull;
    int j0 = 0;
    if (MODE == 1) mymask = ((const unsigned long long*)(P.ws + OFF_MASK))[((size_t)(b * 2 + k)) * 4096 + tq];
    else j0 = (i >= 8) ? i - 8 : 0;
    attn_blocks<MODE>(rs, sK, sV, 4096, j0, i, qf, st, tq, mymask, lds, tid);
#pragma unroll
    for (int cf = 0; cf < 4; ++cf) {
        float l = st.l[cf]; l += __shfl_xor(l, 16); l += __shfl_xor(l, 32);
        const float sc = ((l > 0.f) ? __builtin_amdgcn_rcpf(l) : 0.f) * bload4f(rs, U.goff, U.sG + (MODE == 1 ? 32 : 64) + cf * 4);
#pragma unroll
        for (int d = 0; d < 4; ++d) {
            const u32x2 pw = __builtin_bit_cast(u32x2, __builtin_amdgcn_raw_buffer_load_b64(rs, (int)U.ooff, (int)(U.sO + cf * 128 + d * 32), 0));
            f32x4 v = st.O[d][cf] * sc;
            v[0] += bf2f(pw.x & 0xffffu); v[1] += bf2f(pw.x >> 16); v[2] += bf2f(pw.y & 0xffffu); v[3] += bf2f(pw.y >> 16);
            u32x2 w; w.x = pk2(v[0], v[1]); w.y = pk2(v[2], v[3]);
            __builtin_amdgcn_raw_buffer_store_b64(w, rs, (int)U.ooff, (int)(U.sO + cf * 128 + d * 32), 0);
        }
    }
}

DEVI void phase_nsa(const Params& P, unsigned char* lds, int tid) {
    const rsrc_t rs = __builtin_amdgcn_make_buffer_rsrc((void*)P.ws, (short)0, (int)0x7fffffff, 0x00020000);
    for (int uu = blockIdx.x; uu < 1024; uu += gridDim.x) { int t = tid; asm volatile("" : "+v"(t)); nsa_cmp_unit(P, rs, uu, lds, t); }
    __syncthreads();
    for (int uu = blockIdx.x; uu < 1024; uu += gridDim.x) { int t = tid; asm volatile("" : "+v"(t)); nsa_kv_unit<1>(P, rs, uu, lds, t); }
    __syncthreads();
    for (int uu = blockIdx.x; uu < 1024; uu += gridDim.x) { int t = tid; asm volatile("" : "+v"(t)); nsa_kv_unit<2>(P, rs, uu, lds, t); }
}

DEVI void phase_merge(const Params& P, unsigned char* lds, int tid) {
    unsigned char* ws = P.ws;
    const rsrc_t rs = __builtin_amdgcn_make_buffer_rsrc((void*)P.ws, (short)0, (int)0x7fffffff, 0x00020000);
    const bf16_t* ga = (const bf16_t*)(ws + OFF_GA);
    const bf16_t* gb = (const bf16_t*)(ws + OFF_GB);
    bf16_t* mg = (bf16_t*)(ws + OFF_MERGED);
    const int lane = tid & 63, wid = __builtin_amdgcn_readfirstlane(tid >> 6), wr = wid >> 1, wc = wid & 1, q = lane >> 4, cl = lane & 15;
    for (int u = blockIdx.x; u < 256 * 8; u += gridDim.x) {
        const int mt = u >> 3, nt = u & 7;
        f32x4 acc[4][4];
        unsigned t[4][4][2];
        gemm128(acc, rs, (unsigned)(OFF_OA + (size_t)mt * 128 * 1024), RowLin{1024}, (unsigned)(OFF_WBRA + (size_t)nt * 128 * 1024), RowLin{1024}, 8, lds, tid);
        const size_t e0 = (size_t)(mt * 128 + wr * 64 + q * 4) * 1024 + nt * 128 + wc * 64 + cl;
#pragma unroll
        for (int m = 0; m < 4; ++m)
#pragma unroll
            for (int n = 0; n < 4; ++n)
#pragma unroll
                for (int jp = 0; jp < 2; ++jp)
                    t[m][n][jp] = pk2(acc[m][n][2 * jp] * bf2f(ga[e0 + (size_t)(m * 16 + 2 * jp) * 1024 + n * 16]),
                                      acc[m][n][2 * jp + 1] * bf2f(ga[e0 + (size_t)(m * 16 + 2 * jp + 1) * 1024 + n * 16]));
        gemm128(acc, rs, (unsigned)(OFF_OB + (size_t)mt * 128 * 1024), RowLin{1024}, (unsigned)(OFF_WBRB + (size_t)nt * 128 * 1024), RowLin{1024}, 8, lds, tid);
#pragma unroll
        for (int m = 0; m < 4; ++m)
#pragma unroll
            for (int n = 0; n < 4; ++n)
#pragma unroll
                for (int j = 0; j < 4; ++j) {
                    const size_t o = e0 + (size_t)(m * 16 + j) * 1024 + n * 16;
                    const float tv = (j & 1) ? bf2f(t[m][n][j >> 1] >> 16) : bf2f(t[m][n][j >> 1] & 0xffffu);
                    st_bf16(mg + o, tv + acc[m][n][j] * bf2f(gb[o]));
                }
    }
}

DEVI void phase_outproj(const Params& P, unsigned char* lds, int tid) {
    unsigned char* ws = P.ws;
    const rsrc_t rs = __builtin_amdgcn_make_buffer_rsrc((void*)P.ws, (short)0, (int)0x7fffffff, 0x00020000);
    const bf16_t* mg = (const bf16_t*)(ws + OFF_MERGED);
    const bf16_t* wo = (const bf16_t*)(ws + OFF_WOUT);
    const float* x = P.in[0];
    float* x1 = P.out;
    const int lane = tid & 63, wid = __builtin_amdgcn_readfirstlane(tid >> 6), wr = wid >> 1, wc = wid & 1, q = lane >> 4, cl = lane & 15;
    for (int u = blockIdx.x; u < 256 * 8; u += gridDim.x) {
        const int mt = u >> 3, nt = u & 7;
        f32x4 acc[4][4];
        gemm128(acc, rs, (unsigned)(OFF_MERGED + (size_t)mt * 128 * 2048), RowLin{2048}, (unsigned)(OFF_WOUT + (size_t)nt * 128 * 2048), RowLin{2048}, 16, lds, tid);
#pragma unroll
        for (int m = 0; m < 4; ++m)
#pragma unroll
            for (int n = 0; n < 4; ++n)
#pragma unroll
                for (int j = 0; j < 4; ++j) {
                    const size_t o = (size_t)(mt * 128 + wr * 64 + m * 16 + q * 4 + j) * 1024 + nt * 128 + wc * 64 + n * 16 + cl;
                    x1[o] = x[o] + acc[m][n][j];
                }
    }
}

DEVI void phase_router(const Params& P, unsigned char* lds, int tid) {
    unsigned char* ws = P.ws;
    const int lane = tid & 63, wid = __builtin_amdgcn_readfirstlane(tid >> 6);
    const float* x1 = P.out; const float* g = P.in[13];
    const float* wg = P.in[14]; const float* bg = P.in[15]; const float* we = P.in[16]; const float* be = P.in[17];
    bf16_t* h2 = (bf16_t*)(ws + OFF_HN);
    unsigned* cnt = (unsigned*)(ws + OFF_CTL);
    int* list = (int*)(ws + OFF_LIST);
    float* wt = (float*)(ws + OFF_WT);
    for (int r = blockIdx.x * 4 + wid; r < NTOK; r += gridDim.x * 4) {
        const float* xr = x1 + (size_t)r * 1024;
        float ss = 0.f;
#pragma unroll
        for (int i = 0; i < 4; ++i) { const f32x4 v = *(const f32x4*)(xr + i * 256 + lane * 4); ss += v[0] * v[0] + v[1] * v[1] + v[2] * v[2] + v[3] * v[3]; }
        ss = wave_sum(ss);
        const float rs = rsqrtf(ss * (1.0f / 1024.0f) + RMS_EPS);
        float lg[36];
#pragma unroll
        for (int e = 0; e < 36; ++e) lg[e] = 0.f;
#pragma unroll 1
        for (int i = 0; i < 4; ++i) {
            const int k0 = i * 256 + lane * 4;
            const f32x4 v = *(const f32x4*)(xr + k0);
            const f32x4 gg = *(const f32x4*)(g + k0);
            float h[4];
#pragma unroll
            for (int c = 0; c < 4; ++c) h[c] = v[c] * rs * gg[c];
            u32x2 w; w.x = pk2(h[0], h[1]); w.y = pk2(h[2], h[3]);
            *(u32x2*)(h2 + (size_t)r * 1024 + k0) = w;
            const float* wgp = wg + (size_t)k0 * 4;
            const float* wep = we + (size_t)k0 * 32;
#pragma unroll
            for (int c = 0; c < 4; ++c) {
                const f32x4 wgv = *(const f32x4*)(wgp + c * 4);
#pragma unroll
                for (int e = 0; e < 4; ++e) lg[e] += h[c] * wgv[e];
#pragma unroll
                for (int e4 = 0; e4 < 8; ++e4) {
                    const f32x4 wev = *(const f32x4*)(wep + c * 32 + e4 * 4);
#pragma unroll
                    for (int e = 0; e < 4; ++e) lg[4 + e4 * 4 + e] += h[c] * wev[e];
                }
            }
        }
#pragma unroll
        for (int e = 0; e < 36; ++e) lg[e] = wave_sum(lg[e]);
        float gl[4];
#pragma unroll
        for (int e = 0; e < 4; ++e) gl[e] = lg[e] + bg[e];
        int gs = 0; float gm = gl[0];
#pragma unroll
        for (int e = 1; e < 4; ++e) if (gl[e] > gm) { gm = gl[e]; gs = e; }
        float den = 0.f;
#pragma unroll
        for (int e = 0; e < 4; ++e) den += __expf(gl[e] - gm);
        const float gp = 1.0f / den;
        float el[8];
#pragma unroll
        for (int e = 0; e < 8; ++e) {
            float vsel = lg[4 + e] + be[e];
            if (gs == 1) vsel = lg[12 + e] + be[8 + e];
            if (gs == 2) vsel = lg[20 + e] + be[16 + e];
            if (gs == 3) vsel = lg[28 + e] + be[24 + e];
            el[e] = vsel;
        }
        int i0 = 0; float v0 = el[0];
#pragma unroll
        for (int e = 1; e < 8; ++e) if (el[e] > v0) { v0 = el[e]; i0 = e; }
        int i1 = -1; float v1 = -__builtin_inff();
#pragma unroll
        for (int e = 0; e < 8; ++e) if (e != i0 && el[e] > v1) { v1 = el[e]; i1 = e; }
        const float e1 = __expf(v1 - v0);
        const float w0 = gp / (1.0f + e1), w1 = gp * e1 / (1.0f + e1);
        if (lane == 0) {
            const int ex0 = gs * 8 + i0, ex1 = gs * 8 + i1;
            const unsigned p0 = atomicAdd(&cnt[ex0], 1u);
            list[(size_t)ex0 * NTOK + p0] = r * 2 + 0;
            const unsigned p1 = atomicAdd(&cnt[ex1], 1u);
            list[(size_t)ex1 * NTOK + p1] = r * 2 + 1;
            wt[(size_t)r * 2 + 0] = w0; wt[(size_t)r * 2 + 1] = w1;
        }
    }
}

struct RowGather { const int* idx; DEVI unsigned operator()(int r) const { return (unsigned)idx[r] * 2048u; } };
struct RowGU { int c0; DEVI unsigned operator()(int r) const {
    const int wcx = r >> 6, w = r & 63; const int col = (w < 32) ? (c0 + wcx * 32 + w) : (256 + c0 + wcx * 32 + (w - 32)); return (unsigned)col * 2048u; } };

DEVI void phase_moe(const Params& P, unsigned char* lds, int tid) {
    unsigned char* ws = P.ws;
    const rsrc_t rs = __builtin_amdgcn_make_buffer_rsrc((void*)P.ws, (short)0, (int)0x7fffffff, 0x00020000);
    const int lane = tid & 63, wid = __builtin_amdgcn_readfirstlane(tid >> 6), wr = wid >> 1, wc = wid & 1, q = lane >> 4, cl = lane & 15;
    const unsigned* cnt = (const unsigned*)(ws + OFF_CTL);
    const int* list = (const int*)(ws + OFF_LIST);
    const bf16_t* h2 = (const bf16_t*)(ws + OFF_HN);
    const bf16_t* wgu = (const bf16_t*)(ws + OFF_WGU);
    const bf16_t* wdn = (const bf16_t*)(ws + OFF_WDN);
    bf16_t* act = (bf16_t*)(ws + OFF_ACT);
    bf16_t* Y = (bf16_t*)(ws + OFF_Y);
    int* rowtok = (int*)(lds + 65536);
    int* rowas = (int*)(lds + 65536 + 512);
    int total = 0;
    for (int e = 0; e < 32; ++e) total += ((int)cnt[e] + 127) >> 7;
    for (int u = blockIdx.x; u < total; u += gridDim.x) {
        int e = 0, tl = u;
        for (; e < 32; ++e) { const int nt = ((int)cnt[e] + 127) >> 7; if (tl < nt) break; tl -= nt; }
        const int ce = (int)cnt[e];
        if (tid < 128) {
            const int r = tl * 128 + tid;
            const int as = (r < ce) ? list[(size_t)e * NTOK + r] : -1;
            rowas[tid] = as; rowtok[tid] = (as >= 0) ? (as >> 1) : 0;
        }
        __syncthreads();
        bf16_t* au = act + (size_t)u * 128 * 256;
        for (int nt = 0; nt < 4; ++nt) {
            f32x4 acc[4][4];
            gemm128(acc, rs, (unsigned)OFF_HN, RowGather{rowtok}, (unsigned)(OFF_WGU + (size_t)e * 512 * 2048), RowGU{nt * 64}, 16, lds, tid);
#pragma unroll
            for (int m = 0; m < 4; ++m)
#pragma unroll
                for (int n = 0; n < 2; ++n)
#pragma unroll
                    for (int j = 0; j < 4; ++j) {
                        const float gt = acc[m][n][j], up = acc[m][n + 2][j];
                        const int row = wr * 64 + m * 16 + q * 4 + j, col = nt * 64 + wc * 32 + n * 16 + cl;
                        st_bf16(au + (size_t)row * 256 + col, siluf_(gt) * up);
                    }
        }
        __syncthreads();
        for (int nt = 0; nt < 8; ++nt) {
            f32x4 acc[4][4];
            gemm128(acc, rs, (unsigned)(OFF_ACT + (size_t)u * 128 * 512), RowLin{512}, (unsigned)(OFF_WDN + (size_t)e * 1024 * 512 + (size_t)nt * 128 * 512), RowLin{512}, 4, lds, tid);
#pragma unroll
            for (int m = 0; m < 4; ++m)
#pragma unroll
                for (int j = 0; j < 4; ++j) {
                    const int row = wr * 64 + m * 16 + q * 4 + j;
                    const int as = rowas[row];
                    if (as >= 0) {
                        bf16_t* yr = Y + ((size_t)(as & 1) * NTOK + (as >> 1)) * 1024 + nt * 128 + wc * 64 + cl;
#pragma unroll
                        for (int n = 0; n < 4; ++n) st_bf16(yr + n * 16, acc[m][n][j]);
                    }
                }
        }
        __syncthreads();
    }
}

DEVI void phase_final(const Params& P, int tid, bool with_moe) {
    unsigned char* ws = P.ws;
    const int lane = tid & 63, wid = __builtin_amdgcn_readfirstlane(tid >> 6);
    const bf16_t* Y = (const bf16_t*)(ws + OFF_Y);
    const float* wt = (const float*)(ws + OFF_WT);
    const float* g = P.in[20];
    float* out = P.out;
    for (int r = blockIdx.x * 4 + wid; r < NTOK; r += gridDim.x * 4) {
        float* xr = out + (size_t)r * 1024;
        const float w0 = with_moe ? wt[(size_t)r * 2] : 0.f, w1 = with_moe ? wt[(size_t)r * 2 + 1] : 0.f;
        f32x4 v[4]; float ss = 0.f;
#pragma unroll
        for (int i = 0; i < 4; ++i) {
            v[i] = *(const f32x4*)(xr + i * 256 + lane * 4);
            if (with_moe) {
                const u32x2 a = *(const u32x2*)(Y + (size_t)r * 1024 + i * 256 + lane * 4);
                const u32x2 b = *(const u32x2*)(Y + ((size_t)NTOK + r) * 1024 + i * 256 + lane * 4);
                v[i][0] += w0 * bf2f(a.x & 0xffffu) + w1 * bf2f(b.x & 0xffffu); v[i][1] += w0 * bf2f(a.x >> 16) + w1 * bf2f(b.x >> 16);
                v[i][2] += w0 * bf2f(a.y & 0xffffu) + w1 * bf2f(b.y & 0xffffu); v[i][3] += w0 * bf2f(a.y >> 16) + w1 * bf2f(b.y >> 16);
            }
            ss += v[i][0] * v[i][0] + v[i][1] * v[i][1] + v[i][2] * v[i][2] + v[i][3] * v[i][3];
        }
        ss = wave_sum(ss);
        const float rs = rsqrtf(ss * (1.0f / 1024.0f) + RMS_EPS);
#pragma unroll
        for (int i = 0; i < 4; ++i) {
            const f32x4 gg = *(const f32x4*)(g + i * 256 + lane * 4);
            f32x4 o; o[0] = v[i][0] * rs * gg[0]; o[1] = v[i][1] * rs * gg[1]; o[2] = v[i][2] * rs * gg[2]; o[3] = v[i][3] * rs * gg[3];
            *(f32x4*)(xr + i * 256 + lane * 4) = o;
        }
    }
}

#define LAUNDER_TID() do { tid = threadIdx.x; asm volatile("" : "+v"(tid)); } while (0)
#ifndef PROBE_TWICE
#define PROBE_TWICE 0
#endif
#define REPS(k) ((PROBE_TWICE == (k)) ? 2 : 1)
__global__ void __launch_bounds__(NTHREADS, 2) fwd_megakernel(Params P) {
    extern __shared__ __attribute__((aligned(16))) unsigned char lds[];
    cg::grid_group grid = cg::this_grid();
    int tid;
    volatile LAS unsigned* bst = (volatile LAS unsigned*)(LAS unsigned char*)(lds + LDS_BYTES - 16);
    if (threadIdx.x < 4) bst[threadIdx.x] = 0u;
    LAUNDER_TID(); phase_prep(P, lds, tid);
    grid.sync();
    const XcdBarrier bar = xcd_barrier_post((unsigned*)(P.ws + OFF_BAR), bst);
    for (int rep = 0; rep < REPS(1); ++rep) { LAUNDER_TID(); phase_gemm1(P, lds, tid); }
    xcd_barrier(bar);
    for (int rep = 0; rep < REPS(2); ++rep) { LAUNDER_TID(); phase_compress(P, lds, tid); __syncthreads(); }
    for (int rep = 0; rep < REPS(3); ++rep) { LAUNDER_TID(); phase_index(P, lds, tid); __syncthreads(); }
    xcd_barrier(bar);
    for (int rep = 0; rep < REPS(4); ++rep) { LAUNDER_TID(); phase_dsa(P, lds, tid); __syncthreads(); }
    for (int rep = 0; rep < REPS(5); ++rep) { LAUNDER_TID(); phase_nsa(P, lds, tid); __syncthreads(); }
    xcd_barrier(bar);
    for (int rep = 0; rep < REPS(6); ++rep) { LAUNDER_TID(); phase_merge(P, lds, tid); }
    xcd_barrier(bar);
    for (int rep = 0; rep < REPS(7); ++rep) { LAUNDER_TID(); phase_outproj(P, lds, tid); }
    xcd_barrier(bar);
    LAUNDER_TID(); phase_router(P, lds, tid);
    xcd_barrier(bar);
    for (int rep = 0; rep < REPS(9); ++rep) { LAUNDER_TID(); phase_moe(P, lds, tid); }
    xcd_barrier(bar);
    LAUNDER_TID(); phase_final(P, tid, true);
}

extern "C" void kernel_launch(void* const* d_in, const int* in_sizes, int n_in, void* d_out, int out_size, void* d_ws, size_t ws_size,
                              hipStream_t stream) {
    static int grid_blocks = 0;
    if (!grid_blocks) {
        int dev = 0, cus = 0, per_cu = 0;
        hipGetDevice(&dev);
        hipDeviceGetAttribute(&cus, hipDeviceAttributeMultiprocessorCount, dev);
        hipFuncSetAttribute((const void*)fwd_megakernel, hipFuncAttributeMaxDynamicSharedMemorySize, LDS_BYTES);
        hipOccupancyMaxActiveBlocksPerMultiprocessor(&per_cu, (const void*)fwd_megakernel, NTHREADS, LDS_BYTES);
        if (per_cu < 1) per_cu = 1;
        if (per_cu > 2) per_cu = 2;
        grid_blocks = cus * per_cu;
        if (ws_size < WS_END) fprintf(stderr, "kernel_launch: workspace too small: %zu < %zu\n", ws_size, (size_t)WS_END);
    }
    Params p{};
    for (int i = 0; i < 21; ++i) p.in[i] = (const float*)d_in[i];
    p.pos = (const int*)d_in[1];
    p.out = (float*)d_out;
    p.ws = (unsigned char*)d_ws;
    for (int i = 0; i < 32; ++i) p.inv_freq[i] = (double)powf(10000.0f, -(float)i / 32.0f);
    p.ph_lo = 0; p.ph_hi = 0;
    void* args[] = {&p};
    hipError_t e = hipLaunchCooperativeKernel((const void*)fwd_megakernel, dim3(grid_blocks), dim3(NTHREADS), args, LDS_BYTES, stream);
    if (e != hipSuccess) fprintf(stderr, "cooperative launch failed: %s (grid %d)\n", hipGetErrorString(e), grid_blocks);
}
```

```cpp
#include <hip/hip_runtime.h>
#include <hip/hip_cooperative_groups.h>
#include <cstdint>
#include <cstdio>
#include <cmath>
namespace cg = cooperative_groups;

#define DEVI __device__ __forceinline__
#ifndef PROBE_TWICE
#define PROBE_TWICE 0
#endif
#define REPS(k) ((PROBE_TWICE == (k)) ? 2 : 1)
typedef unsigned short bf16_t;
typedef short bf16x8 __attribute__((ext_vector_type(8)));
typedef short s16x4 __attribute__((ext_vector_type(4)));
typedef float f32x4 __attribute__((ext_vector_type(4)));
typedef float f32x2 __attribute__((ext_vector_type(2)));
typedef unsigned u32x4 __attribute__((ext_vector_type(4)));
typedef unsigned u32x2 __attribute__((ext_vector_type(2)));
#define LAS __attribute__((address_space(3)))

constexpr int NB = 8, SL = 4096, DM = 1024, NTOK = NB * SL;
constexpr int INW = 4288;
constexpr int NTHREADS = 256;
constexpr int LDS_BYTES = 81920;
constexpr float RMS_EPS = 1e-6f;
constexpr float LOG2E = 1.4426950408889634f;

constexpr int WIN_ROWS = 4352;
constexpr int G1_COLS = 4352;

constexpr size_t al256(size_t x) { return (x + 255) & ~(size_t)255; }
constexpr size_t OFF_CTL   = 0;
constexpr size_t OFF_BAR   = 4096;
constexpr size_t OFF_WIN_T = 32768;
constexpr size_t OFF_WBRA  = OFF_WIN_T + (size_t)WIN_ROWS * 1024 * 2;
constexpr size_t OFF_WBRB  = OFF_WBRA + (size_t)1024 * 512 * 2;
constexpr size_t OFF_WOUT  = OFF_WBRB + (size_t)1024 * 512 * 2;
constexpr size_t OFF_W1K   = OFF_WOUT + (size_t)1024 * 1024 * 2;
constexpr size_t OFF_W1V   = OFF_W1K + (size_t)128 * 2048 * 2;
constexpr size_t OFF_W2K   = OFF_W1V + (size_t)128 * 2048 * 2;
constexpr size_t OFF_W2V   = OFF_W2K + (size_t)64 * 128 * 2;
constexpr size_t OFF_WGU   = OFF_W2V + (size_t)64 * 128 * 2;
constexpr size_t OFF_WDN   = OFF_WGU + (size_t)32 * 512 * 1024 * 2;
constexpr size_t OFF_BIAS1 = OFF_WDN + (size_t)32 * 1024 * 256 * 2;
constexpr size_t OFF_WR    = OFF_BIAS1 + 1024;
constexpr size_t OFF_CS    = OFF_WR + (size_t)48 * 1024 * 4;
constexpr size_t OFF_HN    = OFF_CS + (size_t)NTOK * 32 * 8;
constexpr size_t OFF_QA    = OFF_HN + (size_t)NTOK * 1024 * 2;
constexpr size_t OFF_KA    = OFF_QA + (size_t)NTOK * 512 * 2;
constexpr size_t OFF_VA    = OFF_KA + (size_t)NTOK * 64 * 2;
constexpr size_t OFF_QI    = OFF_VA + (size_t)NTOK * 64 * 2;
constexpr size_t OFF_KI    = OFF_QI + (size_t)NTOK * 256 * 2;
constexpr size_t OFF_WI    = OFF_KI + (size_t)NTOK * 32 * 2;
constexpr size_t OFF_QBN   = OFF_WI + (size_t)NTOK * 8 * 4;
constexpr size_t OFF_QBR   = OFF_QBN + (size_t)NTOK * 512 * 2;
constexpr size_t KV_STRIDE = (size_t)NTOK * 128 * 2 + 65536 * 4;
constexpr size_t OFF_KV    = OFF_QBR + (size_t)NTOK * 512 * 2;
constexpr size_t OFF_GATES = OFF_KV + 6 * KV_STRIDE;
constexpr size_t OFF_QKV_END = OFF_GATES + (size_t)NTOK * 24 * 4;
constexpr size_t OFF_KC    = al256(OFF_QKV_END);
constexpr size_t OFF_VCT   = OFF_KC + (size_t)16 * 256 * 64 * 2;
constexpr size_t OFF_SEL   = OFF_VCT + (size_t)16 * 256 * 64 * 2;
constexpr size_t OFF_OA    = OFF_HN;
constexpr size_t OFF_OB    = OFF_OA + (size_t)NTOK * 512 * 2;
constexpr size_t OFF_GA    = OFF_SEL + (size_t)NTOK * 256 * 2;
constexpr size_t OFF_GB    = OFF_GA + (size_t)NTOK * 1024 * 2;
constexpr size_t OFF_MASK  = OFF_GB + (size_t)NTOK * 1024 * 2;
constexpr size_t OFF_LIST  = OFF_MASK + (size_t)16 * 4096 * 8;
constexpr size_t OFF_WT    = OFF_LIST + (size_t)32 * NTOK * 4;
constexpr size_t WS_END    = OFF_WT + (size_t)NTOK * 2 * 4;
constexpr size_t OFF_MERGED = OFF_QA;
constexpr size_t OFF_ACT    = OFF_QA;
constexpr size_t OFF_Y      = OFF_QA + (size_t)40 * 1024 * 1024;
static_assert(OFF_Y + (size_t)2 * NTOK * 1024 * 2 <= OFF_QKV_END, "Y overlay");
static_assert((size_t)544 * 128 * 256 * 2 <= (size_t)40 * 1024 * 1024, "ACT overlay");

struct Params {
    const float* in[21];
    const int* pos;
    float* out;
    unsigned char* ws;
    double inv_freq[32];
    int ph_lo, ph_hi;
};

DEVI unsigned f2bf(float f) { unsigned u = __float_as_uint(f); return (u + 0x7fffu + ((u >> 16) & 1u)) >> 16; }
DEVI unsigned pk2(float lo, float hi) { return f2bf(lo) | (f2bf(hi) << 16); }
DEVI float bf2f(unsigned h) { return __uint_as_float(h << 16); }
DEVI float sigmoidf_(float x) { return __builtin_amdgcn_rcpf(1.0f + __builtin_amdgcn_exp2f(-x * 1.4426950408889634f)); }
DEVI float wave_sum(float v) {
#pragma unroll
    for (int o = 32; o > 0; o >>= 1) v += __shfl_xor(v, o);
    return v;
}
DEVI int wave_sum_i32(int v) {
    v += __builtin_amdgcn_update_dpp(0, v, 0xB1, 0xF, 0xF, true);
    v += __builtin_amdgcn_update_dpp(0, v, 0x4E, 0xF, 0xF, true);
    v += __builtin_amdgcn_update_dpp(0, v, 0x141, 0xF, 0xF, true);
    v += __builtin_amdgcn_update_dpp(0, v, 0x140, 0xF, 0xF, true);
    return __builtin_amdgcn_readlane(v, 0) + __builtin_amdgcn_readlane(v, 16) + __builtin_amdgcn_readlane(v, 32) + __builtin_amdgcn_readlane(v, 48);
}
DEVI float wave_sum_f32_dpp(float v) {
    v += __builtin_bit_cast(float, __builtin_amdgcn_update_dpp(0, __builtin_bit_cast(int, v), 0xB1, 0xF, 0xF, true));
    v += __builtin_bit_cast(float, __builtin_amdgcn_update_dpp(0, __builtin_bit_cast(int, v), 0x4E, 0xF, 0xF, true));
    v += __builtin_bit_cast(float, __builtin_amdgcn_update_dpp(0, __builtin_bit_cast(int, v), 0x141, 0xF, 0xF, true));
    v += __builtin_bit_cast(float, __builtin_amdgcn_update_dpp(0, __builtin_bit_cast(int, v), 0x140, 0xF, 0xF, true));
    const int iv = __builtin_bit_cast(int, v);
    return (__builtin_bit_cast(float, __builtin_amdgcn_readlane(iv, 0)) + __builtin_bit_cast(float, __builtin_amdgcn_readlane(iv, 16))) +
           (__builtin_bit_cast(float, __builtin_amdgcn_readlane(iv, 32)) + __builtin_bit_cast(float, __builtin_amdgcn_readlane(iv, 48)));
}
DEVI bf16x8 pack8(const f32x4& a, const f32x4& b) {
    u32x4 w; w.x = pk2(a[0], a[1]); w.y = pk2(a[2], a[3]); w.z = pk2(b[0], b[1]); w.w = pk2(b[2], b[3]);
    return __builtin_bit_cast(bf16x8, w);
}
#define MFMA16(a, b, c) __builtin_amdgcn_mfma_f32_16x16x32_bf16((a), (b), (c), 0, 0, 0)


#define XB_TMO      128
#define XB_XCNT(j)  (256  + 64 * (j))
#define XB_XSUB(j)  (1280 + 64 * (j))
#define XB_XGEN(j)  (2304 + 64 * (j))
#define XB_TOP      3328
#define XB_TOPGEN   3392
#define XCD_BAR_WORDS 3456
#define XB_SPIN_CAP (1u << 22)
DEVI unsigned xb_ld(unsigned* p)              { return __hip_atomic_load(p, __ATOMIC_RELAXED, __HIP_MEMORY_SCOPE_AGENT); }
DEVI unsigned xb_add(unsigned* p, unsigned v) { return __hip_atomic_fetch_add(p, v, __ATOMIC_RELAXED, __HIP_MEMORY_SCOPE_AGENT); }
DEVI unsigned xb_xcc_id() { return (unsigned)__builtin_amdgcn_s_getreg((3 << 11) | 20) & 0xFu; }
#define XB_SPIN(cond, bar) do { unsigned _sp = 0; while (cond) { __builtin_amdgcn_s_sleep(1); \
    if ((++_sp & 255u) == 0u) { if (xb_ld(&(bar)[XB_TMO])) break; if (_sp > XB_SPIN_CAP) { atomicAdd(&(bar)[XB_TMO], 1u); break; } } } } while (0)
struct XcdBarrier { unsigned* bar; unsigned x; volatile LAS unsigned* st; };
DEVI XcdBarrier xcd_barrier_post(unsigned* bar, volatile LAS unsigned* st) {
    XcdBarrier b; b.bar = bar; b.x = xb_xcc_id(); b.st = st;
    if (threadIdx.x == 0) (void)xb_add(&bar[XB_XCNT(b.x)], 1u);
    return b;
}
DEVI void xcd_barrier_complete(unsigned* bar, unsigned x, unsigned& nloc, unsigned& nx) {
    const unsigned G = gridDim.x * gridDim.y * gridDim.z;
    unsigned sum, cnt, mine, sp = 0u;
    for (;;) {
        sum = 0u; cnt = 0u; mine = 0u;
#pragma unroll
        for (unsigned j = 0; j < 16; ++j) { const unsigned c = xb_ld(&bar[XB_XCNT(j)]); sum += c; cnt += (c > 0u) ? 1u : 0u; mine = (j == x) ? c : mine; }
        if (sum == G) break;
        __builtin_amdgcn_s_sleep(1);
        if ((++sp & 255u) == 0u) { if (xb_ld(&bar[XB_TMO])) break; if (sp > XB_SPIN_CAP) { atomicAdd(&bar[XB_TMO], 1u); break; } }
    }
    nloc = mine > 0u ? mine : 1u; nx = cnt > 0u ? cnt : 1u;
}
DEVI void xcd_barrier(const XcdBarrier& b) {
    asm volatile("s_waitcnt vmcnt(0)" ::: "memory");
    __syncthreads();
    if (threadIdx.x == 0) {
        unsigned* bar = b.bar;
        __builtin_amdgcn_s_waitcnt(0);
        unsigned nloc = b.st[0], nx = b.st[1];
        if (nloc == 0u) { xcd_barrier_complete(bar, b.x, nloc, nx); b.st[0] = nloc; b.st[1] = nx; }
        const unsigned old = xb_add(&bar[XB_XSUB(b.x)], 1u);
        const unsigned gen = old / nloc;
        if (old + 1u == (gen + 1u) * nloc) {
            __builtin_amdgcn_fence(__ATOMIC_RELEASE, "agent");
            asm volatile("s_waitcnt vmcnt(0)" ::: "memory");
            const unsigned og = xb_add(&bar[XB_TOP], 1u);
            const unsigned tg = og / nx;
            if (og + 1u == (tg + 1u) * nx) xb_add(&bar[XB_TOPGEN], 1u);
            else XB_SPIN(xb_ld(&bar[XB_TOPGEN]) == tg, bar);
            __builtin_amdgcn_fence(__ATOMIC_ACQUIRE, "agent");
            xb_add(&bar[XB_XGEN(b.x)], 1u);
            asm volatile("s_waitcnt vmcnt(0)" ::: "memory");
        } else {
            XB_SPIN(xb_ld(&bar[XB_XGEN(b.x)]) == gen, bar);
            __builtin_amdgcn_fence(__ATOMIC_ACQUIRE, "agent");
            asm volatile("s_waitcnt vmcnt(0)" ::: "memory");
        }
    }
    __syncthreads();
}

typedef __amdgpu_buffer_rsrc_t rsrc_t;
DEVI u32x4 bload16(rsrc_t r, unsigned voff, unsigned soff) { return __builtin_bit_cast(u32x4, __builtin_amdgcn_raw_buffer_load_b128(r, (int)voff, (int)soff, 0)); }
DEVI void glds16(rsrc_t r, unsigned char* lds_dst_uniform, unsigned voff, unsigned soff) {
    __builtin_amdgcn_raw_ptr_buffer_load_lds(r, (LAS void*)lds_dst_uniform, 16, (int)voff, (int)soff, 0, 0);
}
template <class FA, class FB>
DEVI void gemm128(f32x4 (&acc)[4][4], rsrc_t rs, unsigned sA, const FA& offA, unsigned sB, const FB& offB, int nk, unsigned char* lds, int tid) {
    const int lane = tid & 63, wid = __builtin_amdgcn_readfirstlane(tid >> 6), wr = wid >> 1, wc = wid & 1;
    const int lr = tid >> 3;
    const unsigned csrc = (unsigned)(((lane & 7) ^ ((lane >> 3) & 7)) << 4);
    unsigned oa[4], ob[4];
#pragma unroll
    for (int i = 0; i < 4; ++i) { oa[i] = offA(lr + 32 * i) + csrc; ob[i] = offB(lr + 32 * i) + csrc; }
#pragma unroll
    for (int m = 0; m < 4; ++m)
#pragma unroll
        for (int n = 0; n < 4; ++n) acc[m][n] = (f32x4){0.f, 0.f, 0.f, 0.f};
    const int q = lane >> 4, r16 = lane & 15;
    const int roffA0 = (wr * 64 + r16) * 128 + (((0 + q) ^ (lane & 7)) << 4);
    const int roffA1 = (wr * 64 + r16) * 128 + (((4 + q) ^ (lane & 7)) << 4);
    const int roffB0 = 16384 + (wc * 64 + r16) * 128 + (((0 + q) ^ (lane & 7)) << 4);
    const int roffB1 = 16384 + (wc * 64 + r16) * 128 + (((4 + q) ^ (lane & 7)) << 4);
    unsigned char* wbase = lds + wid * 1024;
#pragma unroll
    for (int i = 0; i < 4; ++i) { glds16(rs, wbase + i * 4096, oa[i], sA); glds16(rs, wbase + 16384 + i * 4096, ob[i], sB); }
    for (int kt = 0; kt < nk; ++kt) {
        unsigned char* cur = lds + (kt & 1) * 32768;
        __syncthreads();
        if (kt + 1 < nk) {
            unsigned char* nb = wbase + ((kt + 1) & 1) * 32768;
#pragma unroll
            for (int i = 0; i < 4; ++i) { glds16(rs, nb + i * 4096, oa[i], sA + (kt + 1) * 128); glds16(rs, nb + 16384 + i * 4096, ob[i], sB + (kt + 1) * 128); }
        }
#pragma unroll
        for (int ks = 0; ks < 2; ++ks) {
            bf16x8 a[4], b[4];
#pragma unroll
            for (int m = 0; m < 4; ++m) a[m] = *(const bf16x8*)(cur + (ks ? roffA1 : roffA0) + m * 2048);
#pragma unroll
            for (int n = 0; n < 4; ++n) b[n] = *(const bf16x8*)(cur + (ks ? roffB1 : roffB0) + n * 2048);
#pragma unroll
            for (int m = 0; m < 4; ++m)
#pragma unroll
                for (int n = 0; n < 4; ++n) acc[m][n] = MFMA16(a[m], b[n], acc[m][n]);
        }
    }
    __syncthreads();
}

struct RowLin { unsigned ldb; DEVI unsigned operator()(int r) const { return (unsigned)r * ldb; } };

DEVI int win_map(int j) {
    if (j < 896) return j;
    if (j < 1408) return j - 896 + 936;
    if (j < 2176) return j - 1408 + 1448;
    if (j < 2208) return j - 2176 + 896;
    if (j < 2216) return j - 2208 + 928;
    if (j < 2240) return j;
    if (j < 2304) return -1;
    return j - 64;
}

struct TJob { const float* src; bf16_t* dst; int K, ld, nrows, perm, nb; size_t sb, db; };
DEVI TJob get_tjob(const Params& P, int j) {
    unsigned char* ws = P.ws;
    switch (j) {
        case 0: return TJob{P.in[3], (bf16_t*)(ws + OFF_WIN_T), 1024, INW, WIN_ROWS, 1, 1, 0, 0};
        case 1: return TJob{P.in[10], (bf16_t*)(ws + OFF_WBRA), 512, 1024, 1024, 0, 1, 0, 0};
        case 2: return TJob{P.in[11], (bf16_t*)(ws + OFF_WBRB), 512, 1024, 1024, 0, 1, 0, 0};
        case 3: return TJob{P.in[12], (bf16_t*)(ws + OFF_WOUT), 1024, 1024, 1024, 0, 1, 0, 0};
        case 4: return TJob{P.in[5], (bf16_t*)(ws + OFF_W1K), 2048, 128, 128, 0, 1, 0, 0};
        case 5: return TJob{P.in[8], (bf16_t*)(ws + OFF_W1V), 2048, 128, 128, 0, 1, 0, 0};
        case 6: return TJob{P.in[6], (bf16_t*)(ws + OFF_W2K), 128, 64, 64, 0, 1, 0, 0};
        case 7: return TJob{P.in[9], (bf16_t*)(ws + OFF_W2V), 128, 64, 64, 0, 1, 0, 0};
        case 8: return TJob{P.in[18], (bf16_t*)(ws + OFF_WGU), 1024, 512, 512, 0, 32, (size_t)1024 * 512, (size_t)512 * 1024};
        default: return TJob{P.in[19], (bf16_t*)(ws + OFF_WDN), 256, 1024, 1024, 0, 32, (size_t)256 * 1024, (size_t)1024 * 256};
    }
}
DEVI int tjob_tiles(int j) {
    switch (j) {
        case 0: return (WIN_ROWS / 64) * 16;
        case 1: case 2: return 16 * 8;
        case 3: return 16 * 16;
        case 4: case 5: return 2 * 32;
        case 6: case 7: return 1 * 2;
        case 8: return 32 * 8 * 16;
        default: return 32 * 16 * 4;
    }
}

DEVI void transpose_tile(const TJob& J, int tile, unsigned char* lds, int tid) {
    float* T = (float*)lds;
    const int kt = J.K / 64, rt = J.nrows / 64;
    const int b = tile / (kt * rt), rem = tile % (kt * rt);
    const int r0 = (rem / kt) * 64, k0 = (rem % kt) * 64;
    const float* src = J.src + (size_t)b * J.sb;
    bf16_t* dst = J.dst + (size_t)b * J.db;
    const int rr = tid & 63;
    int col = r0 + rr; if (J.perm) col = win_map(col);
#pragma unroll
    for (int i = 0; i < 16; ++i) {
        const int kk = i * 4 + (tid >> 6);
        T[kk * 65 + rr] = (col >= 0) ? src[(size_t)(k0 + kk) * J.ld + col] : 0.f;
    }
    __syncthreads();
    const int r2 = tid >> 2, ks = (tid & 3) * 16;
    u32x4 w0, w1;
    w0.x = pk2(T[(ks + 0) * 65 + r2], T[(ks + 1) * 65 + r2]); w0.y = pk2(T[(ks + 2) * 65 + r2], T[(ks + 3) * 65 + r2]);
    w0.z = pk2(T[(ks + 4) * 65 + r2], T[(ks + 5) * 65 + r2]); w0.w = pk2(T[(ks + 6) * 65 + r2], T[(ks + 7) * 65 + r2]);
    w1.x = pk2(T[(ks + 8) * 65 + r2], T[(ks + 9) * 65 + r2]); w1.y = pk2(T[(ks + 10) * 65 + r2], T[(ks + 11) * 65 + r2]);
    w1.z = pk2(T[(ks + 12) * 65 + r2], T[(ks + 13) * 65 + r2]); w1.w = pk2(T[(ks + 14) * 65 + r2], T[(ks + 15) * 65 + r2]);
    bf16_t* d = dst + (size_t)(r0 + r2) * J.K + k0 + ks;
    *(u32x4*)d = w0; *(u32x4*)(d + 8) = w1;
    __syncthreads();
}

DEVI void rms_row_bf16(const float* xr, const float* g, bf16_t* o, int lane) {
    f32x4 v[4]; float ss = 0.f;
#pragma unroll
    for (int i = 0; i < 4; ++i) { v[i] = *(const f32x4*)(xr + i * 256 + lane * 4); ss += v[i][0] * v[i][0] + v[i][1] * v[i][1] + v[i][2] * v[i][2] + v[i][3] * v[i][3]; }
    ss = wave_sum(ss);
    const float rs = rsqrtf(ss * (1.0f / 1024.0f) + RMS_EPS);
#pragma unroll
    for (int i = 0; i < 4; ++i) {
        const f32x4 gg = *(const f32x4*)(g + i * 256 + lane * 4);
        u32x2 w; w.x = pk2(v[i][0] * rs * gg[0], v[i][1] * rs * gg[1]); w.y = pk2(v[i][2] * rs * gg[2], v[i][3] * rs * gg[3]);
        *(u32x2*)(o + i * 256 + lane * 4) = w;
    }
}

DEVI void phase_prep(const Params& P, unsigned char* lds, int tid) {
    unsigned char* ws = P.ws;
    const int lane = tid & 63, wid = __builtin_amdgcn_readfirstlane(tid >> 6);
    if (blockIdx.x == 0) {
        if (tid < 64) ((unsigned*)(ws + OFF_CTL))[tid] = 0u;
        for (int i = tid; i < XCD_BAR_WORDS; i += NTHREADS) ((unsigned*)(ws + OFF_BAR))[i] = 0u;
    }
    int base = 0;
    for (int j = 0; j < 10; ++j) {
        const int nt = tjob_tiles(j);
        const TJob J = get_tjob(P, j);
        for (int t = blockIdx.x; t < nt; t += gridDim.x) transpose_tile(J, t, lds, tid);
        base += nt;
    }
    {
        const float* x = P.in[0]; const float* g = P.in[2]; bf16_t* hn = (bf16_t*)(ws + OFF_HN);
        for (int r = blockIdx.x * 4 + wid; r < NTOK; r += gridDim.x * 4) rms_row_bf16(x + (size_t)r * 1024, g, hn + (size_t)r * 1024, lane);
    }
    {
        f32x2* cs = (f32x2*)(ws + OFF_CS);
        for (int e = blockIdx.x * NTHREADS + tid; e < NTOK * 32; e += gridDim.x * NTHREADS) {
            const int tok = e >> 5, i = e & 31;
            const double a = (double)P.pos[tok] * P.inv_freq[i];
            double t = a * 0.15915494309189535;
            t -= floor(t);
            const float tf = (float)t;
            cs[e] = (f32x2){__builtin_amdgcn_cosf(tf), __builtin_amdgcn_sinf(tf)};
        }
    }
    {
        float* wr = (float*)(ws + OFF_WR);
        const float* g = P.in[13]; const float* wg = P.in[14]; const float* we = P.in[16];
        for (int e = blockIdx.x * NTHREADS + tid; e < 48 * 1024; e += gridDim.x * NTHREADS) {
            const int c = e >> 10, k = e & 1023;
            float v = 0.f;
            if (c < 4) v = wg[k * 4 + c]; else if (c < 36) v = we[k * 32 + (c - 4)];
            wr[e] = v * g[k];
        }
    }
    {
        float* red = (float*)lds;
        for (int job = blockIdx.x; job < 32; job += gridDim.x) {
            const int kv = job >> 4, cg8 = job & 15;
            const float* pe = P.in[kv ? 7 : 4]; const float* w1 = P.in[kv ? 8 : 5];
            const int cc = tid & 7, jj = tid >> 3;
            float s = 0.f;
            for (int j = jj; j < 2048; j += 32) s += pe[j] * w1[(size_t)j * 128 + cg8 * 8 + cc];
            red[tid] = s;
            __syncthreads();
            if (tid < 8) { float t = 0.f; for (int u = 0; u < 32; ++u) t += red[u * 8 + tid]; ((float*)(ws + OFF_BIAS1))[kv * 128 + cg8 * 8 + tid] = t; }
            __syncthreads();
        }
    }
}

DEVI void st_bf16(bf16_t* p, float v) { *p = (bf16_t)f2bf(v); }

DEVI void phase_gemm1(const Params& P, unsigned char* lds, int tid) {
    unsigned char* ws = P.ws;
    const rsrc_t rs = __builtin_amdgcn_make_buffer_rsrc((void*)P.ws, (short)0, (int)0x7fffffff, 0x00020000);
    const bf16_t* hn = (const bf16_t*)(ws + OFF_HN);
    const bf16_t* wt = (const bf16_t*)(ws + OFF_WIN_T);
    const f32x2* cs = (const f32x2*)(ws + OFF_CS);
    const int lane = tid & 63, wid = __builtin_amdgcn_readfirstlane(tid >> 6), wr = wid >> 1, wc = wid & 1, q = lane >> 4, cl = lane & 15;
    constexpr int NT_N = G1_COLS / 128;
    for (int u = blockIdx.x; u < (NTOK / 128) * NT_N; u += gridDim.x) {
        const int mt = u / NT_N, nt = u % NT_N;
        f32x4 acc[4][4];
        gemm128(acc, rs, (unsigned)(OFF_HN + (size_t)mt * 128 * 2048), RowLin{2048}, (unsigned)(OFF_WIN_T + (size_t)nt * 128 * 2048), RowLin{2048}, 16, lds, tid);
        const int c64 = nt * 2 + wc;
        const int tok0 = mt * 128 + wr * 64;
        if (c64 < 10 || (c64 >= 14 && c64 < 22) || (c64 >= 22 && c64 < 34)) {
            bool do_rope; float scale = 1.f; int kind;
            int g = 0, hk = 0;
            if (c64 < 8) { kind = 0; do_rope = true; scale = 0.125f; }
            else if (c64 == 8) { kind = 1; do_rope = true; }
            else if (c64 == 9) { kind = 2; do_rope = false; }
            else if (c64 < 22) { kind = 3; do_rope = true; scale = 0.125f; }
            else { kind = 4; g = (c64 - 22) >> 1; hk = (c64 - 22) & 1; do_rope = (g == 2 || g == 4); }
#pragma unroll
            for (int m = 0; m < 4; ++m) {
                float o[4][4];
                float nr[4][4];
#pragma unroll
                for (int n = 0; n < 4; ++n)
#pragma unroll
                    for (int j = 0; j < 4; ++j) { nr[n][j] = acc[m][n][j] * scale; o[n][j] = nr[n][j]; }
                if (do_rope) {
#pragma unroll
                    for (int j = 0; j < 4; ++j) {
                        const int tok = tok0 + m * 16 + q * 4 + j;
#pragma unroll
                        for (int n = 0; n < 2; ++n) {
                            const f32x2 c = cs[(size_t)tok * 32 + n * 16 + cl];
                            const float x1 = nr[n][j], x2 = nr[n + 2][j];
                            o[n][j] = x1 * c.x - x2 * c.y; o[n + 2][j] = x1 * c.y + x2 * c.x;
                        }
                    }
                }
                const int tokb = tok0 + m * 16 + q * 4;
                if (kind == 0) {
                    bf16_t* d = (bf16_t*)(ws + OFF_QA);
#pragma unroll
                    for (int n = 0; n < 4; ++n)
#pragma unroll
                        for (int j = 0; j < 4; ++j) st_bf16(d + (size_t)(tokb + j) * 512 + c64 * 64 + n * 16 + cl, o[n][j]);
                } else if (kind == 1 || kind == 2) {
                    bf16_t* d = (bf16_t*)(ws + (kind == 1 ? OFF_KA : OFF_VA));
#pragma unroll
                    for (int n = 0; n < 4; ++n)
#pragma unroll
                        for (int j = 0; j < 4; ++j) st_bf16(d + (size_t)(tokb + j) * 64 + n * 16 + cl, o[n][j]);
                } else if (kind == 3) {
                    bf16_t* dn = (bf16_t*)(ws + OFF_QBN); bf16_t* dr = (bf16_t*)(ws + OFF_QBR);
                    const int h = c64 - 14;
#pragma unroll
                    for (int n = 0; n < 4; ++n)
#pragma unroll
                        for (int j = 0; j < 4; ++j) {
                            st_bf16(dn + (size_t)(tokb + j) * 512 + h * 64 + n * 16 + cl, nr[n][j]);
                            st_bf16(dr + (size_t)(tokb + j) * 512 + h * 64 + n * 16 + cl, o[n][j]);
                        }
                } else {
                    bf16_t* d = (bf16_t*)(ws + OFF_KV + (size_t)g * KV_STRIDE);
                    const int b = tokb >> 12, tl = tokb & 4095;
                    if (g == 3 || g == 5) {
#pragma unroll
                        for (int n = 0; n < 4; ++n) {
                            u32x2 w; w.x = pk2(o[n][0], o[n][1]); w.y = pk2(o[n][2], o[n][3]);
                            *(u32x2*)(d + ((size_t)((b * 2 + hk) * 64 + n * 16 + cl)) * 4096 + tl) = w;
                        }
                    } else {
#pragma unroll
                        for (int n = 0; n < 4; ++n)
#pragma unroll
                            for (int j = 0; j < 4; ++j) st_bf16(d + ((size_t)((b * 2 + hk) * 4096 + tl + j)) * 64 + n * 16 + cl, o[n][j]);
                    }
                }
            }
        } else if (c64 >= 10 && c64 < 14) {
            bf16_t* d = (bf16_t*)(ws + OFF_QI);
#pragma unroll
            for (int m = 0; m < 4; ++m)
#pragma unroll
                for (int j = 0; j < 4; ++j) {
                    const int tok = tok0 + m * 16 + q * 4 + j;
                    const f32x2 c = cs[(size_t)tok * 32 + 2 * cl];
#pragma unroll
                    for (int hh = 0; hh < 2; ++hh) {
                        const float x1 = acc[m][2 * hh][j], x2 = acc[m][2 * hh + 1][j];
                        const int head = 2 * (c64 - 10) + hh;
                        st_bf16(d + (size_t)tok * 256 + head * 32 + cl, x1 * c.x - x2 * c.y);
                        st_bf16(d + (size_t)tok * 256 + head * 32 + 16 + cl, x1 * c.y + x2 * c.x);
                    }
                }
        } else if (c64 >= 36) {
            bf16_t* d = (bf16_t*)(ws + (c64 < 52 ? OFF_GA : OFF_GB));
            const int cb = (c64 < 52 ? c64 - 36 : c64 - 52) * 64;
#pragma unroll
            for (int m = 0; m < 4; ++m)
#pragma unroll
                for (int n = 0; n < 4; ++n)
#pragma unroll
                    for (int j = 0; j < 4; ++j) st_bf16(d + (size_t)(tok0 + m * 16 + q * 4 + j) * 1024 + cb + n * 16 + cl, sigmoidf_(acc[m][n][j]));
        } else if (c64 == 34) {
            bf16_t* dki = (bf16_t*)(ws + OFF_KI); float* dwi = (float*)(ws + OFF_WI); float* dg = (float*)(ws + OFF_GATES);
#pragma unroll
            for (int m = 0; m < 4; ++m)
#pragma unroll
                for (int j = 0; j < 4; ++j) {
                    const int tok = tok0 + m * 16 + q * 4 + j;
                    const f32x2 c = cs[(size_t)tok * 32 + 2 * cl];
                    const float x1 = acc[m][0][j], x2 = acc[m][1][j];
                    st_bf16(dki + (size_t)tok * 32 + cl, x1 * c.x - x2 * c.y);
                    st_bf16(dki + (size_t)tok * 32 + 16 + cl, x1 * c.y + x2 * c.x);
                    const float v2 = acc[m][2][j], v3 = acc[m][3][j];
                    if (cl < 8) dwi[(size_t)tok * 8 + cl] = v2; else dg[(size_t)tok * 24 + (cl - 8)] = sigmoidf_(v2);
                    dg[(size_t)tok * 24 + 8 + cl] = sigmoidf_(v3);
                }
        }
    }
}

DEVI float siluf_(float x) { return x * __builtin_amdgcn_rcpf(1.0f + __builtin_amdgcn_exp2f(-x * 1.4426950408889634f)); }

DEVI void phase_compress(const Params& P, unsigned char* lds, int tid) {
    unsigned char* ws = P.ws;
    const rsrc_t rs = __builtin_amdgcn_make_buffer_rsrc((void*)P.ws, (short)0, (int)0x7fffffff, 0x00020000);
    const int lane = tid & 63, wid = __builtin_amdgcn_readfirstlane(tid >> 6), wr = wid >> 1, wc = wid & 1, q = lane >> 4, cl = lane & 15;
    for (int u = blockIdx.x; u < 64; u += gridDim.x) {
        const int kv = u >> 5, mt = u & 31;
        const bf16_t* A = (const bf16_t*)(ws + OFF_KV + (size_t)kv * KV_STRIDE) + (size_t)mt * 128 * 1024;
        const bf16_t* W1 = (const bf16_t*)(ws + (kv ? OFF_W1V : OFF_W1K));
        const bf16_t* W2 = (const bf16_t*)(ws + (kv ? OFF_W2V : OFF_W2K));
        const float* bias = (const float*)(ws + OFF_BIAS1) + kv * 128;
        f32x4 acc[4][4];
        gemm128(acc, rs, (unsigned)(OFF_KV + (size_t)kv * KV_STRIDE + (size_t)mt * 128 * 2048), RowLin{2048}, (unsigned)(kv ? OFF_W1V : OFF_W1K), RowLin{4096}, 32, lds, tid);
#pragma unroll
        for (int m = 0; m < 4; ++m)
#pragma unroll
            for (int n = 0; n < 4; ++n) {
                const int col = wc * 64 + n * 16 + cl;
                const float bb = bias[col];
#pragma unroll
                for (int j = 0; j < 4; ++j) {
                    const int row = wr * 64 + m * 16 + q * 4 + j;
                    const int ktile = col >> 6, ch = (col & 63) >> 3, wi = col & 7;
                    *(bf16_t*)(lds + ktile * 16384 + row * 128 + ((ch ^ (row & 7)) << 4) + wi * 2) = (bf16_t)f2bf(siluf_(acc[m][n][j] + bb));
                }
            }
#pragma unroll
        for (int i = 0; i < 4; ++i) {
            const int idx = tid + 256 * i;
            const int row = idx >> 4, ch16 = idx & 15, ktile = ch16 >> 3, ch = ch16 & 7;
            *(u32x4*)(lds + 32768 + ktile * 8192 + row * 128 + ((ch ^ (row & 7)) << 4)) = *(const u32x4*)(W2 + (size_t)row * 128 + ch16 * 8);
        }
        __syncthreads();
        f32x4 a2[4][2];
#pragma unroll
        for (int m = 0; m < 4; ++m) { a2[m][0] = (f32x4){0.f, 0.f, 0.f, 0.f}; a2[m][1] = (f32x4){0.f, 0.f, 0.f, 0.f}; }
#pragma unroll
        for (int kk = 0; kk < 4; ++kk) {
            const int ktile = kk >> 1, ks = kk & 1;
            bf16x8 a[4], b[2];
#pragma unroll
            for (int m = 0; m < 4; ++m) { const int row = wr * 64 + m * 16 + cl; a[m] = *(const bf16x8*)(lds + ktile * 16384 + row * 128 + (((ks * 4 + q) ^ (row & 7)) << 4)); }
#pragma unroll
            for (int n = 0; n < 2; ++n) { const int row = wc * 32 + n * 16 + cl; b[n] = *(const bf16x8*)(lds + 32768 + ktile * 8192 + row * 128 + (((ks * 4 + q) ^ (row & 7)) << 4)); }
#pragma unroll
            for (int m = 0; m < 4; ++m)
#pragma unroll
                for (int n = 0; n < 2; ++n) a2[m][n] = MFMA16(a[m], b[n], a2[m][n]);
        }
#pragma unroll
        for (int m = 0; m < 4; ++m)
#pragma unroll
            for (int n = 0; n < 2; ++n) {
                const int d = wc * 32 + n * 16 + cl;
                const int r0 = mt * 128 + wr * 64 + m * 16 + q * 4;
                float v[4];
#pragma unroll
                for (int j = 0; j < 4; ++j) v[j] = (((r0 + j) & 255) == 255) ? 0.f : a2[m][n][j];
                if (kv == 0) {
                    bf16_t* kc = (bf16_t*)(ws + OFF_KC);
#pragma unroll
                    for (int j = 0; j < 4; ++j) st_bf16(kc + (size_t)(r0 + j) * 64 + d, v[j]);
                } else {
                    bf16_t* vct = (bf16_t*)(ws + OFF_VCT);
                    u32x2 w; w.x = pk2(v[0], v[1]); w.y = pk2(v[2], v[3]);
                    *(u32x2*)(vct + ((size_t)((r0 >> 8) * 64 + d)) * 256 + (r0 & 255)) = w;
                }
            }
        __syncthreads();
    }
}

DEVI void phase_index(const Params& P, unsigned char* lds, int tid) {
    unsigned char* ws = P.ws;
    const bf16_t* QI = (const bf16_t*)(ws + OFF_QI);
    const bf16_t* KI = (const bf16_t*)(ws + OFF_KI);
    const float* WI = (const float*)(ws + OFF_WI);
    bf16_t* SEL = (bf16_t*)(ws + OFF_SEL);
    float* S = (float*)lds;
    const int lane = tid & 63, wid = __builtin_amdgcn_readfirstlane(tid >> 6), q = lane >> 4, cl = lane & 15;
    for (int u = blockIdx.x; u < NTOK / 4; u += gridDim.x) {
        const int b = u >> 10, w10 = u & 1023, s10 = (w10 < 512) ? w10 : 1535 - w10;
        const int t0 = s10 * 4, tok0 = b * 4096 + t0;
        const int t = t0 + wid;
        const int tok = tok0 + wid;
        if (t0 + 3 < 256) {
            for (int i = lane; i < 256; i += 64) SEL[(size_t)tok * 256 + i] = (bf16_t)(i <= t ? i : 0);
            continue;
        }
        {
            bf16x8 a[2];
#pragma unroll
            for (int hg = 0; hg < 2; ++hg) a[hg] = *(const bf16x8*)(QI + (size_t)(tok0 + (cl >> 2)) * 256 + (4 * hg + (cl & 3)) * 32 + q * 8);
            const f32x4 w0 = *(const f32x4*)(WI + (size_t)(tok0 + q) * 8), w1 = *(const f32x4*)(WI + (size_t)(tok0 + q) * 8 + 4);
            const int ktmax = (t0 + 3) >> 4;
            const bf16_t* kb = KI + (size_t)b * 4096 * 32 + cl * 32 + q * 8;
            for (int rep31 = 0; rep31 < REPS(31); ++rep31)
            for (int kt0 = wid; kt0 <= ktmax; kt0 += 16) {
                bf16x8 bk[4];
#pragma unroll
                for (int uu = 0; uu < 4; ++uu) { const int kt = (kt0 + 4 * uu <= ktmax) ? kt0 + 4 * uu : kt0; bk[uu] = *(const bf16x8*)(kb + (size_t)kt * 16 * 32); }
#pragma unroll
                for (int uu = 0; uu < 4; ++uu) {
                    const int kt = kt0 + 4 * uu;
                    f32x4 c0 = {0.f, 0.f, 0.f, 0.f}, c1 = {0.f, 0.f, 0.f, 0.f};
                    c0 = MFMA16(a[0], bk[uu], c0); c1 = MFMA16(a[1], bk[uu], c1);
                    float sc = 0.f;
#pragma unroll
                    for (int j = 0; j < 4; ++j) { sc += w0[j] * fmaxf(c0[j], 0.f); sc += w1[j] * fmaxf(c1[j], 0.f); }
                    if (kt <= ktmax) S[q * 4096 + kt * 16 + cl] = sc;
                }
            }
        }
        __syncthreads();
        {
            const int n = t + 1;
            const float* Sq = S + wid * 4096;
            if (n <= 256) {
                for (int i = lane; i < 256; i += 64) SEL[(size_t)tok * 256 + i] = (bf16_t)(i <= t ? i : 0);
            } else {
                const int nr = (n + 63) >> 6;
                float x[64];
                const float NINF = -__builtin_inff();
                float mx = NINF, mn = __builtin_inff();
#pragma unroll
                for (int r = 0; r < 64; ++r) {
                    const int key = r * 64 + lane;
                    const float v = Sq[key];
                    x[r] = (key < n) ? v : NINF;
                    mn = fminf(mn, (key < n) ? v : __builtin_inff());
                    mx = fmaxf(mx, x[r]);
                }
#pragma unroll
                for (int o = 32; o > 0; o >>= 1) { mx = fmaxf(mx, __shfl_xor(mx, o)); mn = fminf(mn, __shfl_xor(mn, o)); }
                float lo = mn, hi = mx, T; int need;
                int chi, clo = n;
                for (int rep32 = 0; rep32 < REPS(32); ++rep32) {
                lo = mn; hi = mx; clo = n;
                {
                    int c = 0;
#pragma unroll
                    for (int g8 = 0; g8 < 8; ++g8) if (g8 * 8 < nr) {
#pragma unroll
                        for (int r = g8 * 8; r < g8 * 8 + 8; ++r) c += (x[r] >= hi) ? 1 : 0;
                    }
                    chi = wave_sum_i32(c);
                }
                if (chi >= 256) { T = hi; need = 256;   }
                else {
                    float s1 = 0.f, s2 = 0.f;
#pragma unroll
                    for (int g8 = 0; g8 < 8; ++g8) if (g8 * 8 < nr) {
#pragma unroll
                        for (int r = g8 * 8; r < g8 * 8 + 8; ++r) { const float v = (x[r] == NINF) ? 0.f : x[r]; s1 += v; s2 += v * v; }
                    }
                    s1 = wave_sum_f32_dpp(s1); s2 = wave_sum_f32_dpp(s2);
                    const float fn = (float)n, mu = s1 / fn;
                    const float sg = sqrtf(fmaxf(s2 / fn - mu * mu, 1e-20f));
                    float vg;
                    {
                        const float pq = 256.0f / fn, pp = fminf(pq, 1.0f - pq);
                        const float tt = sqrtf(-2.0f * __logf(fmaxf(pp, 1e-6f)));
                        const float zz = tt - (2.515517f + 0.802853f * tt + 0.010328f * tt * tt) / (1.0f + 1.432788f * tt + 0.189269f * tt * tt + 0.001308f * tt * tt * tt);
                        vg = mu + ((pq <= 0.5f) ? zz : -zz) * sg;
                    }
                    bool found = false, adjacent = false; float thr = 0.f;
                    for (int it = 0; it < 160; ++it) {
                        if (clo - chi <= 64) break;
                        const float mid = 0.5f * lo + 0.5f * hi;
                        if (!(mid > lo && mid < hi)) { adjacent = true; break; }
                        float v = vg;
                        if (!(v > lo && v < hi) || (it & 3) == 3) v = mid;
                        int c = 0;
#pragma unroll
                        for (int g8 = 0; g8 < 8; ++g8) if (g8 * 8 < nr) {
#pragma unroll
                            for (int r = g8 * 8; r < g8 * 8 + 8; ++r) c += (x[r] >= v) ? 1 : 0;
                        }
                        c = wave_sum_i32(c);
                        if (c == 256) { found = true; thr = v; break; }
                        if (c > 256) { lo = v; clo = c; } else { hi = v; chi = c; }
                        const float zv = (v - mu) / sg;
                        const float dens = fmaxf(fn * 0.39894228f * __expf(-0.5f * zv * zv), 0.5f) / sg;
                        vg = v + ((float)c - ((c > 256) ? 244.0f : 268.0f)) / dens;
                    }
                    if (found) { T = thr; need = -1; }
                    else if (adjacent) { T = lo; need = 256 - chi; }
                    else {
                        float* cand = (float*)(lds + 65536) + wid * 64;
                        cand[lane] = NINF;
                        int cb = 0;
                        const unsigned long long ltm = (1ull << lane) - 1ull;
#pragma unroll
                        for (int g8 = 0; g8 < 8; ++g8) if (g8 * 8 < nr) {
#pragma unroll
                            for (int r = g8 * 8; r < g8 * 8 + 8; ++r) {
                                const bool isc = (x[r] >= lo) && (x[r] < hi);
                                const unsigned long long bm = __ballot(isc);
                                if (isc) cand[cb + __popcll(bm & ltm)] = x[r];
                                cb += __popcll(bm);
                            }
                        }
                        const float y = cand[lane];
                        int cgt = 0, cge = 0;
#pragma unroll
                        for (int k = 0; k < 64; ++k) { const float yk = __builtin_bit_cast(float, __builtin_amdgcn_readlane(__builtin_bit_cast(int, y), k)); cgt += (yk > y) ? 1 : 0; cge += (yk >= y) ? 1 : 0; }
                        const int nd = 256 - chi;
                        const bool isT = (y != NINF) && (cgt <= nd - 1) && (cge >= nd);
                        const unsigned long long tm = __ballot(isT);
                        const int tl = (tm != 0ull) ? (int)__builtin_ctzll(tm) : 0;
                        T = __shfl(y, tl);
                        need = nd - __shfl(cgt, tl);
                    }
                }
                asm volatile("" : "+v"(mn), "+v"(mx));
                }
                for (int rep33 = 0; rep33 < REPS(33); ++rep33) {
                int base = 0, eqc = 0;
                const unsigned long long lt = (1ull << lane) - 1ull;
#pragma unroll
                for (int g8 = 0; g8 < 8; ++g8) if (g8 * 8 < nr) {
#pragma unroll
                    for (int r = g8 * 8; r < g8 * 8 + 8; ++r) {
                        bool sel;
                        if (need < 0) sel = x[r] >= T;
                        else {
                            const bool eq = (x[r] == T);
                            const unsigned long long em = __ballot(eq);
                            sel = (x[r] > T) || (eq && (eqc + __popcll(em & lt) < need));
                            eqc += __popcll(em);
                        }
                        const unsigned long long sm = __ballot(sel);
                        if (sel) { const int pp = base + __popcll(sm & lt); if (pp < 256) SEL[(size_t)tok * 256 + pp] = (bf16_t)(r * 64 + lane); }
                        base += __popcll(sm);
                    }
                }
                }
            }
        }
        __syncthreads();
    }
}

DEVI void phase_dsa(const Params& P, unsigned char* lds, int tid) {
    unsigned char* ws = P.ws;
    const bf16_t* QA = (const bf16_t*)(ws + OFF_QA);
    const bf16_t* KA = (const bf16_t*)(ws + OFF_KA);
    const bf16_t* VA = (const bf16_t*)(ws + OFF_VA);
    const bf16_t* SEL = (const bf16_t*)(ws + OFF_SEL);
    bf16_t* OA = (bf16_t*)(ws + OFF_OA);
    const int lane = tid & 63, wid = __builtin_amdgcn_readfirstlane(tid >> 6), q = lane >> 4, cl = lane & 15;
    unsigned char* vl = lds + wid * 8192;
    const float NINF = -__builtin_inff();
    for (int tok = blockIdx.x * 4 + wid; tok < NTOK; tok += gridDim.x * 4) {
        const int b = tok >> 12, t = tok & 4095;
        const int cnt = (t + 1 < 256) ? t + 1 : 256;
        const int nc64 = (cnt + 63) >> 6;
        const bf16_t* sel = SEL + (size_t)tok * 256;
        const bf16_t* kb = KA + (size_t)b * 4096 * 64;
        const bf16_t* vb = VA + (size_t)b * 4096 * 64;
        bf16x8 bq[2];
#pragma unroll
        for (int ks = 0; ks < 2; ++ks) {
            bq[ks] = (bf16x8){0, 0, 0, 0, 0, 0, 0, 0};
            if (cl < 8) bq[ks] = *(const bf16x8*)(QA + (size_t)tok * 512 + cl * 64 + ks * 32 + q * 8);
        }
        f32x4 s[16];
#pragma unroll
        for (int rf = 0; rf < 16; ++rf) {
            s[rf] = (f32x4){0.f, 0.f, 0.f, 0.f};
            if ((rf >> 2) < nc64) {
                const int p = 32 * (rf >> 1) + 8 * (cl >> 2) + 4 * (rf & 1) + (cl & 3);
                const int key = sel[p];
                const bf16_t* kr = kb + (size_t)key * 64 + q * 8;
                const bf16x8 a0 = *(const bf16x8*)(kr), a1 = *(const bf16x8*)(kr + 32);
                s[rf] = MFMA16(a0, bq[0], s[rf]); s[rf] = MFMA16(a1, bq[1], s[rf]);
            }
        }
        float mx = NINF;
#pragma unroll
        for (int rf = 0; rf < 16; ++rf)
#pragma unroll
            for (int j = 0; j < 4; ++j) {
                const int p = 32 * (rf >> 1) + 8 * q + 4 * (rf & 1) + j;
                if (p >= cnt) s[rf][j] = NINF;
                mx = fmaxf(mx, s[rf][j]);
            }
        mx = fmaxf(mx, __shfl_xor(mx, 16)); mx = fmaxf(mx, __shfl_xor(mx, 32));
        float ls = 0.f;
#pragma unroll
        for (int rf = 0; rf < 16; ++rf)
#pragma unroll
            for (int j = 0; j < 4; ++j) { const float pv = __builtin_amdgcn_exp2f((s[rf][j] - mx) * LOG2E); s[rf][j] = pv; ls += pv; }
        ls += __shfl_xor(ls, 16); ls += __shfl_xor(ls, 32);
        const float inv = 1.0f / ls;
        f32x4 o[4];
#pragma unroll
        for (int d = 0; d < 4; ++d) o[d] = (f32x4){0.f, 0.f, 0.f, 0.f};
#pragma unroll
        for (int cc = 0; cc < 4; ++cc) {
            if (cc < nc64) {
                const int mykey = sel[cc * 64 + lane];
                __builtin_amdgcn_wave_barrier();
#pragma unroll
                for (int i = 0; i < 8; ++i) {
                    const int row = (lane >> 3) + 8 * i;
                    const int key = __shfl(mykey, row);
                    *(u32x4*)(vl + row * 128 + (lane & 7) * 16) = *(const u32x4*)(vb + (size_t)key * 64 + (lane & 7) * 8);
                }
                __builtin_amdgcn_wave_barrier();
#pragma unroll
                for (int c2 = 0; c2 < 2; ++c2) {
                    const bf16x8 pb = pack8(s[cc * 4 + c2 * 2], s[cc * 4 + c2 * 2 + 1]);
#pragma unroll
                    for (int d = 0; d < 4; ++d) {
                        LAS unsigned char* a0addr = (LAS unsigned char*)(vl) + (c2 * 32 + 8 * q + (cl >> 2)) * 128 + (d * 16 + 4 * (cl & 3)) * 2;
                        const s16x4 lo4 = __builtin_amdgcn_ds_read_tr16_b64_v4i16((LAS s16x4*)(a0addr));
                        const s16x4 hi4 = __builtin_amdgcn_ds_read_tr16_b64_v4i16((LAS s16x4*)(a0addr + 4 * 128));
                        const bf16x8 av = {lo4[0], lo4[1], lo4[2], lo4[3], hi4[0], hi4[1], hi4[2], hi4[3]};
                        o[d] = MFMA16(av, pb, o[d]);
                    }
                }
            }
        }
        if (cl < 8) {
#pragma unroll
            for (int d = 0; d < 4; ++d) {
                u32x2 w; w.x = pk2(o[d][0] * inv, o[d][1] * inv); w.y = pk2(o[d][2] * inv, o[d][3] * inv);
                *(u32x2*)(OA + (size_t)tok * 512 + cl * 64 + d * 16 + q * 4) = w;
            }
        }
    }
}

DEVI int fK(int row) { return (row & 3) | (((row >> 3) & 1) << 2); }

struct AttnState { f32x4 O[4][4]; float m[4]; float l[4]; };

template <int MODE>
DEVI void attn_blocks(rsrc_t rs, unsigned sK, unsigned sV, int ldv, int jb0, int jb1, const bf16x8 (&qf)[4][2], AttnState& st,
                      int tq, unsigned long long selmask, unsigned char* lds, int tid) {
    const int lane = tid & 63, q = lane >> 4, cl = lane & 15;
    const float NINF = -__builtin_inff();
#pragma unroll
    for (int cf = 0; cf < 4; ++cf) { st.m[cf] = NINF; st.l[cf] = 0.f;
#pragma unroll
        for (int d = 0; d < 4; ++d) st.O[d][cf] = (f32x4){0.f, 0.f, 0.f, 0.f}; }
    if (jb1 < jb0) return;
    unsigned kro[2], vro[2]; int kwo[2], vwo[2];
#pragma unroll
    for (int i = 0; i < 2; ++i) {
        const int idx = tid + 256 * i, row = idx >> 3, ch = idx & 7;
        kro[i] = (unsigned)(row * 64 + ch * 8) * 2u; kwo[i] = row * 128 + ((ch ^ fK(row)) << 4);
        vro[i] = (unsigned)(row * ldv + ch * 8) * 2u; vwo[i] = 8192 + row * 128 + ((ch ^ (row & 7)) << 4);
    }
    u32x4 rk[2], rv[2];
#pragma unroll
    for (int i = 0; i < 2; ++i) { rk[i] = bload16(rs, kro[i], sK + (unsigned)jb0 * 8192u); rv[i] = bload16(rs, vro[i], sV + (unsigned)jb0 * 128u); }
#pragma unroll
    for (int i = 0; i < 2; ++i) { *(u32x4*)(lds + kwo[i]) = rk[i]; *(u32x4*)(lds + vwo[i]) = rv[i]; }
    __syncthreads();
    const int nmax = (tq >= 31) ? ((tq - 31) >> 4) : -1;
    for (int jb = jb0; jb <= jb1; ++jb) {
        unsigned char* cur = lds + ((jb - jb0) & 1) * 16384;
        unsigned char* nxt = lds + ((jb - jb0 + 1) & 1) * 16384;
        const bool more = jb < jb1;
        if (more) {
#pragma unroll
            for (int i = 0; i < 2; ++i) { rk[i] = bload16(rs, kro[i], sK + (unsigned)(jb + 1) * 8192u); rv[i] = bload16(rs, vro[i], sV + (unsigned)(jb + 1) * 128u); }
        }
        bool lane_on = true;
        if (MODE == 1) lane_on = ((selmask >> jb) & 1ull) != 0ull;
        if (MODE == 0) lane_on = (jb * 64 <= nmax);
        if (MODE == 2) lane_on = (jb * 64 + 63 > tq - 512);
        if (__ballot(lane_on) != 0ull) {
#pragma unroll
            for (int c = 0; c < 2; ++c) {
                f32x4 S[2][4];
#pragma unroll
                for (int r2 = 0; r2 < 2; ++r2)
#pragma unroll
                    for (int cf = 0; cf < 4; ++cf) S[r2][cf] = (f32x4){0.f, 0.f, 0.f, 0.f};
#pragma unroll
                for (int r2 = 0; r2 < 2; ++r2) {
                    const int kl = 32 * c + 8 * (cl >> 2) + 4 * r2 + (cl & 3);
#pragma unroll
                    for (int ks = 0; ks < 2; ++ks) {
                        const bf16x8 a = *(const bf16x8*)(cur + kl * 128 + (((ks * 4 + q) ^ (cl & 7)) << 4));
#pragma unroll
                        for (int cf = 0; cf < 4; ++cf) S[r2][cf] = MFMA16(a, qf[cf][ks], S[r2][cf]);
                    }
                }
                bf16x8 pb[4];
#pragma unroll
                for (int cf = 0; cf < 4; ++cf) {
                    float bm = NINF;
#pragma unroll
                    for (int r2 = 0; r2 < 2; ++r2)
#pragma unroll
                        for (int j = 0; j < 4; ++j) {
                            const int key = jb * 64 + 32 * c + 8 * q + 4 * r2 + j;
                            bool v;
                            if (MODE == 0) v = key <= nmax;
                            else if (MODE == 1) v = lane_on && key <= tq;
                            else v = key <= tq && key > tq - 512;
                            if (!v) S[r2][cf][j] = NINF;
                            bm = fmaxf(bm, S[r2][cf][j]);
                        }
                    bm = fmaxf(bm, __shfl_xor(bm, 16)); bm = fmaxf(bm, __shfl_xor(bm, 32));
                    const float mnew = fmaxf(st.m[cf], bm);
                    const float mref = (mnew == NINF) ? 0.f : mnew;
                    const float alpha = __builtin_amdgcn_exp2f((st.m[cf] - mref) * LOG2E);
                    st.m[cf] = mnew;
                    float ps = 0.f;
#pragma unroll
                    for (int r2 = 0; r2 < 2; ++r2)
#pragma unroll
                        for (int j = 0; j < 4; ++j) { const float pv = __builtin_amdgcn_exp2f((S[r2][cf][j] - mref) * LOG2E); S[r2][cf][j] = pv; ps += pv; }
                    st.l[cf] = st.l[cf] * alpha + ps;
#pragma unroll
                    for (int d = 0; d < 4; ++d) st.O[d][cf] *= alpha;
                    pb[cf] = pack8(S[0][cf], S[1][cf]);
                }
#pragma unroll
                for (int d = 0; d < 4; ++d) {
                    const int row = d * 16 + cl;
                    const bf16x8 av = *(const bf16x8*)(cur + 8192 + row * 128 + (((c * 4 + q) ^ (row & 7)) << 4));
#pragma unroll
                    for (int cf = 0; cf < 4; ++cf) st.O[d][cf] = MFMA16(av, pb[cf], st.O[d][cf]);
                }
            }
        }
        if (more) {
#pragma unroll
            for (int i = 0; i < 2; ++i) { *(u32x4*)(nxt + kwo[i]) = rk[i]; *(u32x4*)(nxt + vwo[i]) = rv[i]; }
        }
        __syncthreads();
    }
}

DEVI f32x4 bload16f(rsrc_t r, unsigned voff, unsigned soff) { return __builtin_bit_cast(f32x4, __builtin_amdgcn_raw_buffer_load_b128(r, (int)voff, (int)soff, 0)); }
DEVI void bstore16f(rsrc_t r, f32x4 v, unsigned voff, unsigned soff) { __builtin_amdgcn_raw_buffer_store_b128(__builtin_bit_cast(u32x4, v), r, (int)voff, (int)soff, 0); }
DEVI float bload4f(rsrc_t r, unsigned voff, unsigned soff) { return __builtin_bit_cast(float, __builtin_amdgcn_raw_buffer_load_b32(r, (int)voff, (int)soff, 0)); }

struct NsaUnit { int i, b, k, t0, tq; unsigned tokw, tokb, qoff, goff, ooff, sQ, sG, sO; };
DEVI NsaUnit nsa_unit(int uu, int tid) {
    NsaUnit U;
    const int lane = tid & 63, wid = __builtin_amdgcn_readfirstlane(tid >> 6), q = lane >> 4, cl = lane & 15;
    const int half = uu >> 9, r = uu & 511, bk = r & 15, ii = r >> 4;
    U.i = half ? ii : 63 - ii; U.b = bk >> 1; U.k = bk & 1;
    U.t0 = U.i * 64; U.tq = U.t0 + wid * 16 + cl;
    U.tokw = (unsigned)(wid * 16 + cl);
    U.tokb = (unsigned)(U.b * 4096 + U.t0);
    U.qoff = U.tokw * 1024u + (unsigned)q * 16u;
    U.goff = U.tokw * 96u;
    U.ooff = U.tokw * 1024u + (unsigned)q * 8u;
    U.sQ = U.tokb * 1024u + (unsigned)U.k * 512u;
    U.sG = (unsigned)OFF_GATES + U.tokb * 96u + (unsigned)U.k * 16u;
    U.sO = (unsigned)OFF_OB + U.tokb * 1024u + (unsigned)U.k * 512u;
    return U;
}

DEVI void nsa_cmp_unit(const Params& P, rsrc_t rs, int uu, unsigned char* lds, int tid) {
    const int lane = tid & 63, wid = __builtin_amdgcn_readfirstlane(tid >> 6), q = lane >> 4, cl = lane & 15;
    const NsaUnit U = nsa_unit(uu, tid);
    const int i = U.i, b = U.b, k = U.k, tq = U.tq;
    AttnState st;
    bf16x8 qf[4][2];
#pragma unroll
    for (int cf = 0; cf < 4; ++cf)
#pragma unroll
        for (int ks = 0; ks < 2; ++ks) qf[cf][ks] = __builtin_bit_cast(bf16x8, bload16(rs, U.qoff, (unsigned)OFF_QBN + U.sQ + cf * 128 + ks * 64));
    const unsigned sKC = (unsigned)OFF_KC + (unsigned)(b * 2 + k) * 256u * 128u;
    const unsigned sVC = (unsigned)OFF_VCT + (unsigned)(b * 2 + k) * 64u * 512u;
    const int nmax_blk = (U.t0 + 63 - 31) >> 4;
    const int jbc = (nmax_blk >> 6) < 3 ? (nmax_blk >> 6) : 3;
    attn_blocks<0>(rs, sKC, sVC, 256, 0, jbc, qf, st, tq, 0ull, lds, tid);
    float linv[4], mfin[4];
#pragma unroll
    for (int cf = 0; cf < 4; ++cf) {
        float l = st.l[cf]; l += __shfl_xor(l, 16); l += __shfl_xor(l, 32);
        linv[cf] = (l > 0.f) ? __builtin_amdgcn_rcpf(l) : 0.f; mfin[cf] = st.m[cf];
        const float sc = linv[cf] * bload4f(rs, U.goff, U.sG + cf * 4);
#pragma unroll
        for (int d = 0; d < 4; ++d) { const f32x4 v = st.O[d][cf] * sc; u32x2 w; w.x = pk2(v[0], v[1]); w.y = pk2(v[2], v[3]);
            __builtin_amdgcn_raw_buffer_store_b64(w, rs, (int)U.ooff, (int)(U.sO + cf * 128 + d * 32), 0); }
    }
    unsigned long long* MSKG = (unsigned long long*)(P.ws + OFF_MASK);
    if (i < 16) {
        if (q == 0) MSKG[((size_t)(b * 2 + k)) * 4096 + tq] = (2ull << i) - 1ull;
        return;
    }
    float* SUM4 = (float*)(lds + 16384);
    float* LAST = (float*)(lds + 32768);
    float* IMP2 = (float*)(lds + 49152);
    const int nmax = (tq >= 31) ? ((tq - 31) >> 4) : -1;
    for (int kb = 0; kb <= jbc; ++kb) {
#pragma unroll
        for (int ii = 0; ii < 2; ++ii) {
            const int idx = tid + 256 * ii, row = idx >> 3, ch = idx & 7;
            *(u32x4*)(lds + row * 128 + ((ch ^ fK(row)) << 4)) = bload16(rs, (unsigned)(row * 64 + ch * 8) * 2u, sKC + (unsigned)kb * 8192u);
        }
        __syncthreads();
#pragma unroll
        for (int rf = 0; rf < 4; ++rf) {
            f32x4 S[4];
#pragma unroll
            for (int cf = 0; cf < 4; ++cf) S[cf] = (f32x4){0.f, 0.f, 0.f, 0.f};
            const int kl = 32 * (rf >> 1) + 8 * (cl >> 2) + 4 * (rf & 1) + (cl & 3);
#pragma unroll
            for (int ks = 0; ks < 2; ++ks) {
                const bf16x8 a = *(const bf16x8*)(lds + kl * 128 + (((ks * 4 + q) ^ (cl & 7)) << 4));
#pragma unroll
                for (int cf = 0; cf < 4; ++cf) S[cf] = MFMA16(a, qf[cf][ks], S[cf]);
            }
            float acc4 = 0.f, accl = 0.f;
#pragma unroll
            for (int j = 0; j < 4; ++j) {
                const int key = kb * 64 + 32 * (rf >> 1) + 8 * q + 4 * (rf & 1) + j;
                float pj = 0.f;
#pragma unroll
                for (int cf = 0; cf < 4; ++cf) pj += __builtin_amdgcn_exp2f((S[cf][j] - mfin[cf]) * LOG2E) * linv[cf];
                pj = (key <= nmax) ? pj : 0.f;
                acc4 += pj; if (j == 3) accl = pj;
            }
            const int jblk = kb * 16 + 8 * (rf >> 1) + 2 * q + (rf & 1);
            SUM4[(wid * 16 + cl) * 64 + jblk] = acc4; LAST[(wid * 16 + cl) * 64 + jblk] = accl;
        }
        __syncthreads();
    }
    {
        const int qi = tid >> 2, jg = tid & 3;
        const int jlim = (jbc + 1) * 16;
        for (int jj = 0; jj < 16; ++jj) {
            const int j = jg * 16 + jj;
            float v = (j < jlim) ? SUM4[qi * 64 + j] : 0.f;
            if (j >= 1 && j - 1 < jlim) v += LAST[qi * 64 + j - 1];
            IMP2[qi * 64 + j] = v;
        }
    }
    __syncthreads();
    {
        const int qi = tid >> 2, jg = tid & 3;
        const float* row = IMP2 + qi * 64;
        unsigned lo = 0u;
        for (int jj = 0; jj < 16; ++jj) {
            const int j = jg * 16 + jj;
            if (j <= i) {
                const bool forced = (j == 0) || (j == i) || (j == i - 1);
                const float kj = forced ? __builtin_inff() : row[j];
                int rank = 0;
                for (int j2 = 0; j2 <= i; ++j2) {
                    const bool f2 = (j2 == 0) || (j2 == i) || (j2 == i - 1);
                    const float k2 = f2 ? __builtin_inff() : row[j2];
                    rank += (k2 > kj || (k2 == kj && j2 < j)) ? 1 : 0;
                }
                if (rank < 16) lo |= (1u << jj);
            }
        }
        unsigned long long bits = (unsigned long long)lo << (jg * 16);
        bits |= __shfl_xor(bits, 1); bits |= __shfl_xor(bits, 2);
        if (jg == 0) MSKG[((size_t)(b * 2 + k)) * 4096 + U.t0 + qi] = bits;
    }
    __syncthreads();
}

template <int MODE>
DEVI void nsa_kv_unit(const Params& P, rsrc_t rs, int uu, unsigned char* lds, int tid) {
    const int lane = tid & 63, q = lane >> 4;
    const NsaUnit U = nsa_unit(uu, tid);
    const int i = U.i, b = U.b, k = U.k, tq = U.tq;
    AttnState st;
    bf16x8 qf[4][2];
#pragma unroll
    for (int cf = 0; cf < 4; ++cf)
#pragma unroll
        for (int ks = 0; ks < 2; ++ks) qf[cf][ks] = __builtin_bit_cast(bf16x8, bload16(rs, U.qoff, (unsigned)OFF_QBR + U.sQ + cf * 128 + ks * 64));
    const unsigned sK = (unsigned)(OFF_KV + (MODE == 1 ? 2 : 4) * KV_STRIDE) + (unsigned)(b * 2 + k) * 4096u * 128u;
    const unsigned sV = (unsigned)(OFF_KV + (MODE == 1 ? 3 : 5) * KV_STRIDE) + (unsigned)(b * 2 + k) * 64u * 8192u;
    unsigned long long mymask = 0ull;
    int j0 = 0;
    if (MODE == 1) mymask = ((const unsigned long long*)(P.ws + OFF_MASK))[((size_t)(b * 2 + k)) * 4096 + tq];
    else j0 = (i >= 8) ? i - 8 : 0;
    attn_blocks<MODE>(rs, sK, sV, 4096, j0, i, qf, st, tq, mymask, lds, tid);
#pragma unroll
    for (int cf = 0; cf < 4; ++cf) {
        float l = st.l[cf]; l += __shfl_xor(l, 16); l += __shfl_xor(l, 32);
        const float sc = ((l > 0.f) ? __builtin_amdgcn_rcpf(l) : 0.f) * bload4f(rs, U.goff, U.sG + (MODE == 1 ? 32 : 64) + cf * 4);
#pragma unroll
        for (int d = 0; d < 4; ++d) {
            const u32x2 pw = __builtin_bit_cast(u32x2, __builtin_amdgcn_raw_buffer_load_b64(rs, (int)U.ooff, (int)(U.sO + cf * 128 + d * 32), 0));
            f32x4 v = st.O[d][cf] * sc;
            v[0] += bf2f(pw.x & 0xffffu); v[1] += bf2f(pw.x >> 16); v[2] += bf2f(pw.y & 0xffffu); v[3] += bf2f(pw.y >> 16);
            u32x2 w; w.x = pk2(v[0], v[1]); w.y = pk2(v[2], v[3]);
            __builtin_amdgcn_raw_buffer_store_b64(w, rs, (int)U.ooff, (int)(U.sO + cf * 128 + d * 32), 0);
        }
    }
}

DEVI void phase_nsa(const Params& P, unsigned char* lds, int tid) {
    const rsrc_t rs = __builtin_amdgcn_make_buffer_rsrc((void*)P.ws, (short)0, (int)0x7fffffff, 0x00020000);
    for (int uu = blockIdx.x; uu < 1024; uu += gridDim.x) { int t = tid; asm volatile("" : "+v"(t)); nsa_cmp_unit(P, rs, uu, lds, t); }
    __syncthreads();
    for (int uu = blockIdx.x; uu < 1024; uu += gridDim.x) { int t = tid; asm volatile("" : "+v"(t)); nsa_kv_unit<1>(P, rs, uu, lds, t); }
    __syncthreads();
    for (int uu = blockIdx.x; uu < 1024; uu += gridDim.x) { int t = tid; asm volatile("" : "+v"(t)); nsa_kv_unit<2>(P, rs, uu, lds, t); }
}

DEVI void phase_merge(const Params& P, unsigned char* lds, int tid) {
    unsigned char* ws = P.ws;
    const rsrc_t rs = __builtin_amdgcn_make_buffer_rsrc((void*)P.ws, (short)0, (int)0x7fffffff, 0x00020000);
    const bf16_t* ga = (const bf16_t*)(ws + OFF_GA);
    const bf16_t* gb = (const bf16_t*)(ws + OFF_GB);
    bf16_t* mg = (bf16_t*)(ws + OFF_MERGED);
    const int lane = tid & 63, wid = __builtin_amdgcn_readfirstlane(tid >> 6), wr = wid >> 1, wc = wid & 1, q = lane >> 4, cl = lane & 15;
    for (int u = blockIdx.x; u < 256 * 8; u += gridDim.x) {
        const int mt = u >> 3, nt = u & 7;
        f32x4 acc[4][4];
        unsigned t[4][4][2];
        gemm128(acc, rs, (unsigned)(OFF_OA + (size_t)mt * 128 * 1024), RowLin{1024}, (unsigned)(OFF_WBRA + (size_t)nt * 128 * 1024), RowLin{1024}, 8, lds, tid);
        const size_t e0 = (size_t)(mt * 128 + wr * 64 + q * 4) * 1024 + nt * 128 + wc * 64 + cl;
#pragma unroll
        for (int m = 0; m < 4; ++m)
#pragma unroll
            for (int n = 0; n < 4; ++n)
#pragma unroll
                for (int jp = 0; jp < 2; ++jp)
                    t[m][n][jp] = pk2(acc[m][n][2 * jp] * bf2f(ga[e0 + (size_t)(m * 16 + 2 * jp) * 1024 + n * 16]),
                                      acc[m][n][2 * jp + 1] * bf2f(ga[e0 + (size_t)(m * 16 + 2 * jp + 1) * 1024 + n * 16]));
        gemm128(acc, rs, (unsigned)(OFF_OB + (size_t)mt * 128 * 1024), RowLin{1024}, (unsigned)(OFF_WBRB + (size_t)nt * 128 * 1024), RowLin{1024}, 8, lds, tid);
#pragma unroll
        for (int m = 0; m < 4; ++m)
#pragma unroll
            for (int n = 0; n < 4; ++n)
#pragma unroll
                for (int j = 0; j < 4; ++j) {
                    const size_t o = e0 + (size_t)(m * 16 + j) * 1024 + n * 16;
                    const float tv = (j & 1) ? bf2f(t[m][n][j >> 1] >> 16) : bf2f(t[m][n][j >> 1] & 0xffffu);
                    st_bf16(mg + o, tv + acc[m][n][j] * bf2f(gb[o]));
                }
    }
}

DEVI void phase_outproj(const Params& P, unsigned char* lds, int tid) {
    unsigned char* ws = P.ws;
    const rsrc_t rs = __builtin_amdgcn_make_buffer_rsrc((void*)P.ws, (short)0, (int)0x7fffffff, 0x00020000);
    const bf16_t* mg = (const bf16_t*)(ws + OFF_MERGED);
    const bf16_t* wo = (const bf16_t*)(ws + OFF_WOUT);
    const float* x = P.in[0];
    float* x1 = P.out;
    const int lane = tid & 63, wid = __builtin_amdgcn_readfirstlane(tid >> 6), wr = wid >> 1, wc = wid & 1, q = lane >> 4, cl = lane & 15;
    for (int u = blockIdx.x; u < 256 * 8; u += gridDim.x) {
        const int mt = u >> 3, nt = u & 7;
        f32x4 acc[4][4];
        gemm128(acc, rs, (unsigned)(OFF_MERGED + (size_t)mt * 128 * 2048), RowLin{2048}, (unsigned)(OFF_WOUT + (size_t)nt * 128 * 2048), RowLin{2048}, 16, lds, tid);
#pragma unroll
        for (int m = 0; m < 4; ++m)
#pragma unroll
            for (int n = 0; n < 4; ++n)
#pragma unroll
                for (int j = 0; j < 4; ++j) {
                    const size_t o = (size_t)(mt * 128 + wr * 64 + m * 16 + q * 4 + j) * 1024 + nt * 128 + wc * 64 + n * 16 + cl;
                    x1[o] = x[o] + acc[m][n][j];
                }
    }
}

DEVI void phase_router(const Params& P, unsigned char* lds, int tid) {
    unsigned char* ws = P.ws;
    const int lane = tid & 63, wid = __builtin_amdgcn_readfirstlane(tid >> 6), q = lane >> 4, cl = lane & 15;
    const float* x1 = P.out; const float* g = P.in[13];
    const float* bg = P.in[15]; const float* be = P.in[17];
    const float* WR = (const float*)(ws + OFF_WR);
    bf16_t* h2 = (bf16_t*)(ws + OFF_HN);
    unsigned* cnt = (unsigned*)(ws + OFF_CTL);
    int* list = (int*)(ws + OFF_LIST);
    float* wt = (float*)(ws + OFF_WT);
    float* WL = (float*)lds;
    float* LG = (float*)(lds + 50688);
    float* RS = (float*)(lds + 50688 + 12288);
    for (int u = blockIdx.x; u < NTOK / 64; u += gridDim.x) {
        const int row0 = u * 64 + wid * 16;
        const float* xa = x1 + (size_t)(row0 + cl) * 1024 + 4 * q;
        f32x4 acc[3];
#pragma unroll
        for (int ct = 0; ct < 3; ++ct) acc[ct] = (f32x4){0.f, 0.f, 0.f, 0.f};
        float ss = 0.f;
        for (int kc = 0; kc < 4; ++kc) {
            __syncthreads();
#pragma unroll
            for (int i = 0; i < 12; ++i) {
                const int idx = tid + 256 * i, r = idx >> 6, c4 = idx & 63;
                *(f32x4*)(WL + r * 264 + c4 * 4) = *(const f32x4*)(WR + (size_t)r * 1024 + kc * 256 + c4 * 4);
            }
            __syncthreads();
#pragma unroll
            for (int jh = 0; jh < 2; ++jh) {
                f32x4 av[8];
#pragma unroll
                for (int j = 0; j < 8; ++j) av[j] = *(const f32x4*)(xa + kc * 256 + (jh * 8 + j) * 16);
#pragma unroll
                for (int j = 0; j < 8; ++j) {
                    ss += av[j][0] * av[j][0] + av[j][1] * av[j][1] + av[j][2] * av[j][2] + av[j][3] * av[j][3];
#pragma unroll
                    for (int ct = 0; ct < 3; ++ct) {
                        const f32x4 bv = *(const f32x4*)(WL + (ct * 16 + cl) * 264 + (jh * 8 + j) * 16 + 4 * q);
#pragma unroll
                        for (int e = 0; e < 4; ++e) acc[ct] = __builtin_amdgcn_mfma_f32_16x16x4f32(av[j][e], bv[e], acc[ct], 0, 0, 0);
                    }
                }
            }
        }
        ss += __shfl_xor(ss, 16); ss += __shfl_xor(ss, 32);
        const float rs = rsqrtf(ss * (1.0f / 1024.0f) + RMS_EPS);
        if (q == 0) RS[wid * 16 + cl] = rs;
        __syncthreads();
#pragma unroll
        for (int j = 0; j < 4; ++j) {
            const float rj = RS[wid * 16 + 4 * q + j];
#pragma unroll
            for (int ct = 0; ct < 3; ++ct) LG[(wid * 16 + 4 * q + j) * 48 + ct * 16 + cl] = acc[ct][j] * rj;
        }
        __syncthreads();
        if (tid < 64) {
            const int r = u * 64 + tid;
            const float* lg = LG + tid * 48;
            float gl[4];
#pragma unroll
            for (int e = 0; e < 4; ++e) gl[e] = lg[e] + bg[e];
            int gs = 0; float gm = gl[0];
#pragma unroll
            for (int e = 1; e < 4; ++e) if (gl[e] > gm) { gm = gl[e]; gs = e; }
            float den = 0.f;
#pragma unroll
            for (int e = 0; e < 4; ++e) den += __expf(gl[e] - gm);
            const float gp = 1.0f / den;
            float el[8];
#pragma unroll
            for (int e = 0; e < 8; ++e) el[e] = lg[4 + gs * 8 + e] + be[gs * 8 + e];
            int i0 = 0; float v0 = el[0];
#pragma unroll
            for (int e = 1; e < 8; ++e) if (el[e] > v0) { v0 = el[e]; i0 = e; }
            int i1 = -1; float v1 = -__builtin_inff();
#pragma unroll
            for (int e = 0; e < 8; ++e) if (e != i0 && el[e] > v1) { v1 = el[e]; i1 = e; }
            const float e1 = __expf(v1 - v0);
            const float w0 = gp / (1.0f + e1), w1 = gp * e1 / (1.0f + e1);
            const int ex0 = gs * 8 + i0, ex1 = gs * 8 + i1;
            const unsigned p0 = atomicAdd(&cnt[ex0], 1u);
            list[(size_t)ex0 * NTOK + p0] = r * 2 + 0;
            const unsigned p1 = atomicAdd(&cnt[ex1], 1u);
            list[(size_t)ex1 * NTOK + p1] = r * 2 + 1;
            wt[(size_t)r * 2 + 0] = w0; wt[(size_t)r * 2 + 1] = w1;
        }
        for (int rr = 0; rr < 16; ++rr) {
            const int row = row0 + rr;
            const float rsr = RS[wid * 16 + rr];
#pragma unroll
            for (int i = 0; i < 4; ++i) {
                const f32x4 v = *(const f32x4*)(x1 + (size_t)row * 1024 + i * 256 + lane * 4);
                const f32x4 gg = *(const f32x4*)(g + i * 256 + lane * 4);
                u32x2 w; w.x = pk2(v[0] * rsr * gg[0], v[1] * rsr * gg[1]); w.y = pk2(v[2] * rsr * gg[2], v[3] * rsr * gg[3]);
                *(u32x2*)(h2 + (size_t)row * 1024 + i * 256 + lane * 4) = w;
            }
        }
    }
}

struct RowGather { const int* idx; DEVI unsigned operator()(int r) const { return (unsigned)idx[r] * 2048u; } };
struct RowGU { int c0; DEVI unsigned operator()(int r) const {
    const int wcx = r >> 6, w = r & 63; const int col = (w < 32) ? (c0 + wcx * 32 + w) : (256 + c0 + wcx * 32 + (w - 32)); return (unsigned)col * 2048u; } };

DEVI void phase_moe(const Params& P, unsigned char* lds, int tid) {
    unsigned char* ws = P.ws;
    const rsrc_t rs = __builtin_amdgcn_make_buffer_rsrc((void*)P.ws, (short)0, (int)0x7fffffff, 0x00020000);
    const int lane = tid & 63, wid = __builtin_amdgcn_readfirstlane(tid >> 6), wr = wid >> 1, wc = wid & 1, q = lane >> 4, cl = lane & 15;
    const unsigned* cnt = (const unsigned*)(ws + OFF_CTL);
    const int* list = (const int*)(ws + OFF_LIST);
    const bf16_t* h2 = (const bf16_t*)(ws + OFF_HN);
    const bf16_t* wgu = (const bf16_t*)(ws + OFF_WGU);
    const bf16_t* wdn = (const bf16_t*)(ws + OFF_WDN);
    bf16_t* act = (bf16_t*)(ws + OFF_ACT);
    bf16_t* Y = (bf16_t*)(ws + OFF_Y);
    int* rowtok = (int*)(lds + 65536);
    int* rowas = (int*)(lds + 65536 + 512);
    int total = 0;
    for (int e = 0; e < 32; ++e) total += ((int)cnt[e] + 127) >> 7;
    for (int u = blockIdx.x; u < total; u += gridDim.x) {
        int e = 0, tl = u;
        for (; e < 32; ++e) { const int nt = ((int)cnt[e] + 127) >> 7; if (tl < nt) break; tl -= nt; }
        const int ce = (int)cnt[e];
        if (tid < 128) {
            const int r = tl * 128 + tid;
            const int as = (r < ce) ? list[(size_t)e * NTOK + r] : -1;
            rowas[tid] = as; rowtok[tid] = (as >= 0) ? (as >> 1) : 0;
        }
        __syncthreads();
        bf16_t* au = act + (size_t)u * 128 * 256;
        for (int nt = 0; nt < 4; ++nt) {
            f32x4 acc[4][4];
            gemm128(acc, rs, (unsigned)OFF_HN, RowGather{rowtok}, (unsigned)(OFF_WGU + (size_t)e * 512 * 2048), RowGU{nt * 64}, 16, lds, tid);
#pragma unroll
            for (int m = 0; m < 4; ++m)
#pragma unroll
                for (int n = 0; n < 2; ++n)
#pragma unroll
                    for (int j = 0; j < 4; ++j) {
                        const float gt = acc[m][n][j], up = acc[m][n + 2][j];
                        const int row = wr * 64 + m * 16 + q * 4 + j, col = nt * 64 + wc * 32 + n * 16 + cl;
                        st_bf16(au + (size_t)row * 256 + col, siluf_(gt) * up);
                    }
        }
        __syncthreads();
        for (int nt = 0; nt < 8; ++nt) {
            f32x4 acc[4][4];
            gemm128(acc, rs, (unsigned)(OFF_ACT + (size_t)u * 128 * 512), RowLin{512}, (unsigned)(OFF_WDN + (size_t)e * 1024 * 512 + (size_t)nt * 128 * 512), RowLin{512}, 4, lds, tid);
#pragma unroll
            for (int m = 0; m < 4; ++m)
#pragma unroll
                for (int j = 0; j < 4; ++j) {
                    const int row = wr * 64 + m * 16 + q * 4 + j;
                    const int as = rowas[row];
                    if (as >= 0) {
                        bf16_t* yr = Y + ((size_t)(as & 1) * NTOK + (as >> 1)) * 1024 + nt * 128 + wc * 64 + cl;
#pragma unroll
                        for (int n = 0; n < 4; ++n) st_bf16(yr + n * 16, acc[m][n][j]);
                    }
                }
        }
        __syncthreads();
    }
}

DEVI void phase_final(const Params& P, int tid, bool with_moe) {
    unsigned char* ws = P.ws;
    const int lane = tid & 63, wid = __builtin_amdgcn_readfirstlane(tid >> 6);
    const bf16_t* Y = (const bf16_t*)(ws + OFF_Y);
    const float* wt = (const float*)(ws + OFF_WT);
    const float* g = P.in[20];
    float* out = P.out;
    for (int r = blockIdx.x * 4 + wid; r < NTOK; r += gridDim.x * 4) {
        float* xr = out + (size_t)r * 1024;
        const float w0 = with_moe ? wt[(size_t)r * 2] : 0.f, w1 = with_moe ? wt[(size_t)r * 2 + 1] : 0.f;
        f32x4 v[4]; float ss = 0.f;
#pragma unroll
        for (int i = 0; i < 4; ++i) {
            v[i] = *(const f32x4*)(xr + i * 256 + lane * 4);
            if (with_moe) {
                const u32x2 a = *(const u32x2*)(Y + (size_t)r * 1024 + i * 256 + lane * 4);
                const u32x2 b = *(const u32x2*)(Y + ((size_t)NTOK + r) * 1024 + i * 256 + lane * 4);
                v[i][0] += w0 * bf2f(a.x & 0xffffu) + w1 * bf2f(b.x & 0xffffu); v[i][1] += w0 * bf2f(a.x >> 16) + w1 * bf2f(b.x >> 16);
                v[i][2] += w0 * bf2f(a.y & 0xffffu) + w1 * bf2f(b.y & 0xffffu); v[i][3] += w0 * bf2f(a.y >> 16) + w1 * bf2f(b.y >> 16);
            }
            ss += v[i][0] * v[i][0] + v[i][1] * v[i][1] + v[i][2] * v[i][2] + v[i][3] * v[i][3];
        }
        ss = wave_sum(ss);
        const float rs = rsqrtf(ss * (1.0f / 1024.0f) + RMS_EPS);
#pragma unroll
        for (int i = 0; i < 4; ++i) {
            const f32x4 gg = *(const f32x4*)(g + i * 256 + lane * 4);
            f32x4 o; o[0] = v[i][0] * rs * gg[0]; o[1] = v[i][1] * rs * gg[1]; o[2] = v[i][2] * rs * gg[2]; o[3] = v[i][3] * rs * gg[3];
            *(f32x4*)(xr + i * 256 + lane * 4) = o;
        }
    }
}

#define LAUNDER_TID() do { tid = threadIdx.x; asm volatile("" : "+v"(tid)); } while (0)
__global__ void __launch_bounds__(NTHREADS, 2) fwd_megakernel(Params P) {
    extern __shared__ __attribute__((aligned(16))) unsigned char lds[];
    cg::grid_group grid = cg::this_grid();
    int tid;
    volatile LAS unsigned* bst = (volatile LAS unsigned*)(LAS unsigned char*)(lds + LDS_BYTES - 16);
    if (threadIdx.x < 4) bst[threadIdx.x] = 0u;
    for (int rep = 0; rep < REPS(10); ++rep) { LAUNDER_TID(); phase_prep(P, lds, tid); __syncthreads(); }
    grid.sync();
    const XcdBarrier bar = xcd_barrier_post((unsigned*)(P.ws + OFF_BAR), bst);
    for (int rep = 0; rep < REPS(1); ++rep) { LAUNDER_TID(); phase_gemm1(P, lds, tid); }
    xcd_barrier(bar);
    for (int rep = 0; rep < REPS(2); ++rep) { LAUNDER_TID(); phase_compress(P, lds, tid); __syncthreads(); }
    for (int rep = 0; rep < REPS(3); ++rep) { LAUNDER_TID(); phase_index(P, lds, tid); __syncthreads(); }
    xcd_barrier(bar);
    for (int rep = 0; rep < REPS(4); ++rep) { LAUNDER_TID(); phase_dsa(P, lds, tid); __syncthreads(); }
    for (int rep = 0; rep < REPS(5); ++rep) { LAUNDER_TID(); phase_nsa(P, lds, tid); __syncthreads(); }
    xcd_barrier(bar);
    for (int rep = 0; rep < REPS(6); ++rep) { LAUNDER_TID(); phase_merge(P, lds, tid); }
    xcd_barrier(bar);
    for (int rep = 0; rep < REPS(7); ++rep) { LAUNDER_TID(); phase_outproj(P, lds, tid); }
    xcd_barrier(bar);
    LAUNDER_TID(); phase_router(P, lds, tid);
    xcd_barrier(bar);
    for (int rep = 0; rep < REPS(9); ++rep) { LAUNDER_TID(); phase_moe(P, lds, tid); }
    xcd_barrier(bar);
    LAUNDER_TID(); phase_final(P, tid, true);
}

extern "C" void kernel_launch(void* const* d_in, const int* in_sizes, int n_in, void* d_out, int out_size, void* d_ws, size_t ws_size,
                              hipStream_t stream) {
    static int grid_blocks = 0;
    if (!grid_blocks) {
        int dev = 0, cus = 0, per_cu = 0;
        hipGetDevice(&dev);
        hipDeviceGetAttribute(&cus, hipDeviceAttributeMultiprocessorCount, dev);
        hipFuncSetAttribute((const void*)fwd_megakernel, hipFuncAttributeMaxDynamicSharedMemorySize, LDS_BYTES);
        hipOccupancyMaxActiveBlocksPerMultiprocessor(&per_cu, (const void*)fwd_megakernel, NTHREADS, LDS_BYTES);
        if (per_cu < 1) per_cu = 1;
        if (per_cu > 2) per_cu = 2;
        grid_blocks = cus * per_cu;
        if (ws_size < WS_END) fprintf(stderr, "kernel_launch: workspace too small: %zu < %zu\n", ws_size, (size_t)WS_END);
    }
    Params p{};
    for (int i = 0; i < 21; ++i) p.in[i] = (const float*)d_in[i];
    p.pos = (const int*)d_in[1];
    p.out = (float*)d_out;
    p.ws = (unsigned char*)d_ws;
    for (int i = 0; i < 32; ++i) p.inv_freq[i] = (double)powf(10000.0f, -(float)i / 32.0f);
    p.ph_lo = 0; p.ph_hi = 0;
    void* args[] = {&p};
    hipError_t e = hipLaunchCooperativeKernel((const void*)fwd_megakernel, dim3(grid_blocks), dim3(NTHREADS), args, LDS_BYTES, stream);
    if (e != hipSuccess) fprintf(stderr, "cooperative launch failed: %s (grid %d)\n", hipGetErrorString(e), grid_blocks);
}
```

```cpp
#include <hip/hip_runtime.h>
#include <hip/hip_cooperative_groups.h>
#include <cstdint>
#include <cstdio>
#include <cmath>
namespace cg = cooperative_groups;

#define DEVI __device__ __forceinline__
#ifndef PROBE_TWICE
#define PROBE_TWICE 0
#endif
#define REPS(k) ((PROBE_TWICE == (k)) ? 2 : 1)
typedef unsigned short bf16_t;
typedef short bf16x8 __attribute__((ext_vector_type(8)));
typedef short s16x4 __attribute__((ext_vector_type(4)));
typedef float f32x4 __attribute__((ext_vector_type(4)));
typedef float f32x2 __attribute__((ext_vector_type(2)));
typedef unsigned u32x4 __attribute__((ext_vector_type(4)));
typedef unsigned u32x2 __attribute__((ext_vector_type(2)));
#define LAS __attribute__((address_space(3)))

constexpr int NB = 8, SL = 4096, DM = 1024, NTOK = NB * SL;
constexpr int INW = 4288;
constexpr int NTHREADS = 256;
constexpr int LDS_BYTES = 81920;
constexpr float RMS_EPS = 1e-6f;
constexpr float LOG2E = 1.4426950408889634f;

constexpr int WIN_ROWS = 4352;
constexpr int G1_COLS = 4352;

constexpr size_t al256(size_t x) { return (x + 255) & ~(size_t)255; }
constexpr size_t OFF_CTL   = 0;
constexpr size_t OFF_BAR   = 4096;
constexpr size_t OFF_WIN_T = 32768;
constexpr size_t OFF_WBRA  = OFF_WIN_T + (size_t)WIN_ROWS * 1024 * 2;
constexpr size_t OFF_WBRB  = OFF_WBRA + (size_t)1024 * 512 * 2;
constexpr size_t OFF_WOUT  = OFF_WBRB + (size_t)1024 * 512 * 2;
constexpr size_t OFF_W1K   = OFF_WOUT + (size_t)1024 * 1024 * 2;
constexpr size_t OFF_W1V   = OFF_W1K + (size_t)128 * 2048 * 2;
constexpr size_t OFF_W2K   = OFF_W1V + (size_t)128 * 2048 * 2;
constexpr size_t OFF_W2V   = OFF_W2K + (size_t)64 * 128 * 2;
constexpr size_t OFF_WGU   = OFF_W2V + (size_t)64 * 128 * 2;
constexpr size_t OFF_WDN   = OFF_WGU + (size_t)32 * 512 * 1024 * 2;
constexpr size_t OFF_BIAS1 = OFF_WDN + (size_t)32 * 1024 * 256 * 2;
constexpr size_t OFF_WR    = OFF_BIAS1 + 1024;
constexpr size_t OFF_CS    = OFF_WR + (size_t)48 * 1024 * 4;
constexpr size_t OFF_HN    = OFF_CS + (size_t)NTOK * 32 * 8;
constexpr size_t OFF_QA    = OFF_HN + (size_t)NTOK * 1024 * 2;
constexpr size_t OFF_KA    = OFF_QA + (size_t)NTOK * 512 * 2;
constexpr size_t OFF_VA    = OFF_KA + (size_t)NTOK * 64 * 2;
constexpr size_t OFF_QI    = OFF_VA + (size_t)NTOK * 64 * 2;
constexpr size_t OFF_KI    = OFF_QI + (size_t)NTOK * 256 * 2;
constexpr size_t OFF_WI    = OFF_KI + (size_t)NTOK * 32 * 2;
constexpr size_t OFF_QBN   = OFF_WI + (size_t)NTOK * 8 * 4;
constexpr size_t OFF_QBR   = OFF_QBN + (size_t)NTOK * 512 * 2;
constexpr size_t KV_STRIDE = (size_t)NTOK * 128 * 2 + 65536 * 4;
constexpr size_t OFF_KV    = OFF_QBR + (size_t)NTOK * 512 * 2;
constexpr size_t OFF_GATES = OFF_KV + 6 * KV_STRIDE;
constexpr size_t OFF_QKV_END = OFF_GATES + (size_t)NTOK * 24 * 4;
constexpr size_t OFF_KC    = al256(OFF_QKV_END);
constexpr size_t OFF_VCT   = OFF_KC + (size_t)16 * 256 * 64 * 2;
constexpr size_t OFF_SEL   = OFF_VCT + (size_t)16 * 256 * 64 * 2;
constexpr size_t OFF_OA    = OFF_HN;
constexpr size_t OFF_OB    = OFF_OA + (size_t)NTOK * 512 * 2;
constexpr size_t OFF_GA    = OFF_SEL + (size_t)NTOK * 256 * 2;
constexpr size_t OFF_GB    = OFF_GA + (size_t)NTOK * 1024 * 2;
constexpr size_t OFF_MASK  = OFF_GB + (size_t)NTOK * 1024 * 2;
constexpr size_t OFF_LIST  = OFF_MASK + (size_t)16 * 4096 * 8;
constexpr size_t OFF_WT    = OFF_LIST + (size_t)32 * NTOK * 4;
constexpr size_t WS_END    = OFF_WT + (size_t)NTOK * 2 * 4;
constexpr size_t OFF_MERGED = OFF_QA;
constexpr size_t OFF_ACT    = OFF_QA;
constexpr size_t OFF_Y      = OFF_QA + (size_t)40 * 1024 * 1024;
static_assert(OFF_Y + (size_t)2 * NTOK * 1024 * 2 <= OFF_QKV_END, "Y overlay");
static_assert((size_t)544 * 128 * 256 * 2 <= (size_t)40 * 1024 * 1024, "ACT overlay");

struct Params {
    const float* in[21];
    const int* pos;
    float* out;
    unsigned char* ws;
    double inv_freq[32];
    int ph_lo, ph_hi;
};

DEVI unsigned f2bf(float f) { unsigned u = __float_as_uint(f); return (u + 0x7fffu + ((u >> 16) & 1u)) >> 16; }
DEVI unsigned pk2(float lo, float hi) { return f2bf(lo) | (f2bf(hi) << 16); }
DEVI float bf2f(unsigned h) { return __uint_as_float(h << 16); }
DEVI float sigmoidf_(float x) { return __builtin_amdgcn_rcpf(1.0f + __builtin_amdgcn_exp2f(-x * 1.4426950408889634f)); }
DEVI float wave_sum(float v) {
#pragma unroll
    for (int o = 32; o > 0; o >>= 1) v += __shfl_xor(v, o);
    return v;
}
DEVI int wave_sum_i32(int v) {
    v += __builtin_amdgcn_update_dpp(0, v, 0xB1, 0xF, 0xF, true);
    v += __builtin_amdgcn_update_dpp(0, v, 0x4E, 0xF, 0xF, true);
    v += __builtin_amdgcn_update_dpp(0, v, 0x141, 0xF, 0xF, true);
    v += __builtin_amdgcn_update_dpp(0, v, 0x140, 0xF, 0xF, true);
    return __builtin_amdgcn_readlane(v, 0) + __builtin_amdgcn_readlane(v, 16) + __builtin_amdgcn_readlane(v, 32) + __builtin_amdgcn_readlane(v, 48);
}
DEVI float wave_sum_f32_dpp(float v) {
    v += __builtin_bit_cast(float, __builtin_amdgcn_update_dpp(0, __builtin_bit_cast(int, v), 0xB1, 0xF, 0xF, true));
    v += __builtin_bit_cast(float, __builtin_amdgcn_update_dpp(0, __builtin_bit_cast(int, v), 0x4E, 0xF, 0xF, true));
    v += __builtin_bit_cast(float, __builtin_amdgcn_update_dpp(0, __builtin_bit_cast(int, v), 0x141, 0xF, 0xF, true));
    v += __builtin_bit_cast(float, __builtin_amdgcn_update_dpp(0, __builtin_bit_cast(int, v), 0x140, 0xF, 0xF, true));
    const int iv = __builtin_bit_cast(int, v);
    return (__builtin_bit_cast(float, __builtin_amdgcn_readlane(iv, 0)) + __builtin_bit_cast(float, __builtin_amdgcn_readlane(iv, 16))) +
           (__builtin_bit_cast(float, __builtin_amdgcn_readlane(iv, 32)) + __builtin_bit_cast(float, __builtin_amdgcn_readlane(iv, 48)));
}
DEVI bf16x8 pack8(const f32x4& a, const f32x4& b) {
    u32x4 w; w.x = pk2(a[0], a[1]); w.y = pk2(a[2], a[3]); w.z = pk2(b[0], b[1]); w.w = pk2(b[2], b[3]);
    return __builtin_bit_cast(bf16x8, w);
}
#define MFMA16(a, b, c) __builtin_amdgcn_mfma_f32_16x16x32_bf16((a), (b), (c), 0, 0, 0)


#define XB_TMO      128
#define XB_XCNT(j)  (256  + 64 * (j))
#define XB_XSUB(j)  (1280 + 64 * (j))
#define XB_XGEN(j)  (2304 + 64 * (j))
#define XB_TOP      3328
#define XB_TOPGEN   3392
#define XCD_BAR_WORDS 3456
#define XB_SPIN_CAP (1u << 22)
DEVI unsigned xb_ld(unsigned* p)              { return __hip_atomic_load(p, __ATOMIC_RELAXED, __HIP_MEMORY_SCOPE_AGENT); }
DEVI unsigned xb_add(unsigned* p, unsigned v) { return __hip_atomic_fetch_add(p, v, __ATOMIC_RELAXED, __HIP_MEMORY_SCOPE_AGENT); }
DEVI unsigned xb_xcc_id() { return (unsigned)__builtin_amdgcn_s_getreg((3 << 11) | 20) & 0xFu; }
#define XB_SPIN(cond, bar) do { unsigned _sp = 0; while (cond) { __builtin_amdgcn_s_sleep(1); \
    if ((++_sp & 255u) == 0u) { if (xb_ld(&(bar)[XB_TMO])) break; if (_sp > XB_SPIN_CAP) { atomicAdd(&(bar)[XB_TMO], 1u); break; } } } } while (0)
struct XcdBarrier { unsigned* bar; unsigned x; volatile LAS unsigned* st; };
DEVI XcdBarrier xcd_barrier_post(unsigned* bar, volatile LAS unsigned* st) {
    XcdBarrier b; b.bar = bar; b.x = xb_xcc_id(); b.st = st;
    if (threadIdx.x == 0) (void)xb_add(&bar[XB_XCNT(b.x)], 1u);
    return b;
}
DEVI void xcd_barrier_complete(unsigned* bar, unsigned x, unsigned& nloc, unsigned& nx) {
    const unsigned G = gridDim.x * gridDim.y * gridDim.z;
    unsigned sum, cnt, mine, sp = 0u;
    for (;;) {
        sum = 0u; cnt = 0u; mine = 0u;
#pragma unroll
        for (unsigned j = 0; j < 16; ++j) { const unsigned c = xb_ld(&bar[XB_XCNT(j)]); sum += c; cnt += (c > 0u) ? 1u : 0u; mine = (j == x) ? c : mine; }
        if (sum == G) break;
        __builtin_amdgcn_s_sleep(1);
        if ((++sp & 255u) == 0u) { if (xb_ld(&bar[XB_TMO])) break; if (sp > XB_SPIN_CAP) { atomicAdd(&bar[XB_TMO], 1u); break; } }
    }
    nloc = mine > 0u ? mine : 1u; nx = cnt > 0u ? cnt : 1u;
}
DEVI void xcd_barrier(const XcdBarrier& b) {
    asm volatile("s_waitcnt vmcnt(0)" ::: "memory");
    __syncthreads();
    if (threadIdx.x == 0) {
        unsigned* bar = b.bar;
        __builtin_amdgcn_s_waitcnt(0);
        unsigned nloc = b.st[0], nx = b.st[1];
        if (nloc == 0u) { xcd_barrier_complete(bar, b.x, nloc, nx); b.st[0] = nloc; b.st[1] = nx; }
        const unsigned old = xb_add(&bar[XB_XSUB(b.x)], 1u);
        const unsigned gen = old / nloc;
        if (old + 1u == (gen + 1u) * nloc) {
            __builtin_amdgcn_fence(__ATOMIC_RELEASE, "agent");
            asm volatile("s_waitcnt vmcnt(0)" ::: "memory");
            const unsigned og = xb_add(&bar[XB_TOP], 1u);
            const unsigned tg = og / nx;
            if (og + 1u == (tg + 1u) * nx) xb_add(&bar[XB_TOPGEN], 1u);
            else XB_SPIN(xb_ld(&bar[XB_TOPGEN]) == tg, bar);
            __builtin_amdgcn_fence(__ATOMIC_ACQUIRE, "agent");
            xb_add(&bar[XB_XGEN(b.x)], 1u);
            asm volatile("s_waitcnt vmcnt(0)" ::: "memory");
        } else {
            XB_SPIN(xb_ld(&bar[XB_XGEN(b.x)]) == gen, bar);
            __builtin_amdgcn_fence(__ATOMIC_ACQUIRE, "agent");
            asm volatile("s_waitcnt vmcnt(0)" ::: "memory");
        }
    }
    __syncthreads();
}

typedef __amdgpu_buffer_rsrc_t rsrc_t;
DEVI u32x4 bload16(rsrc_t r, unsigned voff, unsigned soff) { return __builtin_bit_cast(u32x4, __builtin_amdgcn_raw_buffer_load_b128(r, (int)voff, (int)soff, 0)); }
DEVI void glds16(rsrc_t r, unsigned char* lds_dst_uniform, unsigned voff, unsigned soff) {
    __builtin_amdgcn_raw_ptr_buffer_load_lds(r, (LAS void*)lds_dst_uniform, 16, (int)voff, (int)soff, 0, 0);
}
template <class FA, class FB>
DEVI void gemm128(f32x4 (&acc)[4][4], rsrc_t rs, unsigned sA, const FA& offA, unsigned sB, const FB& offB, int nk, unsigned char* lds, int tid) {
    const int lane = tid & 63, wid = __builtin_amdgcn_readfirstlane(tid >> 6), wr = wid >> 1, wc = wid & 1;
    const int lr = tid >> 3;
    const unsigned csrc = (unsigned)(((lane & 7) ^ ((lane >> 3) & 7)) << 4);
    unsigned oa[4], ob[4];
#pragma unroll
    for (int i = 0; i < 4; ++i) { oa[i] = offA(lr + 32 * i) + csrc; ob[i] = offB(lr + 32 * i) + csrc; }
#pragma unroll
    for (int m = 0; m < 4; ++m)
#pragma unroll
        for (int n = 0; n < 4; ++n) acc[m][n] = (f32x4){0.f, 0.f, 0.f, 0.f};
    const int q = lane >> 4, r16 = lane & 15;
    const int roffA0 = (wr * 64 + r16) * 128 + (((0 + q) ^ (lane & 7)) << 4);
    const int roffA1 = (wr * 64 + r16) * 128 + (((4 + q) ^ (lane & 7)) << 4);
    const int roffB0 = 16384 + (wc * 64 + r16) * 128 + (((0 + q) ^ (lane & 7)) << 4);
    const int roffB1 = 16384 + (wc * 64 + r16) * 128 + (((4 + q) ^ (lane & 7)) << 4);
    unsigned char* wbase = lds + wid * 1024;
#pragma unroll
    for (int i = 0; i < 4; ++i) { glds16(rs, wbase + i * 4096, oa[i], sA); glds16(rs, wbase + 16384 + i * 4096, ob[i], sB); }
    for (int kt = 0; kt < nk; ++kt) {
        unsigned char* cur = lds + (kt & 1) * 32768;
        __syncthreads();
        if (kt + 1 < nk) {
            unsigned char* nb = wbase + ((kt + 1) & 1) * 32768;
#pragma unroll
            for (int i = 0; i < 4; ++i) { glds16(rs, nb + i * 4096, oa[i], sA + (kt + 1) * 128); glds16(rs, nb + 16384 + i * 4096, ob[i], sB + (kt + 1) * 128); }
        }
#pragma unroll
        for (int ks = 0; ks < 2; ++ks) {
            bf16x8 a[4], b[4];
#pragma unroll
            for (int m = 0; m < 4; ++m) a[m] = *(const bf16x8*)(cur + (ks ? roffA1 : roffA0) + m * 2048);
#pragma unroll
            for (int n = 0; n < 4; ++n) b[n] = *(const bf16x8*)(cur + (ks ? roffB1 : roffB0) + n * 2048);
#pragma unroll
            for (int m = 0; m < 4; ++m)
#pragma unroll
                for (int n = 0; n < 4; ++n) acc[m][n] = MFMA16(b[n], a[m], acc[m][n]);
        }
    }
    __syncthreads();
}

DEVI bool tile_map(int k, int ncol, int& mt, int& nt) {
    if (gridDim.x == 512) {
        const int x = blockIdx.x & 7, j = blockIdx.x >> 3;
        const int v = j + 64 * k;
        if (v >= 32 * ncol) return false;
        const int nfull = ncol >> 3, rem = ncol & 7;
        int mtl;
        if (v < nfull * 256) { const int cg = v >> 8, w = v & 255; mtl = (w >> 6) * 8 + ((w & 63) >> 3); nt = cg * 8 + (w & 7); }
        else { const int v2 = v - nfull * 256, per = 8 * rem; const int rg = v2 / per, w = v2 % per; mtl = rg * 8 + w / rem; nt = nfull * 8 + w % rem; }
        mt = x * 32 + mtl;
        return true;
    }
    const int u = blockIdx.x + gridDim.x * k;
    if (u >= 256 * ncol) return false;
    mt = u / ncol; nt = u % ncol;
    return true;
}
struct RowLin { unsigned ldb; DEVI unsigned operator()(int r) const { return (unsigned)r * ldb; } };

DEVI int win_map(int j) {
    if (j < 896) return j;
    if (j < 1408) return j - 896 + 936;
    if (j < 2176) return j - 1408 + 1448;
    if (j < 2208) return j - 2176 + 896;
    if (j < 2216) return j - 2208 + 928;
    if (j < 2240) return j;
    if (j < 2304) return -1;
    return j - 64;
}

struct TJob { const float* src; bf16_t* dst; int K, ld, nrows, perm, nb; size_t sb, db; };
DEVI TJob get_tjob(const Params& P, int j) {
    unsigned char* ws = P.ws;
    switch (j) {
        case 0: return TJob{P.in[3], (bf16_t*)(ws + OFF_WIN_T), 1024, INW, WIN_ROWS, 1, 1, 0, 0};
        case 1: return TJob{P.in[10], (bf16_t*)(ws + OFF_WBRA), 512, 1024, 1024, 0, 1, 0, 0};
        case 2: return TJob{P.in[11], (bf16_t*)(ws + OFF_WBRB), 512, 1024, 1024, 0, 1, 0, 0};
        case 3: return TJob{P.in[12], (bf16_t*)(ws + OFF_WOUT), 1024, 1024, 1024, 0, 1, 0, 0};
        case 4: return TJob{P.in[5], (bf16_t*)(ws + OFF_W1K), 2048, 128, 128, 0, 1, 0, 0};
        case 5: return TJob{P.in[8], (bf16_t*)(ws + OFF_W1V), 2048, 128, 128, 0, 1, 0, 0};
        case 6: return TJob{P.in[6], (bf16_t*)(ws + OFF_W2K), 128, 64, 64, 0, 1, 0, 0};
        case 7: return TJob{P.in[9], (bf16_t*)(ws + OFF_W2V), 128, 64, 64, 0, 1, 0, 0};
        case 8: return TJob{P.in[18], (bf16_t*)(ws + OFF_WGU), 1024, 512, 512, 0, 32, (size_t)1024 * 512, (size_t)512 * 1024};
        default: return TJob{P.in[19], (bf16_t*)(ws + OFF_WDN), 256, 1024, 1024, 0, 32, (size_t)256 * 1024, (size_t)1024 * 256};
    }
}
DEVI int tjob_tiles(int j) {
    switch (j) {
        case 0: return (WIN_ROWS / 64) * 16;
        case 1: case 2: return 16 * 8;
        case 3: return 16 * 16;
        case 4: case 5: return 2 * 32;
        case 6: case 7: return 1 * 2;
        case 8: return 32 * 8 * 16;
        default: return 32 * 16 * 4;
    }
}

DEVI void transpose_tile(const TJob& J, int tile, unsigned char* lds, int tid) {
    float* T = (float*)lds;
    const int kt = J.K / 64, rt = J.nrows / 64;
    const int b = tile / (kt * rt), rem = tile % (kt * rt);
    const int r0 = (rem / kt) * 64, k0 = (rem % kt) * 64;
    const float* src = J.src + (size_t)b * J.sb;
    bf16_t* dst = J.dst + (size_t)b * J.db;
    const int rr = tid & 63;
    int col = r0 + rr; if (J.perm) col = win_map(col);
#pragma unroll
    for (int i = 0; i < 16; ++i) {
        const int kk = i * 4 + (tid >> 6);
        T[kk * 65 + rr] = (col >= 0) ? src[(size_t)(k0 + kk) * J.ld + col] : 0.f;
    }
    __syncthreads();
    const int r2 = tid >> 2, ks = (tid & 3) * 16;
    u32x4 w0, w1;
    w0.x = pk2(T[(ks + 0) * 65 + r2], T[(ks + 1) * 65 + r2]); w0.y = pk2(T[(ks + 2) * 65 + r2], T[(ks + 3) * 65 + r2]);
    w0.z = pk2(T[(ks + 4) * 65 + r2], T[(ks + 5) * 65 + r2]); w0.w = pk2(T[(ks + 6) * 65 + r2], T[(ks + 7) * 65 + r2]);
    w1.x = pk2(T[(ks + 8) * 65 + r2], T[(ks + 9) * 65 + r2]); w1.y = pk2(T[(ks + 10) * 65 + r2], T[(ks + 11) * 65 + r2]);
    w1.z = pk2(T[(ks + 12) * 65 + r2], T[(ks + 13) * 65 + r2]); w1.w = pk2(T[(ks + 14) * 65 + r2], T[(ks + 15) * 65 + r2]);
    bf16_t* d = dst + (size_t)(r0 + r2) * J.K + k0 + ks;
    *(u32x4*)d = w0; *(u32x4*)(d + 8) = w1;
    __syncthreads();
}

DEVI void rms_row_bf16(const float* xr, const float* g, bf16_t* o, int lane) {
    f32x4 v[4]; float ss = 0.f;
#pragma unroll
    for (int i = 0; i < 4; ++i) { v[i] = *(const f32x4*)(xr + i * 256 + lane * 4); ss += v[i][0] * v[i][0] + v[i][1] * v[i][1] + v[i][2] * v[i][2] + v[i][3] * v[i][3]; }
    ss = wave_sum(ss);
    const float rs = rsqrtf(ss * (1.0f / 1024.0f) + RMS_EPS);
#pragma unroll
    for (int i = 0; i < 4; ++i) {
        const f32x4 gg = *(const f32x4*)(g + i * 256 + lane * 4);
        u32x2 w; w.x = pk2(v[i][0] * rs * gg[0], v[i][1] * rs * gg[1]); w.y = pk2(v[i][2] * rs * gg[2], v[i][3] * rs * gg[3]);
        *(u32x2*)(o + i * 256 + lane * 4) = w;
    }
}

DEVI void phase_prep(const Params& P, unsigned char* lds, int tid) {
    unsigned char* ws = P.ws;
    const int lane = tid & 63, wid = __builtin_amdgcn_readfirstlane(tid >> 6);
    if (blockIdx.x == 0) {
        if (tid < 64) ((unsigned*)(ws + OFF_CTL))[tid] = 0u;
        for (int i = tid; i < XCD_BAR_WORDS; i += NTHREADS) ((unsigned*)(ws + OFF_BAR))[i] = 0u;
    }
    int base = 0;
    for (int j = 0; j < 10; ++j) {
        const int nt = tjob_tiles(j);
        const TJob J = get_tjob(P, j);
        for (int t = blockIdx.x; t < nt; t += gridDim.x) transpose_tile(J, t, lds, tid);
        base += nt;
    }
    {
        const float* x = P.in[0]; const float* g = P.in[2]; bf16_t* hn = (bf16_t*)(ws + OFF_HN);
        for (int r = blockIdx.x * 4 + wid; r < NTOK; r += gridDim.x * 4) rms_row_bf16(x + (size_t)r * 1024, g, hn + (size_t)r * 1024, lane);
    }
    {
        f32x2* cs = (f32x2*)(ws + OFF_CS);
        for (int e = blockIdx.x * NTHREADS + tid; e < NTOK * 32; e += gridDim.x * NTHREADS) {
            const int tok = e >> 5, i = e & 31;
            const double a = (double)P.pos[tok] * P.inv_freq[i];
            double t = a * 0.15915494309189535;
            t -= floor(t);
            const float tf = (float)t;
            cs[e] = (f32x2){__builtin_amdgcn_cosf(tf), __builtin_amdgcn_sinf(tf)};
        }
    }
    {
        float* wr = (float*)(ws + OFF_WR);
        const float* g = P.in[13]; const float* wg = P.in[14]; const float* we = P.in[16];
        for (int e = blockIdx.x * NTHREADS + tid; e < 48 * 1024; e += gridDim.x * NTHREADS) {
            const int c = e >> 10, k = e & 1023;
            float v = 0.f;
            if (c < 4) v = wg[k * 4 + c]; else if (c < 36) v = we[k * 32 + (c - 4)];
            wr[e] = v * g[k];
        }
    }
    {
        float* red = (float*)lds;
        for (int job = blockIdx.x; job < 32; job += gridDim.x) {
            const int kv = job >> 4, cg8 = job & 15;
            const float* pe = P.in[kv ? 7 : 4]; const float* w1 = P.in[kv ? 8 : 5];
            const int cc = tid & 7, jj = tid >> 3;
            float s = 0.f;
            for (int j = jj; j < 2048; j += 32) s += pe[j] * w1[(size_t)j * 128 + cg8 * 8 + cc];
            red[tid] = s;
            __syncthreads();
            if (tid < 8) { float t = 0.f; for (int u = 0; u < 32; ++u) t += red[u * 8 + tid]; ((float*)(ws + OFF_BIAS1))[kv * 128 + cg8 * 8 + tid] = t; }
            __syncthreads();
        }
    }
}

DEVI void st_bf16(bf16_t* p, float v) { *p = (bf16_t)f2bf(v); }

DEVI void phase_gemm1(const Params& P, unsigned char* lds, int tid) {
    unsigned char* ws = P.ws;
    const rsrc_t rs = __builtin_amdgcn_make_buffer_rsrc((void*)P.ws, (short)0, (int)0x7fffffff, 0x00020000);
    const bf16_t* hn = (const bf16_t*)(ws + OFF_HN);
    const bf16_t* wt = (const bf16_t*)(ws + OFF_WIN_T);
    const f32x2* cs = (const f32x2*)(ws + OFF_CS);
    const int lane = tid & 63, wid = __builtin_amdgcn_readfirstlane(tid >> 6), wr = wid >> 1, wc = wid & 1, q = lane >> 4, cl = lane & 15;
    constexpr int NT_N = G1_COLS / 128;
    for (int kk = 0;; ++kk) {
        int mt, nt;
        if (!tile_map(kk, NT_N, mt, nt)) break;
        f32x4 acc[4][4];
        gemm128(acc, rs, (unsigned)(OFF_HN + (size_t)mt * 128 * 2048), RowLin{2048}, (unsigned)(OFF_WIN_T + (size_t)nt * 128 * 2048), RowLin{2048}, 16, lds, tid);
        const int c64 = nt * 2 + wc;
        const int tok0 = mt * 128 + wr * 64 + cl;
        if (c64 < 10 || (c64 >= 14 && c64 < 34)) {
            bool do_rope; float scale = 1.f; int kind;
            int g = 0, hk = 0;
            if (c64 < 8) { kind = 0; do_rope = true; scale = 0.125f; }
            else if (c64 == 8) { kind = 1; do_rope = true; }
            else if (c64 == 9) { kind = 2; do_rope = false; }
            else if (c64 < 22) { kind = 3; do_rope = true; scale = 0.125f; }
            else { kind = 4; g = (c64 - 22) >> 1; hk = (c64 - 22) & 1; do_rope = (g == 2 || g == 4); }
#pragma unroll
            for (int m = 0; m < 4; ++m) {
                const int tok = tok0 + m * 16;
                f32x4 o[4], nr[4];
#pragma unroll
                for (int n = 0; n < 4; ++n) { nr[n] = acc[m][n] * scale; o[n] = nr[n]; }
                if (do_rope) {
#pragma unroll
                    for (int n = 0; n < 2; ++n) {
                        const f32x4 c01 = *(const f32x4*)(cs + (size_t)tok * 32 + n * 16 + q * 4);
                        const f32x4 c23 = *(const f32x4*)(cs + (size_t)tok * 32 + n * 16 + q * 4 + 2);
                        const float cc[4] = {c01[0], c01[2], c23[0], c23[2]}, sn[4] = {c01[1], c01[3], c23[1], c23[3]};
#pragma unroll
                        for (int j = 0; j < 4; ++j) {
                            const float x1 = nr[n][j], x2 = nr[n + 2][j];
                            o[n][j] = x1 * cc[j] - x2 * sn[j]; o[n + 2][j] = x1 * sn[j] + x2 * cc[j];
                        }
                    }
                }
                if (kind == 0 || kind == 1 || kind == 2) {
                    bf16_t* d = (kind == 0) ? (bf16_t*)(ws + OFF_QA) + (size_t)tok * 512 + c64 * 64 : (bf16_t*)(ws + (kind == 1 ? OFF_KA : OFF_VA)) + (size_t)tok * 64;
#pragma unroll
                    for (int n = 0; n < 4; ++n) { u32x2 w; w.x = pk2(o[n][0], o[n][1]); w.y = pk2(o[n][2], o[n][3]); *(u32x2*)(d + n * 16 + q * 4) = w; }
                } else if (kind == 3) {
                    const int h = c64 - 14;
                    bf16_t* dn = (bf16_t*)(ws + OFF_QBN) + (size_t)tok * 512 + h * 64; bf16_t* dr = (bf16_t*)(ws + OFF_QBR) + (size_t)tok * 512 + h * 64;
#pragma unroll
                    for (int n = 0; n < 4; ++n) {
                        u32x2 w; w.x = pk2(nr[n][0], nr[n][1]); w.y = pk2(nr[n][2], nr[n][3]); *(u32x2*)(dn + n * 16 + q * 4) = w;
                        u32x2 v; v.x = pk2(o[n][0], o[n][1]); v.y = pk2(o[n][2], o[n][3]); *(u32x2*)(dr + n * 16 + q * 4) = v;
                    }
                } else {
                    bf16_t* d = (bf16_t*)(ws + OFF_KV + (size_t)g * KV_STRIDE);
                    const int b = tok >> 12, tl = tok & 4095;
                    if (g == 3 || g == 5) {
#pragma unroll
                        for (int n = 0; n < 4; ++n)
#pragma unroll
                            for (int j = 0; j < 4; ++j) st_bf16(d + ((size_t)((b * 2 + hk) * 64 + n * 16 + q * 4 + j)) * 4096 + tl, o[n][j]);
                    } else {
#pragma unroll
                        for (int n = 0; n < 4; ++n) { u32x2 w; w.x = pk2(o[n][0], o[n][1]); w.y = pk2(o[n][2], o[n][3]);
                            *(u32x2*)(d + ((size_t)((b * 2 + hk) * 4096 + tl)) * 64 + n * 16 + q * 4) = w; }
                    }
                }
            }
        } else if (c64 >= 10 && c64 < 14) {
            bf16_t* d = (bf16_t*)(ws + OFF_QI);
#pragma unroll
            for (int m = 0; m < 4; ++m) {
                const int tok = tok0 + m * 16;
                float cc[4], sn[4];
#pragma unroll
                for (int j = 0; j < 4; ++j) { const f32x2 c = cs[(size_t)tok * 32 + 2 * (4 * q + j)]; cc[j] = c.x; sn[j] = c.y; }
#pragma unroll
                for (int hh = 0; hh < 2; ++hh) {
                    const int head = 2 * (c64 - 10) + hh;
                    f32x4 r1, r2;
#pragma unroll
                    for (int j = 0; j < 4; ++j) { const float x1 = acc[m][2 * hh][j], x2 = acc[m][2 * hh + 1][j]; r1[j] = x1 * cc[j] - x2 * sn[j]; r2[j] = x1 * sn[j] + x2 * cc[j]; }
                    u32x2 w; w.x = pk2(r1[0], r1[1]); w.y = pk2(r1[2], r1[3]); *(u32x2*)(d + (size_t)tok * 256 + head * 32 + q * 4) = w;
                    u32x2 v; v.x = pk2(r2[0], r2[1]); v.y = pk2(r2[2], r2[3]); *(u32x2*)(d + (size_t)tok * 256 + head * 32 + 16 + q * 4) = v;
                }
            }
        } else if (c64 >= 36) {
            bf16_t* d = (bf16_t*)(ws + (c64 < 52 ? OFF_GA : OFF_GB));
            const int cb = (c64 < 52 ? c64 - 36 : c64 - 52) * 64;
#pragma unroll
            for (int m = 0; m < 4; ++m)
#pragma unroll
                for (int n = 0; n < 4; ++n) {
                    u32x2 w; w.x = pk2(sigmoidf_(acc[m][n][0]), sigmoidf_(acc[m][n][1])); w.y = pk2(sigmoidf_(acc[m][n][2]), sigmoidf_(acc[m][n][3]));
                    *(u32x2*)(d + (size_t)(tok0 + m * 16) * 1024 + cb + n * 16 + q * 4) = w;
                }
        } else if (c64 == 34) {
            bf16_t* dki = (bf16_t*)(ws + OFF_KI); float* dwi = (float*)(ws + OFF_WI); float* dg = (float*)(ws + OFF_GATES);
#pragma unroll
            for (int m = 0; m < 4; ++m) {
                const int tok = tok0 + m * 16;
                f32x4 r1, r2;
#pragma unroll
                for (int j = 0; j < 4; ++j) {
                    const f32x2 c = cs[(size_t)tok * 32 + 2 * (4 * q + j)];
                    const float x1 = acc[m][0][j], x2 = acc[m][1][j];
                    r1[j] = x1 * c.x - x2 * c.y; r2[j] = x1 * c.y + x2 * c.x;
                }
                u32x2 w; w.x = pk2(r1[0], r1[1]); w.y = pk2(r1[2], r1[3]); *(u32x2*)(dki + (size_t)tok * 32 + q * 4) = w;
                u32x2 v; v.x = pk2(r2[0], r2[1]); v.y = pk2(r2[2], r2[3]); *(u32x2*)(dki + (size_t)tok * 32 + 16 + q * 4) = v;
                if (q < 2) *(f32x4*)(dwi + (size_t)tok * 8 + q * 4) = acc[m][2];
                else { f32x4 sv; for (int j = 0; j < 4; ++j) sv[j] = sigmoidf_(acc[m][2][j]); *(f32x4*)(dg + (size_t)tok * 24 + (q * 4 - 8)) = sv; }
                { f32x4 sv; for (int j = 0; j < 4; ++j) sv[j] = sigmoidf_(acc[m][3][j]); *(f32x4*)(dg + (size_t)tok * 24 + 8 + q * 4) = sv; }
            }
        }
    }
}

DEVI float siluf_(float x) { return x * __builtin_amdgcn_rcpf(1.0f + __builtin_amdgcn_exp2f(-x * 1.4426950408889634f)); }

DEVI void phase_compress(const Params& P, unsigned char* lds, int tid) {
    unsigned char* ws = P.ws;
    const rsrc_t rs = __builtin_amdgcn_make_buffer_rsrc((void*)P.ws, (short)0, (int)0x7fffffff, 0x00020000);
    const int lane = tid & 63, wid = __builtin_amdgcn_readfirstlane(tid >> 6), wr = wid >> 1, wc = wid & 1, q = lane >> 4, cl = lane & 15;
    for (int u = blockIdx.x; u < 64; u += gridDim.x) {
        const int kv = u >> 5, mt = u & 31;
        const bf16_t* A = (const bf16_t*)(ws + OFF_KV + (size_t)kv * KV_STRIDE) + (size_t)mt * 128 * 1024;
        const bf16_t* W1 = (const bf16_t*)(ws + (kv ? OFF_W1V : OFF_W1K));
        const bf16_t* W2 = (const bf16_t*)(ws + (kv ? OFF_W2V : OFF_W2K));
        const float* bias = (const float*)(ws + OFF_BIAS1) + kv * 128;
        f32x4 acc[4][4];
        gemm128(acc, rs, (unsigned)(OFF_KV + (size_t)kv * KV_STRIDE + (size_t)mt * 128 * 2048), RowLin{2048}, (unsigned)(kv ? OFF_W1V : OFF_W1K), RowLin{4096}, 32, lds, tid);
#pragma unroll
        for (int m = 0; m < 4; ++m)
#pragma unroll
            for (int n = 0; n < 4; ++n) {
                const int col = wc * 64 + n * 16 + q * 4, row = wr * 64 + m * 16 + cl;
                const f32x4 bb = *(const f32x4*)(bias + col);
                const int ktile = col >> 6, ch = (col & 63) >> 3, wi = col & 7;
                u32x2 w; w.x = pk2(siluf_(acc[m][n][0] + bb[0]), siluf_(acc[m][n][1] + bb[1])); w.y = pk2(siluf_(acc[m][n][2] + bb[2]), siluf_(acc[m][n][3] + bb[3]));
                *(u32x2*)(lds + ktile * 16384 + row * 128 + ((ch ^ (row & 7)) << 4) + wi * 2) = w;
            }
#pragma unroll
        for (int i = 0; i < 4; ++i) {
            const int idx = tid + 256 * i;
            const int row = idx >> 4, ch16 = idx & 15, ktile = ch16 >> 3, ch = ch16 & 7;
            *(u32x4*)(lds + 32768 + ktile * 8192 + row * 128 + ((ch ^ (row & 7)) << 4)) = *(const u32x4*)(W2 + (size_t)row * 128 + ch16 * 8);
        }
        __syncthreads();
        f32x4 a2[4][2];
#pragma unroll
        for (int m = 0; m < 4; ++m) { a2[m][0] = (f32x4){0.f, 0.f, 0.f, 0.f}; a2[m][1] = (f32x4){0.f, 0.f, 0.f, 0.f}; }
#pragma unroll
        for (int kk = 0; kk < 4; ++kk) {
            const int ktile = kk >> 1, ks = kk & 1;
            bf16x8 a[4], b[2];
#pragma unroll
            for (int m = 0; m < 4; ++m) { const int row = wr * 64 + m * 16 + cl; a[m] = *(const bf16x8*)(lds + ktile * 16384 + row * 128 + (((ks * 4 + q) ^ (row & 7)) << 4)); }
#pragma unroll
            for (int n = 0; n < 2; ++n) { const int row = wc * 32 + n * 16 + cl; b[n] = *(const bf16x8*)(lds + 32768 + ktile * 8192 + row * 128 + (((ks * 4 + q) ^ (row & 7)) << 4)); }
#pragma unroll
            for (int m = 0; m < 4; ++m)
#pragma unroll
                for (int n = 0; n < 2; ++n) a2[m][n] = MFMA16(b[n], a[m], a2[m][n]);
        }
#pragma unroll
        for (int m = 0; m < 4; ++m)
#pragma unroll
            for (int n = 0; n < 2; ++n) {
                const int d = wc * 32 + n * 16 + q * 4;
                const int r = mt * 128 + wr * 64 + m * 16 + cl;
                const bool dead = ((r & 255) == 255);
                float v[4];
#pragma unroll
                for (int j = 0; j < 4; ++j) v[j] = dead ? 0.f : a2[m][n][j];
                if (kv == 0) {
                    bf16_t* kc = (bf16_t*)(ws + OFF_KC);
                    u32x2 w; w.x = pk2(v[0], v[1]); w.y = pk2(v[2], v[3]);
                    *(u32x2*)(kc + (size_t)r * 64 + d) = w;
                } else {
                    bf16_t* vct = (bf16_t*)(ws + OFF_VCT);
#pragma unroll
                    for (int j = 0; j < 4; ++j) st_bf16(vct + ((size_t)((r >> 8) * 64 + d + j)) * 256 + (r & 255), v[j]);
                }
            }
        __syncthreads();
    }
}

DEVI void phase_index(const Params& P, unsigned char* lds, int tid) {
    unsigned char* ws = P.ws;
    const bf16_t* QI = (const bf16_t*)(ws + OFF_QI);
    const bf16_t* KI = (const bf16_t*)(ws + OFF_KI);
    const float* WI = (const float*)(ws + OFF_WI);
    bf16_t* SEL = (bf16_t*)(ws + OFF_SEL);
    float* S = (float*)lds;
    const int lane = tid & 63, wid = __builtin_amdgcn_readfirstlane(tid >> 6), q = lane >> 4, cl = lane & 15;
    for (int u = blockIdx.x; u < NTOK / 4; u += gridDim.x) {
        const int b = u >> 10, w10 = u & 1023, s10 = (w10 < 512) ? w10 : 1535 - w10;
        const int t0 = s10 * 4, tok0 = b * 4096 + t0;
        const int t = t0 + wid;
        const int tok = tok0 + wid;
        if (t0 + 3 < 256) {
            for (int i = lane; i < 256; i += 64) SEL[(size_t)tok * 256 + i] = (bf16_t)(i <= t ? i : 0);
            continue;
        }
        {
            bf16x8 a[2];
#pragma unroll
            for (int hg = 0; hg < 2; ++hg) a[hg] = *(const bf16x8*)(QI + (size_t)(tok0 + (cl >> 2)) * 256 + (4 * hg + (cl & 3)) * 32 + q * 8);
            const f32x4 w0 = *(const f32x4*)(WI + (size_t)(tok0 + q) * 8), w1 = *(const f32x4*)(WI + (size_t)(tok0 + q) * 8 + 4);
            const int ktmax = (t0 + 3) >> 4;
            const bf16_t* kb = KI + (size_t)b * 4096 * 32 + cl * 32 + q * 8;
            for (int rep31 = 0; rep31 < REPS(31); ++rep31)
            for (int kt0 = wid; kt0 <= ktmax; kt0 += 16) {
                bf16x8 bk[4];
#pragma unroll
                for (int uu = 0; uu < 4; ++uu) { const int kt = (kt0 + 4 * uu <= ktmax) ? kt0 + 4 * uu : kt0; bk[uu] = *(const bf16x8*)(kb + (size_t)kt * 16 * 32); }
#pragma unroll
                for (int uu = 0; uu < 4; ++uu) {
                    const int kt = kt0 + 4 * uu;
                    f32x4 c0 = {0.f, 0.f, 0.f, 0.f}, c1 = {0.f, 0.f, 0.f, 0.f};
                    c0 = MFMA16(a[0], bk[uu], c0); c1 = MFMA16(a[1], bk[uu], c1);
                    float sc = 0.f;
#pragma unroll
                    for (int j = 0; j < 4; ++j) { sc += w0[j] * fmaxf(c0[j], 0.f); sc += w1[j] * fmaxf(c1[j], 0.f); }
                    if (kt <= ktmax) S[q * 4096 + kt * 16 + cl] = sc;
                }
            }
        }
        __syncthreads();
        {
            const int n = t + 1;
            const float* Sq = S + wid * 4096;
            if (n <= 256) {
                for (int i = lane; i < 256; i += 64) SEL[(size_t)tok * 256 + i] = (bf16_t)(i <= t ? i : 0);
            } else {
                const int nr = (n + 63) >> 6;
                float x[64];
                const float NINF = -__builtin_inff();
                float mx = NINF, mn = __builtin_inff();
#pragma unroll
                for (int r = 0; r < 64; ++r) {
                    const int key = r * 64 + lane;
                    const float v = Sq[key];
                    x[r] = (key < n) ? v : NINF;
                    mn = fminf(mn, (key < n) ? v : __builtin_inff());
                    mx = fmaxf(mx, x[r]);
                }
#pragma unroll
                for (int o = 32; o > 0; o >>= 1) { mx = fmaxf(mx, __shfl_xor(mx, o)); mn = fminf(mn, __shfl_xor(mn, o)); }
                float lo = mn, hi = mx, T; int need;
                int chi, clo = n;
                for (int rep32 = 0; rep32 < REPS(32); ++rep32) {
                lo = mn; hi = mx; clo = n;
                {
                    int c = 0;
#pragma unroll
                    for (int g8 = 0; g8 < 8; ++g8) if (g8 * 8 < nr) {
#pragma unroll
                        for (int r = g8 * 8; r < g8 * 8 + 8; ++r) c += (x[r] >= hi) ? 1 : 0;
                    }
                    chi = wave_sum_i32(c);
                }
                if (chi >= 256) { T = hi; need = 256;   }
                else {
                    float s1 = 0.f, s2 = 0.f;
#pragma unroll
                    for (int g8 = 0; g8 < 8; ++g8) if (g8 * 8 < nr) {
#pragma unroll
                        for (int r = g8 * 8; r < g8 * 8 + 8; ++r) { const float v = (x[r] == NINF) ? 0.f : x[r]; s1 += v; s2 += v * v; }
                    }
                    s1 = wave_sum_f32_dpp(s1); s2 = wave_sum_f32_dpp(s2);
                    const float fn = (float)n, mu = s1 / fn;
                    const float sg = sqrtf(fmaxf(s2 / fn - mu * mu, 1e-20f));
                    float vg;
                    {
                        const float pq = 256.0f / fn, pp = fminf(pq, 1.0f - pq);
                        const float tt = sqrtf(-2.0f * __logf(fmaxf(pp, 1e-6f)));
                        const float zz = tt - (2.515517f + 0.802853f * tt + 0.010328f * tt * tt) / (1.0f + 1.432788f * tt + 0.189269f * tt * tt + 0.001308f * tt * tt * tt);
                        vg = mu + ((pq <= 0.5f) ? zz : -zz) * sg;
                    }
                    bool found = false, adjacent = false; float thr = 0.f;
                    for (int it = 0; it < 160; ++it) {
                        if (clo - chi <= 64) break;
                        const float mid = 0.5f * lo + 0.5f * hi;
                        if (!(mid > lo && mid < hi)) { adjacent = true; break; }
                        float v = vg;
                        if (!(v > lo && v < hi) || (it & 3) == 3) v = mid;
                        int c = 0;
#pragma unroll
                        for (int g8 = 0; g8 < 8; ++g8) if (g8 * 8 < nr) {
#pragma unroll
                            for (int r = g8 * 8; r < g8 * 8 + 8; ++r) c += (x[r] >= v) ? 1 : 0;
                        }
                        c = wave_sum_i32(c);
                        if (c == 256) { found = true; thr = v; break; }
                        if (c > 256) { lo = v; clo = c; } else { hi = v; chi = c; }
                        const float zv = (v - mu) / sg;
                        const float dens = fmaxf(fn * 0.39894228f * __expf(-0.5f * zv * zv), 0.5f) / sg;
                        vg = v + ((float)c - ((c > 256) ? 244.0f : 268.0f)) / dens;
                    }
                    if (found) { T = thr; need = -1; }
                    else if (adjacent) { T = lo; need = 256 - chi; }
                    else {
                        float* cand = (float*)(lds + 65536) + wid * 64;
                        cand[lane] = NINF;
                        int cb = 0;
                        const unsigned long long ltm = (1ull << lane) - 1ull;
#pragma unroll
                        for (int g8 = 0; g8 < 8; ++g8) if (g8 * 8 < nr) {
#pragma unroll
                            for (int r = g8 * 8; r < g8 * 8 + 8; ++r) {
                                const bool isc = (x[r] >= lo) && (x[r] < hi);
                                const unsigned long long bm = __ballot(isc);
                                if (isc) cand[cb + __popcll(bm & ltm)] = x[r];
                                cb += __popcll(bm);
                            }
                        }
                        const float y = cand[lane];
                        int cgt = 0, cge = 0;
#pragma unroll
                        for (int k = 0; k < 64; ++k) { const float yk = __builtin_bit_cast(float, __builtin_amdgcn_readlane(__builtin_bit_cast(int, y), k)); cgt += (yk > y) ? 1 : 0; cge += (yk >= y) ? 1 : 0; }
                        const int nd = 256 - chi;
                        const bool isT = (y != NINF) && (cgt <= nd - 1) && (cge >= nd);
                        const unsigned long long tm = __ballot(isT);
                        const int tl = (tm != 0ull) ? (int)__builtin_ctzll(tm) : 0;
                        T = __shfl(y, tl);
                        need = nd - __shfl(cgt, tl);
                    }
                }
                asm volatile("" : "+v"(mn), "+v"(mx));
                }
                for (int rep33 = 0; rep33 < REPS(33); ++rep33) {
                int base = 0, eqc = 0;
                const unsigned long long lt = (1ull << lane) - 1ull;
#pragma unroll
                for (int g8 = 0; g8 < 8; ++g8) if (g8 * 8 < nr) {
#pragma unroll
                    for (int r = g8 * 8; r < g8 * 8 + 8; ++r) {
                        bool sel;
                        if (need < 0) sel = x[r] >= T;
                        else {
                            const bool eq = (x[r] == T);
                            const unsigned long long em = __ballot(eq);
                            sel = (x[r] > T) || (eq && (eqc + __popcll(em & lt) < need));
                            eqc += __popcll(em);
                        }
                        const unsigned long long sm = __ballot(sel);
                        if (sel) { const int pp = base + __popcll(sm & lt); if (pp < 256) SEL[(size_t)tok * 256 + pp] = (bf16_t)(r * 64 + lane); }
                        base += __popcll(sm);
                    }
                }
                }
            }
        }
        __syncthreads();
    }
}

DEVI void phase_dsa(const Params& P, unsigned char* lds, int tid) {
    unsigned char* ws = P.ws;
    const bf16_t* QA = (const bf16_t*)(ws + OFF_QA);
    const bf16_t* KA = (const bf16_t*)(ws + OFF_KA);
    const bf16_t* VA = (const bf16_t*)(ws + OFF_VA);
    const bf16_t* SEL = (const bf16_t*)(ws + OFF_SEL);
    bf16_t* OA = (bf16_t*)(ws + OFF_OA);
    const int lane = tid & 63, wid = __builtin_amdgcn_readfirstlane(tid >> 6), q = lane >> 4, cl = lane & 15;
    unsigned char* vl = lds + wid * 8192;
    const float NINF = -__builtin_inff();
    for (int tok = blockIdx.x * 4 + wid; tok < NTOK; tok += gridDim.x * 4) {
        const int b = tok >> 12, t = tok & 4095;
        const int cnt = (t + 1 < 256) ? t + 1 : 256;
        const int nc64 = (cnt + 63) >> 6;
        const bf16_t* sel = SEL + (size_t)tok * 256;
        const bf16_t* kb = KA + (size_t)b * 4096 * 64;
        const bf16_t* vb = VA + (size_t)b * 4096 * 64;
        bf16x8 bq[2];
#pragma unroll
        for (int ks = 0; ks < 2; ++ks) {
            bq[ks] = (bf16x8){0, 0, 0, 0, 0, 0, 0, 0};
            if (cl < 8) bq[ks] = *(const bf16x8*)(QA + (size_t)tok * 512 + cl * 64 + ks * 32 + q * 8);
        }
        f32x4 s[16];
#pragma unroll
        for (int rf = 0; rf < 16; ++rf) {
            s[rf] = (f32x4){0.f, 0.f, 0.f, 0.f};
            if ((rf >> 2) < nc64) {
                const int p = 32 * (rf >> 1) + 8 * (cl >> 2) + 4 * (rf & 1) + (cl & 3);
                const int key = sel[p];
                const bf16_t* kr = kb + (size_t)key * 64 + q * 8;
                const bf16x8 a0 = *(const bf16x8*)(kr), a1 = *(const bf16x8*)(kr + 32);
                s[rf] = MFMA16(a0, bq[0], s[rf]); s[rf] = MFMA16(a1, bq[1], s[rf]);
            }
        }
        float mx = NINF;
#pragma unroll
        for (int rf = 0; rf < 16; ++rf)
#pragma unroll
            for (int j = 0; j < 4; ++j) {
                const int p = 32 * (rf >> 1) + 8 * q + 4 * (rf & 1) + j;
                if (p >= cnt) s[rf][j] = NINF;
                mx = fmaxf(mx, s[rf][j]);
            }
        mx = fmaxf(mx, __shfl_xor(mx, 16)); mx = fmaxf(mx, __shfl_xor(mx, 32));
        float ls = 0.f;
#pragma unroll
        for (int rf = 0; rf < 16; ++rf)
#pragma unroll
            for (int j = 0; j < 4; ++j) { const float pv = __builtin_amdgcn_exp2f((s[rf][j] - mx) * LOG2E); s[rf][j] = pv; ls += pv; }
        ls += __shfl_xor(ls, 16); ls += __shfl_xor(ls, 32);
        const float inv = 1.0f / ls;
        f32x4 o[4];
#pragma unroll
        for (int d = 0; d < 4; ++d) o[d] = (f32x4){0.f, 0.f, 0.f, 0.f};
#pragma unroll
        for (int cc = 0; cc < 4; ++cc) {
            if (cc < nc64) {
                const int mykey = sel[cc * 64 + lane];
                __builtin_amdgcn_wave_barrier();
#pragma unroll
                for (int i = 0; i < 8; ++i) {
                    const int row = (lane >> 3) + 8 * i;
                    const int key = __shfl(mykey, row);
                    *(u32x4*)(vl + row * 128 + (lane & 7) * 16) = *(const u32x4*)(vb + (size_t)key * 64 + (lane & 7) * 8);
                }
                __builtin_amdgcn_wave_barrier();
#pragma unroll
                for (int c2 = 0; c2 < 2; ++c2) {
                    const bf16x8 pb = pack8(s[cc * 4 + c2 * 2], s[cc * 4 + c2 * 2 + 1]);
#pragma unroll
                    for (int d = 0; d < 4; ++d) {
                        LAS unsigned char* a0addr = (LAS unsigned char*)(vl) + (c2 * 32 + 8 * q + (cl >> 2)) * 128 + (d * 16 + 4 * (cl & 3)) * 2;
                        const s16x4 lo4 = __builtin_amdgcn_ds_read_tr16_b64_v4i16((LAS s16x4*)(a0addr));
                        const s16x4 hi4 = __builtin_amdgcn_ds_read_tr16_b64_v4i16((LAS s16x4*)(a0addr + 4 * 128));
                        const bf16x8 av = {lo4[0], lo4[1], lo4[2], lo4[3], hi4[0], hi4[1], hi4[2], hi4[3]};
                        o[d] = MFMA16(av, pb, o[d]);
                    }
                }
            }
        }
        if (cl < 8) {
#pragma unroll
            for (int d = 0; d < 4; ++d) {
                u32x2 w; w.x = pk2(o[d][0] * inv, o[d][1] * inv); w.y = pk2(o[d][2] * inv, o[d][3] * inv);
                *(u32x2*)(OA + (size_t)tok * 512 + cl * 64 + d * 16 + q * 4) = w;
            }
        }
    }
}

DEVI int fK(int row) { return (row & 3) | (((row >> 3) & 1) << 2); }

struct AttnState { f32x4 O[4][4]; float m[4]; float l[4]; };

template <int MODE>
DEVI void attn_blocks(rsrc_t rs, unsigned sK, unsigned sV, int ldv, int jb0, int jb1, const bf16x8 (&qf)[4][2], AttnState& st,
                      int tq, unsigned long long selmask, unsigned char* lds, int tid) {
    const int lane = tid & 63, q = lane >> 4, cl = lane & 15;
    const float NINF = -__builtin_inff();
#pragma unroll
    for (int cf = 0; cf < 4; ++cf) { st.m[cf] = NINF; st.l[cf] = 0.f;
#pragma unroll
        for (int d = 0; d < 4; ++d) st.O[d][cf] = (f32x4){0.f, 0.f, 0.f, 0.f}; }
    if (jb1 < jb0) return;
    unsigned kro[2], vro[2]; int kwo[2], vwo[2];
#pragma unroll
    for (int i = 0; i < 2; ++i) {
        const int idx = tid + 256 * i, row = idx >> 3, ch = idx & 7;
        kro[i] = (unsigned)(row * 64 + ch * 8) * 2u; kwo[i] = row * 128 + ((ch ^ fK(row)) << 4);
        vro[i] = (unsigned)(row * ldv + ch * 8) * 2u; vwo[i] = 8192 + row * 128 + ((ch ^ (row & 7)) << 4);
    }
    u32x4 rk[2], rv[2];
#pragma unroll
    for (int i = 0; i < 2; ++i) { rk[i] = bload16(rs, kro[i], sK + (unsigned)jb0 * 8192u); rv[i] = bload16(rs, vro[i], sV + (unsigned)jb0 * 128u); }
#pragma unroll
    for (int i = 0; i < 2; ++i) { *(u32x4*)(lds + kwo[i]) = rk[i]; *(u32x4*)(lds + vwo[i]) = rv[i]; }
    __syncthreads();
    const int nmax = (tq >= 31) ? ((tq - 31) >> 4) : -1;
    for (int jb = jb0; jb <= jb1; ++jb) {
        unsigned char* cur = lds + ((jb - jb0) & 1) * 16384;
        unsigned char* nxt = lds + ((jb - jb0 + 1) & 1) * 16384;
        const bool more = jb < jb1;
        if (more) {
#pragma unroll
            for (int i = 0; i < 2; ++i) { rk[i] = bload16(rs, kro[i], sK + (unsigned)(jb + 1) * 8192u); rv[i] = bload16(rs, vro[i], sV + (unsigned)(jb + 1) * 128u); }
        }
        bool lane_on = true;
        if (MODE == 1) lane_on = ((selmask >> jb) & 1ull) != 0ull;
        if (MODE == 0) lane_on = (jb * 64 <= nmax);
        if (MODE == 2) lane_on = (jb * 64 + 63 > tq - 512);
        if (__ballot(lane_on) != 0ull) {
#pragma unroll
            for (int c = 0; c < 2; ++c) {
                f32x4 S[2][4];
#pragma unroll
                for (int r2 = 0; r2 < 2; ++r2)
#pragma unroll
                    for (int cf = 0; cf < 4; ++cf) S[r2][cf] = (f32x4){0.f, 0.f, 0.f, 0.f};
#pragma unroll
                for (int r2 = 0; r2 < 2; ++r2) {
                    const int kl = 32 * c + 8 * (cl >> 2) + 4 * r2 + (cl & 3);
#pragma unroll
                    for (int ks = 0; ks < 2; ++ks) {
                        const bf16x8 a = *(const bf16x8*)(cur + kl * 128 + (((ks * 4 + q) ^ (cl & 7)) << 4));
#pragma unroll
                        for (int cf = 0; cf < 4; ++cf) S[r2][cf] = MFMA16(a, qf[cf][ks], S[r2][cf]);
                    }
                }
                bf16x8 pb[4];
#pragma unroll
                for (int cf = 0; cf < 4; ++cf) {
                    float bm = NINF;
#pragma unroll
                    for (int r2 = 0; r2 < 2; ++r2)
#pragma unroll
                        for (int j = 0; j < 4; ++j) {
                            const int key = jb * 64 + 32 * c + 8 * q + 4 * r2 + j;
                            bool v;
                            if (MODE == 0) v = key <= nmax;
                            else if (MODE == 1) v = lane_on && key <= tq;
                            else v = key <= tq && key > tq - 512;
                            if (!v) S[r2][cf][j] = NINF;
                            bm = fmaxf(bm, S[r2][cf][j]);
                        }
                    bm = fmaxf(bm, __shfl_xor(bm, 16)); bm = fmaxf(bm, __shfl_xor(bm, 32));
                    const float mnew = fmaxf(st.m[cf], bm);
                    const float mref = (mnew == NINF) ? 0.f : mnew;
                    const float alpha = __builtin_amdgcn_exp2f((st.m[cf] - mref) * LOG2E);
                    st.m[cf] = mnew;
                    float ps = 0.f;
#pragma unroll
                    for (int r2 = 0; r2 < 2; ++r2)
#pragma unroll
                        for (int j = 0; j < 4; ++j) { const float pv = __builtin_amdgcn_exp2f((S[r2][cf][j] - mref) * LOG2E); S[r2][cf][j] = pv; ps += pv; }
                    st.l[cf] = st.l[cf] * alpha + ps;
#pragma unroll
                    for (int d = 0; d < 4; ++d) st.O[d][cf] *= alpha;
                    pb[cf] = pack8(S[0][cf], S[1][cf]);
                }
#pragma unroll
                for (int d = 0; d < 4; ++d) {
                    const int row = d * 16 + cl;
                    const bf16x8 av = *(const bf16x8*)(cur + 8192 + row * 128 + (((c * 4 + q) ^ (row & 7)) << 4));
#pragma unroll
                    for (int cf = 0; cf < 4; ++cf) st.O[d][cf] = MFMA16(av, pb[cf], st.O[d][cf]);
                }
            }
        }
        if (more) {
#pragma unroll
            for (int i = 0; i < 2; ++i) { *(u32x4*)(nxt + kwo[i]) = rk[i]; *(u32x4*)(nxt + vwo[i]) = rv[i]; }
        }
        __syncthreads();
    }
}

DEVI f32x4 bload16f(rsrc_t r, unsigned voff, unsigned soff) { return __builtin_bit_cast(f32x4, __builtin_amdgcn_raw_buffer_load_b128(r, (int)voff, (int)soff, 0)); }
DEVI void bstore16f(rsrc_t r, f32x4 v, unsigned voff, unsigned soff) { __builtin_amdgcn_raw_buffer_store_b128(__builtin_bit_cast(u32x4, v), r, (int)voff, (int)soff, 0); }
DEVI float bload4f(rsrc_t r, unsigned voff, unsigned soff) { return __builtin_bit_cast(float, __builtin_amdgcn_raw_buffer_load_b32(r, (int)voff, (int)soff, 0)); }

struct NsaUnit { int i, b, k, t0, tq; unsigned tokw, tokb, qoff, goff, ooff, sQ, sG, sO; };
DEVI NsaUnit nsa_unit(int uu, int tid) {
    NsaUnit U;
    const int lane = tid & 63, wid = __builtin_amdgcn_readfirstlane(tid >> 6), q = lane >> 4, cl = lane & 15;
    const int half = uu >> 9, r = uu & 511, bk = r & 15, ii = r >> 4;
    U.i = half ? ii : 63 - ii; U.b = bk >> 1; U.k = bk & 1;
    U.t0 = U.i * 64; U.tq = U.t0 + wid * 16 + cl;
    U.tokw = (unsigned)(wid * 16 + cl);
    U.tokb = (unsigned)(U.b * 4096 + U.t0);
    U.qoff = U.tokw * 1024u + (unsigned)q * 16u;
    U.goff = U.tokw * 96u;
    U.ooff = U.tokw * 1024u + (unsigned)q * 8u;
    U.sQ = U.tokb * 1024u + (unsigned)U.k * 512u;
    U.sG = (unsigned)OFF_GATES + U.tokb * 96u + (unsigned)U.k * 16u;
    U.sO = (unsigned)OFF_OB + U.tokb * 1024u + (unsigned)U.k * 512u;
    return U;
}

DEVI void nsa_cmp_unit(const Params& P, rsrc_t rs, int uu, unsigned char* lds, int tid) {
    const int lane = tid & 63, wid = __builtin_amdgcn_readfirstlane(tid >> 6), q = lane >> 4, cl = lane & 15;
    const NsaUnit U = nsa_unit(uu, tid);
    const int i = U.i, b = U.b, k = U.k, tq = U.tq;
    AttnState st;
    bf16x8 qf[4][2];
#pragma unroll
    for (int cf = 0; cf < 4; ++cf)
#pragma unroll
        for (int ks = 0; ks < 2; ++ks) qf[cf][ks] = __builtin_bit_cast(bf16x8, bload16(rs, U.qoff, (unsigned)OFF_QBN + U.sQ + cf * 128 + ks * 64));
    const unsigned sKC = (unsigned)OFF_KC + (unsigned)(b * 2 + k) * 256u * 128u;
    const unsigned sVC = (unsigned)OFF_VCT + (unsigned)(b * 2 + k) * 64u * 512u;
    const int nmax_blk = (U.t0 + 63 - 31) >> 4;
    const int jbc = (nmax_blk >> 6) < 3 ? (nmax_blk >> 6) : 3;
    attn_blocks<0>(rs, sKC, sVC, 256, 0, jbc, qf, st, tq, 0ull, lds, tid);
    float linv[4], mfin[4];
#pragma unroll
    for (int cf = 0; cf < 4; ++cf) {
        float l = st.l[cf]; l += __shfl_xor(l, 16); l += __shfl_xor(l, 32);
        linv[cf] = (l > 0.f) ? __builtin_amdgcn_rcpf(l) : 0.f; mfin[cf] = st.m[cf];
        const float sc = linv[cf] * bload4f(rs, U.goff, U.sG + cf * 4);
#pragma unroll
        for (int d = 0; d < 4; ++d) { const f32x4 v = st.O[d][cf] * sc; u32x2 w; w.x = pk2(v[0], v[1]); w.y = pk2(v[2], v[3]);
            __builtin_amdgcn_raw_buffer_store_b64(w, rs, (int)U.ooff, (int)(U.sO + cf * 128 + d * 32), 0); }
    }
    unsigned long long* MSKG = (unsigned long long*)(P.ws + OFF_MASK);
    if (i < 16) {
        if (q == 0) MSKG[((size_t)(b * 2 + k)) * 4096 + tq] = (2ull << i) - 1ull;
        return;
    }
    float* SUM4 = (float*)(lds + 16384);
    float* LAST = (float*)(lds + 32768);
    float* IMP2 = (float*)(lds + 49152);
    const int nmax = (tq >= 31) ? ((tq - 31) >> 4) : -1;
    for (int kb = 0; kb <= jbc; ++kb) {
#pragma unroll
        for (int ii = 0; ii < 2; ++ii) {
            const int idx = tid + 256 * ii, row = idx >> 3, ch = idx & 7;
            *(u32x4*)(lds + row * 128 + ((ch ^ fK(row)) << 4)) = bload16(rs, (unsigned)(row * 64 + ch * 8) * 2u, sKC + (unsigned)kb * 8192u);
        }
        __syncthreads();
#pragma unroll
        for (int rf = 0; rf < 4; ++rf) {
            f32x4 S[4];
#pragma unroll
            for (int cf = 0; cf < 4; ++cf) S[cf] = (f32x4){0.f, 0.f, 0.f, 0.f};
            const int kl = 32 * (rf >> 1) + 8 * (cl >> 2) + 4 * (rf & 1) + (cl & 3);
#pragma unroll
            for (int ks = 0; ks < 2; ++ks) {
                const bf16x8 a = *(const bf16x8*)(lds + kl * 128 + (((ks * 4 + q) ^ (cl & 7)) << 4));
#pragma unroll
                for (int cf = 0; cf < 4; ++cf) S[cf] = MFMA16(a, qf[cf][ks], S[cf]);
            }
            float acc4 = 0.f, accl = 0.f;
#pragma unroll
            for (int j = 0; j < 4; ++j) {
                const int key = kb * 64 + 32 * (rf >> 1) + 8 * q + 4 * (rf & 1) + j;
                float pj = 0.f;
#pragma unroll
                for (int cf = 0; cf < 4; ++cf) pj += __builtin_amdgcn_exp2f((S[cf][j] - mfin[cf]) * LOG2E) * linv[cf];
                pj = (key <= nmax) ? pj : 0.f;
                acc4 += pj; if (j == 3) accl = pj;
            }
            const int jblk = kb * 16 + 8 * (rf >> 1) + 2 * q + (rf & 1);
            SUM4[(wid * 16 + cl) * 64 + jblk] = acc4; LAST[(wid * 16 + cl) * 64 + jblk] = accl;
        }
        __syncthreads();
    }
    {
        const int qi = tid >> 2, jg = tid & 3;
        const int jlim = (jbc + 1) * 16;
        for (int jj = 0; jj < 16; ++jj) {
            const int j = jg * 16 + jj;
            float v = (j < jlim) ? SUM4[qi * 64 + j] : 0.f;
            if (j >= 1 && j - 1 < jlim) v += LAST[qi * 64 + j - 1];
            IMP2[qi * 64 + j] = v;
        }
    }
    __syncthreads();
    {
        const int qi = tid >> 2, jg = tid & 3;
        const float* row = IMP2 + qi * 64;
        unsigned lo = 0u;
        for (int jj = 0; jj < 16; ++jj) {
            const int j = jg * 16 + jj;
            if (j <= i) {
                const bool forced = (j == 0) || (j == i) || (j == i - 1);
                const float kj = forced ? __builtin_inff() : row[j];
                int rank = 0;
                for (int j2 = 0; j2 <= i; ++j2) {
                    const bool f2 = (j2 == 0) || (j2 == i) || (j2 == i - 1);
                    const float k2 = f2 ? __builtin_inff() : row[j2];
                    rank += (k2 > kj || (k2 == kj && j2 < j)) ? 1 : 0;
                }
                if (rank < 16) lo |= (1u << jj);
            }
        }
        unsigned long long bits = (unsigned long long)lo << (jg * 16);
        bits |= __shfl_xor(bits, 1); bits |= __shfl_xor(bits, 2);
        if (jg == 0) MSKG[((size_t)(b * 2 + k)) * 4096 + U.t0 + qi] = bits;
    }
    __syncthreads();
}

template <int MODE>
DEVI void nsa_kv_unit(const Params& P, rsrc_t rs, int uu, unsigned char* lds, int tid) {
    const int lane = tid & 63, q = lane >> 4;
    const NsaUnit U = nsa_unit(uu, tid);
    const int i = U.i, b = U.b, k = U.k, tq = U.tq;
    AttnState st;
    bf16x8 qf[4][2];
#pragma unroll
    for (int cf = 0; cf < 4; ++cf)
#pragma unroll
        for (int ks = 0; ks < 2; ++ks) qf[cf][ks] = __builtin_bit_cast(bf16x8, bload16(rs, U.qoff, (unsigned)OFF_QBR + U.sQ + cf * 128 + ks * 64));
    const unsigned sK = (unsigned)(OFF_KV + (MODE == 1 ? 2 : 4) * KV_STRIDE) + (unsigned)(b * 2 + k) * 4096u * 128u;
    const unsigned sV = (unsigned)(OFF_KV + (MODE == 1 ? 3 : 5) * KV_STRIDE) + (unsigned)(b * 2 + k) * 64u * 8192u;
    unsigned long long mymask = 0ull;
    int j0 = 0;
    if (MODE == 1) mymask = ((const unsigned long long*)(P.ws + OFF_MASK))[((size_t)(b * 2 + k)) * 4096 + tq];
    else j0 = (i >= 8) ? i - 8 : 0;
    attn_blocks<MODE>(rs, sK, sV, 4096, j0, i, qf, st, tq, mymask, lds, tid);
#pragma unroll
    for (int cf = 0; cf < 4; ++cf) {
        float l = st.l[cf]; l += __shfl_xor(l, 16); l += __shfl_xor(l, 32);
        const float sc = ((l > 0.f) ? __builtin_amdgcn_rcpf(l) : 0.f) * bload4f(rs, U.goff, U.sG + (MODE == 1 ? 32 : 64) + cf * 4);
#pragma unroll
        for (int d = 0; d < 4; ++d) {
            const u32x2 pw = __builtin_bit_cast(u32x2, __builtin_amdgcn_raw_buffer_load_b64(rs, (int)U.ooff, (int)(U.sO + cf * 128 + d * 32), 0));
            f32x4 v = st.O[d][cf] * sc;
            v[0] += bf2f(pw.x & 0xffffu); v[1] += bf2f(pw.x >> 16); v[2] += bf2f(pw.y & 0xffffu); v[3] += bf2f(pw.y >> 16);
            u32x2 w; w.x = pk2(v[0], v[1]); w.y = pk2(v[2], v[3]);
            __builtin_amdgcn_raw_buffer_store_b64(w, rs, (int)U.ooff, (int)(U.sO + cf * 128 + d * 32), 0);
        }
    }
}

DEVI void phase_nsa(const Params& P, unsigned char* lds, int tid) {
    const rsrc_t rs = __builtin_amdgcn_make_buffer_rsrc((void*)P.ws, (short)0, (int)0x7fffffff, 0x00020000);
    for (int uu = blockIdx.x; uu < 1024; uu += gridDim.x) { int t = tid; asm volatile("" : "+v"(t)); nsa_cmp_unit(P, rs, uu, lds, t); }
    __syncthreads();
    for (int uu = blockIdx.x; uu < 1024; uu += gridDim.x) { int t = tid; asm volatile("" : "+v"(t)); nsa_kv_unit<1>(P, rs, uu, lds, t); }
    __syncthreads();
    for (int uu = blockIdx.x; uu < 1024; uu += gridDim.x) { int t = tid; asm volatile("" : "+v"(t)); nsa_kv_unit<2>(P, rs, uu, lds, t); }
}

DEVI void phase_merge(const Params& P, unsigned char* lds, int tid) {
    unsigned char* ws = P.ws;
    const rsrc_t rs = __builtin_amdgcn_make_buffer_rsrc((void*)P.ws, (short)0, (int)0x7fffffff, 0x00020000);
    const bf16_t* ga = (const bf16_t*)(ws + OFF_GA);
    const bf16_t* gb = (const bf16_t*)(ws + OFF_GB);
    bf16_t* mg = (bf16_t*)(ws + OFF_MERGED);
    const int lane = tid & 63, wid = __builtin_amdgcn_readfirstlane(tid >> 6), wr = wid >> 1, wc = wid & 1, q = lane >> 4, cl = lane & 15;
    for (int kk = 0;; ++kk) {
        int mt, nt;
        if (!tile_map(kk, 8, mt, nt)) break;
        f32x4 acc[4][4];
        unsigned t[4][4][2];
        gemm128(acc, rs, (unsigned)(OFF_OA + (size_t)mt * 128 * 1024), RowLin{1024}, (unsigned)(OFF_WBRA + (size_t)nt * 128 * 1024), RowLin{1024}, 8, lds, tid);
        const size_t e0 = (size_t)(mt * 128 + wr * 64 + cl) * 1024 + nt * 128 + wc * 64 + q * 4;
#pragma unroll
        for (int m = 0; m < 4; ++m)
#pragma unroll
            for (int n = 0; n < 4; ++n) {
                const u32x2 gv = *(const u32x2*)(ga + e0 + (size_t)m * 16 * 1024 + n * 16);
                t[m][n][0] = pk2(acc[m][n][0] * bf2f(gv.x & 0xffffu), acc[m][n][1] * bf2f(gv.x >> 16));
                t[m][n][1] = pk2(acc[m][n][2] * bf2f(gv.y & 0xffffu), acc[m][n][3] * bf2f(gv.y >> 16));
            }
        gemm128(acc, rs, (unsigned)(OFF_OB + (size_t)mt * 128 * 1024), RowLin{1024}, (unsigned)(OFF_WBRB + (size_t)nt * 128 * 1024), RowLin{1024}, 8, lds, tid);
#pragma unroll
        for (int m = 0; m < 4; ++m)
#pragma unroll
            for (int n = 0; n < 4; ++n) {
                const size_t o = e0 + (size_t)m * 16 * 1024 + n * 16;
                const u32x2 gv = *(const u32x2*)(gb + o);
                u32x2 w;
                w.x = pk2(bf2f(t[m][n][0] & 0xffffu) + acc[m][n][0] * bf2f(gv.x & 0xffffu), bf2f(t[m][n][0] >> 16) + acc[m][n][1] * bf2f(gv.x >> 16));
                w.y = pk2(bf2f(t[m][n][1] & 0xffffu) + acc[m][n][2] * bf2f(gv.y & 0xffffu), bf2f(t[m][n][1] >> 16) + acc[m][n][3] * bf2f(gv.y >> 16));
                *(u32x2*)(mg + o) = w;
            }
    }
}

DEVI void phase_outproj(const Params& P, unsigned char* lds, int tid) {
    unsigned char* ws = P.ws;
    const rsrc_t rs = __builtin_amdgcn_make_buffer_rsrc((void*)P.ws, (short)0, (int)0x7fffffff, 0x00020000);
    const bf16_t* mg = (const bf16_t*)(ws + OFF_MERGED);
    const bf16_t* wo = (const bf16_t*)(ws + OFF_WOUT);
    const float* x = P.in[0];
    float* x1 = P.out;
    const int lane = tid & 63, wid = __builtin_amdgcn_readfirstlane(tid >> 6), wr = wid >> 1, wc = wid & 1, q = lane >> 4, cl = lane & 15;
    for (int kk = 0;; ++kk) {
        int mt, nt;
        if (!tile_map(kk, 8, mt, nt)) break;
        f32x4 acc[4][4];
        gemm128(acc, rs, (unsigned)(OFF_MERGED + (size_t)mt * 128 * 2048), RowLin{2048}, (unsigned)(OFF_WOUT + (size_t)nt * 128 * 2048), RowLin{2048}, 16, lds, tid);
#pragma unroll
        for (int m = 0; m < 4; ++m)
#pragma unroll
            for (int n = 0; n < 4; ++n) {
                const size_t o = (size_t)(mt * 128 + wr * 64 + m * 16 + cl) * 1024 + nt * 128 + wc * 64 + n * 16 + q * 4;
                *(f32x4*)(x1 + o) = *(const f32x4*)(x + o) + acc[m][n];
            }
    }
}

DEVI void phase_router(const Params& P, unsigned char* lds, int tid) {
    unsigned char* ws = P.ws;
    const int lane = tid & 63, wid = __builtin_amdgcn_readfirstlane(tid >> 6), q = lane >> 4, cl = lane & 15;
    const float* x1 = P.out; const float* g = P.in[13];
    const float* bg = P.in[15]; const float* be = P.in[17];
    const float* WR = (const float*)(ws + OFF_WR);
    bf16_t* h2 = (bf16_t*)(ws + OFF_HN);
    unsigned* cnt = (unsigned*)(ws + OFF_CTL);
    int* list = (int*)(ws + OFF_LIST);
    float* wt = (float*)(ws + OFF_WT);
    float* WL = (float*)lds;
    float* LG = (float*)(lds + 50688);
    float* RS = (float*)(lds + 50688 + 12288);
    for (int u = blockIdx.x; u < NTOK / 64; u += gridDim.x) {
        const int row0 = u * 64 + wid * 16;
        const float* xa = x1 + (size_t)(row0 + cl) * 1024 + 4 * q;
        f32x4 acc[3];
#pragma unroll
        for (int ct = 0; ct < 3; ++ct) acc[ct] = (f32x4){0.f, 0.f, 0.f, 0.f};
        float ss = 0.f;
        for (int kc = 0; kc < 4; ++kc) {
            __syncthreads();
#pragma unroll
            for (int i = 0; i < 12; ++i) {
                const int idx = tid + 256 * i, r = idx >> 6, c4 = idx & 63;
                *(f32x4*)(WL + r * 264 + c4 * 4) = *(const f32x4*)(WR + (size_t)r * 1024 + kc * 256 + c4 * 4);
            }
            __syncthreads();
#pragma unroll
            for (int jh = 0; jh < 2; ++jh) {
                f32x4 av[8];
#pragma unroll
                for (int j = 0; j < 8; ++j) av[j] = *(const f32x4*)(xa + kc * 256 + (jh * 8 + j) * 16);
#pragma unroll
                for (int j = 0; j < 8; ++j) {
                    ss += av[j][0] * av[j][0] + av[j][1] * av[j][1] + av[j][2] * av[j][2] + av[j][3] * av[j][3];
#pragma unroll
                    for (int ct = 0; ct < 3; ++ct) {
                        const f32x4 bv = *(const f32x4*)(WL + (ct * 16 + cl) * 264 + (jh * 8 + j) * 16 + 4 * q);
#pragma unroll
                        for (int e = 0; e < 4; ++e) acc[ct] = __builtin_amdgcn_mfma_f32_16x16x4f32(av[j][e], bv[e], acc[ct], 0, 0, 0);
                    }
                }
            }
        }
        ss += __shfl_xor(ss, 16); ss += __shfl_xor(ss, 32);
        const float rs = rsqrtf(ss * (1.0f / 1024.0f) + RMS_EPS);
        if (q == 0) RS[wid * 16 + cl] = rs;
        __syncthreads();
#pragma unroll
        for (int j = 0; j < 4; ++j) {
            const float rj = RS[wid * 16 + 4 * q + j];
#pragma unroll
            for (int ct = 0; ct < 3; ++ct) LG[(wid * 16 + 4 * q + j) * 48 + ct * 16 + cl] = acc[ct][j] * rj;
        }
        __syncthreads();
        if (tid < 64) {
            const int r = u * 64 + tid;
            const float* lg = LG + tid * 48;
            float gl[4];
#pragma unroll
            for (int e = 0; e < 4; ++e) gl[e] = lg[e] + bg[e];
            int gs = 0; float gm = gl[0];
#pragma unroll
            for (int e = 1; e < 4; ++e) if (gl[e] > gm) { gm = gl[e]; gs = e; }
            float den = 0.f;
#pragma unroll
            for (int e = 0; e < 4; ++e) den += __expf(gl[e] - gm);
            const float gp = 1.0f / den;
            float el[8];
#pragma unroll
            for (int e = 0; e < 8; ++e) el[e] = lg[4 + gs * 8 + e] + be[gs * 8 + e];
            int i0 = 0; float v0 = el[0];
#pragma unroll
            for (int e = 1; e < 8; ++e) if (el[e] > v0) { v0 = el[e]; i0 = e; }
            int i1 = -1; float v1 = -__builtin_inff();
#pragma unroll
            for (int e = 0; e < 8; ++e) if (e != i0 && el[e] > v1) { v1 = el[e]; i1 = e; }
            const float e1 = __expf(v1 - v0);
            const float w0 = gp / (1.0f + e1), w1 = gp * e1 / (1.0f + e1);
            const int ex0 = gs * 8 + i0, ex1 = gs * 8 + i1;
            const unsigned p0 = atomicAdd(&cnt[ex0], 1u);
            list[(size_t)ex0 * NTOK + p0] = r * 2 + 0;
            const unsigned p1 = atomicAdd(&cnt[ex1], 1u);
            list[(size_t)ex1 * NTOK + p1] = r * 2 + 1;
            wt[(size_t)r * 2 + 0] = w0; wt[(size_t)r * 2 + 1] = w1;
        }
        for (int rr = 0; rr < 16; ++rr) {
            const int row = row0 + rr;
            const float rsr = RS[wid * 16 + rr];
#pragma unroll
            for (int i = 0; i < 4; ++i) {
                const f32x4 v = *(const f32x4*)(x1 + (size_t)row * 1024 + i * 256 + lane * 4);
                const f32x4 gg = *(const f32x4*)(g + i * 256 + lane * 4);
                u32x2 w; w.x = pk2(v[0] * rsr * gg[0], v[1] * rsr * gg[1]); w.y = pk2(v[2] * rsr * gg[2], v[3] * rsr * gg[3]);
                *(u32x2*)(h2 + (size_t)row * 1024 + i * 256 + lane * 4) = w;
            }
        }
    }
}

struct RowGather { const int* idx; DEVI unsigned operator()(int r) const { return (unsigned)idx[r] * 2048u; } };
struct RowGU { int c0; DEVI unsigned operator()(int r) const {
    const int wcx = r >> 6, w = r & 63; const int col = (w < 32) ? (c0 + wcx * 32 + w) : (256 + c0 + wcx * 32 + (w - 32)); return (unsigned)col * 2048u; } };

DEVI int moe_find_tile(const unsigned* cnt, int u, int& e, int& tl) {
    int t = u, ee = 0, ce = 0;
    for (; ee < 32; ++ee) { ce = (int)cnt[ee]; const int nt = (ce + 127) >> 7; if (t < nt) break; t -= nt; }
    e = ee; tl = t; return ce;
}
DEVI void phase_moe_a(const Params& P, unsigned char* lds, int tid) {
    unsigned char* ws = P.ws;
    const rsrc_t rs = __builtin_amdgcn_make_buffer_rsrc((void*)P.ws, (short)0, (int)0x7fffffff, 0x00020000);
    const int lane = tid & 63, wid = __builtin_amdgcn_readfirstlane(tid >> 6), wr = wid >> 1, wc = wid & 1, q = lane >> 4, cl = lane & 15;
    const unsigned* cnt = (const unsigned*)(ws + OFF_CTL);
    const int* list = (const int*)(ws + OFF_LIST);
    bf16_t* act = (bf16_t*)(ws + OFF_ACT);
    int* rowtok = (int*)(lds + 65536);
    int total = 0;
    for (int e = 0; e < 32; ++e) total += ((int)cnt[e] + 127) >> 7;
    for (int v = blockIdx.x; v < total * 4; v += gridDim.x) {
        const int u = v >> 2, nt = v & 3;
        int e, tl; const int ce = moe_find_tile(cnt, u, e, tl);
        if (tid < 128) { const int r = tl * 128 + tid; rowtok[tid] = (r < ce) ? (list[(size_t)e * NTOK + r] >> 1) : 0; }
        __syncthreads();
        bf16_t* au = act + (size_t)u * 128 * 256;
        f32x4 acc[4][4];
        gemm128(acc, rs, (unsigned)OFF_HN, RowGather{rowtok}, (unsigned)(OFF_WGU + (size_t)e * 512 * 2048), RowGU{nt * 64}, 16, lds, tid);
#pragma unroll
        for (int m = 0; m < 4; ++m)
#pragma unroll
            for (int n = 0; n < 2; ++n) {
                const int row = wr * 64 + m * 16 + cl, col = nt * 64 + wc * 32 + n * 16 + q * 4;
                u32x2 w;
                w.x = pk2(siluf_(acc[m][n][0]) * acc[m][n + 2][0], siluf_(acc[m][n][1]) * acc[m][n + 2][1]);
                w.y = pk2(siluf_(acc[m][n][2]) * acc[m][n + 2][2], siluf_(acc[m][n][3]) * acc[m][n + 2][3]);
                *(u32x2*)(au + (size_t)row * 256 + col) = w;
            }
    }
}
DEVI void phase_moe_b(const Params& P, unsigned char* lds, int tid) {
    unsigned char* ws = P.ws;
    const rsrc_t rs = __builtin_amdgcn_make_buffer_rsrc((void*)P.ws, (short)0, (int)0x7fffffff, 0x00020000);
    const int lane = tid & 63, wid = __builtin_amdgcn_readfirstlane(tid >> 6), wr = wid >> 1, wc = wid & 1, q = lane >> 4, cl = lane & 15;
    const unsigned* cnt = (const unsigned*)(ws + OFF_CTL);
    const int* list = (const int*)(ws + OFF_LIST);
    bf16_t* Y = (bf16_t*)(ws + OFF_Y);
    int* rowas = (int*)(lds + 65536);
    int total = 0;
    for (int e = 0; e < 32; ++e) total += ((int)cnt[e] + 127) >> 7;
    for (int v = blockIdx.x; v < total * 4; v += gridDim.x) {
        const int u = v >> 2, np = v & 3;
        int e, tl; const int ce = moe_find_tile(cnt, u, e, tl);
        if (tid < 128) { const int r = tl * 128 + tid; rowas[tid] = (r < ce) ? list[(size_t)e * NTOK + r] : -1; }
        __syncthreads();
        for (int h = 0; h < 2; ++h) {
            const int nt = np * 2 + h;
            f32x4 acc[4][4];
            gemm128(acc, rs, (unsigned)(OFF_ACT + (size_t)u * 128 * 512), RowLin{512}, (unsigned)(OFF_WDN + (size_t)e * 1024 * 512 + (size_t)nt * 128 * 512), RowLin{512}, 4, lds, tid);
#pragma unroll
            for (int m = 0; m < 4; ++m) {
                const int row = wr * 64 + m * 16 + cl;
                const int as = rowas[row];
                if (as >= 0) {
                    bf16_t* yr = Y + ((size_t)(as & 1) * NTOK + (as >> 1)) * 1024 + nt * 128 + wc * 64 + q * 4;
#pragma unroll
                    for (int n = 0; n < 4; ++n) { u32x2 w; w.x = pk2(acc[m][n][0], acc[m][n][1]); w.y = pk2(acc[m][n][2], acc[m][n][3]); *(u32x2*)(yr + n * 16) = w; }
                }
            }
        }
        __syncthreads();
    }
}

DEVI void phase_final(const Params& P, int tid, bool with_moe) {
    unsigned char* ws = P.ws;
    const int lane = tid & 63, wid = __builtin_amdgcn_readfirstlane(tid >> 6);
    const bf16_t* Y = (const bf16_t*)(ws + OFF_Y);
    const float* wt = (const float*)(ws + OFF_WT);
    const float* g = P.in[20];
    float* out = P.out;
    for (int r = blockIdx.x * 4 + wid; r < NTOK; r += gridDim.x * 4) {
        float* xr = out + (size_t)r * 1024;
        const float w0 = with_moe ? wt[(size_t)r * 2] : 0.f, w1 = with_moe ? wt[(size_t)r * 2 + 1] : 0.f;
        f32x4 v[4]; float ss = 0.f;
#pragma unroll
        for (int i = 0; i < 4; ++i) {
            v[i] = *(const f32x4*)(xr + i * 256 + lane * 4);
            if (with_moe) {
                const u32x2 a = *(const u32x2*)(Y + (size_t)r * 1024 + i * 256 + lane * 4);
                const u32x2 b = *(const u32x2*)(Y + ((size_t)NTOK + r) * 1024 + i * 256 + lane * 4);
                v[i][0] += w0 * bf2f(a.x & 0xffffu) + w1 * bf2f(b.x & 0xffffu); v[i][1] += w0 * bf2f(a.x >> 16) + w1 * bf2f(b.x >> 16);
                v[i][2] += w0 * bf2f(a.y & 0xffffu) + w1 * bf2f(b.y & 0xffffu); v[i][3] += w0 * bf2f(a.y >> 16) + w1 * bf2f(b.y >> 16);
            }
            ss += v[i][0] * v[i][0] + v[i][1] * v[i][1] + v[i][2] * v[i][2] + v[i][3] * v[i][3];
        }
        ss = wave_sum(ss);
        const float rs = rsqrtf(ss * (1.0f / 1024.0f) + RMS_EPS);
#pragma unroll
        for (int i = 0; i < 4; ++i) {
            const f32x4 gg = *(const f32x4*)(g + i * 256 + lane * 4);
            f32x4 o; o[0] = v[i][0] * rs * gg[0]; o[1] = v[i][1] * rs * gg[1]; o[2] = v[i][2] * rs * gg[2]; o[3] = v[i][3] * rs * gg[3];
            *(f32x4*)(xr + i * 256 + lane * 4) = o;
        }
    }
}

#define LAUNDER_TID() do { tid = threadIdx.x; asm volatile("" : "+v"(tid)); } while (0)
__global__ void __launch_bounds__(NTHREADS, 2) fwd_megakernel(Params P) {
    extern __shared__ __attribute__((aligned(16))) unsigned char lds[];
    cg::grid_group grid = cg::this_grid();
    int tid;
    volatile LAS unsigned* bst = (volatile LAS unsigned*)(LAS unsigned char*)(lds + LDS_BYTES - 16);
    if (threadIdx.x < 4) bst[threadIdx.x] = 0u;
    for (int rep = 0; rep < REPS(10); ++rep) { LAUNDER_TID(); phase_prep(P, lds, tid); __syncthreads(); }
    grid.sync();
    const XcdBarrier bar = xcd_barrier_post((unsigned*)(P.ws + OFF_BAR), bst);
    for (int rep = 0; rep < REPS(1); ++rep) { LAUNDER_TID(); phase_gemm1(P, lds, tid); }
    xcd_barrier(bar);
    for (int rep = 0; rep < REPS(2); ++rep) { LAUNDER_TID(); phase_compress(P, lds, tid); __syncthreads(); }
    for (int rep = 0; rep < REPS(3); ++rep) { LAUNDER_TID(); phase_index(P, lds, tid); __syncthreads(); }
    xcd_barrier(bar);
    for (int rep = 0; rep < REPS(4); ++rep) { LAUNDER_TID(); phase_dsa(P, lds, tid); __syncthreads(); }
    for (int rep = 0; rep < REPS(5); ++rep) { LAUNDER_TID(); phase_nsa(P, lds, tid); __syncthreads(); }
    xcd_barrier(bar);
    for (int rep = 0; rep < REPS(6); ++rep) { LAUNDER_TID(); phase_merge(P, lds, tid); }
    xcd_barrier(bar);
    for (int rep = 0; rep < REPS(7); ++rep) { LAUNDER_TID(); phase_outproj(P, lds, tid); }
    xcd_barrier(bar);
    LAUNDER_TID(); phase_router(P, lds, tid);
    xcd_barrier(bar);
    for (int rep = 0; rep < REPS(9); ++rep) { LAUNDER_TID(); phase_moe_a(P, lds, tid); }
    xcd_barrier(bar);
    for (int rep = 0; rep < REPS(11); ++rep) { LAUNDER_TID(); phase_moe_b(P, lds, tid); }
    xcd_barrier(bar);
    LAUNDER_TID(); phase_final(P, tid, true);
}

extern "C" void kernel_launch(void* const* d_in, const int* in_sizes, int n_in, void* d_out, int out_size, void* d_ws, size_t ws_size,
                              hipStream_t stream) {
    static int grid_blocks = 0;
    if (!grid_blocks) {
        int dev = 0, cus = 0, per_cu = 0;
        hipGetDevice(&dev);
        hipDeviceGetAttribute(&cus, hipDeviceAttributeMultiprocessorCount, dev);
        hipFuncSetAttribute((const void*)fwd_megakernel, hipFuncAttributeMaxDynamicSharedMemorySize, LDS_BYTES);
        hipOccupancyMaxActiveBlocksPerMultiprocessor(&per_cu, (const void*)fwd_megakernel, NTHREADS, LDS_BYTES);
        if (per_cu < 1) per_cu = 1;
        if (per_cu > 2) per_cu = 2;
        grid_blocks = cus * per_cu;
        if (ws_size < WS_END) fprintf(stderr, "kernel_launch: workspace too small: %zu < %zu\n", ws_size, (size_t)WS_END);
    }
    Params p{};
    for (int i = 0; i < 21; ++i) p.in[i] = (const float*)d_in[i];
    p.pos = (const int*)d_in[1];
    p.out = (float*)d_out;
    p.ws = (unsigned char*)d_ws;
    for (int i = 0; i < 32; ++i) p.inv_freq[i] = (double)powf(10000.0f, -(float)i / 32.0f);
    p.ph_lo = 0; p.ph_hi = 0;
    void* args[] = {&p};
    hipError_t e = hipLaunchCooperativeKernel((const void*)fwd_megakernel, dim3(grid_blocks), dim3(NTHREADS), args, LDS_BYTES, stream);
    if (e != hipSuccess) fprintf(stderr, "cooperative launch failed: %s (grid %d)\n", hipGetErrorString(e), grid_blocks);
}
```

```cpp
#include <hip/hip_runtime.h>
#include <hip/hip_cooperative_groups.h>
#include <cstdint>
#include <cstdio>
#include <cmath>
namespace cg = cooperative_groups;

#define DEVI __device__ __forceinline__
#ifndef PROBE_TWICE
#define PROBE_TWICE 0
#endif
#define REPS(k) ((PROBE_TWICE == (k)) ? 2 : 1)
typedef unsigned short bf16_t;
typedef short bf16x8 __attribute__((ext_vector_type(8)));
typedef short s16x4 __attribute__((ext_vector_type(4)));
typedef float f32x4 __attribute__((ext_vector_type(4)));
typedef float f32x2 __attribute__((ext_vector_type(2)));
typedef unsigned u32x4 __attribute__((ext_vector_type(4)));
typedef unsigned u32x2 __attribute__((ext_vector_type(2)));
#define LAS __attribute__((address_space(3)))

constexpr int NB = 8, SL = 4096, DM = 1024, NTOK = NB * SL;
constexpr int INW = 4288;
constexpr int NTHREADS = 256;
constexpr int LDS_BYTES = 81920;
constexpr float RMS_EPS = 1e-6f;
constexpr float LOG2E = 1.4426950408889634f;

constexpr int WIN_ROWS = 4352;
constexpr int G1_COLS = 4352;

constexpr size_t al256(size_t x) { return (x + 255) & ~(size_t)255; }
constexpr size_t OFF_CTL   = 0;
constexpr size_t OFF_BAR   = 4096;
constexpr size_t OFF_WIN_T = 32768;
constexpr size_t OFF_WBRA  = OFF_WIN_T + (size_t)WIN_ROWS * 1024 * 2;
constexpr size_t OFF_WBRB  = OFF_WBRA + (size_t)1024 * 512 * 2;
constexpr size_t OFF_WOUT  = OFF_WBRB + (size_t)1024 * 512 * 2;
constexpr size_t OFF_W1K   = OFF_WOUT + (size_t)1024 * 1024 * 2;
constexpr size_t OFF_W1V   = OFF_W1K + (size_t)128 * 2048 * 2;
constexpr size_t OFF_W2K   = OFF_W1V + (size_t)128 * 2048 * 2;
constexpr size_t OFF_W2V   = OFF_W2K + (size_t)64 * 128 * 2;
constexpr size_t OFF_WGU   = OFF_W2V + (size_t)64 * 128 * 2;
constexpr size_t OFF_WDN   = OFF_WGU + (size_t)32 * 512 * 1024 * 2;
constexpr size_t OFF_BIAS1 = OFF_WDN + (size_t)32 * 1024 * 256 * 2;
constexpr size_t OFF_WR    = OFF_BIAS1 + 1024;
constexpr size_t OFF_CS    = OFF_WR + (size_t)48 * 1024 * 4;
constexpr size_t OFF_HN    = OFF_CS + (size_t)NTOK * 32 * 8;
constexpr size_t OFF_QA    = OFF_HN + (size_t)NTOK * 1024 * 2;
constexpr size_t OFF_KA    = OFF_QA + (size_t)NTOK * 512 * 2;
constexpr size_t OFF_VA    = OFF_KA + (size_t)NTOK * 64 * 2;
constexpr size_t OFF_QI    = OFF_VA + (size_t)NTOK * 64 * 2;
constexpr size_t OFF_KI    = OFF_QI + (size_t)NTOK * 256 * 2;
constexpr size_t OFF_WI    = OFF_KI + (size_t)NTOK * 32 * 2;
constexpr size_t OFF_QBN   = OFF_WI + (size_t)NTOK * 8 * 4;
constexpr size_t OFF_QBR   = OFF_QBN + (size_t)NTOK * 512 * 2;
constexpr size_t KV_STRIDE = (size_t)NTOK * 128 * 2 + 65536 * 4;
constexpr size_t OFF_KV    = OFF_QBR + (size_t)NTOK * 512 * 2;
constexpr size_t OFF_GATES = OFF_KV + 6 * KV_STRIDE;
constexpr size_t OFF_QKV_END = OFF_GATES + (size_t)NTOK * 24 * 4;
constexpr size_t OFF_KC    = al256(OFF_QKV_END);
constexpr size_t OFF_VCT   = OFF_KC + (size_t)16 * 256 * 64 * 2;
constexpr size_t OFF_SEL   = OFF_VCT + (size_t)16 * 256 * 64 * 2;
constexpr size_t OFF_OA    = OFF_HN;
constexpr size_t OFF_OB    = OFF_OA + (size_t)NTOK * 512 * 2;
constexpr size_t OFF_GA    = OFF_SEL + (size_t)NTOK * 256 * 2;
constexpr size_t OFF_GB    = OFF_GA + (size_t)NTOK * 1024 * 2;
constexpr size_t OFF_MASK  = OFF_GB + (size_t)NTOK * 1024 * 2;
constexpr size_t OFF_LIST  = OFF_MASK + (size_t)16 * 4096 * 8;
constexpr size_t OFF_WT    = OFF_LIST + (size_t)32 * NTOK * 4;
constexpr size_t OFF_RS    = OFF_WT + (size_t)NTOK * 2 * 4;
constexpr size_t WS_END    = OFF_RS + (size_t)NTOK * 4;
constexpr size_t OFF_MERGED = OFF_QA;
constexpr size_t OFF_ACT    = OFF_QA;
constexpr size_t OFF_Y      = OFF_QA + (size_t)40 * 1024 * 1024;
static_assert(OFF_Y + (size_t)2 * NTOK * 1024 * 2 <= OFF_QKV_END, "Y overlay");
static_assert((size_t)544 * 128 * 256 * 2 <= (size_t)40 * 1024 * 1024, "ACT overlay");

struct Params {
    const float* in[21];
    const int* pos;
    float* out;
    unsigned char* ws;
    double inv_freq[32];
    int ph_lo, ph_hi;
};

DEVI unsigned f2bf(float f) { unsigned u = __float_as_uint(f); return (u + 0x7fffu + ((u >> 16) & 1u)) >> 16; }
typedef __bf16 bf16v2_t __attribute__((ext_vector_type(2)));
DEVI unsigned pk2(float lo, float hi) { const f32x2 v = {lo, hi}; return __builtin_bit_cast(unsigned, __builtin_convertvector(v, bf16v2_t)); }
DEVI float rows_max(float x) {
    float a = x, b = x;
    asm volatile("v_nop\n\tv_nop\n\tv_permlane16_swap_b32 %0, %1" : "+v"(a), "+v"(b));
    x = fmaxf(a, b); a = x; b = x;
    asm volatile("v_nop\n\tv_nop\n\tv_permlane32_swap_b32 %0, %1" : "+v"(a), "+v"(b));
    return fmaxf(a, b);
}
DEVI float rows_sum(float x) {
    float a = x, b = x;
    asm volatile("v_nop\n\tv_nop\n\tv_permlane16_swap_b32 %0, %1" : "+v"(a), "+v"(b));
    x = a + b; a = x; b = x;
    asm volatile("v_nop\n\tv_nop\n\tv_permlane32_swap_b32 %0, %1" : "+v"(a), "+v"(b));
    return a + b;
}
DEVI float bf2f(unsigned h) { return __uint_as_float(h << 16); }
DEVI float sigmoidf_(float x) { return __builtin_amdgcn_rcpf(1.0f + __builtin_amdgcn_exp2f(-x * 1.4426950408889634f)); }
DEVI float wave_sum(float v) {
#pragma unroll
    for (int o = 32; o > 0; o >>= 1) v += __shfl_xor(v, o);
    return v;
}
DEVI int wave_sum_i32(int v) {
    v += __builtin_amdgcn_update_dpp(0, v, 0xB1, 0xF, 0xF, true);
    v += __builtin_amdgcn_update_dpp(0, v, 0x4E, 0xF, 0xF, true);
    v += __builtin_amdgcn_update_dpp(0, v, 0x141, 0xF, 0xF, true);
    v += __builtin_amdgcn_update_dpp(0, v, 0x140, 0xF, 0xF, true);
    return __builtin_amdgcn_readlane(v, 0) + __builtin_amdgcn_readlane(v, 16) + __builtin_amdgcn_readlane(v, 32) + __builtin_amdgcn_readlane(v, 48);
}
DEVI float wave_sum_f32_dpp(float v) {
    v += __builtin_bit_cast(float, __builtin_amdgcn_update_dpp(0, __builtin_bit_cast(int, v), 0xB1, 0xF, 0xF, true));
    v += __builtin_bit_cast(float, __builtin_amdgcn_update_dpp(0, __builtin_bit_cast(int, v), 0x4E, 0xF, 0xF, true));
    v += __builtin_bit_cast(float, __builtin_amdgcn_update_dpp(0, __builtin_bit_cast(int, v), 0x141, 0xF, 0xF, true));
    v += __builtin_bit_cast(float, __builtin_amdgcn_update_dpp(0, __builtin_bit_cast(int, v), 0x140, 0xF, 0xF, true));
    const int iv = __builtin_bit_cast(int, v);
    return (__builtin_bit_cast(float, __builtin_amdgcn_readlane(iv, 0)) + __builtin_bit_cast(float, __builtin_amdgcn_readlane(iv, 16))) +
           (__builtin_bit_cast(float, __builtin_amdgcn_readlane(iv, 32)) + __builtin_bit_cast(float, __builtin_amdgcn_readlane(iv, 48)));
}
DEVI bf16x8 pack8(const f32x4& a, const f32x4& b) {
    u32x4 w; w.x = pk2(a[0], a[1]); w.y = pk2(a[2], a[3]); w.z = pk2(b[0], b[1]); w.w = pk2(b[2], b[3]);
    return __builtin_bit_cast(bf16x8, w);
}
#define MFMA16(a, b, c) __builtin_amdgcn_mfma_f32_16x16x32_bf16((a), (b), (c), 0, 0, 0)


#define XB_TMO      128
#define XB_XCNT(j)  (256  + 64 * (j))
#define XB_XSUB(j)  (1280 + 64 * (j))
#define XB_XGEN(j)  (2304 + 64 * (j))
#define XB_TOP      3328
#define XB_TOPGEN   3392
#define XCD_BAR_WORDS 3456
#define XB_SPIN_CAP (1u << 22)
DEVI unsigned xb_ld(unsigned* p)              { return __hip_atomic_load(p, __ATOMIC_RELAXED, __HIP_MEMORY_SCOPE_AGENT); }
DEVI unsigned xb_add(unsigned* p, unsigned v) { return __hip_atomic_fetch_add(p, v, __ATOMIC_RELAXED, __HIP_MEMORY_SCOPE_AGENT); }
DEVI unsigned xb_xcc_id() { return (unsigned)__builtin_amdgcn_s_getreg((3 << 11) | 20) & 0xFu; }
#define XB_SPIN(cond, bar) do { unsigned _sp = 0; while (cond) { __builtin_amdgcn_s_sleep(1); \
    if ((++_sp & 255u) == 0u) { if (xb_ld(&(bar)[XB_TMO])) break; if (_sp > XB_SPIN_CAP) { atomicAdd(&(bar)[XB_TMO], 1u); break; } } } } while (0)
struct XcdBarrier { unsigned* bar; unsigned x; volatile LAS unsigned* st; };
DEVI XcdBarrier xcd_barrier_post(unsigned* bar, volatile LAS unsigned* st) {
    XcdBarrier b; b.bar = bar; b.x = xb_xcc_id(); b.st = st;
    if (threadIdx.x == 0) (void)xb_add(&bar[XB_XCNT(b.x)], 1u);
    return b;
}
DEVI void xcd_barrier_complete(unsigned* bar, unsigned x, unsigned& nloc, unsigned& nx) {
    const unsigned G = gridDim.x * gridDim.y * gridDim.z;
    unsigned sum, cnt, mine, sp = 0u;
    for (;;) {
        sum = 0u; cnt = 0u; mine = 0u;
#pragma unroll
        for (unsigned j = 0; j < 16; ++j) { const unsigned c = xb_ld(&bar[XB_XCNT(j)]); sum += c; cnt += (c > 0u) ? 1u : 0u; mine = (j == x) ? c : mine; }
        if (sum == G) break;
        __builtin_amdgcn_s_sleep(1);
        if ((++sp & 255u) == 0u) { if (xb_ld(&bar[XB_TMO])) break; if (sp > XB_SPIN_CAP) { atomicAdd(&bar[XB_TMO], 1u); break; } }
    }
    nloc = mine > 0u ? mine : 1u; nx = cnt > 0u ? cnt : 1u;
}
DEVI void xcd_barrier(const XcdBarrier& b) {
    asm volatile("s_waitcnt vmcnt(0)" ::: "memory");
    __syncthreads();
    if (threadIdx.x == 0) {
        unsigned* bar = b.bar;
        __builtin_amdgcn_s_waitcnt(0);
        unsigned nloc = b.st[0], nx = b.st[1];
        if (nloc == 0u) { xcd_barrier_complete(bar, b.x, nloc, nx); b.st[0] = nloc; b.st[1] = nx; }
        const unsigned old = xb_add(&bar[XB_XSUB(b.x)], 1u);
        const unsigned gen = old / nloc;
        if (old + 1u == (gen + 1u) * nloc) {
            __builtin_amdgcn_fence(__ATOMIC_RELEASE, "agent");
            asm volatile("s_waitcnt vmcnt(0)" ::: "memory");
            const unsigned og = xb_add(&bar[XB_TOP], 1u);
            const unsigned tg = og / nx;
            if (og + 1u == (tg + 1u) * nx) xb_add(&bar[XB_TOPGEN], 1u);
            else XB_SPIN(xb_ld(&bar[XB_TOPGEN]) == tg, bar);
            __builtin_amdgcn_fence(__ATOMIC_ACQUIRE, "agent");
            xb_add(&bar[XB_XGEN(b.x)], 1u);
            asm volatile("s_waitcnt vmcnt(0)" ::: "memory");
        } else {
            XB_SPIN(xb_ld(&bar[XB_XGEN(b.x)]) == gen, bar);
            __builtin_amdgcn_fence(__ATOMIC_ACQUIRE, "agent");
            asm volatile("s_waitcnt vmcnt(0)" ::: "memory");
        }
    }
    __syncthreads();
}

typedef __amdgpu_buffer_rsrc_t rsrc_t;
DEVI u32x4 bload16(rsrc_t r, unsigned voff, unsigned soff) { return __builtin_bit_cast(u32x4, __builtin_amdgcn_raw_buffer_load_b128(r, (int)voff, (int)soff, 0)); }
DEVI void glds16(rsrc_t r, unsigned char* lds_dst_uniform, unsigned voff, unsigned soff) {
    __builtin_amdgcn_raw_ptr_buffer_load_lds(r, (LAS void*)lds_dst_uniform, 16, (int)voff, (int)soff, 0, 0);
}
template <class FA, class FB>
DEVI void gemm128(f32x4 (&acc)[4][4], rsrc_t rs, unsigned sA, const FA& offA, unsigned sB, const FB& offB, int nk, unsigned char* lds, int tid) {
    const int lane = tid & 63, wid = __builtin_amdgcn_readfirstlane(tid >> 6), wr = wid >> 1, wc = wid & 1;
    const int lr = tid >> 3;
    const unsigned csrc = (unsigned)(((lane & 7) ^ ((lane >> 3) & 7)) << 4);
    unsigned oa[4], ob[4];
#pragma unroll
    for (int i = 0; i < 4; ++i) { oa[i] = offA(lr + 32 * i) + csrc; ob[i] = offB(lr + 32 * i) + csrc; }
#pragma unroll
    for (int m = 0; m < 4; ++m)
#pragma unroll
        for (int n = 0; n < 4; ++n) acc[m][n] = (f32x4){0.f, 0.f, 0.f, 0.f};
    const int q = lane >> 4, r16 = lane & 15;
    const int roffA0 = (wr * 64 + r16) * 128 + (((0 + q) ^ (lane & 7)) << 4);
    const int roffA1 = (wr * 64 + r16) * 128 + (((4 + q) ^ (lane & 7)) << 4);
    const int roffB0 = 16384 + (wc * 64 + r16) * 128 + (((0 + q) ^ (lane & 7)) << 4);
    const int roffB1 = 16384 + (wc * 64 + r16) * 128 + (((4 + q) ^ (lane & 7)) << 4);
    unsigned char* wbase = lds + wid * 1024;
#pragma unroll
    for (int i = 0; i < 4; ++i) { glds16(rs, wbase + i * 4096, oa[i], sA); glds16(rs, wbase + 16384 + i * 4096, ob[i], sB); }
    for (int kt = 0; kt < nk; ++kt) {
        unsigned char* cur = lds + (kt & 1) * 32768;
        __syncthreads();
        if (kt + 1 < nk) {
            unsigned char* nb = wbase + ((kt + 1) & 1) * 32768;
#pragma unroll
            for (int i = 0; i < 4; ++i) { glds16(rs, nb + i * 4096, oa[i], sA + (kt + 1) * 128); glds16(rs, nb + 16384 + i * 4096, ob[i], sB + (kt + 1) * 128); }
        }
        bf16x8 a0[4], b0[4], a1[4], b1[4];
#pragma unroll
        for (int m = 0; m < 4; ++m) a0[m] = *(const bf16x8*)(cur + roffA0 + m * 2048);
#pragma unroll
        for (int n = 0; n < 4; ++n) b0[n] = *(const bf16x8*)(cur + roffB0 + n * 2048);
#pragma unroll
        for (int m = 0; m < 4; ++m) a1[m] = *(const bf16x8*)(cur + roffA1 + m * 2048);
#pragma unroll
        for (int n = 0; n < 4; ++n) b1[n] = *(const bf16x8*)(cur + roffB1 + n * 2048);
#pragma unroll
        for (int m = 0; m < 4; ++m)
#pragma unroll
            for (int n = 0; n < 4; ++n) acc[m][n] = MFMA16(b0[n], a0[m], acc[m][n]);
#pragma unroll
        for (int m = 0; m < 4; ++m)
#pragma unroll
            for (int n = 0; n < 4; ++n) acc[m][n] = MFMA16(b1[n], a1[m], acc[m][n]);
    }
    __syncthreads();
}

DEVI bool tile_map(int k, int ncol, int& mt, int& nt) {
    if (gridDim.x == 512) {
        const int x = blockIdx.x & 7, j = blockIdx.x >> 3;
        const int v = j + 64 * k;
        if (v >= 32 * ncol) return false;
        const int nfull = ncol >> 3, rem = ncol & 7;
        int mtl;
        if (v < nfull * 256) { const int cg = v >> 8, w = v & 255; mtl = (w >> 6) * 8 + ((w & 63) >> 3); nt = cg * 8 + (w & 7); }
        else { const int v2 = v - nfull * 256, per = 8 * rem; const int rg = v2 / per, w = v2 % per; mtl = rg * 8 + w / rem; nt = nfull * 8 + w % rem; }
        mt = x * 32 + mtl;
        return true;
    }
    const int u = blockIdx.x + gridDim.x * k;
    if (u >= 256 * ncol) return false;
    mt = u / ncol; nt = u % ncol;
    return true;
}
struct RowLin { unsigned ldb; DEVI unsigned operator()(int r) const { return (unsigned)r * ldb; } };

DEVI int win_map(int j) {
    if (j < 896) return j;
    if (j < 1408) return j - 896 + 936;
    if (j < 2176) return j - 1408 + 1448;
    if (j < 2208) return j - 2176 + 896;
    if (j < 2216) return j - 2208 + 928;
    if (j < 2240) return j;
    if (j < 2304) return -1;
    return j - 64;
}

struct TJob { const float* src; bf16_t* dst; int K, ld, nrows, perm, nb; size_t sb, db; };
DEVI TJob get_tjob(const Params& P, int j) {
    unsigned char* ws = P.ws;
    switch (j) {
        case 0: return TJob{P.in[3], (bf16_t*)(ws + OFF_WIN_T), 1024, INW, WIN_ROWS, 1, 1, 0, 0};
        case 1: return TJob{P.in[10], (bf16_t*)(ws + OFF_WBRA), 512, 1024, 1024, 0, 1, 0, 0};
        case 2: return TJob{P.in[11], (bf16_t*)(ws + OFF_WBRB), 512, 1024, 1024, 0, 1, 0, 0};
        case 3: return TJob{P.in[12], (bf16_t*)(ws + OFF_WOUT), 1024, 1024, 1024, 0, 1, 0, 0};
        case 4: return TJob{P.in[5], (bf16_t*)(ws + OFF_W1K), 2048, 128, 128, 0, 1, 0, 0};
        case 5: return TJob{P.in[8], (bf16_t*)(ws + OFF_W1V), 2048, 128, 128, 0, 1, 0, 0};
        case 6: return TJob{P.in[6], (bf16_t*)(ws + OFF_W2K), 128, 64, 64, 0, 1, 0, 0};
        case 7: return TJob{P.in[9], (bf16_t*)(ws + OFF_W2V), 128, 64, 64, 0, 1, 0, 0};
        case 8: return TJob{P.in[18], (bf16_t*)(ws + OFF_WGU), 1024, 512, 512, 0, 32, (size_t)1024 * 512, (size_t)512 * 1024};
        default: return TJob{P.in[19], (bf16_t*)(ws + OFF_WDN), 256, 1024, 1024, 0, 32, (size_t)256 * 1024, (size_t)1024 * 256};
    }
}
DEVI int tjob_tiles(int j) {
    switch (j) {
        case 0: return (WIN_ROWS / 64) * 16;
        case 1: case 2: return 16 * 8;
        case 3: return 16 * 16;
        case 4: case 5: return 2 * 32;
        case 6: case 7: return 1 * 2;
        case 8: return 32 * 8 * 16;
        default: return 32 * 16 * 4;
    }
}

DEVI void transpose_tile(const TJob& J, int tile, unsigned char* lds, int tid) {
    float* T = (float*)lds;
    const int kt = J.K / 64, rt = J.nrows / 64;
    const int b = tile / (kt * rt), rem = tile % (kt * rt);
    const int r0 = (rem / kt) * 64, k0 = (rem % kt) * 64;
    const float* src = J.src + (size_t)b * J.sb;
    bf16_t* dst = J.dst + (size_t)b * J.db;
    const int n4 = (tid & 15) * 4;
    int col = r0 + n4; if (J.perm) col = win_map(col);
    f32x4 ld4[4];
#pragma unroll
    for (int i = 0; i < 4; ++i) {
        const int kk = (tid >> 4) + 16 * i;
        ld4[i] = (col >= 0) ? *(const f32x4*)(src + (size_t)(k0 + kk) * J.ld + col) : (f32x4){0.f, 0.f, 0.f, 0.f};
    }
#pragma unroll
    for (int i = 0; i < 4; ++i) {
        const int kk = (tid >> 4) + 16 * i;
#pragma unroll
        for (int e = 0; e < 4; ++e) T[kk * 65 + n4 + e] = ld4[i][e];
    }
    __syncthreads();
    const int r2 = tid >> 2, ks = (tid & 3) * 16;
    u32x4 w0, w1;
    w0.x = pk2(T[(ks + 0) * 65 + r2], T[(ks + 1) * 65 + r2]); w0.y = pk2(T[(ks + 2) * 65 + r2], T[(ks + 3) * 65 + r2]);
    w0.z = pk2(T[(ks + 4) * 65 + r2], T[(ks + 5) * 65 + r2]); w0.w = pk2(T[(ks + 6) * 65 + r2], T[(ks + 7) * 65 + r2]);
    w1.x = pk2(T[(ks + 8) * 65 + r2], T[(ks + 9) * 65 + r2]); w1.y = pk2(T[(ks + 10) * 65 + r2], T[(ks + 11) * 65 + r2]);
    w1.z = pk2(T[(ks + 12) * 65 + r2], T[(ks + 13) * 65 + r2]); w1.w = pk2(T[(ks + 14) * 65 + r2], T[(ks + 15) * 65 + r2]);
    bf16_t* d = dst + (size_t)(r0 + r2) * J.K + k0 + ks;
    *(u32x4*)d = w0; *(u32x4*)(d + 8) = w1;
    __syncthreads();
}

DEVI void rms_row_bf16(const float* xr, const float* g, bf16_t* o, int lane) {
    f32x4 v[4]; float ss = 0.f;
#pragma unroll
    for (int i = 0; i < 4; ++i) { v[i] = *(const f32x4*)(xr + i * 256 + lane * 4); ss += v[i][0] * v[i][0] + v[i][1] * v[i][1] + v[i][2] * v[i][2] + v[i][3] * v[i][3]; }
    ss = wave_sum(ss);
    const float rs = rsqrtf(ss * (1.0f / 1024.0f) + RMS_EPS);
#pragma unroll
    for (int i = 0; i < 4; ++i) {
        const f32x4 gg = *(const f32x4*)(g + i * 256 + lane * 4);
        u32x2 w; w.x = pk2(v[i][0] * rs * gg[0], v[i][1] * rs * gg[1]); w.y = pk2(v[i][2] * rs * gg[2], v[i][3] * rs * gg[3]);
        *(u32x2*)(o + i * 256 + lane * 4) = w;
    }
}

DEVI void phase_prep(const Params& P, unsigned char* lds, int tid) {
    unsigned char* ws = P.ws;
    const int lane = tid & 63, wid = __builtin_amdgcn_readfirstlane(tid >> 6);
    if (blockIdx.x == 0) {
        if (tid < 64) ((unsigned*)(ws + OFF_CTL))[tid] = 0u;
        for (int i = tid; i < XCD_BAR_WORDS; i += NTHREADS) ((unsigned*)(ws + OFF_BAR))[i] = 0u;
    }
    int base = 0;
    for (int j = 0; j < 10; ++j) {
        const int nt = tjob_tiles(j);
        const TJob J = get_tjob(P, j);
        for (int t = blockIdx.x; t < nt; t += gridDim.x) transpose_tile(J, t, lds, tid);
        base += nt;
    }
    {
        const float* x = P.in[0]; const float* g = P.in[2]; bf16_t* hn = (bf16_t*)(ws + OFF_HN);
        for (int r = blockIdx.x * 4 + wid; r < NTOK; r += gridDim.x * 4) rms_row_bf16(x + (size_t)r * 1024, g, hn + (size_t)r * 1024, lane);
    }
    {
        f32x2* cs = (f32x2*)(ws + OFF_CS);
        for (int e = blockIdx.x * NTHREADS + tid; e < NTOK * 32; e += gridDim.x * NTHREADS) {
            const int tok = e >> 5, i = e & 31;
            const double a = (double)P.pos[tok] * P.inv_freq[i];
            double t = a * 0.15915494309189535;
            t -= floor(t);
            const float tf = (float)t;
            cs[e] = (f32x2){__builtin_amdgcn_cosf(tf), __builtin_amdgcn_sinf(tf)};
        }
    }
    {
        float* wr = (float*)(ws + OFF_WR);
        const float* g = P.in[13]; const float* wg = P.in[14]; const float* we = P.in[16];
        for (int e = blockIdx.x * NTHREADS + tid; e < 48 * 1024; e += gridDim.x * NTHREADS) {
            const int c = e >> 10, k = e & 1023;
            float v = 0.f;
            if (c < 4) v = wg[k * 4 + c]; else if (c < 36) v = we[k * 32 + (c - 4)];
            wr[e] = v * g[k];
        }
    }
    {
        float* red = (float*)lds;
        for (int job = blockIdx.x; job < 32; job += gridDim.x) {
            const int kv = job >> 4, cg8 = job & 15;
            const float* pe = P.in[kv ? 7 : 4]; const float* w1 = P.in[kv ? 8 : 5];
            const int cc = tid & 7, jj = tid >> 3;
            float s = 0.f;
            for (int j = jj; j < 2048; j += 32) s += pe[j] * w1[(size_t)j * 128 + cg8 * 8 + cc];
            red[tid] = s;
            __syncthreads();
            if (tid < 8) { float t = 0.f; for (int u = 0; u < 32; ++u) t += red[u * 8 + tid]; ((float*)(ws + OFF_BIAS1))[kv * 128 + cg8 * 8 + tid] = t; }
            __syncthreads();
        }
    }
}

DEVI void st_bf16(bf16_t* p, float v) { *p = (bf16_t)f2bf(v); }

DEVI void phase_gemm1(const Params& P, unsigned char* lds, int tid) {
    unsigned char* ws = P.ws;
    const rsrc_t rs = __builtin_amdgcn_make_buffer_rsrc((void*)P.ws, (short)0, (int)0x7fffffff, 0x00020000);
    const bf16_t* hn = (const bf16_t*)(ws + OFF_HN);
    const bf16_t* wt = (const bf16_t*)(ws + OFF_WIN_T);
    const f32x2* cs = (const f32x2*)(ws + OFF_CS);
    const int lane = tid & 63, wid = __builtin_amdgcn_readfirstlane(tid >> 6), wr = wid >> 1, wc = wid & 1, q = lane >> 4, cl = lane & 15;
    constexpr int NT_N = G1_COLS / 128;
    for (int kk = 0;; ++kk) {
        int mt, nt;
        if (!tile_map(kk, NT_N, mt, nt)) break;
        f32x4 acc[4][4];
        gemm128(acc, rs, (unsigned)(OFF_HN + (size_t)mt * 128 * 2048), RowLin{2048}, (unsigned)(OFF_WIN_T + (size_t)nt * 128 * 2048), RowLin{2048}, 16, lds, tid);
        const int c64 = nt * 2 + wc;
        const int tok0 = mt * 128 + wr * 64 + cl;
        if (c64 < 10 || (c64 >= 14 && c64 < 34)) {
            bool do_rope; float scale = 1.f; int kind;
            int g = 0, hk = 0;
            if (c64 < 8) { kind = 0; do_rope = true; scale = 0.125f * LOG2E; }
            else if (c64 == 8) { kind = 1; do_rope = true; }
            else if (c64 == 9) { kind = 2; do_rope = false; }
            else if (c64 < 22) { kind = 3; do_rope = true; scale = 0.125f * LOG2E; }
            else { kind = 4; g = (c64 - 22) >> 1; hk = (c64 - 22) & 1; do_rope = (g == 2 || g == 4); }
#pragma unroll
            for (int m = 0; m < 4; ++m) {
                const int tok = tok0 + m * 16;
                f32x4 o[4], nr[4];
#pragma unroll
                for (int n = 0; n < 4; ++n) { nr[n] = acc[m][n] * scale; o[n] = nr[n]; }
                if (do_rope) {
#pragma unroll
                    for (int n = 0; n < 2; ++n) {
                        const f32x4 c01 = *(const f32x4*)(cs + (size_t)tok * 32 + n * 16 + q * 4);
                        const f32x4 c23 = *(const f32x4*)(cs + (size_t)tok * 32 + n * 16 + q * 4 + 2);
                        const float cc[4] = {c01[0], c01[2], c23[0], c23[2]}, sn[4] = {c01[1], c01[3], c23[1], c23[3]};
#pragma unroll
                        for (int j = 0; j < 4; ++j) {
                            const float x1 = nr[n][j], x2 = nr[n + 2][j];
                            o[n][j] = x1 * cc[j] - x2 * sn[j]; o[n + 2][j] = x1 * sn[j] + x2 * cc[j];
                        }
                    }
                }
                if (kind == 0 || kind == 1 || kind == 2) {
                    bf16_t* d = (kind == 0) ? (bf16_t*)(ws + OFF_QA) + (size_t)tok * 512 + c64 * 64 : (bf16_t*)(ws + (kind == 1 ? OFF_KA : OFF_VA)) + (size_t)tok * 64;
#pragma unroll
                    for (int n = 0; n < 4; ++n) { u32x2 w; w.x = pk2(o[n][0], o[n][1]); w.y = pk2(o[n][2], o[n][3]); *(u32x2*)(d + n * 16 + q * 4) = w; }
                } else if (kind == 3) {
                    const int h = c64 - 14;
                    bf16_t* dn = (bf16_t*)(ws + OFF_QBN) + (size_t)tok * 512 + h * 64; bf16_t* dr = (bf16_t*)(ws + OFF_QBR) + (size_t)tok * 512 + h * 64;
#pragma unroll
                    for (int n = 0; n < 4; ++n) {
                        u32x2 w; w.x = pk2(nr[n][0], nr[n][1]); w.y = pk2(nr[n][2], nr[n][3]); *(u32x2*)(dn + n * 16 + q * 4) = w;
                        u32x2 v; v.x = pk2(o[n][0], o[n][1]); v.y = pk2(o[n][2], o[n][3]); *(u32x2*)(dr + n * 16 + q * 4) = v;
                    }
                } else {
                    bf16_t* d = (bf16_t*)(ws + OFF_KV + (size_t)g * KV_STRIDE);
                    const int b = tok >> 12, tl = tok & 4095;
                    if (g == 3 || g == 5) {
#pragma unroll
                        for (int n = 0; n < 4; ++n)
#pragma unroll
                            for (int j = 0; j < 4; ++j) st_bf16(d + ((size_t)((b * 2 + hk) * 64 + n * 16 + q * 4 + j)) * 4096 + tl, o[n][j]);
                    } else {
#pragma unroll
                        for (int n = 0; n < 4; ++n) { u32x2 w; w.x = pk2(o[n][0], o[n][1]); w.y = pk2(o[n][2], o[n][3]);
                            *(u32x2*)(d + ((size_t)((b * 2 + hk) * 4096 + tl)) * 64 + n * 16 + q * 4) = w; }
                    }
                }
            }
        } else if (c64 >= 10 && c64 < 14) {
            bf16_t* d = (bf16_t*)(ws + OFF_QI);
#pragma unroll
            for (int m = 0; m < 4; ++m) {
                const int tok = tok0 + m * 16;
                float cc[4], sn[4];
#pragma unroll
                for (int j = 0; j < 4; ++j) { const f32x2 c = cs[(size_t)tok * 32 + 2 * (4 * q + j)]; cc[j] = c.x; sn[j] = c.y; }
#pragma unroll
                for (int hh = 0; hh < 2; ++hh) {
                    const int head = 2 * (c64 - 10) + hh;
                    f32x4 r1, r2;
#pragma unroll
                    for (int j = 0; j < 4; ++j) { const float x1 = acc[m][2 * hh][j], x2 = acc[m][2 * hh + 1][j]; r1[j] = x1 * cc[j] - x2 * sn[j]; r2[j] = x1 * sn[j] + x2 * cc[j]; }
                    u32x2 w; w.x = pk2(r1[0], r1[1]); w.y = pk2(r1[2], r1[3]); *(u32x2*)(d + (size_t)tok * 256 + head * 32 + q * 4) = w;
                    u32x2 v; v.x = pk2(r2[0], r2[1]); v.y = pk2(r2[2], r2[3]); *(u32x2*)(d + (size_t)tok * 256 + head * 32 + 16 + q * 4) = v;
                }
            }
        } else if (c64 >= 36) {
            bf16_t* d = (bf16_t*)(ws + (c64 < 52 ? OFF_GA : OFF_GB));
            const int cb = (c64 < 52 ? c64 - 36 : c64 - 52) * 64;
#pragma unroll
            for (int m = 0; m < 4; ++m)
#pragma unroll
                for (int n = 0; n < 4; ++n) {
                    u32x2 w; w.x = pk2(sigmoidf_(acc[m][n][0]), sigmoidf_(acc[m][n][1])); w.y = pk2(sigmoidf_(acc[m][n][2]), sigmoidf_(acc[m][n][3]));
                    *(u32x2*)(d + (size_t)(tok0 + m * 16) * 1024 + cb + n * 16 + q * 4) = w;
                }
        } else if (c64 == 34) {
            bf16_t* dki = (bf16_t*)(ws + OFF_KI); float* dwi = (float*)(ws + OFF_WI); float* dg = (float*)(ws + OFF_GATES);
#pragma unroll
            for (int m = 0; m < 4; ++m) {
                const int tok = tok0 + m * 16;
                f32x4 r1, r2;
#pragma unroll
                for (int j = 0; j < 4; ++j) {
                    const f32x2 c = cs[(size_t)tok * 32 + 2 * (4 * q + j)];
                    const float x1 = acc[m][0][j], x2 = acc[m][1][j];
                    r1[j] = x1 * c.x - x2 * c.y; r2[j] = x1 * c.y + x2 * c.x;
                }
                u32x2 w; w.x = pk2(r1[0], r1[1]); w.y = pk2(r1[2], r1[3]); *(u32x2*)(dki + (size_t)tok * 32 + q * 4) = w;
                u32x2 v; v.x = pk2(r2[0], r2[1]); v.y = pk2(r2[2], r2[3]); *(u32x2*)(dki + (size_t)tok * 32 + 16 + q * 4) = v;
                if (q < 2) *(f32x4*)(dwi + (size_t)tok * 8 + q * 4) = acc[m][2];
                else { f32x4 sv; for (int j = 0; j < 4; ++j) sv[j] = sigmoidf_(acc[m][2][j]); *(f32x4*)(dg + (size_t)tok * 24 + (q * 4 - 8)) = sv; }
                { f32x4 sv; for (int j = 0; j < 4; ++j) sv[j] = sigmoidf_(acc[m][3][j]); *(f32x4*)(dg + (size_t)tok * 24 + 8 + q * 4) = sv; }
            }
        }
    }
}

DEVI float siluf_(float x) { return x * __builtin_amdgcn_rcpf(1.0f + __builtin_amdgcn_exp2f(-x * 1.4426950408889634f)); }

DEVI void phase_compress(const Params& P, unsigned char* lds, int tid) {
    unsigned char* ws = P.ws;
    const rsrc_t rs = __builtin_amdgcn_make_buffer_rsrc((void*)P.ws, (short)0, (int)0x7fffffff, 0x00020000);
    const int lane = tid & 63, wid = __builtin_amdgcn_readfirstlane(tid >> 6), wr = wid >> 1, wc = wid & 1, q = lane >> 4, cl = lane & 15;
    for (int u = blockIdx.x; u < 64; u += gridDim.x) {
        const int kv = u >> 5, mt = u & 31;
        const bf16_t* A = (const bf16_t*)(ws + OFF_KV + (size_t)kv * KV_STRIDE) + (size_t)mt * 128 * 1024;
        const bf16_t* W1 = (const bf16_t*)(ws + (kv ? OFF_W1V : OFF_W1K));
        const bf16_t* W2 = (const bf16_t*)(ws + (kv ? OFF_W2V : OFF_W2K));
        const float* bias = (const float*)(ws + OFF_BIAS1) + kv * 128;
        f32x4 acc[4][4];
        gemm128(acc, rs, (unsigned)(OFF_KV + (size_t)kv * KV_STRIDE + (size_t)mt * 128 * 2048), RowLin{2048}, (unsigned)(kv ? OFF_W1V : OFF_W1K), RowLin{4096}, 32, lds, tid);
#pragma unroll
        for (int m = 0; m < 4; ++m)
#pragma unroll
            for (int n = 0; n < 4; ++n) {
                const int col = wc * 64 + n * 16 + q * 4, row = wr * 64 + m * 16 + cl;
                const f32x4 bb = *(const f32x4*)(bias + col);
                const int ktile = col >> 6, ch = (col & 63) >> 3, wi = col & 7;
                u32x2 w; w.x = pk2(siluf_(acc[m][n][0] + bb[0]), siluf_(acc[m][n][1] + bb[1])); w.y = pk2(siluf_(acc[m][n][2] + bb[2]), siluf_(acc[m][n][3] + bb[3]));
                *(u32x2*)(lds + ktile * 16384 + row * 128 + ((ch ^ (row & 7)) << 4) + wi * 2) = w;
            }
#pragma unroll
        for (int i = 0; i < 4; ++i) {
            const int idx = tid + 256 * i;
            const int row = idx >> 4, ch16 = idx & 15, ktile = ch16 >> 3, ch = ch16 & 7;
            *(u32x4*)(lds + 32768 + ktile * 8192 + row * 128 + ((ch ^ (row & 7)) << 4)) = *(const u32x4*)(W2 + (size_t)row * 128 + ch16 * 8);
        }
        __syncthreads();
        f32x4 a2[4][2];
#pragma unroll
        for (int m = 0; m < 4; ++m) { a2[m][0] = (f32x4){0.f, 0.f, 0.f, 0.f}; a2[m][1] = (f32x4){0.f, 0.f, 0.f, 0.f}; }
#pragma unroll
        for (int kk = 0; kk < 4; ++kk) {
            const int ktile = kk >> 1, ks = kk & 1;
            bf16x8 a[4], b[2];
#pragma unroll
            for (int m = 0; m < 4; ++m) { const int row = wr * 64 + m * 16 + cl; a[m] = *(const bf16x8*)(lds + ktile * 16384 + row * 128 + (((ks * 4 + q) ^ (row & 7)) << 4)); }
#pragma unroll
            for (int n = 0; n < 2; ++n) { const int row = wc * 32 + n * 16 + cl; b[n] = *(const bf16x8*)(lds + 32768 + ktile * 8192 + row * 128 + (((ks * 4 + q) ^ (row & 7)) << 4)); }
#pragma unroll
            for (int m = 0; m < 4; ++m)
#pragma unroll
                for (int n = 0; n < 2; ++n) a2[m][n] = MFMA16(b[n], a[m], a2[m][n]);
        }
#pragma unroll
        for (int m = 0; m < 4; ++m)
#pragma unroll
            for (int n = 0; n < 2; ++n) {
                const int d = wc * 32 + n * 16 + q * 4;
                const int r = mt * 128 + wr * 64 + m * 16 + cl;
                const bool dead = ((r & 255) == 255);
                float v[4];
#pragma unroll
                for (int j = 0; j < 4; ++j) v[j] = dead ? 0.f : a2[m][n][j];
                if (kv == 0) {
                    bf16_t* kc = (bf16_t*)(ws + OFF_KC);
                    u32x2 w; w.x = pk2(v[0], v[1]); w.y = pk2(v[2], v[3]);
                    *(u32x2*)(kc + (size_t)r * 64 + d) = w;
                } else {
                    bf16_t* vct = (bf16_t*)(ws + OFF_VCT);
#pragma unroll
                    for (int j = 0; j < 4; ++j) st_bf16(vct + ((size_t)((r >> 8) * 64 + d + j)) * 256 + (r & 255), v[j]);
                }
            }
        __syncthreads();
    }
}

DEVI void phase_index(const Params& P, unsigned char* lds, int tid) {
    unsigned char* ws = P.ws;
    const bf16_t* QI = (const bf16_t*)(ws + OFF_QI);
    const bf16_t* KI = (const bf16_t*)(ws + OFF_KI);
    const float* WI = (const float*)(ws + OFF_WI);
    bf16_t* SEL = (bf16_t*)(ws + OFF_SEL);
    float* S = (float*)lds;
    const int lane = tid & 63, wid = __builtin_amdgcn_readfirstlane(tid >> 6), q = lane >> 4, cl = lane & 15;
    for (int u = blockIdx.x; u < NTOK / 4; u += gridDim.x) {
        const int b = u >> 10, w10 = u & 1023, s10 = (w10 < 512) ? w10 : 1535 - w10;
        const int t0 = s10 * 4, tok0 = b * 4096 + t0;
        const int t = t0 + wid;
        const int tok = tok0 + wid;
        if (t0 + 3 < 256) {
            for (int i = lane; i < 256; i += 64) SEL[(size_t)tok * 256 + i] = (bf16_t)(i <= t ? i : 0);
            continue;
        }
        {
            bf16x8 a[2];
#pragma unroll
            for (int hg = 0; hg < 2; ++hg) a[hg] = *(const bf16x8*)(QI + (size_t)(tok0 + (cl >> 2)) * 256 + (4 * hg + (cl & 3)) * 32 + q * 8);
            const f32x4 w0 = *(const f32x4*)(WI + (size_t)(tok0 + q) * 8), w1 = *(const f32x4*)(WI + (size_t)(tok0 + q) * 8 + 4);
            const int ktmax = (t0 + 3) >> 4;
            const bf16_t* kb = KI + (size_t)b * 4096 * 32 + cl * 32 + q * 8;
            for (int rep31 = 0; rep31 < REPS(31); ++rep31)
            for (int kt0 = wid; kt0 <= ktmax; kt0 += 16) {
                bf16x8 bk[4];
#pragma unroll
                for (int uu = 0; uu < 4; ++uu) { const int kt = (kt0 + 4 * uu <= ktmax) ? kt0 + 4 * uu : kt0; bk[uu] = *(const bf16x8*)(kb + (size_t)kt * 16 * 32); }
#pragma unroll
                for (int uu = 0; uu < 4; ++uu) {
                    const int kt = kt0 + 4 * uu;
                    f32x4 c0 = {0.f, 0.f, 0.f, 0.f}, c1 = {0.f, 0.f, 0.f, 0.f};
                    c0 = MFMA16(a[0], bk[uu], c0); c1 = MFMA16(a[1], bk[uu], c1);
                    float sc = 0.f;
#pragma unroll
                    for (int j = 0; j < 4; ++j) { sc += w0[j] * fmaxf(c0[j], 0.f); sc += w1[j] * fmaxf(c1[j], 0.f); }
                    if (kt <= ktmax) S[q * 4096 + kt * 16 + cl] = sc;
                }
            }
        }
        __syncthreads();
        {
            const int n = t + 1;
            const float* Sq = S + wid * 4096;
            if (n <= 256) {
                for (int i = lane; i < 256; i += 64) SEL[(size_t)tok * 256 + i] = (bf16_t)(i <= t ? i : 0);
            } else {
                const int nr = (n + 63) >> 6;
                float x[64];
                const float NINF = -__builtin_inff();
                float mx = NINF, mn = __builtin_inff();
#pragma unroll
                for (int r = 0; r < 64; ++r) {
                    const int key = r * 64 + lane;
                    const float v = Sq[key];
                    x[r] = (key < n) ? v : NINF;
                    mn = fminf(mn, (key < n) ? v : __builtin_inff());
                    mx = fmaxf(mx, x[r]);
                }
#pragma unroll
                for (int o = 32; o > 0; o >>= 1) { mx = fmaxf(mx, __shfl_xor(mx, o)); mn = fminf(mn, __shfl_xor(mn, o)); }
                float lo = mn, hi = mx, T; int need;
                int chi, clo = n;
                for (int rep32 = 0; rep32 < REPS(32); ++rep32) {
                lo = mn; hi = mx; clo = n;
                {
                    int c = 0;
#pragma unroll
                    for (int g8 = 0; g8 < 8; ++g8) if (g8 * 8 < nr) {
#pragma unroll
                        for (int r = g8 * 8; r < g8 * 8 + 8; ++r) c += (x[r] >= hi) ? 1 : 0;
                    }
                    chi = wave_sum_i32(c);
                }
                if (chi >= 256) { T = hi; need = 256;   }
                else {
                    float s1 = 0.f, s2 = 0.f;
#pragma unroll
                    for (int g8 = 0; g8 < 8; ++g8) if (g8 * 8 < nr) {
#pragma unroll
                        for (int r = g8 * 8; r < g8 * 8 + 8; ++r) { const float v = (x[r] == NINF) ? 0.f : x[r]; s1 += v; s2 += v * v; }
                    }
                    s1 = wave_sum_f32_dpp(s1); s2 = wave_sum_f32_dpp(s2);
                    const float fn = (float)n, mu = s1 / fn;
                    const float sg = sqrtf(fmaxf(s2 / fn - mu * mu, 1e-20f));
                    float vg;
                    {
                        const float pq = 256.0f / fn, pp = fminf(pq, 1.0f - pq);
                        const float tt = sqrtf(-2.0f * __logf(fmaxf(pp, 1e-6f)));
                        const float zz = tt - (2.515517f + 0.802853f * tt + 0.010328f * tt * tt) / (1.0f + 1.432788f * tt + 0.189269f * tt * tt + 0.001308f * tt * tt * tt);
                        vg = mu + ((pq <= 0.5f) ? zz : -zz) * sg;
                    }
                    bool found = false, adjacent = false; float thr = 0.f;
                    for (int it = 0; it < 160; ++it) {
                        if (clo - chi <= 64) break;
                        const float mid = 0.5f * lo + 0.5f * hi;
                        if (!(mid > lo && mid < hi)) { adjacent = true; break; }
                        float v = vg;
                        if (!(v > lo && v < hi) || (it & 3) == 3) v = mid;
                        int c = 0;
#pragma unroll
                        for (int g8 = 0; g8 < 8; ++g8) if (g8 * 8 < nr) {
#pragma unroll
                            for (int r = g8 * 8; r < g8 * 8 + 8; ++r) c += (x[r] >= v) ? 1 : 0;
                        }
                        c = wave_sum_i32(c);
                        if (c == 256) { found = true; thr = v; break; }
                        if (c > 256) { lo = v; clo = c; } else { hi = v; chi = c; }
                        const float zv = (v - mu) / sg;
                        const float dens = fmaxf(fn * 0.39894228f * __expf(-0.5f * zv * zv), 0.5f) / sg;
                        vg = v + ((float)c - ((c > 256) ? 244.0f : 268.0f)) / dens;
                    }
                    if (found) { T = thr; need = -1; }
                    else if (adjacent) { T = lo; need = 256 - chi; }
                    else {
                        float* cand = (float*)(lds + 65536) + wid * 64;
                        cand[lane] = NINF;
                        int cb = 0;
                        const unsigned long long ltm = (1ull << lane) - 1ull;
#pragma unroll
                        for (int g8 = 0; g8 < 8; ++g8) if (g8 * 8 < nr) {
#pragma unroll
                            for (int r = g8 * 8; r < g8 * 8 + 8; ++r) {
                                const bool isc = (x[r] >= lo) && (x[r] < hi);
                                const unsigned long long bm = __ballot(isc);
                                if (isc) cand[cb + __popcll(bm & ltm)] = x[r];
                                cb += __popcll(bm);
                            }
                        }
                        const float y = cand[lane];
                        int cgt = 0, cge = 0;
#pragma unroll
                        for (int k = 0; k < 64; ++k) { const float yk = __builtin_bit_cast(float, __builtin_amdgcn_readlane(__builtin_bit_cast(int, y), k)); cgt += (yk > y) ? 1 : 0; cge += (yk >= y) ? 1 : 0; }
                        const int nd = 256 - chi;
                        const bool isT = (y != NINF) && (cgt <= nd - 1) && (cge >= nd);
                        const unsigned long long tm = __ballot(isT);
                        const int tl = (tm != 0ull) ? (int)__builtin_ctzll(tm) : 0;
                        T = __shfl(y, tl);
                        need = nd - __shfl(cgt, tl);
                    }
                }
                asm volatile("" : "+v"(mn), "+v"(mx));
                }
                for (int rep33 = 0; rep33 < REPS(33); ++rep33) {
                int base = 0, eqc = 0;
                const unsigned long long lt = (1ull << lane) - 1ull;
#pragma unroll
                for (int g8 = 0; g8 < 8; ++g8) if (g8 * 8 < nr) {
#pragma unroll
                    for (int r = g8 * 8; r < g8 * 8 + 8; ++r) {
                        bool sel;
                        if (need < 0) sel = x[r] >= T;
                        else {
                            const bool eq = (x[r] == T);
                            const unsigned long long em = __ballot(eq);
                            sel = (x[r] > T) || (eq && (eqc + __popcll(em & lt) < need));
                            eqc += __popcll(em);
                        }
                        const unsigned long long sm = __ballot(sel);
                        if (sel) { const int pp = base + __popcll(sm & lt); if (pp < 256) SEL[(size_t)tok * 256 + pp] = (bf16_t)(r * 64 + lane); }
                        base += __popcll(sm);
                    }
                }
                }
            }
        }
        __syncthreads();
    }
}

DEVI void phase_dsa(const Params& P, unsigned char* lds, int tid) {
    unsigned char* ws = P.ws;
    const bf16_t* QA = (const bf16_t*)(ws + OFF_QA);
    const bf16_t* KA = (const bf16_t*)(ws + OFF_KA);
    const bf16_t* VA = (const bf16_t*)(ws + OFF_VA);
    const bf16_t* SEL = (const bf16_t*)(ws + OFF_SEL);
    bf16_t* OA = (bf16_t*)(ws + OFF_OA);
    const int lane = tid & 63, wid = __builtin_amdgcn_readfirstlane(tid >> 6), q = lane >> 4, cl = lane & 15;
    unsigned char* vl = lds + wid * 8192;
    const float NINF = -__builtin_inff();
    for (int tok = blockIdx.x * 4 + wid; tok < NTOK; tok += gridDim.x * 4) {
        const int b = tok >> 12, t = tok & 4095;
        const int cnt = (t + 1 < 256) ? t + 1 : 256;
        const int nc64 = (cnt + 63) >> 6;
        const bf16_t* sel = SEL + (size_t)tok * 256;
        const bf16_t* kb = KA + (size_t)b * 4096 * 64;
        const bf16_t* vb = VA + (size_t)b * 4096 * 64;
        bf16x8 bq[2];
#pragma unroll
        for (int ks = 0; ks < 2; ++ks) {
            bq[ks] = (bf16x8){0, 0, 0, 0, 0, 0, 0, 0};
            if (cl < 8) bq[ks] = *(const bf16x8*)(QA + (size_t)tok * 512 + cl * 64 + ks * 32 + q * 8);
        }
        f32x4 s[16];
#pragma unroll
        for (int rf = 0; rf < 16; ++rf) {
            s[rf] = (f32x4){0.f, 0.f, 0.f, 0.f};
            if ((rf >> 2) < nc64) {
                const int p = 32 * (rf >> 1) + 8 * (cl >> 2) + 4 * (rf & 1) + (cl & 3);
                const int key = sel[p];
                const bf16_t* kr = kb + (size_t)key * 64 + q * 8;
                const bf16x8 a0 = *(const bf16x8*)(kr), a1 = *(const bf16x8*)(kr + 32);
                s[rf] = MFMA16(a0, bq[0], s[rf]); s[rf] = MFMA16(a1, bq[1], s[rf]);
            }
        }
        float mx = NINF;
#pragma unroll
        for (int rf = 0; rf < 16; ++rf)
#pragma unroll
            for (int j = 0; j < 4; ++j) {
                const int p = 32 * (rf >> 1) + 8 * q + 4 * (rf & 1) + j;
                if (p >= cnt) s[rf][j] = NINF;
                mx = fmaxf(mx, s[rf][j]);
            }
        mx = rows_max(mx);
        float ls = 0.f;
#pragma unroll
        for (int rf = 0; rf < 16; ++rf)
#pragma unroll
            for (int j = 0; j < 4; ++j) { const float pv = __builtin_amdgcn_exp2f(s[rf][j] - mx); s[rf][j] = pv; ls += pv; }
        ls = rows_sum(ls);
        const float inv = __builtin_amdgcn_rcpf(ls);
        f32x4 o[4];
#pragma unroll
        for (int d = 0; d < 4; ++d) o[d] = (f32x4){0.f, 0.f, 0.f, 0.f};
#pragma unroll
        for (int cc = 0; cc < 4; ++cc) {
            if (cc < nc64) {
                const int mykey = sel[cc * 64 + lane];
                __builtin_amdgcn_wave_barrier();
#pragma unroll
                for (int i = 0; i < 8; ++i) {
                    const int row = (lane >> 3) + 8 * i;
                    const int key = __shfl(mykey, row);
                    *(u32x4*)(vl + row * 128 + (lane & 7) * 16) = *(const u32x4*)(vb + (size_t)key * 64 + (lane & 7) * 8);
                }
                __builtin_amdgcn_wave_barrier();
#pragma unroll
                for (int c2 = 0; c2 < 2; ++c2) {
                    const bf16x8 pb = pack8(s[cc * 4 + c2 * 2], s[cc * 4 + c2 * 2 + 1]);
#pragma unroll
                    for (int d = 0; d < 4; ++d) {
                        LAS unsigned char* a0addr = (LAS unsigned char*)(vl) + (c2 * 32 + 8 * q + (cl >> 2)) * 128 + (d * 16 + 4 * (cl & 3)) * 2;
                        const s16x4 lo4 = __builtin_amdgcn_ds_read_tr16_b64_v4i16((LAS s16x4*)(a0addr));
                        const s16x4 hi4 = __builtin_amdgcn_ds_read_tr16_b64_v4i16((LAS s16x4*)(a0addr + 4 * 128));
                        const bf16x8 av = {lo4[0], lo4[1], lo4[2], lo4[3], hi4[0], hi4[1], hi4[2], hi4[3]};
                        o[d] = MFMA16(av, pb, o[d]);
                    }
                }
            }
        }
        if (cl < 8) {
#pragma unroll
            for (int d = 0; d < 4; ++d) {
                u32x2 w; w.x = pk2(o[d][0] * inv, o[d][1] * inv); w.y = pk2(o[d][2] * inv, o[d][3] * inv);
                *(u32x2*)(OA + (size_t)tok * 512 + cl * 64 + d * 16 + q * 4) = w;
            }
        }
    }
}

DEVI int fK(int row) { return (row & 3) | (((row >> 3) & 1) << 2); }

struct AttnState { f32x4 O[4][4]; float m[4]; float l[4]; };

template <int MODE>
DEVI void attn_blocks(rsrc_t rs, unsigned sK, unsigned sV, int ldv, int jb0, int jb1, const bf16x8 (&qf)[4][2], AttnState& st,
                      int tq, unsigned long long selmask, unsigned char* lds, int tid) {
    const int lane = tid & 63, q = lane >> 4, cl = lane & 15;
    const float NINF = -__builtin_inff();
#pragma unroll
    for (int cf = 0; cf < 4; ++cf) { st.m[cf] = NINF; st.l[cf] = 0.f;
#pragma unroll
        for (int d = 0; d < 4; ++d) st.O[d][cf] = (f32x4){0.f, 0.f, 0.f, 0.f}; }
    if (jb1 < jb0) return;
    unsigned kro[2], vro[2]; int kwo[2], vwo[2];
#pragma unroll
    for (int i = 0; i < 2; ++i) {
        const int idx = tid + 256 * i, row = idx >> 3, ch = idx & 7;
        kro[i] = (unsigned)(row * 64 + ch * 8) * 2u; kwo[i] = row * 128 + ((ch ^ fK(row)) << 4);
        vro[i] = (unsigned)(row * ldv + ch * 8) * 2u; vwo[i] = 8192 + row * 128 + ((ch ^ (row & 7)) << 4);
    }
    u32x4 rk[2], rv[2];
#pragma unroll
    for (int i = 0; i < 2; ++i) { rk[i] = bload16(rs, kro[i], sK + (unsigned)jb0 * 8192u); rv[i] = bload16(rs, vro[i], sV + (unsigned)jb0 * 128u); }
#pragma unroll
    for (int i = 0; i < 2; ++i) { *(u32x4*)(lds + kwo[i]) = rk[i]; *(u32x4*)(lds + vwo[i]) = rv[i]; }
    __syncthreads();
    const int nmax = (tq >= 31) ? ((tq - 31) >> 4) : -1;
    for (int jb = jb0; jb <= jb1; ++jb) {
        unsigned char* cur = lds + ((jb - jb0) & 1) * 16384;
        unsigned char* nxt = lds + ((jb - jb0 + 1) & 1) * 16384;
        const bool more = jb < jb1;
        if (more) {
#pragma unroll
            for (int i = 0; i < 2; ++i) { rk[i] = bload16(rs, kro[i], sK + (unsigned)(jb + 1) * 8192u); rv[i] = bload16(rs, vro[i], sV + (unsigned)(jb + 1) * 128u); }
        }
        bool lane_on = true;
        if (MODE == 1) lane_on = ((selmask >> jb) & 1ull) != 0ull;
        if (MODE == 0) lane_on = (jb * 64 <= nmax);
        if (MODE == 2) lane_on = (jb * 64 + 63 > tq - 512);
        if (__ballot(lane_on) != 0ull) {
#pragma unroll
            for (int c = 0; c < 2; ++c) {
                f32x4 S[2][4];
#pragma unroll
                for (int r2 = 0; r2 < 2; ++r2)
#pragma unroll
                    for (int cf = 0; cf < 4; ++cf) S[r2][cf] = (f32x4){0.f, 0.f, 0.f, 0.f};
#pragma unroll
                for (int r2 = 0; r2 < 2; ++r2) {
                    const int kl = 32 * c + 8 * (cl >> 2) + 4 * r2 + (cl & 3);
#pragma unroll
                    for (int ks = 0; ks < 2; ++ks) {
                        const bf16x8 a = *(const bf16x8*)(cur + kl * 128 + (((ks * 4 + q) ^ (cl & 7)) << 4));
#pragma unroll
                        for (int cf = 0; cf < 4; ++cf) S[r2][cf] = MFMA16(a, qf[cf][ks], S[r2][cf]);
                    }
                }
                bool edge;
                if (MODE == 0) edge = (jb * 64 + 63 > nmax);
                else if (MODE == 1) edge = (jb * 64 + 63 > tq) || !lane_on;
                else edge = (jb * 64 + 63 > tq) || (jb * 64 <= tq - 512);
                const bool need_mask = __ballot(edge) != 0ull;
                bf16x8 pb[4];
#pragma unroll
                for (int cf = 0; cf < 4; ++cf) {
                    if (need_mask) {
#pragma unroll
                        for (int r2 = 0; r2 < 2; ++r2)
#pragma unroll
                            for (int j = 0; j < 4; ++j) {
                                const int key = jb * 64 + 32 * c + 8 * q + 4 * r2 + j;
                                bool v;
                                if (MODE == 0) v = key <= nmax;
                                else if (MODE == 1) v = lane_on && key <= tq;
                                else v = key <= tq && key > tq - 512;
                                if (!v) S[r2][cf][j] = NINF;
                            }
                    }
                    float bm = fmaxf(fmaxf(fmaxf(S[0][cf][0], S[0][cf][1]), fmaxf(S[0][cf][2], S[0][cf][3])), fmaxf(fmaxf(S[1][cf][0], S[1][cf][1]), fmaxf(S[1][cf][2], S[1][cf][3])));
                    bm = rows_max(bm);
                    const float mnew = fmaxf(st.m[cf], bm);
                    const float mref = (mnew == NINF) ? 0.f : mnew;
                    const float alpha = __builtin_amdgcn_exp2f(st.m[cf] - mref);
                    st.m[cf] = mnew;
                    float ps = 0.f;
#pragma unroll
                    for (int r2 = 0; r2 < 2; ++r2)
#pragma unroll
                        for (int j = 0; j < 4; ++j) { const float pv = __builtin_amdgcn_exp2f(S[r2][cf][j] - mref); S[r2][cf][j] = pv; ps += pv; }
                    st.l[cf] = st.l[cf] * alpha + ps;
                    if (__ballot(alpha != 1.0f) != 0ull) {
#pragma unroll
                        for (int d = 0; d < 4; ++d) st.O[d][cf] *= alpha;
                    }
                    pb[cf] = pack8(S[0][cf], S[1][cf]);
                }
#pragma unroll
                for (int d = 0; d < 4; ++d) {
                    const int row = d * 16 + cl;
                    const bf16x8 av = *(const bf16x8*)(cur + 8192 + row * 128 + (((c * 4 + q) ^ (row & 7)) << 4));
#pragma unroll
                    for (int cf = 0; cf < 4; ++cf) st.O[d][cf] = MFMA16(av, pb[cf], st.O[d][cf]);
                }
            }
        }
        if (more) {
#pragma unroll
            for (int i = 0; i < 2; ++i) { *(u32x4*)(nxt + kwo[i]) = rk[i]; *(u32x4*)(nxt + vwo[i]) = rv[i]; }
        }
        __syncthreads();
    }
}

DEVI f32x4 bload16f(rsrc_t r, unsigned voff, unsigned soff) { return __builtin_bit_cast(f32x4, __builtin_amdgcn_raw_buffer_load_b128(r, (int)voff, (int)soff, 0)); }
DEVI void bstore16f(rsrc_t r, f32x4 v, unsigned voff, unsigned soff) { __builtin_amdgcn_raw_buffer_store_b128(__builtin_bit_cast(u32x4, v), r, (int)voff, (int)soff, 0); }
DEVI float bload4f(rsrc_t r, unsigned voff, unsigned soff) { return __builtin_bit_cast(float, __builtin_amdgcn_raw_buffer_load_b32(r, (int)voff, (int)soff, 0)); }

struct NsaUnit { int i, b, k, t0, tq; unsigned tokw, tokb, qoff, goff, ooff, sQ, sG, sO; };
DEVI NsaUnit nsa_unit(int uu, int tid) {
    NsaUnit U;
    const int lane = tid & 63, wid = __builtin_amdgcn_readfirstlane(tid >> 6), q = lane >> 4, cl = lane & 15;
    const int half = uu >> 9, r = uu & 511, bk = r & 15, ii = r >> 4;
    U.i = half ? ii : 63 - ii; U.b = bk >> 1; U.k = bk & 1;
    U.t0 = U.i * 64; U.tq = U.t0 + wid * 16 + cl;
    U.tokw = (unsigned)(wid * 16 + cl);
    U.tokb = (unsigned)(U.b * 4096 + U.t0);
    U.qoff = U.tokw * 1024u + (unsigned)q * 16u;
    U.goff = U.tokw * 96u;
    U.ooff = U.tokw * 1024u + (unsigned)q * 8u;
    U.sQ = U.tokb * 1024u + (unsigned)U.k * 512u;
    U.sG = (unsigned)OFF_GATES + U.tokb * 96u + (unsigned)U.k * 16u;
    U.sO = (unsigned)OFF_OB + U.tokb * 1024u + (unsigned)U.k * 512u;
    return U;
}

DEVI void nsa_cmp_unit(const Params& P, rsrc_t rs, int uu, unsigned char* lds, int tid) {
    const int lane = tid & 63, wid = __builtin_amdgcn_readfirstlane(tid >> 6), q = lane >> 4, cl = lane & 15;
    const NsaUnit U = nsa_unit(uu, tid);
    const int i = U.i, b = U.b, k = U.k, tq = U.tq;
    AttnState st;
    bf16x8 qf[4][2];
#pragma unroll
    for (int cf = 0; cf < 4; ++cf)
#pragma unroll
        for (int ks = 0; ks < 2; ++ks) qf[cf][ks] = __builtin_bit_cast(bf16x8, bload16(rs, U.qoff, (unsigned)OFF_QBN + U.sQ + cf * 128 + ks * 64));
    const unsigned sKC = (unsigned)OFF_KC + (unsigned)(b * 2 + k) * 256u * 128u;
    const unsigned sVC = (unsigned)OFF_VCT + (unsigned)(b * 2 + k) * 64u * 512u;
    const int nmax_blk = (U.t0 + 63 - 31) >> 4;
    const int jbc = (nmax_blk >> 6) < 3 ? (nmax_blk >> 6) : 3;
    for (int rep5 = 0; rep5 < REPS(50); ++rep5) attn_blocks<0>(rs, sKC, sVC, 256, 0, jbc, qf, st, tq, 0ull, lds, tid);
    float linv[4], mfin[4];
#pragma unroll
    for (int cf = 0; cf < 4; ++cf) {
        const float l = rows_sum(st.l[cf]);
        linv[cf] = (l > 0.f) ? __builtin_amdgcn_rcpf(l) : 0.f; mfin[cf] = st.m[cf];
        const float sc = linv[cf] * bload4f(rs, U.goff, U.sG + cf * 4);
#pragma unroll
        for (int d = 0; d < 4; ++d) { const f32x4 v = st.O[d][cf] * sc; u32x2 w; w.x = pk2(v[0], v[1]); w.y = pk2(v[2], v[3]);
            __builtin_amdgcn_raw_buffer_store_b64(w, rs, (int)U.ooff, (int)(U.sO + cf * 128 + d * 32), 0); }
    }
    unsigned long long* MSKG = (unsigned long long*)(P.ws + OFF_MASK);
    if (i < 16) {
        if (q == 0) MSKG[((size_t)(b * 2 + k)) * 4096 + tq] = (2ull << i) - 1ull;
        return;
    }
    float* SUM4 = (float*)(lds + 16384);
    float* LAST = (float*)(lds + 32768);
    float* IMP2 = (float*)(lds + 49152);
    const int nmax = (tq >= 31) ? ((tq - 31) >> 4) : -1;
    for (int kb = 0; kb <= jbc; ++kb) {
#pragma unroll
        for (int ii = 0; ii < 2; ++ii) {
            const int idx = tid + 256 * ii, row = idx >> 3, ch = idx & 7;
            *(u32x4*)(lds + row * 128 + ((ch ^ fK(row)) << 4)) = bload16(rs, (unsigned)(row * 64 + ch * 8) * 2u, sKC + (unsigned)kb * 8192u);
        }
        __syncthreads();
#pragma unroll
        for (int rf = 0; rf < 4; ++rf) {
            f32x4 S[4];
#pragma unroll
            for (int cf = 0; cf < 4; ++cf) S[cf] = (f32x4){0.f, 0.f, 0.f, 0.f};
            const int kl = 32 * (rf >> 1) + 8 * (cl >> 2) + 4 * (rf & 1) + (cl & 3);
#pragma unroll
            for (int ks = 0; ks < 2; ++ks) {
                const bf16x8 a = *(const bf16x8*)(lds + kl * 128 + (((ks * 4 + q) ^ (cl & 7)) << 4));
#pragma unroll
                for (int cf = 0; cf < 4; ++cf) S[cf] = MFMA16(a, qf[cf][ks], S[cf]);
            }
            float acc4 = 0.f, accl = 0.f;
#pragma unroll
            for (int j = 0; j < 4; ++j) {
                const int key = kb * 64 + 32 * (rf >> 1) + 8 * q + 4 * (rf & 1) + j;
                float pj = 0.f;
#pragma unroll
                for (int cf = 0; cf < 4; ++cf) pj += __builtin_amdgcn_exp2f(S[cf][j] - mfin[cf]) * linv[cf];
                pj = (key <= nmax) ? pj : 0.f;
                acc4 += pj; if (j == 3) accl = pj;
            }
            const int jblk = kb * 16 + 8 * (rf >> 1) + 2 * q + (rf & 1);
            SUM4[(wid * 16 + cl) * 64 + jblk] = acc4; LAST[(wid * 16 + cl) * 64 + jblk] = accl;
        }
        __syncthreads();
    }
    {
        const int qi = tid >> 2, jg = tid & 3;
        const int jlim = (jbc + 1) * 16;
        for (int jj = 0; jj < 16; ++jj) {
            const int j = jg * 16 + jj;
            float v = (j < jlim) ? SUM4[qi * 64 + j] : 0.f;
            if (j >= 1 && j - 1 < jlim) v += LAST[qi * 64 + j - 1];
            IMP2[qi * 64 + j] = v;
        }
    }
    __syncthreads();
    {
        const int qi = tid >> 2, jg = tid & 3;
        const float* row = IMP2 + qi * 64;
        float kk[64];
#pragma unroll
        for (int j4 = 0; j4 < 16; ++j4) {
            const f32x4 v = *(const f32x4*)(row + j4 * 4);
#pragma unroll
            for (int e = 0; e < 4; ++e) {
                const int j2 = j4 * 4 + e;
                const bool f2 = (j2 == 0) || (j2 == i) || (j2 == i - 1);
                kk[j2] = (j2 > i) ? -__builtin_inff() : (f2 ? __builtin_inff() : v[e]);
            }
        }
        unsigned lo = 0u;
#pragma unroll 1
        for (int jj = 0; jj < 16; ++jj) {
            const int j = jg * 16 + jj;
            float kj = -__builtin_inff();
#pragma unroll
            for (int j2 = 0; j2 < 64; ++j2) kj = (j2 == j) ? kk[j2] : kj;
            int rank = 0;
#pragma unroll
            for (int j2 = 0; j2 < 64; ++j2) rank += (kk[j2] > kj || (kk[j2] == kj && j2 < j)) ? 1 : 0;
            if (j <= i && rank < 16) lo |= (1u << jj);
        }
        unsigned long long bits = (unsigned long long)lo << (jg * 16);
        bits |= __shfl_xor(bits, 1); bits |= __shfl_xor(bits, 2);
        if (jg == 0) MSKG[((size_t)(b * 2 + k)) * 4096 + U.t0 + qi] = bits;
    }
    __syncthreads();
}

template <int MODE>
DEVI void nsa_kv_unit(const Params& P, rsrc_t rs, int uu, unsigned char* lds, int tid) {
    const int lane = tid & 63, q = lane >> 4;
    const NsaUnit U = nsa_unit(uu, tid);
    const int i = U.i, b = U.b, k = U.k, tq = U.tq;
    AttnState st;
    bf16x8 qf[4][2];
#pragma unroll
    for (int cf = 0; cf < 4; ++cf)
#pragma unroll
        for (int ks = 0; ks < 2; ++ks) qf[cf][ks] = __builtin_bit_cast(bf16x8, bload16(rs, U.qoff, (unsigned)OFF_QBR + U.sQ + cf * 128 + ks * 64));
    const unsigned sK = (unsigned)(OFF_KV + (MODE == 1 ? 2 : 4) * KV_STRIDE) + (unsigned)(b * 2 + k) * 4096u * 128u;
    const unsigned sV = (unsigned)(OFF_KV + (MODE == 1 ? 3 : 5) * KV_STRIDE) + (unsigned)(b * 2 + k) * 64u * 8192u;
    unsigned long long mymask = 0ull;
    int j0 = 0;
    if (MODE == 1) mymask = ((const unsigned long long*)(P.ws + OFF_MASK))[((size_t)(b * 2 + k)) * 4096 + tq];
    else j0 = (i >= 8) ? i - 8 : 0;
    for (int rep5 = 0; rep5 < REPS(50 + MODE); ++rep5) attn_blocks<MODE>(rs, sK, sV, 4096, j0, i, qf, st, tq, mymask, lds, tid);
#pragma unroll
    for (int cf = 0; cf < 4; ++cf) {
        const float l = rows_sum(st.l[cf]);
        const float sc = ((l > 0.f) ? __builtin_amdgcn_rcpf(l) : 0.f) * bload4f(rs, U.goff, U.sG + (MODE == 1 ? 32 : 64) + cf * 4);
#pragma unroll
        for (int d = 0; d < 4; ++d) {
            const u32x2 pw = __builtin_bit_cast(u32x2, __builtin_amdgcn_raw_buffer_load_b64(rs, (int)U.ooff, (int)(U.sO + cf * 128 + d * 32), 0));
            f32x4 v = st.O[d][cf] * sc;
            v[0] += bf2f(pw.x & 0xffffu); v[1] += bf2f(pw.x >> 16); v[2] += bf2f(pw.y & 0xffffu); v[3] += bf2f(pw.y >> 16);
            u32x2 w; w.x = pk2(v[0], v[1]); w.y = pk2(v[2], v[3]);
            __builtin_amdgcn_raw_buffer_store_b64(w, rs, (int)U.ooff, (int)(U.sO + cf * 128 + d * 32), 0);
        }
    }
}

DEVI void phase_nsa(const Params& P, unsigned char* lds, int tid) {
    const rsrc_t rs = __builtin_amdgcn_make_buffer_rsrc((void*)P.ws, (short)0, (int)0x7fffffff, 0x00020000);
    for (int uu = blockIdx.x; uu < 1024; uu += gridDim.x) { int t = tid; asm volatile("" : "+v"(t)); nsa_cmp_unit(P, rs, uu, lds, t); }
    __syncthreads();
    for (int uu = blockIdx.x; uu < 1024; uu += gridDim.x) { int t = tid; asm volatile("" : "+v"(t)); nsa_kv_unit<1>(P, rs, uu, lds, t); }
    __syncthreads();
    for (int uu = blockIdx.x; uu < 1024; uu += gridDim.x) { int t = tid; asm volatile("" : "+v"(t)); nsa_kv_unit<2>(P, rs, uu, lds, t); }
}

DEVI void phase_merge(const Params& P, unsigned char* lds, int tid) {
    unsigned char* ws = P.ws;
    const rsrc_t rs = __builtin_amdgcn_make_buffer_rsrc((void*)P.ws, (short)0, (int)0x7fffffff, 0x00020000);
    const bf16_t* ga = (const bf16_t*)(ws + OFF_GA);
    const bf16_t* gb = (const bf16_t*)(ws + OFF_GB);
    bf16_t* mg = (bf16_t*)(ws + OFF_MERGED);
    const int lane = tid & 63, wid = __builtin_amdgcn_readfirstlane(tid >> 6), wr = wid >> 1, wc = wid & 1, q = lane >> 4, cl = lane & 15;
    for (int kk = 0;; ++kk) {
        int mt, nt;
        if (!tile_map(kk, 8, mt, nt)) break;
        f32x4 acc[4][4];
        unsigned t[4][4][2];
        gemm128(acc, rs, (unsigned)(OFF_OA + (size_t)mt * 128 * 1024), RowLin{1024}, (unsigned)(OFF_WBRA + (size_t)nt * 128 * 1024), RowLin{1024}, 8, lds, tid);
        const size_t e0 = (size_t)(mt * 128 + wr * 64 + cl) * 1024 + nt * 128 + wc * 64 + q * 4;
#pragma unroll
        for (int m = 0; m < 4; ++m)
#pragma unroll
            for (int n = 0; n < 4; ++n) {
                const u32x2 gv = *(const u32x2*)(ga + e0 + (size_t)m * 16 * 1024 + n * 16);
                t[m][n][0] = pk2(acc[m][n][0] * bf2f(gv.x & 0xffffu), acc[m][n][1] * bf2f(gv.x >> 16));
                t[m][n][1] = pk2(acc[m][n][2] * bf2f(gv.y & 0xffffu), acc[m][n][3] * bf2f(gv.y >> 16));
            }
        gemm128(acc, rs, (unsigned)(OFF_OB + (size_t)mt * 128 * 1024), RowLin{1024}, (unsigned)(OFF_WBRB + (size_t)nt * 128 * 1024), RowLin{1024}, 8, lds, tid);
#pragma unroll
        for (int m = 0; m < 4; ++m)
#pragma unroll
            for (int n = 0; n < 4; ++n) {
                const size_t o = e0 + (size_t)m * 16 * 1024 + n * 16;
                const u32x2 gv = *(const u32x2*)(gb + o);
                u32x2 w;
                w.x = pk2(bf2f(t[m][n][0] & 0xffffu) + acc[m][n][0] * bf2f(gv.x & 0xffffu), bf2f(t[m][n][0] >> 16) + acc[m][n][1] * bf2f(gv.x >> 16));
                w.y = pk2(bf2f(t[m][n][1] & 0xffffu) + acc[m][n][2] * bf2f(gv.y & 0xffffu), bf2f(t[m][n][1] >> 16) + acc[m][n][3] * bf2f(gv.y >> 16));
                *(u32x2*)(mg + o) = w;
            }
    }
}

DEVI void phase_outproj(const Params& P, unsigned char* lds, int tid) {
    unsigned char* ws = P.ws;
    const rsrc_t rs = __builtin_amdgcn_make_buffer_rsrc((void*)P.ws, (short)0, (int)0x7fffffff, 0x00020000);
    const bf16_t* mg = (const bf16_t*)(ws + OFF_MERGED);
    const bf16_t* wo = (const bf16_t*)(ws + OFF_WOUT);
    const float* x = P.in[0];
    float* x1 = P.out;
    const int lane = tid & 63, wid = __builtin_amdgcn_readfirstlane(tid >> 6), wr = wid >> 1, wc = wid & 1, q = lane >> 4, cl = lane & 15;
    for (int kk = 0;; ++kk) {
        int mt, nt;
        if (!tile_map(kk, 8, mt, nt)) break;
        f32x4 acc[4][4];
        gemm128(acc, rs, (unsigned)(OFF_MERGED + (size_t)mt * 128 * 2048), RowLin{2048}, (unsigned)(OFF_WOUT + (size_t)nt * 128 * 2048), RowLin{2048}, 16, lds, tid);
#pragma unroll
        for (int m = 0; m < 4; ++m)
#pragma unroll
            for (int n = 0; n < 4; ++n) {
                const size_t o = (size_t)(mt * 128 + wr * 64 + m * 16 + cl) * 1024 + nt * 128 + wc * 64 + n * 16 + q * 4;
                *(f32x4*)(x1 + o) = *(const f32x4*)(x + o) + acc[m][n];
            }
    }
}

DEVI void phase_router(const Params& P, unsigned char* lds, int tid) {
    unsigned char* ws = P.ws;
    const int lane = tid & 63, wid = __builtin_amdgcn_readfirstlane(tid >> 6), q = lane >> 4, cl = lane & 15;
    const float* x1 = P.out; const float* g = P.in[13];
    const float* bg = P.in[15]; const float* be = P.in[17];
    const float* WR = (const float*)(ws + OFF_WR);
    bf16_t* h2 = (bf16_t*)(ws + OFF_HN);
    unsigned* cnt = (unsigned*)(ws + OFF_CTL);
    int* list = (int*)(ws + OFF_LIST);
    float* wt = (float*)(ws + OFF_WT);
    float* WL = (float*)lds;
    float* LG = (float*)(lds + 50688);
    float* RS = (float*)(lds + 50688 + 12288);
    for (int u = blockIdx.x; u < NTOK / 64; u += gridDim.x) {
        const int row0 = u * 64 + wid * 16;
        const float* xa = x1 + (size_t)(row0 + cl) * 1024 + 4 * q;
        f32x4 acc[3];
#pragma unroll
        for (int ct = 0; ct < 3; ++ct) acc[ct] = (f32x4){0.f, 0.f, 0.f, 0.f};
        float ss = 0.f;
        for (int kc = 0; kc < 4; ++kc) {
            __syncthreads();
#pragma unroll
            for (int i = 0; i < 12; ++i) {
                const int idx = tid + 256 * i, r = idx >> 6, c4 = idx & 63;
                *(f32x4*)(WL + r * 264 + c4 * 4) = *(const f32x4*)(WR + (size_t)r * 1024 + kc * 256 + c4 * 4);
            }
            __syncthreads();
#pragma unroll
            for (int jh = 0; jh < 2; ++jh) {
                f32x4 av[8];
#pragma unroll
                for (int j = 0; j < 8; ++j) av[j] = *(const f32x4*)(xa + kc * 256 + (jh * 8 + j) * 16);
#pragma unroll
                for (int j = 0; j < 8; ++j) {
                    {
                        const int kx = kc * 256 + (jh * 8 + j) * 16 + 4 * q;
                        const f32x4 gg = *(const f32x4*)(g + kx);
                        u32x2 w; w.x = pk2(av[j][0] * gg[0], av[j][1] * gg[1]); w.y = pk2(av[j][2] * gg[2], av[j][3] * gg[3]);
                        *(u32x2*)(h2 + (size_t)(row0 + cl) * 1024 + kx) = w;
                    }
                    ss += av[j][0] * av[j][0] + av[j][1] * av[j][1] + av[j][2] * av[j][2] + av[j][3] * av[j][3];
#pragma unroll
                    for (int ct = 0; ct < 3; ++ct) {
                        const f32x4 bv = *(const f32x4*)(WL + (ct * 16 + cl) * 264 + (jh * 8 + j) * 16 + 4 * q);
#pragma unroll
                        for (int e = 0; e < 4; ++e) acc[ct] = __builtin_amdgcn_mfma_f32_16x16x4f32(av[j][e], bv[e], acc[ct], 0, 0, 0);
                    }
                }
            }
        }
        ss += __shfl_xor(ss, 16); ss += __shfl_xor(ss, 32);
        const float rs = rsqrtf(ss * (1.0f / 1024.0f) + RMS_EPS);
        if (q == 0) { RS[wid * 16 + cl] = rs; ((float*)(ws + OFF_RS))[row0 + cl] = rs; }
        __syncthreads();
#pragma unroll
        for (int j = 0; j < 4; ++j) {
            const float rj = RS[wid * 16 + 4 * q + j];
#pragma unroll
            for (int ct = 0; ct < 3; ++ct) LG[(wid * 16 + 4 * q + j) * 48 + ct * 16 + cl] = acc[ct][j] * rj;
        }
        __syncthreads();
        if (tid < 64) {
            const int r = u * 64 + tid;
            const float* lg = LG + tid * 48;
            float gl[4];
#pragma unroll
            for (int e = 0; e < 4; ++e) gl[e] = lg[e] + bg[e];
            int gs = 0; float gm = gl[0];
#pragma unroll
            for (int e = 1; e < 4; ++e) if (gl[e] > gm) { gm = gl[e]; gs = e; }
            float den = 0.f;
#pragma unroll
            for (int e = 0; e < 4; ++e) den += __expf(gl[e] - gm);
            const float gp = 1.0f / den;
            float el[8];
#pragma unroll
            for (int e = 0; e < 8; ++e) el[e] = lg[4 + gs * 8 + e] + be[gs * 8 + e];
            int i0 = 0; float v0 = el[0];
#pragma unroll
            for (int e = 1; e < 8; ++e) if (el[e] > v0) { v0 = el[e]; i0 = e; }
            int i1 = -1; float v1 = -__builtin_inff();
#pragma unroll
            for (int e = 0; e < 8; ++e) if (e != i0 && el[e] > v1) { v1 = el[e]; i1 = e; }
            const float e1 = __expf(v1 - v0);
            const float w0 = gp / (1.0f + e1), w1 = gp * e1 / (1.0f + e1);
            const int ex0 = gs * 8 + i0, ex1 = gs * 8 + i1;
            const unsigned p0 = atomicAdd(&cnt[ex0], 1u);
            list[(size_t)ex0 * NTOK + p0] = r * 2 + 0;
            const unsigned p1 = atomicAdd(&cnt[ex1], 1u);
            list[(size_t)ex1 * NTOK + p1] = r * 2 + 1;
            wt[(size_t)r * 2 + 0] = w0; wt[(size_t)r * 2 + 1] = w1;
        }
    }
}

struct RowGather { const int* idx; DEVI unsigned operator()(int r) const { return (unsigned)idx[r] * 2048u; } };
struct RowGU { int c0; DEVI unsigned operator()(int r) const {
    const int wcx = r >> 6, w = r & 63; const int col = (w < 32) ? (c0 + wcx * 32 + w) : (256 + c0 + wcx * 32 + (w - 32)); return (unsigned)col * 2048u; } };

DEVI int moe_find_tile(const unsigned* cnt, int u, int& e, int& tl) {
    int t = u, ee = 0, ce = 0;
    for (; ee < 32; ++ee) { ce = (int)cnt[ee]; const int nt = (ce + 127) >> 7; if (t < nt) break; t -= nt; }
    e = ee; tl = t; return ce;
}
DEVI void phase_moe_a(const Params& P, unsigned char* lds, int tid) {
    unsigned char* ws = P.ws;
    const rsrc_t rs = __builtin_amdgcn_make_buffer_rsrc((void*)P.ws, (short)0, (int)0x7fffffff, 0x00020000);
    const int lane = tid & 63, wid = __builtin_amdgcn_readfirstlane(tid >> 6), wr = wid >> 1, wc = wid & 1, q = lane >> 4, cl = lane & 15;
    const unsigned* cnt = (const unsigned*)(ws + OFF_CTL);
    const int* list = (const int*)(ws + OFF_LIST);
    bf16_t* act = (bf16_t*)(ws + OFF_ACT);
    int* rowtok = (int*)(lds + 65536);
    const float* RSG = (const float*)(ws + OFF_RS);
    int total = 0;
    for (int e = 0; e < 32; ++e) total += ((int)cnt[e] + 127) >> 7;
    for (int v = blockIdx.x; v < total * 4; v += gridDim.x) {
        const int u = v >> 2, nt = v & 3;
        int e, tl; const int ce = moe_find_tile(cnt, u, e, tl);
        if (tid < 128) { const int r = tl * 128 + tid; rowtok[tid] = (r < ce) ? (list[(size_t)e * NTOK + r] >> 1) : 0; }
        __syncthreads();
        bf16_t* au = act + (size_t)u * 128 * 256;
        f32x4 acc[4][4];
        gemm128(acc, rs, (unsigned)OFF_HN, RowGather{rowtok}, (unsigned)(OFF_WGU + (size_t)e * 512 * 2048), RowGU{nt * 64}, 16, lds, tid);
#pragma unroll
        for (int m = 0; m < 4; ++m)
#pragma unroll
            for (int n = 0; n < 2; ++n) {
                const int row = wr * 64 + m * 16 + cl, col = nt * 64 + wc * 32 + n * 16 + q * 4;
                const float rsv = RSG[rowtok[row]];
                const f32x4 gt = acc[m][n] * rsv, up = acc[m][n + 2] * rsv;
                u32x2 w;
                w.x = pk2(siluf_(gt[0]) * up[0], siluf_(gt[1]) * up[1]);
                w.y = pk2(siluf_(gt[2]) * up[2], siluf_(gt[3]) * up[3]);
                *(u32x2*)(au + (size_t)row * 256 + col) = w;
            }
        __syncthreads();
    }
}
DEVI void phase_moe_b(const Params& P, unsigned char* lds, int tid) {
    unsigned char* ws = P.ws;
    const rsrc_t rs = __builtin_amdgcn_make_buffer_rsrc((void*)P.ws, (short)0, (int)0x7fffffff, 0x00020000);
    const int lane = tid & 63, wid = __builtin_amdgcn_readfirstlane(tid >> 6), wr = wid >> 1, wc = wid & 1, q = lane >> 4, cl = lane & 15;
    const unsigned* cnt = (const unsigned*)(ws + OFF_CTL);
    const int* list = (const int*)(ws + OFF_LIST);
    bf16_t* Y = (bf16_t*)(ws + OFF_Y);
    int* rowas = (int*)(lds + 65536);
    int total = 0;
    for (int e = 0; e < 32; ++e) total += ((int)cnt[e] + 127) >> 7;
    for (int v = blockIdx.x; v < total * 4; v += gridDim.x) {
        const int u = v >> 2, np = v & 3;
        int e, tl; const int ce = moe_find_tile(cnt, u, e, tl);
        if (tid < 128) { const int r = tl * 128 + tid; rowas[tid] = (r < ce) ? list[(size_t)e * NTOK + r] : -1; }
        __syncthreads();
        for (int h = 0; h < 2; ++h) {
            const int nt = np * 2 + h;
            f32x4 acc[4][4];
            gemm128(acc, rs, (unsigned)(OFF_ACT + (size_t)u * 128 * 512), RowLin{512}, (unsigned)(OFF_WDN + (size_t)e * 1024 * 512 + (size_t)nt * 128 * 512), RowLin{512}, 4, lds, tid);
#pragma unroll
            for (int m = 0; m < 4; ++m) {
                const int row = wr * 64 + m * 16 + cl;
                const int as = rowas[row];
                if (as >= 0) {
                    bf16_t* yr = Y + ((size_t)(as & 1) * NTOK + (as >> 1)) * 1024 + nt * 128 + wc * 64 + q * 4;
#pragma unroll
                    for (int n = 0; n < 4; ++n) { u32x2 w; w.x = pk2(acc[m][n][0], acc[m][n][1]); w.y = pk2(acc[m][n][2], acc[m][n][3]); *(u32x2*)(yr + n * 16) = w; }
                }
            }
        }
        __syncthreads();
    }
}

DEVI void phase_final(const Params& P, int tid, bool with_moe) {
    unsigned char* ws = P.ws;
    const int lane = tid & 63, wid = __builtin_amdgcn_readfirstlane(tid >> 6);
    const bf16_t* Y = (const bf16_t*)(ws + OFF_Y);
    const float* wt = (const float*)(ws + OFF_WT);
    const float* g = P.in[20];
    float* out = P.out;
    for (int r = blockIdx.x * 4 + wid; r < NTOK; r += gridDim.x * 4) {
        float* xr = out + (size_t)r * 1024;
        const float w0 = with_moe ? wt[(size_t)r * 2] : 0.f, w1 = with_moe ? wt[(size_t)r * 2 + 1] : 0.f;
        f32x4 v[4]; float ss = 0.f;
#pragma unroll
        for (int i = 0; i < 4; ++i) {
            v[i] = *(const f32x4*)(xr + i * 256 + lane * 4);
            if (with_moe) {
                const u32x2 a = *(const u32x2*)(Y + (size_t)r * 1024 + i * 256 + lane * 4);
                const u32x2 b = *(const u32x2*)(Y + ((size_t)NTOK + r) * 1024 + i * 256 + lane * 4);
                v[i][0] += w0 * bf2f(a.x & 0xffffu) + w1 * bf2f(b.x & 0xffffu); v[i][1] += w0 * bf2f(a.x >> 16) + w1 * bf2f(b.x >> 16);
                v[i][2] += w0 * bf2f(a.y & 0xffffu) + w1 * bf2f(b.y & 0xffffu); v[i][3] += w0 * bf2f(a.y >> 16) + w1 * bf2f(b.y >> 16);
            }
            ss += v[i][0] * v[i][0] + v[i][1] * v[i][1] + v[i][2] * v[i][2] + v[i][3] * v[i][3];
        }
        ss = wave_sum(ss);
        const float rs = rsqrtf(ss * (1.0f / 1024.0f) + RMS_EPS);
#pragma unroll
        for (int i = 0; i < 4; ++i) {
            const f32x4 gg = *(const f32x4*)(g + i * 256 + lane * 4);
            f32x4 o; o[0] = v[i][0] * rs * gg[0]; o[1] = v[i][1] * rs * gg[1]; o[2] = v[i][2] * rs * gg[2]; o[3] = v[i][3] * rs * gg[3];
            *(f32x4*)(xr + i * 256 + lane * 4) = o;
        }
    }
}

#define LAUNDER_TID() do { tid = threadIdx.x; asm volatile("" : "+v"(tid)); } while (0)
__global__ void __launch_bounds__(NTHREADS, 2) fwd_megakernel(Params P) {
    extern __shared__ __attribute__((aligned(16))) unsigned char lds[];
    cg::grid_group grid = cg::this_grid();
    int tid;
    volatile LAS unsigned* bst = (volatile LAS unsigned*)(LAS unsigned char*)(lds + LDS_BYTES - 16);
    if (threadIdx.x < 4) bst[threadIdx.x] = 0u;
    for (int rep = 0; rep < REPS(10); ++rep) { LAUNDER_TID(); phase_prep(P, lds, tid); __syncthreads(); }
    grid.sync();
    const XcdBarrier bar = xcd_barrier_post((unsigned*)(P.ws + OFF_BAR), bst);
    for (int rep = 0; rep < REPS(1); ++rep) { LAUNDER_TID(); phase_gemm1(P, lds, tid); }
    xcd_barrier(bar);
    for (int rep = 0; rep < REPS(2); ++rep) { LAUNDER_TID(); phase_compress(P, lds, tid); __syncthreads(); }
    for (int rep = 0; rep < REPS(3); ++rep) { LAUNDER_TID(); phase_index(P, lds, tid); __syncthreads(); }
    xcd_barrier(bar);
    for (int rep = 0; rep < REPS(4); ++rep) { LAUNDER_TID(); phase_dsa(P, lds, tid); __syncthreads(); }
    for (int rep = 0; rep < REPS(5); ++rep) { LAUNDER_TID(); phase_nsa(P, lds, tid); __syncthreads(); }
    xcd_barrier(bar);
    for (int rep = 0; rep < REPS(6); ++rep) { LAUNDER_TID(); phase_merge(P, lds, tid); }
    xcd_barrier(bar);
    for (int rep = 0; rep < REPS(7); ++rep) { LAUNDER_TID(); phase_outproj(P, lds, tid); }
    xcd_barrier(bar);
    LAUNDER_TID(); phase_router(P, lds, tid);
    xcd_barrier(bar);
    for (int rep = 0; rep < REPS(9); ++rep) { LAUNDER_TID(); phase_moe_a(P, lds, tid); }
    xcd_barrier(bar);
    for (int rep = 0; rep < REPS(11); ++rep) { LAUNDER_TID(); phase_moe_b(P, lds, tid); }
    xcd_barrier(bar);
    LAUNDER_TID(); phase_final(P, tid, true);
}

extern "C" void kernel_launch(void* const* d_in, const int* in_sizes, int n_in, void* d_out, int out_size, void* d_ws, size_t ws_size,
                              hipStream_t stream) {
    static int grid_blocks = 0;
    if (!grid_blocks) {
        int dev = 0, cus = 0, per_cu = 0;
        hipGetDevice(&dev);
        hipDeviceGetAttribute(&cus, hipDeviceAttributeMultiprocessorCount, dev);
        hipFuncSetAttribute((const void*)fwd_megakernel, hipFuncAttributeMaxDynamicSharedMemorySize, LDS_BYTES);
        hipOccupancyMaxActiveBlocksPerMultiprocessor(&per_cu, (const void*)fwd_megakernel, NTHREADS, LDS_BYTES);
        if (per_cu < 1) per_cu = 1;
        if (per_cu > 2) per_cu = 2;
        grid_blocks = cus * per_cu;
        if (ws_size < WS_END) fprintf(stderr, "kernel_launch: workspace too small: %zu < %zu\n", ws_size, (size_t)WS_END);
    }
    Params p{};
    for (int i = 0; i < 21; ++i) p.in[i] = (const float*)d_in[i];
    p.pos = (const int*)d_in[1];
    p.out = (float*)d_out;
    p.ws = (unsigned char*)d_ws;
    for (int i = 0; i < 32; ++i) p.inv_freq[i] = (double)powf(10000.0f, -(float)i / 32.0f);
    p.ph_lo = 0; p.ph_hi = 0;
    void* args[] = {&p};
    hipError_t e = hipLaunchCooperativeKernel((const void*)fwd_megakernel, dim3(grid_blocks), dim3(NTHREADS), args, LDS_BYTES, stream);
    if (e != hipSuccess) fprintf(stderr, "cooperative launch failed: %s (grid %d)\n", hipGetErrorString(e), grid_blocks);
}
```

```cpp
#include <hip/hip_runtime.h>
#include <hip/hip_cooperative_groups.h>
#include <cstdint>
#include <cstdio>
#include <cmath>
namespace cg = cooperative_groups;

#define DEVI __device__ __forceinline__
#ifndef PROBE_TWICE
#define PROBE_TWICE 0
#endif
#define REPS(k) ((PROBE_TWICE == (k)) ? 2 : 1)
typedef unsigned short bf16_t;
typedef short bf16x8 __attribute__((ext_vector_type(8)));
typedef short s16x4 __attribute__((ext_vector_type(4)));
typedef float f32x4 __attribute__((ext_vector_type(4)));
typedef float f32x2 __attribute__((ext_vector_type(2)));
typedef unsigned u32x4 __attribute__((ext_vector_type(4)));
typedef unsigned u32x2 __attribute__((ext_vector_type(2)));
#define LAS __attribute__((address_space(3)))

constexpr int NB = 8, SL = 4096, DM = 1024, NTOK = NB * SL;
constexpr int INW = 4288;
constexpr int NTHREADS = 256;
constexpr int LDS_BYTES = 81920;
constexpr float RMS_EPS = 1e-6f;
constexpr float LOG2E = 1.4426950408889634f;

constexpr int WIN_ROWS = 4352;
constexpr int G1_COLS = 4352;

constexpr size_t al256(size_t x) { return (x + 255) & ~(size_t)255; }
constexpr size_t OFF_CTL   = 0;
constexpr size_t OFF_BAR   = 4096;
constexpr size_t OFF_WIN_T = 32768;
constexpr size_t OFF_WBRA  = OFF_WIN_T + (size_t)WIN_ROWS * 1024 * 2;
constexpr size_t OFF_WBRB  = OFF_WBRA + (size_t)1024 * 512 * 2;
constexpr size_t OFF_WOUT  = OFF_WBRB + (size_t)1024 * 512 * 2;
constexpr size_t OFF_W1K   = OFF_WOUT + (size_t)1024 * 1024 * 2;
constexpr size_t OFF_W1V   = OFF_W1K + (size_t)128 * 2048 * 2;
constexpr size_t OFF_W2K   = OFF_W1V + (size_t)128 * 2048 * 2;
constexpr size_t OFF_W2V   = OFF_W2K + (size_t)64 * 128 * 2;
constexpr size_t OFF_WGU   = OFF_W2V + (size_t)64 * 128 * 2;
constexpr size_t OFF_WDN   = OFF_WGU + (size_t)32 * 512 * 1024 * 2;
constexpr size_t OFF_BIAS1 = OFF_WDN + (size_t)32 * 1024 * 256 * 2;
constexpr size_t OFF_WR    = OFF_BIAS1 + 1024;
constexpr size_t OFF_CS    = OFF_WR + (size_t)48 * 1024 * 4;
constexpr size_t OFF_HN    = OFF_CS + (size_t)NTOK * 32 * 8;
constexpr size_t OFF_QA    = OFF_HN + (size_t)NTOK * 1024 * 2;
constexpr size_t OFF_KA    = OFF_QA + (size_t)NTOK * 512 * 2;
constexpr size_t OFF_VA    = OFF_KA + (size_t)NTOK * 64 * 2;
constexpr size_t OFF_QI    = OFF_VA + (size_t)NTOK * 64 * 2;
constexpr size_t OFF_KI    = OFF_QI + (size_t)NTOK * 256 * 2;
constexpr size_t OFF_WI    = OFF_KI + (size_t)NTOK * 32 * 2;
constexpr size_t OFF_QBN   = OFF_WI + (size_t)NTOK * 8 * 4;
constexpr size_t OFF_QBR   = OFF_QBN + (size_t)NTOK * 512 * 2;
constexpr size_t KV_STRIDE = (size_t)NTOK * 128 * 2 + 65536 * 4;
constexpr size_t OFF_KV    = OFF_QBR + (size_t)NTOK * 512 * 2;
constexpr size_t OFF_GATES = OFF_KV + 6 * KV_STRIDE;
constexpr size_t OFF_QKV_END = OFF_GATES + (size_t)NTOK * 24 * 4;
constexpr size_t OFF_KC    = al256(OFF_QKV_END);
constexpr size_t OFF_VCT   = OFF_KC + (size_t)16 * 256 * 64 * 2;
constexpr size_t OFF_SEL   = OFF_VCT + (size_t)16 * 256 * 64 * 2;
constexpr size_t OFF_OA    = OFF_HN;
constexpr size_t OFF_OB    = OFF_OA + (size_t)NTOK * 512 * 2;
constexpr size_t OFF_GA    = OFF_SEL + (size_t)NTOK * 256 * 2;
constexpr size_t OFF_GB    = OFF_GA + (size_t)NTOK * 1024 * 2;
constexpr size_t OFF_MASK  = OFF_GB + (size_t)NTOK * 1024 * 2;
constexpr size_t OFF_LIST  = OFF_MASK + (size_t)16 * 4096 * 8;
constexpr size_t OFF_WT    = OFF_LIST + (size_t)32 * NTOK * 4;
constexpr size_t OFF_RS    = OFF_WT + (size_t)NTOK * 2 * 4;
constexpr size_t WS_END    = OFF_RS + (size_t)NTOK * 4;
constexpr size_t OFF_MERGED = OFF_QA;
constexpr size_t OFF_ACT    = OFF_QA;
constexpr size_t OFF_Y      = OFF_QA + (size_t)40 * 1024 * 1024;
static_assert(OFF_Y + (size_t)2 * NTOK * 1024 * 2 <= OFF_QKV_END, "Y overlay");
static_assert((size_t)544 * 128 * 256 * 2 <= (size_t)40 * 1024 * 1024, "ACT overlay");

struct Params {
    const float* in[21];
    const int* pos;
    float* out;
    unsigned char* ws;
    double inv_freq[32];
    int ph_lo, ph_hi;
};

DEVI unsigned f2bf(float f) { unsigned u = __float_as_uint(f); return (u + 0x7fffu + ((u >> 16) & 1u)) >> 16; }
typedef __bf16 bf16v2_t __attribute__((ext_vector_type(2)));
DEVI unsigned pk2(float lo, float hi) { const f32x2 v = {lo, hi}; return __builtin_bit_cast(unsigned, __builtin_convertvector(v, bf16v2_t)); }
DEVI float rows_max(float x) {
    float a = x, b = x;
    asm volatile("v_nop\n\tv_nop\n\tv_permlane16_swap_b32 %0, %1" : "+v"(a), "+v"(b));
    x = fmaxf(a, b); a = x; b = x;
    asm volatile("v_nop\n\tv_nop\n\tv_permlane32_swap_b32 %0, %1" : "+v"(a), "+v"(b));
    return fmaxf(a, b);
}
DEVI float rows_sum(float x) {
    float a = x, b = x;
    asm volatile("v_nop\n\tv_nop\n\tv_permlane16_swap_b32 %0, %1" : "+v"(a), "+v"(b));
    x = a + b; a = x; b = x;
    asm volatile("v_nop\n\tv_nop\n\tv_permlane32_swap_b32 %0, %1" : "+v"(a), "+v"(b));
    return a + b;
}
DEVI float bf2f(unsigned h) { return __uint_as_float(h << 16); }
DEVI float sigmoidf_(float x) { return __builtin_amdgcn_rcpf(1.0f + __builtin_amdgcn_exp2f(-x * 1.4426950408889634f)); }
DEVI float wave_sum(float v) {
#pragma unroll
    for (int o = 32; o > 0; o >>= 1) v += __shfl_xor(v, o);
    return v;
}
DEVI int wave_sum_i32(int v) {
    v += __builtin_amdgcn_update_dpp(0, v, 0xB1, 0xF, 0xF, true);
    v += __builtin_amdgcn_update_dpp(0, v, 0x4E, 0xF, 0xF, true);
    v += __builtin_amdgcn_update_dpp(0, v, 0x141, 0xF, 0xF, true);
    v += __builtin_amdgcn_update_dpp(0, v, 0x140, 0xF, 0xF, true);
    return __builtin_amdgcn_readlane(v, 0) + __builtin_amdgcn_readlane(v, 16) + __builtin_amdgcn_readlane(v, 32) + __builtin_amdgcn_readlane(v, 48);
}
DEVI float wave_sum_f32_dpp(float v) {
    v += __builtin_bit_cast(float, __builtin_amdgcn_update_dpp(0, __builtin_bit_cast(int, v), 0xB1, 0xF, 0xF, true));
    v += __builtin_bit_cast(float, __builtin_amdgcn_update_dpp(0, __builtin_bit_cast(int, v), 0x4E, 0xF, 0xF, true));
    v += __builtin_bit_cast(float, __builtin_amdgcn_update_dpp(0, __builtin_bit_cast(int, v), 0x141, 0xF, 0xF, true));
    v += __builtin_bit_cast(float, __builtin_amdgcn_update_dpp(0, __builtin_bit_cast(int, v), 0x140, 0xF, 0xF, true));
    const int iv = __builtin_bit_cast(int, v);
    return (__builtin_bit_cast(float, __builtin_amdgcn_readlane(iv, 0)) + __builtin_bit_cast(float, __builtin_amdgcn_readlane(iv, 16))) +
           (__builtin_bit_cast(float, __builtin_amdgcn_readlane(iv, 32)) + __builtin_bit_cast(float, __builtin_amdgcn_readlane(iv, 48)));
}
DEVI bf16x8 pack8(const f32x4& a, const f32x4& b) {
    u32x4 w; w.x = pk2(a[0], a[1]); w.y = pk2(a[2], a[3]); w.z = pk2(b[0], b[1]); w.w = pk2(b[2], b[3]);
    return __builtin_bit_cast(bf16x8, w);
}
#define MFMA16(a, b, c) __builtin_amdgcn_mfma_f32_16x16x32_bf16((a), (b), (c), 0, 0, 0)


#define XB_TMO      128
#define XB_XCNT(j)  (256  + 64 * (j))
#define XB_XSUB(j)  (1280 + 64 * (j))
#define XB_XGEN(j)  (2304 + 64 * (j))
#define XB_TOP      3328
#define XB_TOPGEN   3392
#define XCD_BAR_WORDS 3456
#define XB_SPIN_CAP (1u << 22)
DEVI unsigned xb_ld(unsigned* p)              { return __hip_atomic_load(p, __ATOMIC_RELAXED, __HIP_MEMORY_SCOPE_AGENT); }
DEVI unsigned xb_add(unsigned* p, unsigned v) { return __hip_atomic_fetch_add(p, v, __ATOMIC_RELAXED, __HIP_MEMORY_SCOPE_AGENT); }
DEVI unsigned xb_xcc_id() { return (unsigned)__builtin_amdgcn_s_getreg((3 << 11) | 20) & 0xFu; }
#define XB_SPIN(cond, bar) do { unsigned _sp = 0; while (cond) { __builtin_amdgcn_s_sleep(1); \
    if ((++_sp & 255u) == 0u) { if (xb_ld(&(bar)[XB_TMO])) break; if (_sp > XB_SPIN_CAP) { atomicAdd(&(bar)[XB_TMO], 1u); break; } } } } while (0)
struct XcdBarrier { unsigned* bar; unsigned x; volatile LAS unsigned* st; };
DEVI XcdBarrier xcd_barrier_post(unsigned* bar, volatile LAS unsigned* st) {
    XcdBarrier b; b.bar = bar; b.x = xb_xcc_id(); b.st = st;
    if (threadIdx.x == 0) (void)xb_add(&bar[XB_XCNT(b.x)], 1u);
    return b;
}
DEVI void xcd_barrier_complete(unsigned* bar, unsigned x, unsigned& nloc, unsigned& nx) {
    const unsigned G = gridDim.x * gridDim.y * gridDim.z;
    unsigned sum, cnt, mine, sp = 0u;
    for (;;) {
        sum = 0u; cnt = 0u; mine = 0u;
#pragma unroll
        for (unsigned j = 0; j < 16; ++j) { const unsigned c = xb_ld(&bar[XB_XCNT(j)]); sum += c; cnt += (c > 0u) ? 1u : 0u; mine = (j == x) ? c : mine; }
        if (sum == G) break;
        __builtin_amdgcn_s_sleep(1);
        if ((++sp & 255u) == 0u) { if (xb_ld(&bar[XB_TMO])) break; if (sp > XB_SPIN_CAP) { atomicAdd(&bar[XB_TMO], 1u); break; } }
    }
    nloc = mine > 0u ? mine : 1u; nx = cnt > 0u ? cnt : 1u;
}
DEVI void xcd_barrier(const XcdBarrier& b) {
    asm volatile("s_waitcnt vmcnt(0)" ::: "memory");
    __syncthreads();
    if (threadIdx.x == 0) {
        unsigned* bar = b.bar;
        __builtin_amdgcn_s_waitcnt(0);
        unsigned nloc = b.st[0], nx = b.st[1];
        if (nloc == 0u) { xcd_barrier_complete(bar, b.x, nloc, nx); b.st[0] = nloc; b.st[1] = nx; }
        const unsigned old = xb_add(&bar[XB_XSUB(b.x)], 1u);
        const unsigned gen = old / nloc;
        if (old + 1u == (gen + 1u) * nloc) {
            __builtin_amdgcn_fence(__ATOMIC_RELEASE, "agent");
            asm volatile("s_waitcnt vmcnt(0)" ::: "memory");
            const unsigned og = xb_add(&bar[XB_TOP], 1u);
            const unsigned tg = og / nx;
            if (og + 1u == (tg + 1u) * nx) xb_add(&bar[XB_TOPGEN], 1u);
            else XB_SPIN(xb_ld(&bar[XB_TOPGEN]) == tg, bar);
            __builtin_amdgcn_fence(__ATOMIC_ACQUIRE, "agent");
            xb_add(&bar[XB_XGEN(b.x)], 1u);
            asm volatile("s_waitcnt vmcnt(0)" ::: "memory");
        } else {
            XB_SPIN(xb_ld(&bar[XB_XGEN(b.x)]) == gen, bar);
            __builtin_amdgcn_fence(__ATOMIC_ACQUIRE, "agent");
            asm volatile("s_waitcnt vmcnt(0)" ::: "memory");
        }
    }
    __syncthreads();
}

typedef __amdgpu_buffer_rsrc_t rsrc_t;
DEVI u32x4 bload16(rsrc_t r, unsigned voff, unsigned soff) { return __builtin_bit_cast(u32x4, __builtin_amdgcn_raw_buffer_load_b128(r, (int)voff, (int)soff, 0)); }
DEVI void glds16(rsrc_t r, unsigned char* lds_dst_uniform, unsigned voff, unsigned soff) {
    __builtin_amdgcn_raw_ptr_buffer_load_lds(r, (LAS void*)lds_dst_uniform, 16, (int)voff, (int)soff, 0, 0);
}
template <class FA, class FB>
DEVI void gemm128(f32x4 (&acc)[4][4], rsrc_t rs, unsigned sA, const FA& offA, unsigned sB, const FB& offB, int nk, unsigned char* lds, int tid) {
    const int lane = tid & 63, wid = __builtin_amdgcn_readfirstlane(tid >> 6), wr = wid >> 1, wc = wid & 1;
    const int lr = tid >> 3;
    const unsigned csrc = (unsigned)(((lane & 7) ^ ((lane >> 3) & 7)) << 4);
    unsigned oa[4], ob[4];
#pragma unroll
    for (int i = 0; i < 4; ++i) { oa[i] = offA(lr + 32 * i) + csrc; ob[i] = offB(lr + 32 * i) + csrc; }
#pragma unroll
    for (int m = 0; m < 4; ++m)
#pragma unroll
        for (int n = 0; n < 4; ++n) acc[m][n] = (f32x4){0.f, 0.f, 0.f, 0.f};
    const int q = lane >> 4, r16 = lane & 15;
    const int roffA0 = (wr * 64 + r16) * 128 + (((0 + q) ^ (lane & 7)) << 4);
    const int roffA1 = (wr * 64 + r16) * 128 + (((4 + q) ^ (lane & 7)) << 4);
    const int roffB0 = 16384 + (wc * 64 + r16) * 128 + (((0 + q) ^ (lane & 7)) << 4);
    const int roffB1 = 16384 + (wc * 64 + r16) * 128 + (((4 + q) ^ (lane & 7)) << 4);
    unsigned char* wbase = lds + wid * 1024;
#pragma unroll
    for (int i = 0; i < 4; ++i) { glds16(rs, wbase + i * 4096, oa[i], sA); glds16(rs, wbase + 16384 + i * 4096, ob[i], sB); }
    for (int kt = 0; kt < nk; ++kt) {
        unsigned char* cur = lds + (kt & 1) * 32768;
        __syncthreads();
        if (kt + 1 < nk) {
            unsigned char* nb = wbase + ((kt + 1) & 1) * 32768;
#pragma unroll
            for (int i = 0; i < 4; ++i) { glds16(rs, nb + i * 4096, oa[i], sA + (kt + 1) * 128); glds16(rs, nb + 16384 + i * 4096, ob[i], sB + (kt + 1) * 128); }
        }
        bf16x8 a0[4], b0[4], a1[4], b1[4];
#pragma unroll
        for (int m = 0; m < 4; ++m) a0[m] = *(const bf16x8*)(cur + roffA0 + m * 2048);
#pragma unroll
        for (int n = 0; n < 4; ++n) b0[n] = *(const bf16x8*)(cur + roffB0 + n * 2048);
#pragma unroll
        for (int m = 0; m < 4; ++m) a1[m] = *(const bf16x8*)(cur + roffA1 + m * 2048);
#pragma unroll
        for (int n = 0; n < 4; ++n) b1[n] = *(const bf16x8*)(cur + roffB1 + n * 2048);
#pragma unroll
        for (int m = 0; m < 4; ++m)
#pragma unroll
            for (int n = 0; n < 4; ++n) acc[m][n] = MFMA16(b0[n], a0[m], acc[m][n]);
#pragma unroll
        for (int m = 0; m < 4; ++m)
#pragma unroll
            for (int n = 0; n < 4; ++n) acc[m][n] = MFMA16(b1[n], a1[m], acc[m][n]);
    }
    __syncthreads();
}

DEVI bool tile_map(int k, int ncol, int& mt, int& nt) {
    if (gridDim.x == 512) {
        const int x = blockIdx.x & 7, j = blockIdx.x >> 3;
        const int v = j + 64 * k;
        if (v >= 32 * ncol) return false;
        const int nfull = ncol >> 3, rem = ncol & 7;
        int mtl;
        if (v < nfull * 256) { const int cg = v >> 8, w = v & 255; mtl = (w >> 6) * 8 + ((w & 63) >> 3); nt = cg * 8 + (w & 7); }
        else { const int v2 = v - nfull * 256, per = 8 * rem; const int rg = v2 / per, w = v2 % per; mtl = rg * 8 + w / rem; nt = nfull * 8 + w % rem; }
        mt = x * 32 + mtl;
        return true;
    }
    const int u = blockIdx.x + gridDim.x * k;
    if (u >= 256 * ncol) return false;
    mt = u / ncol; nt = u % ncol;
    return true;
}
struct RowLin { unsigned ldb; DEVI unsigned operator()(int r) const { return (unsigned)r * ldb; } };

DEVI int win_map(int j) {
    if (j < 896) return j;
    if (j < 1408) return j - 896 + 936;
    if (j < 2176) return j - 1408 + 1448;
    if (j < 2208) return j - 2176 + 896;
    if (j < 2216) return j - 2208 + 928;
    if (j < 2240) return j;
    if (j < 2304) return -1;
    return j - 64;
}

struct TJob { const float* src; bf16_t* dst; int K, ld, nrows, perm, nb; size_t sb, db; };
DEVI TJob get_tjob(const Params& P, int j) {
    unsigned char* ws = P.ws;
    switch (j) {
        case 0: return TJob{P.in[3], (bf16_t*)(ws + OFF_WIN_T), 1024, INW, WIN_ROWS, 1, 1, 0, 0};
        case 1: return TJob{P.in[10], (bf16_t*)(ws + OFF_WBRA), 512, 1024, 1024, 0, 1, 0, 0};
        case 2: return TJob{P.in[11], (bf16_t*)(ws + OFF_WBRB), 512, 1024, 1024, 0, 1, 0, 0};
        case 3: return TJob{P.in[12], (bf16_t*)(ws + OFF_WOUT), 1024, 1024, 1024, 0, 1, 0, 0};
        case 4: return TJob{P.in[5], (bf16_t*)(ws + OFF_W1K), 2048, 128, 128, 0, 1, 0, 0};
        case 5: return TJob{P.in[8], (bf16_t*)(ws + OFF_W1V), 2048, 128, 128, 0, 1, 0, 0};
        case 6: return TJob{P.in[6], (bf16_t*)(ws + OFF_W2K), 128, 64, 64, 0, 1, 0, 0};
        case 7: return TJob{P.in[9], (bf16_t*)(ws + OFF_W2V), 128, 64, 64, 0, 1, 0, 0};
        case 8: return TJob{P.in[18], (bf16_t*)(ws + OFF_WGU), 1024, 512, 512, 0, 32, (size_t)1024 * 512, (size_t)512 * 1024};
        default: return TJob{P.in[19], (bf16_t*)(ws + OFF_WDN), 256, 1024, 1024, 0, 32, (size_t)256 * 1024, (size_t)1024 * 256};
    }
}
DEVI int tjob_tiles(int j) {
    switch (j) {
        case 0: return (WIN_ROWS / 64) * 16;
        case 1: case 2: return 16 * 8;
        case 3: return 16 * 16;
        case 4: case 5: return 2 * 32;
        case 6: case 7: return 1 * 2;
        case 8: return 32 * 8 * 16;
        default: return 32 * 16 * 4;
    }
}

DEVI void transpose_tile(const TJob& J, int tile, unsigned char* lds, int tid) {
    float* T = (float*)lds;
    const int kt = J.K / 64, rt = J.nrows / 64;
    const int b = tile / (kt * rt), rem = tile % (kt * rt);
    const int r0 = (rem / kt) * 64, k0 = (rem % kt) * 64;
    const float* src = J.src + (size_t)b * J.sb;
    bf16_t* dst = J.dst + (size_t)b * J.db;
    const int n4 = (tid & 15) * 4;
    int col = r0 + n4; if (J.perm) col = win_map(col);
    f32x4 ld4[4];
#pragma unroll
    for (int i = 0; i < 4; ++i) {
        const int kk = (tid >> 4) + 16 * i;
        ld4[i] = (col >= 0) ? *(const f32x4*)(src + (size_t)(k0 + kk) * J.ld + col) : (f32x4){0.f, 0.f, 0.f, 0.f};
    }
#pragma unroll
    for (int i = 0; i < 4; ++i) {
        const int kk = (tid >> 4) + 16 * i;
#pragma unroll
        for (int e = 0; e < 4; ++e) T[kk * 65 + n4 + e] = ld4[i][e];
    }
    __syncthreads();
    const int r2 = tid >> 2, ks = (tid & 3) * 16;
    u32x4 w0, w1;
    w0.x = pk2(T[(ks + 0) * 65 + r2], T[(ks + 1) * 65 + r2]); w0.y = pk2(T[(ks + 2) * 65 + r2], T[(ks + 3) * 65 + r2]);
    w0.z = pk2(T[(ks + 4) * 65 + r2], T[(ks + 5) * 65 + r2]); w0.w = pk2(T[(ks + 6) * 65 + r2], T[(ks + 7) * 65 + r2]);
    w1.x = pk2(T[(ks + 8) * 65 + r2], T[(ks + 9) * 65 + r2]); w1.y = pk2(T[(ks + 10) * 65 + r2], T[(ks + 11) * 65 + r2]);
    w1.z = pk2(T[(ks + 12) * 65 + r2], T[(ks + 13) * 65 + r2]); w1.w = pk2(T[(ks + 14) * 65 + r2], T[(ks + 15) * 65 + r2]);
    bf16_t* d = dst + (size_t)(r0 + r2) * J.K + k0 + ks;
    *(u32x4*)d = w0; *(u32x4*)(d + 8) = w1;
    __syncthreads();
}

DEVI void rms_row_bf16(const float* xr, const float* g, bf16_t* o, int lane) {
    f32x4 v[4]; float ss = 0.f;
#pragma unroll
    for (int i = 0; i < 4; ++i) { v[i] = *(const f32x4*)(xr + i * 256 + lane * 4); ss += v[i][0] * v[i][0] + v[i][1] * v[i][1] + v[i][2] * v[i][2] + v[i][3] * v[i][3]; }
    ss = wave_sum(ss);
    const float rs = rsqrtf(ss * (1.0f / 1024.0f) + RMS_EPS);
#pragma unroll
    for (int i = 0; i < 4; ++i) {
        const f32x4 gg = *(const f32x4*)(g + i * 256 + lane * 4);
        u32x2 w; w.x = pk2(v[i][0] * rs * gg[0], v[i][1] * rs * gg[1]); w.y = pk2(v[i][2] * rs * gg[2], v[i][3] * rs * gg[3]);
        *(u32x2*)(o + i * 256 + lane * 4) = w;
    }
}

DEVI void phase_prep(const Params& P, unsigned char* lds, int tid) {
    unsigned char* ws = P.ws;
    const int lane = tid & 63, wid = __builtin_amdgcn_readfirstlane(tid >> 6);
    int base = 0;
    for (int j = 0; j < 10; ++j) {
        const int nt = tjob_tiles(j);
        const TJob J = get_tjob(P, j);
        for (int t = blockIdx.x; t < nt; t += gridDim.x) transpose_tile(J, t, lds, tid);
        base += nt;
    }
    {
        const float* x = P.in[0]; const float* g = P.in[2]; bf16_t* hn = (bf16_t*)(ws + OFF_HN);
        for (int r = blockIdx.x * 4 + wid; r < NTOK; r += gridDim.x * 4) rms_row_bf16(x + (size_t)r * 1024, g, hn + (size_t)r * 1024, lane);
    }
    {
        f32x2* cs = (f32x2*)(ws + OFF_CS);
        for (int e = blockIdx.x * NTHREADS + tid; e < NTOK * 32; e += gridDim.x * NTHREADS) {
            const int tok = e >> 5, i = e & 31;
            const double a = (double)P.pos[tok] * P.inv_freq[i];
            double t = a * 0.15915494309189535;
            t -= floor(t);
            const float tf = (float)t;
            cs[e] = (f32x2){__builtin_amdgcn_cosf(tf), __builtin_amdgcn_sinf(tf)};
        }
    }
    {
        float* wr = (float*)(ws + OFF_WR);
        const float* g = P.in[13]; const float* wg = P.in[14]; const float* we = P.in[16];
        for (int e = blockIdx.x * NTHREADS + tid; e < 48 * 1024; e += gridDim.x * NTHREADS) {
            const int c = e >> 10, k = e & 1023;
            float v = 0.f;
            if (c < 4) v = wg[k * 4 + c]; else if (c < 36) v = we[k * 32 + (c - 4)];
            wr[e] = v * g[k];
        }
    }
    {
        float* red = (float*)lds;
        for (int job = blockIdx.x; job < 32; job += gridDim.x) {
            const int kv = job >> 4, cg8 = job & 15;
            const float* pe = P.in[kv ? 7 : 4]; const float* w1 = P.in[kv ? 8 : 5];
            const int cc = tid & 7, jj = tid >> 3;
            float s = 0.f;
            for (int j = jj; j < 2048; j += 32) s += pe[j] * w1[(size_t)j * 128 + cg8 * 8 + cc];
            red[tid] = s;
            __syncthreads();
            if (tid < 8) { float t = 0.f; for (int u = 0; u < 32; ++u) t += red[u * 8 + tid]; ((float*)(ws + OFF_BIAS1))[kv * 128 + cg8 * 8 + tid] = t; }
            __syncthreads();
        }
    }
}

DEVI void st_bf16(bf16_t* p, float v) { *p = (bf16_t)f2bf(v); }

DEVI void phase_gemm1(const Params& P, unsigned char* lds, int tid) {
    unsigned char* ws = P.ws;
    const rsrc_t rs = __builtin_amdgcn_make_buffer_rsrc((void*)P.ws, (short)0, (int)0x7fffffff, 0x00020000);
    const bf16_t* hn = (const bf16_t*)(ws + OFF_HN);
    const bf16_t* wt = (const bf16_t*)(ws + OFF_WIN_T);
    const f32x2* cs = (const f32x2*)(ws + OFF_CS);
    const int lane = tid & 63, wid = __builtin_amdgcn_readfirstlane(tid >> 6), wr = wid >> 1, wc = wid & 1, q = lane >> 4, cl = lane & 15;
    constexpr int NT_N = G1_COLS / 128;
    for (int kk = 0;; ++kk) {
        int mt, nt;
        if (!tile_map(kk, NT_N, mt, nt)) break;
        f32x4 acc[4][4];
        gemm128(acc, rs, (unsigned)(OFF_HN + (size_t)mt * 128 * 2048), RowLin{2048}, (unsigned)(OFF_WIN_T + (size_t)nt * 128 * 2048), RowLin{2048}, 16, lds, tid);
        const int c64 = nt * 2 + wc;
        const int tok0 = mt * 128 + wr * 64 + cl;
        if (c64 < 10 || (c64 >= 14 && c64 < 34)) {
            bool do_rope; float scale = 1.f; int kind;
            int g = 0, hk = 0;
            if (c64 < 8) { kind = 0; do_rope = true; scale = 0.125f * LOG2E; }
            else if (c64 == 8) { kind = 1; do_rope = true; }
            else if (c64 == 9) { kind = 2; do_rope = false; }
            else if (c64 < 22) { kind = 3; do_rope = true; scale = 0.125f * LOG2E; }
            else { kind = 4; g = (c64 - 22) >> 1; hk = (c64 - 22) & 1; do_rope = (g == 2 || g == 4); }
#pragma unroll
            for (int m = 0; m < 4; ++m) {
                const int tok = tok0 + m * 16;
                f32x4 o[4], nr[4];
#pragma unroll
                for (int n = 0; n < 4; ++n) { nr[n] = acc[m][n] * scale; o[n] = nr[n]; }
                if (do_rope) {
#pragma unroll
                    for (int n = 0; n < 2; ++n) {
                        const f32x4 c01 = *(const f32x4*)(cs + (size_t)tok * 32 + n * 16 + q * 4);
                        const f32x4 c23 = *(const f32x4*)(cs + (size_t)tok * 32 + n * 16 + q * 4 + 2);
                        const float cc[4] = {c01[0], c01[2], c23[0], c23[2]}, sn[4] = {c01[1], c01[3], c23[1], c23[3]};
#pragma unroll
                        for (int j = 0; j < 4; ++j) {
                            const float x1 = nr[n][j], x2 = nr[n + 2][j];
                            o[n][j] = x1 * cc[j] - x2 * sn[j]; o[n + 2][j] = x1 * sn[j] + x2 * cc[j];
                        }
                    }
                }
                if (kind == 0 || kind == 1 || kind == 2) {
                    bf16_t* d = (kind == 0) ? (bf16_t*)(ws + OFF_QA) + (size_t)tok * 512 + c64 * 64 : (bf16_t*)(ws + (kind == 1 ? OFF_KA : OFF_VA)) + (size_t)tok * 64;
#pragma unroll
                    for (int n = 0; n < 4; ++n) { u32x2 w; w.x = pk2(o[n][0], o[n][1]); w.y = pk2(o[n][2], o[n][3]); *(u32x2*)(d + n * 16 + q * 4) = w; }
                } else if (kind == 3) {
                    const int h = c64 - 14;
                    bf16_t* dn = (bf16_t*)(ws + OFF_QBN) + (size_t)tok * 512 + h * 64; bf16_t* dr = (bf16_t*)(ws + OFF_QBR) + (size_t)tok * 512 + h * 64;
#pragma unroll
                    for (int n = 0; n < 4; ++n) {
                        u32x2 w; w.x = pk2(nr[n][0], nr[n][1]); w.y = pk2(nr[n][2], nr[n][3]); *(u32x2*)(dn + n * 16 + q * 4) = w;
                        u32x2 v; v.x = pk2(o[n][0], o[n][1]); v.y = pk2(o[n][2], o[n][3]); *(u32x2*)(dr + n * 16 + q * 4) = v;
                    }
                } else {
                    bf16_t* d = (bf16_t*)(ws + OFF_KV + (size_t)g * KV_STRIDE);
                    const int b = tok >> 12, tl = tok & 4095;
                    if (g == 3 || g == 5) {
#pragma unroll
                        for (int n = 0; n < 4; ++n)
#pragma unroll
                            for (int j = 0; j < 4; ++j) st_bf16(d + ((size_t)((b * 2 + hk) * 64 + n * 16 + q * 4 + j)) * 4096 + tl, o[n][j]);
                    } else {
#pragma unroll
                        for (int n = 0; n < 4; ++n) { u32x2 w; w.x = pk2(o[n][0], o[n][1]); w.y = pk2(o[n][2], o[n][3]);
                            *(u32x2*)(d + ((size_t)((b * 2 + hk) * 4096 + tl)) * 64 + n * 16 + q * 4) = w; }
                    }
                }
            }
        } else if (c64 >= 10 && c64 < 14) {
            bf16_t* d = (bf16_t*)(ws + OFF_QI);
#pragma unroll
            for (int m = 0; m < 4; ++m) {
                const int tok = tok0 + m * 16;
                float cc[4], sn[4];
#pragma unroll
                for (int j = 0; j < 4; ++j) { const f32x2 c = cs[(size_t)tok * 32 + 2 * (4 * q + j)]; cc[j] = c.x; sn[j] = c.y; }
#pragma unroll
                for (int hh = 0; hh < 2; ++hh) {
                    const int head = 2 * (c64 - 10) + hh;
                    f32x4 r1, r2;
#pragma unroll
                    for (int j = 0; j < 4; ++j) { const float x1 = acc[m][2 * hh][j], x2 = acc[m][2 * hh + 1][j]; r1[j] = x1 * cc[j] - x2 * sn[j]; r2[j] = x1 * sn[j] + x2 * cc[j]; }
                    u32x2 w; w.x = pk2(r1[0], r1[1]); w.y = pk2(r1[2], r1[3]); *(u32x2*)(d + (size_t)tok * 256 + head * 32 + q * 4) = w;
                    u32x2 v; v.x = pk2(r2[0], r2[1]); v.y = pk2(r2[2], r2[3]); *(u32x2*)(d + (size_t)tok * 256 + head * 32 + 16 + q * 4) = v;
                }
            }
        } else if (c64 >= 36) {
            bf16_t* d = (bf16_t*)(ws + (c64 < 52 ? OFF_GA : OFF_GB));
            const int cb = (c64 < 52 ? c64 - 36 : c64 - 52) * 64;
#pragma unroll
            for (int m = 0; m < 4; ++m)
#pragma unroll
                for (int n = 0; n < 4; ++n) {
                    u32x2 w; w.x = pk2(sigmoidf_(acc[m][n][0]), sigmoidf_(acc[m][n][1])); w.y = pk2(sigmoidf_(acc[m][n][2]), sigmoidf_(acc[m][n][3]));
                    *(u32x2*)(d + (size_t)(tok0 + m * 16) * 1024 + cb + n * 16 + q * 4) = w;
                }
        } else if (c64 == 34) {
            bf16_t* dki = (bf16_t*)(ws + OFF_KI); float* dwi = (float*)(ws + OFF_WI); float* dg = (float*)(ws + OFF_GATES);
#pragma unroll
            for (int m = 0; m < 4; ++m) {
                const int tok = tok0 + m * 16;
                f32x4 r1, r2;
#pragma unroll
                for (int j = 0; j < 4; ++j) {
                    const f32x2 c = cs[(size_t)tok * 32 + 2 * (4 * q + j)];
                    const float x1 = acc[m][0][j], x2 = acc[m][1][j];
                    r1[j] = x1 * c.x - x2 * c.y; r2[j] = x1 * c.y + x2 * c.x;
                }
                u32x2 w; w.x = pk2(r1[0], r1[1]); w.y = pk2(r1[2], r1[3]); *(u32x2*)(dki + (size_t)tok * 32 + q * 4) = w;
                u32x2 v; v.x = pk2(r2[0], r2[1]); v.y = pk2(r2[2], r2[3]); *(u32x2*)(dki + (size_t)tok * 32 + 16 + q * 4) = v;
                if (q < 2) *(f32x4*)(dwi + (size_t)tok * 8 + q * 4) = acc[m][2];
                else { f32x4 sv; for (int j = 0; j < 4; ++j) sv[j] = sigmoidf_(acc[m][2][j]); *(f32x4*)(dg + (size_t)tok * 24 + (q * 4 - 8)) = sv; }
                { f32x4 sv; for (int j = 0; j < 4; ++j) sv[j] = sigmoidf_(acc[m][3][j]); *(f32x4*)(dg + (size_t)tok * 24 + 8 + q * 4) = sv; }
            }
        }
    }
}

DEVI float siluf_(float x) { return x * __builtin_amdgcn_rcpf(1.0f + __builtin_amdgcn_exp2f(-x * 1.4426950408889634f)); }

DEVI void phase_compress(const Params& P, unsigned char* lds, int tid) {
    unsigned char* ws = P.ws;
    const rsrc_t rs = __builtin_amdgcn_make_buffer_rsrc((void*)P.ws, (short)0, (int)0x7fffffff, 0x00020000);
    const int lane = tid & 63, wid = __builtin_amdgcn_readfirstlane(tid >> 6), wr = wid >> 1, wc = wid & 1, q = lane >> 4, cl = lane & 15;
    for (int u = blockIdx.x; u < 64; u += gridDim.x) {
        const int kv = u >> 5, mt = u & 31;
        const bf16_t* A = (const bf16_t*)(ws + OFF_KV + (size_t)kv * KV_STRIDE) + (size_t)mt * 128 * 1024;
        const bf16_t* W1 = (const bf16_t*)(ws + (kv ? OFF_W1V : OFF_W1K));
        const bf16_t* W2 = (const bf16_t*)(ws + (kv ? OFF_W2V : OFF_W2K));
        const float* bias = (const float*)(ws + OFF_BIAS1) + kv * 128;
        f32x4 acc[4][4];
        gemm128(acc, rs, (unsigned)(OFF_KV + (size_t)kv * KV_STRIDE + (size_t)mt * 128 * 2048), RowLin{2048}, (unsigned)(kv ? OFF_W1V : OFF_W1K), RowLin{4096}, 32, lds, tid);
#pragma unroll
        for (int m = 0; m < 4; ++m)
#pragma unroll
            for (int n = 0; n < 4; ++n) {
                const int col = wc * 64 + n * 16 + q * 4, row = wr * 64 + m * 16 + cl;
                const f32x4 bb = *(const f32x4*)(bias + col);
                const int ktile = col >> 6, ch = (col & 63) >> 3, wi = col & 7;
                u32x2 w; w.x = pk2(siluf_(acc[m][n][0] + bb[0]), siluf_(acc[m][n][1] + bb[1])); w.y = pk2(siluf_(acc[m][n][2] + bb[2]), siluf_(acc[m][n][3] + bb[3]));
                *(u32x2*)(lds + ktile * 16384 + row * 128 + ((ch ^ (row & 7)) << 4) + wi * 2) = w;
            }
#pragma unroll
        for (int i = 0; i < 4; ++i) {
            const int idx = tid + 256 * i;
            const int row = idx >> 4, ch16 = idx & 15, ktile = ch16 >> 3, ch = ch16 & 7;
            *(u32x4*)(lds + 32768 + ktile * 8192 + row * 128 + ((ch ^ (row & 7)) << 4)) = *(const u32x4*)(W2 + (size_t)row * 128 + ch16 * 8);
        }
        __syncthreads();
        f32x4 a2[4][2];
#pragma unroll
        for (int m = 0; m < 4; ++m) { a2[m][0] = (f32x4){0.f, 0.f, 0.f, 0.f}; a2[m][1] = (f32x4){0.f, 0.f, 0.f, 0.f}; }
#pragma unroll
        for (int kk = 0; kk < 4; ++kk) {
            const int ktile = kk >> 1, ks = kk & 1;
            bf16x8 a[4], b[2];
#pragma unroll
            for (int m = 0; m < 4; ++m) { const int row = wr * 64 + m * 16 + cl; a[m] = *(const bf16x8*)(lds + ktile * 16384 + row * 128 + (((ks * 4 + q) ^ (row & 7)) << 4)); }
#pragma unroll
            for (int n = 0; n < 2; ++n) { const int row = wc * 32 + n * 16 + cl; b[n] = *(const bf16x8*)(lds + 32768 + ktile * 8192 + row * 128 + (((ks * 4 + q) ^ (row & 7)) << 4)); }
#pragma unroll
            for (int m = 0; m < 4; ++m)
#pragma unroll
                for (int n = 0; n < 2; ++n) a2[m][n] = MFMA16(b[n], a[m], a2[m][n]);
        }
#pragma unroll
        for (int m = 0; m < 4; ++m)
#pragma unroll
            for (int n = 0; n < 2; ++n) {
                const int d = wc * 32 + n * 16 + q * 4;
                const int r = mt * 128 + wr * 64 + m * 16 + cl;
                const bool dead = ((r & 255) == 255);
                float v[4];
#pragma unroll
                for (int j = 0; j < 4; ++j) v[j] = dead ? 0.f : a2[m][n][j];
                if (kv == 0) {
                    bf16_t* kc = (bf16_t*)(ws + OFF_KC);
                    u32x2 w; w.x = pk2(v[0], v[1]); w.y = pk2(v[2], v[3]);
                    *(u32x2*)(kc + (size_t)r * 64 + d) = w;
                } else {
                    bf16_t* vct = (bf16_t*)(ws + OFF_VCT);
#pragma unroll
                    for (int j = 0; j < 4; ++j) st_bf16(vct + ((size_t)((r >> 8) * 64 + d + j)) * 256 + (r & 255), v[j]);
                }
            }
        __syncthreads();
    }
}

DEVI void phase_index(const Params& P, unsigned char* lds, int tid) {
    unsigned char* ws = P.ws;
    const bf16_t* QI = (const bf16_t*)(ws + OFF_QI);
    const bf16_t* KI = (const bf16_t*)(ws + OFF_KI);
    const float* WI = (const float*)(ws + OFF_WI);
    bf16_t* SEL = (bf16_t*)(ws + OFF_SEL);
    float* S = (float*)lds;
    const int lane = tid & 63, wid = __builtin_amdgcn_readfirstlane(tid >> 6), q = lane >> 4, cl = lane & 15;
    for (int u = blockIdx.x; u < NTOK / 4; u += gridDim.x) {
        const int b = u >> 10, w10 = u & 1023, s10 = (w10 < 512) ? w10 : 1535 - w10;
        const int t0 = s10 * 4, tok0 = b * 4096 + t0;
        const int t = t0 + wid;
        const int tok = tok0 + wid;
        if (t0 + 3 < 256) {
            for (int i = lane; i < 256; i += 64) SEL[(size_t)tok * 256 + i] = (bf16_t)(i <= t ? i : 0);
            continue;
        }
        {
            bf16x8 a[2];
#pragma unroll
            for (int hg = 0; hg < 2; ++hg) a[hg] = *(const bf16x8*)(QI + (size_t)(tok0 + (cl >> 2)) * 256 + (4 * hg + (cl & 3)) * 32 + q * 8);
            const f32x4 w0 = *(const f32x4*)(WI + (size_t)(tok0 + q) * 8), w1 = *(const f32x4*)(WI + (size_t)(tok0 + q) * 8 + 4);
            const int ktmax = (t0 + 3) >> 4;
            const bf16_t* kb = KI + (size_t)b * 4096 * 32 + cl * 32 + q * 8;
            for (int rep31 = 0; rep31 < REPS(31); ++rep31)
            for (int kt0 = wid; kt0 <= ktmax; kt0 += 16) {
                bf16x8 bk[4];
#pragma unroll
                for (int uu = 0; uu < 4; ++uu) { const int kt = (kt0 + 4 * uu <= ktmax) ? kt0 + 4 * uu : kt0; bk[uu] = *(const bf16x8*)(kb + (size_t)kt * 16 * 32); }
#pragma unroll
                for (int uu = 0; uu < 4; ++uu) {
                    const int kt = kt0 + 4 * uu;
                    f32x4 c0 = {0.f, 0.f, 0.f, 0.f}, c1 = {0.f, 0.f, 0.f, 0.f};
                    c0 = MFMA16(a[0], bk[uu], c0); c1 = MFMA16(a[1], bk[uu], c1);
                    float sc = 0.f;
#pragma unroll
                    for (int j = 0; j < 4; ++j) { sc += w0[j] * fmaxf(c0[j], 0.f); sc += w1[j] * fmaxf(c1[j], 0.f); }
                    if (kt <= ktmax) S[q * 4096 + kt * 16 + cl] = sc;
                }
            }
        }
        __syncthreads();
        {
            const int n = t + 1;
            const float* Sq = S + wid * 4096;
            if (n <= 256) {
                for (int i = lane; i < 256; i += 64) SEL[(size_t)tok * 256 + i] = (bf16_t)(i <= t ? i : 0);
            } else {
                const int nr = (n + 63) >> 6;
                float x[64];
                const float NINF = -__builtin_inff();
                float mx = NINF, mn = __builtin_inff();
#pragma unroll
                for (int r = 0; r < 64; ++r) {
                    const int key = r * 64 + lane;
                    const float v = Sq[key];
                    x[r] = (key < n) ? v : NINF;
                    mn = fminf(mn, (key < n) ? v : __builtin_inff());
                    mx = fmaxf(mx, x[r]);
                }
#pragma unroll
                for (int o = 32; o > 0; o >>= 1) { mx = fmaxf(mx, __shfl_xor(mx, o)); mn = fminf(mn, __shfl_xor(mn, o)); }
                float lo = mn, hi = mx, T; int need;
                int chi, clo = n;
                for (int rep32 = 0; rep32 < REPS(32); ++rep32) {
                lo = mn; hi = mx; clo = n;
                {
                    int c = 0;
#pragma unroll
                    for (int g8 = 0; g8 < 8; ++g8) if (g8 * 8 < nr) {
#pragma unroll
                        for (int r = g8 * 8; r < g8 * 8 + 8; ++r) c += (x[r] >= hi) ? 1 : 0;
                    }
                    chi = wave_sum_i32(c);
                }
                if (chi >= 256) { T = hi; need = 256;   }
                else {
                    float s1 = 0.f, s2 = 0.f;
#pragma unroll
                    for (int g8 = 0; g8 < 8; ++g8) if (g8 * 8 < nr) {
#pragma unroll
                        for (int r = g8 * 8; r < g8 * 8 + 8; ++r) { const float v = (x[r] == NINF) ? 0.f : x[r]; s1 += v; s2 += v * v; }
                    }
                    s1 = wave_sum_f32_dpp(s1); s2 = wave_sum_f32_dpp(s2);
                    const float fn = (float)n, mu = s1 / fn;
                    const float sg = sqrtf(fmaxf(s2 / fn - mu * mu, 1e-20f));
                    float vg;
                    {
                        const float pq = 256.0f / fn, pp = fminf(pq, 1.0f - pq);
                        const float tt = sqrtf(-2.0f * __logf(fmaxf(pp, 1e-6f)));
                        const float zz = tt - (2.515517f + 0.802853f * tt + 0.010328f * tt * tt) / (1.0f + 1.432788f * tt + 0.189269f * tt * tt + 0.001308f * tt * tt * tt);
                        vg = mu + ((pq <= 0.5f) ? zz : -zz) * sg;
                    }
                    bool found = false, adjacent = false; float thr = 0.f;
                    for (int it = 0; it < 160; ++it) {
                        if (clo - chi <= 64) break;
                        const float mid = 0.5f * lo + 0.5f * hi;
                        if (!(mid > lo && mid < hi)) { adjacent = true; break; }
                        float v = vg;
                        if (!(v > lo && v < hi) || (it & 3) == 3) v = mid;
                        int c = 0;
#pragma unroll
                        for (int g8 = 0; g8 < 8; ++g8) if (g8 * 8 < nr) {
#pragma unroll
                            for (int r = g8 * 8; r < g8 * 8 + 8; ++r) c += (x[r] >= v) ? 1 : 0;
                        }
                        c = wave_sum_i32(c);
                        if (c == 256) { found = true; thr = v; break; }
                        if (c > 256) { lo = v; clo = c; } else { hi = v; chi = c; }
                        const float zv = (v - mu) / sg;
                        const float dens = fmaxf(fn * 0.39894228f * __expf(-0.5f * zv * zv), 0.5f) / sg;
                        vg = v + ((float)c - ((c > 256) ? 244.0f : 268.0f)) / dens;
                    }
                    if (found) { T = thr; need = -1; }
                    else if (adjacent) { T = lo; need = 256 - chi; }
                    else {
                        float* cand = (float*)(lds + 65536) + wid * 64;
                        cand[lane] = NINF;
                        int cb = 0;
                        const unsigned long long ltm = (1ull << lane) - 1ull;
#pragma unroll
                        for (int g8 = 0; g8 < 8; ++g8) if (g8 * 8 < nr) {
#pragma unroll
                            for (int r = g8 * 8; r < g8 * 8 + 8; ++r) {
                                const bool isc = (x[r] >= lo) && (x[r] < hi);
                                const unsigned long long bm = __ballot(isc);
                                if (isc) cand[cb + __popcll(bm & ltm)] = x[r];
                                cb += __popcll(bm);
                            }
                        }
                        const float y = cand[lane];
                        int cgt = 0, cge = 0;
#pragma unroll
                        for (int k = 0; k < 64; ++k) { const float yk = __builtin_bit_cast(float, __builtin_amdgcn_readlane(__builtin_bit_cast(int, y), k)); cgt += (yk > y) ? 1 : 0; cge += (yk >= y) ? 1 : 0; }
                        const int nd = 256 - chi;
                        const bool isT = (y != NINF) && (cgt <= nd - 1) && (cge >= nd);
                        const unsigned long long tm = __ballot(isT);
                        const int tl = (tm != 0ull) ? (int)__builtin_ctzll(tm) : 0;
                        T = __shfl(y, tl);
                        need = nd - __shfl(cgt, tl);
                    }
                }
                asm volatile("" : "+v"(mn), "+v"(mx));
                }
                bf16_t* selb = (bf16_t*)(lds + 65536 + 1024) + wid * 256;
                for (int rep33 = 0; rep33 < REPS(33); ++rep33) {
                int base = 0, eqc = 0;
                const unsigned long long lt = (1ull << lane) - 1ull;
#pragma unroll
                for (int g8 = 0; g8 < 8; ++g8) if (g8 * 8 < nr) {
#pragma unroll
                    for (int r = g8 * 8; r < g8 * 8 + 8; ++r) {
                        bool sel;
                        if (need < 0) sel = x[r] >= T;
                        else {
                            const bool eq = (x[r] == T);
                            const unsigned long long em = __ballot(eq);
                            sel = (x[r] > T) || (eq && (eqc + __popcll(em & lt) < need));
                            eqc += __popcll(em);
                        }
                        const unsigned long long sm = __ballot(sel);
                        if (sel) { const int pp = base + __popcll(sm & lt); if (pp < 256) selb[pp] = (bf16_t)(r * 64 + lane); }
                        base += __popcll(sm);
                    }
                }
                }
                __builtin_amdgcn_wave_barrier();
                if (lane < 32) *(u32x4*)(SEL + (size_t)tok * 256 + lane * 8) = *(const u32x4*)(selb + lane * 8);
                __builtin_amdgcn_wave_barrier();
            }
        }
        __syncthreads();
    }
}

DEVI int dsa_vswz(int row) { return (((row >> 1) & 1) << 1) | (((row >> 3) & 1) << 2); }
DEVI void phase_dsa(const Params& P, unsigned char* lds, int tid) {
    unsigned char* ws = P.ws;
    const bf16_t* QA = (const bf16_t*)(ws + OFF_QA);
    const bf16_t* KA = (const bf16_t*)(ws + OFF_KA);
    const bf16_t* VA = (const bf16_t*)(ws + OFF_VA);
    const bf16_t* SEL = (const bf16_t*)(ws + OFF_SEL);
    bf16_t* OA = (bf16_t*)(ws + OFF_OA);
    const int lane = tid & 63, wid = __builtin_amdgcn_readfirstlane(tid >> 6), q = lane >> 4, cl = lane & 15;
    unsigned char* vl = lds + wid * 8192;
    const float NINF = -__builtin_inff();
    const int stride = gridDim.x * 4;
    int tok = blockIdx.x * 4 + wid;
    if (tok >= NTOK) return;
    int kidx[16], mk[4]; bf16x8 bq[2];
    {
        const bf16_t* sel = SEL + (size_t)tok * 256;
#pragma unroll
        for (int rf = 0; rf < 16; ++rf) kidx[rf] = sel[32 * (rf >> 1) + 8 * (cl >> 2) + 4 * (rf & 1) + (cl & 3)];
#pragma unroll
        for (int cc = 0; cc < 4; ++cc) mk[cc] = sel[cc * 64 + lane];
#pragma unroll
        for (int ks = 0; ks < 2; ++ks) bq[ks] = *(const bf16x8*)(QA + (size_t)tok * 512 + (cl & 7) * 64 + ks * 32 + q * 8);
    }
    const int wrow = lane >> 3;
    for (; tok < NTOK; tok += stride) {
        const int b = tok >> 12, t = tok & 4095;
        const int cnt = (t + 1 < 256) ? t + 1 : 256;
        const int nc64 = (cnt + 63) >> 6;
        const bf16_t* kb = KA + (size_t)b * 4096 * 64;
        const bf16_t* vb = VA + (size_t)b * 4096 * 64;
        const bf16x8 zero8 = {0, 0, 0, 0, 0, 0, 0, 0};
        const bf16x8 bq0 = (cl < 8) ? bq[0] : zero8, bq1 = (cl < 8) ? bq[1] : zero8;
        u32x4 vr[2][8];
#pragma unroll
        for (int i = 0; i < 8; ++i) { const int key = __shfl(mk[0], wrow + 8 * i); vr[0][i] = *(const u32x4*)(vb + (size_t)key * 64 + (lane & 7) * 8); }
        f32x4 s[16];
#pragma unroll
        for (int rf = 0; rf < 16; ++rf) {
            s[rf] = (f32x4){0.f, 0.f, 0.f, 0.f};
            if ((rf >> 2) < nc64) {
                const bf16_t* kr = kb + (size_t)kidx[rf] * 64 + q * 8;
                const bf16x8 a0 = *(const bf16x8*)(kr), a1 = *(const bf16x8*)(kr + 32);
                s[rf] = MFMA16(a0, bq0, s[rf]); s[rf] = MFMA16(a1, bq1, s[rf]);
            }
        }
        int mkc[4];
#pragma unroll
        for (int cc = 0; cc < 4; ++cc) mkc[cc] = mk[cc];
        {
            const int tn = (tok + stride < NTOK) ? tok + stride : tok;
            const bf16_t* sel = SEL + (size_t)tn * 256;
#pragma unroll
            for (int rf = 0; rf < 16; ++rf) kidx[rf] = sel[32 * (rf >> 1) + 8 * (cl >> 2) + 4 * (rf & 1) + (cl & 3)];
#pragma unroll
            for (int cc = 0; cc < 4; ++cc) mk[cc] = sel[cc * 64 + lane];
#pragma unroll
            for (int ks = 0; ks < 2; ++ks) bq[ks] = *(const bf16x8*)(QA + (size_t)tn * 512 + (cl & 7) * 64 + ks * 32 + q * 8);
        }
        float mx = NINF;
#pragma unroll
        for (int rf = 0; rf < 16; ++rf)
#pragma unroll
            for (int j = 0; j < 4; ++j) {
                const int p = 32 * (rf >> 1) + 8 * q + 4 * (rf & 1) + j;
                if (p >= cnt) s[rf][j] = NINF;
                mx = fmaxf(mx, s[rf][j]);
            }
        mx = rows_max(mx);
        float ls = 0.f;
#pragma unroll
        for (int rf = 0; rf < 16; ++rf)
#pragma unroll
            for (int j = 0; j < 4; ++j) { const float pv = __builtin_amdgcn_exp2f(s[rf][j] - mx); s[rf][j] = pv; ls += pv; }
        ls = rows_sum(ls);
        const float inv = __builtin_amdgcn_rcpf(ls);
        f32x4 o[4];
#pragma unroll
        for (int d = 0; d < 4; ++d) o[d] = (f32x4){0.f, 0.f, 0.f, 0.f};
#pragma unroll
        for (int cc = 0; cc < 4; ++cc) {
            if (cc < nc64) {
                if (cc + 1 < 4 && cc + 1 < nc64) {
#pragma unroll
                    for (int i = 0; i < 8; ++i) { const int key = __shfl(mkc[(cc + 1) & 3], wrow + 8 * i); vr[(cc + 1) & 1][i] = *(const u32x4*)(vb + (size_t)key * 64 + (lane & 7) * 8); }
                }
                __builtin_amdgcn_wave_barrier();
#pragma unroll
                for (int i = 0; i < 8; ++i) { const int row = wrow + 8 * i; *(u32x4*)(vl + row * 128 + (((lane & 7) ^ dsa_vswz(row)) << 4)) = vr[cc & 1][i]; }
                __builtin_amdgcn_wave_barrier();
#pragma unroll
                for (int c2 = 0; c2 < 2; ++c2) {
                    const bf16x8 pb = pack8(s[cc * 4 + c2 * 2], s[cc * 4 + c2 * 2 + 1]);
#pragma unroll
                    for (int d = 0; d < 4; ++d) {
                        const int r0 = c2 * 32 + 8 * q + (cl >> 2), r1 = r0 + 4;
                        const int ch = d * 2 + ((cl & 3) >> 1), wb = 8 * (cl & 1);
                        const s16x4 lo4 = __builtin_amdgcn_ds_read_tr16_b64_v4i16((LAS s16x4*)((LAS unsigned char*)(vl) + r0 * 128 + ((ch ^ dsa_vswz(r0)) << 4) + wb));
                        const s16x4 hi4 = __builtin_amdgcn_ds_read_tr16_b64_v4i16((LAS s16x4*)((LAS unsigned char*)(vl) + r1 * 128 + ((ch ^ dsa_vswz(r1)) << 4) + wb));
                        const bf16x8 av = {lo4[0], lo4[1], lo4[2], lo4[3], hi4[0], hi4[1], hi4[2], hi4[3]};
                        o[d] = MFMA16(av, pb, o[d]);
                    }
                }
            }
        }
        if (cl < 8) {
#pragma unroll
            for (int d = 0; d < 4; ++d) {
                u32x2 w; w.x = pk2(o[d][0] * inv, o[d][1] * inv); w.y = pk2(o[d][2] * inv, o[d][3] * inv);
                *(u32x2*)(OA + (size_t)tok * 512 + cl * 64 + d * 16 + q * 4) = w;
            }
        }
    }
}

DEVI int fK(int row) { return (row & 3) | (((row >> 3) & 1) << 2); }

struct AttnState { f32x4 O[4][4]; float m[4]; float l[4]; };

template <int MODE>
DEVI void attn_blocks(rsrc_t rs, unsigned sK, unsigned sV, int ldv, int jb0, int jb1, const bf16x8 (&qf)[4][2], AttnState& st,
                      int tq, unsigned long long selmask, unsigned char* lds, int tid) {
    const int lane = tid & 63, q = lane >> 4, cl = lane & 15;
    const float NINF = -__builtin_inff();
#pragma unroll
    for (int cf = 0; cf < 4; ++cf) { st.m[cf] = NINF; st.l[cf] = 0.f;
#pragma unroll
        for (int d = 0; d < 4; ++d) st.O[d][cf] = (f32x4){0.f, 0.f, 0.f, 0.f}; }
    if (jb1 < jb0) return;
    unsigned kro[2], vro[2]; int kwo[2], vwo[2];
#pragma unroll
    for (int i = 0; i < 2; ++i) {
        const int idx = tid + 256 * i, row = idx >> 3, ch = idx & 7;
        kro[i] = (unsigned)(row * 64 + ch * 8) * 2u; kwo[i] = row * 128 + ((ch ^ fK(row)) << 4);
        vro[i] = (unsigned)(row * ldv + ch * 8) * 2u; vwo[i] = 8192 + row * 128 + ((ch ^ (row & 7)) << 4);
    }
    u32x4 rk[2], rv[2];
#pragma unroll
    for (int i = 0; i < 2; ++i) { rk[i] = bload16(rs, kro[i], sK + (unsigned)jb0 * 8192u); rv[i] = bload16(rs, vro[i], sV + (unsigned)jb0 * 128u); }
#pragma unroll
    for (int i = 0; i < 2; ++i) { *(u32x4*)(lds + kwo[i]) = rk[i]; *(u32x4*)(lds + vwo[i]) = rv[i]; }
    __syncthreads();
    const int nmax = (tq >= 31) ? ((tq - 31) >> 4) : -1;
    for (int jb = jb0; jb <= jb1; ++jb) {
        unsigned char* cur = lds + ((jb - jb0) & 1) * 16384;
        unsigned char* nxt = lds + ((jb - jb0 + 1) & 1) * 16384;
        const bool more = jb < jb1;
        if (more) {
#pragma unroll
            for (int i = 0; i < 2; ++i) { rk[i] = bload16(rs, kro[i], sK + (unsigned)(jb + 1) * 8192u); rv[i] = bload16(rs, vro[i], sV + (unsigned)(jb + 1) * 128u); }
        }
        bool lane_on = true;
        if (MODE == 1) lane_on = ((selmask >> jb) & 1ull) != 0ull;
        if (MODE == 0) lane_on = (jb * 64 <= nmax);
        if (MODE == 2) lane_on = (jb * 64 + 63 > tq - 512);
        if (__ballot(lane_on) != 0ull) {
#pragma unroll
            for (int c = 0; c < 2; ++c) {
                f32x4 S[2][4];
#pragma unroll
                for (int r2 = 0; r2 < 2; ++r2)
#pragma unroll
                    for (int cf = 0; cf < 4; ++cf) S[r2][cf] = (f32x4){0.f, 0.f, 0.f, 0.f};
#pragma unroll
                for (int r2 = 0; r2 < 2; ++r2) {
                    const int kl = 32 * c + 8 * (cl >> 2) + 4 * r2 + (cl & 3);
#pragma unroll
                    for (int ks = 0; ks < 2; ++ks) {
                        const bf16x8 a = *(const bf16x8*)(cur + kl * 128 + (((ks * 4 + q) ^ (cl & 7)) << 4));
#pragma unroll
                        for (int cf = 0; cf < 4; ++cf) S[r2][cf] = MFMA16(a, qf[cf][ks], S[r2][cf]);
                    }
                }
                bool edge;
                if (MODE == 0) edge = (jb * 64 + 63 > nmax);
                else if (MODE == 1) edge = (jb * 64 + 63 > tq) || !lane_on;
                else edge = (jb * 64 + 63 > tq) || (jb * 64 <= tq - 512);
                const bool need_mask = __ballot(edge) != 0ull;
                bf16x8 pb[4];
#pragma unroll
                for (int cf = 0; cf < 4; ++cf) {
                    if (need_mask) {
#pragma unroll
                        for (int r2 = 0; r2 < 2; ++r2)
#pragma unroll
                            for (int j = 0; j < 4; ++j) {
                                const int key = jb * 64 + 32 * c + 8 * q + 4 * r2 + j;
                                bool v;
                                if (MODE == 0) v = key <= nmax;
                                else if (MODE == 1) v = lane_on && key <= tq;
                                else v = key <= tq && key > tq - 512;
                                if (!v) S[r2][cf][j] = NINF;
                            }
                    }
                    float bm = fmaxf(fmaxf(fmaxf(S[0][cf][0], S[0][cf][1]), fmaxf(S[0][cf][2], S[0][cf][3])), fmaxf(fmaxf(S[1][cf][0], S[1][cf][1]), fmaxf(S[1][cf][2], S[1][cf][3])));
                    bm = rows_max(bm);
                    const float mnew = fmaxf(st.m[cf], bm);
                    const float mref = (mnew == NINF) ? 0.f : mnew;
                    const float alpha = __builtin_amdgcn_exp2f(st.m[cf] - mref);
                    st.m[cf] = mnew;
                    float ps = 0.f;
#pragma unroll
                    for (int r2 = 0; r2 < 2; ++r2)
#pragma unroll
                        for (int j = 0; j < 4; ++j) { const float pv = __builtin_amdgcn_exp2f(S[r2][cf][j] - mref); S[r2][cf][j] = pv; ps += pv; }
                    st.l[cf] = st.l[cf] * alpha + ps;
                    if (__ballot(alpha != 1.0f) != 0ull) {
#pragma unroll
                        for (int d = 0; d < 4; ++d) st.O[d][cf] *= alpha;
                    }
                    pb[cf] = pack8(S[0][cf], S[1][cf]);
                }
#pragma unroll
                for (int d = 0; d < 4; ++d) {
                    const int row = d * 16 + cl;
                    const bf16x8 av = *(const bf16x8*)(cur + 8192 + row * 128 + (((c * 4 + q) ^ (row & 7)) << 4));
#pragma unroll
                    for (int cf = 0; cf < 4; ++cf) st.O[d][cf] = MFMA16(av, pb[cf], st.O[d][cf]);
                }
            }
        }
        if (more) {
#pragma unroll
            for (int i = 0; i < 2; ++i) { *(u32x4*)(nxt + kwo[i]) = rk[i]; *(u32x4*)(nxt + vwo[i]) = rv[i]; }
        }
        __syncthreads();
    }
}

DEVI f32x4 bload16f(rsrc_t r, unsigned voff, unsigned soff) { return __builtin_bit_cast(f32x4, __builtin_amdgcn_raw_buffer_load_b128(r, (int)voff, (int)soff, 0)); }
DEVI void bstore16f(rsrc_t r, f32x4 v, unsigned voff, unsigned soff) { __builtin_amdgcn_raw_buffer_store_b128(__builtin_bit_cast(u32x4, v), r, (int)voff, (int)soff, 0); }
DEVI float bload4f(rsrc_t r, unsigned voff, unsigned soff) { return __builtin_bit_cast(float, __builtin_amdgcn_raw_buffer_load_b32(r, (int)voff, (int)soff, 0)); }

struct NsaUnit { int i, b, k, t0, tq; unsigned tokw, tokb, qoff, goff, ooff, sQ, sG, sO; };
DEVI NsaUnit nsa_unit(int uu, int tid) {
    NsaUnit U;
    const int lane = tid & 63, wid = __builtin_amdgcn_readfirstlane(tid >> 6), q = lane >> 4, cl = lane & 15;
    const int half = uu >> 9, r = uu & 511, bk = r & 15, ii = r >> 4;
    U.i = half ? ii : 63 - ii; U.b = bk >> 1; U.k = bk & 1;
    U.t0 = U.i * 64; U.tq = U.t0 + wid * 16 + cl;
    U.tokw = (unsigned)(wid * 16 + cl);
    U.tokb = (unsigned)(U.b * 4096 + U.t0);
    U.qoff = U.tokw * 1024u + (unsigned)q * 16u;
    U.goff = U.tokw * 96u;
    U.ooff = U.tokw * 1024u + (unsigned)q * 8u;
    U.sQ = U.tokb * 1024u + (unsigned)U.k * 512u;
    U.sG = (unsigned)OFF_GATES + U.tokb * 96u + (unsigned)U.k * 16u;
    U.sO = (unsigned)OFF_OB + U.tokb * 1024u + (unsigned)U.k * 512u;
    return U;
}

DEVI void nsa_cmp_unit(const Params& P, rsrc_t rs, int uu, unsigned char* lds, int tid) {
    const int lane = tid & 63, wid = __builtin_amdgcn_readfirstlane(tid >> 6), q = lane >> 4, cl = lane & 15;
    const NsaUnit U = nsa_unit(uu, tid);
    const int i = U.i, b = U.b, k = U.k, tq = U.tq;
    AttnState st;
    bf16x8 qf[4][2];
#pragma unroll
    for (int cf = 0; cf < 4; ++cf)
#pragma unroll
        for (int ks = 0; ks < 2; ++ks) qf[cf][ks] = __builtin_bit_cast(bf16x8, bload16(rs, U.qoff, (unsigned)OFF_QBN + U.sQ + cf * 128 + ks * 64));
    const unsigned sKC = (unsigned)OFF_KC + (unsigned)(b * 2 + k) * 256u * 128u;
    const unsigned sVC = (unsigned)OFF_VCT + (unsigned)(b * 2 + k) * 64u * 512u;
    const int nmax_blk = (U.t0 + 63 - 31) >> 4;
    const int jbc = (nmax_blk >> 6) < 3 ? (nmax_blk >> 6) : 3;
    for (int rep5 = 0; rep5 < REPS(50); ++rep5) attn_blocks<0>(rs, sKC, sVC, 256, 0, jbc, qf, st, tq, 0ull, lds, tid);
    float linv[4], mfin[4];
#pragma unroll
    for (int cf = 0; cf < 4; ++cf) {
        const float l = rows_sum(st.l[cf]);
        linv[cf] = (l > 0.f) ? __builtin_amdgcn_rcpf(l) : 0.f; mfin[cf] = st.m[cf];
        const float sc = linv[cf] * bload4f(rs, U.goff, U.sG + cf * 4);
#pragma unroll
        for (int d = 0; d < 4; ++d) { const f32x4 v = st.O[d][cf] * sc; u32x2 w; w.x = pk2(v[0], v[1]); w.y = pk2(v[2], v[3]);
            __builtin_amdgcn_raw_buffer_store_b64(w, rs, (int)U.ooff, (int)(U.sO + cf * 128 + d * 32), 0); }
    }
    unsigned long long* MSKG = (unsigned long long*)(P.ws + OFF_MASK);
    if (i < 16) {
        if (q == 0) MSKG[((size_t)(b * 2 + k)) * 4096 + tq] = (2ull << i) - 1ull;
        return;
    }
    float* SUM4 = (float*)(lds + 16384);
    float* LAST = (float*)(lds + 32768);
    float* IMP2 = (float*)(lds + 49152);
    const int nmax = (tq >= 31) ? ((tq - 31) >> 4) : -1;
    for (int kb = 0; kb <= jbc; ++kb) {
#pragma unroll
        for (int ii = 0; ii < 2; ++ii) {
            const int idx = tid + 256 * ii, row = idx >> 3, ch = idx & 7;
            *(u32x4*)(lds + row * 128 + ((ch ^ fK(row)) << 4)) = bload16(rs, (unsigned)(row * 64 + ch * 8) * 2u, sKC + (unsigned)kb * 8192u);
        }
        __syncthreads();
#pragma unroll
        for (int rf = 0; rf < 4; ++rf) {
            f32x4 S[4];
#pragma unroll
            for (int cf = 0; cf < 4; ++cf) S[cf] = (f32x4){0.f, 0.f, 0.f, 0.f};
            const int kl = 32 * (rf >> 1) + 8 * (cl >> 2) + 4 * (rf & 1) + (cl & 3);
#pragma unroll
            for (int ks = 0; ks < 2; ++ks) {
                const bf16x8 a = *(const bf16x8*)(lds + kl * 128 + (((ks * 4 + q) ^ (cl & 7)) << 4));
#pragma unroll
                for (int cf = 0; cf < 4; ++cf) S[cf] = MFMA16(a, qf[cf][ks], S[cf]);
            }
            float acc4 = 0.f, accl = 0.f;
#pragma unroll
            for (int j = 0; j < 4; ++j) {
                const int key = kb * 64 + 32 * (rf >> 1) + 8 * q + 4 * (rf & 1) + j;
                float pj = 0.f;
#pragma unroll
                for (int cf = 0; cf < 4; ++cf) pj += __builtin_amdgcn_exp2f(S[cf][j] - mfin[cf]) * linv[cf];
                pj = (key <= nmax) ? pj : 0.f;
                acc4 += pj; if (j == 3) accl = pj;
            }
            const int jblk = kb * 16 + 8 * (rf >> 1) + 2 * q + (rf & 1);
            SUM4[(wid * 16 + cl) * 64 + jblk] = acc4; LAST[(wid * 16 + cl) * 64 + jblk] = accl;
        }
        __syncthreads();
    }
    {
        const int qi = tid >> 2, jg = tid & 3;
        const int jlim = (jbc + 1) * 16;
        for (int jj = 0; jj < 16; ++jj) {
            const int j = jg * 16 + jj;
            float v = (j < jlim) ? SUM4[qi * 64 + j] : 0.f;
            if (j >= 1 && j - 1 < jlim) v += LAST[qi * 64 + j - 1];
            IMP2[qi * 64 + j] = v;
        }
    }
    __syncthreads();
    {
        const int qi = tid >> 2, jg = tid & 3;
        const float* row = IMP2 + qi * 64;
        float kk[64];
#pragma unroll
        for (int j4 = 0; j4 < 16; ++j4) {
            const f32x4 v = *(const f32x4*)(row + j4 * 4);
#pragma unroll
            for (int e = 0; e < 4; ++e) {
                const int j2 = j4 * 4 + e;
                const bool f2 = (j2 == 0) || (j2 == i) || (j2 == i - 1);
                kk[j2] = (j2 > i) ? -__builtin_inff() : (f2 ? __builtin_inff() : v[e]);
            }
        }
        unsigned lo = 0u;
#pragma unroll 1
        for (int jj = 0; jj < 16; ++jj) {
            const int j = jg * 16 + jj;
            float kj = -__builtin_inff();
#pragma unroll
            for (int j2 = 0; j2 < 64; ++j2) kj = (j2 == j) ? kk[j2] : kj;
            int rank = 0;
#pragma unroll
            for (int j2 = 0; j2 < 64; ++j2) rank += (kk[j2] > kj || (kk[j2] == kj && j2 < j)) ? 1 : 0;
            if (j <= i && rank < 16) lo |= (1u << jj);
        }
        unsigned long long bits = (unsigned long long)lo << (jg * 16);
        bits |= __shfl_xor(bits, 1); bits |= __shfl_xor(bits, 2);
        if (jg == 0) MSKG[((size_t)(b * 2 + k)) * 4096 + U.t0 + qi] = bits;
    }
    __syncthreads();
}

template <int MODE>
DEVI void nsa_kv_unit(const Params& P, rsrc_t rs, int uu, unsigned char* lds, int tid) {
    const int lane = tid & 63, q = lane >> 4;
    const NsaUnit U = nsa_unit(uu, tid);
    const int i = U.i, b = U.b, k = U.k, tq = U.tq;
    AttnState st;
    bf16x8 qf[4][2];
#pragma unroll
    for (int cf = 0; cf < 4; ++cf)
#pragma unroll
        for (int ks = 0; ks < 2; ++ks) qf[cf][ks] = __builtin_bit_cast(bf16x8, bload16(rs, U.qoff, (unsigned)OFF_QBR + U.sQ + cf * 128 + ks * 64));
    const unsigned sK = (unsigned)(OFF_KV + (MODE == 1 ? 2 : 4) * KV_STRIDE) + (unsigned)(b * 2 + k) * 4096u * 128u;
    const unsigned sV = (unsigned)(OFF_KV + (MODE == 1 ? 3 : 5) * KV_STRIDE) + (unsigned)(b * 2 + k) * 64u * 8192u;
    unsigned long long mymask = 0ull;
    int j0 = 0;
    if (MODE == 1) mymask = ((const unsigned long long*)(P.ws + OFF_MASK))[((size_t)(b * 2 + k)) * 4096 + tq];
    else j0 = (i >= 8) ? i - 8 : 0;
    for (int rep5 = 0; rep5 < REPS(50 + MODE); ++rep5) attn_blocks<MODE>(rs, sK, sV, 4096, j0, i, qf, st, tq, mymask, lds, tid);
#pragma unroll
    for (int cf = 0; cf < 4; ++cf) {
        const float l = rows_sum(st.l[cf]);
        const float sc = ((l > 0.f) ? __builtin_amdgcn_rcpf(l) : 0.f) * bload4f(rs, U.goff, U.sG + (MODE == 1 ? 32 : 64) + cf * 4);
#pragma unroll
        for (int d = 0; d < 4; ++d) {
            const u32x2 pw = __builtin_bit_cast(u32x2, __builtin_amdgcn_raw_buffer_load_b64(rs, (int)U.ooff, (int)(U.sO + cf * 128 + d * 32), 0));
            f32x4 v = st.O[d][cf] * sc;
            v[0] += bf2f(pw.x & 0xffffu); v[1] += bf2f(pw.x >> 16); v[2] += bf2f(pw.y & 0xffffu); v[3] += bf2f(pw.y >> 16);
            u32x2 w; w.x = pk2(v[0], v[1]); w.y = pk2(v[2], v[3]);
            __builtin_amdgcn_raw_buffer_store_b64(w, rs, (int)U.ooff, (int)(U.sO + cf * 128 + d * 32), 0);
        }
    }
}

DEVI void phase_nsa(const Params& P, unsigned char* lds, int tid) {
    const rsrc_t rs = __builtin_amdgcn_make_buffer_rsrc((void*)P.ws, (short)0, (int)0x7fffffff, 0x00020000);
    for (int uu = blockIdx.x; uu < 1024; uu += gridDim.x) { int t = tid; asm volatile("" : "+v"(t)); nsa_cmp_unit(P, rs, uu, lds, t); }
    __syncthreads();
    for (int uu = blockIdx.x; uu < 1024; uu += gridDim.x) { int t = tid; asm volatile("" : "+v"(t)); nsa_kv_unit<1>(P, rs, uu, lds, t); }
    __syncthreads();
    for (int uu = blockIdx.x; uu < 1024; uu += gridDim.x) { int t = tid; asm volatile("" : "+v"(t)); nsa_kv_unit<2>(P, rs, uu, lds, t); }
}

DEVI void phase_merge(const Params& P, unsigned char* lds, int tid) {
    unsigned char* ws = P.ws;
    const rsrc_t rs = __builtin_amdgcn_make_buffer_rsrc((void*)P.ws, (short)0, (int)0x7fffffff, 0x00020000);
    const bf16_t* ga = (const bf16_t*)(ws + OFF_GA);
    const bf16_t* gb = (const bf16_t*)(ws + OFF_GB);
    bf16_t* mg = (bf16_t*)(ws + OFF_MERGED);
    const int lane = tid & 63, wid = __builtin_amdgcn_readfirstlane(tid >> 6), wr = wid >> 1, wc = wid & 1, q = lane >> 4, cl = lane & 15;
    for (int kk = 0;; ++kk) {
        int mt, nt;
        if (!tile_map(kk, 8, mt, nt)) break;
        f32x4 acc[4][4];
        unsigned t[4][4][2];
        gemm128(acc, rs, (unsigned)(OFF_OA + (size_t)mt * 128 * 1024), RowLin{1024}, (unsigned)(OFF_WBRA + (size_t)nt * 128 * 1024), RowLin{1024}, 8, lds, tid);
        const size_t e0 = (size_t)(mt * 128 + wr * 64 + cl) * 1024 + nt * 128 + wc * 64 + q * 4;
#pragma unroll
        for (int m = 0; m < 4; ++m)
#pragma unroll
            for (int n = 0; n < 4; ++n) {
                const u32x2 gv = *(const u32x2*)(ga + e0 + (size_t)m * 16 * 1024 + n * 16);
                t[m][n][0] = pk2(acc[m][n][0] * bf2f(gv.x & 0xffffu), acc[m][n][1] * bf2f(gv.x >> 16));
                t[m][n][1] = pk2(acc[m][n][2] * bf2f(gv.y & 0xffffu), acc[m][n][3] * bf2f(gv.y >> 16));
            }
        gemm128(acc, rs, (unsigned)(OFF_OB + (size_t)mt * 128 * 1024), RowLin{1024}, (unsigned)(OFF_WBRB + (size_t)nt * 128 * 1024), RowLin{1024}, 8, lds, tid);
#pragma unroll
        for (int m = 0; m < 4; ++m)
#pragma unroll
            for (int n = 0; n < 4; ++n) {
                const size_t o = e0 + (size_t)m * 16 * 1024 + n * 16;
                const u32x2 gv = *(const u32x2*)(gb + o);
                u32x2 w;
                w.x = pk2(bf2f(t[m][n][0] & 0xffffu) + acc[m][n][0] * bf2f(gv.x & 0xffffu), bf2f(t[m][n][0] >> 16) + acc[m][n][1] * bf2f(gv.x >> 16));
                w.y = pk2(bf2f(t[m][n][1] & 0xffffu) + acc[m][n][2] * bf2f(gv.y & 0xffffu), bf2f(t[m][n][1] >> 16) + acc[m][n][3] * bf2f(gv.y >> 16));
                *(u32x2*)(mg + o) = w;
            }
    }
}

DEVI void phase_outproj(const Params& P, unsigned char* lds, int tid) {
    unsigned char* ws = P.ws;
    const rsrc_t rs = __builtin_amdgcn_make_buffer_rsrc((void*)P.ws, (short)0, (int)0x7fffffff, 0x00020000);
    const bf16_t* mg = (const bf16_t*)(ws + OFF_MERGED);
    const bf16_t* wo = (const bf16_t*)(ws + OFF_WOUT);
    const float* x = P.in[0];
    float* x1 = P.out;
    const int lane = tid & 63, wid = __builtin_amdgcn_readfirstlane(tid >> 6), wr = wid >> 1, wc = wid & 1, q = lane >> 4, cl = lane & 15;
    for (int kk = 0;; ++kk) {
        int mt, nt;
        if (!tile_map(kk, 8, mt, nt)) break;
        f32x4 acc[4][4];
        gemm128(acc, rs, (unsigned)(OFF_MERGED + (size_t)mt * 128 * 2048), RowLin{2048}, (unsigned)(OFF_WOUT + (size_t)nt * 128 * 2048), RowLin{2048}, 16, lds, tid);
#pragma unroll
        for (int m = 0; m < 4; ++m)
#pragma unroll
            for (int n = 0; n < 4; ++n) {
                const size_t o = (size_t)(mt * 128 + wr * 64 + m * 16 + cl) * 1024 + nt * 128 + wc * 64 + n * 16 + q * 4;
                *(f32x4*)(x1 + o) = *(const f32x4*)(x + o) + acc[m][n];
            }
    }
}

DEVI void phase_router(const Params& P, unsigned char* lds, int tid) {
    unsigned char* ws = P.ws;
    const int lane = tid & 63, wid = __builtin_amdgcn_readfirstlane(tid >> 6), q = lane >> 4, cl = lane & 15;
    const float* x1 = P.out; const float* g = P.in[13];
    const float* bg = P.in[15]; const float* be = P.in[17];
    const float* WR = (const float*)(ws + OFF_WR);
    bf16_t* h2 = (bf16_t*)(ws + OFF_HN);
    unsigned* cnt = (unsigned*)(ws + OFF_CTL);
    int* list = (int*)(ws + OFF_LIST);
    float* wt = (float*)(ws + OFF_WT);
    float* WL = (float*)lds;
    float* LG = (float*)(lds + 50688);
    float* RS = (float*)(lds + 50688 + 12288);
    for (int u = blockIdx.x; u < NTOK / 64; u += gridDim.x) {
        const int row0 = u * 64 + wid * 16;
        const float* xa = x1 + (size_t)(row0 + cl) * 1024 + 4 * q;
        f32x4 acc[3];
#pragma unroll
        for (int ct = 0; ct < 3; ++ct) acc[ct] = (f32x4){0.f, 0.f, 0.f, 0.f};
        float ss = 0.f;
        for (int kc = 0; kc < 4; ++kc) {
            __syncthreads();
#pragma unroll
            for (int i = 0; i < 12; ++i) {
                const int idx = tid + 256 * i, r = idx >> 6, c4 = idx & 63;
                *(f32x4*)(WL + r * 264 + c4 * 4) = *(const f32x4*)(WR + (size_t)r * 1024 + kc * 256 + c4 * 4);
            }
            __syncthreads();
#pragma unroll
            for (int jh = 0; jh < 2; ++jh) {
                f32x4 av[8];
#pragma unroll
                for (int j = 0; j < 8; ++j) av[j] = *(const f32x4*)(xa + kc * 256 + (jh * 8 + j) * 16);
#pragma unroll
                for (int j = 0; j < 8; ++j) {
                    {
                        const int kx = kc * 256 + (jh * 8 + j) * 16 + 4 * q;
                        const f32x4 gg = *(const f32x4*)(g + kx);
                        u32x2 w; w.x = pk2(av[j][0] * gg[0], av[j][1] * gg[1]); w.y = pk2(av[j][2] * gg[2], av[j][3] * gg[3]);
                        *(u32x2*)(h2 + (size_t)(row0 + cl) * 1024 + kx) = w;
                    }
                    ss += av[j][0] * av[j][0] + av[j][1] * av[j][1] + av[j][2] * av[j][2] + av[j][3] * av[j][3];
#pragma unroll
                    for (int ct = 0; ct < 3; ++ct) {
                        const f32x4 bv = *(const f32x4*)(WL + (ct * 16 + cl) * 264 + (jh * 8 + j) * 16 + 4 * q);
#pragma unroll
                        for (int e = 0; e < 4; ++e) acc[ct] = __builtin_amdgcn_mfma_f32_16x16x4f32(av[j][e], bv[e], acc[ct], 0, 0, 0);
                    }
                }
            }
        }
        ss += __shfl_xor(ss, 16); ss += __shfl_xor(ss, 32);
        const float rs = rsqrtf(ss * (1.0f / 1024.0f) + RMS_EPS);
        if (q == 0) { RS[wid * 16 + cl] = rs; ((float*)(ws + OFF_RS))[row0 + cl] = rs; }
        __syncthreads();
#pragma unroll
        for (int j = 0; j < 4; ++j) {
            const float rj = RS[wid * 16 + 4 * q + j];
#pragma unroll
            for (int ct = 0; ct < 3; ++ct) LG[(wid * 16 + 4 * q + j) * 48 + ct * 16 + cl] = acc[ct][j] * rj;
        }
        __syncthreads();
        if (tid < 64) {
            const int r = u * 64 + tid;
            const float* lg = LG + tid * 48;
            float gl[4];
#pragma unroll
            for (int e = 0; e < 4; ++e) gl[e] = lg[e] + bg[e];
            int gs = 0; float gm = gl[0];
#pragma unroll
            for (int e = 1; e < 4; ++e) if (gl[e] > gm) { gm = gl[e]; gs = e; }
            float den = 0.f;
#pragma unroll
            for (int e = 0; e < 4; ++e) den += __expf(gl[e] - gm);
            const float gp = 1.0f / den;
            float el[8];
#pragma unroll
            for (int e = 0; e < 8; ++e) el[e] = lg[4 + gs * 8 + e] + be[gs * 8 + e];
            int i0 = 0; float v0 = el[0];
#pragma unroll
            for (int e = 1; e < 8; ++e) if (el[e] > v0) { v0 = el[e]; i0 = e; }
            int i1 = -1; float v1 = -__builtin_inff();
#pragma unroll
            for (int e = 0; e < 8; ++e) if (e != i0 && el[e] > v1) { v1 = el[e]; i1 = e; }
            const float e1 = __expf(v1 - v0);
            const float w0 = gp / (1.0f + e1), w1 = gp * e1 / (1.0f + e1);
            const int ex0 = gs * 8 + i0, ex1 = gs * 8 + i1;
            const unsigned p0 = atomicAdd(&cnt[ex0], 1u);
            list[(size_t)ex0 * NTOK + p0] = r * 2 + 0;
            const unsigned p1 = atomicAdd(&cnt[ex1], 1u);
            list[(size_t)ex1 * NTOK + p1] = r * 2 + 1;
            wt[(size_t)r * 2 + 0] = w0; wt[(size_t)r * 2 + 1] = w1;
        }
    }
}

struct RowGather { const int* idx; DEVI unsigned operator()(int r) const { return (unsigned)idx[r] * 2048u; } };
struct RowGU { int c0; DEVI unsigned operator()(int r) const {
    const int wcx = r >> 6, w = r & 63; const int col = (w < 32) ? (c0 + wcx * 32 + w) : (256 + c0 + wcx * 32 + (w - 32)); return (unsigned)col * 2048u; } };

DEVI int moe_find_tile(const unsigned* cnt, int u, int& e, int& tl) {
    int t = u, ee = 0, ce = 0;
    for (; ee < 32; ++ee) { ce = (int)cnt[ee]; const int nt = (ce + 127) >> 7; if (t < nt) break; t -= nt; }
    e = ee; tl = t; return ce;
}
DEVI void phase_moe_a(const Params& P, unsigned char* lds, int tid) {
    unsigned char* ws = P.ws;
    const rsrc_t rs = __builtin_amdgcn_make_buffer_rsrc((void*)P.ws, (short)0, (int)0x7fffffff, 0x00020000);
    const int lane = tid & 63, wid = __builtin_amdgcn_readfirstlane(tid >> 6), wr = wid >> 1, wc = wid & 1, q = lane >> 4, cl = lane & 15;
    const unsigned* cnt = (const unsigned*)(ws + OFF_CTL);
    const int* list = (const int*)(ws + OFF_LIST);
    bf16_t* act = (bf16_t*)(ws + OFF_ACT);
    int* rowtok = (int*)(lds + 65536);
    const float* RSG = (const float*)(ws + OFF_RS);
    int total = 0;
    for (int e = 0; e < 32; ++e) total += ((int)cnt[e] + 127) >> 7;
    for (int v = blockIdx.x; v < total * 4; v += gridDim.x) {
        const int u = v >> 2, nt = v & 3;
        int e, tl; const int ce = moe_find_tile(cnt, u, e, tl);
        if (tid < 128) { const int r = tl * 128 + tid; rowtok[tid] = (r < ce) ? (list[(size_t)e * NTOK + r] >> 1) : 0; }
        __syncthreads();
        bf16_t* au = act + (size_t)u * 128 * 256;
        f32x4 acc[4][4];
        gemm128(acc, rs, (unsigned)OFF_HN, RowGather{rowtok}, (unsigned)(OFF_WGU + (size_t)e * 512 * 2048), RowGU{nt * 64}, 16, lds, tid);
#pragma unroll
        for (int m = 0; m < 4; ++m)
#pragma unroll
            for (int n = 0; n < 2; ++n) {
                const int row = wr * 64 + m * 16 + cl, col = nt * 64 + wc * 32 + n * 16 + q * 4;
                const float rsv = RSG[rowtok[row]];
                const f32x4 gt = acc[m][n] * rsv, up = acc[m][n + 2] * rsv;
                u32x2 w;
                w.x = pk2(siluf_(gt[0]) * up[0], siluf_(gt[1]) * up[1]);
                w.y = pk2(siluf_(gt[2]) * up[2], siluf_(gt[3]) * up[3]);
                *(u32x2*)(au + (size_t)row * 256 + col) = w;
            }
        __syncthreads();
    }
}
DEVI void phase_moe_b(const Params& P, unsigned char* lds, int tid) {
    unsigned char* ws = P.ws;
    const rsrc_t rs = __builtin_amdgcn_make_buffer_rsrc((void*)P.ws, (short)0, (int)0x7fffffff, 0x00020000);
    const int lane = tid & 63, wid = __builtin_amdgcn_readfirstlane(tid >> 6), wr = wid >> 1, wc = wid & 1, q = lane >> 4, cl = lane & 15;
    const unsigned* cnt = (const unsigned*)(ws + OFF_CTL);
    const int* list = (const int*)(ws + OFF_LIST);
    bf16_t* Y = (bf16_t*)(ws + OFF_Y);
    int* rowas = (int*)(lds + 65536);
    int total = 0;
    for (int e = 0; e < 32; ++e) total += ((int)cnt[e] + 127) >> 7;
    for (int v = blockIdx.x; v < total * 4; v += gridDim.x) {
        const int u = v >> 2, np = v & 3;
        int e, tl; const int ce = moe_find_tile(cnt, u, e, tl);
        if (tid < 128) { const int r = tl * 128 + tid; rowas[tid] = (r < ce) ? list[(size_t)e * NTOK + r] : -1; }
        __syncthreads();
        for (int h = 0; h < 2; ++h) {
            const int nt = np * 2 + h;
            f32x4 acc[4][4];
            gemm128(acc, rs, (unsigned)(OFF_ACT + (size_t)u * 128 * 512), RowLin{512}, (unsigned)(OFF_WDN + (size_t)e * 1024 * 512 + (size_t)nt * 128 * 512), RowLin{512}, 4, lds, tid);
#pragma unroll
            for (int m = 0; m < 4; ++m) {
                const int row = wr * 64 + m * 16 + cl;
                const int as = rowas[row];
                if (as >= 0) {
                    bf16_t* yr = Y + ((size_t)(as & 1) * NTOK + (as >> 1)) * 1024 + nt * 128 + wc * 64 + q * 4;
#pragma unroll
                    for (int n = 0; n < 4; ++n) { u32x2 w; w.x = pk2(acc[m][n][0], acc[m][n][1]); w.y = pk2(acc[m][n][2], acc[m][n][3]); *(u32x2*)(yr + n * 16) = w; }
                }
            }
        }
        __syncthreads();
    }
}

DEVI void phase_final(const Params& P, int tid, bool with_moe) {
    unsigned char* ws = P.ws;
    const int lane = tid & 63, wid = __builtin_amdgcn_readfirstlane(tid >> 6);
    const bf16_t* Y = (const bf16_t*)(ws + OFF_Y);
    const float* wt = (const float*)(ws + OFF_WT);
    const float* g = P.in[20];
    float* out = P.out;
    for (int r = blockIdx.x * 4 + wid; r < NTOK; r += gridDim.x * 4) {
        float* xr = out + (size_t)r * 1024;
        const float w0 = with_moe ? wt[(size_t)r * 2] : 0.f, w1 = with_moe ? wt[(size_t)r * 2 + 1] : 0.f;
        f32x4 v[4]; float ss = 0.f;
#pragma unroll
        for (int i = 0; i < 4; ++i) {
            v[i] = *(const f32x4*)(xr + i * 256 + lane * 4);
            if (with_moe) {
                const u32x2 a = *(const u32x2*)(Y + (size_t)r * 1024 + i * 256 + lane * 4);
                const u32x2 b = *(const u32x2*)(Y + ((size_t)NTOK + r) * 1024 + i * 256 + lane * 4);
                v[i][0] += w0 * bf2f(a.x & 0xffffu) + w1 * bf2f(b.x & 0xffffu); v[i][1] += w0 * bf2f(a.x >> 16) + w1 * bf2f(b.x >> 16);
                v[i][2] += w0 * bf2f(a.y & 0xffffu) + w1 * bf2f(b.y & 0xffffu); v[i][3] += w0 * bf2f(a.y >> 16) + w1 * bf2f(b.y >> 16);
            }
            ss += v[i][0] * v[i][0] + v[i][1] * v[i][1] + v[i][2] * v[i][2] + v[i][3] * v[i][3];
        }
        ss = wave_sum(ss);
        const float rs = rsqrtf(ss * (1.0f / 1024.0f) + RMS_EPS);
#pragma unroll
        for (int i = 0; i < 4; ++i) {
            const f32x4 gg = *(const f32x4*)(g + i * 256 + lane * 4);
            f32x4 o; o[0] = v[i][0] * rs * gg[0]; o[1] = v[i][1] * rs * gg[1]; o[2] = v[i][2] * rs * gg[2]; o[3] = v[i][3] * rs * gg[3];
            *(f32x4*)(xr + i * 256 + lane * 4) = o;
        }
    }
}

#define LAUNDER_TID() do { tid = threadIdx.x; asm volatile("" : "+v"(tid)); } while (0)
__global__ void __launch_bounds__(NTHREADS, 2) fwd_megakernel(Params P) {
    extern __shared__ __attribute__((aligned(16))) unsigned char lds[];
    cg::grid_group grid = cg::this_grid();
    int tid;
    volatile LAS unsigned* bst = (volatile LAS unsigned*)(LAS unsigned char*)(lds + LDS_BYTES - 16);
    if (threadIdx.x < 4) bst[threadIdx.x] = 0u;
    __syncthreads();
    const XcdBarrier bar = xcd_barrier_post((unsigned*)(P.ws + OFF_BAR), bst);
    if (P.ph_lo != 0) grid.sync();
    for (int rep = 0; rep < REPS(10); ++rep) { LAUNDER_TID(); phase_prep(P, lds, tid); __syncthreads(); }
    xcd_barrier(bar);
    for (int rep = 0; rep < REPS(1); ++rep) { LAUNDER_TID(); phase_gemm1(P, lds, tid); }
    xcd_barrier(bar);
    for (int rep = 0; rep < REPS(2); ++rep) { LAUNDER_TID(); phase_compress(P, lds, tid); __syncthreads(); }
    for (int rep = 0; rep < REPS(3); ++rep) { LAUNDER_TID(); phase_index(P, lds, tid); __syncthreads(); }
    xcd_barrier(bar);
    for (int rep = 0; rep < REPS(4); ++rep) { LAUNDER_TID(); phase_dsa(P, lds, tid); __syncthreads(); }
    for (int rep = 0; rep < REPS(5); ++rep) { LAUNDER_TID(); phase_nsa(P, lds, tid); __syncthreads(); }
    xcd_barrier(bar);
    for (int rep = 0; rep < REPS(6); ++rep) { LAUNDER_TID(); phase_merge(P, lds, tid); }
    xcd_barrier(bar);
    for (int rep = 0; rep < REPS(7); ++rep) { LAUNDER_TID(); phase_outproj(P, lds, tid); }
    xcd_barrier(bar);
    LAUNDER_TID(); phase_router(P, lds, tid);
    xcd_barrier(bar);
    for (int rep = 0; rep < REPS(9); ++rep) { LAUNDER_TID(); phase_moe_a(P, lds, tid); }
    xcd_barrier(bar);
    for (int rep = 0; rep < REPS(11); ++rep) { LAUNDER_TID(); phase_moe_b(P, lds, tid); }
    xcd_barrier(bar);
    LAUNDER_TID(); phase_final(P, tid, true);
}

extern "C" void kernel_launch(void* const* d_in, const int* in_sizes, int n_in, void* d_out, int out_size, void* d_ws, size_t ws_size,
                              hipStream_t stream) {
    static int grid_blocks = 0;
    if (!grid_blocks) {
        int dev = 0, cus = 0, per_cu = 0;
        hipGetDevice(&dev);
        hipDeviceGetAttribute(&cus, hipDeviceAttributeMultiprocessorCount, dev);
        hipFuncSetAttribute((const void*)fwd_megakernel, hipFuncAttributeMaxDynamicSharedMemorySize, LDS_BYTES);
        hipOccupancyMaxActiveBlocksPerMultiprocessor(&per_cu, (const void*)fwd_megakernel, NTHREADS, LDS_BYTES);
        if (per_cu < 1) per_cu = 1;
        if (per_cu > 2) per_cu = 2;
        grid_blocks = cus * per_cu;
        if (ws_size < WS_END) fprintf(stderr, "kernel_launch: workspace too small: %zu < %zu\n", ws_size, (size_t)WS_END);
    }
    Params p{};
    for (int i = 0; i < 21; ++i) p.in[i] = (const float*)d_in[i];
    p.pos = (const int*)d_in[1];
    p.out = (float*)d_out;
    p.ws = (unsigned char*)d_ws;
    for (int i = 0; i < 32; ++i) p.inv_freq[i] = (double)powf(10000.0f, -(float)i / 32.0f);
    p.ph_lo = 0; p.ph_hi = 0;
    (void)hipMemsetAsync(d_ws, 0, OFF_WIN_T, stream);
    void* args[] = {&p};
    hipError_t e = hipLaunchCooperativeKernel((const void*)fwd_megakernel, dim3(grid_blocks), dim3(NTHREADS), args, LDS_BYTES, stream);
    if (e != hipSuccess) fprintf(stderr, "cooperative launch failed: %s (grid %d)\n", hipGetErrorString(e), grid_blocks);
}
```

```cpp
#include <hip/hip_runtime.h>
#include <hip/hip_cooperative_groups.h>
#include <cstdint>
#include <cstdio>
#include <cmath>
namespace cg = cooperative_groups;

#define DEVI __device__ __forceinline__
#ifndef PROBE_TWICE
#define PROBE_TWICE 0
#endif
#define REPS(k) ((PROBE_TWICE == (k)) ? 2 : 1)
typedef unsigned short bf16_t;
typedef short bf16x8 __attribute__((ext_vector_type(8)));
typedef short s16x4 __attribute__((ext_vector_type(4)));
typedef float f32x4 __attribute__((ext_vector_type(4)));
typedef float f32x2 __attribute__((ext_vector_type(2)));
typedef unsigned u32x4 __attribute__((ext_vector_type(4)));
typedef unsigned u32x2 __attribute__((ext_vector_type(2)));
#define LAS __attribute__((address_space(3)))

constexpr int NB = 8, SL = 4096, DM = 1024, NTOK = NB * SL;
constexpr int INW = 4288;
constexpr int NTHREADS = 256;
constexpr int LDS_BYTES = 81920;
constexpr float RMS_EPS = 1e-6f;
constexpr float LOG2E = 1.4426950408889634f;

constexpr int WIN_ROWS = 4352;
constexpr int G1_COLS = 4352;

constexpr size_t al256(size_t x) { return (x + 255) & ~(size_t)255; }
constexpr size_t OFF_CTL   = 0;
constexpr size_t OFF_BAR   = 4096;
constexpr size_t OFF_WIN_T = 32768;
constexpr size_t OFF_WBRA  = OFF_WIN_T + (size_t)WIN_ROWS * 1024 * 2;
constexpr size_t OFF_WBRB  = OFF_WBRA + (size_t)1024 * 512 * 2;
constexpr size_t OFF_WOUT  = OFF_WBRB + (size_t)1024 * 512 * 2;
constexpr size_t OFF_W1K   = OFF_WOUT + (size_t)1024 * 1024 * 2;
constexpr size_t OFF_W1V   = OFF_W1K + (size_t)128 * 2048 * 2;
constexpr size_t OFF_W2K   = OFF_W1V + (size_t)128 * 2048 * 2;
constexpr size_t OFF_W2V   = OFF_W2K + (size_t)64 * 128 * 2;
constexpr size_t OFF_WGU   = OFF_W2V + (size_t)64 * 128 * 2;
constexpr size_t OFF_WDN   = OFF_WGU + (size_t)32 * 512 * 1024 * 2;
constexpr size_t OFF_BIAS1 = OFF_WDN + (size_t)32 * 1024 * 256 * 2;
constexpr size_t OFF_WR    = OFF_BIAS1 + 1024;
constexpr size_t OFF_CS    = OFF_WR + (size_t)48 * 1024 * 4;
constexpr size_t OFF_HN    = OFF_CS + (size_t)NTOK * 32 * 8;
constexpr size_t OFF_QA    = OFF_HN + (size_t)NTOK * 1024 * 2;
constexpr size_t OFF_KA    = OFF_QA + (size_t)NTOK * 512 * 2;
constexpr size_t OFF_VA    = OFF_KA + (size_t)NTOK * 64 * 2;
constexpr size_t OFF_QI    = OFF_VA + (size_t)NTOK * 64 * 2;
constexpr size_t OFF_KI    = OFF_QI + (size_t)NTOK * 256 * 2;
constexpr size_t OFF_WI    = OFF_KI + (size_t)NTOK * 32 * 2;
constexpr size_t OFF_QBN   = OFF_WI + (size_t)NTOK * 8 * 4;
constexpr size_t OFF_QBR   = OFF_QBN + (size_t)NTOK * 512 * 2;
constexpr size_t KV_STRIDE = (size_t)NTOK * 128 * 2 + 65536 * 4;
constexpr size_t OFF_KV    = OFF_QBR + (size_t)NTOK * 512 * 2;
constexpr size_t OFF_GATES = OFF_KV + 6 * KV_STRIDE;
constexpr size_t OFF_QKV_END = OFF_GATES + (size_t)NTOK * 24 * 4;
constexpr size_t OFF_KC    = al256(OFF_QKV_END);
constexpr size_t OFF_VCT   = OFF_KC + (size_t)16 * 256 * 64 * 2;
constexpr size_t OFF_SEL   = OFF_VCT + (size_t)16 * 256 * 64 * 2;
constexpr size_t OFF_OA    = OFF_HN;
constexpr size_t OFF_OB    = OFF_OA + (size_t)NTOK * 512 * 2;
constexpr size_t OFF_GA    = OFF_SEL + (size_t)NTOK * 256 * 2;
constexpr size_t OFF_GB    = OFF_GA + (size_t)NTOK * 1024 * 2;
constexpr size_t OFF_MASK  = OFF_GB + (size_t)NTOK * 1024 * 2;
constexpr size_t OFF_LIST  = OFF_MASK + (size_t)16 * 4096 * 8;
constexpr size_t OFF_WT    = OFF_LIST + (size_t)32 * NTOK * 4;
constexpr size_t OFF_RS    = OFF_WT + (size_t)NTOK * 2 * 4;
constexpr size_t WS_END    = OFF_RS + (size_t)NTOK * 4;
constexpr size_t OFF_MERGED = OFF_QA;
constexpr size_t OFF_ACT    = OFF_QA;
constexpr size_t OFF_Y      = OFF_QA + (size_t)40 * 1024 * 1024;
static_assert(OFF_Y + (size_t)2 * NTOK * 1024 * 2 <= OFF_QKV_END, "Y overlay");
static_assert((size_t)544 * 128 * 256 * 2 <= (size_t)40 * 1024 * 1024, "ACT overlay");

struct Params {
    const float* in[21];
    const int* pos;
    float* out;
    unsigned char* ws;
    double inv_freq[32];
    int ph_lo, ph_hi;
};

DEVI unsigned f2bf(float f) { unsigned u = __float_as_uint(f); return (u + 0x7fffu + ((u >> 16) & 1u)) >> 16; }
typedef __bf16 bf16v2_t __attribute__((ext_vector_type(2)));
DEVI unsigned pk2(float lo, float hi) { const f32x2 v = {lo, hi}; return __builtin_bit_cast(unsigned, __builtin_convertvector(v, bf16v2_t)); }
DEVI float rows_max(float x) {
    float a = x, b = x;
    asm volatile("v_nop\n\tv_nop\n\tv_permlane16_swap_b32 %0, %1" : "+v"(a), "+v"(b));
    x = fmaxf(a, b); a = x; b = x;
    asm volatile("v_nop\n\tv_nop\n\tv_permlane32_swap_b32 %0, %1" : "+v"(a), "+v"(b));
    return fmaxf(a, b);
}
DEVI float rows_sum(float x) {
    float a = x, b = x;
    asm volatile("v_nop\n\tv_nop\n\tv_permlane16_swap_b32 %0, %1" : "+v"(a), "+v"(b));
    x = a + b; a = x; b = x;
    asm volatile("v_nop\n\tv_nop\n\tv_permlane32_swap_b32 %0, %1" : "+v"(a), "+v"(b));
    return a + b;
}
DEVI float bf2f(unsigned h) { return __uint_as_float(h << 16); }
DEVI float sigmoidf_(float x) { return __builtin_amdgcn_rcpf(1.0f + __builtin_amdgcn_exp2f(-x * 1.4426950408889634f)); }
DEVI float wave_sum(float v) {
#pragma unroll
    for (int o = 32; o > 0; o >>= 1) v += __shfl_xor(v, o);
    return v;
}
DEVI int wave_sum_i32(int v) {
    v += __builtin_amdgcn_update_dpp(0, v, 0xB1, 0xF, 0xF, true);
    v += __builtin_amdgcn_update_dpp(0, v, 0x4E, 0xF, 0xF, true);
    v += __builtin_amdgcn_update_dpp(0, v, 0x141, 0xF, 0xF, true);
    v += __builtin_amdgcn_update_dpp(0, v, 0x140, 0xF, 0xF, true);
    return __builtin_amdgcn_readlane(v, 0) + __builtin_amdgcn_readlane(v, 16) + __builtin_amdgcn_readlane(v, 32) + __builtin_amdgcn_readlane(v, 48);
}
DEVI float wave_sum_f32_dpp(float v) {
    v += __builtin_bit_cast(float, __builtin_amdgcn_update_dpp(0, __builtin_bit_cast(int, v), 0xB1, 0xF, 0xF, true));
    v += __builtin_bit_cast(float, __builtin_amdgcn_update_dpp(0, __builtin_bit_cast(int, v), 0x4E, 0xF, 0xF, true));
    v += __builtin_bit_cast(float, __builtin_amdgcn_update_dpp(0, __builtin_bit_cast(int, v), 0x141, 0xF, 0xF, true));
    v += __builtin_bit_cast(float, __builtin_amdgcn_update_dpp(0, __builtin_bit_cast(int, v), 0x140, 0xF, 0xF, true));
    const int iv = __builtin_bit_cast(int, v);
    return (__builtin_bit_cast(float, __builtin_amdgcn_readlane(iv, 0)) + __builtin_bit_cast(float, __builtin_amdgcn_readlane(iv, 16))) +
           (__builtin_bit_cast(float, __builtin_amdgcn_readlane(iv, 32)) + __builtin_bit_cast(float, __builtin_amdgcn_readlane(iv, 48)));
}
DEVI bf16x8 pack8(const f32x4& a, const f32x4& b) {
    u32x4 w; w.x = pk2(a[0], a[1]); w.y = pk2(a[2], a[3]); w.z = pk2(b[0], b[1]); w.w = pk2(b[2], b[3]);
    return __builtin_bit_cast(bf16x8, w);
}
#define MFMA16(a, b, c) __builtin_amdgcn_mfma_f32_16x16x32_bf16((a), (b), (c), 0, 0, 0)


#define XB_TMO      128
#define XB_XCNT(j)  (256  + 64 * (j))
#define XB_XSUB(j)  (1280 + 64 * (j))
#define XB_XGEN(j)  (2304 + 64 * (j))
#define XB_TOP      3328
#define XB_TOPGEN   3392
#define XCD_BAR_WORDS 3456
#define XB_SPIN_CAP (1u << 22)
DEVI unsigned xb_ld(unsigned* p)              { return __hip_atomic_load(p, __ATOMIC_RELAXED, __HIP_MEMORY_SCOPE_AGENT); }
DEVI unsigned xb_add(unsigned* p, unsigned v) { return __hip_atomic_fetch_add(p, v, __ATOMIC_RELAXED, __HIP_MEMORY_SCOPE_AGENT); }
DEVI unsigned xb_xcc_id() { return (unsigned)__builtin_amdgcn_s_getreg((3 << 11) | 20) & 0xFu; }
#define XB_SPIN(cond, bar) do { unsigned _sp = 0; while (cond) { __builtin_amdgcn_s_sleep(1); \
    if ((++_sp & 255u) == 0u) { if (xb_ld(&(bar)[XB_TMO])) break; if (_sp > XB_SPIN_CAP) { atomicAdd(&(bar)[XB_TMO], 1u); break; } } } } while (0)
struct XcdBarrier { unsigned* bar; unsigned x; volatile LAS unsigned* st; };
DEVI XcdBarrier xcd_barrier_post(unsigned* bar, volatile LAS unsigned* st) {
    XcdBarrier b; b.bar = bar; b.x = xb_xcc_id(); b.st = st;
    if (threadIdx.x == 0) (void)xb_add(&bar[XB_XCNT(b.x)], 1u);
    return b;
}
DEVI void xcd_barrier_complete(unsigned* bar, unsigned x, unsigned& nloc, unsigned& nx) {
    const unsigned G = gridDim.x * gridDim.y * gridDim.z;
    unsigned sum, cnt, mine, sp = 0u;
    for (;;) {
        sum = 0u; cnt = 0u; mine = 0u;
#pragma unroll
        for (unsigned j = 0; j < 16; ++j) { const unsigned c = xb_ld(&bar[XB_XCNT(j)]); sum += c; cnt += (c > 0u) ? 1u : 0u; mine = (j == x) ? c : mine; }
        if (sum == G) break;
        __builtin_amdgcn_s_sleep(1);
        if ((++sp & 255u) == 0u) { if (xb_ld(&bar[XB_TMO])) break; if (sp > XB_SPIN_CAP) { atomicAdd(&bar[XB_TMO], 1u); break; } }
    }
    nloc = mine > 0u ? mine : 1u; nx = cnt > 0u ? cnt : 1u;
}
DEVI void xcd_barrier(const XcdBarrier& b) {
    asm volatile("s_waitcnt vmcnt(0)" ::: "memory");
    __syncthreads();
    if (threadIdx.x == 0) {
        unsigned* bar = b.bar;
        __builtin_amdgcn_s_waitcnt(0);
        unsigned nloc = b.st[0], nx = b.st[1];
        if (nloc == 0u) { xcd_barrier_complete(bar, b.x, nloc, nx); b.st[0] = nloc; b.st[1] = nx; }
        const unsigned old = xb_add(&bar[XB_XSUB(b.x)], 1u);
        const unsigned gen = old / nloc;
        if (old + 1u == (gen + 1u) * nloc) {
            __builtin_amdgcn_fence(__ATOMIC_RELEASE, "agent");
            asm volatile("s_waitcnt vmcnt(0)" ::: "memory");
            const unsigned og = xb_add(&bar[XB_TOP], 1u);
            const unsigned tg = og / nx;
            if (og + 1u == (tg + 1u) * nx) xb_add(&bar[XB_TOPGEN], 1u);
            else XB_SPIN(xb_ld(&bar[XB_TOPGEN]) == tg, bar);
            __builtin_amdgcn_fence(__ATOMIC_ACQUIRE, "agent");
            xb_add(&bar[XB_XGEN(b.x)], 1u);
            asm volatile("s_waitcnt vmcnt(0)" ::: "memory");
        } else {
            XB_SPIN(xb_ld(&bar[XB_XGEN(b.x)]) == gen, bar);
            __builtin_amdgcn_fence(__ATOMIC_ACQUIRE, "agent");
            asm volatile("s_waitcnt vmcnt(0)" ::: "memory");
        }
    }
    __syncthreads();
}

typedef __amdgpu_buffer_rsrc_t rsrc_t;
DEVI u32x4 bload16(rsrc_t r, unsigned voff, unsigned soff) { return __builtin_bit_cast(u32x4, __builtin_amdgcn_raw_buffer_load_b128(r, (int)voff, (int)soff, 0)); }
DEVI void glds16(rsrc_t r, unsigned char* lds_dst_uniform, unsigned voff, unsigned soff) {
    __builtin_amdgcn_raw_ptr_buffer_load_lds(r, (LAS void*)lds_dst_uniform, 16, (int)voff, (int)soff, 0, 0);
}
template <class FA, class FB>
DEVI void gemm128(f32x4 (&acc)[4][4], rsrc_t rs, unsigned sA, const FA& offA, unsigned sB, const FB& offB, int nk, unsigned char* lds, int tid) {
    const int lane = tid & 63, wid = __builtin_amdgcn_readfirstlane(tid >> 6), wr = wid >> 1, wc = wid & 1;
    const int lr = tid >> 3;
    const unsigned csrc = (unsigned)(((lane & 7) ^ ((lane >> 3) & 7)) << 4);
    unsigned oa[4], ob[4];
#pragma unroll
    for (int i = 0; i < 4; ++i) { oa[i] = offA(lr + 32 * i) + csrc; ob[i] = offB(lr + 32 * i) + csrc; }
#pragma unroll
    for (int m = 0; m < 4; ++m)
#pragma unroll
        for (int n = 0; n < 4; ++n) acc[m][n] = (f32x4){0.f, 0.f, 0.f, 0.f};
    const int q = lane >> 4, r16 = lane & 15;
    const int roffA0 = (wr * 64 + r16) * 128 + (((0 + q) ^ (lane & 7)) << 4);
    const int roffA1 = (wr * 64 + r16) * 128 + (((4 + q) ^ (lane & 7)) << 4);
    const int roffB0 = 16384 + (wc * 64 + r16) * 128 + (((0 + q) ^ (lane & 7)) << 4);
    const int roffB1 = 16384 + (wc * 64 + r16) * 128 + (((4 + q) ^ (lane & 7)) << 4);
    unsigned char* wbase = lds + wid * 1024;
#pragma unroll
    for (int i = 0; i < 4; ++i) { glds16(rs, wbase + i * 4096, oa[i], sA); glds16(rs, wbase + 16384 + i * 4096, ob[i], sB); }
    for (int kt = 0; kt < nk; ++kt) {
        unsigned char* cur = lds + (kt & 1) * 32768;
        __syncthreads();
        if (kt + 1 < nk) {
            unsigned char* nb = wbase + ((kt + 1) & 1) * 32768;
#pragma unroll
            for (int i = 0; i < 4; ++i) { glds16(rs, nb + i * 4096, oa[i], sA + (kt + 1) * 128); glds16(rs, nb + 16384 + i * 4096, ob[i], sB + (kt + 1) * 128); }
        }
        bf16x8 a0[4], b0[4], a1[4], b1[4];
#pragma unroll
        for (int m = 0; m < 4; ++m) a0[m] = *(const bf16x8*)(cur + roffA0 + m * 2048);
#pragma unroll
        for (int n = 0; n < 4; ++n) b0[n] = *(const bf16x8*)(cur + roffB0 + n * 2048);
#pragma unroll
        for (int m = 0; m < 4; ++m) a1[m] = *(const bf16x8*)(cur + roffA1 + m * 2048);
#pragma unroll
        for (int n = 0; n < 4; ++n) b1[n] = *(const bf16x8*)(cur + roffB1 + n * 2048);
#pragma unroll
        for (int m = 0; m < 4; ++m)
#pragma unroll
            for (int n = 0; n < 4; ++n) acc[m][n] = MFMA16(b0[n], a0[m], acc[m][n]);
#pragma unroll
        for (int m = 0; m < 4; ++m)
#pragma unroll
            for (int n = 0; n < 4; ++n) acc[m][n] = MFMA16(b1[n], a1[m], acc[m][n]);
    }
    __syncthreads();
}

DEVI bool tile_map(int k, int ncol, int& mt, int& nt) {
    if (gridDim.x == 512) {
        const int x = blockIdx.x & 7, j = blockIdx.x >> 3;
        const int v = j + 64 * k;
        if (v >= 32 * ncol) return false;
        const int nfull = ncol >> 3, rem = ncol & 7;
        int mtl;
        if (v < nfull * 256) { const int cg = v >> 8, w = v & 255; mtl = (w >> 6) * 8 + ((w & 63) >> 3); nt = cg * 8 + (w & 7); }
        else { const int v2 = v - nfull * 256, per = 8 * rem; const int rg = v2 / per, w = v2 % per; mtl = rg * 8 + w / rem; nt = nfull * 8 + w % rem; }
        mt = x * 32 + mtl;
        return true;
    }
    const int u = blockIdx.x + gridDim.x * k;
    if (u >= 256 * ncol) return false;
    mt = u / ncol; nt = u % ncol;
    return true;
}
struct RowLin { unsigned ldb; DEVI unsigned operator()(int r) const { return (unsigned)r * ldb; } };

DEVI int win_map(int j) {
    if (j < 896) return j;
    if (j < 1408) return j - 896 + 936;
    if (j < 2176) return j - 1408 + 1448;
    if (j < 2208) return j - 2176 + 896;
    if (j < 2216) return j - 2208 + 928;
    if (j < 2240) return j;
    if (j < 2304) return -1;
    return j - 64;
}

struct TJob { const float* src; bf16_t* dst; int K, ld, nrows, perm, nb; size_t sb, db; };
DEVI TJob get_tjob(const Params& P, int j) {
    unsigned char* ws = P.ws;
    switch (j) {
        case 0: return TJob{P.in[3], (bf16_t*)(ws + OFF_WIN_T), 1024, INW, WIN_ROWS, 1, 1, 0, 0};
        case 1: return TJob{P.in[10], (bf16_t*)(ws + OFF_WBRA), 512, 1024, 1024, 0, 1, 0, 0};
        case 2: return TJob{P.in[11], (bf16_t*)(ws + OFF_WBRB), 512, 1024, 1024, 0, 1, 0, 0};
        case 3: return TJob{P.in[12], (bf16_t*)(ws + OFF_WOUT), 1024, 1024, 1024, 0, 1, 0, 0};
        case 4: return TJob{P.in[5], (bf16_t*)(ws + OFF_W1K), 2048, 128, 128, 0, 1, 0, 0};
        case 5: return TJob{P.in[8], (bf16_t*)(ws + OFF_W1V), 2048, 128, 128, 0, 1, 0, 0};
        case 6: return TJob{P.in[6], (bf16_t*)(ws + OFF_W2K), 128, 64, 64, 0, 1, 0, 0};
        case 7: return TJob{P.in[9], (bf16_t*)(ws + OFF_W2V), 128, 64, 64, 0, 1, 0, 0};
        case 8: return TJob{P.in[18], (bf16_t*)(ws + OFF_WGU), 1024, 512, 512, 0, 32, (size_t)1024 * 512, (size_t)512 * 1024};
        default: return TJob{P.in[19], (bf16_t*)(ws + OFF_WDN), 256, 1024, 1024, 0, 32, (size_t)256 * 1024, (size_t)1024 * 256};
    }
}
DEVI int tjob_tiles(int j) {
    switch (j) {
        case 0: return (WIN_ROWS / 64) * 16;
        case 1: case 2: return 16 * 8;
        case 3: return 16 * 16;
        case 4: case 5: return 2 * 32;
        case 6: case 7: return 1 * 2;
        case 8: return 32 * 8 * 16;
        default: return 32 * 16 * 4;
    }
}

DEVI void transpose_tile(const TJob& J, int tile, unsigned char* lds, int tid) {
    float* T = (float*)lds;
    const int kt = J.K / 64, rt = J.nrows / 64;
    const int b = tile / (kt * rt), rem = tile % (kt * rt);
    const int r0 = (rem / kt) * 64, k0 = (rem % kt) * 64;
    const float* src = J.src + (size_t)b * J.sb;
    bf16_t* dst = J.dst + (size_t)b * J.db;
    const int n4 = (tid & 15) * 4;
    int col = r0 + n4; if (J.perm) col = win_map(col);
    f32x4 ld4[4];
#pragma unroll
    for (int i = 0; i < 4; ++i) {
        const int kk = (tid >> 4) + 16 * i;
        ld4[i] = (col >= 0) ? *(const f32x4*)(src + (size_t)(k0 + kk) * J.ld + col) : (f32x4){0.f, 0.f, 0.f, 0.f};
    }
#pragma unroll
    for (int i = 0; i < 4; ++i) {
        const int kk = (tid >> 4) + 16 * i;
#pragma unroll
        for (int e = 0; e < 4; ++e) T[kk * 65 + n4 + e] = ld4[i][e];
    }
    __syncthreads();
    const int r2 = tid >> 2, ks = (tid & 3) * 16;
    u32x4 w0, w1;
    w0.x = pk2(T[(ks + 0) * 65 + r2], T[(ks + 1) * 65 + r2]); w0.y = pk2(T[(ks + 2) * 65 + r2], T[(ks + 3) * 65 + r2]);
    w0.z = pk2(T[(ks + 4) * 65 + r2], T[(ks + 5) * 65 + r2]); w0.w = pk2(T[(ks + 6) * 65 + r2], T[(ks + 7) * 65 + r2]);
    w1.x = pk2(T[(ks + 8) * 65 + r2], T[(ks + 9) * 65 + r2]); w1.y = pk2(T[(ks + 10) * 65 + r2], T[(ks + 11) * 65 + r2]);
    w1.z = pk2(T[(ks + 12) * 65 + r2], T[(ks + 13) * 65 + r2]); w1.w = pk2(T[(ks + 14) * 65 + r2], T[(ks + 15) * 65 + r2]);
    bf16_t* d = dst + (size_t)(r0 + r2) * J.K + k0 + ks;
    *(u32x4*)d = w0; *(u32x4*)(d + 8) = w1;
    __syncthreads();
}

DEVI void rms_row_bf16(const float* xr, const float* g, bf16_t* o, int lane) {
    f32x4 v[4]; float ss = 0.f;
#pragma unroll
    for (int i = 0; i < 4; ++i) { v[i] = *(const f32x4*)(xr + i * 256 + lane * 4); ss += v[i][0] * v[i][0] + v[i][1] * v[i][1] + v[i][2] * v[i][2] + v[i][3] * v[i][3]; }
    ss = wave_sum(ss);
    const float rs = rsqrtf(ss * (1.0f / 1024.0f) + RMS_EPS);
#pragma unroll
    for (int i = 0; i < 4; ++i) {
        const f32x4 gg = *(const f32x4*)(g + i * 256 + lane * 4);
        u32x2 w; w.x = pk2(v[i][0] * rs * gg[0], v[i][1] * rs * gg[1]); w.y = pk2(v[i][2] * rs * gg[2], v[i][3] * rs * gg[3]);
        *(u32x2*)(o + i * 256 + lane * 4) = w;
    }
}

DEVI void phase_prep(const Params& P, unsigned char* lds, int tid) {
    unsigned char* ws = P.ws;
    const int lane = tid & 63, wid = __builtin_amdgcn_readfirstlane(tid >> 6);
    int base = 0;
    for (int j = 0; j < 10; ++j) {
        const int nt = tjob_tiles(j);
        const TJob J = get_tjob(P, j);
        for (int t = blockIdx.x; t < nt; t += gridDim.x) transpose_tile(J, t, lds, tid);
        base += nt;
    }
    {
        const float* x = P.in[0]; const float* g = P.in[2]; bf16_t* hn = (bf16_t*)(ws + OFF_HN);
        for (int r = blockIdx.x * 4 + wid; r < NTOK; r += gridDim.x * 4) rms_row_bf16(x + (size_t)r * 1024, g, hn + (size_t)r * 1024, lane);
    }
    {
        f32x2* cs = (f32x2*)(ws + OFF_CS);
        for (int e = blockIdx.x * NTHREADS + tid; e < NTOK * 32; e += gridDim.x * NTHREADS) {
            const int tok = e >> 5, i = e & 31;
            const double a = (double)P.pos[tok] * P.inv_freq[i];
            double t = a * 0.15915494309189535;
            t -= floor(t);
            const float tf = (float)t;
            cs[e] = (f32x2){__builtin_amdgcn_cosf(tf), __builtin_amdgcn_sinf(tf)};
        }
    }
    {
        float* wr = (float*)(ws + OFF_WR);
        const float* g = P.in[13]; const float* wg = P.in[14]; const float* we = P.in[16];
        for (int e = blockIdx.x * NTHREADS + tid; e < 48 * 1024; e += gridDim.x * NTHREADS) {
            const int c = e >> 10, k = e & 1023;
            float v = 0.f;
            if (c < 4) v = wg[k * 4 + c]; else if (c < 36) v = we[k * 32 + (c - 4)];
            wr[e] = v * g[k];
        }
    }
    {
        float* red = (float*)lds;
        for (int job = blockIdx.x; job < 32; job += gridDim.x) {
            const int kv = job >> 4, cg8 = job & 15;
            const float* pe = P.in[kv ? 7 : 4]; const float* w1 = P.in[kv ? 8 : 5];
            const int cc = tid & 7, jj = tid >> 3;
            float s = 0.f;
            for (int j = jj; j < 2048; j += 32) s += pe[j] * w1[(size_t)j * 128 + cg8 * 8 + cc];
            red[tid] = s;
            __syncthreads();
            if (tid < 8) { float t = 0.f; for (int u = 0; u < 32; ++u) t += red[u * 8 + tid]; ((float*)(ws + OFF_BIAS1))[kv * 128 + cg8 * 8 + tid] = t; }
            __syncthreads();
        }
    }
}

DEVI void st_bf16(bf16_t* p, float v) { *p = (bf16_t)f2bf(v); }

DEVI int gemm1_col_tile(int part, int i) {
    if (part == 0) return (i < 2) ? 5 + i : ((i < 4) ? 9 + i : 17);
    return (i < 5) ? i : ((i < 9) ? i + 2 : ((i < 13) ? i + 4 : i + 5));
}
DEVI void phase_gemm1(const Params& P, unsigned char* lds, int tid, int part) {
    unsigned char* ws = P.ws;
    const rsrc_t rs = __builtin_amdgcn_make_buffer_rsrc((void*)P.ws, (short)0, (int)0x7fffffff, 0x00020000);
    const bf16_t* hn = (const bf16_t*)(ws + OFF_HN);
    const bf16_t* wt = (const bf16_t*)(ws + OFF_WIN_T);
    const f32x2* cs = (const f32x2*)(ws + OFF_CS);
    const int lane = tid & 63, wid = __builtin_amdgcn_readfirstlane(tid >> 6), wr = wid >> 1, wc = wid & 1, q = lane >> 4, cl = lane & 15;
    constexpr int NT_N = G1_COLS / 128;
    for (int kk = 0;; ++kk) {
        int mt, nti;
        if (!tile_map(kk, part == 0 ? 5 : NT_N - 5, mt, nti)) break;
        const int nt = gemm1_col_tile(part, nti);
        f32x4 acc[4][4];
        gemm128(acc, rs, (unsigned)(OFF_HN + (size_t)mt * 128 * 2048), RowLin{2048}, (unsigned)(OFF_WIN_T + (size_t)nt * 128 * 2048), RowLin{2048}, 16, lds, tid);
        const int c64 = nt * 2 + wc;
        const int tok0 = mt * 128 + wr * 64 + cl;
        if (c64 < 10 || (c64 >= 14 && c64 < 34)) {
            bool do_rope; float scale = 1.f; int kind;
            int g = 0, hk = 0;
            if (c64 < 8) { kind = 0; do_rope = true; scale = 0.125f * LOG2E; }
            else if (c64 == 8) { kind = 1; do_rope = true; }
            else if (c64 == 9) { kind = 2; do_rope = false; }
            else if (c64 < 22) { kind = 3; do_rope = true; scale = 0.125f * LOG2E; }
            else { kind = 4; g = (c64 - 22) >> 1; hk = (c64 - 22) & 1; do_rope = (g == 2 || g == 4); }
#pragma unroll
            for (int m = 0; m < 4; ++m) {
                const int tok = tok0 + m * 16;
                f32x4 o[4], nr[4];
#pragma unroll
                for (int n = 0; n < 4; ++n) { nr[n] = acc[m][n] * scale; o[n] = nr[n]; }
                if (do_rope) {
#pragma unroll
                    for (int n = 0; n < 2; ++n) {
                        const f32x4 c01 = *(const f32x4*)(cs + (size_t)tok * 32 + n * 16 + q * 4);
                        const f32x4 c23 = *(const f32x4*)(cs + (size_t)tok * 32 + n * 16 + q * 4 + 2);
                        const float cc[4] = {c01[0], c01[2], c23[0], c23[2]}, sn[4] = {c01[1], c01[3], c23[1], c23[3]};
#pragma unroll
                        for (int j = 0; j < 4; ++j) {
                            const float x1 = nr[n][j], x2 = nr[n + 2][j];
                            o[n][j] = x1 * cc[j] - x2 * sn[j]; o[n + 2][j] = x1 * sn[j] + x2 * cc[j];
                        }
                    }
                }
                if (kind == 0 || kind == 1 || kind == 2) {
                    bf16_t* d = (kind == 0) ? (bf16_t*)(ws + OFF_QA) + (size_t)tok * 512 + c64 * 64 : (bf16_t*)(ws + (kind == 1 ? OFF_KA : OFF_VA)) + (size_t)tok * 64;
#pragma unroll
                    for (int n = 0; n < 4; ++n) { u32x2 w; w.x = pk2(o[n][0], o[n][1]); w.y = pk2(o[n][2], o[n][3]); *(u32x2*)(d + n * 16 + q * 4) = w; }
                } else if (kind == 3) {
                    const int h = c64 - 14;
                    bf16_t* dn = (bf16_t*)(ws + OFF_QBN) + (size_t)tok * 512 + h * 64; bf16_t* dr = (bf16_t*)(ws + OFF_QBR) + (size_t)tok * 512 + h * 64;
#pragma unroll
                    for (int n = 0; n < 4; ++n) {
                        u32x2 w; w.x = pk2(nr[n][0], nr[n][1]); w.y = pk2(nr[n][2], nr[n][3]); *(u32x2*)(dn + n * 16 + q * 4) = w;
                        u32x2 v; v.x = pk2(o[n][0], o[n][1]); v.y = pk2(o[n][2], o[n][3]); *(u32x2*)(dr + n * 16 + q * 4) = v;
                    }
                } else {
                    bf16_t* d = (bf16_t*)(ws + OFF_KV + (size_t)g * KV_STRIDE);
                    const int b = tok >> 12, tl = tok & 4095;
                    if (g == 3 || g == 5) {
#pragma unroll
                        for (int n = 0; n < 4; ++n)
#pragma unroll
                            for (int j = 0; j < 4; ++j) st_bf16(d + ((size_t)((b * 2 + hk) * 64 + n * 16 + q * 4 + j)) * 4096 + tl, o[n][j]);
                    } else {
#pragma unroll
                        for (int n = 0; n < 4; ++n) { u32x2 w; w.x = pk2(o[n][0], o[n][1]); w.y = pk2(o[n][2], o[n][3]);
                            *(u32x2*)(d + ((size_t)((b * 2 + hk) * 4096 + tl)) * 64 + n * 16 + q * 4) = w; }
                    }
                }
            }
        } else if (c64 >= 10 && c64 < 14) {
            bf16_t* d = (bf16_t*)(ws + OFF_QI);
#pragma unroll
            for (int m = 0; m < 4; ++m) {
                const int tok = tok0 + m * 16;
                float cc[4], sn[4];
#pragma unroll
                for (int j = 0; j < 4; ++j) { const f32x2 c = cs[(size_t)tok * 32 + 2 * (4 * q + j)]; cc[j] = c.x; sn[j] = c.y; }
#pragma unroll
                for (int hh = 0; hh < 2; ++hh) {
                    const int head = 2 * (c64 - 10) + hh;
                    f32x4 r1, r2;
#pragma unroll
                    for (int j = 0; j < 4; ++j) { const float x1 = acc[m][2 * hh][j], x2 = acc[m][2 * hh + 1][j]; r1[j] = x1 * cc[j] - x2 * sn[j]; r2[j] = x1 * sn[j] + x2 * cc[j]; }
                    u32x2 w; w.x = pk2(r1[0], r1[1]); w.y = pk2(r1[2], r1[3]); *(u32x2*)(d + (size_t)tok * 256 + head * 32 + q * 4) = w;
                    u32x2 v; v.x = pk2(r2[0], r2[1]); v.y = pk2(r2[2], r2[3]); *(u32x2*)(d + (size_t)tok * 256 + head * 32 + 16 + q * 4) = v;
                }
            }
        } else if (c64 >= 36) {
            bf16_t* d = (bf16_t*)(ws + (c64 < 52 ? OFF_GA : OFF_GB));
            const int cb = (c64 < 52 ? c64 - 36 : c64 - 52) * 64;
#pragma unroll
            for (int m = 0; m < 4; ++m)
#pragma unroll
                for (int n = 0; n < 4; ++n) {
                    u32x2 w; w.x = pk2(sigmoidf_(acc[m][n][0]), sigmoidf_(acc[m][n][1])); w.y = pk2(sigmoidf_(acc[m][n][2]), sigmoidf_(acc[m][n][3]));
                    *(u32x2*)(d + (size_t)(tok0 + m * 16) * 1024 + cb + n * 16 + q * 4) = w;
                }
        } else if (c64 == 34) {
            bf16_t* dki = (bf16_t*)(ws + OFF_KI); float* dwi = (float*)(ws + OFF_WI); float* dg = (float*)(ws + OFF_GATES);
#pragma unroll
            for (int m = 0; m < 4; ++m) {
                const int tok = tok0 + m * 16;
                f32x4 r1, r2;
#pragma unroll
                for (int j = 0; j < 4; ++j) {
                    const f32x2 c = cs[(size_t)tok * 32 + 2 * (4 * q + j)];
                    const float x1 = acc[m][0][j], x2 = acc[m][1][j];
                    r1[j] = x1 * c.x - x2 * c.y; r2[j] = x1 * c.y + x2 * c.x;
                }
                u32x2 w; w.x = pk2(r1[0], r1[1]); w.y = pk2(r1[2], r1[3]); *(u32x2*)(dki + (size_t)tok * 32 + q * 4) = w;
                u32x2 v; v.x = pk2(r2[0], r2[1]); v.y = pk2(r2[2], r2[3]); *(u32x2*)(dki + (size_t)tok * 32 + 16 + q * 4) = v;
                if (q < 2) *(f32x4*)(dwi + (size_t)tok * 8 + q * 4) = acc[m][2];
                else { f32x4 sv; for (int j = 0; j < 4; ++j) sv[j] = sigmoidf_(acc[m][2][j]); *(f32x4*)(dg + (size_t)tok * 24 + (q * 4 - 8)) = sv; }
                { f32x4 sv; for (int j = 0; j < 4; ++j) sv[j] = sigmoidf_(acc[m][3][j]); *(f32x4*)(dg + (size_t)tok * 24 + 8 + q * 4) = sv; }
            }
        }
    }
}

DEVI float siluf_(float x) { return x * __builtin_amdgcn_rcpf(1.0f + __builtin_amdgcn_exp2f(-x * 1.4426950408889634f)); }

DEVI void phase_compress(const Params& P, unsigned char* lds, int tid) {
    unsigned char* ws = P.ws;
    const rsrc_t rs = __builtin_amdgcn_make_buffer_rsrc((void*)P.ws, (short)0, (int)0x7fffffff, 0x00020000);
    const int lane = tid & 63, wid = __builtin_amdgcn_readfirstlane(tid >> 6), wr = wid >> 1, wc = wid & 1, q = lane >> 4, cl = lane & 15;
    for (int u = blockIdx.x; u < 64; u += gridDim.x) {
        const int kv = u >> 5, mt = u & 31;
        const bf16_t* A = (const bf16_t*)(ws + OFF_KV + (size_t)kv * KV_STRIDE) + (size_t)mt * 128 * 1024;
        const bf16_t* W1 = (const bf16_t*)(ws + (kv ? OFF_W1V : OFF_W1K));
        const bf16_t* W2 = (const bf16_t*)(ws + (kv ? OFF_W2V : OFF_W2K));
        const float* bias = (const float*)(ws + OFF_BIAS1) + kv * 128;
        f32x4 acc[4][4];
        gemm128(acc, rs, (unsigned)(OFF_KV + (size_t)kv * KV_STRIDE + (size_t)mt * 128 * 2048), RowLin{2048}, (unsigned)(kv ? OFF_W1V : OFF_W1K), RowLin{4096}, 32, lds, tid);
#pragma unroll
        for (int m = 0; m < 4; ++m)
#pragma unroll
            for (int n = 0; n < 4; ++n) {
                const int col = wc * 64 + n * 16 + q * 4, row = wr * 64 + m * 16 + cl;
                const f32x4 bb = *(const f32x4*)(bias + col);
                const int ktile = col >> 6, ch = (col & 63) >> 3, wi = col & 7;
                u32x2 w; w.x = pk2(siluf_(acc[m][n][0] + bb[0]), siluf_(acc[m][n][1] + bb[1])); w.y = pk2(siluf_(acc[m][n][2] + bb[2]), siluf_(acc[m][n][3] + bb[3]));
                *(u32x2*)(lds + ktile * 16384 + row * 128 + ((ch ^ (row & 7)) << 4) + wi * 2) = w;
            }
#pragma unroll
        for (int i = 0; i < 4; ++i) {
            const int idx = tid + 256 * i;
            const int row = idx >> 4, ch16 = idx & 15, ktile = ch16 >> 3, ch = ch16 & 7;
            *(u32x4*)(lds + 32768 + ktile * 8192 + row * 128 + ((ch ^ (row & 7)) << 4)) = *(const u32x4*)(W2 + (size_t)row * 128 + ch16 * 8);
        }
        __syncthreads();
        f32x4 a2[4][2];
#pragma unroll
        for (int m = 0; m < 4; ++m) { a2[m][0] = (f32x4){0.f, 0.f, 0.f, 0.f}; a2[m][1] = (f32x4){0.f, 0.f, 0.f, 0.f}; }
#pragma unroll
        for (int kk = 0; kk < 4; ++kk) {
            const int ktile = kk >> 1, ks = kk & 1;
            bf16x8 a[4], b[2];
#pragma unroll
            for (int m = 0; m < 4; ++m) { const int row = wr * 64 + m * 16 + cl; a[m] = *(const bf16x8*)(lds + ktile * 16384 + row * 128 + (((ks * 4 + q) ^ (row & 7)) << 4)); }
#pragma unroll
            for (int n = 0; n < 2; ++n) { const int row = wc * 32 + n * 16 + cl; b[n] = *(const bf16x8*)(lds + 32768 + ktile * 8192 + row * 128 + (((ks * 4 + q) ^ (row & 7)) << 4)); }
#pragma unroll
            for (int m = 0; m < 4; ++m)
#pragma unroll
                for (int n = 0; n < 2; ++n) a2[m][n] = MFMA16(b[n], a[m], a2[m][n]);
        }
#pragma unroll
        for (int m = 0; m < 4; ++m)
#pragma unroll
            for (int n = 0; n < 2; ++n) {
                const int d = wc * 32 + n * 16 + q * 4;
                const int r = mt * 128 + wr * 64 + m * 16 + cl;
                const bool dead = ((r & 255) == 255);
                float v[4];
#pragma unroll
                for (int j = 0; j < 4; ++j) v[j] = dead ? 0.f : a2[m][n][j];
                if (kv == 0) {
                    bf16_t* kc = (bf16_t*)(ws + OFF_KC);
                    u32x2 w; w.x = pk2(v[0], v[1]); w.y = pk2(v[2], v[3]);
                    *(u32x2*)(kc + (size_t)r * 64 + d) = w;
                } else {
                    bf16_t* vct = (bf16_t*)(ws + OFF_VCT);
#pragma unroll
                    for (int j = 0; j < 4; ++j) st_bf16(vct + ((size_t)((r >> 8) * 64 + d + j)) * 256 + (r & 255), v[j]);
                }
            }
        __syncthreads();
    }
}

DEVI void phase_index(const Params& P, unsigned char* lds, int tid) {
    unsigned char* ws = P.ws;
    const bf16_t* QI = (const bf16_t*)(ws + OFF_QI);
    const bf16_t* KI = (const bf16_t*)(ws + OFF_KI);
    const float* WI = (const float*)(ws + OFF_WI);
    bf16_t* SEL = (bf16_t*)(ws + OFF_SEL);
    float* S = (float*)lds;
    const int lane = tid & 63, wid = __builtin_amdgcn_readfirstlane(tid >> 6), q = lane >> 4, cl = lane & 15;
    for (int u = blockIdx.x; u < NTOK / 4; u += gridDim.x) {
        const int b = u >> 10, w10 = u & 1023, s10 = (w10 < 512) ? w10 : 1535 - w10;
        const int t0 = s10 * 4, tok0 = b * 4096 + t0;
        const int t = t0 + wid;
        const int tok = tok0 + wid;
        if (t0 + 3 < 256) {
            for (int i = lane; i < 256; i += 64) SEL[(size_t)tok * 256 + i] = (bf16_t)(i <= t ? i : 0);
            continue;
        }
        {
            bf16x8 a[2];
#pragma unroll
            for (int hg = 0; hg < 2; ++hg) a[hg] = *(const bf16x8*)(QI + (size_t)(tok0 + (cl >> 2)) * 256 + (4 * hg + (cl & 3)) * 32 + q * 8);
            const f32x4 w0 = *(const f32x4*)(WI + (size_t)(tok0 + q) * 8), w1 = *(const f32x4*)(WI + (size_t)(tok0 + q) * 8 + 4);
            const int ktmax = (t0 + 3) >> 4;
            const bf16_t* kb = KI + (size_t)b * 4096 * 32 + cl * 32 + q * 8;
            for (int kt0 = wid; kt0 <= ktmax; kt0 += 16) {
                bf16x8 bk[4];
#pragma unroll
                for (int uu = 0; uu < 4; ++uu) { const int kt = (kt0 + 4 * uu <= ktmax) ? kt0 + 4 * uu : kt0; bk[uu] = *(const bf16x8*)(kb + (size_t)kt * 16 * 32); }
#pragma unroll
                for (int uu = 0; uu < 4; ++uu) {
                    const int kt = kt0 + 4 * uu;
                    f32x4 c0 = {0.f, 0.f, 0.f, 0.f}, c1 = {0.f, 0.f, 0.f, 0.f};
                    c0 = MFMA16(a[0], bk[uu], c0); c1 = MFMA16(a[1], bk[uu], c1);
                    float sc = 0.f;
#pragma unroll
                    for (int j = 0; j < 4; ++j) { sc += w0[j] * fmaxf(c0[j], 0.f); sc += w1[j] * fmaxf(c1[j], 0.f); }
                    if (kt <= ktmax) S[q * 4096 + kt * 16 + cl] = sc;
                }
            }
        }
        __syncthreads();
        {
            const int n = t + 1;
            const float* Sq = S + wid * 4096;
            if (n <= 256) {
                for (int i = lane; i < 256; i += 64) SEL[(size_t)tok * 256 + i] = (bf16_t)(i <= t ? i : 0);
            } else {
                const int nr = (n + 63) >> 6;
                float x[64];
                const float NINF = -__builtin_inff();
                float mx = NINF, mn = __builtin_inff();
#pragma unroll
                for (int r = 0; r < 64; ++r) {
                    const int key = r * 64 + lane;
                    const float v = Sq[key];
                    x[r] = (key < n) ? v : NINF;
                    mn = fminf(mn, (key < n) ? v : __builtin_inff());
                    mx = fmaxf(mx, x[r]);
                }
#pragma unroll
                for (int o = 32; o > 0; o >>= 1) { mx = fmaxf(mx, __shfl_xor(mx, o)); mn = fminf(mn, __shfl_xor(mn, o)); }
                float lo = mn, hi = mx, T; int need;
                int chi, clo = n;
                for (int rep32 = 0; rep32 < REPS(32); ++rep32) {
                lo = mn; hi = mx; clo = n;
                {
                    int c = 0;
#pragma unroll
                    for (int g8 = 0; g8 < 8; ++g8) if (g8 * 8 < nr) {
#pragma unroll
                        for (int r = g8 * 8; r < g8 * 8 + 8; ++r) c += (x[r] >= hi) ? 1 : 0;
                    }
                    chi = wave_sum_i32(c);
                }
                if (chi >= 256) { T = hi; need = 256;   }
                else {
                    float s1 = 0.f, s2 = 0.f;
#pragma unroll
                    for (int g8 = 0; g8 < 8; ++g8) if (g8 * 8 < nr) {
#pragma unroll
                        for (int r = g8 * 8; r < g8 * 8 + 8; ++r) { const float v = (x[r] == NINF) ? 0.f : x[r]; s1 += v; s2 += v * v; }
                    }
                    s1 = wave_sum_f32_dpp(s1); s2 = wave_sum_f32_dpp(s2);
                    const float fn = (float)n, mu = s1 / fn;
                    const float sg = sqrtf(fmaxf(s2 / fn - mu * mu, 1e-20f));
                    float vg;
                    {
                        const float pq = 256.0f / fn, pp = fminf(pq, 1.0f - pq);
                        const float tt = sqrtf(-2.0f * __logf(fmaxf(pp, 1e-6f)));
                        const float zz = tt - (2.515517f + 0.802853f * tt + 0.010328f * tt * tt) / (1.0f + 1.432788f * tt + 0.189269f * tt * tt + 0.001308f * tt * tt * tt);
                        vg = mu + ((pq <= 0.5f) ? zz : -zz) * sg;
                    }
                    bool found = false, adjacent = false; float thr = 0.f;
                    for (int it = 0; it < 160; ++it) {
                        if (clo - chi <= 64) break;
                        const float mid = 0.5f * lo + 0.5f * hi;
                        if (!(mid > lo && mid < hi)) { adjacent = true; break; }
                        float v = vg;
                        if (!(v > lo && v < hi) || (it & 3) == 3) v = mid;
                        int c = 0;
#pragma unroll
                        for (int g8 = 0; g8 < 8; ++g8) if (g8 * 8 < nr) {
#pragma unroll
                            for (int r = g8 * 8; r < g8 * 8 + 8; ++r) c += (x[r] >= v) ? 1 : 0;
                        }
                        c = wave_sum_i32(c);
                        if (c == 256) { found = true; thr = v; break; }
                        if (c > 256) { lo = v; clo = c; } else { hi = v; chi = c; }
                        const float zv = (v - mu) / sg;
                        const float dens = fmaxf(fn * 0.39894228f * __expf(-0.5f * zv * zv), 0.5f) / sg;
                        vg = v + ((float)c - ((c > 256) ? 244.0f : 268.0f)) / dens;
                    }
                    if (found) { T = thr; need = -1; }
                    else if (adjacent) { T = lo; need = 256 - chi; }
                    else {
                        float* cand = (float*)(lds + 65536) + wid * 64;
                        cand[lane] = NINF;
                        int cb = 0;
                        const unsigned long long ltm = (1ull << lane) - 1ull;
#pragma unroll
                        for (int g8 = 0; g8 < 8; ++g8) if (g8 * 8 < nr) {
#pragma unroll
                            for (int r = g8 * 8; r < g8 * 8 + 8; ++r) {
                                const bool isc = (x[r] >= lo) && (x[r] < hi);
                                const unsigned long long bm = __ballot(isc);
                                if (isc) cand[cb + __popcll(bm & ltm)] = x[r];
                                cb += __popcll(bm);
                            }
                        }
                        const float y = cand[lane];
                        int cgt = 0, cge = 0;
#pragma unroll
                        for (int k = 0; k < 64; ++k) { const float yk = __builtin_bit_cast(float, __builtin_amdgcn_readlane(__builtin_bit_cast(int, y), k)); cgt += (yk > y) ? 1 : 0; cge += (yk >= y) ? 1 : 0; }
                        const int nd = 256 - chi;
                        const bool isT = (y != NINF) && (cgt <= nd - 1) && (cge >= nd);
                        const unsigned long long tm = __ballot(isT);
                        const int tl = (tm != 0ull) ? (int)__builtin_ctzll(tm) : 0;
                        T = __shfl(y, tl);
                        need = nd - __shfl(cgt, tl);
                    }
                }
                asm volatile("" : "+v"(mn), "+v"(mx));
                }
                bf16_t* selb = (bf16_t*)(lds + 65536 + 1024) + wid * 256;
                for (int rep33 = 0; rep33 < REPS(33); ++rep33) {
                int base = 0, eqc = 0;
                const unsigned long long lt = (1ull << lane) - 1ull;
#pragma unroll
                for (int g8 = 0; g8 < 8; ++g8) if (g8 * 8 < nr) {
#pragma unroll
                    for (int r = g8 * 8; r < g8 * 8 + 8; ++r) {
                        bool sel;
                        if (need < 0) sel = x[r] >= T;
                        else {
                            const bool eq = (x[r] == T);
                            const unsigned long long em = __ballot(eq);
                            sel = (x[r] > T) || (eq && (eqc + __popcll(em & lt) < need));
                            eqc += __popcll(em);
                        }
                        const unsigned long long sm = __ballot(sel);
                        if (sel) { const int pp = base + __popcll(sm & lt); if (pp < 256) selb[pp] = (bf16_t)(r * 64 + lane); }
                        base += __popcll(sm);
                    }
                }
                }
                __builtin_amdgcn_wave_barrier();
                if (lane < 32) *(u32x4*)(SEL + (size_t)tok * 256 + lane * 8) = *(const u32x4*)(selb + lane * 8);
                __builtin_amdgcn_wave_barrier();
            }
        }
        __syncthreads();
    }
}

DEVI int dsa_vswz(int row) { return (((row >> 1) & 1) << 1) | (((row >> 3) & 1) << 2); }
DEVI void phase_dsa(const Params& P, unsigned char* lds, int tid) {
    unsigned char* ws = P.ws;
    const bf16_t* QA = (const bf16_t*)(ws + OFF_QA);
    const bf16_t* KA = (const bf16_t*)(ws + OFF_KA);
    const bf16_t* VA = (const bf16_t*)(ws + OFF_VA);
    const bf16_t* SEL = (const bf16_t*)(ws + OFF_SEL);
    bf16_t* OA = (bf16_t*)(ws + OFF_OA);
    const int lane = tid & 63, wid = __builtin_amdgcn_readfirstlane(tid >> 6), q = lane >> 4, cl = lane & 15;
    unsigned char* vl = lds + wid * 8192;
    const float NINF = -__builtin_inff();
    const int stride = gridDim.x * 4;
    int tok = blockIdx.x * 4 + wid;
    if (tok >= NTOK) return;
    int kidx[16], mk[4]; bf16x8 bq[2];
    {
        const bf16_t* sel = SEL + (size_t)tok * 256;
#pragma unroll
        for (int rf = 0; rf < 16; ++rf) kidx[rf] = sel[32 * (rf >> 1) + 8 * (cl >> 2) + 4 * (rf & 1) + (cl & 3)];
#pragma unroll
        for (int cc = 0; cc < 4; ++cc) mk[cc] = sel[cc * 64 + lane];
#pragma unroll
        for (int ks = 0; ks < 2; ++ks) bq[ks] = *(const bf16x8*)(QA + (size_t)tok * 512 + (cl & 7) * 64 + ks * 32 + q * 8);
    }
    const int wrow = lane >> 3;
    for (; tok < NTOK; tok += stride) {
        const int b = tok >> 12, t = tok & 4095;
        const int cnt = (t + 1 < 256) ? t + 1 : 256;
        const int nc64 = (cnt + 63) >> 6;
        const bf16_t* kb = KA + (size_t)b * 4096 * 64;
        const bf16_t* vb = VA + (size_t)b * 4096 * 64;
        const bf16x8 zero8 = {0, 0, 0, 0, 0, 0, 0, 0};
        const bf16x8 bq0 = (cl < 8) ? bq[0] : zero8, bq1 = (cl < 8) ? bq[1] : zero8;
        u32x4 vr[8];
#pragma unroll
        for (int i = 0; i < 8; ++i) { const int key = __shfl(mk[0], wrow + 8 * i); vr[i] = *(const u32x4*)(vb + (size_t)key * 64 + (lane & 7) * 8); }
        f32x4 s[16];
#pragma unroll
        for (int rf = 0; rf < 16; ++rf) {
            s[rf] = (f32x4){0.f, 0.f, 0.f, 0.f};
            if ((rf >> 2) < nc64) {
                const bf16_t* kr = kb + (size_t)kidx[rf] * 64 + q * 8;
                const bf16x8 a0 = *(const bf16x8*)(kr), a1 = *(const bf16x8*)(kr + 32);
                s[rf] = MFMA16(a0, bq0, s[rf]); s[rf] = MFMA16(a1, bq1, s[rf]);
            }
            if ((rf & 3) == 3) asm volatile("" ::: "memory");
        }
        int mkc[4];
#pragma unroll
        for (int cc = 0; cc < 4; ++cc) mkc[cc] = mk[cc];
        {
            const int tn = (tok + stride < NTOK) ? tok + stride : tok;
            const bf16_t* sel = SEL + (size_t)tn * 256;
#pragma unroll
            for (int rf = 0; rf < 16; ++rf) kidx[rf] = sel[32 * (rf >> 1) + 8 * (cl >> 2) + 4 * (rf & 1) + (cl & 3)];
#pragma unroll
            for (int cc = 0; cc < 4; ++cc) mk[cc] = sel[cc * 64 + lane];
#pragma unroll
            for (int ks = 0; ks < 2; ++ks) bq[ks] = *(const bf16x8*)(QA + (size_t)tn * 512 + (cl & 7) * 64 + ks * 32 + q * 8);
        }
        float mx = NINF;
#pragma unroll
        for (int rf = 0; rf < 16; ++rf)
#pragma unroll
            for (int j = 0; j < 4; ++j) {
                const int p = 32 * (rf >> 1) + 8 * q + 4 * (rf & 1) + j;
                if (p >= cnt) s[rf][j] = NINF;
                mx = fmaxf(mx, s[rf][j]);
            }
        mx = rows_max(mx);
        float ls = 0.f;
#pragma unroll
        for (int rf = 0; rf < 16; ++rf)
#pragma unroll
            for (int j = 0; j < 4; ++j) { const float pv = __builtin_amdgcn_exp2f(s[rf][j] - mx); s[rf][j] = pv; ls += pv; }
        ls = rows_sum(ls);
        const float inv = __builtin_amdgcn_rcpf(ls);
        bf16x8 pbs[8];
#pragma unroll
        for (int c8 = 0; c8 < 8; ++c8) pbs[c8] = pack8(s[2 * c8], s[2 * c8 + 1]);
        f32x4 o[4];
#pragma unroll
        for (int d = 0; d < 4; ++d) o[d] = (f32x4){0.f, 0.f, 0.f, 0.f};
#pragma unroll
        for (int cc = 0; cc < 4; ++cc) {
            if (cc < nc64) {
                __builtin_amdgcn_wave_barrier();
#pragma unroll
                for (int i = 0; i < 8; ++i) { const int row = wrow + 8 * i; *(u32x4*)(vl + row * 128 + (((lane & 7) ^ dsa_vswz(row)) << 4)) = vr[i]; }
                __builtin_amdgcn_wave_barrier();
                if (cc + 1 < 4 && cc + 1 < nc64) {
#pragma unroll
                    for (int i = 0; i < 8; ++i) { const int key = __shfl(mkc[(cc + 1) & 3], wrow + 8 * i); vr[i] = *(const u32x4*)(vb + (size_t)key * 64 + (lane & 7) * 8); }
                }
#pragma unroll
                for (int c2 = 0; c2 < 2; ++c2) {
                    const bf16x8 pb = pbs[cc * 2 + c2];
#pragma unroll
                    for (int d = 0; d < 4; ++d) {
                        const int r0 = c2 * 32 + 8 * q + (cl >> 2), r1 = r0 + 4;
                        const int ch = d * 2 + ((cl & 3) >> 1), wb = 8 * (cl & 1);
                        const s16x4 lo4 = __builtin_amdgcn_ds_read_tr16_b64_v4i16((LAS s16x4*)((LAS unsigned char*)(vl) + r0 * 128 + ((ch ^ dsa_vswz(r0)) << 4) + wb));
                        const s16x4 hi4 = __builtin_amdgcn_ds_read_tr16_b64_v4i16((LAS s16x4*)((LAS unsigned char*)(vl) + r1 * 128 + ((ch ^ dsa_vswz(r1)) << 4) + wb));
                        const bf16x8 av = {lo4[0], lo4[1], lo4[2], lo4[3], hi4[0], hi4[1], hi4[2], hi4[3]};
                        o[d] = MFMA16(av, pb, o[d]);
                    }
                }
            }
        }
        if (cl < 8) {
#pragma unroll
            for (int d = 0; d < 4; ++d) {
                u32x2 w; w.x = pk2(o[d][0] * inv, o[d][1] * inv); w.y = pk2(o[d][2] * inv, o[d][3] * inv);
                *(u32x2*)(OA + (size_t)tok * 512 + cl * 64 + d * 16 + q * 4) = w;
            }
        }
    }
}

DEVI int fK(int row) { return (row & 3) | (((row >> 3) & 1) << 2); }

struct AttnState { f32x4 O[4][4]; float m[4]; float l[4]; };

template <int MODE>
DEVI void attn_blocks(rsrc_t rs, unsigned sK, unsigned sV, int ldv, int jb0, int jb1, const bf16x8 (&qf)[4][2], AttnState& st,
                      int tq, unsigned long long selmask, unsigned char* lds, int tid) {
    const int lane = tid & 63, q = lane >> 4, cl = lane & 15;
    const float NINF = -__builtin_inff();
#pragma unroll
    for (int cf = 0; cf < 4; ++cf) { st.m[cf] = NINF; st.l[cf] = 0.f;
#pragma unroll
        for (int d = 0; d < 4; ++d) st.O[d][cf] = (f32x4){0.f, 0.f, 0.f, 0.f}; }
    if (jb1 < jb0) return;
    unsigned kro[2], vro[2]; int kwo[2], vwo[2];
#pragma unroll
    for (int i = 0; i < 2; ++i) {
        const int idx = tid + 256 * i, row = idx >> 3, ch = idx & 7;
        kro[i] = (unsigned)(row * 64 + ch * 8) * 2u; kwo[i] = row * 128 + ((ch ^ fK(row)) << 4);
        vro[i] = (unsigned)(row * ldv + ch * 8) * 2u; vwo[i] = 8192 + row * 128 + ((ch ^ (row & 7)) << 4);
    }
    u32x4 rk[2], rv[2];
#pragma unroll
    for (int i = 0; i < 2; ++i) { rk[i] = bload16(rs, kro[i], sK + (unsigned)jb0 * 8192u); rv[i] = bload16(rs, vro[i], sV + (unsigned)jb0 * 128u); }
#pragma unroll
    for (int i = 0; i < 2; ++i) { *(u32x4*)(lds + kwo[i]) = rk[i]; *(u32x4*)(lds + vwo[i]) = rv[i]; }
    __syncthreads();
    const int nmax = (tq >= 31) ? ((tq - 31) >> 4) : -1;
    for (int jb = jb0; jb <= jb1; ++jb) {
        unsigned char* cur = lds + ((jb - jb0) & 1) * 16384;
        unsigned char* nxt = lds + ((jb - jb0 + 1) & 1) * 16384;
        const bool more = jb < jb1;
        if (more) {
#pragma unroll
            for (int i = 0; i < 2; ++i) { rk[i] = bload16(rs, kro[i], sK + (unsigned)(jb + 1) * 8192u); rv[i] = bload16(rs, vro[i], sV + (unsigned)(jb + 1) * 128u); }
        }
        bool lane_on = true;
        if (MODE == 1) lane_on = ((selmask >> jb) & 1ull) != 0ull;
        if (MODE == 0) lane_on = (jb * 64 <= nmax);
        if (MODE == 2) lane_on = (jb * 64 + 63 > tq - 512);
        if (__ballot(lane_on) != 0ull) {
#pragma unroll
            for (int c = 0; c < 2; ++c) {
                f32x4 S[2][4];
#pragma unroll
                for (int r2 = 0; r2 < 2; ++r2)
#pragma unroll
                    for (int cf = 0; cf < 4; ++cf) S[r2][cf] = (f32x4){0.f, 0.f, 0.f, 0.f};
#pragma unroll
                for (int r2 = 0; r2 < 2; ++r2) {
                    const int kl = 32 * c + 8 * (cl >> 2) + 4 * r2 + (cl & 3);
#pragma unroll
                    for (int ks = 0; ks < 2; ++ks) {
                        const bf16x8 a = *(const bf16x8*)(cur + kl * 128 + (((ks * 4 + q) ^ (cl & 7)) << 4));
#pragma unroll
                        for (int cf = 0; cf < 4; ++cf) S[r2][cf] = MFMA16(a, qf[cf][ks], S[r2][cf]);
                    }
                }
                bool edge;
                if (MODE == 0) edge = (jb * 64 + 63 > nmax);
                else if (MODE == 1) edge = (jb * 64 + 63 > tq) || !lane_on;
                else edge = (jb * 64 + 63 > tq) || (jb * 64 <= tq - 512);
                const bool need_mask = __ballot(edge) != 0ull;
                bf16x8 pb[4];
#pragma unroll
                for (int cf = 0; cf < 4; ++cf) {
                    if (need_mask) {
#pragma unroll
                        for (int r2 = 0; r2 < 2; ++r2)
#pragma unroll
                            for (int j = 0; j < 4; ++j) {
                                const int key = jb * 64 + 32 * c + 8 * q + 4 * r2 + j;
                                bool v;
                                if (MODE == 0) v = key <= nmax;
                                else if (MODE == 1) v = lane_on && key <= tq;
                                else v = key <= tq && key > tq - 512;
                                if (!v) S[r2][cf][j] = NINF;
                            }
                    }
                    float bm = fmaxf(fmaxf(fmaxf(S[0][cf][0], S[0][cf][1]), fmaxf(S[0][cf][2], S[0][cf][3])), fmaxf(fmaxf(S[1][cf][0], S[1][cf][1]), fmaxf(S[1][cf][2], S[1][cf][3])));
                    bm = rows_max(bm);
                    const float mnew = fmaxf(st.m[cf], bm);
                    const float mref = (mnew == NINF) ? 0.f : mnew;
                    const float alpha = __builtin_amdgcn_exp2f(st.m[cf] - mref);
                    st.m[cf] = mnew;
                    float ps = 0.f;
#pragma unroll
                    for (int r2 = 0; r2 < 2; ++r2)
#pragma unroll
                        for (int j = 0; j < 4; ++j) { const float pv = __builtin_amdgcn_exp2f(S[r2][cf][j] - mref); S[r2][cf][j] = pv; ps += pv; }
                    st.l[cf] = st.l[cf] * alpha + ps;
                    if (__ballot(alpha != 1.0f) != 0ull) {
#pragma unroll
                        for (int d = 0; d < 4; ++d) st.O[d][cf] *= alpha;
                    }
                    pb[cf] = pack8(S[0][cf], S[1][cf]);
                }
#pragma unroll
                for (int d = 0; d < 4; ++d) {
                    const int row = d * 16 + cl;
                    const bf16x8 av = *(const bf16x8*)(cur + 8192 + row * 128 + (((c * 4 + q) ^ (row & 7)) << 4));
#pragma unroll
                    for (int cf = 0; cf < 4; ++cf) st.O[d][cf] = MFMA16(av, pb[cf], st.O[d][cf]);
                }
            }
        }
        if (more) {
#pragma unroll
            for (int i = 0; i < 2; ++i) { *(u32x4*)(nxt + kwo[i]) = rk[i]; *(u32x4*)(nxt + vwo[i]) = rv[i]; }
        }
        __syncthreads();
    }
}

DEVI f32x4 bload16f(rsrc_t r, unsigned voff, unsigned soff) { return __builtin_bit_cast(f32x4, __builtin_amdgcn_raw_buffer_load_b128(r, (int)voff, (int)soff, 0)); }
DEVI void bstore16f(rsrc_t r, f32x4 v, unsigned voff, unsigned soff) { __builtin_amdgcn_raw_buffer_store_b128(__builtin_bit_cast(u32x4, v), r, (int)voff, (int)soff, 0); }
DEVI float bload4f(rsrc_t r, unsigned voff, unsigned soff) { return __builtin_bit_cast(float, __builtin_amdgcn_raw_buffer_load_b32(r, (int)voff, (int)soff, 0)); }

struct NsaUnit { int i, b, k, t0, tq; unsigned tokw, tokb, qoff, goff, ooff, sQ, sG, sO; };
DEVI NsaUnit nsa_unit(int uu, int tid) {
    NsaUnit U;
    const int lane = tid & 63, wid = __builtin_amdgcn_readfirstlane(tid >> 6), q = lane >> 4, cl = lane & 15;
    const int half = uu >> 9, r = uu & 511, bk = r & 15, ii = r >> 4;
    U.i = half ? ii : 63 - ii; U.b = bk >> 1; U.k = bk & 1;
    U.t0 = U.i * 64; U.tq = U.t0 + wid * 16 + cl;
    U.tokw = (unsigned)(wid * 16 + cl);
    U.tokb = (unsigned)(U.b * 4096 + U.t0);
    U.qoff = U.tokw * 1024u + (unsigned)q * 16u;
    U.goff = U.tokw * 96u;
    U.ooff = U.tokw * 1024u + (unsigned)q * 8u;
    U.sQ = U.tokb * 1024u + (unsigned)U.k * 512u;
    U.sG = (unsigned)OFF_GATES + U.tokb * 96u + (unsigned)U.k * 16u;
    U.sO = (unsigned)OFF_OB + U.tokb * 1024u + (unsigned)U.k * 512u;
    return U;
}

DEVI void nsa_cmp_unit(const Params& P, rsrc_t rs, int uu, unsigned char* lds, int tid) {
    const int lane = tid & 63, wid = __builtin_amdgcn_readfirstlane(tid >> 6), q = lane >> 4, cl = lane & 15;
    const NsaUnit U = nsa_unit(uu, tid);
    const int i = U.i, b = U.b, k = U.k, tq = U.tq;
    AttnState st;
    bf16x8 qf[4][2];
#pragma unroll
    for (int cf = 0; cf < 4; ++cf)
#pragma unroll
        for (int ks = 0; ks < 2; ++ks) qf[cf][ks] = __builtin_bit_cast(bf16x8, bload16(rs, U.qoff, (unsigned)OFF_QBN + U.sQ + cf * 128 + ks * 64));
    const unsigned sKC = (unsigned)OFF_KC + (unsigned)(b * 2 + k) * 256u * 128u;
    const unsigned sVC = (unsigned)OFF_VCT + (unsigned)(b * 2 + k) * 64u * 512u;
    const int nmax_blk = (U.t0 + 63 - 31) >> 4;
    const int jbc = (nmax_blk >> 6) < 3 ? (nmax_blk >> 6) : 3;
    attn_blocks<0>(rs, sKC, sVC, 256, 0, jbc, qf, st, tq, 0ull, lds, tid);
    float linv[4], mfin[4];
#pragma unroll
    for (int cf = 0; cf < 4; ++cf) {
        const float l = rows_sum(st.l[cf]);
        linv[cf] = (l > 0.f) ? __builtin_amdgcn_rcpf(l) : 0.f; mfin[cf] = st.m[cf];
        const float sc = linv[cf] * bload4f(rs, U.goff, U.sG + cf * 4);
#pragma unroll
        for (int d = 0; d < 4; ++d) { const f32x4 v = st.O[d][cf] * sc; u32x2 w; w.x = pk2(v[0], v[1]); w.y = pk2(v[2], v[3]);
            __builtin_amdgcn_raw_buffer_store_b64(w, rs, (int)U.ooff, (int)(U.sO + cf * 128 + d * 32), 0); }
    }
    unsigned long long* MSKG = (unsigned long long*)(P.ws + OFF_MASK);
    if (i < 16) {
        if (q == 0) MSKG[((size_t)(b * 2 + k)) * 4096 + tq] = (2ull << i) - 1ull;
        return;
    }
    float* SUM4 = (float*)(lds + 16384);
    float* LAST = (float*)(lds + 32768);
    float* IMP2 = (float*)(lds + 49152);
    const int nmax = (tq >= 31) ? ((tq - 31) >> 4) : -1;
    for (int kb = 0; kb <= jbc; ++kb) {
#pragma unroll
        for (int ii = 0; ii < 2; ++ii) {
            const int idx = tid + 256 * ii, row = idx >> 3, ch = idx & 7;
            *(u32x4*)(lds + row * 128 + ((ch ^ fK(row)) << 4)) = bload16(rs, (unsigned)(row * 64 + ch * 8) * 2u, sKC + (unsigned)kb * 8192u);
        }
        __syncthreads();
#pragma unroll
        for (int rf = 0; rf < 4; ++rf) {
            f32x4 S[4];
#pragma unroll
            for (int cf = 0; cf < 4; ++cf) S[cf] = (f32x4){0.f, 0.f, 0.f, 0.f};
            const int kl = 32 * (rf >> 1) + 8 * (cl >> 2) + 4 * (rf & 1) + (cl & 3);
#pragma unroll
            for (int ks = 0; ks < 2; ++ks) {
                const bf16x8 a = *(const bf16x8*)(lds + kl * 128 + (((ks * 4 + q) ^ (cl & 7)) << 4));
#pragma unroll
                for (int cf = 0; cf < 4; ++cf) S[cf] = MFMA16(a, qf[cf][ks], S[cf]);
            }
            float acc4 = 0.f, accl = 0.f;
#pragma unroll
            for (int j = 0; j < 4; ++j) {
                const int key = kb * 64 + 32 * (rf >> 1) + 8 * q + 4 * (rf & 1) + j;
                float pj = 0.f;
#pragma unroll
                for (int cf = 0; cf < 4; ++cf) pj += __builtin_amdgcn_exp2f(S[cf][j] - mfin[cf]) * linv[cf];
                pj = (key <= nmax) ? pj : 0.f;
                acc4 += pj; if (j == 3) accl = pj;
            }
            const int jblk = kb * 16 + 8 * (rf >> 1) + 2 * q + (rf & 1);
            SUM4[(wid * 16 + cl) * 64 + jblk] = acc4; LAST[(wid * 16 + cl) * 64 + jblk] = accl;
        }
        __syncthreads();
    }
    {
        const int qi = tid >> 2, jg = tid & 3;
        const int jlim = (jbc + 1) * 16;
        for (int jj = 0; jj < 16; ++jj) {
            const int j = jg * 16 + jj;
            float v = (j < jlim) ? SUM4[qi * 64 + j] : 0.f;
            if (j >= 1 && j - 1 < jlim) v += LAST[qi * 64 + j - 1];
            IMP2[qi * 64 + j] = v;
        }
    }
    __syncthreads();
    {
        const int qi = tid >> 2, jg = tid & 3;
        const float* row = IMP2 + qi * 64;
        float kk[64];
#pragma unroll
        for (int j4 = 0; j4 < 16; ++j4) {
            const f32x4 v = *(const f32x4*)(row + j4 * 4);
#pragma unroll
            for (int e = 0; e < 4; ++e) {
                const int j2 = j4 * 4 + e;
                const bool f2 = (j2 == 0) || (j2 == i) || (j2 == i - 1);
                kk[j2] = (j2 > i) ? -__builtin_inff() : (f2 ? __builtin_inff() : v[e]);
            }
        }
        unsigned lo = 0u;
#pragma unroll 1
        for (int jj = 0; jj < 16; ++jj) {
            const int j = jg * 16 + jj;
            float kj = -__builtin_inff();
#pragma unroll
            for (int j2 = 0; j2 < 64; ++j2) kj = (j2 == j) ? kk[j2] : kj;
            int rank = 0;
#pragma unroll
            for (int j2 = 0; j2 < 64; ++j2) rank += (kk[j2] > kj || (kk[j2] == kj && j2 < j)) ? 1 : 0;
            if (j <= i && rank < 16) lo |= (1u << jj);
        }
        unsigned long long bits = (unsigned long long)lo << (jg * 16);
        bits |= __shfl_xor(bits, 1); bits |= __shfl_xor(bits, 2);
        if (jg == 0) MSKG[((size_t)(b * 2 + k)) * 4096 + U.t0 + qi] = bits;
    }
    __syncthreads();
}

template <int MODE>
DEVI void nsa_kv_unit(const Params& P, rsrc_t rs, int uu, unsigned char* lds, int tid) {
    const int lane = tid & 63, q = lane >> 4;
    const NsaUnit U = nsa_unit(uu, tid);
    const int i = U.i, b = U.b, k = U.k, tq = U.tq;
    AttnState st;
    bf16x8 qf[4][2];
#pragma unroll
    for (int cf = 0; cf < 4; ++cf)
#pragma unroll
        for (int ks = 0; ks < 2; ++ks) qf[cf][ks] = __builtin_bit_cast(bf16x8, bload16(rs, U.qoff, (unsigned)OFF_QBR + U.sQ + cf * 128 + ks * 64));
    const unsigned sK = (unsigned)(OFF_KV + (MODE == 1 ? 2 : 4) * KV_STRIDE) + (unsigned)(b * 2 + k) * 4096u * 128u;
    const unsigned sV = (unsigned)(OFF_KV + (MODE == 1 ? 3 : 5) * KV_STRIDE) + (unsigned)(b * 2 + k) * 64u * 8192u;
    unsigned long long mymask = 0ull;
    int j0 = 0;
    if (MODE == 1) mymask = ((const unsigned long long*)(P.ws + OFF_MASK))[((size_t)(b * 2 + k)) * 4096 + tq];
    else j0 = (i >= 8) ? i - 8 : 0;
    attn_blocks<MODE>(rs, sK, sV, 4096, j0, i, qf, st, tq, mymask, lds, tid);
#pragma unroll
    for (int cf = 0; cf < 4; ++cf) {
        const float l = rows_sum(st.l[cf]);
        const float sc = ((l > 0.f) ? __builtin_amdgcn_rcpf(l) : 0.f) * bload4f(rs, U.goff, U.sG + (MODE == 1 ? 32 : 64) + cf * 4);
#pragma unroll
        for (int d = 0; d < 4; ++d) {
            const u32x2 pw = __builtin_bit_cast(u32x2, __builtin_amdgcn_raw_buffer_load_b64(rs, (int)U.ooff, (int)(U.sO + cf * 128 + d * 32), 0));
            f32x4 v = st.O[d][cf] * sc;
            v[0] += bf2f(pw.x & 0xffffu); v[1] += bf2f(pw.x >> 16); v[2] += bf2f(pw.y & 0xffffu); v[3] += bf2f(pw.y >> 16);
            u32x2 w; w.x = pk2(v[0], v[1]); w.y = pk2(v[2], v[3]);
            __builtin_amdgcn_raw_buffer_store_b64(w, rs, (int)U.ooff, (int)(U.sO + cf * 128 + d * 32), 0);
        }
    }
}

DEVI void phase_nsa(const Params& P, unsigned char* lds, int tid) {
    const rsrc_t rs = __builtin_amdgcn_make_buffer_rsrc((void*)P.ws, (short)0, (int)0x7fffffff, 0x00020000);
    for (int uu = blockIdx.x; uu < 1024; uu += gridDim.x) { int t = tid; asm volatile("" : "+v"(t)); nsa_cmp_unit(P, rs, uu, lds, t); }
    __syncthreads();
    for (int uu = blockIdx.x; uu < 1024; uu += gridDim.x) { int t = tid; asm volatile("" : "+v"(t)); nsa_kv_unit<1>(P, rs, uu, lds, t); }
    __syncthreads();
    for (int uu = blockIdx.x; uu < 1024; uu += gridDim.x) { int t = tid; asm volatile("" : "+v"(t)); nsa_kv_unit<2>(P, rs, uu, lds, t); }
}

DEVI void phase_merge(const Params& P, unsigned char* lds, int tid) {
    unsigned char* ws = P.ws;
    const rsrc_t rs = __builtin_amdgcn_make_buffer_rsrc((void*)P.ws, (short)0, (int)0x7fffffff, 0x00020000);
    const bf16_t* ga = (const bf16_t*)(ws + OFF_GA);
    const bf16_t* gb = (const bf16_t*)(ws + OFF_GB);
    bf16_t* mg = (bf16_t*)(ws + OFF_MERGED);
    const int lane = tid & 63, wid = __builtin_amdgcn_readfirstlane(tid >> 6), wr = wid >> 1, wc = wid & 1, q = lane >> 4, cl = lane & 15;
    for (int kk = 0;; ++kk) {
        int mt, nt;
        if (!tile_map(kk, 8, mt, nt)) break;
        f32x4 acc[4][4];
        unsigned t[4][4][2];
        gemm128(acc, rs, (unsigned)(OFF_OA + (size_t)mt * 128 * 1024), RowLin{1024}, (unsigned)(OFF_WBRA + (size_t)nt * 128 * 1024), RowLin{1024}, 8, lds, tid);
        const size_t e0 = (size_t)(mt * 128 + wr * 64 + cl) * 1024 + nt * 128 + wc * 64 + q * 4;
#pragma unroll
        for (int m = 0; m < 4; ++m)
#pragma unroll
            for (int n = 0; n < 4; ++n) {
                const u32x2 gv = *(const u32x2*)(ga + e0 + (size_t)m * 16 * 1024 + n * 16);
                t[m][n][0] = pk2(acc[m][n][0] * bf2f(gv.x & 0xffffu), acc[m][n][1] * bf2f(gv.x >> 16));
                t[m][n][1] = pk2(acc[m][n][2] * bf2f(gv.y & 0xffffu), acc[m][n][3] * bf2f(gv.y >> 16));
            }
        gemm128(acc, rs, (unsigned)(OFF_OB + (size_t)mt * 128 * 1024), RowLin{1024}, (unsigned)(OFF_WBRB + (size_t)nt * 128 * 1024), RowLin{1024}, 8, lds, tid);
#pragma unroll
        for (int m = 0; m < 4; ++m)
#pragma unroll
            for (int n = 0; n < 4; ++n) {
                const size_t o = e0 + (size_t)m * 16 * 1024 + n * 16;
                const u32x2 gv = *(const u32x2*)(gb + o);
                u32x2 w;
                w.x = pk2(bf2f(t[m][n][0] & 0xffffu) + acc[m][n][0] * bf2f(gv.x & 0xffffu), bf2f(t[m][n][0] >> 16) + acc[m][n][1] * bf2f(gv.x >> 16));
                w.y = pk2(bf2f(t[m][n][1] & 0xffffu) + acc[m][n][2] * bf2f(gv.y & 0xffffu), bf2f(t[m][n][1] >> 16) + acc[m][n][3] * bf2f(gv.y >> 16));
                *(u32x2*)(mg + o) = w;
            }
    }
}

DEVI void phase_outproj(const Params& P, unsigned char* lds, int tid) {
    unsigned char* ws = P.ws;
    const rsrc_t rs = __builtin_amdgcn_make_buffer_rsrc((void*)P.ws, (short)0, (int)0x7fffffff, 0x00020000);
    const bf16_t* mg = (const bf16_t*)(ws + OFF_MERGED);
    const bf16_t* wo = (const bf16_t*)(ws + OFF_WOUT);
    const float* x = P.in[0];
    float* x1 = P.out;
    const int lane = tid & 63, wid = __builtin_amdgcn_readfirstlane(tid >> 6), wr = wid >> 1, wc = wid & 1, q = lane >> 4, cl = lane & 15;
    for (int kk = 0;; ++kk) {
        int mt, nt;
        if (!tile_map(kk, 8, mt, nt)) break;
        f32x4 acc[4][4];
        gemm128(acc, rs, (unsigned)(OFF_MERGED + (size_t)mt * 128 * 2048), RowLin{2048}, (unsigned)(OFF_WOUT + (size_t)nt * 128 * 2048), RowLin{2048}, 16, lds, tid);
#pragma unroll
        for (int m = 0; m < 4; ++m)
#pragma unroll
            for (int n = 0; n < 4; ++n) {
                const size_t o = (size_t)(mt * 128 + wr * 64 + m * 16 + cl) * 1024 + nt * 128 + wc * 64 + n * 16 + q * 4;
                *(f32x4*)(x1 + o) = *(const f32x4*)(x + o) + acc[m][n];
            }
    }
}

DEVI void phase_router(const Params& P, unsigned char* lds, int tid) {
    unsigned char* ws = P.ws;
    const int lane = tid & 63, wid = __builtin_amdgcn_readfirstlane(tid >> 6), q = lane >> 4, cl = lane & 15;
    const float* x1 = P.out; const float* g = P.in[13];
    const float* bg = P.in[15]; const float* be = P.in[17];
    const float* WR = (const float*)(ws + OFF_WR);
    bf16_t* h2 = (bf16_t*)(ws + OFF_HN);
    unsigned* cnt = (unsigned*)(ws + OFF_CTL);
    int* list = (int*)(ws + OFF_LIST);
    float* wt = (float*)(ws + OFF_WT);
    float* WL = (float*)lds;
    float* LG = (float*)(lds + 50688);
    float* RS = (float*)(lds + 50688 + 12288);
    for (int u = blockIdx.x; u < NTOK / 64; u += gridDim.x) {
        const int row0 = u * 64 + wid * 16;
        const float* xa = x1 + (size_t)(row0 + cl) * 1024 + 4 * q;
        f32x4 acc[3];
#pragma unroll
        for (int ct = 0; ct < 3; ++ct) acc[ct] = (f32x4){0.f, 0.f, 0.f, 0.f};
        float ss = 0.f;
        for (int kc = 0; kc < 4; ++kc) {
            __syncthreads();
#pragma unroll
            for (int i = 0; i < 12; ++i) {
                const int idx = tid + 256 * i, r = idx >> 6, c4 = idx & 63;
                *(f32x4*)(WL + r * 264 + c4 * 4) = *(const f32x4*)(WR + (size_t)r * 1024 + kc * 256 + c4 * 4);
            }
            __syncthreads();
#pragma unroll
            for (int jh = 0; jh < 2; ++jh) {
                f32x4 av[8];
#pragma unroll
                for (int j = 0; j < 8; ++j) av[j] = *(const f32x4*)(xa + kc * 256 + (jh * 8 + j) * 16);
#pragma unroll
                for (int j = 0; j < 8; ++j) {
                    {
                        const int kx = kc * 256 + (jh * 8 + j) * 16 + 4 * q;
                        const f32x4 gg = *(const f32x4*)(g + kx);
                        u32x2 w; w.x = pk2(av[j][0] * gg[0], av[j][1] * gg[1]); w.y = pk2(av[j][2] * gg[2], av[j][3] * gg[3]);
                        *(u32x2*)(h2 + (size_t)(row0 + cl) * 1024 + kx) = w;
                    }
                    ss += av[j][0] * av[j][0] + av[j][1] * av[j][1] + av[j][2] * av[j][2] + av[j][3] * av[j][3];
#pragma unroll
                    for (int ct = 0; ct < 3; ++ct) {
                        const f32x4 bv = *(const f32x4*)(WL + (ct * 16 + cl) * 264 + (jh * 8 + j) * 16 + 4 * q);
#pragma unroll
                        for (int e = 0; e < 4; ++e) acc[ct] = __builtin_amdgcn_mfma_f32_16x16x4f32(av[j][e], bv[e], acc[ct], 0, 0, 0);
                    }
                }
            }
        }
        ss += __shfl_xor(ss, 16); ss += __shfl_xor(ss, 32);
        const float rs = rsqrtf(ss * (1.0f / 1024.0f) + RMS_EPS);
        if (q == 0) { RS[wid * 16 + cl] = rs; ((float*)(ws + OFF_RS))[row0 + cl] = rs; }
        __syncthreads();
#pragma unroll
        for (int j = 0; j < 4; ++j) {
            const float rj = RS[wid * 16 + 4 * q + j];
#pragma unroll
            for (int ct = 0; ct < 3; ++ct) LG[(wid * 16 + 4 * q + j) * 48 + ct * 16 + cl] = acc[ct][j] * rj;
        }
        __syncthreads();
        if (tid < 64) {
            const int r = u * 64 + tid;
            const float* lg = LG + tid * 48;
            float gl[4];
#pragma unroll
            for (int e = 0; e < 4; ++e) gl[e] = lg[e] + bg[e];
            int gs = 0; float gm = gl[0];
#pragma unroll
            for (int e = 1; e < 4; ++e) if (gl[e] > gm) { gm = gl[e]; gs = e; }
            float den = 0.f;
#pragma unroll
            for (int e = 0; e < 4; ++e) den += __expf(gl[e] - gm);
            const float gp = 1.0f / den;
            float el[8];
#pragma unroll
            for (int e = 0; e < 8; ++e) el[e] = lg[4 + gs * 8 + e] + be[gs * 8 + e];
            int i0 = 0; float v0 = el[0];
#pragma unroll
            for (int e = 1; e < 8; ++e) if (el[e] > v0) { v0 = el[e]; i0 = e; }
            int i1 = -1; float v1 = -__builtin_inff();
#pragma unroll
            for (int e = 0; e < 8; ++e) if (e != i0 && el[e] > v1) { v1 = el[e]; i1 = e; }
            const float e1 = __expf(v1 - v0);
            const float w0 = gp / (1.0f + e1), w1 = gp * e1 / (1.0f + e1);
            const int ex0 = gs * 8 + i0, ex1 = gs * 8 + i1;
            const unsigned p0 = atomicAdd(&cnt[ex0], 1u);
            list[(size_t)ex0 * NTOK + p0] = r * 2 + 0;
            const unsigned p1 = atomicAdd(&cnt[ex1], 1u);
            list[(size_t)ex1 * NTOK + p1] = r * 2 + 1;
            wt[(size_t)r * 2 + 0] = w0; wt[(size_t)r * 2 + 1] = w1;
        }
    }
}

struct RowGather { const int* idx; DEVI unsigned operator()(int r) const { return (unsigned)idx[r] * 2048u; } };
struct RowGU { int c0; DEVI unsigned operator()(int r) const {
    const int wcx = r >> 6, w = r & 63; const int col = (w < 32) ? (c0 + wcx * 32 + w) : (256 + c0 + wcx * 32 + (w - 32)); return (unsigned)col * 2048u; } };

DEVI int moe_find_tile(const unsigned* cnt, int u, int& e, int& tl) {
    int t = u, ee = 0, ce = 0;
    for (; ee < 32; ++ee) { ce = (int)cnt[ee]; const int nt = (ce + 127) >> 7; if (t < nt) break; t -= nt; }
    e = ee; tl = t; return ce;
}
DEVI void phase_moe_a(const Params& P, unsigned char* lds, int tid) {
    unsigned char* ws = P.ws;
    const rsrc_t rs = __builtin_amdgcn_make_buffer_rsrc((void*)P.ws, (short)0, (int)0x7fffffff, 0x00020000);
    const int lane = tid & 63, wid = __builtin_amdgcn_readfirstlane(tid >> 6), wr = wid >> 1, wc = wid & 1, q = lane >> 4, cl = lane & 15;
    const unsigned* cnt = (const unsigned*)(ws + OFF_CTL);
    const int* list = (const int*)(ws + OFF_LIST);
    bf16_t* act = (bf16_t*)(ws + OFF_ACT);
    int* rowtok = (int*)(lds + 65536);
    const float* RSG = (const float*)(ws + OFF_RS);
    int total = 0;
    for (int e = 0; e < 32; ++e) total += ((int)cnt[e] + 127) >> 7;
    for (int v = blockIdx.x; v < total * 4; v += gridDim.x) {
        const int u = v >> 2, nt = v & 3;
        int e, tl; const int ce = moe_find_tile(cnt, u, e, tl);
        if (tid < 128) { const int r = tl * 128 + tid; rowtok[tid] = (r < ce) ? (list[(size_t)e * NTOK + r] >> 1) : 0; }
        __syncthreads();
        bf16_t* au = act + (size_t)u * 128 * 256;
        f32x4 acc[4][4];
        gemm128(acc, rs, (unsigned)OFF_HN, RowGather{rowtok}, (unsigned)(OFF_WGU + (size_t)e * 512 * 2048), RowGU{nt * 64}, 16, lds, tid);
#pragma unroll
        for (int m = 0; m < 4; ++m)
#pragma unroll
            for (int n = 0; n < 2; ++n) {
                const int row = wr * 64 + m * 16 + cl, col = nt * 64 + wc * 32 + n * 16 + q * 4;
                const float rsv = RSG[rowtok[row]];
                const f32x4 gt = acc[m][n] * rsv, up = acc[m][n + 2] * rsv;
                u32x2 w;
                w.x = pk2(siluf_(gt[0]) * up[0], siluf_(gt[1]) * up[1]);
                w.y = pk2(siluf_(gt[2]) * up[2], siluf_(gt[3]) * up[3]);
                *(u32x2*)(au + (size_t)row * 256 + col) = w;
            }
        __syncthreads();
    }
}
DEVI void phase_moe_b(const Params& P, unsigned char* lds, int tid) {
    unsigned char* ws = P.ws;
    const rsrc_t rs = __builtin_amdgcn_make_buffer_rsrc((void*)P.ws, (short)0, (int)0x7fffffff, 0x00020000);
    const int lane = tid & 63, wid = __builtin_amdgcn_readfirstlane(tid >> 6), wr = wid >> 1, wc = wid & 1, q = lane >> 4, cl = lane & 15;
    const unsigned* cnt = (const unsigned*)(ws + OFF_CTL);
    const int* list = (const int*)(ws + OFF_LIST);
    bf16_t* Y = (bf16_t*)(ws + OFF_Y);
    int* rowas = (int*)(lds + 65536);
    int total = 0;
    for (int e = 0; e < 32; ++e) total += ((int)cnt[e] + 127) >> 7;
    for (int v = blockIdx.x; v < total * 4; v += gridDim.x) {
        const int u = v >> 2, np = v & 3;
        int e, tl; const int ce = moe_find_tile(cnt, u, e, tl);
        if (tid < 128) { const int r = tl * 128 + tid; rowas[tid] = (r < ce) ? list[(size_t)e * NTOK + r] : -1; }
        __syncthreads();
        for (int h = 0; h < 2; ++h) {
            const int nt = np * 2 + h;
            f32x4 acc[4][4];
            gemm128(acc, rs, (unsigned)(OFF_ACT + (size_t)u * 128 * 512), RowLin{512}, (unsigned)(OFF_WDN + (size_t)e * 1024 * 512 + (size_t)nt * 128 * 512), RowLin{512}, 4, lds, tid);
#pragma unroll
            for (int m = 0; m < 4; ++m) {
                const int row = wr * 64 + m * 16 + cl;
                const int as = rowas[row];
                if (as >= 0) {
                    bf16_t* yr = Y + ((size_t)(as & 1) * NTOK + (as >> 1)) * 1024 + nt * 128 + wc * 64 + q * 4;
#pragma unroll
                    for (int n = 0; n < 4; ++n) { u32x2 w; w.x = pk2(acc[m][n][0], acc[m][n][1]); w.y = pk2(acc[m][n][2], acc[m][n][3]); *(u32x2*)(yr + n * 16) = w; }
                }
            }
        }
        __syncthreads();
    }
}

DEVI void phase_final(const Params& P, int tid, bool with_moe) {
    unsigned char* ws = P.ws;
    const int lane = tid & 63, wid = __builtin_amdgcn_readfirstlane(tid >> 6);
    const bf16_t* Y = (const bf16_t*)(ws + OFF_Y);
    const float* wt = (const float*)(ws + OFF_WT);
    const float* g = P.in[20];
    float* out = P.out;
    for (int r = blockIdx.x * 4 + wid; r < NTOK; r += gridDim.x * 4) {
        float* xr = out + (size_t)r * 1024;
        const float w0 = with_moe ? wt[(size_t)r * 2] : 0.f, w1 = with_moe ? wt[(size_t)r * 2 + 1] : 0.f;
        f32x4 v[4]; float ss = 0.f;
#pragma unroll
        for (int i = 0; i < 4; ++i) {
            v[i] = *(const f32x4*)(xr + i * 256 + lane * 4);
            if (with_moe) {
                const u32x2 a = *(const u32x2*)(Y + (size_t)r * 1024 + i * 256 + lane * 4);
                const u32x2 b = *(const u32x2*)(Y + ((size_t)NTOK + r) * 1024 + i * 256 + lane * 4);
                v[i][0] += w0 * bf2f(a.x & 0xffffu) + w1 * bf2f(b.x & 0xffffu); v[i][1] += w0 * bf2f(a.x >> 16) + w1 * bf2f(b.x >> 16);
                v[i][2] += w0 * bf2f(a.y & 0xffffu) + w1 * bf2f(b.y & 0xffffu); v[i][3] += w0 * bf2f(a.y >> 16) + w1 * bf2f(b.y >> 16);
            }
            ss += v[i][0] * v[i][0] + v[i][1] * v[i][1] + v[i][2] * v[i][2] + v[i][3] * v[i][3];
        }
        ss = wave_sum(ss);
        const float rs = rsqrtf(ss * (1.0f / 1024.0f) + RMS_EPS);
#pragma unroll
        for (int i = 0; i < 4; ++i) {
            const f32x4 gg = *(const f32x4*)(g + i * 256 + lane * 4);
            f32x4 o; o[0] = v[i][0] * rs * gg[0]; o[1] = v[i][1] * rs * gg[1]; o[2] = v[i][2] * rs * gg[2]; o[3] = v[i][3] * rs * gg[3];
            *(f32x4*)(xr + i * 256 + lane * 4) = o;
        }
    }
}

#define LAUNDER_TID() do { tid = wave_id * 64 + (int)__builtin_amdgcn_mbcnt_hi(~0u, __builtin_amdgcn_mbcnt_lo(~0u, 0u)); asm volatile("" : "+v"(tid)); } while (0)
__global__ void __launch_bounds__(NTHREADS, 2) fwd_megakernel(Params P) {
    extern __shared__ __attribute__((aligned(16))) unsigned char lds[];
    cg::grid_group grid = cg::this_grid();
    int tid;
    const int wave_id = __builtin_amdgcn_readfirstlane((int)(threadIdx.x >> 6));
    volatile LAS unsigned* bst = (volatile LAS unsigned*)(LAS unsigned char*)(lds + LDS_BYTES - 16);
    if (threadIdx.x < 4) bst[threadIdx.x] = 0u;
    __syncthreads();
    (void)xcd_barrier_post((unsigned*)(P.ws + OFF_BAR), bst);
#define GRID_BARRIER() do { XcdBarrier b_; b_.bar = (unsigned*)(P.ws + OFF_BAR); b_.x = xb_xcc_id(); b_.st = (volatile LAS unsigned*)(LAS unsigned char*)(lds + LDS_BYTES - 16); xcd_barrier(b_); } while (0)
    if (P.ph_lo != 0) grid.sync();
    LAUNDER_TID(); phase_prep(P, lds, tid); __syncthreads();
    GRID_BARRIER();
    {
        const int first_idx = (blockIdx.x >> 8) & 1;
        for (int step = 0; step < 3; ++step) {
            const int what = (step == 0) ? 0 : 1 + ((step - 1) ^ first_idx);
            if (what <= 1) { LAUNDER_TID(); phase_gemm1(P, lds, tid, what); }
            else {
                LAUNDER_TID(); phase_compress(P, lds, tid); __syncthreads();
                LAUNDER_TID(); phase_index(P, lds, tid);
            }
            __syncthreads();
            if (step == 0) GRID_BARRIER();
        }
    }
    GRID_BARRIER();
    if (((blockIdx.x >> 8) & 1) == 0) { LAUNDER_TID(); phase_dsa(P, lds, tid); __syncthreads(); }
    LAUNDER_TID(); phase_nsa(P, lds, tid); __syncthreads();
    if (((blockIdx.x >> 8) & 1) != 0) { LAUNDER_TID(); phase_dsa(P, lds, tid); __syncthreads(); }
    GRID_BARRIER();
    LAUNDER_TID(); phase_merge(P, lds, tid);
    GRID_BARRIER();
    LAUNDER_TID(); phase_outproj(P, lds, tid);
    GRID_BARRIER();
    LAUNDER_TID(); phase_router(P, lds, tid);
    GRID_BARRIER();
    LAUNDER_TID(); phase_moe_a(P, lds, tid);
    GRID_BARRIER();
    LAUNDER_TID(); phase_moe_b(P, lds, tid);
    GRID_BARRIER();
    LAUNDER_TID(); phase_final(P, tid, true);
}

extern "C" void kernel_launch(void* const* d_in, const int* in_sizes, int n_in, void* d_out, int out_size, void* d_ws, size_t ws_size,
                              hipStream_t stream) {
    static int grid_blocks = 0;
    if (!grid_blocks) {
        int dev = 0, cus = 0, per_cu = 0;
        hipGetDevice(&dev);
        hipDeviceGetAttribute(&cus, hipDeviceAttributeMultiprocessorCount, dev);
        hipFuncSetAttribute((const void*)fwd_megakernel, hipFuncAttributeMaxDynamicSharedMemorySize, LDS_BYTES);
        hipOccupancyMaxActiveBlocksPerMultiprocessor(&per_cu, (const void*)fwd_megakernel, NTHREADS, LDS_BYTES);
        if (per_cu < 1) per_cu = 1;
        if (per_cu > 2) per_cu = 2;
        grid_blocks = cus * per_cu;
        if (ws_size < WS_END) fprintf(stderr, "kernel_launch: workspace too small: %zu < %zu\n", ws_size, (size_t)WS_END);
    }
    Params p{};
    for (int i = 0; i < 21; ++i) p.in[i] = (const float*)d_in[i];
    p.pos = (const int*)d_in[1];
    p.out = (float*)d_out;
    p.ws = (unsigned char*)d_ws;
    for (int i = 0; i < 32; ++i) p.inv_freq[i] = (double)powf(10000.0f, -(float)i / 32.0f);
    p.ph_lo = 0; p.ph_hi = 0;
    (void)hipMemsetAsync(d_ws, 0, OFF_WIN_T, stream);
    void* args[] = {&p};
    hipError_t e = hipLaunchCooperativeKernel((const void*)fwd_megakernel, dim3(grid_blocks), dim3(NTHREADS), args, LDS_BYTES, stream);
    if (e != hipSuccess) fprintf(stderr, "cooperative launch failed: %s (grid %d)\n", hipGetErrorString(e), grid_blocks);
}
```

```cpp
#include <hip/hip_runtime.h>
#include <hip/hip_cooperative_groups.h>
#include <cstdint>
#include <cstdio>
#include <cmath>
namespace cg = cooperative_groups;

#define DEVI __device__ __forceinline__
#ifndef PROBE_TWICE
#define PROBE_TWICE 0
#endif
#define REPS(k) ((PROBE_TWICE == (k)) ? 2 : 1)
typedef unsigned short bf16_t;
typedef short bf16x8 __attribute__((ext_vector_type(8)));
typedef short s16x4 __attribute__((ext_vector_type(4)));
typedef float f32x4 __attribute__((ext_vector_type(4)));
typedef float f32x2 __attribute__((ext_vector_type(2)));
typedef unsigned u32x4 __attribute__((ext_vector_type(4)));
typedef unsigned u32x2 __attribute__((ext_vector_type(2)));
#define LAS __attribute__((address_space(3)))

constexpr int NB = 8, SL = 4096, DM = 1024, NTOK = NB * SL;
constexpr int INW = 4288;
constexpr int NTHREADS = 256;
constexpr int LDS_BYTES = 81920;
constexpr float RMS_EPS = 1e-6f;
constexpr float LOG2E = 1.4426950408889634f;

constexpr int WIN_ROWS = 4352;
constexpr int G1_COLS = 4352;

constexpr size_t al256(size_t x) { return (x + 255) & ~(size_t)255; }
constexpr size_t OFF_CTL   = 0;
constexpr size_t OFF_BAR   = 4096;
constexpr size_t OFF_WIN_T = 32768;
constexpr size_t OFF_WBRA  = OFF_WIN_T + (size_t)WIN_ROWS * 1024 * 2;
constexpr size_t OFF_WBRB  = OFF_WBRA + (size_t)1024 * 512 * 2;
constexpr size_t OFF_WOUT  = OFF_WBRB + (size_t)1024 * 512 * 2;
constexpr size_t OFF_W1K   = OFF_WOUT + (size_t)1024 * 1024 * 2;
constexpr size_t OFF_W1V   = OFF_W1K + (size_t)128 * 2048 * 2;
constexpr size_t OFF_W2K   = OFF_W1V + (size_t)128 * 2048 * 2;
constexpr size_t OFF_W2V   = OFF_W2K + (size_t)64 * 128 * 2;
constexpr size_t OFF_WGU   = OFF_W2V + (size_t)64 * 128 * 2;
constexpr size_t OFF_WDN   = OFF_WGU + (size_t)32 * 512 * 1024 * 2;
constexpr size_t OFF_BIAS1 = OFF_WDN + (size_t)32 * 1024 * 256 * 2;
constexpr size_t OFF_WR    = OFF_BIAS1 + 1024;
constexpr size_t OFF_CS    = OFF_WR + (size_t)48 * 1024 * 4;
constexpr size_t OFF_HN    = OFF_CS + (size_t)NTOK * 32 * 8;
constexpr size_t OFF_QA    = OFF_HN + (size_t)NTOK * 1024 * 2;
constexpr size_t OFF_KA    = OFF_QA + (size_t)NTOK * 512 * 2;
constexpr size_t OFF_VA    = OFF_KA + (size_t)NTOK * 64 * 2;
constexpr size_t OFF_QI    = OFF_VA + (size_t)NTOK * 64 * 2;
constexpr size_t OFF_KI    = OFF_QI + (size_t)NTOK * 256 * 2;
constexpr size_t OFF_WI    = OFF_KI + (size_t)NTOK * 32 * 2;
constexpr size_t OFF_QBN   = OFF_WI + (size_t)NTOK * 8 * 4;
constexpr size_t OFF_QBR   = OFF_QBN + (size_t)NTOK * 512 * 2;
constexpr size_t KV_STRIDE = (size_t)NTOK * 128 * 2 + 65536 * 4;
constexpr size_t OFF_KV    = OFF_QBR + (size_t)NTOK * 512 * 2;
constexpr size_t OFF_GATES = OFF_KV + 6 * KV_STRIDE;
constexpr size_t OFF_QKV_END = OFF_GATES + (size_t)NTOK * 24 * 4;
constexpr size_t OFF_KC    = al256(OFF_QKV_END);
constexpr size_t OFF_VCT   = OFF_KC + (size_t)16 * 256 * 64 * 2;
constexpr size_t OFF_SEL   = OFF_VCT + (size_t)16 * 256 * 64 * 2;
constexpr size_t OFF_OA    = OFF_HN;
constexpr size_t OFF_OB    = OFF_OA + (size_t)NTOK * 512 * 2;
constexpr size_t OFF_GA    = OFF_SEL + (size_t)NTOK * 256 * 2;
constexpr size_t OFF_GB    = OFF_GA + (size_t)NTOK * 1024 * 2;
constexpr size_t OFF_MASK  = OFF_GB + (size_t)NTOK * 1024 * 2;
constexpr size_t OFF_LIST  = OFF_MASK + (size_t)16 * 4096 * 8;
constexpr size_t OFF_WT    = OFF_LIST + (size_t)32 * NTOK * 4;
constexpr size_t OFF_RS    = OFF_WT + (size_t)NTOK * 2 * 4;
constexpr size_t WS_END    = OFF_RS + (size_t)NTOK * 4;
constexpr size_t OFF_MERGED = OFF_QA;
constexpr size_t OFF_ACT    = OFF_QA;
constexpr size_t OFF_Y      = OFF_QA + (size_t)40 * 1024 * 1024;
static_assert(OFF_Y + (size_t)2 * NTOK * 1024 * 2 <= OFF_QKV_END, "Y overlay");
static_assert((size_t)544 * 128 * 256 * 2 <= (size_t)40 * 1024 * 1024, "ACT overlay");

struct Params {
    const float* in[21];
    const int* pos;
    float* out;
    unsigned char* ws;
    double inv_freq[32];
    int ph_lo, ph_hi;
};

DEVI unsigned f2bf(float f) { unsigned u = __float_as_uint(f); return (u + 0x7fffu + ((u >> 16) & 1u)) >> 16; }
typedef __bf16 bf16v2_t __attribute__((ext_vector_type(2)));
DEVI unsigned pk2(float lo, float hi) { const f32x2 v = {lo, hi}; return __builtin_bit_cast(unsigned, __builtin_convertvector(v, bf16v2_t)); }
DEVI float rows_max(float x) {
    float a = x, b = x;
    asm volatile("v_nop\n\tv_nop\n\tv_permlane16_swap_b32 %0, %1" : "+v"(a), "+v"(b));
    x = fmaxf(a, b); a = x; b = x;
    asm volatile("v_nop\n\tv_nop\n\tv_permlane32_swap_b32 %0, %1" : "+v"(a), "+v"(b));
    return fmaxf(a, b);
}
DEVI float rows_sum(float x) {
    float a = x, b = x;
    asm volatile("v_nop\n\tv_nop\n\tv_permlane16_swap_b32 %0, %1" : "+v"(a), "+v"(b));
    x = a + b; a = x; b = x;
    asm volatile("v_nop\n\tv_nop\n\tv_permlane32_swap_b32 %0, %1" : "+v"(a), "+v"(b));
    return a + b;
}
DEVI float bf2f(unsigned h) { return __uint_as_float(h << 16); }
DEVI float sigmoidf_(float x) { return __builtin_amdgcn_rcpf(1.0f + __builtin_amdgcn_exp2f(-x * 1.4426950408889634f)); }
DEVI float wave_sum(float v) {
#pragma unroll
    for (int o = 32; o > 0; o >>= 1) v += __shfl_xor(v, o);
    return v;
}
DEVI int wave_sum_i32(int v) {
    v += __builtin_amdgcn_update_dpp(0, v, 0xB1, 0xF, 0xF, true);
    v += __builtin_amdgcn_update_dpp(0, v, 0x4E, 0xF, 0xF, true);
    v += __builtin_amdgcn_update_dpp(0, v, 0x141, 0xF, 0xF, true);
    v += __builtin_amdgcn_update_dpp(0, v, 0x140, 0xF, 0xF, true);
    return __builtin_amdgcn_readlane(v, 0) + __builtin_amdgcn_readlane(v, 16) + __builtin_amdgcn_readlane(v, 32) + __builtin_amdgcn_readlane(v, 48);
}
DEVI float wave_sum_f32_dpp(float v) {
    v += __builtin_bit_cast(float, __builtin_amdgcn_update_dpp(0, __builtin_bit_cast(int, v), 0xB1, 0xF, 0xF, true));
    v += __builtin_bit_cast(float, __builtin_amdgcn_update_dpp(0, __builtin_bit_cast(int, v), 0x4E, 0xF, 0xF, true));
    v += __builtin_bit_cast(float, __builtin_amdgcn_update_dpp(0, __builtin_bit_cast(int, v), 0x141, 0xF, 0xF, true));
    v += __builtin_bit_cast(float, __builtin_amdgcn_update_dpp(0, __builtin_bit_cast(int, v), 0x140, 0xF, 0xF, true));
    const int iv = __builtin_bit_cast(int, v);
    return (__builtin_bit_cast(float, __builtin_amdgcn_readlane(iv, 0)) + __builtin_bit_cast(float, __builtin_amdgcn_readlane(iv, 16))) +
           (__builtin_bit_cast(float, __builtin_amdgcn_readlane(iv, 32)) + __builtin_bit_cast(float, __builtin_amdgcn_readlane(iv, 48)));
}
DEVI bf16x8 pack8(const f32x4& a, const f32x4& b) {
    u32x4 w; w.x = pk2(a[0], a[1]); w.y = pk2(a[2], a[3]); w.z = pk2(b[0], b[1]); w.w = pk2(b[2], b[3]);
    return __builtin_bit_cast(bf16x8, w);
}
#define MFMA16(a, b, c) __builtin_amdgcn_mfma_f32_16x16x32_bf16((a), (b), (c), 0, 0, 0)


#define XB_TMO      128
#define XB_XCNT(j)  (256  + 64 * (j))
#define XB_XSUB(j)  (1280 + 64 * (j))
#define XB_XGEN(j)  (2304 + 64 * (j))
#define XB_TOP      3328
#define XB_TOPGEN   3392
#define XCD_BAR_WORDS 3456
#define XB_SPIN_CAP (1u << 22)
DEVI unsigned xb_ld(unsigned* p)              { return __hip_atomic_load(p, __ATOMIC_RELAXED, __HIP_MEMORY_SCOPE_AGENT); }
DEVI unsigned xb_add(unsigned* p, unsigned v) { return __hip_atomic_fetch_add(p, v, __ATOMIC_RELAXED, __HIP_MEMORY_SCOPE_AGENT); }
DEVI unsigned xb_xcc_id() { return (unsigned)__builtin_amdgcn_s_getreg((3 << 11) | 20) & 0xFu; }
#define XB_SPIN(cond, bar) do { unsigned _sp = 0; while (cond) { __builtin_amdgcn_s_sleep(1); \
    if ((++_sp & 255u) == 0u) { if (xb_ld(&(bar)[XB_TMO])) break; if (_sp > XB_SPIN_CAP) { atomicAdd(&(bar)[XB_TMO], 1u); break; } } } } while (0)
struct XcdBarrier { unsigned* bar; unsigned x; volatile LAS unsigned* st; };
DEVI XcdBarrier xcd_barrier_post(unsigned* bar, volatile LAS unsigned* st) {
    XcdBarrier b; b.bar = bar; b.x = xb_xcc_id(); b.st = st;
    if (threadIdx.x == 0) (void)xb_add(&bar[XB_XCNT(b.x)], 1u);
    return b;
}
DEVI void xcd_barrier_complete(unsigned* bar, unsigned x, unsigned& nloc, unsigned& nx) {
    const unsigned G = gridDim.x * gridDim.y * gridDim.z;
    unsigned sum, cnt, mine, sp = 0u;
    for (;;) {
        sum = 0u; cnt = 0u; mine = 0u;
#pragma unroll
        for (unsigned j = 0; j < 16; ++j) { const unsigned c = xb_ld(&bar[XB_XCNT(j)]); sum += c; cnt += (c > 0u) ? 1u : 0u; mine = (j == x) ? c : mine; }
        if (sum == G) break;
        __builtin_amdgcn_s_sleep(1);
        if ((++sp & 255u) == 0u) { if (xb_ld(&bar[XB_TMO])) break; if (sp > XB_SPIN_CAP) { atomicAdd(&bar[XB_TMO], 1u); break; } }
    }
    nloc = mine > 0u ? mine : 1u; nx = cnt > 0u ? cnt : 1u;
}
DEVI void xcd_barrier(const XcdBarrier& b) {
    asm volatile("s_waitcnt vmcnt(0)" ::: "memory");
    __syncthreads();
    if (threadIdx.x == 0) {
        unsigned* bar = b.bar;
        __builtin_amdgcn_s_waitcnt(0);
        unsigned nloc = b.st[0], nx = b.st[1];
        if (nloc == 0u) { xcd_barrier_complete(bar, b.x, nloc, nx); b.st[0] = nloc; b.st[1] = nx; }
        const unsigned old = xb_add(&bar[XB_XSUB(b.x)], 1u);
        const unsigned gen = old / nloc;
        if (old + 1u == (gen + 1u) * nloc) {
            __builtin_amdgcn_fence(__ATOMIC_RELEASE, "agent");
            asm volatile("s_waitcnt vmcnt(0)" ::: "memory");
            const unsigned og = xb_add(&bar[XB_TOP], 1u);
            const unsigned tg = og / nx;
            if (og + 1u == (tg + 1u) * nx) xb_add(&bar[XB_TOPGEN], 1u);
            else XB_SPIN(xb_ld(&bar[XB_TOPGEN]) == tg, bar);
            __builtin_amdgcn_fence(__ATOMIC_ACQUIRE, "agent");
            xb_add(&bar[XB_XGEN(b.x)], 1u);
            asm volatile("s_waitcnt vmcnt(0)" ::: "memory");
        } else {
            XB_SPIN(xb_ld(&bar[XB_XGEN(b.x)]) == gen, bar);
            __builtin_amdgcn_fence(__ATOMIC_ACQUIRE, "agent");
            asm volatile("s_waitcnt vmcnt(0)" ::: "memory");
        }
    }
    __syncthreads();
}

typedef __amdgpu_buffer_rsrc_t rsrc_t;
DEVI u32x4 bload16(rsrc_t r, unsigned voff, unsigned soff) { return __builtin_bit_cast(u32x4, __builtin_amdgcn_raw_buffer_load_b128(r, (int)voff, (int)soff, 0)); }
DEVI void glds16(rsrc_t r, unsigned char* lds_dst_uniform, unsigned voff, unsigned soff) {
    __builtin_amdgcn_raw_ptr_buffer_load_lds(r, (LAS void*)lds_dst_uniform, 16, (int)voff, (int)soff, 0, 0);
}
template <class FA, class FB>
DEVI void gemm128(f32x4 (&acc)[4][4], rsrc_t rs, unsigned sA, const FA& offA, unsigned sB, const FB& offB, int nk, unsigned char* lds, int tid) {
    const int lane = tid & 63, wid = __builtin_amdgcn_readfirstlane(tid >> 6), wr = wid >> 1, wc = wid & 1;
    const int lr = tid >> 3;
    const unsigned csrc = (unsigned)(((lane & 7) ^ ((lane >> 3) & 7)) << 4);
    unsigned oa[4], ob[4];
#pragma unroll
    for (int i = 0; i < 4; ++i) { oa[i] = offA(lr + 32 * i) + csrc; ob[i] = offB(lr + 32 * i) + csrc; }
#pragma unroll
    for (int m = 0; m < 4; ++m)
#pragma unroll
        for (int n = 0; n < 4; ++n) acc[m][n] = (f32x4){0.f, 0.f, 0.f, 0.f};
    const int q = lane >> 4, r16 = lane & 15;
    const int roffA0 = (wr * 64 + r16) * 128 + (((0 + q) ^ (lane & 7)) << 4);
    const int roffA1 = (wr * 64 + r16) * 128 + (((4 + q) ^ (lane & 7)) << 4);
    const int roffB0 = 16384 + (wc * 64 + r16) * 128 + (((0 + q) ^ (lane & 7)) << 4);
    const int roffB1 = 16384 + (wc * 64 + r16) * 128 + (((4 + q) ^ (lane & 7)) << 4);
    unsigned char* wbase = lds + wid * 1024;
#pragma unroll
    for (int i = 0; i < 4; ++i) { glds16(rs, wbase + i * 4096, oa[i], sA); glds16(rs, wbase + 16384 + i * 4096, ob[i], sB); }
    for (int kt = 0; kt < nk; ++kt) {
        unsigned char* cur = lds + (kt & 1) * 32768;
        __syncthreads();
        if (kt + 1 < nk) {
            unsigned char* nb = wbase + ((kt + 1) & 1) * 32768;
#pragma unroll
            for (int i = 0; i < 4; ++i) { glds16(rs, nb + i * 4096, oa[i], sA + (kt + 1) * 128); glds16(rs, nb + 16384 + i * 4096, ob[i], sB + (kt + 1) * 128); }
        }
        bf16x8 a0[4], b0[4], a1[4], b1[4];
#pragma unroll
        for (int m = 0; m < 4; ++m) a0[m] = *(const bf16x8*)(cur + roffA0 + m * 2048);
#pragma unroll
        for (int n = 0; n < 4; ++n) b0[n] = *(const bf16x8*)(cur + roffB0 + n * 2048);
#pragma unroll
        for (int m = 0; m < 4; ++m) a1[m] = *(const bf16x8*)(cur + roffA1 + m * 2048);
#pragma unroll
        for (int n = 0; n < 4; ++n) b1[n] = *(const bf16x8*)(cur + roffB1 + n * 2048);
#pragma unroll
        for (int m = 0; m < 4; ++m)
#pragma unroll
            for (int n = 0; n < 4; ++n) acc[m][n] = MFMA16(b0[n], a0[m], acc[m][n]);
#pragma unroll
        for (int m = 0; m < 4; ++m)
#pragma unroll
            for (int n = 0; n < 4; ++n) acc[m][n] = MFMA16(b1[n], a1[m], acc[m][n]);
    }
    __syncthreads();
}

DEVI bool tile_map(int k, int ncol, int& mt, int& nt) {
    if (gridDim.x == 512) {
        const int x = blockIdx.x & 7, j = blockIdx.x >> 3;
        const int v = j + 64 * k;
        if (v >= 32 * ncol) return false;
        const int nfull = ncol >> 3, rem = ncol & 7;
        int mtl;
        if (v < nfull * 256) { const int cg = v >> 8, w = v & 255; mtl = (w >> 6) * 8 + ((w & 63) >> 3); nt = cg * 8 + (w & 7); }
        else { const int v2 = v - nfull * 256, per = 8 * rem; const int rg = v2 / per, w = v2 % per; mtl = rg * 8 + w / rem; nt = nfull * 8 + w % rem; }
        mt = x * 32 + mtl;
        return true;
    }
    const int u = blockIdx.x + gridDim.x * k;
    if (u >= 256 * ncol) return false;
    mt = u / ncol; nt = u % ncol;
    return true;
}
struct RowLin { unsigned ldb; DEVI unsigned operator()(int r) const { return (unsigned)r * ldb; } };

DEVI int win_map(int j) {
    if (j < 896) return j;
    if (j < 1408) return j - 896 + 936;
    if (j < 2176) return j - 1408 + 1448;
    if (j < 2208) return j - 2176 + 896;
    if (j < 2216) return j - 2208 + 928;
    if (j < 2240) return j;
    if (j < 2304) return -1;
    return j - 64;
}

struct TJob { const float* src; bf16_t* dst; int K, ld, nrows, perm, nb; size_t sb, db; };
DEVI TJob get_tjob(const Params& P, int j) {
    unsigned char* ws = P.ws;
    switch (j) {
        case 0: return TJob{P.in[3], (bf16_t*)(ws + OFF_WIN_T), 1024, INW, WIN_ROWS, 1, 1, 0, 0};
        case 1: return TJob{P.in[10], (bf16_t*)(ws + OFF_WBRA), 512, 1024, 1024, 0, 1, 0, 0};
        case 2: return TJob{P.in[11], (bf16_t*)(ws + OFF_WBRB), 512, 1024, 1024, 0, 1, 0, 0};
        case 3: return TJob{P.in[12], (bf16_t*)(ws + OFF_WOUT), 1024, 1024, 1024, 0, 1, 0, 0};
        case 4: return TJob{P.in[5], (bf16_t*)(ws + OFF_W1K), 2048, 128, 128, 0, 1, 0, 0};
        case 5: return TJob{P.in[8], (bf16_t*)(ws + OFF_W1V), 2048, 128, 128, 0, 1, 0, 0};
        case 6: return TJob{P.in[6], (bf16_t*)(ws + OFF_W2K), 128, 64, 64, 0, 1, 0, 0};
        case 7: return TJob{P.in[9], (bf16_t*)(ws + OFF_W2V), 128, 64, 64, 0, 1, 0, 0};
        case 8: return TJob{P.in[18], (bf16_t*)(ws + OFF_WGU), 1024, 512, 512, 0, 32, (size_t)1024 * 512, (size_t)512 * 1024};
        default: return TJob{P.in[19], (bf16_t*)(ws + OFF_WDN), 256, 1024, 1024, 0, 32, (size_t)256 * 1024, (size_t)1024 * 256};
    }
}
DEVI int tjob_tiles(int j) {
    switch (j) {
        case 0: return (WIN_ROWS / 64) * 16;
        case 1: case 2: return 16 * 8;
        case 3: return 16 * 16;
        case 4: case 5: return 2 * 32;
        case 6: case 7: return 1 * 2;
        case 8: return 32 * 8 * 16;
        default: return 32 * 16 * 4;
    }
}

DEVI void transpose_tile(const TJob& J, int tile, unsigned char* lds, int tid) {
    float* T = (float*)lds;
    const int kt = J.K / 64, rt = J.nrows / 64;
    const int b = tile / (kt * rt), rem = tile % (kt * rt);
    const int r0 = (rem / kt) * 64, k0 = (rem % kt) * 64;
    const float* src = J.src + (size_t)b * J.sb;
    bf16_t* dst = J.dst + (size_t)b * J.db;
    const int n4 = (tid & 15) * 4;
    int col = r0 + n4; if (J.perm) col = win_map(col);
    f32x4 ld4[4];
#pragma unroll
    for (int i = 0; i < 4; ++i) {
        const int kk = (tid >> 4) + 16 * i;
        ld4[i] = (col >= 0) ? *(const f32x4*)(src + (size_t)(k0 + kk) * J.ld + col) : (f32x4){0.f, 0.f, 0.f, 0.f};
    }
#pragma unroll
    for (int i = 0; i < 4; ++i) {
        const int kk = (tid >> 4) + 16 * i;
#pragma unroll
        for (int e = 0; e < 4; ++e) T[kk * 65 + n4 + e] = ld4[i][e];
    }
    __syncthreads();
    const int r2 = tid >> 2, ks = (tid & 3) * 16;
    u32x4 w0, w1;
    w0.x = pk2(T[(ks + 0) * 65 + r2], T[(ks + 1) * 65 + r2]); w0.y = pk2(T[(ks + 2) * 65 + r2], T[(ks + 3) * 65 + r2]);
    w0.z = pk2(T[(ks + 4) * 65 + r2], T[(ks + 5) * 65 + r2]); w0.w = pk2(T[(ks + 6) * 65 + r2], T[(ks + 7) * 65 + r2]);
    w1.x = pk2(T[(ks + 8) * 65 + r2], T[(ks + 9) * 65 + r2]); w1.y = pk2(T[(ks + 10) * 65 + r2], T[(ks + 11) * 65 + r2]);
    w1.z = pk2(T[(ks + 12) * 65 + r2], T[(ks + 13) * 65 + r2]); w1.w = pk2(T[(ks + 14) * 65 + r2], T[(ks + 15) * 65 + r2]);
    bf16_t* d = dst + (size_t)(r0 + r2) * J.K + k0 + ks;
    *(u32x4*)d = w0; *(u32x4*)(d + 8) = w1;
    __syncthreads();
}

DEVI void rms_row_bf16(const float* xr, const float* g, bf16_t* o, int lane) {
    f32x4 v[4]; float ss = 0.f;
#pragma unroll
    for (int i = 0; i < 4; ++i) { v[i] = *(const f32x4*)(xr + i * 256 + lane * 4); ss += v[i][0] * v[i][0] + v[i][1] * v[i][1] + v[i][2] * v[i][2] + v[i][3] * v[i][3]; }
    ss = wave_sum(ss);
    const float rs = rsqrtf(ss * (1.0f / 1024.0f) + RMS_EPS);
#pragma unroll
    for (int i = 0; i < 4; ++i) {
        const f32x4 gg = *(const f32x4*)(g + i * 256 + lane * 4);
        u32x2 w; w.x = pk2(v[i][0] * rs * gg[0], v[i][1] * rs * gg[1]); w.y = pk2(v[i][2] * rs * gg[2], v[i][3] * rs * gg[3]);
        *(u32x2*)(o + i * 256 + lane * 4) = w;
    }
}

DEVI void phase_prep(const Params& P, unsigned char* lds, int tid, int part) {
    unsigned char* ws = P.ws;
    const int lane = tid & 63, wid = __builtin_amdgcn_readfirstlane(tid >> 6);
    int base = 0;
#pragma unroll
    for (int j = 0; j < 10; ++j) {
        const bool early = (j == 0) || (j >= 4 && j <= 7);
        if (early == (part == 0)) {
            const int nt = tjob_tiles(j);
            const TJob J = get_tjob(P, j);
            for (int t = blockIdx.x; t < nt; t += gridDim.x) transpose_tile(J, t, lds, tid);
        }
    }
    (void)base;
    if (part == 1) {
        float* wr = (float*)(ws + OFF_WR);
        const float* g = P.in[13]; const float* wg = P.in[14]; const float* we = P.in[16];
        for (int e = blockIdx.x * NTHREADS + tid; e < 48 * 1024; e += gridDim.x * NTHREADS) {
            const int c = e >> 10, k = e & 1023;
            float v = 0.f;
            if (c < 4) v = wg[k * 4 + c]; else if (c < 36) v = we[k * 32 + (c - 4)];
            wr[e] = v * g[k];
        }
        return;
    }
    {
        const float* x = P.in[0]; const float* g = P.in[2]; bf16_t* hn = (bf16_t*)(ws + OFF_HN);
        for (int r = blockIdx.x * 4 + wid; r < NTOK; r += gridDim.x * 4) rms_row_bf16(x + (size_t)r * 1024, g, hn + (size_t)r * 1024, lane);
    }
    {
        f32x2* cs = (f32x2*)(ws + OFF_CS);
        for (int e = blockIdx.x * NTHREADS + tid; e < NTOK * 32; e += gridDim.x * NTHREADS) {
            const int tok = e >> 5, i = e & 31;
            const double a = (double)P.pos[tok] * P.inv_freq[i];
            double t = a * 0.15915494309189535;
            t -= floor(t);
            const float tf = (float)t;
            cs[e] = (f32x2){__builtin_amdgcn_cosf(tf), __builtin_amdgcn_sinf(tf)};
        }
    }
    {
        float* red = (float*)lds;
        for (int job = blockIdx.x; job < 32; job += gridDim.x) {
            const int kv = job >> 4, cg8 = job & 15;
            const float* pe = P.in[kv ? 7 : 4]; const float* w1 = P.in[kv ? 8 : 5];
            const int cc = tid & 7, jj = tid >> 3;
            float s = 0.f;
            for (int j = jj; j < 2048; j += 32) s += pe[j] * w1[(size_t)j * 128 + cg8 * 8 + cc];
            red[tid] = s;
            __syncthreads();
            if (tid < 8) { float t = 0.f; for (int u = 0; u < 32; ++u) t += red[u * 8 + tid]; ((float*)(ws + OFF_BIAS1))[kv * 128 + cg8 * 8 + tid] = t; }
            __syncthreads();
        }
    }
}

DEVI void st_bf16(bf16_t* p, float v) { *p = (bf16_t)f2bf(v); }

DEVI int gemm1_col_tile(int part, int i) {
    if (part == 0) return (i < 2) ? 5 + i : ((i < 4) ? 9 + i : 17);
    return (i < 5) ? i : ((i < 9) ? i + 2 : ((i < 13) ? i + 4 : i + 5));
}
DEVI void phase_gemm1(const Params& P, unsigned char* lds, int tid, int part) {
    unsigned char* ws = P.ws;
    const rsrc_t rs = __builtin_amdgcn_make_buffer_rsrc((void*)P.ws, (short)0, (int)0x7fffffff, 0x00020000);
    const bf16_t* hn = (const bf16_t*)(ws + OFF_HN);
    const bf16_t* wt = (const bf16_t*)(ws + OFF_WIN_T);
    const f32x2* cs = (const f32x2*)(ws + OFF_CS);
    const int lane = tid & 63, wid = __builtin_amdgcn_readfirstlane(tid >> 6), wr = wid >> 1, wc = wid & 1, q = lane >> 4, cl = lane & 15;
    constexpr int NT_N = G1_COLS / 128;
    for (int kk = 0;; ++kk) {
        int mt, nti;
        if (!tile_map(kk, part == 0 ? 5 : NT_N - 5, mt, nti)) break;
        const int nt = gemm1_col_tile(part, nti);
        f32x4 acc[4][4];
        gemm128(acc, rs, (unsigned)(OFF_HN + (size_t)mt * 128 * 2048), RowLin{2048}, (unsigned)(OFF_WIN_T + (size_t)nt * 128 * 2048), RowLin{2048}, 16, lds, tid);
        const int c64 = nt * 2 + wc;
        const int tok0 = mt * 128 + wr * 64 + cl;
        if (c64 < 10 || (c64 >= 14 && c64 < 34)) {
            bool do_rope; float scale = 1.f; int kind;
            int g = 0, hk = 0;
            if (c64 < 8) { kind = 0; do_rope = true; scale = 0.125f * LOG2E; }
            else if (c64 == 8) { kind = 1; do_rope = true; }
            else if (c64 == 9) { kind = 2; do_rope = false; }
            else if (c64 < 22) { kind = 3; do_rope = true; scale = 0.125f * LOG2E; }
            else { kind = 4; g = (c64 - 22) >> 1; hk = (c64 - 22) & 1; do_rope = (g == 2 || g == 4); }
#pragma unroll
            for (int m = 0; m < 4; ++m) {
                const int tok = tok0 + m * 16;
                f32x4 o[4], nr[4];
#pragma unroll
                for (int n = 0; n < 4; ++n) { nr[n] = acc[m][n] * scale; o[n] = nr[n]; }
                if (do_rope) {
#pragma unroll
                    for (int n = 0; n < 2; ++n) {
                        const f32x4 c01 = *(const f32x4*)(cs + (size_t)tok * 32 + n * 16 + q * 4);
                        const f32x4 c23 = *(const f32x4*)(cs + (size_t)tok * 32 + n * 16 + q * 4 + 2);
                        const float cc[4] = {c01[0], c01[2], c23[0], c23[2]}, sn[4] = {c01[1], c01[3], c23[1], c23[3]};
#pragma unroll
                        for (int j = 0; j < 4; ++j) {
                            const float x1 = nr[n][j], x2 = nr[n + 2][j];
                            o[n][j] = x1 * cc[j] - x2 * sn[j]; o[n + 2][j] = x1 * sn[j] + x2 * cc[j];
                        }
                    }
                }
                if (kind == 0 || kind == 1 || kind == 2) {
                    bf16_t* d = (kind == 0) ? (bf16_t*)(ws + OFF_QA) + (size_t)tok * 512 + c64 * 64 : (bf16_t*)(ws + (kind == 1 ? OFF_KA : OFF_VA)) + (size_t)tok * 64;
#pragma unroll
                    for (int n = 0; n < 4; ++n) { u32x2 w; w.x = pk2(o[n][0], o[n][1]); w.y = pk2(o[n][2], o[n][3]); *(u32x2*)(d + n * 16 + q * 4) = w; }
                } else if (kind == 3) {
                    const int h = c64 - 14;
                    bf16_t* dn = (bf16_t*)(ws + OFF_QBN) + (size_t)tok * 512 + h * 64; bf16_t* dr = (bf16_t*)(ws + OFF_QBR) + (size_t)tok * 512 + h * 64;
#pragma unroll
                    for (int n = 0; n < 4; ++n) {
                        u32x2 w; w.x = pk2(nr[n][0], nr[n][1]); w.y = pk2(nr[n][2], nr[n][3]); *(u32x2*)(dn + n * 16 + q * 4) = w;
                        u32x2 v; v.x = pk2(o[n][0], o[n][1]); v.y = pk2(o[n][2], o[n][3]); *(u32x2*)(dr + n * 16 + q * 4) = v;
                    }
                } else {
                    bf16_t* d = (bf16_t*)(ws + OFF_KV + (size_t)g * KV_STRIDE);
                    const int b = tok >> 12, tl = tok & 4095;
                    if (g == 3 || g == 5) {
#pragma unroll
                        for (int n = 0; n < 4; ++n)
#pragma unroll
                            for (int j = 0; j < 4; ++j) st_bf16(d + ((size_t)((b * 2 + hk) * 64 + n * 16 + q * 4 + j)) * 4096 + tl, o[n][j]);
                    } else {
#pragma unroll
                        for (int n = 0; n < 4; ++n) { u32x2 w; w.x = pk2(o[n][0], o[n][1]); w.y = pk2(o[n][2], o[n][3]);
                            *(u32x2*)(d + ((size_t)((b * 2 + hk) * 4096 + tl)) * 64 + n * 16 + q * 4) = w; }
                    }
                }
            }
        } else if (c64 >= 10 && c64 < 14) {
            bf16_t* d = (bf16_t*)(ws + OFF_QI);
#pragma unroll
            for (int m = 0; m < 4; ++m) {
                const int tok = tok0 + m * 16;
                float cc[4], sn[4];
#pragma unroll
                for (int j = 0; j < 4; ++j) { const f32x2 c = cs[(size_t)tok * 32 + 2 * (4 * q + j)]; cc[j] = c.x; sn[j] = c.y; }
#pragma unroll
                for (int hh = 0; hh < 2; ++hh) {
                    const int head = 2 * (c64 - 10) + hh;
                    f32x4 r1, r2;
#pragma unroll
                    for (int j = 0; j < 4; ++j) { const float x1 = acc[m][2 * hh][j], x2 = acc[m][2 * hh + 1][j]; r1[j] = x1 * cc[j] - x2 * sn[j]; r2[j] = x1 * sn[j] + x2 * cc[j]; }
                    u32x2 w; w.x = pk2(r1[0], r1[1]); w.y = pk2(r1[2], r1[3]); *(u32x2*)(d + (size_t)tok * 256 + head * 32 + q * 4) = w;
                    u32x2 v; v.x = pk2(r2[0], r2[1]); v.y = pk2(r2[2], r2[3]); *(u32x2*)(d + (size_t)tok * 256 + head * 32 + 16 + q * 4) = v;
                }
            }
        } else if (c64 >= 36) {
            bf16_t* d = (bf16_t*)(ws + (c64 < 52 ? OFF_GA : OFF_GB));
            const int cb = (c64 < 52 ? c64 - 36 : c64 - 52) * 64;
#pragma unroll
            for (int m = 0; m < 4; ++m)
#pragma unroll
                for (int n = 0; n < 4; ++n) {
                    u32x2 w; w.x = pk2(sigmoidf_(acc[m][n][0]), sigmoidf_(acc[m][n][1])); w.y = pk2(sigmoidf_(acc[m][n][2]), sigmoidf_(acc[m][n][3]));
                    *(u32x2*)(d + (size_t)(tok0 + m * 16) * 1024 + cb + n * 16 + q * 4) = w;
                }
        } else if (c64 == 34) {
            bf16_t* dki = (bf16_t*)(ws + OFF_KI); float* dwi = (float*)(ws + OFF_WI); float* dg = (float*)(ws + OFF_GATES);
#pragma unroll
            for (int m = 0; m < 4; ++m) {
                const int tok = tok0 + m * 16;
                f32x4 r1, r2;
#pragma unroll
                for (int j = 0; j < 4; ++j) {
                    const f32x2 c = cs[(size_t)tok * 32 + 2 * (4 * q + j)];
                    const float x1 = acc[m][0][j], x2 = acc[m][1][j];
                    r1[j] = x1 * c.x - x2 * c.y; r2[j] = x1 * c.y + x2 * c.x;
                }
                u32x2 w; w.x = pk2(r1[0], r1[1]); w.y = pk2(r1[2], r1[3]); *(u32x2*)(dki + (size_t)tok * 32 + q * 4) = w;
                u32x2 v; v.x = pk2(r2[0], r2[1]); v.y = pk2(r2[2], r2[3]); *(u32x2*)(dki + (size_t)tok * 32 + 16 + q * 4) = v;
                if (q < 2) *(f32x4*)(dwi + (size_t)tok * 8 + q * 4) = acc[m][2];
                else { f32x4 sv; for (int j = 0; j < 4; ++j) sv[j] = sigmoidf_(acc[m][2][j]); *(f32x4*)(dg + (size_t)tok * 24 + (q * 4 - 8)) = sv; }
                { f32x4 sv; for (int j = 0; j < 4; ++j) sv[j] = sigmoidf_(acc[m][3][j]); *(f32x4*)(dg + (size_t)tok * 24 + 8 + q * 4) = sv; }
            }
        }
    }
}

DEVI float siluf_(float x) { return x * __builtin_amdgcn_rcpf(1.0f + __builtin_amdgcn_exp2f(-x * 1.4426950408889634f)); }

DEVI void phase_compress(const Params& P, unsigned char* lds, int tid) {
    unsigned char* ws = P.ws;
    const rsrc_t rs = __builtin_amdgcn_make_buffer_rsrc((void*)P.ws, (short)0, (int)0x7fffffff, 0x00020000);
    const int lane = tid & 63, wid = __builtin_amdgcn_readfirstlane(tid >> 6), wr = wid >> 1, wc = wid & 1, q = lane >> 4, cl = lane & 15;
    for (int u = blockIdx.x; u < 64; u += gridDim.x) {
        const int kv = u >> 5, mt = u & 31;
        const bf16_t* A = (const bf16_t*)(ws + OFF_KV + (size_t)kv * KV_STRIDE) + (size_t)mt * 128 * 1024;
        const bf16_t* W1 = (const bf16_t*)(ws + (kv ? OFF_W1V : OFF_W1K));
        const bf16_t* W2 = (const bf16_t*)(ws + (kv ? OFF_W2V : OFF_W2K));
        const float* bias = (const float*)(ws + OFF_BIAS1) + kv * 128;
        f32x4 acc[4][4];
        gemm128(acc, rs, (unsigned)(OFF_KV + (size_t)kv * KV_STRIDE + (size_t)mt * 128 * 2048), RowLin{2048}, (unsigned)(kv ? OFF_W1V : OFF_W1K), RowLin{4096}, 32, lds, tid);
#pragma unroll
        for (int m = 0; m < 4; ++m)
#pragma unroll
            for (int n = 0; n < 4; ++n) {
                const int col = wc * 64 + n * 16 + q * 4, row = wr * 64 + m * 16 + cl;
                const f32x4 bb = *(const f32x4*)(bias + col);
                const int ktile = col >> 6, ch = (col & 63) >> 3, wi = col & 7;
                u32x2 w; w.x = pk2(siluf_(acc[m][n][0] + bb[0]), siluf_(acc[m][n][1] + bb[1])); w.y = pk2(siluf_(acc[m][n][2] + bb[2]), siluf_(acc[m][n][3] + bb[3]));
                *(u32x2*)(lds + ktile * 16384 + row * 128 + ((ch ^ (row & 7)) << 4) + wi * 2) = w;
            }
#pragma unroll
        for (int i = 0; i < 4; ++i) {
            const int idx = tid + 256 * i;
            const int row = idx >> 4, ch16 = idx & 15, ktile = ch16 >> 3, ch = ch16 & 7;
            *(u32x4*)(lds + 32768 + ktile * 8192 + row * 128 + ((ch ^ (row & 7)) << 4)) = *(const u32x4*)(W2 + (size_t)row * 128 + ch16 * 8);
        }
        __syncthreads();
        f32x4 a2[4][2];
#pragma unroll
        for (int m = 0; m < 4; ++m) { a2[m][0] = (f32x4){0.f, 0.f, 0.f, 0.f}; a2[m][1] = (f32x4){0.f, 0.f, 0.f, 0.f}; }
#pragma unroll
        for (int kk = 0; kk < 4; ++kk) {
            const int ktile = kk >> 1, ks = kk & 1;
            bf16x8 a[4], b[2];
#pragma unroll
            for (int m = 0; m < 4; ++m) { const int row = wr * 64 + m * 16 + cl; a[m] = *(const bf16x8*)(lds + ktile * 16384 + row * 128 + (((ks * 4 + q) ^ (row & 7)) << 4)); }
#pragma unroll
            for (int n = 0; n < 2; ++n) { const int row = wc * 32 + n * 16 + cl; b[n] = *(const bf16x8*)(lds + 32768 + ktile * 8192 + row * 128 + (((ks * 4 + q) ^ (row & 7)) << 4)); }
#pragma unroll
            for (int m = 0; m < 4; ++m)
#pragma unroll
                for (int n = 0; n < 2; ++n) a2[m][n] = MFMA16(b[n], a[m], a2[m][n]);
        }
#pragma unroll
        for (int m = 0; m < 4; ++m)
#pragma unroll
            for (int n = 0; n < 2; ++n) {
                const int d = wc * 32 + n * 16 + q * 4;
                const int r = mt * 128 + wr * 64 + m * 16 + cl;
                const bool dead = ((r & 255) == 255);
                float v[4];
#pragma unroll
                for (int j = 0; j < 4; ++j) v[j] = dead ? 0.f : a2[m][n][j];
                if (kv == 0) {
                    bf16_t* kc = (bf16_t*)(ws + OFF_KC);
                    u32x2 w; w.x = pk2(v[0], v[1]); w.y = pk2(v[2], v[3]);
                    *(u32x2*)(kc + (size_t)r * 64 + d) = w;
                } else {
                    bf16_t* vct = (bf16_t*)(ws + OFF_VCT);
#pragma unroll
                    for (int j = 0; j < 4; ++j) st_bf16(vct + ((size_t)((r >> 8) * 64 + d + j)) * 256 + (r & 255), v[j]);
                }
            }
        __syncthreads();
    }
}

DEVI void phase_index(const Params& P, unsigned char* lds, int tid) {
    unsigned char* ws = P.ws;
    const bf16_t* QI = (const bf16_t*)(ws + OFF_QI);
    const bf16_t* KI = (const bf16_t*)(ws + OFF_KI);
    const float* WI = (const float*)(ws + OFF_WI);
    bf16_t* SEL = (bf16_t*)(ws + OFF_SEL);
    float* S = (float*)lds;
    const int lane = tid & 63, wid = __builtin_amdgcn_readfirstlane(tid >> 6), q = lane >> 4, cl = lane & 15;
    for (int u = blockIdx.x; u < NTOK / 4; u += gridDim.x) {
        const int b = u >> 10, w10 = u & 1023, s10 = (w10 < 512) ? w10 : 1535 - w10;
        const int t0 = s10 * 4, tok0 = b * 4096 + t0;
        const int t = t0 + wid;
        const int tok = tok0 + wid;
        if (t0 + 3 < 256) {
            for (int i = lane; i < 256; i += 64) SEL[(size_t)tok * 256 + i] = (bf16_t)(i <= t ? i : 0);
            continue;
        }
        {
            bf16x8 a[2];
#pragma unroll
            for (int hg = 0; hg < 2; ++hg) a[hg] = *(const bf16x8*)(QI + (size_t)(tok0 + (cl >> 2)) * 256 + (4 * hg + (cl & 3)) * 32 + q * 8);
            const f32x4 w0 = *(const f32x4*)(WI + (size_t)(tok0 + q) * 8), w1 = *(const f32x4*)(WI + (size_t)(tok0 + q) * 8 + 4);
            const int ktmax = (t0 + 3) >> 4;
            const bf16_t* kb = KI + (size_t)b * 4096 * 32 + cl * 32 + q * 8;
            for (int kt0 = wid; kt0 <= ktmax; kt0 += 16) {
                bf16x8 bk[4];
#pragma unroll
                for (int uu = 0; uu < 4; ++uu) { const int kt = (kt0 + 4 * uu <= ktmax) ? kt0 + 4 * uu : kt0; bk[uu] = *(const bf16x8*)(kb + (size_t)kt * 16 * 32); }
#pragma unroll
                for (int uu = 0; uu < 4; ++uu) {
                    const int kt = kt0 + 4 * uu;
                    f32x4 c0 = {0.f, 0.f, 0.f, 0.f}, c1 = {0.f, 0.f, 0.f, 0.f};
                    c0 = MFMA16(a[0], bk[uu], c0); c1 = MFMA16(a[1], bk[uu], c1);
                    float sc = 0.f;
#pragma unroll
                    for (int j = 0; j < 4; ++j) { sc += w0[j] * fmaxf(c0[j], 0.f); sc += w1[j] * fmaxf(c1[j], 0.f); }
                    if (kt <= ktmax) S[q * 4096 + kt * 16 + cl] = sc;
                }
            }
        }
        __syncthreads();
        {
            const int n = t + 1;
            const float* Sq = S + wid * 4096;
            if (n <= 256) {
                for (int i = lane; i < 256; i += 64) SEL[(size_t)tok * 256 + i] = (bf16_t)(i <= t ? i : 0);
            } else {
                const int nr = (n + 63) >> 6;
                float x[64];
                const float NINF = -__builtin_inff();
                float mx = NINF, mn = __builtin_inff();
#pragma unroll
                for (int r = 0; r < 64; ++r) {
                    const int key = r * 64 + lane;
                    const float v = Sq[key];
                    x[r] = (key < n) ? v : NINF;
                    mn = fminf(mn, (key < n) ? v : __builtin_inff());
                    mx = fmaxf(mx, x[r]);
                }
#pragma unroll
                for (int o = 32; o > 0; o >>= 1) { mx = fmaxf(mx, __shfl_xor(mx, o)); mn = fminf(mn, __shfl_xor(mn, o)); }
                float lo = mn, hi = mx, T; int need;
                int chi, clo = n;
                for (int rep32 = 0; rep32 < REPS(32); ++rep32) {
                lo = mn; hi = mx; clo = n;
                {
                    int c = 0;
#pragma unroll
                    for (int g8 = 0; g8 < 8; ++g8) if (g8 * 8 < nr) {
#pragma unroll
                        for (int r = g8 * 8; r < g8 * 8 + 8; ++r) c += (x[r] >= hi) ? 1 : 0;
                    }
                    chi = wave_sum_i32(c);
                }
                if (chi >= 256) { T = hi; need = 256;   }
                else {
                    float s1 = 0.f, s2 = 0.f;
#pragma unroll
                    for (int g8 = 0; g8 < 8; ++g8) if (g8 * 8 < nr) {
#pragma unroll
                        for (int r = g8 * 8; r < g8 * 8 + 8; ++r) { const float v = (x[r] == NINF) ? 0.f : x[r]; s1 += v; s2 += v * v; }
                    }
                    s1 = wave_sum_f32_dpp(s1); s2 = wave_sum_f32_dpp(s2);
                    const float fn = (float)n, mu = s1 / fn;
                    const float sg = sqrtf(fmaxf(s2 / fn - mu * mu, 1e-20f));
                    float vg;
                    {
                        const float pq = 256.0f / fn, pp = fminf(pq, 1.0f - pq);
                        const float tt = sqrtf(-2.0f * __logf(fmaxf(pp, 1e-6f)));
                        const float zz = tt - (2.515517f + 0.802853f * tt + 0.010328f * tt * tt) / (1.0f + 1.432788f * tt + 0.189269f * tt * tt + 0.001308f * tt * tt * tt);
                        vg = mu + ((pq <= 0.5f) ? zz : -zz) * sg;
                    }
                    bool found = false, adjacent = false; float thr = 0.f;
                    for (int it = 0; it < 160; ++it) {
                        if (clo - chi <= 64) break;
                        const float mid = 0.5f * lo + 0.5f * hi;
                        if (!(mid > lo && mid < hi)) { adjacent = true; break; }
                        float v = vg;
                        if (!(v > lo && v < hi) || (it & 3) == 3) v = mid;
                        int c = 0;
#pragma unroll
                        for (int g8 = 0; g8 < 8; ++g8) if (g8 * 8 < nr) {
#pragma unroll
                            for (int r = g8 * 8; r < g8 * 8 + 8; ++r) c += (x[r] >= v) ? 1 : 0;
                        }
                        c = wave_sum_i32(c);
                        if (c == 256) { found = true; thr = v; break; }
                        if (c > 256) { lo = v; clo = c; } else { hi = v; chi = c; }
                        const float zv = (v - mu) / sg;
                        const float dens = fmaxf(fn * 0.39894228f * __expf(-0.5f * zv * zv), 0.5f) / sg;
                        vg = v + ((float)c - ((c > 256) ? 244.0f : 268.0f)) / dens;
                    }
                    if (found) { T = thr; need = -1; }
                    else if (adjacent) { T = lo; need = 256 - chi; }
                    else {
                        float* cand = (float*)(lds + 65536) + wid * 64;
                        cand[lane] = NINF;
                        int cb = 0;
                        const unsigned long long ltm = (1ull << lane) - 1ull;
#pragma unroll
                        for (int g8 = 0; g8 < 8; ++g8) if (g8 * 8 < nr) {
#pragma unroll
                            for (int r = g8 * 8; r < g8 * 8 + 8; ++r) {
                                const bool isc = (x[r] >= lo) && (x[r] < hi);
                                const unsigned long long bm = __ballot(isc);
                                if (isc) cand[cb + __popcll(bm & ltm)] = x[r];
                                cb += __popcll(bm);
                            }
                        }
                        const float y = cand[lane];
                        int cgt = 0, cge = 0;
#pragma unroll
                        for (int k = 0; k < 64; ++k) { const float yk = __builtin_bit_cast(float, __builtin_amdgcn_readlane(__builtin_bit_cast(int, y), k)); cgt += (yk > y) ? 1 : 0; cge += (yk >= y) ? 1 : 0; }
                        const int nd = 256 - chi;
                        const bool isT = (y != NINF) && (cgt <= nd - 1) && (cge >= nd);
                        const unsigned long long tm = __ballot(isT);
                        const int tl = (tm != 0ull) ? (int)__builtin_ctzll(tm) : 0;
                        T = __shfl(y, tl);
                        need = nd - __shfl(cgt, tl);
                    }
                }
                asm volatile("" : "+v"(mn), "+v"(mx));
                }
                bf16_t* selb = (bf16_t*)(lds + 65536 + 1024) + wid * 256;
                for (int rep33 = 0; rep33 < REPS(33); ++rep33) {
                int base = 0, eqc = 0;
                const unsigned long long lt = (1ull << lane) - 1ull;
#pragma unroll
                for (int g8 = 0; g8 < 8; ++g8) if (g8 * 8 < nr) {
#pragma unroll
                    for (int r = g8 * 8; r < g8 * 8 + 8; ++r) {
                        bool sel;
                        if (need < 0) sel = x[r] >= T;
                        else {
                            const bool eq = (x[r] == T);
                            const unsigned long long em = __ballot(eq);
                            sel = (x[r] > T) || (eq && (eqc + __popcll(em & lt) < need));
                            eqc += __popcll(em);
                        }
                        const unsigned long long sm = __ballot(sel);
                        if (sel) { const int pp = base + __popcll(sm & lt); if (pp < 256) selb[pp] = (bf16_t)(r * 64 + lane); }
                        base += __popcll(sm);
                    }
                }
                }
                __builtin_amdgcn_wave_barrier();
                if (lane < 32) *(u32x4*)(SEL + (size_t)tok * 256 + lane * 8) = *(const u32x4*)(selb + lane * 8);
                __builtin_amdgcn_wave_barrier();
            }
        }
        __syncthreads();
    }
}

DEVI int dsa_vswz(int row) { return (((row >> 1) & 1) << 1) | (((row >> 3) & 1) << 2); }
DEVI void phase_dsa(const Params& P, unsigned char* lds, int tid) {
    unsigned char* ws = P.ws;
    const bf16_t* QA = (const bf16_t*)(ws + OFF_QA);
    const bf16_t* KA = (const bf16_t*)(ws + OFF_KA);
    const bf16_t* VA = (const bf16_t*)(ws + OFF_VA);
    const bf16_t* SEL = (const bf16_t*)(ws + OFF_SEL);
    bf16_t* OA = (bf16_t*)(ws + OFF_OA);
    const int lane = tid & 63, wid = __builtin_amdgcn_readfirstlane(tid >> 6), q = lane >> 4, cl = lane & 15;
    unsigned char* vl = lds + wid * 8192;
    const float NINF = -__builtin_inff();
    const int stride = gridDim.x * 4;
    int tok = blockIdx.x * 4 + wid;
    if (tok >= NTOK) return;
    int kidx[16], mk[4]; bf16x8 bq[2];
    {
        const bf16_t* sel = SEL + (size_t)tok * 256;
#pragma unroll
        for (int rf = 0; rf < 16; ++rf) kidx[rf] = sel[32 * (rf >> 1) + 8 * (cl >> 2) + 4 * (rf & 1) + (cl & 3)];
#pragma unroll
        for (int cc = 0; cc < 4; ++cc) mk[cc] = sel[cc * 64 + lane];
#pragma unroll
        for (int ks = 0; ks < 2; ++ks) bq[ks] = *(const bf16x8*)(QA + (size_t)tok * 512 + (cl & 7) * 64 + ks * 32 + q * 8);
    }
    const int wrow = lane >> 3;
    for (; tok < NTOK; tok += stride) {
        const int b = tok >> 12, t = tok & 4095;
        const int cnt = (t + 1 < 256) ? t + 1 : 256;
        const int nc64 = (cnt + 63) >> 6;
        const bf16_t* kb = KA + (size_t)b * 4096 * 64;
        const bf16_t* vb = VA + (size_t)b * 4096 * 64;
        const bf16x8 zero8 = {0, 0, 0, 0, 0, 0, 0, 0};
        const bf16x8 bq0 = (cl < 8) ? bq[0] : zero8, bq1 = (cl < 8) ? bq[1] : zero8;
        u32x4 vr[8];
#pragma unroll
        for (int i = 0; i < 8; ++i) { const int key = __shfl(mk[0], wrow + 8 * i); vr[i] = *(const u32x4*)(vb + (size_t)key * 64 + (lane & 7) * 8); }
        f32x4 s[16];
#pragma unroll
        for (int rf = 0; rf < 16; ++rf) {
            s[rf] = (f32x4){0.f, 0.f, 0.f, 0.f};
            if ((rf >> 2) < nc64) {
                const bf16_t* kr = kb + (size_t)kidx[rf] * 64 + q * 8;
                const bf16x8 a0 = *(const bf16x8*)(kr), a1 = *(const bf16x8*)(kr + 32);
                s[rf] = MFMA16(a0, bq0, s[rf]); s[rf] = MFMA16(a1, bq1, s[rf]);
            }
            if ((rf & 3) == 3) asm volatile("" ::: "memory");
        }
        int mkc[4];
#pragma unroll
        for (int cc = 0; cc < 4; ++cc) mkc[cc] = mk[cc];
        {
            const int tn = (tok + stride < NTOK) ? tok + stride : tok;
            const bf16_t* sel = SEL + (size_t)tn * 256;
#pragma unroll
            for (int rf = 0; rf < 16; ++rf) kidx[rf] = sel[32 * (rf >> 1) + 8 * (cl >> 2) + 4 * (rf & 1) + (cl & 3)];
#pragma unroll
            for (int cc = 0; cc < 4; ++cc) mk[cc] = sel[cc * 64 + lane];
#pragma unroll
            for (int ks = 0; ks < 2; ++ks) bq[ks] = *(const bf16x8*)(QA + (size_t)tn * 512 + (cl & 7) * 64 + ks * 32 + q * 8);
        }
        float mx = NINF;
#pragma unroll
        for (int rf = 0; rf < 16; ++rf)
#pragma unroll
            for (int j = 0; j < 4; ++j) {
                const int p = 32 * (rf >> 1) + 8 * q + 4 * (rf & 1) + j;
                if (p >= cnt) s[rf][j] = NINF;
                mx = fmaxf(mx, s[rf][j]);
            }
        mx = rows_max(mx);
        float ls = 0.f;
#pragma unroll
        for (int rf = 0; rf < 16; ++rf)
#pragma unroll
            for (int j = 0; j < 4; ++j) { const float pv = __builtin_amdgcn_exp2f(s[rf][j] - mx); s[rf][j] = pv; ls += pv; }
        ls = rows_sum(ls);
        const float inv = __builtin_amdgcn_rcpf(ls);
        bf16x8 pbs[8];
#pragma unroll
        for (int c8 = 0; c8 < 8; ++c8) pbs[c8] = pack8(s[2 * c8], s[2 * c8 + 1]);
        f32x4 o[4];
#pragma unroll
        for (int d = 0; d < 4; ++d) o[d] = (f32x4){0.f, 0.f, 0.f, 0.f};
#pragma unroll
        for (int cc = 0; cc < 4; ++cc) {
            if (cc < nc64) {
                __builtin_amdgcn_wave_barrier();
#pragma unroll
                for (int i = 0; i < 8; ++i) { const int row = wrow + 8 * i; *(u32x4*)(vl + row * 128 + (((lane & 7) ^ dsa_vswz(row)) << 4)) = vr[i]; }
                __builtin_amdgcn_wave_barrier();
                if (cc + 1 < 4 && cc + 1 < nc64) {
#pragma unroll
                    for (int i = 0; i < 8; ++i) { const int key = __shfl(mkc[(cc + 1) & 3], wrow + 8 * i); vr[i] = *(const u32x4*)(vb + (size_t)key * 64 + (lane & 7) * 8); }
                }
#pragma unroll
                for (int c2 = 0; c2 < 2; ++c2) {
                    const bf16x8 pb = pbs[cc * 2 + c2];
#pragma unroll
                    for (int d = 0; d < 4; ++d) {
                        const int r0 = c2 * 32 + 8 * q + (cl >> 2), r1 = r0 + 4;
                        const int ch = d * 2 + ((cl & 3) >> 1), wb = 8 * (cl & 1);
                        const s16x4 lo4 = __builtin_amdgcn_ds_read_tr16_b64_v4i16((LAS s16x4*)((LAS unsigned char*)(vl) + r0 * 128 + ((ch ^ dsa_vswz(r0)) << 4) + wb));
                        const s16x4 hi4 = __builtin_amdgcn_ds_read_tr16_b64_v4i16((LAS s16x4*)((LAS unsigned char*)(vl) + r1 * 128 + ((ch ^ dsa_vswz(r1)) << 4) + wb));
                        const bf16x8 av = {lo4[0], lo4[1], lo4[2], lo4[3], hi4[0], hi4[1], hi4[2], hi4[3]};
                        o[d] = MFMA16(av, pb, o[d]);
                    }
                }
            }
        }
        if (cl < 8) {
#pragma unroll
            for (int d = 0; d < 4; ++d) {
                u32x2 w; w.x = pk2(o[d][0] * inv, o[d][1] * inv); w.y = pk2(o[d][2] * inv, o[d][3] * inv);
                *(u32x2*)(OA + (size_t)tok * 512 + cl * 64 + d * 16 + q * 4) = w;
            }
        }
    }
}

DEVI int fK(int row) { return (row & 3) | (((row >> 3) & 1) << 2); }

struct AttnState { f32x4 O[4][4]; float m[4]; float l[4]; };

template <int MODE>
DEVI void attn_blocks(rsrc_t rs, unsigned sK, unsigned sV, int ldv, int jb0, int jb1, const bf16x8 (&qf)[4][2], AttnState& st,
                      int tq, unsigned long long selmask, unsigned char* lds, int tid) {
    const int lane = tid & 63, q = lane >> 4, cl = lane & 15;
    const float NINF = -__builtin_inff();
#pragma unroll
    for (int cf = 0; cf < 4; ++cf) { st.m[cf] = NINF; st.l[cf] = 0.f;
#pragma unroll
        for (int d = 0; d < 4; ++d) st.O[d][cf] = (f32x4){0.f, 0.f, 0.f, 0.f}; }
    if (jb1 < jb0) return;
    unsigned kro[2], vro[2]; int kwo[2], vwo[2];
#pragma unroll
    for (int i = 0; i < 2; ++i) {
        const int idx = tid + 256 * i, row = idx >> 3, ch = idx & 7;
        kro[i] = (unsigned)(row * 64 + ch * 8) * 2u; kwo[i] = row * 128 + ((ch ^ fK(row)) << 4);
        vro[i] = (unsigned)(row * ldv + ch * 8) * 2u; vwo[i] = 8192 + row * 128 + ((ch ^ (row & 7)) << 4);
    }
    u32x4 rk[2], rv[2];
#pragma unroll
    for (int i = 0; i < 2; ++i) { rk[i] = bload16(rs, kro[i], sK + (unsigned)jb0 * 8192u); rv[i] = bload16(rs, vro[i], sV + (unsigned)jb0 * 128u); }
#pragma unroll
    for (int i = 0; i < 2; ++i) { *(u32x4*)(lds + kwo[i]) = rk[i]; *(u32x4*)(lds + vwo[i]) = rv[i]; }
    __syncthreads();
    const int nmax = (tq >= 31) ? ((tq - 31) >> 4) : -1;
    for (int jb = jb0; jb <= jb1; ++jb) {
        unsigned char* cur = lds + ((jb - jb0) & 1) * 16384;
        unsigned char* nxt = lds + ((jb - jb0 + 1) & 1) * 16384;
        const bool more = jb < jb1;
        if (more) {
#pragma unroll
            for (int i = 0; i < 2; ++i) { rk[i] = bload16(rs, kro[i], sK + (unsigned)(jb + 1) * 8192u); rv[i] = bload16(rs, vro[i], sV + (unsigned)(jb + 1) * 128u); }
        }
        bool lane_on = true;
        if (MODE == 1) lane_on = ((selmask >> jb) & 1ull) != 0ull;
        if (MODE == 0) lane_on = (jb * 64 <= nmax);
        if (MODE == 2) lane_on = (jb * 64 + 63 > tq - 512);
        if (__ballot(lane_on) != 0ull) {
#pragma unroll
            for (int c = 0; c < 2; ++c) {
                f32x4 S[2][4];
#pragma unroll
                for (int r2 = 0; r2 < 2; ++r2)
#pragma unroll
                    for (int cf = 0; cf < 4; ++cf) S[r2][cf] = (f32x4){0.f, 0.f, 0.f, 0.f};
#pragma unroll
                for (int r2 = 0; r2 < 2; ++r2) {
                    const int kl = 32 * c + 8 * (cl >> 2) + 4 * r2 + (cl & 3);
#pragma unroll
                    for (int ks = 0; ks < 2; ++ks) {
                        const bf16x8 a = *(const bf16x8*)(cur + kl * 128 + (((ks * 4 + q) ^ (cl & 7)) << 4));
#pragma unroll
                        for (int cf = 0; cf < 4; ++cf) S[r2][cf] = MFMA16(a, qf[cf][ks], S[r2][cf]);
                    }
                }
                bool edge;
                if (MODE == 0) edge = (jb * 64 + 63 > nmax);
                else if (MODE == 1) edge = (jb * 64 + 63 > tq) || !lane_on;
                else edge = (jb * 64 + 63 > tq) || (jb * 64 <= tq - 512);
                const bool need_mask = __ballot(edge) != 0ull;
                bf16x8 pb[4];
#pragma unroll
                for (int cf = 0; cf < 4; ++cf) {
                    if (need_mask) {
#pragma unroll
                        for (int r2 = 0; r2 < 2; ++r2)
#pragma unroll
                            for (int j = 0; j < 4; ++j) {
                                const int key = jb * 64 + 32 * c + 8 * q + 4 * r2 + j;
                                bool v;
                                if (MODE == 0) v = key <= nmax;
                                else if (MODE == 1) v = lane_on && key <= tq;
                                else v = key <= tq && key > tq - 512;
                                if (!v) S[r2][cf][j] = NINF;
                            }
                    }
                    float bm = fmaxf(fmaxf(fmaxf(S[0][cf][0], S[0][cf][1]), fmaxf(S[0][cf][2], S[0][cf][3])), fmaxf(fmaxf(S[1][cf][0], S[1][cf][1]), fmaxf(S[1][cf][2], S[1][cf][3])));
                    bm = rows_max(bm);
                    const float mnew = fmaxf(st.m[cf], bm);
                    const float mref = (mnew == NINF) ? 0.f : mnew;
                    const float alpha = __builtin_amdgcn_exp2f(st.m[cf] - mref);
                    st.m[cf] = mnew;
                    float ps = 0.f;
#pragma unroll
                    for (int r2 = 0; r2 < 2; ++r2)
#pragma unroll
                        for (int j = 0; j < 4; ++j) { const float pv = __builtin_amdgcn_exp2f(S[r2][cf][j] - mref); S[r2][cf][j] = pv; ps += pv; }
                    st.l[cf] = st.l[cf] * alpha + ps;
                    if (__ballot(alpha != 1.0f) != 0ull) {
#pragma unroll
                        for (int d = 0; d < 4; ++d) st.O[d][cf] *= alpha;
                    }
                    pb[cf] = pack8(S[0][cf], S[1][cf]);
                }
#pragma unroll
                for (int d = 0; d < 4; ++d) {
                    const int row = d * 16 + cl;
                    const bf16x8 av = *(const bf16x8*)(cur + 8192 + row * 128 + (((c * 4 + q) ^ (row & 7)) << 4));
#pragma unroll
                    for (int cf = 0; cf < 4; ++cf) st.O[d][cf] = MFMA16(av, pb[cf], st.O[d][cf]);
                }
            }
        }
        if (more) {
#pragma unroll
            for (int i = 0; i < 2; ++i) { *(u32x4*)(nxt + kwo[i]) = rk[i]; *(u32x4*)(nxt + vwo[i]) = rv[i]; }
        }
        __syncthreads();
    }
}

DEVI f32x4 bload16f(rsrc_t r, unsigned voff, unsigned soff) { return __builtin_bit_cast(f32x4, __builtin_amdgcn_raw_buffer_load_b128(r, (int)voff, (int)soff, 0)); }
DEVI void bstore16f(rsrc_t r, f32x4 v, unsigned voff, unsigned soff) { __builtin_amdgcn_raw_buffer_store_b128(__builtin_bit_cast(u32x4, v), r, (int)voff, (int)soff, 0); }
DEVI float bload4f(rsrc_t r, unsigned voff, unsigned soff) { return __builtin_bit_cast(float, __builtin_amdgcn_raw_buffer_load_b32(r, (int)voff, (int)soff, 0)); }

struct NsaUnit { int i, b, k, t0, tq; unsigned tokw, tokb, qoff, goff, ooff, sQ, sG, sO; };
DEVI NsaUnit nsa_unit(int uu, int tid) {
    NsaUnit U;
    const int lane = tid & 63, wid = __builtin_amdgcn_readfirstlane(tid >> 6), q = lane >> 4, cl = lane & 15;
    const int half = uu >> 9, r = uu & 511, bk = r & 15, ii = r >> 4;
    U.i = half ? ii : 63 - ii; U.b = bk >> 1; U.k = bk & 1;
    U.t0 = U.i * 64; U.tq = U.t0 + wid * 16 + cl;
    U.tokw = (unsigned)(wid * 16 + cl);
    U.tokb = (unsigned)(U.b * 4096 + U.t0);
    U.qoff = U.tokw * 1024u + (unsigned)q * 16u;
    U.goff = U.tokw * 96u;
    U.ooff = U.tokw * 1024u + (unsigned)q * 8u;
    U.sQ = U.tokb * 1024u + (unsigned)U.k * 512u;
    U.sG = (unsigned)OFF_GATES + U.tokb * 96u + (unsigned)U.k * 16u;
    U.sO = (unsigned)OFF_OB + U.tokb * 1024u + (unsigned)U.k * 512u;
    return U;
}

DEVI void nsa_cmp_unit(const Params& P, rsrc_t rs, int uu, unsigned char* lds, int tid) {
    const int lane = tid & 63, wid = __builtin_amdgcn_readfirstlane(tid >> 6), q = lane >> 4, cl = lane & 15;
    const NsaUnit U = nsa_unit(uu, tid);
    const int i = U.i, b = U.b, k = U.k, tq = U.tq;
    AttnState st;
    bf16x8 qf[4][2];
#pragma unroll
    for (int cf = 0; cf < 4; ++cf)
#pragma unroll
        for (int ks = 0; ks < 2; ++ks) qf[cf][ks] = __builtin_bit_cast(bf16x8, bload16(rs, U.qoff, (unsigned)OFF_QBN + U.sQ + cf * 128 + ks * 64));
    const unsigned sKC = (unsigned)OFF_KC + (unsigned)(b * 2 + k) * 256u * 128u;
    const unsigned sVC = (unsigned)OFF_VCT + (unsigned)(b * 2 + k) * 64u * 512u;
    const int nmax_blk = (U.t0 + 63 - 31) >> 4;
    const int jbc = (nmax_blk >> 6) < 3 ? (nmax_blk >> 6) : 3;
    attn_blocks<0>(rs, sKC, sVC, 256, 0, jbc, qf, st, tq, 0ull, lds, tid);
    float linv[4], mfin[4];
#pragma unroll
    for (int cf = 0; cf < 4; ++cf) {
        const float l = rows_sum(st.l[cf]);
        linv[cf] = (l > 0.f) ? __builtin_amdgcn_rcpf(l) : 0.f; mfin[cf] = st.m[cf];
        const float sc = linv[cf] * bload4f(rs, U.goff, U.sG + cf * 4);
#pragma unroll
        for (int d = 0; d < 4; ++d) { const f32x4 v = st.O[d][cf] * sc; u32x2 w; w.x = pk2(v[0], v[1]); w.y = pk2(v[2], v[3]);
            __builtin_amdgcn_raw_buffer_store_b64(w, rs, (int)U.ooff, (int)(U.sO + cf * 128 + d * 32), 0); }
    }
    unsigned long long* MSKG = (unsigned long long*)(P.ws + OFF_MASK);
    if (i < 16) {
        if (q == 0) MSKG[((size_t)(b * 2 + k)) * 4096 + tq] = (2ull << i) - 1ull;
        return;
    }
    float* SUM4 = (float*)(lds + 16384);
    float* LAST = (float*)(lds + 32768);
    float* IMP2 = (float*)(lds + 49152);
    const int nmax = (tq >= 31) ? ((tq - 31) >> 4) : -1;
    for (int kb = 0; kb <= jbc; ++kb) {
#pragma unroll
        for (int ii = 0; ii < 2; ++ii) {
            const int idx = tid + 256 * ii, row = idx >> 3, ch = idx & 7;
            *(u32x4*)(lds + row * 128 + ((ch ^ fK(row)) << 4)) = bload16(rs, (unsigned)(row * 64 + ch * 8) * 2u, sKC + (unsigned)kb * 8192u);
        }
        __syncthreads();
#pragma unroll
        for (int rf = 0; rf < 4; ++rf) {
            f32x4 S[4];
#pragma unroll
            for (int cf = 0; cf < 4; ++cf) S[cf] = (f32x4){0.f, 0.f, 0.f, 0.f};
            const int kl = 32 * (rf >> 1) + 8 * (cl >> 2) + 4 * (rf & 1) + (cl & 3);
#pragma unroll
            for (int ks = 0; ks < 2; ++ks) {
                const bf16x8 a = *(const bf16x8*)(lds + kl * 128 + (((ks * 4 + q) ^ (cl & 7)) << 4));
#pragma unroll
                for (int cf = 0; cf < 4; ++cf) S[cf] = MFMA16(a, qf[cf][ks], S[cf]);
            }
            float acc4 = 0.f, accl = 0.f;
#pragma unroll
            for (int j = 0; j < 4; ++j) {
                const int key = kb * 64 + 32 * (rf >> 1) + 8 * q + 4 * (rf & 1) + j;
                float pj = 0.f;
#pragma unroll
                for (int cf = 0; cf < 4; ++cf) pj += __builtin_amdgcn_exp2f(S[cf][j] - mfin[cf]) * linv[cf];
                pj = (key <= nmax) ? pj : 0.f;
                acc4 += pj; if (j == 3) accl = pj;
            }
            const int jblk = kb * 16 + 8 * (rf >> 1) + 2 * q + (rf & 1);
            SUM4[(wid * 16 + cl) * 64 + jblk] = acc4; LAST[(wid * 16 + cl) * 64 + jblk] = accl;
        }
        __syncthreads();
    }
    {
        const int qi = tid >> 2, jg = tid & 3;
        const int jlim = (jbc + 1) * 16;
        for (int jj = 0; jj < 16; ++jj) {
            const int j = jg * 16 + jj;
            float v = (j < jlim) ? SUM4[qi * 64 + j] : 0.f;
            if (j >= 1 && j - 1 < jlim) v += LAST[qi * 64 + j - 1];
            IMP2[qi * 64 + j] = v;
        }
    }
    __syncthreads();
    {
        const int qi = tid >> 2, jg = tid & 3;
        const float* row = IMP2 + qi * 64;
        float kk[64];
#pragma unroll
        for (int j4 = 0; j4 < 16; ++j4) {
            const f32x4 v = *(const f32x4*)(row + j4 * 4);
#pragma unroll
            for (int e = 0; e < 4; ++e) {
                const int j2 = j4 * 4 + e;
                const bool f2 = (j2 == 0) || (j2 == i) || (j2 == i - 1);
                kk[j2] = (j2 > i) ? -__builtin_inff() : (f2 ? __builtin_inff() : v[e]);
            }
        }
        unsigned lo = 0u;
#pragma unroll 1
        for (int jj = 0; jj < 16; ++jj) {
            const int j = jg * 16 + jj;
            float kj = -__builtin_inff();
#pragma unroll
            for (int j2 = 0; j2 < 64; ++j2) kj = (j2 == j) ? kk[j2] : kj;
            int rank = 0;
#pragma unroll
            for (int j2 = 0; j2 < 64; ++j2) rank += (kk[j2] > kj || (kk[j2] == kj && j2 < j)) ? 1 : 0;
            if (j <= i && rank < 16) lo |= (1u << jj);
        }
        unsigned long long bits = (unsigned long long)lo << (jg * 16);
        bits |= __shfl_xor(bits, 1); bits |= __shfl_xor(bits, 2);
        if (jg == 0) MSKG[((size_t)(b * 2 + k)) * 4096 + U.t0 + qi] = bits;
    }
    __syncthreads();
}

template <int MODE>
DEVI void nsa_kv_unit(const Params& P, rsrc_t rs, int uu, unsigned char* lds, int tid) {
    const int lane = tid & 63, q = lane >> 4;
    const NsaUnit U = nsa_unit(uu, tid);
    const int i = U.i, b = U.b, k = U.k, tq = U.tq;
    AttnState st;
    bf16x8 qf[4][2];
#pragma unroll
    for (int cf = 0; cf < 4; ++cf)
#pragma unroll
        for (int ks = 0; ks < 2; ++ks) qf[cf][ks] = __builtin_bit_cast(bf16x8, bload16(rs, U.qoff, (unsigned)OFF_QBR + U.sQ + cf * 128 + ks * 64));
    const unsigned sK = (unsigned)(OFF_KV + (MODE == 1 ? 2 : 4) * KV_STRIDE) + (unsigned)(b * 2 + k) * 4096u * 128u;
    const unsigned sV = (unsigned)(OFF_KV + (MODE == 1 ? 3 : 5) * KV_STRIDE) + (unsigned)(b * 2 + k) * 64u * 8192u;
    unsigned long long mymask = 0ull;
    int j0 = 0;
    if (MODE == 1) mymask = ((const unsigned long long*)(P.ws + OFF_MASK))[((size_t)(b * 2 + k)) * 4096 + tq];
    else j0 = (i >= 8) ? i - 8 : 0;
    attn_blocks<MODE>(rs, sK, sV, 4096, j0, i, qf, st, tq, mymask, lds, tid);
#pragma unroll
    for (int cf = 0; cf < 4; ++cf) {
        const float l = rows_sum(st.l[cf]);
        const float sc = ((l > 0.f) ? __builtin_amdgcn_rcpf(l) : 0.f) * bload4f(rs, U.goff, U.sG + (MODE == 1 ? 32 : 64) + cf * 4);
#pragma unroll
        for (int d = 0; d < 4; ++d) {
            const u32x2 pw = __builtin_bit_cast(u32x2, __builtin_amdgcn_raw_buffer_load_b64(rs, (int)U.ooff, (int)(U.sO + cf * 128 + d * 32), 0));
            f32x4 v = st.O[d][cf] * sc;
            v[0] += bf2f(pw.x & 0xffffu); v[1] += bf2f(pw.x >> 16); v[2] += bf2f(pw.y & 0xffffu); v[3] += bf2f(pw.y >> 16);
            u32x2 w; w.x = pk2(v[0], v[1]); w.y = pk2(v[2], v[3]);
            __builtin_amdgcn_raw_buffer_store_b64(w, rs, (int)U.ooff, (int)(U.sO + cf * 128 + d * 32), 0);
        }
    }
}

DEVI void phase_nsa(const Params& P, unsigned char* lds, int tid) {
    const rsrc_t rs = __builtin_amdgcn_make_buffer_rsrc((void*)P.ws, (short)0, (int)0x7fffffff, 0x00020000);
    for (int uu = blockIdx.x; uu < 1024; uu += gridDim.x) { int t = tid; asm volatile("" : "+v"(t)); nsa_cmp_unit(P, rs, uu, lds, t); }
    __syncthreads();
    for (int uu = blockIdx.x; uu < 1024; uu += gridDim.x) { int t = tid; asm volatile("" : "+v"(t)); nsa_kv_unit<1>(P, rs, uu, lds, t); }
    __syncthreads();
    for (int uu = blockIdx.x; uu < 1024; uu += gridDim.x) { int t = tid; asm volatile("" : "+v"(t)); nsa_kv_unit<2>(P, rs, uu, lds, t); }
}

DEVI void phase_merge(const Params& P, unsigned char* lds, int tid) {
    unsigned char* ws = P.ws;
    const rsrc_t rs = __builtin_amdgcn_make_buffer_rsrc((void*)P.ws, (short)0, (int)0x7fffffff, 0x00020000);
    const bf16_t* ga = (const bf16_t*)(ws + OFF_GA);
    const bf16_t* gb = (const bf16_t*)(ws + OFF_GB);
    bf16_t* mg = (bf16_t*)(ws + OFF_MERGED);
    const int lane = tid & 63, wid = __builtin_amdgcn_readfirstlane(tid >> 6), wr = wid >> 1, wc = wid & 1, q = lane >> 4, cl = lane & 15;
    for (int kk = 0;; ++kk) {
        int mt, nt;
        if (!tile_map(kk, 8, mt, nt)) break;
        f32x4 acc[4][4];
        unsigned t[4][4][2];
        gemm128(acc, rs, (unsigned)(OFF_OA + (size_t)mt * 128 * 1024), RowLin{1024}, (unsigned)(OFF_WBRA + (size_t)nt * 128 * 1024), RowLin{1024}, 8, lds, tid);
        const size_t e0 = (size_t)(mt * 128 + wr * 64 + cl) * 1024 + nt * 128 + wc * 64 + q * 4;
#pragma unroll
        for (int m = 0; m < 4; ++m)
#pragma unroll
            for (int n = 0; n < 4; ++n) {
                const u32x2 gv = *(const u32x2*)(ga + e0 + (size_t)m * 16 * 1024 + n * 16);
                t[m][n][0] = pk2(acc[m][n][0] * bf2f(gv.x & 0xffffu), acc[m][n][1] * bf2f(gv.x >> 16));
                t[m][n][1] = pk2(acc[m][n][2] * bf2f(gv.y & 0xffffu), acc[m][n][3] * bf2f(gv.y >> 16));
            }
        gemm128(acc, rs, (unsigned)(OFF_OB + (size_t)mt * 128 * 1024), RowLin{1024}, (unsigned)(OFF_WBRB + (size_t)nt * 128 * 1024), RowLin{1024}, 8, lds, tid);
#pragma unroll
        for (int m = 0; m < 4; ++m)
#pragma unroll
            for (int n = 0; n < 4; ++n) {
                const size_t o = e0 + (size_t)m * 16 * 1024 + n * 16;
                const u32x2 gv = *(const u32x2*)(gb + o);
                u32x2 w;
                w.x = pk2(bf2f(t[m][n][0] & 0xffffu) + acc[m][n][0] * bf2f(gv.x & 0xffffu), bf2f(t[m][n][0] >> 16) + acc[m][n][1] * bf2f(gv.x >> 16));
                w.y = pk2(bf2f(t[m][n][1] & 0xffffu) + acc[m][n][2] * bf2f(gv.y & 0xffffu), bf2f(t[m][n][1] >> 16) + acc[m][n][3] * bf2f(gv.y >> 16));
                *(u32x2*)(mg + o) = w;
            }
    }
}

DEVI void phase_outproj(const Params& P, unsigned char* lds, int tid) {
    unsigned char* ws = P.ws;
    const rsrc_t rs = __builtin_amdgcn_make_buffer_rsrc((void*)P.ws, (short)0, (int)0x7fffffff, 0x00020000);
    const bf16_t* mg = (const bf16_t*)(ws + OFF_MERGED);
    const bf16_t* wo = (const bf16_t*)(ws + OFF_WOUT);
    const float* x = P.in[0];
    float* x1 = P.out;
    const int lane = tid & 63, wid = __builtin_amdgcn_readfirstlane(tid >> 6), wr = wid >> 1, wc = wid & 1, q = lane >> 4, cl = lane & 15;
    for (int kk = 0;; ++kk) {
        int mt, nt;
        if (!tile_map(kk, 8, mt, nt)) break;
        f32x4 acc[4][4];
        gemm128(acc, rs, (unsigned)(OFF_MERGED + (size_t)mt * 128 * 2048), RowLin{2048}, (unsigned)(OFF_WOUT + (size_t)nt * 128 * 2048), RowLin{2048}, 16, lds, tid);
#pragma unroll
        for (int m = 0; m < 4; ++m)
#pragma unroll
            for (int n = 0; n < 4; ++n) {
                const size_t o = (size_t)(mt * 128 + wr * 64 + m * 16 + cl) * 1024 + nt * 128 + wc * 64 + n * 16 + q * 4;
                *(f32x4*)(x1 + o) = *(const f32x4*)(x + o) + acc[m][n];
            }
    }
}

DEVI void phase_router(const Params& P, unsigned char* lds, int tid) {
    unsigned char* ws = P.ws;
    const int lane = tid & 63, wid = __builtin_amdgcn_readfirstlane(tid >> 6), q = lane >> 4, cl = lane & 15;
    const float* x1 = P.out; const float* g = P.in[13];
    const float* bg = P.in[15]; const float* be = P.in[17];
    const float* WR = (const float*)(ws + OFF_WR);
    bf16_t* h2 = (bf16_t*)(ws + OFF_HN);
    unsigned* cnt = (unsigned*)(ws + OFF_CTL);
    int* list = (int*)(ws + OFF_LIST);
    float* wt = (float*)(ws + OFF_WT);
    float* WL = (float*)lds;
    float* LG = (float*)(lds + 50688);
    float* RS = (float*)(lds + 50688 + 12288);
    for (int u = blockIdx.x; u < NTOK / 64; u += gridDim.x) {
        const int row0 = u * 64 + wid * 16;
        const float* xa = x1 + (size_t)(row0 + cl) * 1024 + 4 * q;
        f32x4 acc[3];
#pragma unroll
        for (int ct = 0; ct < 3; ++ct) acc[ct] = (f32x4){0.f, 0.f, 0.f, 0.f};
        float ss = 0.f;
        for (int kc = 0; kc < 4; ++kc) {
            __syncthreads();
#pragma unroll
            for (int i = 0; i < 12; ++i) {
                const int idx = tid + 256 * i, r = idx >> 6, c4 = idx & 63;
                *(f32x4*)(WL + r * 264 + c4 * 4) = *(const f32x4*)(WR + (size_t)r * 1024 + kc * 256 + c4 * 4);
            }
            __syncthreads();
#pragma unroll
            for (int jh = 0; jh < 2; ++jh) {
                f32x4 av[8];
#pragma unroll
                for (int j = 0; j < 8; ++j) av[j] = *(const f32x4*)(xa + kc * 256 + (jh * 8 + j) * 16);
#pragma unroll
                for (int j = 0; j < 8; ++j) {
                    {
                        const int kx = kc * 256 + (jh * 8 + j) * 16 + 4 * q;
                        const f32x4 gg = *(const f32x4*)(g + kx);
                        u32x2 w; w.x = pk2(av[j][0] * gg[0], av[j][1] * gg[1]); w.y = pk2(av[j][2] * gg[2], av[j][3] * gg[3]);
                        *(u32x2*)(h2 + (size_t)(row0 + cl) * 1024 + kx) = w;
                    }
                    ss += av[j][0] * av[j][0] + av[j][1] * av[j][1] + av[j][2] * av[j][2] + av[j][3] * av[j][3];
#pragma unroll
                    for (int ct = 0; ct < 3; ++ct) {
                        const f32x4 bv = *(const f32x4*)(WL + (ct * 16 + cl) * 264 + (jh * 8 + j) * 16 + 4 * q);
#pragma unroll
                        for (int e = 0; e < 4; ++e) acc[ct] = __builtin_amdgcn_mfma_f32_16x16x4f32(av[j][e], bv[e], acc[ct], 0, 0, 0);
                    }
                }
            }
        }
        ss += __shfl_xor(ss, 16); ss += __shfl_xor(ss, 32);
        const float rs = rsqrtf(ss * (1.0f / 1024.0f) + RMS_EPS);
        if (q == 0) { RS[wid * 16 + cl] = rs; ((float*)(ws + OFF_RS))[row0 + cl] = rs; }
        __syncthreads();
#pragma unroll
        for (int j = 0; j < 4; ++j) {
            const float rj = RS[wid * 16 + 4 * q + j];
#pragma unroll
            for (int ct = 0; ct < 3; ++ct) LG[(wid * 16 + 4 * q + j) * 48 + ct * 16 + cl] = acc[ct][j] * rj;
        }
        __syncthreads();
        if (tid < 64) {
            const int r = u * 64 + tid;
            const float* lg = LG + tid * 48;
            float gl[4];
#pragma unroll
            for (int e = 0; e < 4; ++e) gl[e] = lg[e] + bg[e];
            int gs = 0; float gm = gl[0];
#pragma unroll
            for (int e = 1; e < 4; ++e) if (gl[e] > gm) { gm = gl[e]; gs = e; }
            float den = 0.f;
#pragma unroll
            for (int e = 0; e < 4; ++e) den += __expf(gl[e] - gm);
            const float gp = 1.0f / den;
            float el[8];
#pragma unroll
            for (int e = 0; e < 8; ++e) el[e] = lg[4 + gs * 8 + e] + be[gs * 8 + e];
            int i0 = 0; float v0 = el[0];
#pragma unroll
            for (int e = 1; e < 8; ++e) if (el[e] > v0) { v0 = el[e]; i0 = e; }
            int i1 = -1; float v1 = -__builtin_inff();
#pragma unroll
            for (int e = 0; e < 8; ++e) if (e != i0 && el[e] > v1) { v1 = el[e]; i1 = e; }
            const float e1 = __expf(v1 - v0);
            const float w0 = gp / (1.0f + e1), w1 = gp * e1 / (1.0f + e1);
            const int ex0 = gs * 8 + i0, ex1 = gs * 8 + i1;
            const unsigned p0 = atomicAdd(&cnt[ex0], 1u);
            list[(size_t)ex0 * NTOK + p0] = r * 2 + 0;
            const unsigned p1 = atomicAdd(&cnt[ex1], 1u);
            list[(size_t)ex1 * NTOK + p1] = r * 2 + 1;
            wt[(size_t)r * 2 + 0] = w0; wt[(size_t)r * 2 + 1] = w1;
        }
    }
}

struct RowGather { const int* idx; DEVI unsigned operator()(int r) const { return (unsigned)idx[r] * 2048u; } };
struct RowGU { int c0; DEVI unsigned operator()(int r) const {
    const int wcx = r >> 6, w = r & 63; const int col = (w < 32) ? (c0 + wcx * 32 + w) : (256 + c0 + wcx * 32 + (w - 32)); return (unsigned)col * 2048u; } };

DEVI int moe_find_tile(const unsigned* cnt, int u, int& e, int& tl) {
    int t = u, ee = 0, ce = 0;
    for (; ee < 32; ++ee) { ce = (int)cnt[ee]; const int nt = (ce + 127) >> 7; if (t < nt) break; t -= nt; }
    e = ee; tl = t; return ce;
}
DEVI void phase_moe_a(const Params& P, unsigned char* lds, int tid) {
    unsigned char* ws = P.ws;
    const rsrc_t rs = __builtin_amdgcn_make_buffer_rsrc((void*)P.ws, (short)0, (int)0x7fffffff, 0x00020000);
    const int lane = tid & 63, wid = __builtin_amdgcn_readfirstlane(tid >> 6), wr = wid >> 1, wc = wid & 1, q = lane >> 4, cl = lane & 15;
    const unsigned* cnt = (const unsigned*)(ws + OFF_CTL);
    const int* list = (const int*)(ws + OFF_LIST);
    bf16_t* act = (bf16_t*)(ws + OFF_ACT);
    int* rowtok = (int*)(lds + 65536);
    const float* RSG = (const float*)(ws + OFF_RS);
    int total = 0;
    for (int e = 0; e < 32; ++e) total += ((int)cnt[e] + 127) >> 7;
    for (int v = blockIdx.x; v < total * 4; v += gridDim.x) {
        const int u = v >> 2, nt = v & 3;
        int e, tl; const int ce = moe_find_tile(cnt, u, e, tl);
        if (tid < 128) { const int r = tl * 128 + tid; rowtok[tid] = (r < ce) ? (list[(size_t)e * NTOK + r] >> 1) : 0; }
        __syncthreads();
        bf16_t* au = act + (size_t)u * 128 * 256;
        f32x4 acc[4][4];
        gemm128(acc, rs, (unsigned)OFF_HN, RowGather{rowtok}, (unsigned)(OFF_WGU + (size_t)e * 512 * 2048), RowGU{nt * 64}, 16, lds, tid);
#pragma unroll
        for (int m = 0; m < 4; ++m)
#pragma unroll
            for (int n = 0; n < 2; ++n) {
                const int row = wr * 64 + m * 16 + cl, col = nt * 64 + wc * 32 + n * 16 + q * 4;
                const float rsv = RSG[rowtok[row]];
                const f32x4 gt = acc[m][n] * rsv, up = acc[m][n + 2] * rsv;
                u32x2 w;
                w.x = pk2(siluf_(gt[0]) * up[0], siluf_(gt[1]) * up[1]);
                w.y = pk2(siluf_(gt[2]) * up[2], siluf_(gt[3]) * up[3]);
                *(u32x2*)(au + (size_t)row * 256 + col) = w;
            }
        __syncthreads();
    }
}
DEVI void phase_moe_b(const Params& P, unsigned char* lds, int tid) {
    unsigned char* ws = P.ws;
    const rsrc_t rs = __builtin_amdgcn_make_buffer_rsrc((void*)P.ws, (short)0, (int)0x7fffffff, 0x00020000);
    const int lane = tid & 63, wid = __builtin_amdgcn_readfirstlane(tid >> 6), wr = wid >> 1, wc = wid & 1, q = lane >> 4, cl = lane & 15;
    const unsigned* cnt = (const unsigned*)(ws + OFF_CTL);
    const int* list = (const int*)(ws + OFF_LIST);
    bf16_t* Y = (bf16_t*)(ws + OFF_Y);
    int* rowas = (int*)(lds + 65536);
    int total = 0;
    for (int e = 0; e < 32; ++e) total += ((int)cnt[e] + 127) >> 7;
    for (int v = blockIdx.x; v < total * 4; v += gridDim.x) {
        const int u = v >> 2, np = v & 3;
        int e, tl; const int ce = moe_find_tile(cnt, u, e, tl);
        if (tid < 128) { const int r = tl * 128 + tid; rowas[tid] = (r < ce) ? list[(size_t)e * NTOK + r] : -1; }
        __syncthreads();
        for (int h = 0; h < 2; ++h) {
            const int nt = np * 2 + h;
            f32x4 acc[4][4];
            gemm128(acc, rs, (unsigned)(OFF_ACT + (size_t)u * 128 * 512), RowLin{512}, (unsigned)(OFF_WDN + (size_t)e * 1024 * 512 + (size_t)nt * 128 * 512), RowLin{512}, 4, lds, tid);
#pragma unroll
            for (int m = 0; m < 4; ++m) {
                const int row = wr * 64 + m * 16 + cl;
                const int as = rowas[row];
                if (as >= 0) {
                    bf16_t* yr = Y + ((size_t)(as & 1) * NTOK + (as >> 1)) * 1024 + nt * 128 + wc * 64 + q * 4;
#pragma unroll
                    for (int n = 0; n < 4; ++n) { u32x2 w; w.x = pk2(acc[m][n][0], acc[m][n][1]); w.y = pk2(acc[m][n][2], acc[m][n][3]); *(u32x2*)(yr + n * 16) = w; }
                }
            }
        }
        __syncthreads();
    }
}

DEVI void phase_final(const Params& P, int tid, bool with_moe) {
    unsigned char* ws = P.ws;
    const int lane = tid & 63, wid = __builtin_amdgcn_readfirstlane(tid >> 6);
    const bf16_t* Y = (const bf16_t*)(ws + OFF_Y);
    const float* wt = (const float*)(ws + OFF_WT);
    const float* g = P.in[20];
    float* out = P.out;
    for (int r = blockIdx.x * 4 + wid; r < NTOK; r += gridDim.x * 4) {
        float* xr = out + (size_t)r * 1024;
        const float w0 = with_moe ? wt[(size_t)r * 2] : 0.f, w1 = with_moe ? wt[(size_t)r * 2 + 1] : 0.f;
        f32x4 v[4]; float ss = 0.f;
#pragma unroll
        for (int i = 0; i < 4; ++i) {
            v[i] = *(const f32x4*)(xr + i * 256 + lane * 4);
            if (with_moe) {
                const u32x2 a = *(const u32x2*)(Y + (size_t)r * 1024 + i * 256 + lane * 4);
                const u32x2 b = *(const u32x2*)(Y + ((size_t)NTOK + r) * 1024 + i * 256 + lane * 4);
                v[i][0] += w0 * bf2f(a.x & 0xffffu) + w1 * bf2f(b.x & 0xffffu); v[i][1] += w0 * bf2f(a.x >> 16) + w1 * bf2f(b.x >> 16);
                v[i][2] += w0 * bf2f(a.y & 0xffffu) + w1 * bf2f(b.y & 0xffffu); v[i][3] += w0 * bf2f(a.y >> 16) + w1 * bf2f(b.y >> 16);
            }
            ss += v[i][0] * v[i][0] + v[i][1] * v[i][1] + v[i][2] * v[i][2] + v[i][3] * v[i][3];
        }
        ss = wave_sum(ss);
        const float rs = rsqrtf(ss * (1.0f / 1024.0f) + RMS_EPS);
#pragma unroll
        for (int i = 0; i < 4; ++i) {
            const f32x4 gg = *(const f32x4*)(g + i * 256 + lane * 4);
            f32x4 o; o[0] = v[i][0] * rs * gg[0]; o[1] = v[i][1] * rs * gg[1]; o[2] = v[i][2] * rs * gg[2]; o[3] = v[i][3] * rs * gg[3];
            *(f32x4*)(xr + i * 256 + lane * 4) = o;
        }
    }
}

#define LAUNDER_TID() do { tid = wave_id * 64 + (int)__builtin_amdgcn_mbcnt_hi(~0u, __builtin_amdgcn_mbcnt_lo(~0u, 0u)); asm volatile("" : "+v"(tid)); } while (0)
__global__ void __launch_bounds__(NTHREADS, 2) fwd_megakernel(Params P) {
    extern __shared__ __attribute__((aligned(16))) unsigned char lds[];
    cg::grid_group grid = cg::this_grid();
    int tid;
    const int wave_id = __builtin_amdgcn_readfirstlane((int)(threadIdx.x >> 6));
    volatile LAS unsigned* bst = (volatile LAS unsigned*)(LAS unsigned char*)(lds + LDS_BYTES - 16);
    if (threadIdx.x < 4) bst[threadIdx.x] = 0u;
    __syncthreads();
    (void)xcd_barrier_post((unsigned*)(P.ws + OFF_BAR), bst);
#define GRID_BARRIER() do { XcdBarrier b_; b_.bar = (unsigned*)(P.ws + OFF_BAR); b_.x = xb_xcc_id(); b_.st = (volatile LAS unsigned*)(LAS unsigned char*)(lds + LDS_BYTES - 16); xcd_barrier(b_); } while (0)
    if (P.ph_lo != 0) grid.sync();
    LAUNDER_TID(); phase_prep(P, lds, tid, 0); __syncthreads();
    GRID_BARRIER();
    {
        const int first_idx = (blockIdx.x >> 8) & 1;
        for (int step = 0; step < 3; ++step) {
            const int what = (step == 0) ? 0 : 1 + ((step - 1) ^ first_idx);
            if (what <= 1) { LAUNDER_TID(); phase_gemm1(P, lds, tid, what); }
            else {
                LAUNDER_TID(); phase_prep(P, lds, tid, 1); __syncthreads();
                LAUNDER_TID(); phase_compress(P, lds, tid); __syncthreads();
                LAUNDER_TID(); phase_index(P, lds, tid);
            }
            __syncthreads();
            if (step == 0) GRID_BARRIER();
        }
    }
    GRID_BARRIER();
    if (((blockIdx.x >> 8) & 1) == 0) { LAUNDER_TID(); phase_dsa(P, lds, tid); __syncthreads(); }
    LAUNDER_TID(); phase_nsa(P, lds, tid); __syncthreads();
    if (((blockIdx.x >> 8) & 1) != 0) { LAUNDER_TID(); phase_dsa(P, lds, tid); __syncthreads(); }
    GRID_BARRIER();
    LAUNDER_TID(); phase_merge(P, lds, tid);
    GRID_BARRIER();
    LAUNDER_TID(); phase_outproj(P, lds, tid);
    GRID_BARRIER();
    LAUNDER_TID(); phase_router(P, lds, tid);
    GRID_BARRIER();
    LAUNDER_TID(); phase_moe_a(P, lds, tid);
    GRID_BARRIER();
    LAUNDER_TID(); phase_moe_b(P, lds, tid);
    GRID_BARRIER();
    LAUNDER_TID(); phase_final(P, tid, true);
}

extern "C" void kernel_launch(void* const* d_in, const int* in_sizes, int n_in, void* d_out, int out_size, void* d_ws, size_t ws_size,
                              hipStream_t stream) {
    static int grid_blocks = 0;
    if (!grid_blocks) {
        int dev = 0, cus = 0, per_cu = 0;
        hipGetDevice(&dev);
        hipDeviceGetAttribute(&cus, hipDeviceAttributeMultiprocessorCount, dev);
        hipFuncSetAttribute((const void*)fwd_megakernel, hipFuncAttributeMaxDynamicSharedMemorySize, LDS_BYTES);
        hipOccupancyMaxActiveBlocksPerMultiprocessor(&per_cu, (const void*)fwd_megakernel, NTHREADS, LDS_BYTES);
        if (per_cu < 1) per_cu = 1;
        if (per_cu > 2) per_cu = 2;
        grid_blocks = cus * per_cu;
        if (ws_size < WS_END) fprintf(stderr, "kernel_launch: workspace too small: %zu < %zu\n", ws_size, (size_t)WS_END);
    }
    Params p{};
    for (int i = 0; i < 21; ++i) p.in[i] = (const float*)d_in[i];
    p.pos = (const int*)d_in[1];
    p.out = (float*)d_out;
    p.ws = (unsigned char*)d_ws;
    for (int i = 0; i < 32; ++i) p.inv_freq[i] = (double)powf(10000.0f, -(float)i / 32.0f);
    p.ph_lo = 0; p.ph_hi = 0;
    (void)hipMemsetAsync(d_ws, 0, OFF_WIN_T, stream);
    void* args[] = {&p};
    hipError_t e = hipLaunchCooperativeKernel((const void*)fwd_megakernel, dim3(grid_blocks), dim3(NTHREADS), args, LDS_BYTES, stream);
    if (e != hipSuccess) fprintf(stderr, "cooperative launch failed: %s (grid %d)\n", hipGetErrorString(e), grid_blocks);
}
```

```cpp
#include <hip/hip_runtime.h>
#include <hip/hip_cooperative_groups.h>
#include <cstdint>
#include <cstdio>
#include <cmath>
namespace cg = cooperative_groups;

#define DEVI __device__ __forceinline__
#ifndef PROBE_TWICE
#define PROBE_TWICE 0
#endif
#define REPS(k) ((PROBE_TWICE == (k)) ? 2 : 1)
typedef unsigned short bf16_t;
typedef short bf16x8 __attribute__((ext_vector_type(8)));
typedef short s16x4 __attribute__((ext_vector_type(4)));
typedef float f32x4 __attribute__((ext_vector_type(4)));
typedef float f32x2 __attribute__((ext_vector_type(2)));
typedef unsigned u32x4 __attribute__((ext_vector_type(4)));
typedef unsigned u32x2 __attribute__((ext_vector_type(2)));
#define LAS __attribute__((address_space(3)))

constexpr int NB = 8, SL = 4096, DM = 1024, NTOK = NB * SL;
constexpr int INW = 4288;
constexpr int NTHREADS = 256;
constexpr int LDS_BYTES = 81920;
constexpr float RMS_EPS = 1e-6f;
constexpr float LOG2E = 1.4426950408889634f;

constexpr int WIN_ROWS = 4352;
constexpr int G1_COLS = 4352;

constexpr size_t al256(size_t x) { return (x + 255) & ~(size_t)255; }
constexpr size_t OFF_CTL   = 0;
constexpr size_t OFF_BAR   = 4096;
constexpr size_t OFF_WIN_T = 32768;
constexpr size_t OFF_WBRA  = OFF_WIN_T + (size_t)WIN_ROWS * 1024 * 2;
constexpr size_t OFF_WBRB  = OFF_WBRA + (size_t)1024 * 512 * 2;
constexpr size_t OFF_WOUT  = OFF_WBRB + (size_t)1024 * 512 * 2;
constexpr size_t OFF_W1K   = OFF_WOUT + (size_t)1024 * 1024 * 2;
constexpr size_t OFF_W1V   = OFF_W1K + (size_t)128 * 2048 * 2;
constexpr size_t OFF_W2K   = OFF_W1V + (size_t)128 * 2048 * 2;
constexpr size_t OFF_W2V   = OFF_W2K + (size_t)64 * 128 * 2;
constexpr size_t OFF_WGU   = OFF_W2V + (size_t)64 * 128 * 2;
constexpr size_t OFF_WDN   = OFF_WGU + (size_t)32 * 512 * 1024 * 2;
constexpr size_t OFF_BIAS1 = OFF_WDN + (size_t)32 * 1024 * 256 * 2;
constexpr size_t OFF_WR    = OFF_BIAS1 + 1024;
constexpr size_t OFF_CS    = OFF_WR + (size_t)48 * 1024 * 4;
constexpr size_t OFF_HN    = OFF_CS + (size_t)NTOK * 32 * 8;
constexpr size_t OFF_QA    = OFF_HN + (size_t)NTOK * 1024 * 2;
constexpr size_t OFF_KA    = OFF_QA + (size_t)NTOK * 512 * 2;
constexpr size_t OFF_VA    = OFF_KA + (size_t)NTOK * 64 * 2;
constexpr size_t OFF_QI    = OFF_VA + (size_t)NTOK * 64 * 2;
constexpr size_t OFF_KI    = OFF_QI + (size_t)NTOK * 256 * 2;
constexpr size_t OFF_WI    = OFF_KI + (size_t)NTOK * 32 * 2;
constexpr size_t OFF_QBN   = OFF_WI + (size_t)NTOK * 8 * 4;
constexpr size_t OFF_QBR   = OFF_QBN + (size_t)NTOK * 512 * 2;
constexpr size_t KV_STRIDE = (size_t)NTOK * 128 * 2 + 65536 * 4;
constexpr size_t OFF_KV    = OFF_QBR + (size_t)NTOK * 512 * 2;
constexpr size_t OFF_GATES = OFF_KV + 6 * KV_STRIDE;
constexpr size_t OFF_QKV_END = OFF_GATES + (size_t)NTOK * 24 * 4;
constexpr size_t OFF_KC    = al256(OFF_QKV_END);
constexpr size_t OFF_VCT   = OFF_KC + (size_t)16 * 256 * 64 * 2;
constexpr size_t OFF_SEL   = OFF_VCT + (size_t)16 * 256 * 64 * 2;
constexpr size_t OFF_OA    = OFF_HN;
constexpr size_t OFF_OB    = OFF_OA + (size_t)NTOK * 512 * 2;
constexpr size_t OFF_GA    = OFF_SEL + (size_t)NTOK * 256 * 2;
constexpr size_t OFF_GB    = OFF_GA + (size_t)NTOK * 1024 * 2;
constexpr size_t OFF_MASK  = OFF_GB + (size_t)NTOK * 1024 * 2;
constexpr size_t OFF_LIST  = OFF_MASK + (size_t)16 * 4096 * 8;
constexpr size_t OFF_WT    = OFF_LIST + (size_t)32 * NTOK * 4;
constexpr size_t OFF_RS    = OFF_WT + (size_t)NTOK * 2 * 4;
constexpr size_t WS_END    = OFF_RS + (size_t)NTOK * 4;
constexpr size_t OFF_MERGED = OFF_QA;
constexpr size_t OFF_ACT    = OFF_QA;
constexpr size_t OFF_Y      = OFF_QA + (size_t)40 * 1024 * 1024;
static_assert(OFF_Y + (size_t)2 * NTOK * 1024 * 2 <= OFF_QKV_END, "Y overlay");
static_assert((size_t)544 * 128 * 256 * 2 <= (size_t)40 * 1024 * 1024, "ACT overlay");

struct Params {
    const float* in[21];
    const int* pos;
    float* out;
    unsigned char* ws;
    double inv_freq[32];
    int ph_lo, ph_hi;
};

DEVI unsigned f2bf(float f) { unsigned u = __float_as_uint(f); return (u + 0x7fffu + ((u >> 16) & 1u)) >> 16; }
typedef __bf16 bf16v2_t __attribute__((ext_vector_type(2)));
DEVI unsigned pk2(float lo, float hi) { const f32x2 v = {lo, hi}; return __builtin_bit_cast(unsigned, __builtin_convertvector(v, bf16v2_t)); }
DEVI float rows_max(float x) {
    float a = x, b = x;
    asm volatile("v_nop\n\tv_nop\n\tv_permlane16_swap_b32 %0, %1" : "+v"(a), "+v"(b));
    x = fmaxf(a, b); a = x; b = x;
    asm volatile("v_nop\n\tv_nop\n\tv_permlane32_swap_b32 %0, %1" : "+v"(a), "+v"(b));
    return fmaxf(a, b);
}
DEVI float rows_sum(float x) {
    float a = x, b = x;
    asm volatile("v_nop\n\tv_nop\n\tv_permlane16_swap_b32 %0, %1" : "+v"(a), "+v"(b));
    x = a + b; a = x; b = x;
    asm volatile("v_nop\n\tv_nop\n\tv_permlane32_swap_b32 %0, %1" : "+v"(a), "+v"(b));
    return a + b;
}
DEVI float bf2f(unsigned h) { return __uint_as_float(h << 16); }
DEVI float sigmoidf_(float x) { return __builtin_amdgcn_rcpf(1.0f + __builtin_amdgcn_exp2f(-x * 1.4426950408889634f)); }
DEVI float wave_sum(float v) {
#pragma unroll
    for (int o = 32; o > 0; o >>= 1) v += __shfl_xor(v, o);
    return v;
}
DEVI int wave_sum_i32(int v) {
    v += __builtin_amdgcn_update_dpp(0, v, 0xB1, 0xF, 0xF, true);
    v += __builtin_amdgcn_update_dpp(0, v, 0x4E, 0xF, 0xF, true);
    v += __builtin_amdgcn_update_dpp(0, v, 0x141, 0xF, 0xF, true);
    v += __builtin_amdgcn_update_dpp(0, v, 0x140, 0xF, 0xF, true);
    return __builtin_amdgcn_readlane(v, 0) + __builtin_amdgcn_readlane(v, 16) + __builtin_amdgcn_readlane(v, 32) + __builtin_amdgcn_readlane(v, 48);
}
DEVI float wave_sum_f32_dpp(float v) {
    v += __builtin_bit_cast(float, __builtin_amdgcn_update_dpp(0, __builtin_bit_cast(int, v), 0xB1, 0xF, 0xF, true));
    v += __builtin_bit_cast(float, __builtin_amdgcn_update_dpp(0, __builtin_bit_cast(int, v), 0x4E, 0xF, 0xF, true));
    v += __builtin_bit_cast(float, __builtin_amdgcn_update_dpp(0, __builtin_bit_cast(int, v), 0x141, 0xF, 0xF, true));
    v += __builtin_bit_cast(float, __builtin_amdgcn_update_dpp(0, __builtin_bit_cast(int, v), 0x140, 0xF, 0xF, true));
    const int iv = __builtin_bit_cast(int, v);
    return (__builtin_bit_cast(float, __builtin_amdgcn_readlane(iv, 0)) + __builtin_bit_cast(float, __builtin_amdgcn_readlane(iv, 16))) +
           (__builtin_bit_cast(float, __builtin_amdgcn_readlane(iv, 32)) + __builtin_bit_cast(float, __builtin_amdgcn_readlane(iv, 48)));
}
DEVI bf16x8 pack8(const f32x4& a, const f32x4& b) {
    u32x4 w; w.x = pk2(a[0], a[1]); w.y = pk2(a[2], a[3]); w.z = pk2(b[0], b[1]); w.w = pk2(b[2], b[3]);
    return __builtin_bit_cast(bf16x8, w);
}
#define MFMA16(a, b, c) __builtin_amdgcn_mfma_f32_16x16x32_bf16((a), (b), (c), 0, 0, 0)


#define XB_TMO      128
#define XB_XCNT(j)  (256  + 64 * (j))
#define XB_XSUB(j)  (1280 + 64 * (j))
#define XB_XGEN(j)  (2304 + 64 * (j))
#define XB_TOP      3328
#define XB_TOPGEN   3392
#define XCD_BAR_WORDS 3456
#define XB_SPIN_CAP (1u << 22)
DEVI unsigned xb_ld(unsigned* p)              { return __hip_atomic_load(p, __ATOMIC_RELAXED, __HIP_MEMORY_SCOPE_AGENT); }
DEVI unsigned xb_add(unsigned* p, unsigned v) { return __hip_atomic_fetch_add(p, v, __ATOMIC_RELAXED, __HIP_MEMORY_SCOPE_AGENT); }
DEVI unsigned xb_xcc_id() { return (unsigned)__builtin_amdgcn_s_getreg((3 << 11) | 20) & 0xFu; }
#define XB_SPIN(cond, bar) do { unsigned _sp = 0; while (cond) { __builtin_amdgcn_s_sleep(1); \
    if ((++_sp & 255u) == 0u) { if (xb_ld(&(bar)[XB_TMO])) break; if (_sp > XB_SPIN_CAP) { atomicAdd(&(bar)[XB_TMO], 1u); break; } } } } while (0)
struct XcdBarrier { unsigned* bar; unsigned x; volatile LAS unsigned* st; };
DEVI XcdBarrier xcd_barrier_post(unsigned* bar, volatile LAS unsigned* st) {
    XcdBarrier b; b.bar = bar; b.x = xb_xcc_id(); b.st = st;
    if (threadIdx.x == 0) (void)xb_add(&bar[XB_XCNT(b.x)], 1u);
    return b;
}
DEVI void xcd_barrier_complete(unsigned* bar, unsigned x, unsigned& nloc, unsigned& nx) {
    const unsigned G = gridDim.x * gridDim.y * gridDim.z;
    unsigned sum, cnt, mine, sp = 0u;
    for (;;) {
        sum = 0u; cnt = 0u; mine = 0u;
#pragma unroll
        for (unsigned j = 0; j < 16; ++j) { const unsigned c = xb_ld(&bar[XB_XCNT(j)]); sum += c; cnt += (c > 0u) ? 1u : 0u; mine = (j == x) ? c : mine; }
        if (sum == G) break;
        __builtin_amdgcn_s_sleep(1);
        if ((++sp & 255u) == 0u) { if (xb_ld(&bar[XB_TMO])) break; if (sp > XB_SPIN_CAP) { atomicAdd(&bar[XB_TMO], 1u); break; } }
    }
    nloc = mine > 0u ? mine : 1u; nx = cnt > 0u ? cnt : 1u;
}
DEVI void xcd_barrier(const XcdBarrier& b) {
    asm volatile("s_waitcnt vmcnt(0)" ::: "memory");
    __syncthreads();
    if (threadIdx.x == 0) {
        unsigned* bar = b.bar;
        __builtin_amdgcn_s_waitcnt(0);
        unsigned nloc = b.st[0], nx = b.st[1];
        if (nloc == 0u) { xcd_barrier_complete(bar, b.x, nloc, nx); b.st[0] = nloc; b.st[1] = nx; }
        const unsigned old = xb_add(&bar[XB_XSUB(b.x)], 1u);
        const unsigned gen = old / nloc;
        if (old + 1u == (gen + 1u) * nloc) {
            __builtin_amdgcn_fence(__ATOMIC_RELEASE, "agent");
            asm volatile("s_waitcnt vmcnt(0)" ::: "memory");
            const unsigned og = xb_add(&bar[XB_TOP], 1u);
            const unsigned tg = og / nx;
            if (og + 1u == (tg + 1u) * nx) xb_add(&bar[XB_TOPGEN], 1u);
            else XB_SPIN(xb_ld(&bar[XB_TOPGEN]) == tg, bar);
            __builtin_amdgcn_fence(__ATOMIC_ACQUIRE, "agent");
            xb_add(&bar[XB_XGEN(b.x)], 1u);
            asm volatile("s_waitcnt vmcnt(0)" ::: "memory");
        } else {
            XB_SPIN(xb_ld(&bar[XB_XGEN(b.x)]) == gen, bar);
            __builtin_amdgcn_fence(__ATOMIC_ACQUIRE, "agent");
            asm volatile("s_waitcnt vmcnt(0)" ::: "memory");
        }
    }
    __syncthreads();
}

typedef __amdgpu_buffer_rsrc_t rsrc_t;
DEVI u32x4 bload16(rsrc_t r, unsigned voff, unsigned soff) { return __builtin_bit_cast(u32x4, __builtin_amdgcn_raw_buffer_load_b128(r, (int)voff, (int)soff, 0)); }
DEVI void glds16(rsrc_t r, unsigned char* lds_dst_uniform, unsigned voff, unsigned soff) {
    __builtin_amdgcn_raw_ptr_buffer_load_lds(r, (LAS void*)lds_dst_uniform, 16, (int)voff, (int)soff, 0, 0);
}
template <class FA, class FB>
DEVI void gemm128(f32x4 (&acc)[4][4], rsrc_t rs, unsigned sA, const FA& offA, unsigned sB, const FB& offB, int nk, unsigned char* lds, int tid) {
    const int lane = tid & 63, wid = __builtin_amdgcn_readfirstlane(tid >> 6), wr = wid >> 1, wc = wid & 1;
    const int lr = tid >> 3;
    const unsigned csrc = (unsigned)(((lane & 7) ^ ((lane >> 3) & 7)) << 4);
    unsigned oa[4], ob[4];
#pragma unroll
    for (int i = 0; i < 4; ++i) { oa[i] = offA(lr + 32 * i) + csrc; ob[i] = offB(lr + 32 * i) + csrc; }
#pragma unroll
    for (int m = 0; m < 4; ++m)
#pragma unroll
        for (int n = 0; n < 4; ++n) acc[m][n] = (f32x4){0.f, 0.f, 0.f, 0.f};
    const int q = lane >> 4, r16 = lane & 15;
    const int roffA0 = (wr * 64 + r16) * 128 + (((0 + q) ^ (lane & 7)) << 4);
    const int roffA1 = (wr * 64 + r16) * 128 + (((4 + q) ^ (lane & 7)) << 4);
    const int roffB0 = 16384 + (wc * 64 + r16) * 128 + (((0 + q) ^ (lane & 7)) << 4);
    const int roffB1 = 16384 + (wc * 64 + r16) * 128 + (((4 + q) ^ (lane & 7)) << 4);
    unsigned char* wbase = lds + wid * 1024;
#pragma unroll
    for (int i = 0; i < 4; ++i) { glds16(rs, wbase + i * 4096, oa[i], sA); glds16(rs, wbase + 16384 + i * 4096, ob[i], sB); }
    for (int kt = 0; kt < nk; ++kt) {
        unsigned char* cur = lds + (kt & 1) * 32768;
        __syncthreads();
        if (kt + 1 < nk) {
            unsigned char* nb = wbase + ((kt + 1) & 1) * 32768;
#pragma unroll
            for (int i = 0; i < 4; ++i) { glds16(rs, nb + i * 4096, oa[i], sA + (kt + 1) * 128); glds16(rs, nb + 16384 + i * 4096, ob[i], sB + (kt + 1) * 128); }
        }
        bf16x8 a0[4], b0[4], a1[4], b1[4];
#pragma unroll
        for (int m = 0; m < 4; ++m) a0[m] = *(const bf16x8*)(cur + roffA0 + m * 2048);
#pragma unroll
        for (int n = 0; n < 4; ++n) b0[n] = *(const bf16x8*)(cur + roffB0 + n * 2048);
#pragma unroll
        for (int m = 0; m < 4; ++m) a1[m] = *(const bf16x8*)(cur + roffA1 + m * 2048);
#pragma unroll
        for (int n = 0; n < 4; ++n) b1[n] = *(const bf16x8*)(cur + roffB1 + n * 2048);
#pragma unroll
        for (int m = 0; m < 4; ++m)
#pragma unroll
            for (int n = 0; n < 4; ++n) acc[m][n] = MFMA16(b0[n], a0[m], acc[m][n]);
#pragma unroll
        for (int m = 0; m < 4; ++m)
#pragma unroll
            for (int n = 0; n < 4; ++n) acc[m][n] = MFMA16(b1[n], a1[m], acc[m][n]);
    }
    __syncthreads();
}

DEVI bool tile_map(int k, int ncol, int& mt, int& nt) {
    if (gridDim.x == 512) {
        const int x = blockIdx.x & 7, j = blockIdx.x >> 3;
        const int v = j + 64 * k;
        if (v >= 32 * ncol) return false;
        const int nfull = ncol >> 3, rem = ncol & 7;
        int mtl;
        if (v < nfull * 256) { const int cg = v >> 8, w = v & 255; mtl = (w >> 6) * 8 + ((w & 63) >> 3); nt = cg * 8 + (w & 7); }
        else { const int v2 = v - nfull * 256, per = 8 * rem; const int rg = v2 / per, w = v2 % per; mtl = rg * 8 + w / rem; nt = nfull * 8 + w % rem; }
        mt = x * 32 + mtl;
        return true;
    }
    const int u = blockIdx.x + gridDim.x * k;
    if (u >= 256 * ncol) return false;
    mt = u / ncol; nt = u % ncol;
    return true;
}
struct RowLin { unsigned ldb; DEVI unsigned operator()(int r) const { return (unsigned)r * ldb; } };

DEVI int win_map(int j) {
    if (j < 896) return j;
    if (j < 1408) return j - 896 + 936;
    if (j < 2176) return j - 1408 + 1448;
    if (j < 2208) return j - 2176 + 896;
    if (j < 2216) return j - 2208 + 928;
    if (j < 2240) return j;
    if (j < 2304) return -1;
    return j - 64;
}

struct TJob { const float* src; bf16_t* dst; int K, ld, nrows, perm, nb; size_t sb, db; };
DEVI TJob get_tjob(const Params& P, int j) {
    unsigned char* ws = P.ws;
    switch (j) {
        case 0: return TJob{P.in[3], (bf16_t*)(ws + OFF_WIN_T), 1024, INW, WIN_ROWS, 1, 1, 0, 0};
        case 1: return TJob{P.in[10], (bf16_t*)(ws + OFF_WBRA), 512, 1024, 1024, 0, 1, 0, 0};
        case 2: return TJob{P.in[11], (bf16_t*)(ws + OFF_WBRB), 512, 1024, 1024, 0, 1, 0, 0};
        case 3: return TJob{P.in[12], (bf16_t*)(ws + OFF_WOUT), 1024, 1024, 1024, 0, 1, 0, 0};
        case 4: return TJob{P.in[5], (bf16_t*)(ws + OFF_W1K), 2048, 128, 128, 0, 1, 0, 0};
        case 5: return TJob{P.in[8], (bf16_t*)(ws + OFF_W1V), 2048, 128, 128, 0, 1, 0, 0};
        case 6: return TJob{P.in[6], (bf16_t*)(ws + OFF_W2K), 128, 64, 64, 0, 1, 0, 0};
        case 7: return TJob{P.in[9], (bf16_t*)(ws + OFF_W2V), 128, 64, 64, 0, 1, 0, 0};
        case 8: return TJob{P.in[18], (bf16_t*)(ws + OFF_WGU), 1024, 512, 512, 0, 32, (size_t)1024 * 512, (size_t)512 * 1024};
        default: return TJob{P.in[19], (bf16_t*)(ws + OFF_WDN), 256, 1024, 1024, 0, 32, (size_t)256 * 1024, (size_t)1024 * 256};
    }
}
DEVI int tjob_tiles(int j) {
    switch (j) {
        case 0: return (WIN_ROWS / 64) * 16;
        case 1: case 2: return 16 * 8;
        case 3: return 16 * 16;
        case 4: case 5: return 2 * 32;
        case 6: case 7: return 1 * 2;
        case 8: return 32 * 8 * 16;
        default: return 32 * 16 * 4;
    }
}

DEVI void transpose_tile(const TJob& J, int tile, unsigned char* lds, int tid) {
    float* T = (float*)lds;
    const int kt = J.K / 64, rt = J.nrows / 64;
    const int b = tile / (kt * rt), rem = tile % (kt * rt);
    const int r0 = (rem / kt) * 64, k0 = (rem % kt) * 64;
    const float* src = J.src + (size_t)b * J.sb;
    bf16_t* dst = J.dst + (size_t)b * J.db;
    const int n4 = (tid & 15) * 4;
    int col = r0 + n4; if (J.perm) col = win_map(col);
    f32x4 ld4[4];
#pragma unroll
    for (int i = 0; i < 4; ++i) {
        const int kk = (tid >> 4) + 16 * i;
        ld4[i] = (col >= 0) ? *(const f32x4*)(src + (size_t)(k0 + kk) * J.ld + col) : (f32x4){0.f, 0.f, 0.f, 0.f};
    }
#pragma unroll
    for (int i = 0; i < 4; ++i) {
        const int kk = (tid >> 4) + 16 * i;
#pragma unroll
        for (int e = 0; e < 4; ++e) T[kk * 65 + n4 + e] = ld4[i][e];
    }
    __syncthreads();
    const int r2 = tid >> 2, ks = (tid & 3) * 16;
    u32x4 w0, w1;
    w0.x = pk2(T[(ks + 0) * 65 + r2], T[(ks + 1) * 65 + r2]); w0.y = pk2(T[(ks + 2) * 65 + r2], T[(ks + 3) * 65 + r2]);
    w0.z = pk2(T[(ks + 4) * 65 + r2], T[(ks + 5) * 65 + r2]); w0.w = pk2(T[(ks + 6) * 65 + r2], T[(ks + 7) * 65 + r2]);
    w1.x = pk2(T[(ks + 8) * 65 + r2], T[(ks + 9) * 65 + r2]); w1.y = pk2(T[(ks + 10) * 65 + r2], T[(ks + 11) * 65 + r2]);
    w1.z = pk2(T[(ks + 12) * 65 + r2], T[(ks + 13) * 65 + r2]); w1.w = pk2(T[(ks + 14) * 65 + r2], T[(ks + 15) * 65 + r2]);
    bf16_t* d = dst + (size_t)(r0 + r2) * J.K + k0 + ks;
    *(u32x4*)d = w0; *(u32x4*)(d + 8) = w1;
    __syncthreads();
}

DEVI void rms_row_bf16(const float* xr, const float* g, bf16_t* o, int lane) {
    f32x4 v[4]; float ss = 0.f;
#pragma unroll
    for (int i = 0; i < 4; ++i) { v[i] = *(const f32x4*)(xr + i * 256 + lane * 4); ss += v[i][0] * v[i][0] + v[i][1] * v[i][1] + v[i][2] * v[i][2] + v[i][3] * v[i][3]; }
    ss = wave_sum(ss);
    const float rs = rsqrtf(ss * (1.0f / 1024.0f) + RMS_EPS);
#pragma unroll
    for (int i = 0; i < 4; ++i) {
        const f32x4 gg = *(const f32x4*)(g + i * 256 + lane * 4);
        u32x2 w; w.x = pk2(v[i][0] * rs * gg[0], v[i][1] * rs * gg[1]); w.y = pk2(v[i][2] * rs * gg[2], v[i][3] * rs * gg[3]);
        *(u32x2*)(o + i * 256 + lane * 4) = w;
    }
}

DEVI void phase_prep(const Params& P, unsigned char* lds, int tid, int part) {
    unsigned char* ws = P.ws;
    const int lane = tid & 63, wid = __builtin_amdgcn_readfirstlane(tid >> 6);
    int base = 0;
#pragma unroll
    for (int j = 0; j < 10; ++j) {
        const bool early = (j == 0) || (j >= 4 && j <= 7);
        if (early == (part == 0)) {
            const int nt = tjob_tiles(j);
            const TJob J = get_tjob(P, j);
            for (int t = blockIdx.x; t < nt; t += gridDim.x) transpose_tile(J, t, lds, tid);
        }
    }
    (void)base;
    if (part == 1) {
        float* wr = (float*)(ws + OFF_WR);
        const float* g = P.in[13]; const float* wg = P.in[14]; const float* we = P.in[16];
        for (int e = blockIdx.x * NTHREADS + tid; e < 48 * 1024; e += gridDim.x * NTHREADS) {
            const int c = e >> 10, k = e & 1023;
            float v = 0.f;
            if (c < 4) v = wg[k * 4 + c]; else if (c < 36) v = we[k * 32 + (c - 4)];
            wr[e] = v * g[k];
        }
        return;
    }
    {
        const float* x = P.in[0]; const float* g = P.in[2]; bf16_t* hn = (bf16_t*)(ws + OFF_HN);
        for (int r = blockIdx.x * 4 + wid; r < NTOK; r += gridDim.x * 4) rms_row_bf16(x + (size_t)r * 1024, g, hn + (size_t)r * 1024, lane);
    }
    {
        f32x2* cs = (f32x2*)(ws + OFF_CS);
        for (int e = blockIdx.x * NTHREADS + tid; e < NTOK * 32; e += gridDim.x * NTHREADS) {
            const int tok = e >> 5, i = e & 31;
            const double a = (double)P.pos[tok] * P.inv_freq[i];
            double t = a * 0.15915494309189535;
            t -= floor(t);
            const float tf = (float)t;
            cs[e] = (f32x2){__builtin_amdgcn_cosf(tf), __builtin_amdgcn_sinf(tf)};
        }
    }
    {
        float* red = (float*)lds;
        for (int job = blockIdx.x; job < 32; job += gridDim.x) {
            const int kv = job >> 4, cg8 = job & 15;
            const float* pe = P.in[kv ? 7 : 4]; const float* w1 = P.in[kv ? 8 : 5];
            const int cc = tid & 7, jj = tid >> 3;
            float s = 0.f;
            for (int j = jj; j < 2048; j += 32) s += pe[j] * w1[(size_t)j * 128 + cg8 * 8 + cc];
            red[tid] = s;
            __syncthreads();
            if (tid < 8) { float t = 0.f; for (int u = 0; u < 32; ++u) t += red[u * 8 + tid]; ((float*)(ws + OFF_BIAS1))[kv * 128 + cg8 * 8 + tid] = t; }
            __syncthreads();
        }
    }
}

DEVI void st_bf16(bf16_t* p, float v) { *p = (bf16_t)f2bf(v); }

DEVI int gemm1_col_tile(int part, int i) {
    if (part == 0) return (i < 2) ? 5 + i : ((i < 4) ? 9 + i : 17);
    return (i < 5) ? i : ((i < 9) ? i + 2 : ((i < 13) ? i + 4 : i + 5));
}
DEVI void phase_gemm1(const Params& P, unsigned char* lds, int tid, int part) {
    unsigned char* ws = P.ws;
    const rsrc_t rs = __builtin_amdgcn_make_buffer_rsrc((void*)P.ws, (short)0, (int)0x7fffffff, 0x00020000);
    const bf16_t* hn = (const bf16_t*)(ws + OFF_HN);
    const bf16_t* wt = (const bf16_t*)(ws + OFF_WIN_T);
    const f32x2* cs = (const f32x2*)(ws + OFF_CS);
    const int lane = tid & 63, wid = __builtin_amdgcn_readfirstlane(tid >> 6), wr = wid >> 1, wc = wid & 1, q = lane >> 4, cl = lane & 15;
    constexpr int NT_N = G1_COLS / 128;
    for (int kk = 0;; ++kk) {
        int mt, nti;
        if (!tile_map(kk, part == 0 ? 5 : NT_N - 5, mt, nti)) break;
        const int nt = gemm1_col_tile(part, nti);
        f32x4 acc[4][4];
        gemm128(acc, rs, (unsigned)(OFF_HN + (size_t)mt * 128 * 2048), RowLin{2048}, (unsigned)(OFF_WIN_T + (size_t)nt * 128 * 2048), RowLin{2048}, 16, lds, tid);
        const int c64 = nt * 2 + wc;
        const int tok0 = mt * 128 + wr * 64 + cl;
        if (c64 < 10 || (c64 >= 14 && c64 < 34)) {
            bool do_rope; float scale = 1.f; int kind;
            int g = 0, hk = 0;
            if (c64 < 8) { kind = 0; do_rope = true; scale = 0.125f * LOG2E; }
            else if (c64 == 8) { kind = 1; do_rope = true; }
            else if (c64 == 9) { kind = 2; do_rope = false; }
            else if (c64 < 22) { kind = 3; do_rope = true; scale = 0.125f * LOG2E; }
            else { kind = 4; g = (c64 - 22) >> 1; hk = (c64 - 22) & 1; do_rope = (g == 2 || g == 4); }
#pragma unroll
            for (int m = 0; m < 4; ++m) {
                const int tok = tok0 + m * 16;
                f32x4 o[4], nr[4];
#pragma unroll
                for (int n = 0; n < 4; ++n) { nr[n] = acc[m][n] * scale; o[n] = nr[n]; }
                if (do_rope) {
#pragma unroll
                    for (int n = 0; n < 2; ++n) {
                        const f32x4 c01 = *(const f32x4*)(cs + (size_t)tok * 32 + n * 16 + q * 4);
                        const f32x4 c23 = *(const f32x4*)(cs + (size_t)tok * 32 + n * 16 + q * 4 + 2);
                        const float cc[4] = {c01[0], c01[2], c23[0], c23[2]}, sn[4] = {c01[1], c01[3], c23[1], c23[3]};
#pragma unroll
                        for (int j = 0; j < 4; ++j) {
                            const float x1 = nr[n][j], x2 = nr[n + 2][j];
                            o[n][j] = x1 * cc[j] - x2 * sn[j]; o[n + 2][j] = x1 * sn[j] + x2 * cc[j];
                        }
                    }
                }
                if (kind == 0 || kind == 1 || kind == 2) {
                    bf16_t* d = (kind == 0) ? (bf16_t*)(ws + OFF_QA) + (size_t)tok * 512 + c64 * 64 : (bf16_t*)(ws + (kind == 1 ? OFF_KA : OFF_VA)) + (size_t)tok * 64;
#pragma unroll
                    for (int n = 0; n < 4; ++n) { u32x2 w; w.x = pk2(o[n][0], o[n][1]); w.y = pk2(o[n][2], o[n][3]); *(u32x2*)(d + n * 16 + q * 4) = w; }
                } else if (kind == 3) {
                    const int h = c64 - 14;
                    bf16_t* dn = (bf16_t*)(ws + OFF_QBN) + (size_t)tok * 512 + h * 64; bf16_t* dr = (bf16_t*)(ws + OFF_QBR) + (size_t)tok * 512 + h * 64;
#pragma unroll
                    for (int n = 0; n < 4; ++n) {
                        u32x2 w; w.x = pk2(nr[n][0], nr[n][1]); w.y = pk2(nr[n][2], nr[n][3]); *(u32x2*)(dn + n * 16 + q * 4) = w;
                        u32x2 v; v.x = pk2(o[n][0], o[n][1]); v.y = pk2(o[n][2], o[n][3]); *(u32x2*)(dr + n * 16 + q * 4) = v;
                    }
                } else {
                    bf16_t* d = (bf16_t*)(ws + OFF_KV + (size_t)g * KV_STRIDE);
                    const int b = tok >> 12, tl = tok & 4095;
                    if (g == 3 || g == 5) {
#pragma unroll
                        for (int n = 0; n < 4; ++n)
#pragma unroll
                            for (int j = 0; j < 4; ++j) st_bf16(d + ((size_t)((b * 2 + hk) * 64 + n * 16 + q * 4 + j)) * 4096 + tl, o[n][j]);
                    } else {
#pragma unroll
                        for (int n = 0; n < 4; ++n) { u32x2 w; w.x = pk2(o[n][0], o[n][1]); w.y = pk2(o[n][2], o[n][3]);
                            *(u32x2*)(d + ((size_t)((b * 2 + hk) * 4096 + tl)) * 64 + n * 16 + q * 4) = w; }
                    }
                }
            }
        } else if (c64 >= 10 && c64 < 14) {
            bf16_t* d = (bf16_t*)(ws + OFF_QI);
#pragma unroll
            for (int m = 0; m < 4; ++m) {
                const int tok = tok0 + m * 16;
                float cc[4], sn[4];
#pragma unroll
                for (int j = 0; j < 4; ++j) { const f32x2 c = cs[(size_t)tok * 32 + 2 * (4 * q + j)]; cc[j] = c.x; sn[j] = c.y; }
#pragma unroll
                for (int hh = 0; hh < 2; ++hh) {
                    const int head = 2 * (c64 - 10) + hh;
                    f32x4 r1, r2;
#pragma unroll
                    for (int j = 0; j < 4; ++j) { const float x1 = acc[m][2 * hh][j], x2 = acc[m][2 * hh + 1][j]; r1[j] = x1 * cc[j] - x2 * sn[j]; r2[j] = x1 * sn[j] + x2 * cc[j]; }
                    u32x2 w; w.x = pk2(r1[0], r1[1]); w.y = pk2(r1[2], r1[3]); *(u32x2*)(d + (size_t)tok * 256 + head * 32 + q * 4) = w;
                    u32x2 v; v.x = pk2(r2[0], r2[1]); v.y = pk2(r2[2], r2[3]); *(u32x2*)(d + (size_t)tok * 256 + head * 32 + 16 + q * 4) = v;
                }
            }
        } else if (c64 >= 36) {
            bf16_t* d = (bf16_t*)(ws + (c64 < 52 ? OFF_GA : OFF_GB));
            const int cb = (c64 < 52 ? c64 - 36 : c64 - 52) * 64;
#pragma unroll
            for (int m = 0; m < 4; ++m)
#pragma unroll
                for (int n = 0; n < 4; ++n) {
                    u32x2 w; w.x = pk2(sigmoidf_(acc[m][n][0]), sigmoidf_(acc[m][n][1])); w.y = pk2(sigmoidf_(acc[m][n][2]), sigmoidf_(acc[m][n][3]));
                    *(u32x2*)(d + (size_t)(tok0 + m * 16) * 1024 + cb + n * 16 + q * 4) = w;
                }
        } else if (c64 == 34) {
            bf16_t* dki = (bf16_t*)(ws + OFF_KI); float* dwi = (float*)(ws + OFF_WI); float* dg = (float*)(ws + OFF_GATES);
#pragma unroll
            for (int m = 0; m < 4; ++m) {
                const int tok = tok0 + m * 16;
                f32x4 r1, r2;
#pragma unroll
                for (int j = 0; j < 4; ++j) {
                    const f32x2 c = cs[(size_t)tok * 32 + 2 * (4 * q + j)];
                    const float x1 = acc[m][0][j], x2 = acc[m][1][j];
                    r1[j] = x1 * c.x - x2 * c.y; r2[j] = x1 * c.y + x2 * c.x;
                }
                u32x2 w; w.x = pk2(r1[0], r1[1]); w.y = pk2(r1[2], r1[3]); *(u32x2*)(dki + (size_t)tok * 32 + q * 4) = w;
                u32x2 v; v.x = pk2(r2[0], r2[1]); v.y = pk2(r2[2], r2[3]); *(u32x2*)(dki + (size_t)tok * 32 + 16 + q * 4) = v;
                if (q < 2) *(f32x4*)(dwi + (size_t)tok * 8 + q * 4) = acc[m][2];
                else { f32x4 sv; for (int j = 0; j < 4; ++j) sv[j] = sigmoidf_(acc[m][2][j]); *(f32x4*)(dg + (size_t)tok * 24 + (q * 4 - 8)) = sv; }
                { f32x4 sv; for (int j = 0; j < 4; ++j) sv[j] = sigmoidf_(acc[m][3][j]); *(f32x4*)(dg + (size_t)tok * 24 + 8 + q * 4) = sv; }
            }
        }
    }
}

DEVI float siluf_(float x) { return x * __builtin_amdgcn_rcpf(1.0f + __builtin_amdgcn_exp2f(-x * 1.4426950408889634f)); }

DEVI void phase_compress(const Params& P, unsigned char* lds, int tid) {
    unsigned char* ws = P.ws;
    const rsrc_t rs = __builtin_amdgcn_make_buffer_rsrc((void*)P.ws, (short)0, (int)0x7fffffff, 0x00020000);
    const int lane = tid & 63, wid = __builtin_amdgcn_readfirstlane(tid >> 6), wr = wid >> 1, wc = wid & 1, q = lane >> 4, cl = lane & 15;
    for (int u = blockIdx.x; u < 64; u += gridDim.x) {
        const int kv = u >> 5, mt = u & 31;
        const bf16_t* A = (const bf16_t*)(ws + OFF_KV + (size_t)kv * KV_STRIDE) + (size_t)mt * 128 * 1024;
        const bf16_t* W1 = (const bf16_t*)(ws + (kv ? OFF_W1V : OFF_W1K));
        const bf16_t* W2 = (const bf16_t*)(ws + (kv ? OFF_W2V : OFF_W2K));
        const float* bias = (const float*)(ws + OFF_BIAS1) + kv * 128;
        f32x4 acc[4][4];
        gemm128(acc, rs, (unsigned)(OFF_KV + (size_t)kv * KV_STRIDE + (size_t)mt * 128 * 2048), RowLin{2048}, (unsigned)(kv ? OFF_W1V : OFF_W1K), RowLin{4096}, 32, lds, tid);
#pragma unroll
        for (int m = 0; m < 4; ++m)
#pragma unroll
            for (int n = 0; n < 4; ++n) {
                const int col = wc * 64 + n * 16 + q * 4, row = wr * 64 + m * 16 + cl;
                const f32x4 bb = *(const f32x4*)(bias + col);
                const int ktile = col >> 6, ch = (col & 63) >> 3, wi = col & 7;
                u32x2 w; w.x = pk2(siluf_(acc[m][n][0] + bb[0]), siluf_(acc[m][n][1] + bb[1])); w.y = pk2(siluf_(acc[m][n][2] + bb[2]), siluf_(acc[m][n][3] + bb[3]));
                *(u32x2*)(lds + ktile * 16384 + row * 128 + ((ch ^ (row & 7)) << 4) + wi * 2) = w;
            }
#pragma unroll
        for (int i = 0; i < 4; ++i) {
            const int idx = tid + 256 * i;
            const int row = idx >> 4, ch16 = idx & 15, ktile = ch16 >> 3, ch = ch16 & 7;
            *(u32x4*)(lds + 32768 + ktile * 8192 + row * 128 + ((ch ^ (row & 7)) << 4)) = *(const u32x4*)(W2 + (size_t)row * 128 + ch16 * 8);
        }
        __syncthreads();
        f32x4 a2[4][2];
#pragma unroll
        for (int m = 0; m < 4; ++m) { a2[m][0] = (f32x4){0.f, 0.f, 0.f, 0.f}; a2[m][1] = (f32x4){0.f, 0.f, 0.f, 0.f}; }
#pragma unroll
        for (int kk = 0; kk < 4; ++kk) {
            const int ktile = kk >> 1, ks = kk & 1;
            bf16x8 a[4], b[2];
#pragma unroll
            for (int m = 0; m < 4; ++m) { const int row = wr * 64 + m * 16 + cl; a[m] = *(const bf16x8*)(lds + ktile * 16384 + row * 128 + (((ks * 4 + q) ^ (row & 7)) << 4)); }
#pragma unroll
            for (int n = 0; n < 2; ++n) { const int row = wc * 32 + n * 16 + cl; b[n] = *(const bf16x8*)(lds + 32768 + ktile * 8192 + row * 128 + (((ks * 4 + q) ^ (row & 7)) << 4)); }
#pragma unroll
            for (int m = 0; m < 4; ++m)
#pragma unroll
                for (int n = 0; n < 2; ++n) a2[m][n] = MFMA16(b[n], a[m], a2[m][n]);
        }
#pragma unroll
        for (int m = 0; m < 4; ++m)
#pragma unroll
            for (int n = 0; n < 2; ++n) {
                const int d = wc * 32 + n * 16 + q * 4;
                const int r = mt * 128 + wr * 64 + m * 16 + cl;
                const bool dead = ((r & 255) == 255);
                float v[4];
#pragma unroll
                for (int j = 0; j < 4; ++j) v[j] = dead ? 0.f : a2[m][n][j];
                if (kv == 0) {
                    bf16_t* kc = (bf16_t*)(ws + OFF_KC);
                    u32x2 w; w.x = pk2(v[0], v[1]); w.y = pk2(v[2], v[3]);
                    *(u32x2*)(kc + (size_t)r * 64 + d) = w;
                } else {
                    bf16_t* vct = (bf16_t*)(ws + OFF_VCT);
#pragma unroll
                    for (int j = 0; j < 4; ++j) st_bf16(vct + ((size_t)((r >> 8) * 64 + d + j)) * 256 + (r & 255), v[j]);
                }
            }
        __syncthreads();
    }
}

DEVI void phase_index(const Params& P, unsigned char* lds, int tid) {
    unsigned char* ws = P.ws;
    const bf16_t* QI = (const bf16_t*)(ws + OFF_QI);
    const bf16_t* KI = (const bf16_t*)(ws + OFF_KI);
    const float* WI = (const float*)(ws + OFF_WI);
    bf16_t* SEL = (bf16_t*)(ws + OFF_SEL);
    float* S = (float*)lds;
    const int lane = tid & 63, wid = __builtin_amdgcn_readfirstlane(tid >> 6), q = lane >> 4, cl = lane & 15;
    for (int u = blockIdx.x; u < NTOK / 4; u += gridDim.x) {
        const int b = u >> 10, w10 = u & 1023, s10 = (w10 < 512) ? w10 : 1535 - w10;
        const int t0 = s10 * 4, tok0 = b * 4096 + t0;
        const int t = t0 + wid;
        const int tok = tok0 + wid;
        if (t0 + 3 < 256) {
            for (int i = lane; i < 256; i += 64) SEL[(size_t)tok * 256 + i] = (bf16_t)(i <= t ? i : 0);
            continue;
        }
        {
            bf16x8 a[2];
#pragma unroll
            for (int hg = 0; hg < 2; ++hg) a[hg] = *(const bf16x8*)(QI + (size_t)(tok0 + (cl >> 2)) * 256 + (4 * hg + (cl & 3)) * 32 + q * 8);
            const f32x4 w0 = *(const f32x4*)(WI + (size_t)(tok0 + q) * 8), w1 = *(const f32x4*)(WI + (size_t)(tok0 + q) * 8 + 4);
            const int ktmax = (t0 + 3) >> 4;
            const bf16_t* kb = KI + (size_t)b * 4096 * 32 + cl * 32 + q * 8;
            for (int kt0 = wid; kt0 <= ktmax; kt0 += 16) {
                bf16x8 bk[4];
#pragma unroll
                for (int uu = 0; uu < 4; ++uu) { const int kt = (kt0 + 4 * uu <= ktmax) ? kt0 + 4 * uu : kt0; bk[uu] = *(const bf16x8*)(kb + (size_t)kt * 16 * 32); }
#pragma unroll
                for (int uu = 0; uu < 4; ++uu) {
                    const int kt = kt0 + 4 * uu;
                    f32x4 c0 = {0.f, 0.f, 0.f, 0.f}, c1 = {0.f, 0.f, 0.f, 0.f};
                    c0 = MFMA16(a[0], bk[uu], c0); c1 = MFMA16(a[1], bk[uu], c1);
                    float sc = 0.f;
#pragma unroll
                    for (int j = 0; j < 4; ++j) { sc += w0[j] * fmaxf(c0[j], 0.f); sc += w1[j] * fmaxf(c1[j], 0.f); }
                    if (kt <= ktmax) S[q * 4096 + kt * 16 + cl] = sc;
                }
            }
        }
        __syncthreads();
        {
            const int n = t + 1;
            const float* Sq = S + wid * 4096;
            if (n <= 256) {
                for (int i = lane; i < 256; i += 64) SEL[(size_t)tok * 256 + i] = (bf16_t)(i <= t ? i : 0);
            } else {
                const int nr = (n + 63) >> 6;
                float x[64];
                const float NINF = -__builtin_inff();
                float mx = NINF, mn = __builtin_inff();
#pragma unroll
                for (int r = 0; r < 64; ++r) {
                    const int key = r * 64 + lane;
                    const float v = Sq[key];
                    x[r] = (key < n) ? v : NINF;
                    mn = fminf(mn, (key < n) ? v : __builtin_inff());
                    mx = fmaxf(mx, x[r]);
                }
#pragma unroll
                for (int o = 32; o > 0; o >>= 1) { mx = fmaxf(mx, __shfl_xor(mx, o)); mn = fminf(mn, __shfl_xor(mn, o)); }
                float lo = mn, hi = mx, T; int need;
                int chi = 0, clo = n;
#define COUNT_GE(dst, thr) do { int c_ = 0; _Pragma("unroll") for (int g8 = 0; g8 < 8; ++g8) if (g8 * 8 < nr) { \
        _Pragma("unroll") for (int r = g8 * 8; r < g8 * 8 + 8; ++r) c_ += __popcll(__ballot(x[r] >= (thr))); } (dst) = c_; } while (0)
                COUNT_GE(chi, hi);
                if (chi >= 256) { T = hi; need = 256;   }
                else {
                    float s1 = 0.f, s2 = 0.f;
#pragma unroll
                    for (int g8 = 0; g8 < 8; ++g8) if (g8 * 8 < nr) {
#pragma unroll
                        for (int r = g8 * 8; r < g8 * 8 + 8; ++r) { const float v = (x[r] == NINF) ? 0.f : x[r]; s1 += v; s2 += v * v; }
                    }
                    s1 = wave_sum_f32_dpp(s1); s2 = wave_sum_f32_dpp(s2);
                    const float fn = (float)n, mu = s1 / fn;
                    const float sg = sqrtf(fmaxf(s2 / fn - mu * mu, 1e-20f));
                    float vg;
                    {
                        const float pq = 256.0f / fn, pp = fminf(pq, 1.0f - pq);
                        const float tt = sqrtf(-2.0f * __logf(fmaxf(pp, 1e-6f)));
                        const float zz = tt - (2.515517f + 0.802853f * tt + 0.010328f * tt * tt) / (1.0f + 1.432788f * tt + 0.189269f * tt * tt + 0.001308f * tt * tt * tt);
                        vg = mu + ((pq <= 0.5f) ? zz : -zz) * sg;
                    }
                    bool found = false, adjacent = false; float thr = 0.f;
                    for (int it = 0; it < 160; ++it) {
                        if (clo - chi <= 64) break;
                        const float mid = 0.5f * lo + 0.5f * hi;
                        if (!(mid > lo && mid < hi)) { adjacent = true; break; }
                        float v = vg;
                        if (!(v > lo && v < hi) || (it & 3) == 3) v = mid;
                        int c; COUNT_GE(c, v);
                        if (c == 256) { found = true; thr = v; break; }
                        if (c > 256) { lo = v; clo = c; } else { hi = v; chi = c; }
                        const float zv = (v - mu) / sg;
                        const float dens = fmaxf(fn * 0.39894228f * __expf(-0.5f * zv * zv), 0.5f) / sg;
                        vg = v + ((float)c - ((c > 256) ? 244.0f : 268.0f)) / dens;
                    }
                    if (found) { T = thr; need = -1; }
                    else if (adjacent) { T = lo; need = 256 - chi; }
                    else {
                        float* cand = (float*)(lds + 65536) + wid * 64;
                        cand[lane] = NINF;
                        int cb = 0;
                        const unsigned long long ltm = (1ull << lane) - 1ull;
#pragma unroll
                        for (int g8 = 0; g8 < 8; ++g8) if (g8 * 8 < nr) {
#pragma unroll
                            for (int r = g8 * 8; r < g8 * 8 + 8; ++r) {
                                const bool isc = (x[r] >= lo) && (x[r] < hi);
                                const unsigned long long bm = __ballot(isc);
                                if (bm != 0ull) {
                                    if (isc) cand[cb + __popcll(bm & ltm)] = x[r];
                                    cb += __popcll(bm);
                                }
                            }
                        }
                        const float y = cand[lane];
                        int cgt = 0, cge = 0;
#pragma unroll
                        for (int k = 0; k < 64; ++k) { const float yk = __builtin_bit_cast(float, __builtin_amdgcn_readlane(__builtin_bit_cast(int, y), k)); cgt += (yk > y) ? 1 : 0; cge += (yk >= y) ? 1 : 0; }
                        const int nd = 256 - chi;
                        const bool isT = (y != NINF) && (cgt <= nd - 1) && (cge >= nd);
                        const unsigned long long tm = __ballot(isT);
                        const int tl = (tm != 0ull) ? (int)__builtin_ctzll(tm) : 0;
                        T = __shfl(y, tl);
                        need = nd - __shfl(cgt, tl);
                    }
                }
                bf16_t* selb = (bf16_t*)(lds + 65536 + 1024) + wid * 256;
                int wlo = 0, whi = 0, tot = 0;
#pragma unroll
                for (int g8 = 0; g8 < 8; ++g8) if (g8 * 8 < nr) {
#pragma unroll
                    for (int r = g8 * 8; r < g8 * 8 + 8; ++r) {
                        const unsigned long long m = __ballot(x[r] >= T);
                        tot += __popcll(m);
                        asm volatile("v_writelane_b32 %0, %1, %2" : "+v"(wlo) : "s"((unsigned)m), "n"(r));
                        asm volatile("v_writelane_b32 %0, %1, %2" : "+v"(whi) : "s"((unsigned)(m >> 32)), "n"(r));
                    }
                }
                if (tot == 256) {
                    const int cw = __popc((unsigned)wlo) + __popc((unsigned)whi);
                    int pos = 0;
#pragma unroll
                    for (int bb = 0; bb < 7; ++bb) {
                        const unsigned long long bmk = __ballot(((cw >> bb) & 1) != 0);
                        pos += (int)__builtin_amdgcn_mbcnt_hi((unsigned)(bmk >> 32), __builtin_amdgcn_mbcnt_lo((unsigned)bmk, 0u)) << bb;
                    }
                    unsigned long long w = ((unsigned long long)(unsigned)whi << 32) | (unsigned long long)(unsigned)wlo;
                    while (w != 0ull) {
                        const int bpos = (int)__builtin_ctzll(w);
                        selb[pos++] = (bf16_t)(lane * 64 + bpos);
                        w &= w - 1ull;
                    }
                } else {
                    if (need < 0) need = 0x7fffffff;
                    int base = 0, eqc = 0;
                    const unsigned long long lt = (1ull << lane) - 1ull;
#pragma unroll
                    for (int g8 = 0; g8 < 8; ++g8) if (g8 * 8 < nr) {
#pragma unroll
                        for (int r = g8 * 8; r < g8 * 8 + 8; ++r) {
                            const bool eq = (x[r] == T);
                            const unsigned long long em = __ballot(eq);
                            const bool sel = (x[r] > T) || (eq && (eqc + __popcll(em & lt) < need));
                            eqc += __popcll(em);
                            const unsigned long long sm = __ballot(sel);
                            if (sel) { const int pp = base + __popcll(sm & lt); if (pp < 256) selb[pp] = (bf16_t)(r * 64 + lane); }
                            base += __popcll(sm);
                        }
                    }
                }
                __builtin_amdgcn_wave_barrier();
                if (lane < 32) *(u32x4*)(SEL + (size_t)tok * 256 + lane * 8) = *(const u32x4*)(selb + lane * 8);
                __builtin_amdgcn_wave_barrier();
            }
        }
        __syncthreads();
    }
}

DEVI int dsa_vswz(int row) { return (((row >> 1) & 1) << 1) | (((row >> 3) & 1) << 2); }
DEVI void phase_dsa(const Params& P, unsigned char* lds, int tid) {
    unsigned char* ws = P.ws;
    const bf16_t* QA = (const bf16_t*)(ws + OFF_QA);
    const bf16_t* KA = (const bf16_t*)(ws + OFF_KA);
    const bf16_t* VA = (const bf16_t*)(ws + OFF_VA);
    const bf16_t* SEL = (const bf16_t*)(ws + OFF_SEL);
    bf16_t* OA = (bf16_t*)(ws + OFF_OA);
    const int lane = tid & 63, wid = __builtin_amdgcn_readfirstlane(tid >> 6), q = lane >> 4, cl = lane & 15;
    unsigned char* vl = lds + wid * 8192;
    const float NINF = -__builtin_inff();
    const int stride = gridDim.x * 4;
    int tok = blockIdx.x * 4 + wid;
    if (tok >= NTOK) return;
    int kidx[16], mk[4]; bf16x8 bq[2];
    {
        const bf16_t* sel = SEL + (size_t)tok * 256;
#pragma unroll
        for (int rf = 0; rf < 16; ++rf) kidx[rf] = sel[32 * (rf >> 1) + 8 * (cl >> 2) + 4 * (rf & 1) + (cl & 3)];
#pragma unroll
        for (int cc = 0; cc < 4; ++cc) mk[cc] = sel[cc * 64 + lane];
#pragma unroll
        for (int ks = 0; ks < 2; ++ks) bq[ks] = *(const bf16x8*)(QA + (size_t)tok * 512 + (cl & 7) * 64 + ks * 32 + q * 8);
    }
    const int wrow = lane >> 3;
    for (; tok < NTOK; tok += stride) {
        const int b = tok >> 12, t = tok & 4095;
        const int cnt = (t + 1 < 256) ? t + 1 : 256;
        const int nc64 = (cnt + 63) >> 6;
        const bf16_t* kb = KA + (size_t)b * 4096 * 64;
        const bf16_t* vb = VA + (size_t)b * 4096 * 64;
        const bf16x8 zero8 = {0, 0, 0, 0, 0, 0, 0, 0};
        const bf16x8 bq0 = (cl < 8) ? bq[0] : zero8, bq1 = (cl < 8) ? bq[1] : zero8;
        u32x4 vr[8];
#pragma unroll
        for (int i = 0; i < 8; ++i) { const int key = __shfl(mk[0], wrow + 8 * i); vr[i] = *(const u32x4*)(vb + (size_t)key * 64 + (lane & 7) * 8); }
        f32x4 s[16];
#pragma unroll
        for (int rf = 0; rf < 16; ++rf) {
            s[rf] = (f32x4){0.f, 0.f, 0.f, 0.f};
            if ((rf >> 2) < nc64) {
                const bf16_t* kr = kb + (size_t)kidx[rf] * 64 + q * 8;
                const bf16x8 a0 = *(const bf16x8*)(kr), a1 = *(const bf16x8*)(kr + 32);
                s[rf] = MFMA16(a0, bq0, s[rf]); s[rf] = MFMA16(a1, bq1, s[rf]);
            }
            if ((rf & 3) == 3) asm volatile("" ::: "memory");
        }
        int mkc[4];
#pragma unroll
        for (int cc = 0; cc < 4; ++cc) mkc[cc] = mk[cc];
        {
            const int tn = (tok + stride < NTOK) ? tok + stride : tok;
            const bf16_t* sel = SEL + (size_t)tn * 256;
#pragma unroll
            for (int rf = 0; rf < 16; ++rf) kidx[rf] = sel[32 * (rf >> 1) + 8 * (cl >> 2) + 4 * (rf & 1) + (cl & 3)];
#pragma unroll
            for (int cc = 0; cc < 4; ++cc) mk[cc] = sel[cc * 64 + lane];
#pragma unroll
            for (int ks = 0; ks < 2; ++ks) bq[ks] = *(const bf16x8*)(QA + (size_t)tn * 512 + (cl & 7) * 64 + ks * 32 + q * 8);
        }
        float mx = NINF;
#pragma unroll
        for (int rf = 0; rf < 16; ++rf)
#pragma unroll
            for (int j = 0; j < 4; ++j) {
                const int p = 32 * (rf >> 1) + 8 * q + 4 * (rf & 1) + j;
                if (p >= cnt) s[rf][j] = NINF;
                mx = fmaxf(mx, s[rf][j]);
            }
        mx = rows_max(mx);
        float ls = 0.f;
#pragma unroll
        for (int rf = 0; rf < 16; ++rf)
#pragma unroll
            for (int j = 0; j < 4; ++j) { const float pv = __builtin_amdgcn_exp2f(s[rf][j] - mx); s[rf][j] = pv; ls += pv; }
        ls = rows_sum(ls);
        const float inv = __builtin_amdgcn_rcpf(ls);
        bf16x8 pbs[8];
#pragma unroll
        for (int c8 = 0; c8 < 8; ++c8) pbs[c8] = pack8(s[2 * c8], s[2 * c8 + 1]);
        f32x4 o[4];
#pragma unroll
        for (int d = 0; d < 4; ++d) o[d] = (f32x4){0.f, 0.f, 0.f, 0.f};
#pragma unroll
        for (int cc = 0; cc < 4; ++cc) {
            if (cc < nc64) {
                __builtin_amdgcn_wave_barrier();
#pragma unroll
                for (int i = 0; i < 8; ++i) { const int row = wrow + 8 * i; *(u32x4*)(vl + row * 128 + (((lane & 7) ^ dsa_vswz(row)) << 4)) = vr[i]; }
                __builtin_amdgcn_wave_barrier();
                if (cc + 1 < 4 && cc + 1 < nc64) {
#pragma unroll
                    for (int i = 0; i < 8; ++i) { const int key = __shfl(mkc[(cc + 1) & 3], wrow + 8 * i); vr[i] = *(const u32x4*)(vb + (size_t)key * 64 + (lane & 7) * 8); }
                }
#pragma unroll
                for (int c2 = 0; c2 < 2; ++c2) {
                    const bf16x8 pb = pbs[cc * 2 + c2];
#pragma unroll
                    for (int d = 0; d < 4; ++d) {
                        const int r0 = c2 * 32 + 8 * q + (cl >> 2), r1 = r0 + 4;
                        const int ch = d * 2 + ((cl & 3) >> 1), wb = 8 * (cl & 1);
                        const s16x4 lo4 = __builtin_amdgcn_ds_read_tr16_b64_v4i16((LAS s16x4*)((LAS unsigned char*)(vl) + r0 * 128 + ((ch ^ dsa_vswz(r0)) << 4) + wb));
                        const s16x4 hi4 = __builtin_amdgcn_ds_read_tr16_b64_v4i16((LAS s16x4*)((LAS unsigned char*)(vl) + r1 * 128 + ((ch ^ dsa_vswz(r1)) << 4) + wb));
                        const bf16x8 av = {lo4[0], lo4[1], lo4[2], lo4[3], hi4[0], hi4[1], hi4[2], hi4[3]};
                        o[d] = MFMA16(av, pb, o[d]);
                    }
                }
            }
        }
        if (cl < 8) {
#pragma unroll
            for (int d = 0; d < 4; ++d) {
                u32x2 w; w.x = pk2(o[d][0] * inv, o[d][1] * inv); w.y = pk2(o[d][2] * inv, o[d][3] * inv);
                *(u32x2*)(OA + (size_t)tok * 512 + cl * 64 + d * 16 + q * 4) = w;
            }
        }
    }
}

DEVI int fK(int row) { return (row & 3) | (((row >> 3) & 1) << 2); }

struct AttnState { f32x4 O[4][4]; float m[4]; float l[4]; };

template <int MODE>
DEVI void attn_blocks(rsrc_t rs, unsigned sK, unsigned sV, int ldv, int jb0, int jb1, const bf16x8 (&qf)[4][2], AttnState& st,
                      int tq, unsigned long long selmask, unsigned char* lds, int tid) {
    const int lane = tid & 63, q = lane >> 4, cl = lane & 15;
    const float NINF = -__builtin_inff();
#pragma unroll
    for (int cf = 0; cf < 4; ++cf) { st.m[cf] = NINF; st.l[cf] = 0.f;
#pragma unroll
        for (int d = 0; d < 4; ++d) st.O[d][cf] = (f32x4){0.f, 0.f, 0.f, 0.f}; }
    if (jb1 < jb0) return;
    unsigned kro[2], vro[2]; int kwo[2], vwo[2];
#pragma unroll
    for (int i = 0; i < 2; ++i) {
        const int idx = tid + 256 * i, row = idx >> 3, ch = idx & 7;
        kro[i] = (unsigned)(row * 64 + ch * 8) * 2u; kwo[i] = row * 128 + ((ch ^ fK(row)) << 4);
        vro[i] = (unsigned)(row * ldv + ch * 8) * 2u; vwo[i] = 8192 + row * 128 + ((ch ^ (row & 7)) << 4);
    }
    u32x4 rk[2], rv[2];
#pragma unroll
    for (int i = 0; i < 2; ++i) { rk[i] = bload16(rs, kro[i], sK + (unsigned)jb0 * 8192u); rv[i] = bload16(rs, vro[i], sV + (unsigned)jb0 * 128u); }
#pragma unroll
    for (int i = 0; i < 2; ++i) { *(u32x4*)(lds + kwo[i]) = rk[i]; *(u32x4*)(lds + vwo[i]) = rv[i]; }
    __syncthreads();
    const int nmax = (tq >= 31) ? ((tq - 31) >> 4) : -1;
    for (int jb = jb0; jb <= jb1; ++jb) {
        unsigned char* cur = lds + ((jb - jb0) & 1) * 16384;
        unsigned char* nxt = lds + ((jb - jb0 + 1) & 1) * 16384;
        const bool more = jb < jb1;
        if (more) {
#pragma unroll
            for (int i = 0; i < 2; ++i) { rk[i] = bload16(rs, kro[i], sK + (unsigned)(jb + 1) * 8192u); rv[i] = bload16(rs, vro[i], sV + (unsigned)(jb + 1) * 128u); }
        }
        bool lane_on = true;
        if (MODE == 1) lane_on = ((selmask >> jb) & 1ull) != 0ull;
        if (MODE == 0) lane_on = (jb * 64 <= nmax);
        if (MODE == 2) lane_on = (jb * 64 + 63 > tq - 512);
        if (__ballot(lane_on) != 0ull) {
#pragma unroll
            for (int c = 0; c < 2; ++c) {
                f32x4 S[2][4];
#pragma unroll
                for (int r2 = 0; r2 < 2; ++r2)
#pragma unroll
                    for (int cf = 0; cf < 4; ++cf) S[r2][cf] = (f32x4){0.f, 0.f, 0.f, 0.f};
#pragma unroll
                for (int r2 = 0; r2 < 2; ++r2) {
                    const int kl = 32 * c + 8 * (cl >> 2) + 4 * r2 + (cl & 3);
#pragma unroll
                    for (int ks = 0; ks < 2; ++ks) {
                        const bf16x8 a = *(const bf16x8*)(cur + kl * 128 + (((ks * 4 + q) ^ (cl & 7)) << 4));
#pragma unroll
                        for (int cf = 0; cf < 4; ++cf) S[r2][cf] = MFMA16(a, qf[cf][ks], S[r2][cf]);
                    }
                }
                bool edge;
                if (MODE == 0) edge = (jb * 64 + 63 > nmax);
                else if (MODE == 1) edge = (jb * 64 + 63 > tq) || !lane_on;
                else edge = (jb * 64 + 63 > tq) || (jb * 64 <= tq - 512);
                const bool need_mask = __ballot(edge) != 0ull;
                bf16x8 pb[4];
#pragma unroll
                for (int cf = 0; cf < 4; ++cf) {
                    if (need_mask) {
#pragma unroll
                        for (int r2 = 0; r2 < 2; ++r2)
#pragma unroll
                            for (int j = 0; j < 4; ++j) {
                                const int key = jb * 64 + 32 * c + 8 * q + 4 * r2 + j;
                                bool v;
                                if (MODE == 0) v = key <= nmax;
                                else if (MODE == 1) v = lane_on && key <= tq;
                                else v = key <= tq && key > tq - 512;
                                if (!v) S[r2][cf][j] = NINF;
                            }
                    }
                    float bm = fmaxf(fmaxf(fmaxf(S[0][cf][0], S[0][cf][1]), fmaxf(S[0][cf][2], S[0][cf][3])), fmaxf(fmaxf(S[1][cf][0], S[1][cf][1]), fmaxf(S[1][cf][2], S[1][cf][3])));
                    bm = rows_max(bm);
                    const float mnew = fmaxf(st.m[cf], bm);
                    const float mref = (mnew == NINF) ? 0.f : mnew;
                    const float alpha = __builtin_amdgcn_exp2f(st.m[cf] - mref);
                    st.m[cf] = mnew;
                    float ps = 0.f;
#pragma unroll
                    for (int r2 = 0; r2 < 2; ++r2)
#pragma unroll
                        for (int j = 0; j < 4; ++j) { const float pv = __builtin_amdgcn_exp2f(S[r2][cf][j] - mref); S[r2][cf][j] = pv; ps += pv; }
                    st.l[cf] = st.l[cf] * alpha + ps;
                    if (__ballot(alpha != 1.0f) != 0ull) {
#pragma unroll
                        for (int d = 0; d < 4; ++d) st.O[d][cf] *= alpha;
                    }
                    pb[cf] = pack8(S[0][cf], S[1][cf]);
                }
#pragma unroll
                for (int d = 0; d < 4; ++d) {
                    const int row = d * 16 + cl;
                    const bf16x8 av = *(const bf16x8*)(cur + 8192 + row * 128 + (((c * 4 + q) ^ (row & 7)) << 4));
#pragma unroll
                    for (int cf = 0; cf < 4; ++cf) st.O[d][cf] = MFMA16(av, pb[cf], st.O[d][cf]);
                }
            }
        }
        if (more) {
#pragma unroll
            for (int i = 0; i < 2; ++i) { *(u32x4*)(nxt + kwo[i]) = rk[i]; *(u32x4*)(nxt + vwo[i]) = rv[i]; }
        }
        __syncthreads();
    }
}

DEVI f32x4 bload16f(rsrc_t r, unsigned voff, unsigned soff) { return __builtin_bit_cast(f32x4, __builtin_amdgcn_raw_buffer_load_b128(r, (int)voff, (int)soff, 0)); }
DEVI void bstore16f(rsrc_t r, f32x4 v, unsigned voff, unsigned soff) { __builtin_amdgcn_raw_buffer_store_b128(__builtin_bit_cast(u32x4, v), r, (int)voff, (int)soff, 0); }
DEVI float bload4f(rsrc_t r, unsigned voff, unsigned soff) { return __builtin_bit_cast(float, __builtin_amdgcn_raw_buffer_load_b32(r, (int)voff, (int)soff, 0)); }

struct NsaUnit { int i, b, k, t0, tq; unsigned tokw, tokb, qoff, goff, ooff, sQ, sG, sO; };
DEVI NsaUnit nsa_unit(int uu, int tid) {
    NsaUnit U;
    const int lane = tid & 63, wid = __builtin_amdgcn_readfirstlane(tid >> 6), q = lane >> 4, cl = lane & 15;
    const int half = uu >> 9, r = uu & 511, bk = r & 15, ii = r >> 4;
    U.i = half ? ii : 63 - ii; U.b = bk >> 1; U.k = bk & 1;
    U.t0 = U.i * 64; U.tq = U.t0 + wid * 16 + cl;
    U.tokw = (unsigned)(wid * 16 + cl);
    U.tokb = (unsigned)(U.b * 4096 + U.t0);
    U.qoff = U.tokw * 1024u + (unsigned)q * 16u;
    U.goff = U.tokw * 96u;
    U.ooff = U.tokw * 1024u + (unsigned)q * 8u;
    U.sQ = U.tokb * 1024u + (unsigned)U.k * 512u;
    U.sG = (unsigned)OFF_GATES + U.tokb * 96u + (unsigned)U.k * 16u;
    U.sO = (unsigned)OFF_OB + U.tokb * 1024u + (unsigned)U.k * 512u;
    return U;
}

DEVI void nsa_cmp_unit(const Params& P, rsrc_t rs, int uu, unsigned char* lds, int tid) {
    const int lane = tid & 63, wid = __builtin_amdgcn_readfirstlane(tid >> 6), q = lane >> 4, cl = lane & 15;
    const NsaUnit U = nsa_unit(uu, tid);
    const int i = U.i, b = U.b, k = U.k, tq = U.tq;
    AttnState st;
    bf16x8 qf[4][2];
#pragma unroll
    for (int cf = 0; cf < 4; ++cf)
#pragma unroll
        for (int ks = 0; ks < 2; ++ks) qf[cf][ks] = __builtin_bit_cast(bf16x8, bload16(rs, U.qoff, (unsigned)OFF_QBN + U.sQ + cf * 128 + ks * 64));
    const unsigned sKC = (unsigned)OFF_KC + (unsigned)(b * 2 + k) * 256u * 128u;
    const unsigned sVC = (unsigned)OFF_VCT + (unsigned)(b * 2 + k) * 64u * 512u;
    const int nmax_blk = (U.t0 + 63 - 31) >> 4;
    const int jbc = (nmax_blk >> 6) < 3 ? (nmax_blk >> 6) : 3;
    attn_blocks<0>(rs, sKC, sVC, 256, 0, jbc, qf, st, tq, 0ull, lds, tid);
    float linv[4], mfin[4];
#pragma unroll
    for (int cf = 0; cf < 4; ++cf) {
        const float l = rows_sum(st.l[cf]);
        linv[cf] = (l > 0.f) ? __builtin_amdgcn_rcpf(l) : 0.f; mfin[cf] = st.m[cf];
        const float sc = linv[cf] * bload4f(rs, U.goff, U.sG + cf * 4);
#pragma unroll
        for (int d = 0; d < 4; ++d) { const f32x4 v = st.O[d][cf] * sc; u32x2 w; w.x = pk2(v[0], v[1]); w.y = pk2(v[2], v[3]);
            __builtin_amdgcn_raw_buffer_store_b64(w, rs, (int)U.ooff, (int)(U.sO + cf * 128 + d * 32), 0); }
    }
    unsigned long long* MSKG = (unsigned long long*)(P.ws + OFF_MASK);
    if (i < 16) {
        if (q == 0) MSKG[((size_t)(b * 2 + k)) * 4096 + tq] = (2ull << i) - 1ull;
        return;
    }
    float* SUM4 = (float*)(lds + 16384);
    float* LAST = (float*)(lds + 32768);
    float* IMP2 = (float*)(lds + 49152);
    const int nmax = (tq >= 31) ? ((tq - 31) >> 4) : -1;
    for (int kb = 0; kb <= jbc; ++kb) {
#pragma unroll
        for (int ii = 0; ii < 2; ++ii) {
            const int idx = tid + 256 * ii, row = idx >> 3, ch = idx & 7;
            *(u32x4*)(lds + row * 128 + ((ch ^ fK(row)) << 4)) = bload16(rs, (unsigned)(row * 64 + ch * 8) * 2u, sKC + (unsigned)kb * 8192u);
        }
        __syncthreads();
#pragma unroll
        for (int rf = 0; rf < 4; ++rf) {
            f32x4 S[4];
#pragma unroll
            for (int cf = 0; cf < 4; ++cf) S[cf] = (f32x4){0.f, 0.f, 0.f, 0.f};
            const int kl = 32 * (rf >> 1) + 8 * (cl >> 2) + 4 * (rf & 1) + (cl & 3);
#pragma unroll
            for (int ks = 0; ks < 2; ++ks) {
                const bf16x8 a = *(const bf16x8*)(lds + kl * 128 + (((ks * 4 + q) ^ (cl & 7)) << 4));
#pragma unroll
                for (int cf = 0; cf < 4; ++cf) S[cf] = MFMA16(a, qf[cf][ks], S[cf]);
            }
            float acc4 = 0.f, accl = 0.f;
#pragma unroll
            for (int j = 0; j < 4; ++j) {
                const int key = kb * 64 + 32 * (rf >> 1) + 8 * q + 4 * (rf & 1) + j;
                float pj = 0.f;
#pragma unroll
                for (int cf = 0; cf < 4; ++cf) pj += __builtin_amdgcn_exp2f(S[cf][j] - mfin[cf]) * linv[cf];
                pj = (key <= nmax) ? pj : 0.f;
                acc4 += pj; if (j == 3) accl = pj;
            }
            const int jblk = kb * 16 + 8 * (rf >> 1) + 2 * q + (rf & 1);
            SUM4[(wid * 16 + cl) * 64 + jblk] = acc4; LAST[(wid * 16 + cl) * 64 + jblk] = accl;
        }
        __syncthreads();
    }
    {
        const int qi = tid >> 2, jg = tid & 3;
        const int jlim = (jbc + 1) * 16;
        for (int jj = 0; jj < 16; ++jj) {
            const int j = jg * 16 + jj;
            float v = (j < jlim) ? SUM4[qi * 64 + j] : 0.f;
            if (j >= 1 && j - 1 < jlim) v += LAST[qi * 64 + j - 1];
            IMP2[qi * 64 + j] = v;
        }
    }
    __syncthreads();
    {
        const int qi = tid >> 2, jg = tid & 3;
        const float* row = IMP2 + qi * 64;
        float kk[64];
#pragma unroll
        for (int j4 = 0; j4 < 16; ++j4) {
            const f32x4 v = *(const f32x4*)(row + j4 * 4);
#pragma unroll
            for (int e = 0; e < 4; ++e) {
                const int j2 = j4 * 4 + e;
                const bool f2 = (j2 == 0) || (j2 == i) || (j2 == i - 1);
                kk[j2] = (j2 > i) ? -__builtin_inff() : (f2 ? __builtin_inff() : v[e]);
            }
        }
        unsigned lo = 0u;
#pragma unroll 1
        for (int jj = 0; jj < 16; ++jj) {
            const int j = jg * 16 + jj;
            float kj = -__builtin_inff();
#pragma unroll
            for (int j2 = 0; j2 < 64; ++j2) kj = (j2 == j) ? kk[j2] : kj;
            int rank = 0;
#pragma unroll
            for (int j2 = 0; j2 < 64; ++j2) rank += (kk[j2] > kj || (kk[j2] == kj && j2 < j)) ? 1 : 0;
            if (j <= i && rank < 16) lo |= (1u << jj);
        }
        unsigned long long bits = (unsigned long long)lo << (jg * 16);
        bits |= __shfl_xor(bits, 1); bits |= __shfl_xor(bits, 2);
        if (jg == 0) MSKG[((size_t)(b * 2 + k)) * 4096 + U.t0 + qi] = bits;
    }
    __syncthreads();
}

template <int MODE>
DEVI void nsa_kv_unit(const Params& P, rsrc_t rs, int uu, unsigned char* lds, int tid) {
    const int lane = tid & 63, q = lane >> 4;
    const NsaUnit U = nsa_unit(uu, tid);
    const int i = U.i, b = U.b, k = U.k, tq = U.tq;
    AttnState st;
    bf16x8 qf[4][2];
#pragma unroll
    for (int cf = 0; cf < 4; ++cf)
#pragma unroll
        for (int ks = 0; ks < 2; ++ks) qf[cf][ks] = __builtin_bit_cast(bf16x8, bload16(rs, U.qoff, (unsigned)OFF_QBR + U.sQ + cf * 128 + ks * 64));
    const unsigned sK = (unsigned)(OFF_KV + (MODE == 1 ? 2 : 4) * KV_STRIDE) + (unsigned)(b * 2 + k) * 4096u * 128u;
    const unsigned sV = (unsigned)(OFF_KV + (MODE == 1 ? 3 : 5) * KV_STRIDE) + (unsigned)(b * 2 + k) * 64u * 8192u;
    unsigned long long mymask = 0ull;
    int j0 = 0;
    if (MODE == 1) mymask = ((const unsigned long long*)(P.ws + OFF_MASK))[((size_t)(b * 2 + k)) * 4096 + tq];
    else j0 = (i >= 8) ? i - 8 : 0;
    attn_blocks<MODE>(rs, sK, sV, 4096, j0, i, qf, st, tq, mymask, lds, tid);
#pragma unroll
    for (int cf = 0; cf < 4; ++cf) {
        const float l = rows_sum(st.l[cf]);
        const float sc = ((l > 0.f) ? __builtin_amdgcn_rcpf(l) : 0.f) * bload4f(rs, U.goff, U.sG + (MODE == 1 ? 32 : 64) + cf * 4);
#pragma unroll
        for (int d = 0; d < 4; ++d) {
            const u32x2 pw = __builtin_bit_cast(u32x2, __builtin_amdgcn_raw_buffer_load_b64(rs, (int)U.ooff, (int)(U.sO + cf * 128 + d * 32), 0));
            f32x4 v = st.O[d][cf] * sc;
            v[0] += bf2f(pw.x & 0xffffu); v[1] += bf2f(pw.x >> 16); v[2] += bf2f(pw.y & 0xffffu); v[3] += bf2f(pw.y >> 16);
            u32x2 w; w.x = pk2(v[0], v[1]); w.y = pk2(v[2], v[3]);
            __builtin_amdgcn_raw_buffer_store_b64(w, rs, (int)U.ooff, (int)(U.sO + cf * 128 + d * 32), 0);
        }
    }
}

DEVI void phase_nsa(const Params& P, unsigned char* lds, int tid) {
    const rsrc_t rs = __builtin_amdgcn_make_buffer_rsrc((void*)P.ws, (short)0, (int)0x7fffffff, 0x00020000);
    for (int uu = blockIdx.x; uu < 1024; uu += gridDim.x) { int t = tid; asm volatile("" : "+v"(t)); nsa_cmp_unit(P, rs, uu, lds, t); }
    __syncthreads();
    for (int uu = blockIdx.x; uu < 1024; uu += gridDim.x) { int t = tid; asm volatile("" : "+v"(t)); nsa_kv_unit<1>(P, rs, uu, lds, t); }
    __syncthreads();
    for (int uu = blockIdx.x; uu < 1024; uu += gridDim.x) { int t = tid; asm volatile("" : "+v"(t)); nsa_kv_unit<2>(P, rs, uu, lds, t); }
}

DEVI void phase_merge(const Params& P, unsigned char* lds, int tid) {
    unsigned char* ws = P.ws;
    const rsrc_t rs = __builtin_amdgcn_make_buffer_rsrc((void*)P.ws, (short)0, (int)0x7fffffff, 0x00020000);
    const bf16_t* ga = (const bf16_t*)(ws + OFF_GA);
    const bf16_t* gb = (const bf16_t*)(ws + OFF_GB);
    bf16_t* mg = (bf16_t*)(ws + OFF_MERGED);
    const int lane = tid & 63, wid = __builtin_amdgcn_readfirstlane(tid >> 6), wr = wid >> 1, wc = wid & 1, q = lane >> 4, cl = lane & 15;
    for (int kk = 0;; ++kk) {
        int mt, nt;
        if (!tile_map(kk, 8, mt, nt)) break;
        f32x4 acc[4][4];
        unsigned t[4][4][2];
        gemm128(acc, rs, (unsigned)(OFF_OA + (size_t)mt * 128 * 1024), RowLin{1024}, (unsigned)(OFF_WBRA + (size_t)nt * 128 * 1024), RowLin{1024}, 8, lds, tid);
        const size_t e0 = (size_t)(mt * 128 + wr * 64 + cl) * 1024 + nt * 128 + wc * 64 + q * 4;
#pragma unroll
        for (int m = 0; m < 4; ++m)
#pragma unroll
            for (int n = 0; n < 4; ++n) {
                const u32x2 gv = *(const u32x2*)(ga + e0 + (size_t)m * 16 * 1024 + n * 16);
                t[m][n][0] = pk2(acc[m][n][0] * bf2f(gv.x & 0xffffu), acc[m][n][1] * bf2f(gv.x >> 16));
                t[m][n][1] = pk2(acc[m][n][2] * bf2f(gv.y & 0xffffu), acc[m][n][3] * bf2f(gv.y >> 16));
            }
        gemm128(acc, rs, (unsigned)(OFF_OB + (size_t)mt * 128 * 1024), RowLin{1024}, (unsigned)(OFF_WBRB + (size_t)nt * 128 * 1024), RowLin{1024}, 8, lds, tid);
#pragma unroll
        for (int m = 0; m < 4; ++m)
#pragma unroll
            for (int n = 0; n < 4; ++n) {
                const size_t o = e0 + (size_t)m * 16 * 1024 + n * 16;
                const u32x2 gv = *(const u32x2*)(gb + o);
                u32x2 w;
                w.x = pk2(bf2f(t[m][n][0] & 0xffffu) + acc[m][n][0] * bf2f(gv.x & 0xffffu), bf2f(t[m][n][0] >> 16) + acc[m][n][1] * bf2f(gv.x >> 16));
                w.y = pk2(bf2f(t[m][n][1] & 0xffffu) + acc[m][n][2] * bf2f(gv.y & 0xffffu), bf2f(t[m][n][1] >> 16) + acc[m][n][3] * bf2f(gv.y >> 16));
                *(u32x2*)(mg + o) = w;
            }
    }
}

DEVI void phase_outproj(const Params& P, unsigned char* lds, int tid) {
    unsigned char* ws = P.ws;
    const rsrc_t rs = __builtin_amdgcn_make_buffer_rsrc((void*)P.ws, (short)0, (int)0x7fffffff, 0x00020000);
    const bf16_t* mg = (const bf16_t*)(ws + OFF_MERGED);
    const bf16_t* wo = (const bf16_t*)(ws + OFF_WOUT);
    const float* x = P.in[0];
    float* x1 = P.out;
    const int lane = tid & 63, wid = __builtin_amdgcn_readfirstlane(tid >> 6), wr = wid >> 1, wc = wid & 1, q = lane >> 4, cl = lane & 15;
    for (int kk = 0;; ++kk) {
        int mt, nt;
        if (!tile_map(kk, 8, mt, nt)) break;
        f32x4 acc[4][4];
        gemm128(acc, rs, (unsigned)(OFF_MERGED + (size_t)mt * 128 * 2048), RowLin{2048}, (unsigned)(OFF_WOUT + (size_t)nt * 128 * 2048), RowLin{2048}, 16, lds, tid);
#pragma unroll
        for (int m = 0; m < 4; ++m)
#pragma unroll
            for (int n = 0; n < 4; ++n) {
                const size_t o = (size_t)(mt * 128 + wr * 64 + m * 16 + cl) * 1024 + nt * 128 + wc * 64 + n * 16 + q * 4;
                *(f32x4*)(x1 + o) = *(const f32x4*)(x + o) + acc[m][n];
            }
    }
}

DEVI void phase_router(const Params& P, unsigned char* lds, int tid) {
    unsigned char* ws = P.ws;
    const int lane = tid & 63, wid = __builtin_amdgcn_readfirstlane(tid >> 6), q = lane >> 4, cl = lane & 15;
    const float* x1 = P.out; const float* g = P.in[13];
    const float* bg = P.in[15]; const float* be = P.in[17];
    const float* WR = (const float*)(ws + OFF_WR);
    bf16_t* h2 = (bf16_t*)(ws + OFF_HN);
    unsigned* cnt = (unsigned*)(ws + OFF_CTL);
    int* list = (int*)(ws + OFF_LIST);
    float* wt = (float*)(ws + OFF_WT);
    float* WL = (float*)lds;
    float* LG = (float*)(lds + 50688);
    float* RS = (float*)(lds + 50688 + 12288);
    for (int u = blockIdx.x; u < NTOK / 64; u += gridDim.x) {
        const int row0 = u * 64 + wid * 16;
        const float* xa = x1 + (size_t)(row0 + cl) * 1024 + 4 * q;
        f32x4 acc[3];
#pragma unroll
        for (int ct = 0; ct < 3; ++ct) acc[ct] = (f32x4){0.f, 0.f, 0.f, 0.f};
        float ss = 0.f;
        for (int kc = 0; kc < 4; ++kc) {
            __syncthreads();
#pragma unroll
            for (int i = 0; i < 12; ++i) {
                const int idx = tid + 256 * i, r = idx >> 6, c4 = idx & 63;
                *(f32x4*)(WL + r * 264 + c4 * 4) = *(const f32x4*)(WR + (size_t)r * 1024 + kc * 256 + c4 * 4);
            }
            __syncthreads();
#pragma unroll
            for (int jh = 0; jh < 2; ++jh) {
                f32x4 av[8];
#pragma unroll
                for (int j = 0; j < 8; ++j) av[j] = *(const f32x4*)(xa + kc * 256 + (jh * 8 + j) * 16);
#pragma unroll
                for (int j = 0; j < 8; ++j) {
                    {
                        const int kx = kc * 256 + (jh * 8 + j) * 16 + 4 * q;
                        const f32x4 gg = *(const f32x4*)(g + kx);
                        u32x2 w; w.x = pk2(av[j][0] * gg[0], av[j][1] * gg[1]); w.y = pk2(av[j][2] * gg[2], av[j][3] * gg[3]);
                        *(u32x2*)(h2 + (size_t)(row0 + cl) * 1024 + kx) = w;
                    }
                    ss += av[j][0] * av[j][0] + av[j][1] * av[j][1] + av[j][2] * av[j][2] + av[j][3] * av[j][3];
#pragma unroll
                    for (int ct = 0; ct < 3; ++ct) {
                        const f32x4 bv = *(const f32x4*)(WL + (ct * 16 + cl) * 264 + (jh * 8 + j) * 16 + 4 * q);
#pragma unroll
                        for (int e = 0; e < 4; ++e) acc[ct] = __builtin_amdgcn_mfma_f32_16x16x4f32(av[j][e], bv[e], acc[ct], 0, 0, 0);
                    }
                }
            }
        }
        ss += __shfl_xor(ss, 16); ss += __shfl_xor(ss, 32);
        const float rs = rsqrtf(ss * (1.0f / 1024.0f) + RMS_EPS);
        if (q == 0) { RS[wid * 16 + cl] = rs; ((float*)(ws + OFF_RS))[row0 + cl] = rs; }
        __syncthreads();
#pragma unroll
        for (int j = 0; j < 4; ++j) {
            const float rj = RS[wid * 16 + 4 * q + j];
#pragma unroll
            for (int ct = 0; ct < 3; ++ct) LG[(wid * 16 + 4 * q + j) * 48 + ct * 16 + cl] = acc[ct][j] * rj;
        }
        __syncthreads();
        if (tid < 64) {
            const int r = u * 64 + tid;
            const float* lg = LG + tid * 48;
            float gl[4];
#pragma unroll
            for (int e = 0; e < 4; ++e) gl[e] = lg[e] + bg[e];
            int gs = 0; float gm = gl[0];
#pragma unroll
            for (int e = 1; e < 4; ++e) if (gl[e] > gm) { gm = gl[e]; gs = e; }
            float den = 0.f;
#pragma unroll
            for (int e = 0; e < 4; ++e) den += __expf(gl[e] - gm);
            const float gp = 1.0f / den;
            float el[8];
#pragma unroll
            for (int e = 0; e < 8; ++e) el[e] = lg[4 + gs * 8 + e] + be[gs * 8 + e];
            int i0 = 0; float v0 = el[0];
#pragma unroll
            for (int e = 1; e < 8; ++e) if (el[e] > v0) { v0 = el[e]; i0 = e; }
            int i1 = -1; float v1 = -__builtin_inff();
#pragma unroll
            for (int e = 0; e < 8; ++e) if (e != i0 && el[e] > v1) { v1 = el[e]; i1 = e; }
            const float e1 = __expf(v1 - v0);
            const float w0 = gp / (1.0f + e1), w1 = gp * e1 / (1.0f + e1);
            const int ex0 = gs * 8 + i0, ex1 = gs * 8 + i1;
            const unsigned p0 = atomicAdd(&cnt[ex0], 1u);
            list[(size_t)ex0 * NTOK + p0] = r * 2 + 0;
            const unsigned p1 = atomicAdd(&cnt[ex1], 1u);
            list[(size_t)ex1 * NTOK + p1] = r * 2 + 1;
            wt[(size_t)r * 2 + 0] = w0; wt[(size_t)r * 2 + 1] = w1;
        }
    }
}

struct RowGather { const int* idx; DEVI unsigned operator()(int r) const { return (unsigned)idx[r] * 2048u; } };
struct RowGU { int c0; DEVI unsigned operator()(int r) const {
    const int wcx = r >> 6, w = r & 63; const int col = (w < 32) ? (c0 + wcx * 32 + w) : (256 + c0 + wcx * 32 + (w - 32)); return (unsigned)col * 2048u; } };

DEVI int moe_find_tile(const unsigned* cnt, int u, int& e, int& tl) {
    int t = u, ee = 0, ce = 0;
    for (; ee < 32; ++ee) { ce = (int)cnt[ee]; const int nt = (ce + 127) >> 7; if (t < nt) break; t -= nt; }
    e = ee; tl = t; return ce;
}
DEVI void phase_moe_a(const Params& P, unsigned char* lds, int tid) {
    unsigned char* ws = P.ws;
    const rsrc_t rs = __builtin_amdgcn_make_buffer_rsrc((void*)P.ws, (short)0, (int)0x7fffffff, 0x00020000);
    const int lane = tid & 63, wid = __builtin_amdgcn_readfirstlane(tid >> 6), wr = wid >> 1, wc = wid & 1, q = lane >> 4, cl = lane & 15;
    const unsigned* cnt = (const unsigned*)(ws + OFF_CTL);
    const int* list = (const int*)(ws + OFF_LIST);
    bf16_t* act = (bf16_t*)(ws + OFF_ACT);
    int* rowtok = (int*)(lds + 65536);
    const float* RSG = (const float*)(ws + OFF_RS);
    int total = 0;
    for (int e = 0; e < 32; ++e) total += ((int)cnt[e] + 127) >> 7;
    for (int v = blockIdx.x; v < total * 4; v += gridDim.x) {
        const int u = v >> 2, nt = v & 3;
        int e, tl; const int ce = moe_find_tile(cnt, u, e, tl);
        if (tid < 128) { const int r = tl * 128 + tid; rowtok[tid] = (r < ce) ? (list[(size_t)e * NTOK + r] >> 1) : 0; }
        __syncthreads();
        bf16_t* au = act + (size_t)u * 128 * 256;
        f32x4 acc[4][4];
        gemm128(acc, rs, (unsigned)OFF_HN, RowGather{rowtok}, (unsigned)(OFF_WGU + (size_t)e * 512 * 2048), RowGU{nt * 64}, 16, lds, tid);
#pragma unroll
        for (int m = 0; m < 4; ++m)
#pragma unroll
            for (int n = 0; n < 2; ++n) {
                const int row = wr * 64 + m * 16 + cl, col = nt * 64 + wc * 32 + n * 16 + q * 4;
                const float rsv = RSG[rowtok[row]];
                const f32x4 gt = acc[m][n] * rsv, up = acc[m][n + 2] * rsv;
                u32x2 w;
                w.x = pk2(siluf_(gt[0]) * up[0], siluf_(gt[1]) * up[1]);
                w.y = pk2(siluf_(gt[2]) * up[2], siluf_(gt[3]) * up[3]);
                *(u32x2*)(au + (size_t)row * 256 + col) = w;
            }
        __syncthreads();
    }
}
DEVI void phase_moe_b(const Params& P, unsigned char* lds, int tid) {
    unsigned char* ws = P.ws;
    const rsrc_t rs = __builtin_amdgcn_make_buffer_rsrc((void*)P.ws, (short)0, (int)0x7fffffff, 0x00020000);
    const int lane = tid & 63, wid = __builtin_amdgcn_readfirstlane(tid >> 6), wr = wid >> 1, wc = wid & 1, q = lane >> 4, cl = lane & 15;
    const unsigned* cnt = (const unsigned*)(ws + OFF_CTL);
    const int* list = (const int*)(ws + OFF_LIST);
    bf16_t* Y = (bf16_t*)(ws + OFF_Y);
    int* rowas = (int*)(lds + 65536);
    int total = 0;
    for (int e = 0; e < 32; ++e) total += ((int)cnt[e] + 127) >> 7;
    for (int v = blockIdx.x; v < total * 4; v += gridDim.x) {
        const int u = v >> 2, np = v & 3;
        int e, tl; const int ce = moe_find_tile(cnt, u, e, tl);
        if (tid < 128) { const int r = tl * 128 + tid; rowas[tid] = (r < ce) ? list[(size_t)e * NTOK + r] : -1; }
        __syncthreads();
        for (int h = 0; h < 2; ++h) {
            const int nt = np * 2 + h;
            f32x4 acc[4][4];
            gemm128(acc, rs, (unsigned)(OFF_ACT + (size_t)u * 128 * 512), RowLin{512}, (unsigned)(OFF_WDN + (size_t)e * 1024 * 512 + (size_t)nt * 128 * 512), RowLin{512}, 4, lds, tid);
#pragma unroll
            for (int m = 0; m < 4; ++m) {
                const int row = wr * 64 + m * 16 + cl;
                const int as = rowas[row];
                if (as >= 0) {
                    bf16_t* yr = Y + ((size_t)(as & 1) * NTOK + (as >> 1)) * 1024 + nt * 128 + wc * 64 + q * 4;
#pragma unroll
                    for (int n = 0; n < 4; ++n) { u32x2 w; w.x = pk2(acc[m][n][0], acc[m][n][1]); w.y = pk2(acc[m][n][2], acc[m][n][3]); *(u32x2*)(yr + n * 16) = w; }
                }
            }
        }
        __syncthreads();
    }
}

DEVI void phase_final(const Params& P, int tid, bool with_moe) {
    unsigned char* ws = P.ws;
    const int lane = tid & 63, wid = __builtin_amdgcn_readfirstlane(tid >> 6);
    const bf16_t* Y = (const bf16_t*)(ws + OFF_Y);
    const float* wt = (const float*)(ws + OFF_WT);
    const float* g = P.in[20];
    float* out = P.out;
    for (int r = blockIdx.x * 4 + wid; r < NTOK; r += gridDim.x * 4) {
        float* xr = out + (size_t)r * 1024;
        const float w0 = with_moe ? wt[(size_t)r * 2] : 0.f, w1 = with_moe ? wt[(size_t)r * 2 + 1] : 0.f;
        f32x4 v[4]; float ss = 0.f;
#pragma unroll
        for (int i = 0; i < 4; ++i) {
            v[i] = *(const f32x4*)(xr + i * 256 + lane * 4);
            if (with_moe) {
                const u32x2 a = *(const u32x2*)(Y + (size_t)r * 1024 + i * 256 + lane * 4);
                const u32x2 b = *(const u32x2*)(Y + ((size_t)NTOK + r) * 1024 + i * 256 + lane * 4);
                v[i][0] += w0 * bf2f(a.x & 0xffffu) + w1 * bf2f(b.x & 0xffffu); v[i][1] += w0 * bf2f(a.x >> 16) + w1 * bf2f(b.x >> 16);
                v[i][2] += w0 * bf2f(a.y & 0xffffu) + w1 * bf2f(b.y & 0xffffu); v[i][3] += w0 * bf2f(a.y >> 16) + w1 * bf2f(b.y >> 16);
            }
            ss += v[i][0] * v[i][0] + v[i][1] * v[i][1] + v[i][2] * v[i][2] + v[i][3] * v[i][3];
        }
        ss = wave_sum(ss);
        const float rs = rsqrtf(ss * (1.0f / 1024.0f) + RMS_EPS);
#pragma unroll
        for (int i = 0; i < 4; ++i) {
            const f32x4 gg = *(const f32x4*)(g + i * 256 + lane * 4);
            f32x4 o; o[0] = v[i][0] * rs * gg[0]; o[1] = v[i][1] * rs * gg[1]; o[2] = v[i][2] * rs * gg[2]; o[3] = v[i][3] * rs * gg[3];
            *(f32x4*)(xr + i * 256 + lane * 4) = o;
        }
    }
}

#define LAUNDER_TID() do { tid = wave_id * 64 + (int)__builtin_amdgcn_mbcnt_hi(~0u, __builtin_amdgcn_mbcnt_lo(~0u, 0u)); asm volatile("" : "+v"(tid)); } while (0)
__global__ void __launch_bounds__(NTHREADS, 2) fwd_megakernel(Params P) {
    extern __shared__ __attribute__((aligned(16))) unsigned char lds[];
    cg::grid_group grid = cg::this_grid();
    int tid;
    const int wave_id = __builtin_amdgcn_readfirstlane((int)(threadIdx.x >> 6));
    volatile LAS unsigned* bst = (volatile LAS unsigned*)(LAS unsigned char*)(lds + LDS_BYTES - 16);
    if (threadIdx.x < 4) bst[threadIdx.x] = 0u;
    __syncthreads();
    (void)xcd_barrier_post((unsigned*)(P.ws + OFF_BAR), bst);
#define GRID_BARRIER() do { XcdBarrier b_; b_.bar = (unsigned*)(P.ws + OFF_BAR); b_.x = xb_xcc_id(); b_.st = (volatile LAS unsigned*)(LAS unsigned char*)(lds + LDS_BYTES - 16); xcd_barrier(b_); } while (0)
    if (P.ph_lo != 0) grid.sync();
    LAUNDER_TID(); phase_prep(P, lds, tid, 0); __syncthreads();
    GRID_BARRIER();
    {
        const int first_idx = (blockIdx.x >> 8) & 1;
        for (int step = 0; step < 3; ++step) {
            const int what = (step == 0) ? 0 : 1 + ((step - 1) ^ first_idx);
            if (what <= 1) { LAUNDER_TID(); phase_gemm1(P, lds, tid, what); }
            else {
                LAUNDER_TID(); phase_prep(P, lds, tid, 1); __syncthreads();
                LAUNDER_TID(); phase_compress(P, lds, tid); __syncthreads();
                LAUNDER_TID(); phase_index(P, lds, tid);
            }
            __syncthreads();
            if (step == 0) GRID_BARRIER();
        }
    }
    GRID_BARRIER();
    if (((blockIdx.x >> 8) & 1) == 0) { LAUNDER_TID(); phase_dsa(P, lds, tid); __syncthreads(); }
    LAUNDER_TID(); phase_nsa(P, lds, tid); __syncthreads();
    if (((blockIdx.x >> 8) & 1) != 0) { LAUNDER_TID(); phase_dsa(P, lds, tid); __syncthreads(); }
    GRID_BARRIER();
    LAUNDER_TID(); phase_merge(P, lds, tid);
    GRID_BARRIER();
    LAUNDER_TID(); phase_outproj(P, lds, tid);
    GRID_BARRIER();
    LAUNDER_TID(); phase_router(P, lds, tid);
    GRID_BARRIER();
    LAUNDER_TID(); phase_moe_a(P, lds, tid);
    GRID_BARRIER();
    LAUNDER_TID(); phase_moe_b(P, lds, tid);
    GRID_BARRIER();
    LAUNDER_TID(); phase_final(P, tid, true);
}

extern "C" void kernel_launch(void* const* d_in, const int* in_sizes, int n_in, void* d_out, int out_size, void* d_ws, size_t ws_size,
                              hipStream_t stream) {
    static int grid_blocks = 0;
    if (!grid_blocks) {
        int dev = 0, cus = 0, per_cu = 0;
        hipGetDevice(&dev);
        hipDeviceGetAttribute(&cus, hipDeviceAttributeMultiprocessorCount, dev);
        hipFuncSetAttribute((const void*)fwd_megakernel, hipFuncAttributeMaxDynamicSharedMemorySize, LDS_BYTES);
        hipOccupancyMaxActiveBlocksPerMultiprocessor(&per_cu, (const void*)fwd_megakernel, NTHREADS, LDS_BYTES);
        if (per_cu < 1) per_cu = 1;
        if (per_cu > 2) per_cu = 2;
        grid_blocks = cus * per_cu;
        if (ws_size < WS_END) fprintf(stderr, "kernel_launch: workspace too small: %zu < %zu\n", ws_size, (size_t)WS_END);
    }
    Params p{};
    for (int i = 0; i < 21; ++i) p.in[i] = (const float*)d_in[i];
    p.pos = (const int*)d_in[1];
    p.out = (float*)d_out;
    p.ws = (unsigned char*)d_ws;
    for (int i = 0; i < 32; ++i) p.inv_freq[i] = (double)powf(10000.0f, -(float)i / 32.0f);
    p.ph_lo = 0; p.ph_hi = 0;
    (void)hipMemsetAsync(d_ws, 0, OFF_WIN_T, stream);
    void* args[] = {&p};
    hipError_t e = hipLaunchCooperativeKernel((const void*)fwd_megakernel, dim3(grid_blocks), dim3(NTHREADS), args, LDS_BYTES, stream);
    if (e != hipSuccess) fprintf(stderr, "cooperative launch failed: %s (grid %d)\n", hipGetErrorString(e), grid_blocks);
}
```

```cpp
#include <hip/hip_runtime.h>
#include <hip/hip_cooperative_groups.h>
#include <cstdint>
#include <cstdio>
#include <cmath>
namespace cg = cooperative_groups;

#define DEVI __device__ __forceinline__
#ifndef PROBE_TWICE
#define PROBE_TWICE 0
#endif
#define REPS(k) ((PROBE_TWICE == (k)) ? 2 : 1)
typedef unsigned short bf16_t;
typedef short bf16x8 __attribute__((ext_vector_type(8)));
typedef short s16x4 __attribute__((ext_vector_type(4)));
typedef float f32x4 __attribute__((ext_vector_type(4)));
typedef float f32x2 __attribute__((ext_vector_type(2)));
typedef unsigned u32x4 __attribute__((ext_vector_type(4)));
typedef unsigned u32x2 __attribute__((ext_vector_type(2)));
#define LAS __attribute__((address_space(3)))

constexpr int NB = 8, SL = 4096, DM = 1024, NTOK = NB * SL;
constexpr int INW = 4288;
constexpr int NTHREADS = 256;
constexpr int LDS_BYTES = 81920;
constexpr float RMS_EPS = 1e-6f;
constexpr float LOG2E = 1.4426950408889634f;

constexpr int WIN_ROWS = 4352;
constexpr int G1_COLS = 4352;

constexpr size_t al256(size_t x) { return (x + 255) & ~(size_t)255; }
constexpr size_t OFF_CTL   = 0;
constexpr size_t OFF_BAR   = 4096;
constexpr size_t OFF_WIN_T = 32768;
constexpr size_t OFF_WBRA  = OFF_WIN_T + (size_t)WIN_ROWS * 1024 * 2;
constexpr size_t OFF_WBRB  = OFF_WBRA + (size_t)1024 * 512 * 2;
constexpr size_t OFF_WOUT  = OFF_WBRB + (size_t)1024 * 512 * 2;
constexpr size_t OFF_W1K   = OFF_WOUT + (size_t)1024 * 1024 * 2;
constexpr size_t OFF_W1V   = OFF_W1K + (size_t)128 * 2048 * 2;
constexpr size_t OFF_W2K   = OFF_W1V + (size_t)128 * 2048 * 2;
constexpr size_t OFF_W2V   = OFF_W2K + (size_t)64 * 128 * 2;
constexpr size_t OFF_WGU   = OFF_W2V + (size_t)64 * 128 * 2;
constexpr size_t OFF_WDN   = OFF_WGU + (size_t)32 * 512 * 1024 * 2;
constexpr size_t OFF_BIAS1 = OFF_WDN + (size_t)32 * 1024 * 256 * 2;
constexpr size_t OFF_WR    = OFF_BIAS1 + 1024;
constexpr size_t OFF_CS    = OFF_WR + (size_t)48 * 1024 * 4;
constexpr size_t OFF_HN    = OFF_CS + (size_t)NTOK * 32 * 8;
constexpr size_t OFF_QA    = OFF_HN + (size_t)NTOK * 1024 * 2;
constexpr size_t OFF_KA    = OFF_QA + (size_t)NTOK * 512 * 2;
constexpr size_t OFF_VA    = OFF_KA + (size_t)NTOK * 64 * 2;
constexpr size_t OFF_QI    = OFF_VA + (size_t)NTOK * 64 * 2;
constexpr size_t OFF_KI    = OFF_QI + (size_t)NTOK * 256 * 2;
constexpr size_t OFF_WI    = OFF_KI + (size_t)NTOK * 32 * 2;
constexpr size_t OFF_QBN   = OFF_WI + (size_t)NTOK * 8 * 4;
constexpr size_t OFF_QBR   = OFF_QBN + (size_t)NTOK * 512 * 2;
constexpr size_t KV_STRIDE = (size_t)NTOK * 128 * 2 + 65536 * 4;
constexpr size_t OFF_KV    = OFF_QBR + (size_t)NTOK * 512 * 2;
constexpr size_t OFF_GATES = OFF_KV + 6 * KV_STRIDE;
constexpr size_t OFF_QKV_END = OFF_GATES + (size_t)NTOK * 24 * 4;
constexpr size_t OFF_KC    = al256(OFF_QKV_END);
constexpr size_t OFF_VCT   = OFF_KC + (size_t)16 * 256 * 64 * 2;
constexpr size_t OFF_SEL   = OFF_VCT + (size_t)16 * 256 * 64 * 2;
constexpr size_t OFF_OA    = OFF_HN;
constexpr size_t OFF_OB    = OFF_OA + (size_t)NTOK * 512 * 2;
constexpr size_t OFF_GA    = OFF_SEL + (size_t)NTOK * 256 * 2;
constexpr size_t OFF_GB    = OFF_GA + (size_t)NTOK * 1024 * 2;
constexpr size_t OFF_MASK  = OFF_GB + (size_t)NTOK * 1024 * 2;
constexpr size_t OFF_LIST  = OFF_MASK + (size_t)16 * 4096 * 8;
constexpr size_t OFF_WT    = OFF_LIST + (size_t)32 * NTOK * 4;
constexpr size_t OFF_RS    = OFF_WT + (size_t)NTOK * 2 * 4;
constexpr size_t WS_END    = OFF_RS + (size_t)NTOK * 4;
constexpr size_t OFF_MERGED = OFF_QA;
constexpr size_t OFF_ACT    = OFF_QA;
constexpr size_t OFF_Y      = OFF_QA + (size_t)40 * 1024 * 1024;
static_assert(OFF_Y + (size_t)2 * NTOK * 1024 * 2 <= OFF_QKV_END, "Y overlay");
static_assert((size_t)544 * 128 * 256 * 2 <= (size_t)40 * 1024 * 1024, "ACT overlay");

struct Params {
    const float* in[21];
    const int* pos;
    float* out;
    unsigned char* ws;
    double inv_freq[32];
    int ph_lo, ph_hi;
};

DEVI unsigned f2bf(float f) { unsigned u = __float_as_uint(f); return (u + 0x7fffu + ((u >> 16) & 1u)) >> 16; }
typedef __bf16 bf16v2_t __attribute__((ext_vector_type(2)));
DEVI unsigned pk2(float lo, float hi) { const f32x2 v = {lo, hi}; return __builtin_bit_cast(unsigned, __builtin_convertvector(v, bf16v2_t)); }
DEVI float rows_max(float x) {
    float a = x, b = x;
    asm volatile("v_nop\n\tv_nop\n\tv_permlane16_swap_b32 %0, %1" : "+v"(a), "+v"(b));
    x = fmaxf(a, b); a = x; b = x;
    asm volatile("v_nop\n\tv_nop\n\tv_permlane32_swap_b32 %0, %1" : "+v"(a), "+v"(b));
    return fmaxf(a, b);
}
DEVI float rows_sum(float x) {
    float a = x, b = x;
    asm volatile("v_nop\n\tv_nop\n\tv_permlane16_swap_b32 %0, %1" : "+v"(a), "+v"(b));
    x = a + b; a = x; b = x;
    asm volatile("v_nop\n\tv_nop\n\tv_permlane32_swap_b32 %0, %1" : "+v"(a), "+v"(b));
    return a + b;
}
DEVI float bf2f(unsigned h) { return __uint_as_float(h << 16); }
DEVI float sigmoidf_(float x) { return __builtin_amdgcn_rcpf(1.0f + __builtin_amdgcn_exp2f(-x * 1.4426950408889634f)); }
DEVI float wave_sum(float v) {
#pragma unroll
    for (int o = 32; o > 0; o >>= 1) v += __shfl_xor(v, o);
    return v;
}
DEVI int wave_sum_i32(int v) {
    v += __builtin_amdgcn_update_dpp(0, v, 0xB1, 0xF, 0xF, true);
    v += __builtin_amdgcn_update_dpp(0, v, 0x4E, 0xF, 0xF, true);
    v += __builtin_amdgcn_update_dpp(0, v, 0x141, 0xF, 0xF, true);
    v += __builtin_amdgcn_update_dpp(0, v, 0x140, 0xF, 0xF, true);
    return __builtin_amdgcn_readlane(v, 0) + __builtin_amdgcn_readlane(v, 16) + __builtin_amdgcn_readlane(v, 32) + __builtin_amdgcn_readlane(v, 48);
}
DEVI float wave_sum_f32_dpp(float v) {
    v += __builtin_bit_cast(float, __builtin_amdgcn_update_dpp(0, __builtin_bit_cast(int, v), 0xB1, 0xF, 0xF, true));
    v += __builtin_bit_cast(float, __builtin_amdgcn_update_dpp(0, __builtin_bit_cast(int, v), 0x4E, 0xF, 0xF, true));
    v += __builtin_bit_cast(float, __builtin_amdgcn_update_dpp(0, __builtin_bit_cast(int, v), 0x141, 0xF, 0xF, true));
    v += __builtin_bit_cast(float, __builtin_amdgcn_update_dpp(0, __builtin_bit_cast(int, v), 0x140, 0xF, 0xF, true));
    const int iv = __builtin_bit_cast(int, v);
    return (__builtin_bit_cast(float, __builtin_amdgcn_readlane(iv, 0)) + __builtin_bit_cast(float, __builtin_amdgcn_readlane(iv, 16))) +
           (__builtin_bit_cast(float, __builtin_amdgcn_readlane(iv, 32)) + __builtin_bit_cast(float, __builtin_amdgcn_readlane(iv, 48)));
}
DEVI bf16x8 pack8(const f32x4& a, const f32x4& b) {
    u32x4 w; w.x = pk2(a[0], a[1]); w.y = pk2(a[2], a[3]); w.z = pk2(b[0], b[1]); w.w = pk2(b[2], b[3]);
    return __builtin_bit_cast(bf16x8, w);
}
#define MFMA16(a, b, c) __builtin_amdgcn_mfma_f32_16x16x32_bf16((a), (b), (c), 0, 0, 0)


#define XB_TMO      128
#define XB_XCNT(j)  (256  + 64 * (j))
#define XB_XSUB(j)  (1280 + 64 * (j))
#define XB_XGEN(j)  (2304 + 64 * (j))
#define XB_TOP      3328
#define XB_TOPGEN   3392
#define XCD_BAR_WORDS 3456
#define XB_SPIN_CAP (1u << 22)
DEVI unsigned xb_ld(unsigned* p)              { return __hip_atomic_load(p, __ATOMIC_RELAXED, __HIP_MEMORY_SCOPE_AGENT); }
DEVI unsigned xb_add(unsigned* p, unsigned v) { return __hip_atomic_fetch_add(p, v, __ATOMIC_RELAXED, __HIP_MEMORY_SCOPE_AGENT); }
DEVI unsigned xb_xcc_id() { return (unsigned)__builtin_amdgcn_s_getreg((3 << 11) | 20) & 0xFu; }
#define XB_SPIN(cond, bar) do { unsigned _sp = 0; while (cond) { __builtin_amdgcn_s_sleep(1); \
    if ((++_sp & 255u) == 0u) { if (xb_ld(&(bar)[XB_TMO])) break; if (_sp > XB_SPIN_CAP) { atomicAdd(&(bar)[XB_TMO], 1u); break; } } } } while (0)
struct XcdBarrier { unsigned* bar; unsigned x; volatile LAS unsigned* st; };
DEVI XcdBarrier xcd_barrier_post(unsigned* bar, volatile LAS unsigned* st) {
    XcdBarrier b; b.bar = bar; b.x = xb_xcc_id(); b.st = st;
    if (threadIdx.x == 0) (void)xb_add(&bar[XB_XCNT(b.x)], 1u);
    return b;
}
DEVI void xcd_barrier_complete(unsigned* bar, unsigned x, unsigned& nloc, unsigned& nx) {
    const unsigned G = gridDim.x * gridDim.y * gridDim.z;
    unsigned sum, cnt, mine, sp = 0u;
    for (;;) {
        sum = 0u; cnt = 0u; mine = 0u;
#pragma unroll
        for (unsigned j = 0; j < 16; ++j) { const unsigned c = xb_ld(&bar[XB_XCNT(j)]); sum += c; cnt += (c > 0u) ? 1u : 0u; mine = (j == x) ? c : mine; }
        if (sum == G) break;
        __builtin_amdgcn_s_sleep(1);
        if ((++sp & 255u) == 0u) { if (xb_ld(&bar[XB_TMO])) break; if (sp > XB_SPIN_CAP) { atomicAdd(&bar[XB_TMO], 1u); break; } }
    }
    nloc = mine > 0u ? mine : 1u; nx = cnt > 0u ? cnt : 1u;
}
DEVI void xcd_barrier(const XcdBarrier& b) {
    asm volatile("s_waitcnt vmcnt(0)" ::: "memory");
    __syncthreads();
    if (threadIdx.x == 0) {
        unsigned* bar = b.bar;
        __builtin_amdgcn_s_waitcnt(0);
        unsigned nloc = b.st[0], nx = b.st[1];
        if (nloc == 0u) { xcd_barrier_complete(bar, b.x, nloc, nx); b.st[0] = nloc; b.st[1] = nx; }
        const unsigned old = xb_add(&bar[XB_XSUB(b.x)], 1u);
        const unsigned gen = old / nloc;
        if (old + 1u == (gen + 1u) * nloc) {
            __builtin_amdgcn_fence(__ATOMIC_RELEASE, "agent");
            asm volatile("s_waitcnt vmcnt(0)" ::: "memory");
            const unsigned og = xb_add(&bar[XB_TOP], 1u);
            const unsigned tg = og / nx;
            if (og + 1u == (tg + 1u) * nx) xb_add(&bar[XB_TOPGEN], 1u);
            else XB_SPIN(xb_ld(&bar[XB_TOPGEN]) == tg, bar);
            __builtin_amdgcn_fence(__ATOMIC_ACQUIRE, "agent");
            xb_add(&bar[XB_XGEN(b.x)], 1u);
            asm volatile("s_waitcnt vmcnt(0)" ::: "memory");
        } else {
            XB_SPIN(xb_ld(&bar[XB_XGEN(b.x)]) == gen, bar);
            __builtin_amdgcn_fence(__ATOMIC_ACQUIRE, "agent");
            asm volatile("s_waitcnt vmcnt(0)" ::: "memory");
        }
    }
    __syncthreads();
}

typedef __amdgpu_buffer_rsrc_t rsrc_t;
DEVI u32x4 bload16(rsrc_t r, unsigned voff, unsigned soff) { return __builtin_bit_cast(u32x4, __builtin_amdgcn_raw_buffer_load_b128(r, (int)voff, (int)soff, 0)); }
DEVI void glds16(rsrc_t r, unsigned char* lds_dst_uniform, unsigned voff, unsigned soff) {
    __builtin_amdgcn_raw_ptr_buffer_load_lds(r, (LAS void*)lds_dst_uniform, 16, (int)voff, (int)soff, 0, 0);
}
template <class FA, class FB>
DEVI void gemm128(f32x4 (&acc)[4][4], rsrc_t rs, unsigned sA, const FA& offA, unsigned sB, const FB& offB, int nk, unsigned char* lds, int tid) {
    const int lane = tid & 63, wid = __builtin_amdgcn_readfirstlane(tid >> 6), wr = wid >> 1, wc = wid & 1;
    const int lr = tid >> 3;
    const unsigned csrc = (unsigned)(((lane & 7) ^ ((lane >> 3) & 7)) << 4);
    unsigned oa[4], ob[4];
#pragma unroll
    for (int i = 0; i < 4; ++i) { oa[i] = offA(lr + 32 * i) + csrc; ob[i] = offB(lr + 32 * i) + csrc; }
#pragma unroll
    for (int m = 0; m < 4; ++m)
#pragma unroll
        for (int n = 0; n < 4; ++n) acc[m][n] = (f32x4){0.f, 0.f, 0.f, 0.f};
    const int q = lane >> 4, r16 = lane & 15;
    const int roffA0 = (wr * 64 + r16) * 128 + (((0 + q) ^ (lane & 7)) << 4);
    const int roffA1 = (wr * 64 + r16) * 128 + (((4 + q) ^ (lane & 7)) << 4);
    const int roffB0 = 16384 + (wc * 64 + r16) * 128 + (((0 + q) ^ (lane & 7)) << 4);
    const int roffB1 = 16384 + (wc * 64 + r16) * 128 + (((4 + q) ^ (lane & 7)) << 4);
    unsigned char* wbase = lds + wid * 1024;
#pragma unroll
    for (int i = 0; i < 4; ++i) { glds16(rs, wbase + i * 4096, oa[i], sA); glds16(rs, wbase + 16384 + i * 4096, ob[i], sB); }
    for (int kt = 0; kt < nk; ++kt) {
        unsigned char* cur = lds + (kt & 1) * 32768;
        __syncthreads();
        if (kt + 1 < nk) {
            unsigned char* nb = wbase + ((kt + 1) & 1) * 32768;
#pragma unroll
            for (int i = 0; i < 4; ++i) { glds16(rs, nb + i * 4096, oa[i], sA + (kt + 1) * 128); glds16(rs, nb + 16384 + i * 4096, ob[i], sB + (kt + 1) * 128); }
        }
        bf16x8 a0[4], b0[4], a1[4], b1[4];
#pragma unroll
        for (int m = 0; m < 4; ++m) a0[m] = *(const bf16x8*)(cur + roffA0 + m * 2048);
#pragma unroll
        for (int n = 0; n < 4; ++n) b0[n] = *(const bf16x8*)(cur + roffB0 + n * 2048);
#pragma unroll
        for (int m = 0; m < 4; ++m) a1[m] = *(const bf16x8*)(cur + roffA1 + m * 2048);
#pragma unroll
        for (int n = 0; n < 4; ++n) b1[n] = *(const bf16x8*)(cur + roffB1 + n * 2048);
#pragma unroll
        for (int m = 0; m < 4; ++m)
#pragma unroll
            for (int n = 0; n < 4; ++n) acc[m][n] = MFMA16(b0[n], a0[m], acc[m][n]);
#pragma unroll
        for (int m = 0; m < 4; ++m)
#pragma unroll
            for (int n = 0; n < 4; ++n) acc[m][n] = MFMA16(b1[n], a1[m], acc[m][n]);
    }
    __syncthreads();
}

DEVI bool tile_map(int k, int ncol, int& mt, int& nt) {
    if (gridDim.x == 512) {
        const int x = blockIdx.x & 7, j = blockIdx.x >> 3;
        const int v = j + 64 * k;
        if (v >= 32 * ncol) return false;
        const int nfull = ncol >> 3, rem = ncol & 7;
        int mtl;
        if (v < nfull * 256) { const int cg = v >> 8, w = v & 255; mtl = (w >> 6) * 8 + ((w & 63) >> 3); nt = cg * 8 + (w & 7); }
        else { const int v2 = v - nfull * 256, per = 8 * rem; const int rg = v2 / per, w = v2 % per; mtl = rg * 8 + w / rem; nt = nfull * 8 + w % rem; }
        mt = x * 32 + mtl;
        return true;
    }
    const int u = blockIdx.x + gridDim.x * k;
    if (u >= 256 * ncol) return false;
    mt = u / ncol; nt = u % ncol;
    return true;
}
struct RowLin { unsigned ldb; DEVI unsigned operator()(int r) const { return (unsigned)r * ldb; } };

DEVI int win_map(int j) {
    if (j < 896) return j;
    if (j < 1408) return j - 896 + 936;
    if (j < 2176) return j - 1408 + 1448;
    if (j < 2208) return j - 2176 + 896;
    if (j < 2216) return j - 2208 + 928;
    if (j < 2240) return j;
    if (j < 2304) return -1;
    return j - 64;
}

struct TJob { const float* src; bf16_t* dst; int K, ld, nrows, perm, nb; size_t sb, db; };
DEVI TJob get_tjob(const Params& P, int j) {
    unsigned char* ws = P.ws;
    switch (j) {
        case 0: return TJob{P.in[3], (bf16_t*)(ws + OFF_WIN_T), 1024, INW, WIN_ROWS, 1, 1, 0, 0};
        case 1: return TJob{P.in[10], (bf16_t*)(ws + OFF_WBRA), 512, 1024, 1024, 0, 1, 0, 0};
        case 2: return TJob{P.in[11], (bf16_t*)(ws + OFF_WBRB), 512, 1024, 1024, 0, 1, 0, 0};
        case 3: return TJob{P.in[12], (bf16_t*)(ws + OFF_WOUT), 1024, 1024, 1024, 0, 1, 0, 0};
        case 4: return TJob{P.in[5], (bf16_t*)(ws + OFF_W1K), 2048, 128, 128, 0, 1, 0, 0};
        case 5: return TJob{P.in[8], (bf16_t*)(ws + OFF_W1V), 2048, 128, 128, 0, 1, 0, 0};
        case 6: return TJob{P.in[6], (bf16_t*)(ws + OFF_W2K), 128, 64, 64, 0, 1, 0, 0};
        case 7: return TJob{P.in[9], (bf16_t*)(ws + OFF_W2V), 128, 64, 64, 0, 1, 0, 0};
        case 8: return TJob{P.in[18], (bf16_t*)(ws + OFF_WGU), 1024, 512, 512, 0, 32, (size_t)1024 * 512, (size_t)512 * 1024};
        default: return TJob{P.in[19], (bf16_t*)(ws + OFF_WDN), 256, 1024, 1024, 0, 32, (size_t)256 * 1024, (size_t)1024 * 256};
    }
}
DEVI int tjob_tiles(int j) {
    switch (j) {
        case 0: return (WIN_ROWS / 64) * 16;
        case 1: case 2: return 16 * 8;
        case 3: return 16 * 16;
        case 4: case 5: return 2 * 32;
        case 6: case 7: return 1 * 2;
        case 8: return 32 * 8 * 16;
        default: return 32 * 16 * 4;
    }
}

DEVI void transpose_tile(const TJob& J, int tile, unsigned char* lds, int tid) {
    float* T = (float*)lds;
    const int kt = J.K / 64, rt = J.nrows / 64;
    const int b = tile / (kt * rt), rem = tile % (kt * rt);
    const int r0 = (rem / kt) * 64, k0 = (rem % kt) * 64;
    const float* src = J.src + (size_t)b * J.sb;
    bf16_t* dst = J.dst + (size_t)b * J.db;
    const int n4 = (tid & 15) * 4;
    int col = r0 + n4; if (J.perm) col = win_map(col);
    f32x4 ld4[4];
#pragma unroll
    for (int i = 0; i < 4; ++i) {
        const int kk = (tid >> 4) + 16 * i;
        ld4[i] = (col >= 0) ? *(const f32x4*)(src + (size_t)(k0 + kk) * J.ld + col) : (f32x4){0.f, 0.f, 0.f, 0.f};
    }
#pragma unroll
    for (int i = 0; i < 4; ++i) {
        const int kk = (tid >> 4) + 16 * i;
#pragma unroll
        for (int e = 0; e < 4; ++e) T[kk * 65 + n4 + e] = ld4[i][e];
    }
    __syncthreads();
    const int r2 = tid >> 2, ks = (tid & 3) * 16;
    u32x4 w0, w1;
    w0.x = pk2(T[(ks + 0) * 65 + r2], T[(ks + 1) * 65 + r2]); w0.y = pk2(T[(ks + 2) * 65 + r2], T[(ks + 3) * 65 + r2]);
    w0.z = pk2(T[(ks + 4) * 65 + r2], T[(ks + 5) * 65 + r2]); w0.w = pk2(T[(ks + 6) * 65 + r2], T[(ks + 7) * 65 + r2]);
    w1.x = pk2(T[(ks + 8) * 65 + r2], T[(ks + 9) * 65 + r2]); w1.y = pk2(T[(ks + 10) * 65 + r2], T[(ks + 11) * 65 + r2]);
    w1.z = pk2(T[(ks + 12) * 65 + r2], T[(ks + 13) * 65 + r2]); w1.w = pk2(T[(ks + 14) * 65 + r2], T[(ks + 15) * 65 + r2]);
    bf16_t* d = dst + (size_t)(r0 + r2) * J.K + k0 + ks;
    *(u32x4*)d = w0; *(u32x4*)(d + 8) = w1;
    __syncthreads();
}

DEVI void rms_row_bf16(const float* xr, const float* g, bf16_t* o, int lane) {
    f32x4 v[4]; float ss = 0.f;
#pragma unroll
    for (int i = 0; i < 4; ++i) { v[i] = *(const f32x4*)(xr + i * 256 + lane * 4); ss += v[i][0] * v[i][0] + v[i][1] * v[i][1] + v[i][2] * v[i][2] + v[i][3] * v[i][3]; }
    ss = wave_sum(ss);
    const float rs = rsqrtf(ss * (1.0f / 1024.0f) + RMS_EPS);
#pragma unroll
    for (int i = 0; i < 4; ++i) {
        const f32x4 gg = *(const f32x4*)(g + i * 256 + lane * 4);
        u32x2 w; w.x = pk2(v[i][0] * rs * gg[0], v[i][1] * rs * gg[1]); w.y = pk2(v[i][2] * rs * gg[2], v[i][3] * rs * gg[3]);
        *(u32x2*)(o + i * 256 + lane * 4) = w;
    }
}

DEVI void phase_prep(const Params& P, unsigned char* lds, int tid, int part) {
    unsigned char* ws = P.ws;
    const int lane = tid & 63, wid = __builtin_amdgcn_readfirstlane(tid >> 6);
    int base = 0;
#pragma unroll
    for (int j = 0; j < 10; ++j) {
        const bool early = (j == 0) || (j >= 4 && j <= 7);
        if (early == (part == 0)) {
            const int nt = tjob_tiles(j);
            const TJob J = get_tjob(P, j);
            for (int t = blockIdx.x; t < nt; t += gridDim.x) transpose_tile(J, t, lds, tid);
        }
    }
    (void)base;
    if (part == 1) {
        float* wr = (float*)(ws + OFF_WR);
        const float* g = P.in[13]; const float* wg = P.in[14]; const float* we = P.in[16];
        for (int e = blockIdx.x * NTHREADS + tid; e < 48 * 1024; e += gridDim.x * NTHREADS) {
            const int c = e >> 10, k = e & 1023;
            float v = 0.f;
            if (c < 4) v = wg[k * 4 + c]; else if (c < 36) v = we[k * 32 + (c - 4)];
            wr[e] = v * g[k];
        }
        return;
    }
    {
        const float* x = P.in[0]; const float* g = P.in[2]; bf16_t* hn = (bf16_t*)(ws + OFF_HN);
        for (int r = blockIdx.x * 4 + wid; r < NTOK; r += gridDim.x * 4) rms_row_bf16(x + (size_t)r * 1024, g, hn + (size_t)r * 1024, lane);
    }
    {
        f32x2* cs = (f32x2*)(ws + OFF_CS);
        for (int e = blockIdx.x * NTHREADS + tid; e < NTOK * 32; e += gridDim.x * NTHREADS) {
            const int tok = e >> 5, i = e & 31;
            const double a = (double)P.pos[tok] * P.inv_freq[i];
            double t = a * 0.15915494309189535;
            t -= floor(t);
            const float tf = (float)t;
            cs[e] = (f32x2){__builtin_amdgcn_cosf(tf), __builtin_amdgcn_sinf(tf)};
        }
    }
    {
        float* red = (float*)lds;
        for (int job = blockIdx.x; job < 32; job += gridDim.x) {
            const int kv = job >> 4, cg8 = job & 15;
            const float* pe = P.in[kv ? 7 : 4]; const float* w1 = P.in[kv ? 8 : 5];
            const int cc = tid & 7, jj = tid >> 3;
            float s = 0.f;
            for (int j = jj; j < 2048; j += 32) s += pe[j] * w1[(size_t)j * 128 + cg8 * 8 + cc];
            red[tid] = s;
            __syncthreads();
            if (tid < 8) { float t = 0.f; for (int u = 0; u < 32; ++u) t += red[u * 8 + tid]; ((float*)(ws + OFF_BIAS1))[kv * 128 + cg8 * 8 + tid] = t; }
            __syncthreads();
        }
    }
}

DEVI void st_bf16(bf16_t* p, float v) { *p = (bf16_t)f2bf(v); }

DEVI int gemm1_col_tile(int part, int i) {
    if (part == 0) return (i < 2) ? 5 + i : ((i < 4) ? 9 + i : 17);
    return (i < 5) ? i : ((i < 9) ? i + 2 : ((i < 13) ? i + 4 : i + 5));
}
DEVI void phase_gemm1(const Params& P, unsigned char* lds, int tid, int part) {
    unsigned char* ws = P.ws;
    const rsrc_t rs = __builtin_amdgcn_make_buffer_rsrc((void*)P.ws, (short)0, (int)0x7fffffff, 0x00020000);
    const bf16_t* hn = (const bf16_t*)(ws + OFF_HN);
    const bf16_t* wt = (const bf16_t*)(ws + OFF_WIN_T);
    const f32x2* cs = (const f32x2*)(ws + OFF_CS);
    const int lane = tid & 63, wid = __builtin_amdgcn_readfirstlane(tid >> 6), wr = wid >> 1, wc = wid & 1, q = lane >> 4, cl = lane & 15;
    constexpr int NT_N = G1_COLS / 128;
    for (int kk = 0;; ++kk) {
        int mt, nti;
        if (!tile_map(kk, part == 0 ? 5 : NT_N - 5, mt, nti)) break;
        const int nt = gemm1_col_tile(part, nti);
        f32x4 acc[4][4];
        gemm128(acc, rs, (unsigned)(OFF_HN + (size_t)mt * 128 * 2048), RowLin{2048}, (unsigned)(OFF_WIN_T + (size_t)nt * 128 * 2048), RowLin{2048}, 16, lds, tid);
        const int c64 = nt * 2 + wc;
        const int tok0 = mt * 128 + wr * 64 + cl;
        if (c64 < 10 || (c64 >= 14 && c64 < 34)) {
            bool do_rope; float scale = 1.f; int kind;
            int g = 0, hk = 0;
            if (c64 < 8) { kind = 0; do_rope = true; scale = 0.125f * LOG2E; }
            else if (c64 == 8) { kind = 1; do_rope = true; }
            else if (c64 == 9) { kind = 2; do_rope = false; }
            else if (c64 < 22) { kind = 3; do_rope = true; scale = 0.125f * LOG2E; }
            else { kind = 4; g = (c64 - 22) >> 1; hk = (c64 - 22) & 1; do_rope = (g == 2 || g == 4); }
#pragma unroll
            for (int m = 0; m < 4; ++m) {
                const int tok = tok0 + m * 16;
                f32x4 o[4], nr[4];
#pragma unroll
                for (int n = 0; n < 4; ++n) { nr[n] = acc[m][n] * scale; o[n] = nr[n]; }
                if (do_rope) {
#pragma unroll
                    for (int n = 0; n < 2; ++n) {
                        const f32x4 c01 = *(const f32x4*)(cs + (size_t)tok * 32 + n * 16 + q * 4);
                        const f32x4 c23 = *(const f32x4*)(cs + (size_t)tok * 32 + n * 16 + q * 4 + 2);
                        const float cc[4] = {c01[0], c01[2], c23[0], c23[2]}, sn[4] = {c01[1], c01[3], c23[1], c23[3]};
#pragma unroll
                        for (int j = 0; j < 4; ++j) {
                            const float x1 = nr[n][j], x2 = nr[n + 2][j];
                            o[n][j] = x1 * cc[j] - x2 * sn[j]; o[n + 2][j] = x1 * sn[j] + x2 * cc[j];
                        }
                    }
                }
                if (kind == 0 || kind == 1 || kind == 2) {
                    bf16_t* d = (kind == 0) ? (bf16_t*)(ws + OFF_QA) + (size_t)tok * 512 + c64 * 64 : (bf16_t*)(ws + (kind == 1 ? OFF_KA : OFF_VA)) + (size_t)tok * 64;
#pragma unroll
                    for (int n = 0; n < 4; ++n) { u32x2 w; w.x = pk2(o[n][0], o[n][1]); w.y = pk2(o[n][2], o[n][3]); *(u32x2*)(d + n * 16 + q * 4) = w; }
                } else if (kind == 3) {
                    const int h = c64 - 14;
                    bf16_t* dn = (bf16_t*)(ws + OFF_QBN) + (size_t)tok * 512 + h * 64; bf16_t* dr = (bf16_t*)(ws + OFF_QBR) + (size_t)tok * 512 + h * 64;
#pragma unroll
                    for (int n = 0; n < 4; ++n) {
                        u32x2 w; w.x = pk2(nr[n][0], nr[n][1]); w.y = pk2(nr[n][2], nr[n][3]); *(u32x2*)(dn + n * 16 + q * 4) = w;
                        u32x2 v; v.x = pk2(o[n][0], o[n][1]); v.y = pk2(o[n][2], o[n][3]); *(u32x2*)(dr + n * 16 + q * 4) = v;
                    }
                } else {
                    bf16_t* d = (bf16_t*)(ws + OFF_KV + (size_t)g * KV_STRIDE);
                    const int b = tok >> 12, tl = tok & 4095;
                    if (g == 3 || g == 5) {
#pragma unroll
                        for (int n = 0; n < 4; ++n)
#pragma unroll
                            for (int j = 0; j < 4; ++j) st_bf16(d + ((size_t)((b * 2 + hk) * 64 + n * 16 + q * 4 + j)) * 4096 + tl, o[n][j]);
                    } else {
#pragma unroll
                        for (int n = 0; n < 4; ++n) { u32x2 w; w.x = pk2(o[n][0], o[n][1]); w.y = pk2(o[n][2], o[n][3]);
                            *(u32x2*)(d + ((size_t)((b * 2 + hk) * 4096 + tl)) * 64 + n * 16 + q * 4) = w; }
                    }
                }
            }
        } else if (c64 >= 10 && c64 < 14) {
            bf16_t* d = (bf16_t*)(ws + OFF_QI);
#pragma unroll
            for (int m = 0; m < 4; ++m) {
                const int tok = tok0 + m * 16;
                float cc[4], sn[4];
#pragma unroll
                for (int j = 0; j < 4; ++j) { const f32x2 c = cs[(size_t)tok * 32 + 2 * (4 * q + j)]; cc[j] = c.x; sn[j] = c.y; }
#pragma unroll
                for (int hh = 0; hh < 2; ++hh) {
                    const int head = 2 * (c64 - 10) + hh;
                    f32x4 r1, r2;
#pragma unroll
                    for (int j = 0; j < 4; ++j) { const float x1 = acc[m][2 * hh][j], x2 = acc[m][2 * hh + 1][j]; r1[j] = x1 * cc[j] - x2 * sn[j]; r2[j] = x1 * sn[j] + x2 * cc[j]; }
                    u32x2 w; w.x = pk2(r1[0], r1[1]); w.y = pk2(r1[2], r1[3]); *(u32x2*)(d + (size_t)tok * 256 + head * 32 + q * 4) = w;
                    u32x2 v; v.x = pk2(r2[0], r2[1]); v.y = pk2(r2[2], r2[3]); *(u32x2*)(d + (size_t)tok * 256 + head * 32 + 16 + q * 4) = v;
                }
            }
        } else if (c64 >= 36) {
            bf16_t* d = (bf16_t*)(ws + (c64 < 52 ? OFF_GA : OFF_GB));
            const int cb = (c64 < 52 ? c64 - 36 : c64 - 52) * 64;
#pragma unroll
            for (int m = 0; m < 4; ++m)
#pragma unroll
                for (int n = 0; n < 4; ++n) {
                    u32x2 w; w.x = pk2(sigmoidf_(acc[m][n][0]), sigmoidf_(acc[m][n][1])); w.y = pk2(sigmoidf_(acc[m][n][2]), sigmoidf_(acc[m][n][3]));
                    *(u32x2*)(d + (size_t)(tok0 + m * 16) * 1024 + cb + n * 16 + q * 4) = w;
                }
        } else if (c64 == 34) {
            bf16_t* dki = (bf16_t*)(ws + OFF_KI); float* dwi = (float*)(ws + OFF_WI); float* dg = (float*)(ws + OFF_GATES);
#pragma unroll
            for (int m = 0; m < 4; ++m) {
                const int tok = tok0 + m * 16;
                f32x4 r1, r2;
#pragma unroll
                for (int j = 0; j < 4; ++j) {
                    const f32x2 c = cs[(size_t)tok * 32 + 2 * (4 * q + j)];
                    const float x1 = acc[m][0][j], x2 = acc[m][1][j];
                    r1[j] = x1 * c.x - x2 * c.y; r2[j] = x1 * c.y + x2 * c.x;
                }
                u32x2 w; w.x = pk2(r1[0], r1[1]); w.y = pk2(r1[2], r1[3]); *(u32x2*)(dki + (size_t)tok * 32 + q * 4) = w;
                u32x2 v; v.x = pk2(r2[0], r2[1]); v.y = pk2(r2[2], r2[3]); *(u32x2*)(dki + (size_t)tok * 32 + 16 + q * 4) = v;
                if (q < 2) *(f32x4*)(dwi + (size_t)tok * 8 + q * 4) = acc[m][2];
                else { f32x4 sv; for (int j = 0; j < 4; ++j) sv[j] = sigmoidf_(acc[m][2][j]); *(f32x4*)(dg + (size_t)tok * 24 + (q * 4 - 8)) = sv; }
                { f32x4 sv; for (int j = 0; j < 4; ++j) sv[j] = sigmoidf_(acc[m][3][j]); *(f32x4*)(dg + (size_t)tok * 24 + 8 + q * 4) = sv; }
            }
        }
    }
}

DEVI float siluf_(float x) { return x * __builtin_amdgcn_rcpf(1.0f + __builtin_amdgcn_exp2f(-x * 1.4426950408889634f)); }

DEVI void phase_compress(const Params& P, unsigned char* lds, int tid) {
    unsigned char* ws = P.ws;
    const rsrc_t rs = __builtin_amdgcn_make_buffer_rsrc((void*)P.ws, (short)0, (int)0x7fffffff, 0x00020000);
    const int lane = tid & 63, wid = __builtin_amdgcn_readfirstlane(tid >> 6), wr = wid >> 1, wc = wid & 1, q = lane >> 4, cl = lane & 15;
    for (int u = blockIdx.x; u < 64; u += gridDim.x) {
        const int kv = u >> 5, mt = u & 31;
        const bf16_t* A = (const bf16_t*)(ws + OFF_KV + (size_t)kv * KV_STRIDE) + (size_t)mt * 128 * 1024;
        const bf16_t* W1 = (const bf16_t*)(ws + (kv ? OFF_W1V : OFF_W1K));
        const bf16_t* W2 = (const bf16_t*)(ws + (kv ? OFF_W2V : OFF_W2K));
        const float* bias = (const float*)(ws + OFF_BIAS1) + kv * 128;
        f32x4 acc[4][4];
        gemm128(acc, rs, (unsigned)(OFF_KV + (size_t)kv * KV_STRIDE + (size_t)mt * 128 * 2048), RowLin{2048}, (unsigned)(kv ? OFF_W1V : OFF_W1K), RowLin{4096}, 32, lds, tid);
#pragma unroll
        for (int m = 0; m < 4; ++m)
#pragma unroll
            for (int n = 0; n < 4; ++n) {
                const int col = wc * 64 + n * 16 + q * 4, row = wr * 64 + m * 16 + cl;
                const f32x4 bb = *(const f32x4*)(bias + col);
                const int ktile = col >> 6, ch = (col & 63) >> 3, wi = col & 7;
                u32x2 w; w.x = pk2(siluf_(acc[m][n][0] + bb[0]), siluf_(acc[m][n][1] + bb[1])); w.y = pk2(siluf_(acc[m][n][2] + bb[2]), siluf_(acc[m][n][3] + bb[3]));
                *(u32x2*)(lds + ktile * 16384 + row * 128 + ((ch ^ (row & 7)) << 4) + wi * 2) = w;
            }
#pragma unroll
        for (int i = 0; i < 4; ++i) {
            const int idx = tid + 256 * i;
            const int row = idx >> 4, ch16 = idx & 15, ktile = ch16 >> 3, ch = ch16 & 7;
            *(u32x4*)(lds + 32768 + ktile * 8192 + row * 128 + ((ch ^ (row & 7)) << 4)) = *(const u32x4*)(W2 + (size_t)row * 128 + ch16 * 8);
        }
        __syncthreads();
        f32x4 a2[4][2];
#pragma unroll
        for (int m = 0; m < 4; ++m) { a2[m][0] = (f32x4){0.f, 0.f, 0.f, 0.f}; a2[m][1] = (f32x4){0.f, 0.f, 0.f, 0.f}; }
#pragma unroll
        for (int kk = 0; kk < 4; ++kk) {
            const int ktile = kk >> 1, ks = kk & 1;
            bf16x8 a[4], b[2];
#pragma unroll
            for (int m = 0; m < 4; ++m) { const int row = wr * 64 + m * 16 + cl; a[m] = *(const bf16x8*)(lds + ktile * 16384 + row * 128 + (((ks * 4 + q) ^ (row & 7)) << 4)); }
#pragma unroll
            for (int n = 0; n < 2; ++n) { const int row = wc * 32 + n * 16 + cl; b[n] = *(const bf16x8*)(lds + 32768 + ktile * 8192 + row * 128 + (((ks * 4 + q) ^ (row & 7)) << 4)); }
#pragma unroll
            for (int m = 0; m < 4; ++m)
#pragma unroll
                for (int n = 0; n < 2; ++n) a2[m][n] = MFMA16(b[n], a[m], a2[m][n]);
        }
#pragma unroll
        for (int m = 0; m < 4; ++m)
#pragma unroll
            for (int n = 0; n < 2; ++n) {
                const int d = wc * 32 + n * 16 + q * 4;
                const int r = mt * 128 + wr * 64 + m * 16 + cl;
                const bool dead = ((r & 255) == 255);
                float v[4];
#pragma unroll
                for (int j = 0; j < 4; ++j) v[j] = dead ? 0.f : a2[m][n][j];
                if (kv == 0) {
                    bf16_t* kc = (bf16_t*)(ws + OFF_KC);
                    u32x2 w; w.x = pk2(v[0], v[1]); w.y = pk2(v[2], v[3]);
                    *(u32x2*)(kc + (size_t)r * 64 + d) = w;
                } else {
                    bf16_t* vct = (bf16_t*)(ws + OFF_VCT);
#pragma unroll
                    for (int j = 0; j < 4; ++j) st_bf16(vct + ((size_t)((r >> 8) * 64 + d + j)) * 256 + (r & 255), v[j]);
                }
            }
        __syncthreads();
    }
}

DEVI void phase_index(const Params& P, unsigned char* lds, int tid) {
    unsigned char* ws = P.ws;
    const bf16_t* QI = (const bf16_t*)(ws + OFF_QI);
    const bf16_t* KI = (const bf16_t*)(ws + OFF_KI);
    const float* WI = (const float*)(ws + OFF_WI);
    bf16_t* SEL = (bf16_t*)(ws + OFF_SEL);
    float* S = (float*)lds;
    const int lane = tid & 63, wid = __builtin_amdgcn_readfirstlane(tid >> 6), q = lane >> 4, cl = lane & 15;
    for (int u = blockIdx.x; u < NTOK / 4; u += gridDim.x) {
        const int b = u >> 10, w10 = u & 1023, s10 = (w10 < 512) ? w10 : 1535 - w10;
        const int t0 = s10 * 4, tok0 = b * 4096 + t0;
        const int t = t0 + wid;
        const int tok = tok0 + wid;
        if (t0 + 3 < 256) {
            for (int i = lane; i < 256; i += 64) SEL[(size_t)tok * 256 + i] = (bf16_t)(i <= t ? i : 0);
            continue;
        }
        {
            bf16x8 a[2];
#pragma unroll
            for (int hg = 0; hg < 2; ++hg) a[hg] = *(const bf16x8*)(QI + (size_t)(tok0 + (cl >> 2)) * 256 + (4 * hg + (cl & 3)) * 32 + q * 8);
            const f32x4 w0 = *(const f32x4*)(WI + (size_t)(tok0 + q) * 8), w1 = *(const f32x4*)(WI + (size_t)(tok0 + q) * 8 + 4);
            const int ktmax = (t0 + 3) >> 4;
            const bf16_t* kb = KI + (size_t)b * 4096 * 32 + cl * 32 + q * 8;
            for (int kt0 = wid; kt0 <= ktmax; kt0 += 16) {
                bf16x8 bk[4];
#pragma unroll
                for (int uu = 0; uu < 4; ++uu) { const int kt = (kt0 + 4 * uu <= ktmax) ? kt0 + 4 * uu : kt0; bk[uu] = *(const bf16x8*)(kb + (size_t)kt * 16 * 32); }
#pragma unroll
                for (int uu = 0; uu < 4; ++uu) {
                    const int kt = kt0 + 4 * uu;
                    f32x4 c0 = {0.f, 0.f, 0.f, 0.f}, c1 = {0.f, 0.f, 0.f, 0.f};
                    c0 = MFMA16(a[0], bk[uu], c0); c1 = MFMA16(a[1], bk[uu], c1);
                    float sc = 0.f;
#pragma unroll
                    for (int j = 0; j < 4; ++j) { sc += w0[j] * fmaxf(c0[j], 0.f); sc += w1[j] * fmaxf(c1[j], 0.f); }
                    if (kt <= ktmax) S[q * 4096 + kt * 16 + cl] = sc;
                }
            }
        }
        __syncthreads();
        {
            const int n = t + 1;
            const float* Sq = S + wid * 4096;
            if (n <= 256) {
                for (int i = lane; i < 256; i += 64) SEL[(size_t)tok * 256 + i] = (bf16_t)(i <= t ? i : 0);
            } else {
                const int nr = (n + 63) >> 6;
                float x[64];
                const float NINF = -__builtin_inff();
                float mx = NINF, mn = __builtin_inff();
#pragma unroll
                for (int r = 0; r < 64; ++r) {
                    const int key = r * 64 + lane;
                    const float v = Sq[key];
                    x[r] = (key < n) ? v : NINF;
                    mn = fminf(mn, (key < n) ? v : __builtin_inff());
                    mx = fmaxf(mx, x[r]);
                }
#pragma unroll
                for (int o = 32; o > 0; o >>= 1) { mx = fmaxf(mx, __shfl_xor(mx, o)); mn = fminf(mn, __shfl_xor(mn, o)); }
                float lo = mn, hi = mx, T; int need;
                int chi = 0, clo = n;
#define COUNT_GE(dst, thr) do { int c_ = 0; _Pragma("unroll") for (int g8 = 0; g8 < 8; ++g8) if (g8 * 8 < nr) { \
        _Pragma("unroll") for (int r = g8 * 8; r < g8 * 8 + 8; ++r) c_ += __popcll(__ballot(x[r] >= (thr))); } (dst) = c_; } while (0)
                COUNT_GE(chi, hi);
                if (chi >= 256) { T = hi; need = 256;   }
                else {
                    float s1 = 0.f, s2 = 0.f;
#pragma unroll
                    for (int g8 = 0; g8 < 8; ++g8) if (g8 * 8 < nr) {
#pragma unroll
                        for (int r = g8 * 8; r < g8 * 8 + 8; ++r) { const float v = (x[r] == NINF) ? 0.f : x[r]; s1 += v; s2 += v * v; }
                    }
                    s1 = wave_sum_f32_dpp(s1); s2 = wave_sum_f32_dpp(s2);
                    const float fn = (float)n, mu = s1 / fn;
                    const float sg = sqrtf(fmaxf(s2 / fn - mu * mu, 1e-20f));
                    float vg;
                    {
                        const float pq = 256.0f / fn, pp = fminf(pq, 1.0f - pq);
                        const float tt = sqrtf(-2.0f * __logf(fmaxf(pp, 1e-6f)));
                        const float zz = tt - (2.515517f + 0.802853f * tt + 0.010328f * tt * tt) / (1.0f + 1.432788f * tt + 0.189269f * tt * tt + 0.001308f * tt * tt * tt);
                        vg = mu + ((pq <= 0.5f) ? zz : -zz) * sg;
                    }
                    bool found = false, adjacent = false; float thr = 0.f;
                    for (int it = 0; it < 160; ++it) {
                        if (clo - chi <= 64) break;
                        const float mid = 0.5f * lo + 0.5f * hi;
                        if (!(mid > lo && mid < hi)) { adjacent = true; break; }
                        float v = vg;
                        if (!(v > lo && v < hi) || (it & 3) == 3) v = mid;
                        int c; COUNT_GE(c, v);
                        if (c == 256) { found = true; thr = v; break; }
                        if (c > 256) { lo = v; clo = c; } else { hi = v; chi = c; }
                        const float zv = (v - mu) / sg;
                        const float dens = fmaxf(fn * 0.39894228f * __expf(-0.5f * zv * zv), 0.5f) / sg;
                        vg = v + ((float)c - ((c > 256) ? 244.0f : 268.0f)) / dens;
                    }
                    if (found) { T = thr; need = -1; }
                    else if (adjacent) { T = lo; need = 256 - chi; }
                    else {
                        float* cand = (float*)(lds + 65536) + wid * 64;
                        cand[lane] = NINF;
                        int cb = 0;
                        const unsigned long long ltm = (1ull << lane) - 1ull;
#pragma unroll
                        for (int g8 = 0; g8 < 8; ++g8) if (g8 * 8 < nr) {
#pragma unroll
                            for (int r = g8 * 8; r < g8 * 8 + 8; ++r) {
                                const bool isc = (x[r] >= lo) && (x[r] < hi);
                                const unsigned long long bm = __ballot(isc);
                                if (bm != 0ull) {
                                    if (isc) cand[cb + __popcll(bm & ltm)] = x[r];
                                    cb += __popcll(bm);
                                }
                            }
                        }
                        const float y = cand[lane];
                        int cgt = 0, cge = 0;
#pragma unroll
                        for (int k = 0; k < 64; ++k) { const float yk = __builtin_bit_cast(float, __builtin_amdgcn_readlane(__builtin_bit_cast(int, y), k)); cgt += (yk > y) ? 1 : 0; cge += (yk >= y) ? 1 : 0; }
                        const int nd = 256 - chi;
                        const bool isT = (y != NINF) && (cgt <= nd - 1) && (cge >= nd);
                        const unsigned long long tm = __ballot(isT);
                        const int tl = (tm != 0ull) ? (int)__builtin_ctzll(tm) : 0;
                        T = __shfl(y, tl);
                        need = nd - __shfl(cgt, tl);
                    }
                }
                bf16_t* selb = (bf16_t*)(lds + 65536 + 1024) + wid * 256;
                int wlo = 0, whi = 0, tot = 0;
#pragma unroll
                for (int g8 = 0; g8 < 8; ++g8) if (g8 * 8 < nr) {
#pragma unroll
                    for (int r = g8 * 8; r < g8 * 8 + 8; ++r) {
                        const unsigned long long m = __ballot(x[r] >= T);
                        tot += __popcll(m);
                        asm volatile("v_writelane_b32 %0, %1, %2" : "+v"(wlo) : "s"((unsigned)m), "n"(r));
                        asm volatile("v_writelane_b32 %0, %1, %2" : "+v"(whi) : "s"((unsigned)(m >> 32)), "n"(r));
                    }
                }
                if (tot == 256) {
                    const int cw = __popc((unsigned)wlo) + __popc((unsigned)whi);
                    int pos = 0;
#pragma unroll
                    for (int bb = 0; bb < 7; ++bb) {
                        const unsigned long long bmk = __ballot(((cw >> bb) & 1) != 0);
                        pos += (int)__builtin_amdgcn_mbcnt_hi((unsigned)(bmk >> 32), __builtin_amdgcn_mbcnt_lo((unsigned)bmk, 0u)) << bb;
                    }
                    unsigned long long w = ((unsigned long long)(unsigned)whi << 32) | (unsigned long long)(unsigned)wlo;
                    while (w != 0ull) {
                        const int bpos = (int)__builtin_ctzll(w);
                        selb[pos++] = (bf16_t)(lane * 64 + bpos);
                        w &= w - 1ull;
                    }
                } else {
                    if (need < 0) need = 0x7fffffff;
                    int base = 0, eqc = 0;
                    const unsigned long long lt = (1ull << lane) - 1ull;
#pragma unroll
                    for (int g8 = 0; g8 < 8; ++g8) if (g8 * 8 < nr) {
#pragma unroll
                        for (int r = g8 * 8; r < g8 * 8 + 8; ++r) {
                            const bool eq = (x[r] == T);
                            const unsigned long long em = __ballot(eq);
                            const bool sel = (x[r] > T) || (eq && (eqc + __popcll(em & lt) < need));
                            eqc += __popcll(em);
                            const unsigned long long sm = __ballot(sel);
                            if (sel) { const int pp = base + __popcll(sm & lt); if (pp < 256) selb[pp] = (bf16_t)(r * 64 + lane); }
                            base += __popcll(sm);
                        }
                    }
                }
                __builtin_amdgcn_wave_barrier();
                if (lane < 32) *(u32x4*)(SEL + (size_t)tok * 256 + lane * 8) = *(const u32x4*)(selb + lane * 8);
                __builtin_amdgcn_wave_barrier();
            }
        }
        __syncthreads();
    }
}

DEVI int dsa_vswz(int row) { return (((row >> 1) & 1) << 1) | (((row >> 3) & 1) << 2); }
DEVI void phase_dsa(const Params& P, unsigned char* lds, int tid) {
    unsigned char* ws = P.ws;
    const bf16_t* QA = (const bf16_t*)(ws + OFF_QA);
    const bf16_t* KA = (const bf16_t*)(ws + OFF_KA);
    const bf16_t* VA = (const bf16_t*)(ws + OFF_VA);
    const bf16_t* SEL = (const bf16_t*)(ws + OFF_SEL);
    bf16_t* OA = (bf16_t*)(ws + OFF_OA);
    const int lane = tid & 63, wid = __builtin_amdgcn_readfirstlane(tid >> 6), q = lane >> 4, cl = lane & 15;
    unsigned char* vl = lds + wid * 8192;
    const float NINF = -__builtin_inff();
    const int stride = gridDim.x * 4;
    int tok = blockIdx.x * 4 + wid;
    if (tok >= NTOK) return;
    int kidx[16], mk[4]; bf16x8 bq[2];
    {
        const bf16_t* sel = SEL + (size_t)tok * 256;
#pragma unroll
        for (int rf = 0; rf < 16; ++rf) kidx[rf] = sel[32 * (rf >> 1) + 8 * (cl >> 2) + 4 * (rf & 1) + (cl & 3)];
#pragma unroll
        for (int cc = 0; cc < 4; ++cc) mk[cc] = sel[cc * 64 + lane];
#pragma unroll
        for (int ks = 0; ks < 2; ++ks) bq[ks] = *(const bf16x8*)(QA + (size_t)tok * 512 + (cl & 7) * 64 + ks * 32 + q * 8);
    }
    const int wrow = lane >> 3;
    for (; tok < NTOK; tok += stride) {
        const int b = tok >> 12, t = tok & 4095;
        const int cnt = (t + 1 < 256) ? t + 1 : 256;
        const int nc64 = (cnt + 63) >> 6;
        const bf16_t* kb = KA + (size_t)b * 4096 * 64;
        const bf16_t* vb = VA + (size_t)b * 4096 * 64;
        const bf16x8 zero8 = {0, 0, 0, 0, 0, 0, 0, 0};
        const bf16x8 bq0 = (cl < 8) ? bq[0] : zero8, bq1 = (cl < 8) ? bq[1] : zero8;
        u32x4 vr[8];
#pragma unroll
        for (int i = 0; i < 8; ++i) { const int key = __shfl(mk[0], wrow + 8 * i); vr[i] = *(const u32x4*)(vb + (size_t)key * 64 + (lane & 7) * 8); }
        f32x4 s[16];
#pragma unroll
        for (int rf = 0; rf < 16; ++rf) {
            s[rf] = (f32x4){0.f, 0.f, 0.f, 0.f};
            if ((rf >> 2) < nc64) {
                const bf16_t* kr = kb + (size_t)kidx[rf] * 64 + q * 8;
                const bf16x8 a0 = *(const bf16x8*)(kr), a1 = *(const bf16x8*)(kr + 32);
                s[rf] = MFMA16(a0, bq0, s[rf]); s[rf] = MFMA16(a1, bq1, s[rf]);
            }
            if ((rf & 3) == 3) asm volatile("" ::: "memory");
        }
        int mkc[4];
#pragma unroll
        for (int cc = 0; cc < 4; ++cc) mkc[cc] = mk[cc];
        {
            const int tn = (tok + stride < NTOK) ? tok + stride : tok;
            const bf16_t* sel = SEL + (size_t)tn * 256;
#pragma unroll
            for (int rf = 0; rf < 16; ++rf) kidx[rf] = sel[32 * (rf >> 1) + 8 * (cl >> 2) + 4 * (rf & 1) + (cl & 3)];
#pragma unroll
            for (int cc = 0; cc < 4; ++cc) mk[cc] = sel[cc * 64 + lane];
#pragma unroll
            for (int ks = 0; ks < 2; ++ks) bq[ks] = *(const bf16x8*)(QA + (size_t)tn * 512 + (cl & 7) * 64 + ks * 32 + q * 8);
        }
        float mx = NINF;
#pragma unroll
        for (int rf = 0; rf < 16; ++rf)
#pragma unroll
            for (int j = 0; j < 4; ++j) {
                const int p = 32 * (rf >> 1) + 8 * q + 4 * (rf & 1) + j;
                if (p >= cnt) s[rf][j] = NINF;
                mx = fmaxf(mx, s[rf][j]);
            }
        mx = rows_max(mx);
        float ls = 0.f;
#pragma unroll
        for (int rf = 0; rf < 16; ++rf)
#pragma unroll
            for (int j = 0; j < 4; ++j) { const float pv = __builtin_amdgcn_exp2f(s[rf][j] - mx); s[rf][j] = pv; ls += pv; }
        ls = rows_sum(ls);
        const float inv = __builtin_amdgcn_rcpf(ls);
        bf16x8 pbs[8];
#pragma unroll
        for (int c8 = 0; c8 < 8; ++c8) pbs[c8] = pack8(s[2 * c8], s[2 * c8 + 1]);
        f32x4 o[4];
#pragma unroll
        for (int d = 0; d < 4; ++d) o[d] = (f32x4){0.f, 0.f, 0.f, 0.f};
#pragma unroll
        for (int cc = 0; cc < 4; ++cc) {
            if (cc < nc64) {
                __builtin_amdgcn_wave_barrier();
#pragma unroll
                for (int i = 0; i < 8; ++i) { const int row = wrow + 8 * i; *(u32x4*)(vl + row * 128 + (((lane & 7) ^ dsa_vswz(row)) << 4)) = vr[i]; }
                __builtin_amdgcn_wave_barrier();
                if (cc + 1 < 4 && cc + 1 < nc64) {
#pragma unroll
                    for (int i = 0; i < 8; ++i) { const int key = __shfl(mkc[(cc + 1) & 3], wrow + 8 * i); vr[i] = *(const u32x4*)(vb + (size_t)key * 64 + (lane & 7) * 8); }
                }
#pragma unroll
                for (int c2 = 0; c2 < 2; ++c2) {
                    const bf16x8 pb = pbs[cc * 2 + c2];
#pragma unroll
                    for (int d = 0; d < 4; ++d) {
                        const int r0 = c2 * 32 + 8 * q + (cl >> 2), r1 = r0 + 4;
                        const int ch = d * 2 + ((cl & 3) >> 1), wb = 8 * (cl & 1);
                        const s16x4 lo4 = __builtin_amdgcn_ds_read_tr16_b64_v4i16((LAS s16x4*)((LAS unsigned char*)(vl) + r0 * 128 + ((ch ^ dsa_vswz(r0)) << 4) + wb));
                        const s16x4 hi4 = __builtin_amdgcn_ds_read_tr16_b64_v4i16((LAS s16x4*)((LAS unsigned char*)(vl) + r1 * 128 + ((ch ^ dsa_vswz(r1)) << 4) + wb));
                        const bf16x8 av = {lo4[0], lo4[1], lo4[2], lo4[3], hi4[0], hi4[1], hi4[2], hi4[3]};
                        o[d] = MFMA16(av, pb, o[d]);
                    }
                }
            }
        }
        if (cl < 8) {
#pragma unroll
            for (int d = 0; d < 4; ++d) {
                u32x2 w; w.x = pk2(o[d][0] * inv, o[d][1] * inv); w.y = pk2(o[d][2] * inv, o[d][3] * inv);
                *(u32x2*)(OA + (size_t)tok * 512 + cl * 64 + d * 16 + q * 4) = w;
            }
        }
    }
}

DEVI int fK(int row) { return (row & 3) | (((row >> 3) & 1) << 2); }

struct AttnState { f32x4 O[4][4]; float m[4]; float l[4]; };

template <int MODE>
DEVI void attn_blocks(rsrc_t rs, unsigned sK, unsigned sV, int ldv, int jb0, int jb1, const bf16x8 (&qf)[4][2], AttnState& st,
                      int tq, unsigned long long selmask, unsigned char* lds, int tid) {
    const int lane = tid & 63, q = lane >> 4, cl = lane & 15;
    const float NINF = -__builtin_inff();
#pragma unroll
    for (int cf = 0; cf < 4; ++cf) { st.m[cf] = NINF; st.l[cf] = 0.f;
#pragma unroll
        for (int d = 0; d < 4; ++d) st.O[d][cf] = (f32x4){0.f, 0.f, 0.f, 0.f}; }
    if (jb1 < jb0) return;
    unsigned kro[2], vro[2]; int kwo[2], vwo[2];
#pragma unroll
    for (int i = 0; i < 2; ++i) {
        const int idx = tid + 256 * i, row = idx >> 3, ch = idx & 7;
        kro[i] = (unsigned)(row * 64 + ch * 8) * 2u; kwo[i] = row * 128 + ((ch ^ fK(row)) << 4);
        vro[i] = (unsigned)(row * ldv + ch * 8) * 2u; vwo[i] = 8192 + row * 128 + ((ch ^ (row & 7)) << 4);
    }
    u32x4 rk[2], rv[2];
#pragma unroll
    for (int i = 0; i < 2; ++i) { rk[i] = bload16(rs, kro[i], sK + (unsigned)jb0 * 8192u); rv[i] = bload16(rs, vro[i], sV + (unsigned)jb0 * 128u); }
#pragma unroll
    for (int i = 0; i < 2; ++i) { *(u32x4*)(lds + kwo[i]) = rk[i]; *(u32x4*)(lds + vwo[i]) = rv[i]; }
    __syncthreads();
    const int nmax = (tq >= 31) ? ((tq - 31) >> 4) : -1;
    for (int jb = jb0; jb <= jb1; ++jb) {
        unsigned char* cur = lds + ((jb - jb0) & 1) * 16384;
        unsigned char* nxt = lds + ((jb - jb0 + 1) & 1) * 16384;
        const bool more = jb < jb1;
        if (more) {
#pragma unroll
            for (int i = 0; i < 2; ++i) { rk[i] = bload16(rs, kro[i], sK + (unsigned)(jb + 1) * 8192u); rv[i] = bload16(rs, vro[i], sV + (unsigned)(jb + 1) * 128u); }
        }
        bool lane_on = true;
        if (MODE == 1) lane_on = ((selmask >> jb) & 1ull) != 0ull;
        if (MODE == 0) lane_on = (jb * 64 <= nmax);
        if (MODE == 2) lane_on = (jb * 64 + 63 > tq - 512);
        if (__ballot(lane_on) != 0ull) {
#pragma unroll
            for (int c = 0; c < 2; ++c) {
                f32x4 S[2][4];
#pragma unroll
                for (int r2 = 0; r2 < 2; ++r2)
#pragma unroll
                    for (int cf = 0; cf < 4; ++cf) S[r2][cf] = (f32x4){0.f, 0.f, 0.f, 0.f};
#pragma unroll
                for (int r2 = 0; r2 < 2; ++r2) {
                    const int kl = 32 * c + 8 * (cl >> 2) + 4 * r2 + (cl & 3);
#pragma unroll
                    for (int ks = 0; ks < 2; ++ks) {
                        const bf16x8 a = *(const bf16x8*)(cur + kl * 128 + (((ks * 4 + q) ^ (cl & 7)) << 4));
#pragma unroll
                        for (int cf = 0; cf < 4; ++cf) S[r2][cf] = MFMA16(a, qf[cf][ks], S[r2][cf]);
                    }
                }
                bool edge;
                if (MODE == 0) edge = (jb * 64 + 63 > nmax);
                else if (MODE == 1) edge = (jb * 64 + 63 > tq) || !lane_on;
                else edge = (jb * 64 + 63 > tq) || (jb * 64 <= tq - 512);
                const bool need_mask = __ballot(edge) != 0ull;
                bf16x8 pb[4];
#pragma unroll
                for (int cf = 0; cf < 4; ++cf) {
                    if (need_mask) {
#pragma unroll
                        for (int r2 = 0; r2 < 2; ++r2)
#pragma unroll
                            for (int j = 0; j < 4; ++j) {
                                const int key = jb * 64 + 32 * c + 8 * q + 4 * r2 + j;
                                bool v;
                                if (MODE == 0) v = key <= nmax;
                                else if (MODE == 1) v = lane_on && key <= tq;
                                else v = key <= tq && key > tq - 512;
                                if (!v) S[r2][cf][j] = NINF;
                            }
                    }
                    const float bml = fmaxf(fmaxf(fmaxf(S[0][cf][0], S[0][cf][1]), fmaxf(S[0][cf][2], S[0][cf][3])), fmaxf(fmaxf(S[1][cf][0], S[1][cf][1]), fmaxf(S[1][cf][2], S[1][cf][3])));
                    if (__ballot(bml > st.m[cf] + 8.0f) != 0ull) {
                        const float bm = rows_max(bml);
                        const float mnew = fmaxf(st.m[cf], bm);
                        const float mr0 = (mnew == NINF) ? 0.f : mnew;
                        const float alpha = __builtin_amdgcn_exp2f(st.m[cf] - mr0);
                        st.m[cf] = mnew;
                        st.l[cf] *= alpha;
#pragma unroll
                        for (int d = 0; d < 4; ++d) st.O[d][cf] *= alpha;
                    }
                    const float mref = (st.m[cf] == NINF) ? 0.f : st.m[cf];
                    float ps = 0.f;
#pragma unroll
                    for (int r2 = 0; r2 < 2; ++r2)
#pragma unroll
                        for (int j = 0; j < 4; ++j) { const float pv = __builtin_amdgcn_exp2f(S[r2][cf][j] - mref); S[r2][cf][j] = pv; ps += pv; }
                    st.l[cf] += ps;
                    pb[cf] = pack8(S[0][cf], S[1][cf]);
                }
#pragma unroll
                for (int d = 0; d < 4; ++d) {
                    const int row = d * 16 + cl;
                    const bf16x8 av = *(const bf16x8*)(cur + 8192 + row * 128 + (((c * 4 + q) ^ (row & 7)) << 4));
#pragma unroll
                    for (int cf = 0; cf < 4; ++cf) st.O[d][cf] = MFMA16(av, pb[cf], st.O[d][cf]);
                }
            }
        }
        if (more) {
#pragma unroll
            for (int i = 0; i < 2; ++i) { *(u32x4*)(nxt + kwo[i]) = rk[i]; *(u32x4*)(nxt + vwo[i]) = rv[i]; }
        }
        __syncthreads();
    }
}

DEVI f32x4 bload16f(rsrc_t r, unsigned voff, unsigned soff) { return __builtin_bit_cast(f32x4, __builtin_amdgcn_raw_buffer_load_b128(r, (int)voff, (int)soff, 0)); }
DEVI void bstore16f(rsrc_t r, f32x4 v, unsigned voff, unsigned soff) { __builtin_amdgcn_raw_buffer_store_b128(__builtin_bit_cast(u32x4, v), r, (int)voff, (int)soff, 0); }
DEVI float bload4f(rsrc_t r, unsigned voff, unsigned soff) { return __builtin_bit_cast(float, __builtin_amdgcn_raw_buffer_load_b32(r, (int)voff, (int)soff, 0)); }

struct NsaUnit { int i, b, k, t0, tq; unsigned tokw, tokb, qoff, goff, ooff, sQ, sG, sO; };
DEVI NsaUnit nsa_unit(int uu, int tid) {
    NsaUnit U;
    const int lane = tid & 63, wid = __builtin_amdgcn_readfirstlane(tid >> 6), q = lane >> 4, cl = lane & 15;
    const int half = uu >> 9, r = uu & 511, bk = r & 15, ii = r >> 4;
    U.i = half ? ii : 63 - ii; U.b = bk >> 1; U.k = bk & 1;
    U.t0 = U.i * 64; U.tq = U.t0 + wid * 16 + cl;
    U.tokw = (unsigned)(wid * 16 + cl);
    U.tokb = (unsigned)(U.b * 4096 + U.t0);
    U.qoff = U.tokw * 1024u + (unsigned)q * 16u;
    U.goff = U.tokw * 96u;
    U.ooff = U.tokw * 1024u + (unsigned)q * 8u;
    U.sQ = U.tokb * 1024u + (unsigned)U.k * 512u;
    U.sG = (unsigned)OFF_GATES + U.tokb * 96u + (unsigned)U.k * 16u;
    U.sO = (unsigned)OFF_OB + U.tokb * 1024u + (unsigned)U.k * 512u;
    return U;
}

DEVI void nsa_cmp_unit(const Params& P, rsrc_t rs, int uu, unsigned char* lds, int tid) {
    const int lane = tid & 63, wid = __builtin_amdgcn_readfirstlane(tid >> 6), q = lane >> 4, cl = lane & 15;
    const NsaUnit U = nsa_unit(uu, tid);
    const int i = U.i, b = U.b, k = U.k, tq = U.tq;
    AttnState st;
    bf16x8 qf[4][2];
#pragma unroll
    for (int cf = 0; cf < 4; ++cf)
#pragma unroll
        for (int ks = 0; ks < 2; ++ks) qf[cf][ks] = __builtin_bit_cast(bf16x8, bload16(rs, U.qoff, (unsigned)OFF_QBN + U.sQ + cf * 128 + ks * 64));
    const unsigned sKC = (unsigned)OFF_KC + (unsigned)(b * 2 + k) * 256u * 128u;
    const unsigned sVC = (unsigned)OFF_VCT + (unsigned)(b * 2 + k) * 64u * 512u;
    const int nmax_blk = (U.t0 + 63 - 31) >> 4;
    const int jbc = (nmax_blk >> 6) < 3 ? (nmax_blk >> 6) : 3;
    attn_blocks<0>(rs, sKC, sVC, 256, 0, jbc, qf, st, tq, 0ull, lds, tid);
    float linv[4], mfin[4];
#pragma unroll
    for (int cf = 0; cf < 4; ++cf) {
        const float l = rows_sum(st.l[cf]);
        linv[cf] = (l > 0.f) ? __builtin_amdgcn_rcpf(l) : 0.f; mfin[cf] = st.m[cf];
        const float sc = linv[cf] * bload4f(rs, U.goff, U.sG + cf * 4);
#pragma unroll
        for (int d = 0; d < 4; ++d) { const f32x4 v = st.O[d][cf] * sc; u32x2 w; w.x = pk2(v[0], v[1]); w.y = pk2(v[2], v[3]);
            __builtin_amdgcn_raw_buffer_store_b64(w, rs, (int)U.ooff, (int)(U.sO + cf * 128 + d * 32), 0); }
    }
    unsigned long long* MSKG = (unsigned long long*)(P.ws + OFF_MASK);
    if (i < 16) {
        if (q == 0) MSKG[((size_t)(b * 2 + k)) * 4096 + tq] = (2ull << i) - 1ull;
        return;
    }
    float* SUM4 = (float*)(lds + 16384);
    float* LAST = (float*)(lds + 32768);
    float* IMP2 = (float*)(lds + 49152);
    const int nmax = (tq >= 31) ? ((tq - 31) >> 4) : -1;
    for (int kb = 0; kb <= jbc; ++kb) {
#pragma unroll
        for (int ii = 0; ii < 2; ++ii) {
            const int idx = tid + 256 * ii, row = idx >> 3, ch = idx & 7;
            *(u32x4*)(lds + row * 128 + ((ch ^ fK(row)) << 4)) = bload16(rs, (unsigned)(row * 64 + ch * 8) * 2u, sKC + (unsigned)kb * 8192u);
        }
        __syncthreads();
#pragma unroll
        for (int rf = 0; rf < 4; ++rf) {
            f32x4 S[4];
#pragma unroll
            for (int cf = 0; cf < 4; ++cf) S[cf] = (f32x4){0.f, 0.f, 0.f, 0.f};
            const int kl = 32 * (rf >> 1) + 8 * (cl >> 2) + 4 * (rf & 1) + (cl & 3);
#pragma unroll
            for (int ks = 0; ks < 2; ++ks) {
                const bf16x8 a = *(const bf16x8*)(lds + kl * 128 + (((ks * 4 + q) ^ (cl & 7)) << 4));
#pragma unroll
                for (int cf = 0; cf < 4; ++cf) S[cf] = MFMA16(a, qf[cf][ks], S[cf]);
            }
            float acc4 = 0.f, accl = 0.f;
#pragma unroll
            for (int j = 0; j < 4; ++j) {
                const int key = kb * 64 + 32 * (rf >> 1) + 8 * q + 4 * (rf & 1) + j;
                float pj = 0.f;
#pragma unroll
                for (int cf = 0; cf < 4; ++cf) pj += __builtin_amdgcn_exp2f(S[cf][j] - mfin[cf]) * linv[cf];
                pj = (key <= nmax) ? pj : 0.f;
                acc4 += pj; if (j == 3) accl = pj;
            }
            const int jblk = kb * 16 + 8 * (rf >> 1) + 2 * q + (rf & 1);
            SUM4[(wid * 16 + cl) * 64 + jblk] = acc4; LAST[(wid * 16 + cl) * 64 + jblk] = accl;
        }
        __syncthreads();
    }
    {
        const int qi = tid >> 2, jg = tid & 3;
        const int jlim = (jbc + 1) * 16;
        for (int jj = 0; jj < 16; ++jj) {
            const int j = jg * 16 + jj;
            float v = (j < jlim) ? SUM4[qi * 64 + j] : 0.f;
            if (j >= 1 && j - 1 < jlim) v += LAST[qi * 64 + j - 1];
            IMP2[qi * 64 + j] = v;
        }
    }
    __syncthreads();
    {
        const int qi = tid >> 2, jg = tid & 3;
        const float* row = IMP2 + qi * 64;
        float kk[64];
#pragma unroll
        for (int j4 = 0; j4 < 16; ++j4) {
            const f32x4 v = *(const f32x4*)(row + j4 * 4);
#pragma unroll
            for (int e = 0; e < 4; ++e) {
                const int j2 = j4 * 4 + e;
                const bool f2 = (j2 == 0) || (j2 == i) || (j2 == i - 1);
                kk[j2] = (j2 > i) ? -__builtin_inff() : (f2 ? __builtin_inff() : v[e]);
            }
        }
        unsigned lo = 0u;
#pragma unroll 1
        for (int jj = 0; jj < 16; ++jj) {
            const int j = jg * 16 + jj;
            float kj = -__builtin_inff();
#pragma unroll
            for (int j2 = 0; j2 < 64; ++j2) kj = (j2 == j) ? kk[j2] : kj;
            int rank = 0;
#pragma unroll
            for (int j2 = 0; j2 < 64; ++j2) rank += (kk[j2] > kj || (kk[j2] == kj && j2 < j)) ? 1 : 0;
            if (j <= i && rank < 16) lo |= (1u << jj);
        }
        unsigned long long bits = (unsigned long long)lo << (jg * 16);
        bits |= __shfl_xor(bits, 1); bits |= __shfl_xor(bits, 2);
        if (jg == 0) MSKG[((size_t)(b * 2 + k)) * 4096 + U.t0 + qi] = bits;
    }
    __syncthreads();
}

template <int MODE>
DEVI void nsa_kv_unit(const Params& P, rsrc_t rs, int uu, unsigned char* lds, int tid) {
    const int lane = tid & 63, q = lane >> 4;
    const NsaUnit U = nsa_unit(uu, tid);
    const int i = U.i, b = U.b, k = U.k, tq = U.tq;
    AttnState st;
    bf16x8 qf[4][2];
#pragma unroll
    for (int cf = 0; cf < 4; ++cf)
#pragma unroll
        for (int ks = 0; ks < 2; ++ks) qf[cf][ks] = __builtin_bit_cast(bf16x8, bload16(rs, U.qoff, (unsigned)OFF_QBR + U.sQ + cf * 128 + ks * 64));
    const unsigned sK = (unsigned)(OFF_KV + (MODE == 1 ? 2 : 4) * KV_STRIDE) + (unsigned)(b * 2 + k) * 4096u * 128u;
    const unsigned sV = (unsigned)(OFF_KV + (MODE == 1 ? 3 : 5) * KV_STRIDE) + (unsigned)(b * 2 + k) * 64u * 8192u;
    unsigned long long mymask = 0ull;
    int j0 = 0;
    if (MODE == 1) mymask = ((const unsigned long long*)(P.ws + OFF_MASK))[((size_t)(b * 2 + k)) * 4096 + tq];
    else j0 = (i >= 8) ? i - 8 : 0;
    attn_blocks<MODE>(rs, sK, sV, 4096, j0, i, qf, st, tq, mymask, lds, tid);
#pragma unroll
    for (int cf = 0; cf < 4; ++cf) {
        const float l = rows_sum(st.l[cf]);
        const float sc = ((l > 0.f) ? __builtin_amdgcn_rcpf(l) : 0.f) * bload4f(rs, U.goff, U.sG + (MODE == 1 ? 32 : 64) + cf * 4);
#pragma unroll
        for (int d = 0; d < 4; ++d) {
            const u32x2 pw = __builtin_bit_cast(u32x2, __builtin_amdgcn_raw_buffer_load_b64(rs, (int)U.ooff, (int)(U.sO + cf * 128 + d * 32), 0));
            f32x4 v = st.O[d][cf] * sc;
            v[0] += bf2f(pw.x & 0xffffu); v[1] += bf2f(pw.x >> 16); v[2] += bf2f(pw.y & 0xffffu); v[3] += bf2f(pw.y >> 16);
            u32x2 w; w.x = pk2(v[0], v[1]); w.y = pk2(v[2], v[3]);
            __builtin_amdgcn_raw_buffer_store_b64(w, rs, (int)U.ooff, (int)(U.sO + cf * 128 + d * 32), 0);
        }
    }
}

DEVI void phase_nsa(const Params& P, unsigned char* lds, int tid) {
    const rsrc_t rs = __builtin_amdgcn_make_buffer_rsrc((void*)P.ws, (short)0, (int)0x7fffffff, 0x00020000);
    for (int uu = blockIdx.x; uu < 1024; uu += gridDim.x) { int t = tid; asm volatile("" : "+v"(t)); nsa_cmp_unit(P, rs, uu, lds, t); }
    __syncthreads();
    for (int uu = blockIdx.x; uu < 1024; uu += gridDim.x) { int t = tid; asm volatile("" : "+v"(t)); nsa_kv_unit<1>(P, rs, uu, lds, t); }
    __syncthreads();
    for (int uu = blockIdx.x; uu < 1024; uu += gridDim.x) { int t = tid; asm volatile("" : "+v"(t)); nsa_kv_unit<2>(P, rs, uu, lds, t); }
}

DEVI void phase_merge(const Params& P, unsigned char* lds, int tid) {
    unsigned char* ws = P.ws;
    const rsrc_t rs = __builtin_amdgcn_make_buffer_rsrc((void*)P.ws, (short)0, (int)0x7fffffff, 0x00020000);
    const bf16_t* ga = (const bf16_t*)(ws + OFF_GA);
    const bf16_t* gb = (const bf16_t*)(ws + OFF_GB);
    bf16_t* mg = (bf16_t*)(ws + OFF_MERGED);
    const int lane = tid & 63, wid = __builtin_amdgcn_readfirstlane(tid >> 6), wr = wid >> 1, wc = wid & 1, q = lane >> 4, cl = lane & 15;
    for (int kk = 0;; ++kk) {
        int mt, nt;
        if (!tile_map(kk, 8, mt, nt)) break;
        f32x4 acc[4][4];
        unsigned t[4][4][2];
        gemm128(acc, rs, (unsigned)(OFF_OA + (size_t)mt * 128 * 1024), RowLin{1024}, (unsigned)(OFF_WBRA + (size_t)nt * 128 * 1024), RowLin{1024}, 8, lds, tid);
        const size_t e0 = (size_t)(mt * 128 + wr * 64 + cl) * 1024 + nt * 128 + wc * 64 + q * 4;
#pragma unroll
        for (int m = 0; m < 4; ++m)
#pragma unroll
            for (int n = 0; n < 4; ++n) {
                const u32x2 gv = *(const u32x2*)(ga + e0 + (size_t)m * 16 * 1024 + n * 16);
                t[m][n][0] = pk2(acc[m][n][0] * bf2f(gv.x & 0xffffu), acc[m][n][1] * bf2f(gv.x >> 16));
                t[m][n][1] = pk2(acc[m][n][2] * bf2f(gv.y & 0xffffu), acc[m][n][3] * bf2f(gv.y >> 16));
            }
        gemm128(acc, rs, (unsigned)(OFF_OB + (size_t)mt * 128 * 1024), RowLin{1024}, (unsigned)(OFF_WBRB + (size_t)nt * 128 * 1024), RowLin{1024}, 8, lds, tid);
#pragma unroll
        for (int m = 0; m < 4; ++m)
#pragma unroll
            for (int n = 0; n < 4; ++n) {
                const size_t o = e0 + (size_t)m * 16 * 1024 + n * 16;
                const u32x2 gv = *(const u32x2*)(gb + o);
                u32x2 w;
                w.x = pk2(bf2f(t[m][n][0] & 0xffffu) + acc[m][n][0] * bf2f(gv.x & 0xffffu), bf2f(t[m][n][0] >> 16) + acc[m][n][1] * bf2f(gv.x >> 16));
                w.y = pk2(bf2f(t[m][n][1] & 0xffffu) + acc[m][n][2] * bf2f(gv.y & 0xffffu), bf2f(t[m][n][1] >> 16) + acc[m][n][3] * bf2f(gv.y >> 16));
                *(u32x2*)(mg + o) = w;
            }
    }
}

DEVI void phase_outproj(const Params& P, unsigned char* lds, int tid) {
    unsigned char* ws = P.ws;
    const rsrc_t rs = __builtin_amdgcn_make_buffer_rsrc((void*)P.ws, (short)0, (int)0x7fffffff, 0x00020000);
    const bf16_t* mg = (const bf16_t*)(ws + OFF_MERGED);
    const bf16_t* wo = (const bf16_t*)(ws + OFF_WOUT);
    const float* x = P.in[0];
    float* x1 = P.out;
    const int lane = tid & 63, wid = __builtin_amdgcn_readfirstlane(tid >> 6), wr = wid >> 1, wc = wid & 1, q = lane >> 4, cl = lane & 15;
    for (int kk = 0;; ++kk) {
        int mt, nt;
        if (!tile_map(kk, 8, mt, nt)) break;
        f32x4 acc[4][4];
        gemm128(acc, rs, (unsigned)(OFF_MERGED + (size_t)mt * 128 * 2048), RowLin{2048}, (unsigned)(OFF_WOUT + (size_t)nt * 128 * 2048), RowLin{2048}, 16, lds, tid);
#pragma unroll
        for (int m = 0; m < 4; ++m)
#pragma unroll
            for (int n = 0; n < 4; ++n) {
                const size_t o = (size_t)(mt * 128 + wr * 64 + m * 16 + cl) * 1024 + nt * 128 + wc * 64 + n * 16 + q * 4;
                *(f32x4*)(x1 + o) = *(const f32x4*)(x + o) + acc[m][n];
            }
    }
}

DEVI void phase_router(const Params& P, unsigned char* lds, int tid) {
    unsigned char* ws = P.ws;
    const int lane = tid & 63, wid = __builtin_amdgcn_readfirstlane(tid >> 6), q = lane >> 4, cl = lane & 15;
    const float* x1 = P.out; const float* g = P.in[13];
    const float* bg = P.in[15]; const float* be = P.in[17];
    const float* WR = (const float*)(ws + OFF_WR);
    bf16_t* h2 = (bf16_t*)(ws + OFF_HN);
    unsigned* cnt = (unsigned*)(ws + OFF_CTL);
    int* list = (int*)(ws + OFF_LIST);
    float* wt = (float*)(ws + OFF_WT);
    float* WL = (float*)lds;
    float* LG = (float*)(lds + 50688);
    float* RS = (float*)(lds + 50688 + 12288);
    for (int u = blockIdx.x; u < NTOK / 64; u += gridDim.x) {
        const int row0 = u * 64 + wid * 16;
        const float* xa = x1 + (size_t)(row0 + cl) * 1024 + 4 * q;
        f32x4 acc[3];
#pragma unroll
        for (int ct = 0; ct < 3; ++ct) acc[ct] = (f32x4){0.f, 0.f, 0.f, 0.f};
        float ss = 0.f;
        for (int kc = 0; kc < 4; ++kc) {
            __syncthreads();
#pragma unroll
            for (int i = 0; i < 12; ++i) {
                const int idx = tid + 256 * i, r = idx >> 6, c4 = idx & 63;
                *(f32x4*)(WL + r * 264 + c4 * 4) = *(const f32x4*)(WR + (size_t)r * 1024 + kc * 256 + c4 * 4);
            }
            __syncthreads();
#pragma unroll
            for (int jh = 0; jh < 2; ++jh) {
                f32x4 av[8];
#pragma unroll
                for (int j = 0; j < 8; ++j) av[j] = *(const f32x4*)(xa + kc * 256 + (jh * 8 + j) * 16);
#pragma unroll
                for (int j = 0; j < 8; ++j) {
                    {
                        const int kx = kc * 256 + (jh * 8 + j) * 16 + 4 * q;
                        const f32x4 gg = *(const f32x4*)(g + kx);
                        u32x2 w; w.x = pk2(av[j][0] * gg[0], av[j][1] * gg[1]); w.y = pk2(av[j][2] * gg[2], av[j][3] * gg[3]);
                        *(u32x2*)(h2 + (size_t)(row0 + cl) * 1024 + kx) = w;
                    }
                    ss += av[j][0] * av[j][0] + av[j][1] * av[j][1] + av[j][2] * av[j][2] + av[j][3] * av[j][3];
#pragma unroll
                    for (int ct = 0; ct < 3; ++ct) {
                        const f32x4 bv = *(const f32x4*)(WL + (ct * 16 + cl) * 264 + (jh * 8 + j) * 16 + 4 * q);
#pragma unroll
                        for (int e = 0; e < 4; ++e) acc[ct] = __builtin_amdgcn_mfma_f32_16x16x4f32(av[j][e], bv[e], acc[ct], 0, 0, 0);
                    }
                }
            }
        }
        ss += __shfl_xor(ss, 16); ss += __shfl_xor(ss, 32);
        const float rs = rsqrtf(ss * (1.0f / 1024.0f) + RMS_EPS);
        if (q == 0) { RS[wid * 16 + cl] = rs; ((float*)(ws + OFF_RS))[row0 + cl] = rs; }
        __syncthreads();
#pragma unroll
        for (int j = 0; j < 4; ++j) {
            const float rj = RS[wid * 16 + 4 * q + j];
#pragma unroll
            for (int ct = 0; ct < 3; ++ct) LG[(wid * 16 + 4 * q + j) * 48 + ct * 16 + cl] = acc[ct][j] * rj;
        }
        __syncthreads();
        if (tid < 64) {
            const int r = u * 64 + tid;
            const float* lg = LG + tid * 48;
            float gl[4];
#pragma unroll
            for (int e = 0; e < 4; ++e) gl[e] = lg[e] + bg[e];
            int gs = 0; float gm = gl[0];
#pragma unroll
            for (int e = 1; e < 4; ++e) if (gl[e] > gm) { gm = gl[e]; gs = e; }
            float den = 0.f;
#pragma unroll
            for (int e = 0; e < 4; ++e) den += __expf(gl[e] - gm);
            const float gp = 1.0f / den;
            float el[8];
#pragma unroll
            for (int e = 0; e < 8; ++e) el[e] = lg[4 + gs * 8 + e] + be[gs * 8 + e];
            int i0 = 0; float v0 = el[0];
#pragma unroll
            for (int e = 1; e < 8; ++e) if (el[e] > v0) { v0 = el[e]; i0 = e; }
            int i1 = -1; float v1 = -__builtin_inff();
#pragma unroll
            for (int e = 0; e < 8; ++e) if (e != i0 && el[e] > v1) { v1 = el[e]; i1 = e; }
            const float e1 = __expf(v1 - v0);
            const float w0 = gp / (1.0f + e1), w1 = gp * e1 / (1.0f + e1);
            const int ex0 = gs * 8 + i0, ex1 = gs * 8 + i1;
            const unsigned p0 = atomicAdd(&cnt[ex0], 1u);
            list[(size_t)ex0 * NTOK + p0] = r * 2 + 0;
            const unsigned p1 = atomicAdd(&cnt[ex1], 1u);
            list[(size_t)ex1 * NTOK + p1] = r * 2 + 1;
            wt[(size_t)r * 2 + 0] = w0; wt[(size_t)r * 2 + 1] = w1;
        }
    }
}

struct RowGather { const int* idx; DEVI unsigned operator()(int r) const { return (unsigned)idx[r] * 2048u; } };
struct RowGU { int c0; DEVI unsigned operator()(int r) const {
    const int wcx = r >> 6, w = r & 63; const int col = (w < 32) ? (c0 + wcx * 32 + w) : (256 + c0 + wcx * 32 + (w - 32)); return (unsigned)col * 2048u; } };

DEVI int moe_find_tile(const unsigned* cnt, int u, int& e, int& tl) {
    int t = u, ee = 0, ce = 0;
    for (; ee < 32; ++ee) { ce = (int)cnt[ee]; const int nt = (ce + 127) >> 7; if (t < nt) break; t -= nt; }
    e = ee; tl = t; return ce;
}
DEVI void phase_moe_a(const Params& P, unsigned char* lds, int tid) {
    unsigned char* ws = P.ws;
    const rsrc_t rs = __builtin_amdgcn_make_buffer_rsrc((void*)P.ws, (short)0, (int)0x7fffffff, 0x00020000);
    const int lane = tid & 63, wid = __builtin_amdgcn_readfirstlane(tid >> 6), wr = wid >> 1, wc = wid & 1, q = lane >> 4, cl = lane & 15;
    const unsigned* cnt = (const unsigned*)(ws + OFF_CTL);
    const int* list = (const int*)(ws + OFF_LIST);
    bf16_t* act = (bf16_t*)(ws + OFF_ACT);
    int* rowtok = (int*)(lds + 65536);
    const float* RSG = (const float*)(ws + OFF_RS);
    int total = 0;
    for (int e = 0; e < 32; ++e) total += ((int)cnt[e] + 127) >> 7;
    for (int v = blockIdx.x; v < total * 4; v += gridDim.x) {
        const int u = v >> 2, nt = v & 3;
        int e, tl; const int ce = moe_find_tile(cnt, u, e, tl);
        if (tid < 128) { const int r = tl * 128 + tid; rowtok[tid] = (r < ce) ? (list[(size_t)e * NTOK + r] >> 1) : 0; }
        __syncthreads();
        bf16_t* au = act + (size_t)u * 128 * 256;
        f32x4 acc[4][4];
        gemm128(acc, rs, (unsigned)OFF_HN, RowGather{rowtok}, (unsigned)(OFF_WGU + (size_t)e * 512 * 2048), RowGU{nt * 64}, 16, lds, tid);
#pragma unroll
        for (int m = 0; m < 4; ++m)
#pragma unroll
            for (int n = 0; n < 2; ++n) {
                const int row = wr * 64 + m * 16 + cl, col = nt * 64 + wc * 32 + n * 16 + q * 4;
                const float rsv = RSG[rowtok[row]];
                const f32x4 gt = acc[m][n] * rsv, up = acc[m][n + 2] * rsv;
                u32x2 w;
                w.x = pk2(siluf_(gt[0]) * up[0], siluf_(gt[1]) * up[1]);
                w.y = pk2(siluf_(gt[2]) * up[2], siluf_(gt[3]) * up[3]);
                *(u32x2*)(au + (size_t)row * 256 + col) = w;
            }
        __syncthreads();
    }
}
DEVI void phase_moe_b(const Params& P, unsigned char* lds, int tid) {
    unsigned char* ws = P.ws;
    const rsrc_t rs = __builtin_amdgcn_make_buffer_rsrc((void*)P.ws, (short)0, (int)0x7fffffff, 0x00020000);
    const int lane = tid & 63, wid = __builtin_amdgcn_readfirstlane(tid >> 6), wr = wid >> 1, wc = wid & 1, q = lane >> 4, cl = lane & 15;
    const unsigned* cnt = (const unsigned*)(ws + OFF_CTL);
    const int* list = (const int*)(ws + OFF_LIST);
    bf16_t* Y = (bf16_t*)(ws + OFF_Y);
    int* rowas = (int*)(lds + 65536);
    int total = 0;
    for (int e = 0; e < 32; ++e) total += ((int)cnt[e] + 127) >> 7;
    for (int v = blockIdx.x; v < total * 4; v += gridDim.x) {
        const int u = v >> 2, np = v & 3;
        int e, tl; const int ce = moe_find_tile(cnt, u, e, tl);
        if (tid < 128) { const int r = tl * 128 + tid; rowas[tid] = (r < ce) ? list[(size_t)e * NTOK + r] : -1; }
        __syncthreads();
        for (int h = 0; h < 2; ++h) {
            const int nt = np * 2 + h;
            f32x4 acc[4][4];
            gemm128(acc, rs, (unsigned)(OFF_ACT + (size_t)u * 128 * 512), RowLin{512}, (unsigned)(OFF_WDN + (size_t)e * 1024 * 512 + (size_t)nt * 128 * 512), RowLin{512}, 4, lds, tid);
#pragma unroll
            for (int m = 0; m < 4; ++m) {
                const int row = wr * 64 + m * 16 + cl;
                const int as = rowas[row];
                if (as >= 0) {
                    bf16_t* yr = Y + ((size_t)(as & 1) * NTOK + (as >> 1)) * 1024 + nt * 128 + wc * 64 + q * 4;
#pragma unroll
                    for (int n = 0; n < 4; ++n) { u32x2 w; w.x = pk2(acc[m][n][0], acc[m][n][1]); w.y = pk2(acc[m][n][2], acc[m][n][3]); *(u32x2*)(yr + n * 16) = w; }
                }
            }
        }
        __syncthreads();
    }
}

DEVI void phase_final(const Params& P, int tid, bool with_moe) {
    unsigned char* ws = P.ws;
    const int lane = tid & 63, wid = __builtin_amdgcn_readfirstlane(tid >> 6);
    const bf16_t* Y = (const bf16_t*)(ws + OFF_Y);
    const float* wt = (const float*)(ws + OFF_WT);
    const float* g = P.in[20];
    float* out = P.out;
    for (int r = blockIdx.x * 4 + wid; r < NTOK; r += gridDim.x * 4) {
        float* xr = out + (size_t)r * 1024;
        const float w0 = with_moe ? wt[(size_t)r * 2] : 0.f, w1 = with_moe ? wt[(size_t)r * 2 + 1] : 0.f;
        f32x4 v[4]; float ss = 0.f;
#pragma unroll
        for (int i = 0; i < 4; ++i) {
            v[i] = *(const f32x4*)(xr + i * 256 + lane * 4);
            if (with_moe) {
                const u32x2 a = *(const u32x2*)(Y + (size_t)r * 1024 + i * 256 + lane * 4);
                const u32x2 b = *(const u32x2*)(Y + ((size_t)NTOK + r) * 1024 + i * 256 + lane * 4);
                v[i][0] += w0 * bf2f(a.x & 0xffffu) + w1 * bf2f(b.x & 0xffffu); v[i][1] += w0 * bf2f(a.x >> 16) + w1 * bf2f(b.x >> 16);
                v[i][2] += w0 * bf2f(a.y & 0xffffu) + w1 * bf2f(b.y & 0xffffu); v[i][3] += w0 * bf2f(a.y >> 16) + w1 * bf2f(b.y >> 16);
            }
            ss += v[i][0] * v[i][0] + v[i][1] * v[i][1] + v[i][2] * v[i][2] + v[i][3] * v[i][3];
        }
        ss = wave_sum(ss);
        const float rs = rsqrtf(ss * (1.0f / 1024.0f) + RMS_EPS);
#pragma unroll
        for (int i = 0; i < 4; ++i) {
            const f32x4 gg = *(const f32x4*)(g + i * 256 + lane * 4);
            f32x4 o; o[0] = v[i][0] * rs * gg[0]; o[1] = v[i][1] * rs * gg[1]; o[2] = v[i][2] * rs * gg[2]; o[3] = v[i][3] * rs * gg[3];
            *(f32x4*)(xr + i * 256 + lane * 4) = o;
        }
    }
}

#define LAUNDER_TID() do { tid = wave_id * 64 + (int)__builtin_amdgcn_mbcnt_hi(~0u, __builtin_amdgcn_mbcnt_lo(~0u, 0u)); asm volatile("" : "+v"(tid)); } while (0)
__global__ void __launch_bounds__(NTHREADS, 2) fwd_megakernel(Params P) {
    extern __shared__ __attribute__((aligned(16))) unsigned char lds[];
    cg::grid_group grid = cg::this_grid();
    int tid;
    const int wave_id = __builtin_amdgcn_readfirstlane((int)(threadIdx.x >> 6));
    volatile LAS unsigned* bst = (volatile LAS unsigned*)(LAS unsigned char*)(lds + LDS_BYTES - 16);
    if (threadIdx.x < 4) bst[threadIdx.x] = 0u;
    __syncthreads();
    (void)xcd_barrier_post((unsigned*)(P.ws + OFF_BAR), bst);
#define GRID_BARRIER() do { XcdBarrier b_; b_.bar = (unsigned*)(P.ws + OFF_BAR); b_.x = xb_xcc_id(); b_.st = (volatile LAS unsigned*)(LAS unsigned char*)(lds + LDS_BYTES - 16); xcd_barrier(b_); } while (0)
    if (P.ph_lo != 0) grid.sync();
    LAUNDER_TID(); phase_prep(P, lds, tid, 0); __syncthreads();
    GRID_BARRIER();
    {
        const int first_idx = (blockIdx.x >> 8) & 1;
        for (int step = 0; step < 3; ++step) {
            const int what = (step == 0) ? 0 : 1 + ((step - 1) ^ first_idx);
            if (what <= 1) { LAUNDER_TID(); phase_gemm1(P, lds, tid, what); }
            else {
                LAUNDER_TID(); phase_prep(P, lds, tid, 1); __syncthreads();
                LAUNDER_TID(); phase_compress(P, lds, tid); __syncthreads();
                LAUNDER_TID(); phase_index(P, lds, tid);
            }
            __syncthreads();
            if (step == 0) GRID_BARRIER();
        }
    }
    GRID_BARRIER();
    if (((blockIdx.x >> 8) & 1) == 0) { LAUNDER_TID(); phase_dsa(P, lds, tid); __syncthreads(); }
    LAUNDER_TID(); phase_nsa(P, lds, tid); __syncthreads();
    if (((blockIdx.x >> 8) & 1) != 0) { LAUNDER_TID(); phase_dsa(P, lds, tid); __syncthreads(); }
    GRID_BARRIER();
    LAUNDER_TID(); phase_merge(P, lds, tid);
    GRID_BARRIER();
    LAUNDER_TID(); phase_outproj(P, lds, tid);
    GRID_BARRIER();
    LAUNDER_TID(); phase_router(P, lds, tid);
    GRID_BARRIER();
    LAUNDER_TID(); phase_moe_a(P, lds, tid);
    GRID_BARRIER();
    LAUNDER_TID(); phase_moe_b(P, lds, tid);
    GRID_BARRIER();
    LAUNDER_TID(); phase_final(P, tid, true);
}

extern "C" void kernel_launch(void* const* d_in, const int* in_sizes, int n_in, void* d_out, int out_size, void* d_ws, size_t ws_size,
                              hipStream_t stream) {
    static int grid_blocks = 0;
    if (!grid_blocks) {
        int dev = 0, cus = 0, per_cu = 0;
        hipGetDevice(&dev);
        hipDeviceGetAttribute(&cus, hipDeviceAttributeMultiprocessorCount, dev);
        hipFuncSetAttribute((const void*)fwd_megakernel, hipFuncAttributeMaxDynamicSharedMemorySize, LDS_BYTES);
        hipOccupancyMaxActiveBlocksPerMultiprocessor(&per_cu, (const void*)fwd_megakernel, NTHREADS, LDS_BYTES);
        if (per_cu < 1) per_cu = 1;
        if (per_cu > 2) per_cu = 2;
        grid_blocks = cus * per_cu;
        if (ws_size < WS_END) fprintf(stderr, "kernel_launch: workspace too small: %zu < %zu\n", ws_size, (size_t)WS_END);
    }
    Params p{};
    for (int i = 0; i < 21; ++i) p.in[i] = (const float*)d_in[i];
    p.pos = (const int*)d_in[1];
    p.out = (float*)d_out;
    p.ws = (unsigned char*)d_ws;
    for (int i = 0; i < 32; ++i) p.inv_freq[i] = (double)powf(10000.0f, -(float)i / 32.0f);
    p.ph_lo = 0; p.ph_hi = 0;
    (void)hipMemsetAsync(d_ws, 0, OFF_WIN_T, stream);
    void* args[] = {&p};
    hipError_t e = hipLaunchCooperativeKernel((const void*)fwd_megakernel, dim3(grid_blocks), dim3(NTHREADS), args, LDS_BYTES, stream);
    if (e != hipSuccess) fprintf(stderr, "cooperative launch failed: %s (grid %d)\n", hipGetErrorString(e), grid_blocks);
}
```

```cpp
#include <hip/hip_runtime.h>
#include <hip/hip_cooperative_groups.h>
#include <cstdint>
#include <cstdio>
#include <cmath>
namespace cg = cooperative_groups;

#define DEVI __device__ __forceinline__
#ifndef PROBE_TWICE
#define PROBE_TWICE 0
#endif
#define REPS(k) ((PROBE_TWICE == (k)) ? 2 : 1)
typedef unsigned short bf16_t;
typedef short bf16x8 __attribute__((ext_vector_type(8)));
typedef short s16x4 __attribute__((ext_vector_type(4)));
typedef float f32x4 __attribute__((ext_vector_type(4)));
typedef float f32x2 __attribute__((ext_vector_type(2)));
typedef unsigned u32x4 __attribute__((ext_vector_type(4)));
typedef unsigned u32x2 __attribute__((ext_vector_type(2)));
#define LAS __attribute__((address_space(3)))

constexpr int NB = 8, SL = 4096, DM = 1024, NTOK = NB * SL;
constexpr int INW = 4288;
constexpr int NTHREADS = 256;
constexpr int LDS_BYTES = 81920;
constexpr float RMS_EPS = 1e-6f;
constexpr float LOG2E = 1.4426950408889634f;

constexpr int WIN_ROWS = 4352;
constexpr int G1_COLS = 4352;

constexpr size_t al256(size_t x) { return (x + 255) & ~(size_t)255; }
constexpr size_t OFF_CTL   = 0;
constexpr size_t OFF_BAR   = 4096;
constexpr size_t OFF_WIN_T = 32768;
constexpr size_t OFF_WBRA  = OFF_WIN_T + (size_t)WIN_ROWS * 1024 * 2;
constexpr size_t OFF_WBRB  = OFF_WBRA + (size_t)1024 * 512 * 2;
constexpr size_t OFF_WOUT  = OFF_WBRB + (size_t)1024 * 512 * 2;
constexpr size_t OFF_W1K   = OFF_WOUT + (size_t)1024 * 1024 * 2;
constexpr size_t OFF_W1V   = OFF_W1K + (size_t)128 * 2048 * 2;
constexpr size_t OFF_W2K   = OFF_W1V + (size_t)128 * 2048 * 2;
constexpr size_t OFF_W2V   = OFF_W2K + (size_t)64 * 128 * 2;
constexpr size_t OFF_WGU   = OFF_W2V + (size_t)64 * 128 * 2;
constexpr size_t OFF_WDN   = OFF_WGU + (size_t)32 * 512 * 1024 * 2;
constexpr size_t OFF_BIAS1 = OFF_WDN + (size_t)32 * 1024 * 256 * 2;
constexpr size_t OFF_WR    = OFF_BIAS1 + 1024;
constexpr size_t OFF_CS    = OFF_WR + (size_t)48 * 1024 * 4;
constexpr size_t OFF_HN    = OFF_CS + (size_t)NTOK * 32 * 8;
constexpr size_t OFF_QA    = OFF_HN + (size_t)NTOK * 1024 * 2;
constexpr size_t OFF_KA    = OFF_QA + (size_t)NTOK * 512 * 2;
constexpr size_t OFF_VA    = OFF_KA + (size_t)NTOK * 64 * 2;
constexpr size_t OFF_QI    = OFF_VA + (size_t)NTOK * 64 * 2;
constexpr size_t OFF_KI    = OFF_QI + (size_t)NTOK * 256 * 2;
constexpr size_t OFF_WI    = OFF_KI + (size_t)NTOK * 32 * 2;
constexpr size_t OFF_QBN   = OFF_WI + (size_t)NTOK * 8 * 4;
constexpr size_t OFF_QBR   = OFF_QBN + (size_t)NTOK * 512 * 2;
constexpr size_t KV_STRIDE = (size_t)NTOK * 128 * 2 + 65536 * 4;
constexpr size_t OFF_KV    = OFF_QBR + (size_t)NTOK * 512 * 2;
constexpr size_t OFF_GATES = OFF_KV + 6 * KV_STRIDE;
constexpr size_t OFF_QKV_END = OFF_GATES + (size_t)NTOK * 24 * 4;
constexpr size_t OFF_KC    = al256(OFF_QKV_END);
constexpr size_t OFF_VCT   = OFF_KC + (size_t)16 * 256 * 64 * 2;
constexpr size_t OFF_SEL   = OFF_VCT + (size_t)16 * 256 * 64 * 2;
constexpr size_t OFF_OA    = OFF_HN;
constexpr size_t OFF_OB    = OFF_OA + (size_t)NTOK * 512 * 2;
constexpr size_t OFF_GA    = OFF_SEL + (size_t)NTOK * 256 * 2;
constexpr size_t OFF_GB    = OFF_GA + (size_t)NTOK * 1024 * 2;
constexpr size_t OFF_MASK  = OFF_GB + (size_t)NTOK * 1024 * 2;
constexpr size_t OFF_LIST  = OFF_MASK + (size_t)16 * 4096 * 8;
constexpr size_t OFF_WT    = OFF_LIST + (size_t)32 * NTOK * 4;
constexpr size_t OFF_RS    = OFF_WT + (size_t)NTOK * 2 * 4;
constexpr size_t WS_END    = OFF_RS + (size_t)NTOK * 4;
constexpr size_t OFF_MERGED = OFF_QA;
constexpr size_t OFF_ACT    = OFF_QA;
constexpr size_t OFF_Y      = OFF_QA + (size_t)40 * 1024 * 1024;
static_assert(OFF_Y + (size_t)2 * NTOK * 1024 * 2 <= OFF_QKV_END, "Y overlay");
static_assert((size_t)544 * 128 * 256 * 2 <= (size_t)40 * 1024 * 1024, "ACT overlay");

struct Params {
    const float* in[21];
    const int* pos;
    float* out;
    unsigned char* ws;
    double inv_freq[32];
    int ph_lo, ph_hi;
};

DEVI unsigned f2bf(float f) { unsigned u = __float_as_uint(f); return (u + 0x7fffu + ((u >> 16) & 1u)) >> 16; }
typedef __bf16 bf16v2_t __attribute__((ext_vector_type(2)));
DEVI unsigned pk2(float lo, float hi) { const f32x2 v = {lo, hi}; return __builtin_bit_cast(unsigned, __builtin_convertvector(v, bf16v2_t)); }
DEVI float rows_max(float x) {
    float a = x, b = x;
    asm volatile("v_nop\n\tv_nop\n\tv_permlane16_swap_b32 %0, %1" : "+v"(a), "+v"(b));
    x = fmaxf(a, b); a = x; b = x;
    asm volatile("v_nop\n\tv_nop\n\tv_permlane32_swap_b32 %0, %1" : "+v"(a), "+v"(b));
    return fmaxf(a, b);
}
DEVI float rows_sum(float x) {
    float a = x, b = x;
    asm volatile("v_nop\n\tv_nop\n\tv_permlane16_swap_b32 %0, %1" : "+v"(a), "+v"(b));
    x = a + b; a = x; b = x;
    asm volatile("v_nop\n\tv_nop\n\tv_permlane32_swap_b32 %0, %1" : "+v"(a), "+v"(b));
    return a + b;
}
DEVI float bf2f(unsigned h) { return __uint_as_float(h << 16); }
DEVI float sigmoidf_(float x) { return __builtin_amdgcn_rcpf(1.0f + __builtin_amdgcn_exp2f(-x * 1.4426950408889634f)); }
DEVI float wave_sum(float v) {
#pragma unroll
    for (int o = 32; o > 0; o >>= 1) v += __shfl_xor(v, o);
    return v;
}
DEVI int wave_sum_i32(int v) {
    v += __builtin_amdgcn_update_dpp(0, v, 0xB1, 0xF, 0xF, true);
    v += __builtin_amdgcn_update_dpp(0, v, 0x4E, 0xF, 0xF, true);
    v += __builtin_amdgcn_update_dpp(0, v, 0x141, 0xF, 0xF, true);
    v += __builtin_amdgcn_update_dpp(0, v, 0x140, 0xF, 0xF, true);
    return __builtin_amdgcn_readlane(v, 0) + __builtin_amdgcn_readlane(v, 16) + __builtin_amdgcn_readlane(v, 32) + __builtin_amdgcn_readlane(v, 48);
}
DEVI float wave_sum_f32_dpp(float v) {
    v += __builtin_bit_cast(float, __builtin_amdgcn_update_dpp(0, __builtin_bit_cast(int, v), 0xB1, 0xF, 0xF, true));
    v += __builtin_bit_cast(float, __builtin_amdgcn_update_dpp(0, __builtin_bit_cast(int, v), 0x4E, 0xF, 0xF, true));
    v += __builtin_bit_cast(float, __builtin_amdgcn_update_dpp(0, __builtin_bit_cast(int, v), 0x141, 0xF, 0xF, true));
    v += __builtin_bit_cast(float, __builtin_amdgcn_update_dpp(0, __builtin_bit_cast(int, v), 0x140, 0xF, 0xF, true));
    const int iv = __builtin_bit_cast(int, v);
    return (__builtin_bit_cast(float, __builtin_amdgcn_readlane(iv, 0)) + __builtin_bit_cast(float, __builtin_amdgcn_readlane(iv, 16))) +
           (__builtin_bit_cast(float, __builtin_amdgcn_readlane(iv, 32)) + __builtin_bit_cast(float, __builtin_amdgcn_readlane(iv, 48)));
}
DEVI bf16x8 pack8(const f32x4& a, const f32x4& b) {
    u32x4 w; w.x = pk2(a[0], a[1]); w.y = pk2(a[2], a[3]); w.z = pk2(b[0], b[1]); w.w = pk2(b[2], b[3]);
    return __builtin_bit_cast(bf16x8, w);
}
#define MFMA16(a, b, c) __builtin_amdgcn_mfma_f32_16x16x32_bf16((a), (b), (c), 0, 0, 0)


#define XB_TMO      128
#define XB_XCNT(j)  (256  + 64 * (j))
#define XB_XSUB(j)  (1280 + 64 * (j))
#define XB_XGEN(j)  (2304 + 64 * (j))
#define XB_TOP      3328
#define XB_TOPGEN   3392
#define XCD_BAR_WORDS 3456
#define XB_SPIN_CAP (1u << 22)
DEVI unsigned xb_ld(unsigned* p)              { return __hip_atomic_load(p, __ATOMIC_RELAXED, __HIP_MEMORY_SCOPE_AGENT); }
DEVI unsigned xb_add(unsigned* p, unsigned v) { return __hip_atomic_fetch_add(p, v, __ATOMIC_RELAXED, __HIP_MEMORY_SCOPE_AGENT); }
DEVI unsigned xb_xcc_id() { return (unsigned)__builtin_amdgcn_s_getreg((3 << 11) | 20) & 0xFu; }
#define XB_SPIN(cond, bar) do { unsigned _sp = 0; while (cond) { __builtin_amdgcn_s_sleep(1); \
    if ((++_sp & 255u) == 0u) { if (xb_ld(&(bar)[XB_TMO])) break; if (_sp > XB_SPIN_CAP) { atomicAdd(&(bar)[XB_TMO], 1u); break; } } } } while (0)
struct XcdBarrier { unsigned* bar; unsigned x; volatile LAS unsigned* st; };
DEVI XcdBarrier xcd_barrier_post(unsigned* bar, volatile LAS unsigned* st) {
    XcdBarrier b; b.bar = bar; b.x = xb_xcc_id(); b.st = st;
    if (threadIdx.x == 0) (void)xb_add(&bar[XB_XCNT(b.x)], 1u);
    return b;
}
DEVI void xcd_barrier_complete(unsigned* bar, unsigned x, unsigned& nloc, unsigned& nx) {
    const unsigned G = gridDim.x * gridDim.y * gridDim.z;
    unsigned sum, cnt, mine, sp = 0u;
    for (;;) {
        sum = 0u; cnt = 0u; mine = 0u;
#pragma unroll
        for (unsigned j = 0; j < 16; ++j) { const unsigned c = xb_ld(&bar[XB_XCNT(j)]); sum += c; cnt += (c > 0u) ? 1u : 0u; mine = (j == x) ? c : mine; }
        if (sum == G) break;
        __builtin_amdgcn_s_sleep(1);
        if ((++sp & 255u) == 0u) { if (xb_ld(&bar[XB_TMO])) break; if (sp > XB_SPIN_CAP) { atomicAdd(&bar[XB_TMO], 1u); break; } }
    }
    nloc = mine > 0u ? mine : 1u; nx = cnt > 0u ? cnt : 1u;
}
DEVI void xcd_barrier(const XcdBarrier& b) {
    asm volatile("s_waitcnt vmcnt(0)" ::: "memory");
    __syncthreads();
    if (threadIdx.x == 0) {
        unsigned* bar = b.bar;
        __builtin_amdgcn_s_waitcnt(0);
        unsigned nloc = b.st[0], nx = b.st[1];
        if (nloc == 0u) { xcd_barrier_complete(bar, b.x, nloc, nx); b.st[0] = nloc; b.st[1] = nx; }
        const unsigned old = xb_add(&bar[XB_XSUB(b.x)], 1u);
        const unsigned gen = old / nloc;
        if (old + 1u == (gen + 1u) * nloc) {
            __builtin_amdgcn_fence(__ATOMIC_RELEASE, "agent");
            asm volatile("s_waitcnt vmcnt(0)" ::: "memory");
            const unsigned og = xb_add(&bar[XB_TOP], 1u);
            const unsigned tg = og / nx;
            if (og + 1u == (tg + 1u) * nx) xb_add(&bar[XB_TOPGEN], 1u);
            else XB_SPIN(xb_ld(&bar[XB_TOPGEN]) == tg, bar);
            __builtin_amdgcn_fence(__ATOMIC_ACQUIRE, "agent");
            xb_add(&bar[XB_XGEN(b.x)], 1u);
            asm volatile("s_waitcnt vmcnt(0)" ::: "memory");
        } else {
            XB_SPIN(xb_ld(&bar[XB_XGEN(b.x)]) == gen, bar);
            __builtin_amdgcn_fence(__ATOMIC_ACQUIRE, "agent");
            asm volatile("s_waitcnt vmcnt(0)" ::: "memory");
        }
    }
    __syncthreads();
}

typedef __amdgpu_buffer_rsrc_t rsrc_t;
DEVI u32x4 bload16(rsrc_t r, unsigned voff, unsigned soff) { return __builtin_bit_cast(u32x4, __builtin_amdgcn_raw_buffer_load_b128(r, (int)voff, (int)soff, 0)); }
DEVI void glds16(rsrc_t r, unsigned char* lds_dst_uniform, unsigned voff, unsigned soff) {
    __builtin_amdgcn_raw_ptr_buffer_load_lds(r, (LAS void*)lds_dst_uniform, 16, (int)voff, (int)soff, 0, 0);
}
template <class FA, class FB>
DEVI void gemm128(f32x4 (&acc)[4][4], rsrc_t rs, unsigned sA, const FA& offA, unsigned sB, const FB& offB, int nk, unsigned char* lds, int tid) {
    const int lane = tid & 63, wid = __builtin_amdgcn_readfirstlane(tid >> 6), wr = wid >> 1, wc = wid & 1;
    const int lr = tid >> 3;
    const unsigned csrc = (unsigned)(((lane & 7) ^ ((lane >> 3) & 7)) << 4);
    unsigned oa[4], ob[4];
#pragma unroll
    for (int i = 0; i < 4; ++i) { oa[i] = offA(lr + 32 * i) + csrc; ob[i] = offB(lr + 32 * i) + csrc; }
#pragma unroll
    for (int m = 0; m < 4; ++m)
#pragma unroll
        for (int n = 0; n < 4; ++n) acc[m][n] = (f32x4){0.f, 0.f, 0.f, 0.f};
    const int q = lane >> 4, r16 = lane & 15;
    const int roffA0 = (wr * 64 + r16) * 128 + (((0 + q) ^ (lane & 7)) << 4);
    const int roffA1 = (wr * 64 + r16) * 128 + (((4 + q) ^ (lane & 7)) << 4);
    const int roffB0 = 16384 + (wc * 64 + r16) * 128 + (((0 + q) ^ (lane & 7)) << 4);
    const int roffB1 = 16384 + (wc * 64 + r16) * 128 + (((4 + q) ^ (lane & 7)) << 4);
    unsigned char* wbase = lds + wid * 1024;
#pragma unroll
    for (int i = 0; i < 4; ++i) { glds16(rs, wbase + i * 4096, oa[i], sA); glds16(rs, wbase + 16384 + i * 4096, ob[i], sB); }
    for (int kt = 0; kt < nk; ++kt) {
        unsigned char* cur = lds + (kt & 1) * 32768;
        __syncthreads();
        if (kt + 1 < nk) {
            unsigned char* nb = wbase + ((kt + 1) & 1) * 32768;
#pragma unroll
            for (int i = 0; i < 4; ++i) { glds16(rs, nb + i * 4096, oa[i], sA + (kt + 1) * 128); glds16(rs, nb + 16384 + i * 4096, ob[i], sB + (kt + 1) * 128); }
        }
        bf16x8 a0[4], b0[4], a1[4], b1[4];
#pragma unroll
        for (int m = 0; m < 4; ++m) a0[m] = *(const bf16x8*)(cur + roffA0 + m * 2048);
#pragma unroll
        for (int n = 0; n < 4; ++n) b0[n] = *(const bf16x8*)(cur + roffB0 + n * 2048);
#pragma unroll
        for (int m = 0; m < 4; ++m) a1[m] = *(const bf16x8*)(cur + roffA1 + m * 2048);
#pragma unroll
        for (int n = 0; n < 4; ++n) b1[n] = *(const bf16x8*)(cur + roffB1 + n * 2048);
#pragma unroll
        for (int m = 0; m < 4; ++m)
#pragma unroll
            for (int n = 0; n < 4; ++n) acc[m][n] = MFMA16(b0[n], a0[m], acc[m][n]);
#pragma unroll
        for (int m = 0; m < 4; ++m)
#pragma unroll
            for (int n = 0; n < 4; ++n) acc[m][n] = MFMA16(b1[n], a1[m], acc[m][n]);
    }
    __syncthreads();
}

DEVI int swzF(int row) { return (0x78 >> (((row >> 2) & 3) * 2)) & 3; }
DEVI void gemm256(f32x4 (&acc)[8][4], rsrc_t rs, unsigned sA, unsigned ldaB, unsigned sB, unsigned ldbB, int nk32, unsigned char* lds, int tid) {
    const int lane = tid & 63, wid = __builtin_amdgcn_readfirstlane(tid >> 6), wr = wid >> 1, wc = wid & 1;
    const int q = lane >> 4, r16 = lane & 15;
    unsigned oa[4], ob[2];
#pragma unroll
    for (int i = 0; i < 4; ++i) { const int row = (wid * 4 + i) * 16 + (lane >> 2); oa[i] = (unsigned)row * ldaB + (unsigned)(((lane & 3) ^ swzF(row)) << 4); }
#pragma unroll
    for (int i = 0; i < 2; ++i) { const int row = (wid * 2 + i) * 16 + (lane >> 2); ob[i] = (unsigned)row * ldbB + (unsigned)(((lane & 3) ^ swzF(row)) << 4); }
#pragma unroll
    for (int m = 0; m < 8; ++m)
#pragma unroll
        for (int n = 0; n < 4; ++n) acc[m][n] = (f32x4){0.f, 0.f, 0.f, 0.f};
    const int roffA = (wr * 128 + r16) * 64 + ((q ^ swzF(r16)) << 4);
    const int roffB = 16384 + (wc * 64 + r16) * 64 + ((q ^ swzF(r16)) << 4);
    unsigned char* wA = lds + wid * 4096;
    unsigned char* wB = lds + 16384 + wid * 2048;
#pragma unroll
    for (int i = 0; i < 4; ++i) glds16(rs, wA + i * 1024, oa[i], sA);
#pragma unroll
    for (int i = 0; i < 2; ++i) glds16(rs, wB + i * 1024, ob[i], sB);
    for (int kt = 0; kt < nk32; ++kt) {
        const unsigned char* cur = lds + (kt & 1) * 24576;
        __syncthreads();
        if (kt + 1 < nk32) {
            const int so = ((kt + 1) & 1) * 24576;
#pragma unroll
            for (int i = 0; i < 4; ++i) glds16(rs, wA + so + i * 1024, oa[i], sA + (kt + 1) * 64);
#pragma unroll
            for (int i = 0; i < 2; ++i) glds16(rs, wB + so + i * 1024, ob[i], sB + (kt + 1) * 64);
        }
        bf16x8 a[8], b[4];
#pragma unroll
        for (int n = 0; n < 4; ++n) b[n] = *(const bf16x8*)(cur + roffB + n * 1024);
#pragma unroll
        for (int m = 0; m < 8; ++m) a[m] = *(const bf16x8*)(cur + roffA + m * 1024);
#pragma unroll
        for (int m = 0; m < 8; ++m)
#pragma unroll
            for (int n = 0; n < 4; ++n) acc[m][n] = MFMA16(b[n], a[m], acc[m][n]);
    }
    __syncthreads();
}

DEVI bool tile_map(int k, int ncol, int& mt, int& nt, int nrow = 256) {
    if (gridDim.x == 512) {
        const int x = blockIdx.x & 7, j = blockIdx.x >> 3;
        const int v = j + 64 * k;
        if (v >= (nrow >> 3) * ncol) return false;
        const int nfull = ncol >> 3, rem = ncol & 7;
        int mtl;
        const int pcg = nrow;
        if (v < nfull * pcg) { const int cg = v / pcg, w = v % pcg; mtl = (w >> 6) * 8 + ((w & 63) >> 3); nt = cg * 8 + (w & 7); }
        else { const int v2 = v - nfull * pcg, per = 8 * rem; const int rg = v2 / per, w = v2 % per; mtl = rg * 8 + w / rem; nt = nfull * 8 + w % rem; }
        mt = x * (nrow >> 3) + mtl;
        return true;
    }
    const int u = blockIdx.x + gridDim.x * k;
    if (u >= nrow * ncol) return false;
    mt = u / ncol; nt = u % ncol;
    return true;
}
struct RowLin { unsigned ldb; DEVI unsigned operator()(int r) const { return (unsigned)r * ldb; } };

DEVI int win_map(int j) {
    if (j < 896) return j;
    if (j < 1408) return j - 896 + 936;
    if (j < 2176) return j - 1408 + 1448;
    if (j < 2208) return j - 2176 + 896;
    if (j < 2216) return j - 2208 + 928;
    if (j < 2240) return j;
    if (j < 2304) return -1;
    return j - 64;
}

struct TJob { const float* src; bf16_t* dst; int K, ld, nrows, perm, nb; size_t sb, db; };
DEVI TJob get_tjob(const Params& P, int j) {
    unsigned char* ws = P.ws;
    switch (j) {
        case 0: return TJob{P.in[3], (bf16_t*)(ws + OFF_WIN_T), 1024, INW, WIN_ROWS, 1, 1, 0, 0};
        case 1: return TJob{P.in[10], (bf16_t*)(ws + OFF_WBRA), 512, 1024, 1024, 0, 1, 0, 0};
        case 2: return TJob{P.in[11], (bf16_t*)(ws + OFF_WBRB), 512, 1024, 1024, 0, 1, 0, 0};
        case 3: return TJob{P.in[12], (bf16_t*)(ws + OFF_WOUT), 1024, 1024, 1024, 0, 1, 0, 0};
        case 4: return TJob{P.in[5], (bf16_t*)(ws + OFF_W1K), 2048, 128, 128, 0, 1, 0, 0};
        case 5: return TJob{P.in[8], (bf16_t*)(ws + OFF_W1V), 2048, 128, 128, 0, 1, 0, 0};
        case 6: return TJob{P.in[6], (bf16_t*)(ws + OFF_W2K), 128, 64, 64, 0, 1, 0, 0};
        case 7: return TJob{P.in[9], (bf16_t*)(ws + OFF_W2V), 128, 64, 64, 0, 1, 0, 0};
        case 8: return TJob{P.in[18], (bf16_t*)(ws + OFF_WGU), 1024, 512, 512, 0, 32, (size_t)1024 * 512, (size_t)512 * 1024};
        default: return TJob{P.in[19], (bf16_t*)(ws + OFF_WDN), 256, 1024, 1024, 0, 32, (size_t)256 * 1024, (size_t)1024 * 256};
    }
}
DEVI int tjob_tiles(int j) {
    switch (j) {
        case 0: return (WIN_ROWS / 64) * 16;
        case 1: case 2: return 16 * 8;
        case 3: return 16 * 16;
        case 4: case 5: return 2 * 32;
        case 6: case 7: return 1 * 2;
        case 8: return 32 * 8 * 16;
        default: return 32 * 16 * 4;
    }
}

DEVI void transpose_tile(const TJob& J, int tile, unsigned char* lds, int tid) {
    float* T = (float*)lds;
    const int kt = J.K / 64, rt = J.nrows / 64;
    const int b = tile / (kt * rt), rem = tile % (kt * rt);
    const int r0 = (rem / kt) * 64, k0 = (rem % kt) * 64;
    const float* src = J.src + (size_t)b * J.sb;
    bf16_t* dst = J.dst + (size_t)b * J.db;
    const int n4 = (tid & 15) * 4;
    int col = r0 + n4; if (J.perm) col = win_map(col);
    f32x4 ld4[4];
#pragma unroll
    for (int i = 0; i < 4; ++i) {
        const int kk = (tid >> 4) + 16 * i;
        ld4[i] = (col >= 0) ? *(const f32x4*)(src + (size_t)(k0 + kk) * J.ld + col) : (f32x4){0.f, 0.f, 0.f, 0.f};
    }
#pragma unroll
    for (int i = 0; i < 4; ++i) {
        const int kk = (tid >> 4) + 16 * i;
#pragma unroll
        for (int e = 0; e < 4; ++e) T[kk * 65 + n4 + e] = ld4[i][e];
    }
    __syncthreads();
    const int r2 = tid >> 2, ks = (tid & 3) * 16;
    u32x4 w0, w1;
    w0.x = pk2(T[(ks + 0) * 65 + r2], T[(ks + 1) * 65 + r2]); w0.y = pk2(T[(ks + 2) * 65 + r2], T[(ks + 3) * 65 + r2]);
    w0.z = pk2(T[(ks + 4) * 65 + r2], T[(ks + 5) * 65 + r2]); w0.w = pk2(T[(ks + 6) * 65 + r2], T[(ks + 7) * 65 + r2]);
    w1.x = pk2(T[(ks + 8) * 65 + r2], T[(ks + 9) * 65 + r2]); w1.y = pk2(T[(ks + 10) * 65 + r2], T[(ks + 11) * 65 + r2]);
    w1.z = pk2(T[(ks + 12) * 65 + r2], T[(ks + 13) * 65 + r2]); w1.w = pk2(T[(ks + 14) * 65 + r2], T[(ks + 15) * 65 + r2]);
    bf16_t* d = dst + (size_t)(r0 + r2) * J.K + k0 + ks;
    *(u32x4*)d = w0; *(u32x4*)(d + 8) = w1;
    __syncthreads();
}

DEVI void rms_row_bf16(const float* xr, const float* g, bf16_t* o, int lane) {
    f32x4 v[4]; float ss = 0.f;
#pragma unroll
    for (int i = 0; i < 4; ++i) { v[i] = *(const f32x4*)(xr + i * 256 + lane * 4); ss += v[i][0] * v[i][0] + v[i][1] * v[i][1] + v[i][2] * v[i][2] + v[i][3] * v[i][3]; }
    ss = wave_sum(ss);
    const float rs = rsqrtf(ss * (1.0f / 1024.0f) + RMS_EPS);
#pragma unroll
    for (int i = 0; i < 4; ++i) {
        const f32x4 gg = *(const f32x4*)(g + i * 256 + lane * 4);
        u32x2 w; w.x = pk2(v[i][0] * rs * gg[0], v[i][1] * rs * gg[1]); w.y = pk2(v[i][2] * rs * gg[2], v[i][3] * rs * gg[3]);
        *(u32x2*)(o + i * 256 + lane * 4) = w;
    }
}

DEVI void phase_prep(const Params& P, unsigned char* lds, int tid, int part) {
    unsigned char* ws = P.ws;
    const int lane = tid & 63, wid = __builtin_amdgcn_readfirstlane(tid >> 6);
    int base = 0;
#pragma unroll
    for (int j = 0; j < 10; ++j) {
        const bool early = (j == 0) || (j >= 4 && j <= 7);
        if (early == (part == 0)) {
            const int nt = tjob_tiles(j);
            const TJob J = get_tjob(P, j);
            for (int t = blockIdx.x; t < nt; t += gridDim.x) transpose_tile(J, t, lds, tid);
        }
    }
    (void)base;
    if (part == 1) {
        float* wr = (float*)(ws + OFF_WR);
        const float* g = P.in[13]; const float* wg = P.in[14]; const float* we = P.in[16];
        for (int e = blockIdx.x * NTHREADS + tid; e < 48 * 1024; e += gridDim.x * NTHREADS) {
            const int c = e >> 10, k = e & 1023;
            float v = 0.f;
            if (c < 4) v = wg[k * 4 + c]; else if (c < 36) v = we[k * 32 + (c - 4)];
            wr[e] = v * g[k];
        }
        return;
    }
    {
        const float* x = P.in[0]; const float* g = P.in[2]; bf16_t* hn = (bf16_t*)(ws + OFF_HN);
        for (int r = blockIdx.x * 4 + wid; r < NTOK; r += gridDim.x * 4) rms_row_bf16(x + (size_t)r * 1024, g, hn + (size_t)r * 1024, lane);
    }
    {
        f32x2* cs = (f32x2*)(ws + OFF_CS);
        for (int e = blockIdx.x * NTHREADS + tid; e < NTOK * 32; e += gridDim.x * NTHREADS) {
            const int tok = e >> 5, i = e & 31;
            const double a = (double)P.pos[tok] * P.inv_freq[i];
            double t = a * 0.15915494309189535;
            t -= floor(t);
            const float tf = (float)t;
            cs[e] = (f32x2){__builtin_amdgcn_cosf(tf), __builtin_amdgcn_sinf(tf)};
        }
    }
    {
        float* red = (float*)lds;
        for (int job = blockIdx.x; job < 32; job += gridDim.x) {
            const int kv = job >> 4, cg8 = job & 15;
            const float* pe = P.in[kv ? 7 : 4]; const float* w1 = P.in[kv ? 8 : 5];
            const int cc = tid & 7, jj = tid >> 3;
            float s = 0.f;
            for (int j = jj; j < 2048; j += 32) s += pe[j] * w1[(size_t)j * 128 + cg8 * 8 + cc];
            red[tid] = s;
            __syncthreads();
            if (tid < 8) { float t = 0.f; for (int u = 0; u < 32; ++u) t += red[u * 8 + tid]; ((float*)(ws + OFF_BIAS1))[kv * 128 + cg8 * 8 + tid] = t; }
            __syncthreads();
        }
    }
}

DEVI void st_bf16(bf16_t* p, float v) { *p = (bf16_t)f2bf(v); }

DEVI int gemm1_col_tile(int part, int i) {
    if (part == 0) return (i < 3) ? 4 + i : ((i < 5) ? 8 + i : 17);
    return (i < 4) ? i : ((i < 8) ? i + 3 : ((i < 12) ? i + 5 : i + 6));
}
template <int MR>
DEVI void gemm1_epilogue(const Params& P, const f32x4 (&acc)[MR][4], int c64, int tok0, int q, int cl) {
    unsigned char* ws = P.ws;
    const f32x2* cs = (const f32x2*)(ws + OFF_CS);
    if (c64 < 10 || (c64 >= 14 && c64 < 34)) {
        bool do_rope; float scale = 1.f; int kind;
        int g = 0, hk = 0;
        if (c64 < 8) { kind = 0; do_rope = true; scale = 0.125f * LOG2E; }
        else if (c64 == 8) { kind = 1; do_rope = true; }
        else if (c64 == 9) { kind = 2; do_rope = false; }
        else if (c64 < 22) { kind = 3; do_rope = true; scale = 0.125f * LOG2E; }
        else { kind = 4; g = (c64 - 22) >> 1; hk = (c64 - 22) & 1; do_rope = (g == 2 || g == 4); }
#pragma unroll
        for (int m = 0; m < MR; ++m) {
            const int tok = tok0 + m * 16;
            f32x4 o[4], nr[4];
#pragma unroll
            for (int n = 0; n < 4; ++n) { nr[n] = acc[m][n] * scale; o[n] = nr[n]; }
            if (do_rope) {
#pragma unroll
                for (int n = 0; n < 2; ++n) {
                    const f32x4 c01 = *(const f32x4*)(cs + (size_t)tok * 32 + n * 16 + q * 4);
                    const f32x4 c23 = *(const f32x4*)(cs + (size_t)tok * 32 + n * 16 + q * 4 + 2);
                    const float cc[4] = {c01[0], c01[2], c23[0], c23[2]}, sn[4] = {c01[1], c01[3], c23[1], c23[3]};
#pragma unroll
                    for (int j = 0; j < 4; ++j) {
                        const float x1 = nr[n][j], x2 = nr[n + 2][j];
                        o[n][j] = x1 * cc[j] - x2 * sn[j]; o[n + 2][j] = x1 * sn[j] + x2 * cc[j];
                    }
                }
            }
            if (kind == 0 || kind == 1 || kind == 2) {
                bf16_t* d = (kind == 0) ? (bf16_t*)(ws + OFF_QA) + (size_t)tok * 512 + c64 * 64 : (bf16_t*)(ws + (kind == 1 ? OFF_KA : OFF_VA)) + (size_t)tok * 64;
#pragma unroll
                for (int n = 0; n < 4; ++n) { u32x2 w; w.x = pk2(o[n][0], o[n][1]); w.y = pk2(o[n][2], o[n][3]); *(u32x2*)(d + n * 16 + q * 4) = w; }
            } else if (kind == 3) {
                const int h = c64 - 14;
                bf16_t* dn = (bf16_t*)(ws + OFF_QBN) + (size_t)tok * 512 + h * 64; bf16_t* dr = (bf16_t*)(ws + OFF_QBR) + (size_t)tok * 512 + h * 64;
#pragma unroll
                for (int n = 0; n < 4; ++n) {
                    u32x2 w; w.x = pk2(nr[n][0], nr[n][1]); w.y = pk2(nr[n][2], nr[n][3]); *(u32x2*)(dn + n * 16 + q * 4) = w;
                    u32x2 v; v.x = pk2(o[n][0], o[n][1]); v.y = pk2(o[n][2], o[n][3]); *(u32x2*)(dr + n * 16 + q * 4) = v;
                }
            } else {
                bf16_t* d = (bf16_t*)(ws + OFF_KV + (size_t)g * KV_STRIDE);
                const int b = tok >> 12, tl = tok & 4095;
                if (g == 3 || g == 5) {
#pragma unroll
                    for (int n = 0; n < 4; ++n)
#pragma unroll
                        for (int j = 0; j < 4; ++j) st_bf16(d + ((size_t)((b * 2 + hk) * 64 + n * 16 + q * 4 + j)) * 4096 + tl, o[n][j]);
                } else {
#pragma unroll
                    for (int n = 0; n < 4; ++n) { u32x2 w; w.x = pk2(o[n][0], o[n][1]); w.y = pk2(o[n][2], o[n][3]);
                        *(u32x2*)(d + ((size_t)((b * 2 + hk) * 4096 + tl)) * 64 + n * 16 + q * 4) = w; }
                }
            }
        }
    } else if (c64 >= 10 && c64 < 14) {
        bf16_t* d = (bf16_t*)(ws + OFF_QI);
#pragma unroll
        for (int m = 0; m < MR; ++m) {
            const int tok = tok0 + m * 16;
            float cc[4], sn[4];
#pragma unroll
            for (int j = 0; j < 4; ++j) { const f32x2 c = cs[(size_t)tok * 32 + 2 * (4 * q + j)]; cc[j] = c.x; sn[j] = c.y; }
#pragma unroll
            for (int hh = 0; hh < 2; ++hh) {
                const int head = 2 * (c64 - 10) + hh;
                f32x4 r1, r2;
#pragma unroll
                for (int j = 0; j < 4; ++j) { const float x1 = acc[m][2 * hh][j], x2 = acc[m][2 * hh + 1][j]; r1[j] = x1 * cc[j] - x2 * sn[j]; r2[j] = x1 * sn[j] + x2 * cc[j]; }
                u32x2 w; w.x = pk2(r1[0], r1[1]); w.y = pk2(r1[2], r1[3]); *(u32x2*)(d + (size_t)tok * 256 + head * 32 + q * 4) = w;
                u32x2 v; v.x = pk2(r2[0], r2[1]); v.y = pk2(r2[2], r2[3]); *(u32x2*)(d + (size_t)tok * 256 + head * 32 + 16 + q * 4) = v;
            }
        }
    } else if (c64 >= 36) {
        bf16_t* d = (bf16_t*)(ws + (c64 < 52 ? OFF_GA : OFF_GB));
        const int cb = (c64 < 52 ? c64 - 36 : c64 - 52) * 64;
#pragma unroll
        for (int m = 0; m < MR; ++m)
#pragma unroll
            for (int n = 0; n < 4; ++n) {
                u32x2 w; w.x = pk2(sigmoidf_(acc[m][n][0]), sigmoidf_(acc[m][n][1])); w.y = pk2(sigmoidf_(acc[m][n][2]), sigmoidf_(acc[m][n][3]));
                *(u32x2*)(d + (size_t)(tok0 + m * 16) * 1024 + cb + n * 16 + q * 4) = w;
            }
    } else if (c64 == 34) {
        bf16_t* dki = (bf16_t*)(ws + OFF_KI); float* dwi = (float*)(ws + OFF_WI); float* dg = (float*)(ws + OFF_GATES);
#pragma unroll
        for (int m = 0; m < MR; ++m) {
            const int tok = tok0 + m * 16;
            f32x4 r1, r2;
#pragma unroll
            for (int j = 0; j < 4; ++j) {
                const f32x2 c = cs[(size_t)tok * 32 + 2 * (4 * q + j)];
                const float x1 = acc[m][0][j], x2 = acc[m][1][j];
                r1[j] = x1 * c.x - x2 * c.y; r2[j] = x1 * c.y + x2 * c.x;
            }
            u32x2 w; w.x = pk2(r1[0], r1[1]); w.y = pk2(r1[2], r1[3]); *(u32x2*)(dki + (size_t)tok * 32 + q * 4) = w;
            u32x2 v; v.x = pk2(r2[0], r2[1]); v.y = pk2(r2[2], r2[3]); *(u32x2*)(dki + (size_t)tok * 32 + 16 + q * 4) = v;
            if (q < 2) *(f32x4*)(dwi + (size_t)tok * 8 + q * 4) = acc[m][2];
            else { f32x4 sv; for (int j = 0; j < 4; ++j) sv[j] = sigmoidf_(acc[m][2][j]); *(f32x4*)(dg + (size_t)tok * 24 + (q * 4 - 8)) = sv; }
            { f32x4 sv; for (int j = 0; j < 4; ++j) sv[j] = sigmoidf_(acc[m][3][j]); *(f32x4*)(dg + (size_t)tok * 24 + 8 + q * 4) = sv; }
        }
    }
}

DEVI void phase_gemm1(const Params& P, unsigned char* lds, int tid, int part) {
    const rsrc_t rs = __builtin_amdgcn_make_buffer_rsrc((void*)P.ws, (short)0, (int)0x7fffffff, 0x00020000);
    const int lane = tid & 63, wid = __builtin_amdgcn_readfirstlane(tid >> 6), wr = wid >> 1, wc = wid & 1, q = lane >> 4, cl = lane & 15;
    constexpr int NT_N = G1_COLS / 128;
    if (part == 0) {
        for (int kk = 0;; ++kk) {
            int mt, nti;
            if (!tile_map(kk, 6, mt, nti)) break;
            const int nt = gemm1_col_tile(0, nti);
            f32x4 acc[4][4];
            gemm128(acc, rs, (unsigned)(OFF_HN + (size_t)mt * 128 * 2048), RowLin{2048}, (unsigned)(OFF_WIN_T + (size_t)nt * 128 * 2048), RowLin{2048}, 16, lds, tid);
            gemm1_epilogue<4>(P, acc, nt * 2 + wc, mt * 128 + wr * 64 + cl, q, cl);
        }
    } else {
        for (int kk = 0;; ++kk) {
            int mt, nti;
            if (!tile_map(kk, NT_N - 6, mt, nti, 128)) break;
            const int nt = gemm1_col_tile(1, nti);
            f32x4 acc[8][4];
            gemm256(acc, rs, (unsigned)(OFF_HN + (size_t)mt * 256 * 2048), 2048u, (unsigned)(OFF_WIN_T + (size_t)nt * 128 * 2048), 2048u, 32, lds, tid);
            gemm1_epilogue<8>(P, acc, nt * 2 + wc, mt * 256 + wr * 128 + cl, q, cl);
        }
    }
}

DEVI float siluf_(float x) { return x * __builtin_amdgcn_rcpf(1.0f + __builtin_amdgcn_exp2f(-x * 1.4426950408889634f)); }

DEVI void phase_compress(const Params& P, unsigned char* lds, int tid) {
    unsigned char* ws = P.ws;
    const rsrc_t rs = __builtin_amdgcn_make_buffer_rsrc((void*)P.ws, (short)0, (int)0x7fffffff, 0x00020000);
    const int lane = tid & 63, wid = __builtin_amdgcn_readfirstlane(tid >> 6), wr = wid >> 1, wc = wid & 1, q = lane >> 4, cl = lane & 15;
    for (int u = blockIdx.x; u < 64; u += gridDim.x) {
        const int kv = u >> 5, mt = u & 31;
        const bf16_t* A = (const bf16_t*)(ws + OFF_KV + (size_t)kv * KV_STRIDE) + (size_t)mt * 128 * 1024;
        const bf16_t* W1 = (const bf16_t*)(ws + (kv ? OFF_W1V : OFF_W1K));
        const bf16_t* W2 = (const bf16_t*)(ws + (kv ? OFF_W2V : OFF_W2K));
        const float* bias = (const float*)(ws + OFF_BIAS1) + kv * 128;
        f32x4 acc[4][4];
        gemm128(acc, rs, (unsigned)(OFF_KV + (size_t)kv * KV_STRIDE + (size_t)mt * 128 * 2048), RowLin{2048}, (unsigned)(kv ? OFF_W1V : OFF_W1K), RowLin{4096}, 32, lds, tid);
#pragma unroll
        for (int m = 0; m < 4; ++m)
#pragma unroll
            for (int n = 0; n < 4; ++n) {
                const int col = wc * 64 + n * 16 + q * 4, row = wr * 64 + m * 16 + cl;
                const f32x4 bb = *(const f32x4*)(bias + col);
                const int ktile = col >> 6, ch = (col & 63) >> 3, wi = col & 7;
                u32x2 w; w.x = pk2(siluf_(acc[m][n][0] + bb[0]), siluf_(acc[m][n][1] + bb[1])); w.y = pk2(siluf_(acc[m][n][2] + bb[2]), siluf_(acc[m][n][3] + bb[3]));
                *(u32x2*)(lds + ktile * 16384 + row * 128 + ((ch ^ (row & 7)) << 4) + wi * 2) = w;
            }
#pragma unroll
        for (int i = 0; i < 4; ++i) {
            const int idx = tid + 256 * i;
            const int row = idx >> 4, ch16 = idx & 15, ktile = ch16 >> 3, ch = ch16 & 7;
            *(u32x4*)(lds + 32768 + ktile * 8192 + row * 128 + ((ch ^ (row & 7)) << 4)) = *(const u32x4*)(W2 + (size_t)row * 128 + ch16 * 8);
        }
        __syncthreads();
        f32x4 a2[4][2];
#pragma unroll
        for (int m = 0; m < 4; ++m) { a2[m][0] = (f32x4){0.f, 0.f, 0.f, 0.f}; a2[m][1] = (f32x4){0.f, 0.f, 0.f, 0.f}; }
#pragma unroll
        for (int kk = 0; kk < 4; ++kk) {
            const int ktile = kk >> 1, ks = kk & 1;
            bf16x8 a[4], b[2];
#pragma unroll
            for (int m = 0; m < 4; ++m) { const int row = wr * 64 + m * 16 + cl; a[m] = *(const bf16x8*)(lds + ktile * 16384 + row * 128 + (((ks * 4 + q) ^ (row & 7)) << 4)); }
#pragma unroll
            for (int n = 0; n < 2; ++n) { const int row = wc * 32 + n * 16 + cl; b[n] = *(const bf16x8*)(lds + 32768 + ktile * 8192 + row * 128 + (((ks * 4 + q) ^ (row & 7)) << 4)); }
#pragma unroll
            for (int m = 0; m < 4; ++m)
#pragma unroll
                for (int n = 0; n < 2; ++n) a2[m][n] = MFMA16(b[n], a[m], a2[m][n]);
        }
#pragma unroll
        for (int m = 0; m < 4; ++m)
#pragma unroll
            for (int n = 0; n < 2; ++n) {
                const int d = wc * 32 + n * 16 + q * 4;
                const int r = mt * 128 + wr * 64 + m * 16 + cl;
                const bool dead = ((r & 255) == 255);
                float v[4];
#pragma unroll
                for (int j = 0; j < 4; ++j) v[j] = dead ? 0.f : a2[m][n][j];
                if (kv == 0) {
                    bf16_t* kc = (bf16_t*)(ws + OFF_KC);
                    u32x2 w; w.x = pk2(v[0], v[1]); w.y = pk2(v[2], v[3]);
                    *(u32x2*)(kc + (size_t)r * 64 + d) = w;
                } else {
                    bf16_t* vct = (bf16_t*)(ws + OFF_VCT);
#pragma unroll
                    for (int j = 0; j < 4; ++j) st_bf16(vct + ((size_t)((r >> 8) * 64 + d + j)) * 256 + (r & 255), v[j]);
                }
            }
        __syncthreads();
    }
}

DEVI void phase_index(const Params& P, unsigned char* lds, int tid) {
    unsigned char* ws = P.ws;
    const bf16_t* QI = (const bf16_t*)(ws + OFF_QI);
    const bf16_t* KI = (const bf16_t*)(ws + OFF_KI);
    const float* WI = (const float*)(ws + OFF_WI);
    bf16_t* SEL = (bf16_t*)(ws + OFF_SEL);
    float* S = (float*)lds;
    const int lane = tid & 63, wid = __builtin_amdgcn_readfirstlane(tid >> 6), q = lane >> 4, cl = lane & 15;
    for (int u = blockIdx.x; u < NTOK / 4; u += gridDim.x) {
        const int b = u >> 10, w10 = u & 1023, s10 = (w10 < 512) ? w10 : 1535 - w10;
        const int t0 = s10 * 4, tok0 = b * 4096 + t0;
        const int t = t0 + wid;
        const int tok = tok0 + wid;
        if (t0 + 3 < 256) {
            for (int i = lane; i < 256; i += 64) SEL[(size_t)tok * 256 + i] = (bf16_t)(i <= t ? i : 0);
            continue;
        }
        {
            bf16x8 a[2];
#pragma unroll
            for (int hg = 0; hg < 2; ++hg) a[hg] = *(const bf16x8*)(QI + (size_t)(tok0 + (cl >> 2)) * 256 + (4 * hg + (cl & 3)) * 32 + q * 8);
            const f32x4 w0 = *(const f32x4*)(WI + (size_t)(tok0 + q) * 8), w1 = *(const f32x4*)(WI + (size_t)(tok0 + q) * 8 + 4);
            const int ktmax = (t0 + 3) >> 4;
            const bf16_t* kb = KI + (size_t)b * 4096 * 32 + cl * 32 + q * 8;
            for (int kt0 = wid; kt0 <= ktmax; kt0 += 16) {
                bf16x8 bk[4];
#pragma unroll
                for (int uu = 0; uu < 4; ++uu) { const int kt = (kt0 + 4 * uu <= ktmax) ? kt0 + 4 * uu : kt0; bk[uu] = *(const bf16x8*)(kb + (size_t)kt * 16 * 32); }
#pragma unroll
                for (int uu = 0; uu < 4; ++uu) {
                    const int kt = kt0 + 4 * uu;
                    f32x4 c0 = {0.f, 0.f, 0.f, 0.f}, c1 = {0.f, 0.f, 0.f, 0.f};
                    c0 = MFMA16(a[0], bk[uu], c0); c1 = MFMA16(a[1], bk[uu], c1);
                    float sc = 0.f;
#pragma unroll
                    for (int j = 0; j < 4; ++j) { sc += w0[j] * fmaxf(c0[j], 0.f); sc += w1[j] * fmaxf(c1[j], 0.f); }
                    if (kt <= ktmax) S[q * 4096 + kt * 16 + cl] = sc;
                }
            }
        }
        __syncthreads();
        {
            const int n = t + 1;
            const float* Sq = S + wid * 4096;
            if (n <= 256) {
                for (int i = lane; i < 256; i += 64) SEL[(size_t)tok * 256 + i] = (bf16_t)(i <= t ? i : 0);
            } else {
                const int nr = (n + 63) >> 6;
                float x[64];
                const float NINF = -__builtin_inff();
                float mx = NINF, mn = __builtin_inff();
#pragma unroll
                for (int r = 0; r < 64; ++r) {
                    const int key = r * 64 + lane;
                    const float v = Sq[key];
                    x[r] = (key < n) ? v : NINF;
                    mn = fminf(mn, (key < n) ? v : __builtin_inff());
                    mx = fmaxf(mx, x[r]);
                }
#pragma unroll
                for (int o = 32; o > 0; o >>= 1) { mx = fmaxf(mx, __shfl_xor(mx, o)); mn = fminf(mn, __shfl_xor(mn, o)); }
                float lo = mn, hi = mx, T; int need;
                int chi = 0, clo = n;
#define COUNT_GE(dst, thr) do { int c_ = 0; _Pragma("unroll") for (int g8 = 0; g8 < 8; ++g8) if (g8 * 8 < nr) { \
        _Pragma("unroll") for (int r = g8 * 8; r < g8 * 8 + 8; ++r) c_ += __popcll(__ballot(x[r] >= (thr))); } (dst) = c_; } while (0)
                COUNT_GE(chi, hi);
                if (chi >= 256) { T = hi; need = 256;   }
                else {
                    float s1 = 0.f, s2 = 0.f;
#pragma unroll
                    for (int g8 = 0; g8 < 8; ++g8) if (g8 * 8 < nr) {
#pragma unroll
                        for (int r = g8 * 8; r < g8 * 8 + 8; ++r) { const float v = (x[r] == NINF) ? 0.f : x[r]; s1 += v; s2 += v * v; }
                    }
                    s1 = wave_sum_f32_dpp(s1); s2 = wave_sum_f32_dpp(s2);
                    const float fn = (float)n, mu = s1 / fn;
                    const float sg = sqrtf(fmaxf(s2 / fn - mu * mu, 1e-20f));
                    float vg;
                    {
                        const float pq = 256.0f / fn, pp = fminf(pq, 1.0f - pq);
                        const float tt = sqrtf(-2.0f * __logf(fmaxf(pp, 1e-6f)));
                        const float zz = tt - (2.515517f + 0.802853f * tt + 0.010328f * tt * tt) / (1.0f + 1.432788f * tt + 0.189269f * tt * tt + 0.001308f * tt * tt * tt);
                        vg = mu + ((pq <= 0.5f) ? zz : -zz) * sg;
                    }
                    bool found = false, adjacent = false; float thr = 0.f;
                    for (int it = 0; it < 160; ++it) {
                        if (clo - chi <= 64) break;
                        const float mid = 0.5f * lo + 0.5f * hi;
                        if (!(mid > lo && mid < hi)) { adjacent = true; break; }
                        float v = vg;
                        if (!(v > lo && v < hi) || (it & 3) == 3) v = mid;
                        int c; COUNT_GE(c, v);
                        if (c == 256) { found = true; thr = v; break; }
                        if (c > 256) { lo = v; clo = c; } else { hi = v; chi = c; }
                        const float zv = (v - mu) / sg;
                        const float dens = fmaxf(fn * 0.39894228f * __expf(-0.5f * zv * zv), 0.5f) / sg;
                        vg = v + ((float)c - ((c > 256) ? 244.0f : 268.0f)) / dens;
                    }
                    if (found) { T = thr; need = -1; }
                    else if (adjacent) { T = lo; need = 256 - chi; }
                    else {
                        float* cand = (float*)(lds + 65536) + wid * 64;
                        cand[lane] = NINF;
                        int cb = 0;
                        const unsigned long long ltm = (1ull << lane) - 1ull;
#pragma unroll
                        for (int g8 = 0; g8 < 8; ++g8) if (g8 * 8 < nr) {
#pragma unroll
                            for (int r = g8 * 8; r < g8 * 8 + 8; ++r) {
                                const bool isc = (x[r] >= lo) && (x[r] < hi);
                                const unsigned long long bm = __ballot(isc);
                                if (bm != 0ull) {
                                    if (isc) cand[cb + __popcll(bm & ltm)] = x[r];
                                    cb += __popcll(bm);
                                }
                            }
                        }
                        const float y = cand[lane];
                        int cgt = 0, cge = 0;
#pragma unroll
                        for (int k = 0; k < 64; ++k) { const float yk = __builtin_bit_cast(float, __builtin_amdgcn_readlane(__builtin_bit_cast(int, y), k)); cgt += (yk > y) ? 1 : 0; cge += (yk >= y) ? 1 : 0; }
                        const int nd = 256 - chi;
                        const bool isT = (y != NINF) && (cgt <= nd - 1) && (cge >= nd);
                        const unsigned long long tm = __ballot(isT);
                        const int tl = (tm != 0ull) ? (int)__builtin_ctzll(tm) : 0;
                        T = __shfl(y, tl);
                        need = nd - __shfl(cgt, tl);
                    }
                }
                bf16_t* selb = (bf16_t*)(lds + 65536 + 1024) + wid * 256;
                int wlo = 0, whi = 0, tot = 0;
#pragma unroll
                for (int g8 = 0; g8 < 8; ++g8) if (g8 * 8 < nr) {
#pragma unroll
                    for (int r = g8 * 8; r < g8 * 8 + 8; ++r) {
                        const unsigned long long m = __ballot(x[r] >= T);
                        tot += __popcll(m);
                        asm volatile("v_writelane_b32 %0, %1, %2" : "+v"(wlo) : "s"((unsigned)m), "n"(r));
                        asm volatile("v_writelane_b32 %0, %1, %2" : "+v"(whi) : "s"((unsigned)(m >> 32)), "n"(r));
                    }
                }
                if (tot == 256) {
                    const int cw = __popc((unsigned)wlo) + __popc((unsigned)whi);
                    int pos = 0;
#pragma unroll
                    for (int bb = 0; bb < 7; ++bb) {
                        const unsigned long long bmk = __ballot(((cw >> bb) & 1) != 0);
                        pos += (int)__builtin_amdgcn_mbcnt_hi((unsigned)(bmk >> 32), __builtin_amdgcn_mbcnt_lo((unsigned)bmk, 0u)) << bb;
                    }
                    unsigned long long w = ((unsigned long long)(unsigned)whi << 32) | (unsigned long long)(unsigned)wlo;
                    while (w != 0ull) {
                        const int bpos = (int)__builtin_ctzll(w);
                        selb[pos++] = (bf16_t)(lane * 64 + bpos);
                        w &= w - 1ull;
                    }
                } else {
                    if (need < 0) need = 0x7fffffff;
                    int base = 0, eqc = 0;
                    const unsigned long long lt = (1ull << lane) - 1ull;
#pragma unroll
                    for (int g8 = 0; g8 < 8; ++g8) if (g8 * 8 < nr) {
#pragma unroll
                        for (int r = g8 * 8; r < g8 * 8 + 8; ++r) {
                            const bool eq = (x[r] == T);
                            const unsigned long long em = __ballot(eq);
                            const bool sel = (x[r] > T) || (eq && (eqc + __popcll(em & lt) < need));
                            eqc += __popcll(em);
                            const unsigned long long sm = __ballot(sel);
                            if (sel) { const int pp = base + __popcll(sm & lt); if (pp < 256) selb[pp] = (bf16_t)(r * 64 + lane); }
                            base += __popcll(sm);
                        }
                    }
                }
                __builtin_amdgcn_wave_barrier();
                if (lane < 32) *(u32x4*)(SEL + (size_t)tok * 256 + lane * 8) = *(const u32x4*)(selb + lane * 8);
                __builtin_amdgcn_wave_barrier();
            }
        }
        __syncthreads();
    }
}

DEVI int dsa_vswz(int row) { return (((row >> 1) & 1) << 1) | (((row >> 3) & 1) << 2); }
DEVI void phase_dsa(const Params& P, unsigned char* lds, int tid) {
    unsigned char* ws = P.ws;
    const bf16_t* QA = (const bf16_t*)(ws + OFF_QA);
    const bf16_t* KA = (const bf16_t*)(ws + OFF_KA);
    const bf16_t* VA = (const bf16_t*)(ws + OFF_VA);
    const bf16_t* SEL = (const bf16_t*)(ws + OFF_SEL);
    bf16_t* OA = (bf16_t*)(ws + OFF_OA);
    const int lane = tid & 63, wid = __builtin_amdgcn_readfirstlane(tid >> 6), q = lane >> 4, cl = lane & 15;
    unsigned char* vl = lds + wid * 8192;
    const float NINF = -__builtin_inff();
    const int stride = gridDim.x * 4;
    int tok = blockIdx.x * 4 + wid;
    if (tok >= NTOK) return;
    int kidx[16], mk[4]; bf16x8 bq[2];
    {
        const bf16_t* sel = SEL + (size_t)tok * 256;
#pragma unroll
        for (int rf = 0; rf < 16; ++rf) kidx[rf] = sel[32 * (rf >> 1) + 8 * (cl >> 2) + 4 * (rf & 1) + (cl & 3)];
#pragma unroll
        for (int cc = 0; cc < 4; ++cc) mk[cc] = sel[cc * 64 + lane];
#pragma unroll
        for (int ks = 0; ks < 2; ++ks) bq[ks] = *(const bf16x8*)(QA + (size_t)tok * 512 + (cl & 7) * 64 + ks * 32 + q * 8);
    }
    const int wrow = lane >> 3;
    for (; tok < NTOK; tok += stride) {
        const int b = tok >> 12, t = tok & 4095;
        const int cnt = (t + 1 < 256) ? t + 1 : 256;
        const int nc64 = (cnt + 63) >> 6;
        const bf16_t* kb = KA + (size_t)b * 4096 * 64;
        const bf16_t* vb = VA + (size_t)b * 4096 * 64;
        const bf16x8 zero8 = {0, 0, 0, 0, 0, 0, 0, 0};
        const bf16x8 bq0 = (cl < 8) ? bq[0] : zero8, bq1 = (cl < 8) ? bq[1] : zero8;
        u32x4 vr[8];
#pragma unroll
        for (int i = 0; i < 8; ++i) { const int key = __shfl(mk[0], wrow + 8 * i); vr[i] = *(const u32x4*)(vb + (size_t)key * 64 + (lane & 7) * 8); }
        f32x4 s[16];
#pragma unroll
        for (int rf = 0; rf < 16; ++rf) {
            s[rf] = (f32x4){0.f, 0.f, 0.f, 0.f};
            if ((rf >> 2) < nc64) {
                const bf16_t* kr = kb + (size_t)kidx[rf] * 64 + q * 8;
                const bf16x8 a0 = *(const bf16x8*)(kr), a1 = *(const bf16x8*)(kr + 32);
                s[rf] = MFMA16(a0, bq0, s[rf]); s[rf] = MFMA16(a1, bq1, s[rf]);
            }
            if ((rf & 3) == 3) asm volatile("" ::: "memory");
        }
        int mkc[4];
#pragma unroll
        for (int cc = 0; cc < 4; ++cc) mkc[cc] = mk[cc];
        {
            const int tn = (tok + stride < NTOK) ? tok + stride : tok;
            const bf16_t* sel = SEL + (size_t)tn * 256;
#pragma unroll
            for (int rf = 0; rf < 16; ++rf) kidx[rf] = sel[32 * (rf >> 1) + 8 * (cl >> 2) + 4 * (rf & 1) + (cl & 3)];
#pragma unroll
            for (int cc = 0; cc < 4; ++cc) mk[cc] = sel[cc * 64 + lane];
#pragma unroll
            for (int ks = 0; ks < 2; ++ks) bq[ks] = *(const bf16x8*)(QA + (size_t)tn * 512 + (cl & 7) * 64 + ks * 32 + q * 8);
        }
        float mx = NINF;
#pragma unroll
        for (int rf = 0; rf < 16; ++rf)
#pragma unroll
            for (int j = 0; j < 4; ++j) {
                const int p = 32 * (rf >> 1) + 8 * q + 4 * (rf & 1) + j;
                if (p >= cnt) s[rf][j] = NINF;
                mx = fmaxf(mx, s[rf][j]);
            }
        mx = rows_max(mx);
        float ls = 0.f;
#pragma unroll
        for (int rf = 0; rf < 16; ++rf)
#pragma unroll
            for (int j = 0; j < 4; ++j) { const float pv = __builtin_amdgcn_exp2f(s[rf][j] - mx); s[rf][j] = pv; ls += pv; }
        ls = rows_sum(ls);
        const float inv = __builtin_amdgcn_rcpf(ls);
        bf16x8 pbs[8];
#pragma unroll
        for (int c8 = 0; c8 < 8; ++c8) pbs[c8] = pack8(s[2 * c8], s[2 * c8 + 1]);
        f32x4 o[4];
#pragma unroll
        for (int d = 0; d < 4; ++d) o[d] = (f32x4){0.f, 0.f, 0.f, 0.f};
#pragma unroll
        for (int cc = 0; cc < 4; ++cc) {
            if (cc < nc64) {
                __builtin_amdgcn_wave_barrier();
#pragma unroll
                for (int i = 0; i < 8; ++i) { const int row = wrow + 8 * i; *(u32x4*)(vl + row * 128 + (((lane & 7) ^ dsa_vswz(row)) << 4)) = vr[i]; }
                __builtin_amdgcn_wave_barrier();
                if (cc + 1 < 4 && cc + 1 < nc64) {
#pragma unroll
                    for (int i = 0; i < 8; ++i) { const int key = __shfl(mkc[(cc + 1) & 3], wrow + 8 * i); vr[i] = *(const u32x4*)(vb + (size_t)key * 64 + (lane & 7) * 8); }
                }
#pragma unroll
                for (int c2 = 0; c2 < 2; ++c2) {
                    const bf16x8 pb = pbs[cc * 2 + c2];
#pragma unroll
                    for (int d = 0; d < 4; ++d) {
                        const int r0 = c2 * 32 + 8 * q + (cl >> 2), r1 = r0 + 4;
                        const int ch = d * 2 + ((cl & 3) >> 1), wb = 8 * (cl & 1);
                        const s16x4 lo4 = __builtin_amdgcn_ds_read_tr16_b64_v4i16((LAS s16x4*)((LAS unsigned char*)(vl) + r0 * 128 + ((ch ^ dsa_vswz(r0)) << 4) + wb));
                        const s16x4 hi4 = __builtin_amdgcn_ds_read_tr16_b64_v4i16((LAS s16x4*)((LAS unsigned char*)(vl) + r1 * 128 + ((ch ^ dsa_vswz(r1)) << 4) + wb));
                        const bf16x8 av = {lo4[0], lo4[1], lo4[2], lo4[3], hi4[0], hi4[1], hi4[2], hi4[3]};
                        o[d] = MFMA16(av, pb, o[d]);
                    }
                }
            }
        }
        if (cl < 8) {
#pragma unroll
            for (int d = 0; d < 4; ++d) {
                u32x2 w; w.x = pk2(o[d][0] * inv, o[d][1] * inv); w.y = pk2(o[d][2] * inv, o[d][3] * inv);
                *(u32x2*)(OA + (size_t)tok * 512 + cl * 64 + d * 16 + q * 4) = w;
            }
        }
    }
}

DEVI int fK(int row) { return (row & 3) | (((row >> 3) & 1) << 2); }

struct AttnState { f32x4 O[4][4]; float m[4]; float l[4]; };

template <int MODE>
DEVI void attn_blocks(rsrc_t rs, unsigned sK, unsigned sV, int ldv, int jb0, int jb1, const bf16x8 (&qf)[4][2], AttnState& st,
                      int tq, unsigned long long selmask, unsigned char* lds, int tid) {
    const int lane = tid & 63, q = lane >> 4, cl = lane & 15;
    const float NINF = -__builtin_inff();
#pragma unroll
    for (int cf = 0; cf < 4; ++cf) { st.m[cf] = NINF; st.l[cf] = 0.f;
#pragma unroll
        for (int d = 0; d < 4; ++d) st.O[d][cf] = (f32x4){0.f, 0.f, 0.f, 0.f}; }
    if (jb1 < jb0) return;
    unsigned kro[2], vro[2]; int kwo[2], vwo[2];
#pragma unroll
    for (int i = 0; i < 2; ++i) {
        const int idx = tid + 256 * i, row = idx >> 3, ch = idx & 7;
        kro[i] = (unsigned)(row * 64 + ch * 8) * 2u; kwo[i] = row * 128 + ((ch ^ fK(row)) << 4);
        vro[i] = (unsigned)(row * ldv + ch * 8) * 2u; vwo[i] = 8192 + row * 128 + ((ch ^ (row & 7)) << 4);
    }
    u32x4 rk[2], rv[2];
#pragma unroll
    for (int i = 0; i < 2; ++i) { rk[i] = bload16(rs, kro[i], sK + (unsigned)jb0 * 8192u); rv[i] = bload16(rs, vro[i], sV + (unsigned)jb0 * 128u); }
#pragma unroll
    for (int i = 0; i < 2; ++i) { *(u32x4*)(lds + kwo[i]) = rk[i]; *(u32x4*)(lds + vwo[i]) = rv[i]; }
    __syncthreads();
    const int nmax = (tq >= 31) ? ((tq - 31) >> 4) : -1;
    for (int jb = jb0; jb <= jb1; ++jb) {
        unsigned char* cur = lds + ((jb - jb0) & 1) * 16384;
        unsigned char* nxt = lds + ((jb - jb0 + 1) & 1) * 16384;
        const bool more = jb < jb1;
        if (more) {
#pragma unroll
            for (int i = 0; i < 2; ++i) { rk[i] = bload16(rs, kro[i], sK + (unsigned)(jb + 1) * 8192u); rv[i] = bload16(rs, vro[i], sV + (unsigned)(jb + 1) * 128u); }
        }
        bool lane_on = true;
        if (MODE == 1) lane_on = ((selmask >> jb) & 1ull) != 0ull;
        if (MODE == 0) lane_on = (jb * 64 <= nmax);
        if (MODE == 2) lane_on = (jb * 64 + 63 > tq - 512);
        if (__ballot(lane_on) != 0ull) {
#pragma unroll
            for (int c = 0; c < 2; ++c) {
                f32x4 S[2][4];
#pragma unroll
                for (int r2 = 0; r2 < 2; ++r2)
#pragma unroll
                    for (int cf = 0; cf < 4; ++cf) S[r2][cf] = (f32x4){0.f, 0.f, 0.f, 0.f};
#pragma unroll
                for (int r2 = 0; r2 < 2; ++r2) {
                    const int kl = 32 * c + 8 * (cl >> 2) + 4 * r2 + (cl & 3);
#pragma unroll
                    for (int ks = 0; ks < 2; ++ks) {
                        const bf16x8 a = *(const bf16x8*)(cur + kl * 128 + (((ks * 4 + q) ^ (cl & 7)) << 4));
#pragma unroll
                        for (int cf = 0; cf < 4; ++cf) S[r2][cf] = MFMA16(a, qf[cf][ks], S[r2][cf]);
                    }
                }
                bool edge;
                if (MODE == 0) edge = (jb * 64 + 63 > nmax);
                else if (MODE == 1) edge = (jb * 64 + 63 > tq) || !lane_on;
                else edge = (jb * 64 + 63 > tq) || (jb * 64 <= tq - 512);
                const bool need_mask = __ballot(edge) != 0ull;
                bf16x8 pb[4];
#pragma unroll
                for (int cf = 0; cf < 4; ++cf) {
                    if (need_mask) {
#pragma unroll
                        for (int r2 = 0; r2 < 2; ++r2)
#pragma unroll
                            for (int j = 0; j < 4; ++j) {
                                const int key = jb * 64 + 32 * c + 8 * q + 4 * r2 + j;
                                bool v;
                                if (MODE == 0) v = key <= nmax;
                                else if (MODE == 1) v = lane_on && key <= tq;
                                else v = key <= tq && key > tq - 512;
                                if (!v) S[r2][cf][j] = NINF;
                            }
                    }
                    const float bml = fmaxf(fmaxf(fmaxf(S[0][cf][0], S[0][cf][1]), fmaxf(S[0][cf][2], S[0][cf][3])), fmaxf(fmaxf(S[1][cf][0], S[1][cf][1]), fmaxf(S[1][cf][2], S[1][cf][3])));
                    if (__ballot(bml > st.m[cf] + 8.0f) != 0ull) {
                        const float bm = rows_max(bml);
                        const float mnew = fmaxf(st.m[cf], bm);
                        const float mr0 = (mnew == NINF) ? 0.f : mnew;
                        const float alpha = __builtin_amdgcn_exp2f(st.m[cf] - mr0);
                        st.m[cf] = mnew;
                        st.l[cf] *= alpha;
#pragma unroll
                        for (int d = 0; d < 4; ++d) st.O[d][cf] *= alpha;
                    }
                    const float mref = (st.m[cf] == NINF) ? 0.f : st.m[cf];
                    float ps = 0.f;
#pragma unroll
                    for (int r2 = 0; r2 < 2; ++r2)
#pragma unroll
                        for (int j = 0; j < 4; ++j) { const float pv = __builtin_amdgcn_exp2f(S[r2][cf][j] - mref); S[r2][cf][j] = pv; ps += pv; }
                    st.l[cf] += ps;
                    pb[cf] = pack8(S[0][cf], S[1][cf]);
                }
#pragma unroll
                for (int d = 0; d < 4; ++d) {
                    const int row = d * 16 + cl;
                    const bf16x8 av = *(const bf16x8*)(cur + 8192 + row * 128 + (((c * 4 + q) ^ (row & 7)) << 4));
#pragma unroll
                    for (int cf = 0; cf < 4; ++cf) st.O[d][cf] = MFMA16(av, pb[cf], st.O[d][cf]);
                }
            }
        }
        if (more) {
#pragma unroll
            for (int i = 0; i < 2; ++i) { *(u32x4*)(nxt + kwo[i]) = rk[i]; *(u32x4*)(nxt + vwo[i]) = rv[i]; }
        }
        __syncthreads();
    }
}

DEVI f32x4 bload16f(rsrc_t r, unsigned voff, unsigned soff) { return __builtin_bit_cast(f32x4, __builtin_amdgcn_raw_buffer_load_b128(r, (int)voff, (int)soff, 0)); }
DEVI void bstore16f(rsrc_t r, f32x4 v, unsigned voff, unsigned soff) { __builtin_amdgcn_raw_buffer_store_b128(__builtin_bit_cast(u32x4, v), r, (int)voff, (int)soff, 0); }
DEVI float bload4f(rsrc_t r, unsigned voff, unsigned soff) { return __builtin_bit_cast(float, __builtin_amdgcn_raw_buffer_load_b32(r, (int)voff, (int)soff, 0)); }

struct NsaUnit { int i, b, k, t0, tq; unsigned tokw, tokb, qoff, goff, ooff, sQ, sG, sO; };
DEVI NsaUnit nsa_unit(int uu, int tid) {
    NsaUnit U;
    const int lane = tid & 63, wid = __builtin_amdgcn_readfirstlane(tid >> 6), q = lane >> 4, cl = lane & 15;
    const int half = uu >> 9, r = uu & 511, bk = r & 15, ii = r >> 4;
    U.i = half ? ii : 63 - ii; U.b = bk >> 1; U.k = bk & 1;
    U.t0 = U.i * 64; U.tq = U.t0 + wid * 16 + cl;
    U.tokw = (unsigned)(wid * 16 + cl);
    U.tokb = (unsigned)(U.b * 4096 + U.t0);
    U.qoff = U.tokw * 1024u + (unsigned)q * 16u;
    U.goff = U.tokw * 96u;
    U.ooff = U.tokw * 1024u + (unsigned)q * 8u;
    U.sQ = U.tokb * 1024u + (unsigned)U.k * 512u;
    U.sG = (unsigned)OFF_GATES + U.tokb * 96u + (unsigned)U.k * 16u;
    U.sO = (unsigned)OFF_OB + U.tokb * 1024u + (unsigned)U.k * 512u;
    return U;
}

DEVI void nsa_cmp_unit(const Params& P, rsrc_t rs, int uu, unsigned char* lds, int tid) {
    const int lane = tid & 63, wid = __builtin_amdgcn_readfirstlane(tid >> 6), q = lane >> 4, cl = lane & 15;
    const NsaUnit U = nsa_unit(uu, tid);
    const int i = U.i, b = U.b, k = U.k, tq = U.tq;
    AttnState st;
    bf16x8 qf[4][2];
#pragma unroll
    for (int cf = 0; cf < 4; ++cf)
#pragma unroll
        for (int ks = 0; ks < 2; ++ks) qf[cf][ks] = __builtin_bit_cast(bf16x8, bload16(rs, U.qoff, (unsigned)OFF_QBN + U.sQ + cf * 128 + ks * 64));
    const unsigned sKC = (unsigned)OFF_KC + (unsigned)(b * 2 + k) * 256u * 128u;
    const unsigned sVC = (unsigned)OFF_VCT + (unsigned)(b * 2 + k) * 64u * 512u;
    const int nmax_blk = (U.t0 + 63 - 31) >> 4;
    const int jbc = (nmax_blk >> 6) < 3 ? (nmax_blk >> 6) : 3;
    attn_blocks<0>(rs, sKC, sVC, 256, 0, jbc, qf, st, tq, 0ull, lds, tid);
    float linv[4], mfin[4];
#pragma unroll
    for (int cf = 0; cf < 4; ++cf) {
        const float l = rows_sum(st.l[cf]);
        linv[cf] = (l > 0.f) ? __builtin_amdgcn_rcpf(l) : 0.f; mfin[cf] = st.m[cf];
        const float sc = linv[cf] * bload4f(rs, U.goff, U.sG + cf * 4);
#pragma unroll
        for (int d = 0; d < 4; ++d) { const f32x4 v = st.O[d][cf] * sc; u32x2 w; w.x = pk2(v[0], v[1]); w.y = pk2(v[2], v[3]);
            __builtin_amdgcn_raw_buffer_store_b64(w, rs, (int)U.ooff, (int)(U.sO + cf * 128 + d * 32), 0); }
    }
    unsigned long long* MSKG = (unsigned long long*)(P.ws + OFF_MASK);
    if (i < 16) {
        if (q == 0) MSKG[((size_t)(b * 2 + k)) * 4096 + tq] = (2ull << i) - 1ull;
        return;
    }
    float* SUM4 = (float*)(lds + 16384);
    float* LAST = (float*)(lds + 32768);
    float* IMP2 = (float*)(lds + 49152);
    const int nmax = (tq >= 31) ? ((tq - 31) >> 4) : -1;
    for (int kb = 0; kb <= jbc; ++kb) {
#pragma unroll
        for (int ii = 0; ii < 2; ++ii) {
            const int idx = tid + 256 * ii, row = idx >> 3, ch = idx & 7;
            *(u32x4*)(lds + row * 128 + ((ch ^ fK(row)) << 4)) = bload16(rs, (unsigned)(row * 64 + ch * 8) * 2u, sKC + (unsigned)kb * 8192u);
        }
        __syncthreads();
#pragma unroll
        for (int rf = 0; rf < 4; ++rf) {
            f32x4 S[4];
#pragma unroll
            for (int cf = 0; cf < 4; ++cf) S[cf] = (f32x4){0.f, 0.f, 0.f, 0.f};
            const int kl = 32 * (rf >> 1) + 8 * (cl >> 2) + 4 * (rf & 1) + (cl & 3);
#pragma unroll
            for (int ks = 0; ks < 2; ++ks) {
                const bf16x8 a = *(const bf16x8*)(lds + kl * 128 + (((ks * 4 + q) ^ (cl & 7)) << 4));
#pragma unroll
                for (int cf = 0; cf < 4; ++cf) S[cf] = MFMA16(a, qf[cf][ks], S[cf]);
            }
            float acc4 = 0.f, accl = 0.f;
#pragma unroll
            for (int j = 0; j < 4; ++j) {
                const int key = kb * 64 + 32 * (rf >> 1) + 8 * q + 4 * (rf & 1) + j;
                float pj = 0.f;
#pragma unroll
                for (int cf = 0; cf < 4; ++cf) pj += __builtin_amdgcn_exp2f(S[cf][j] - mfin[cf]) * linv[cf];
                pj = (key <= nmax) ? pj : 0.f;
                acc4 += pj; if (j == 3) accl = pj;
            }
            const int jblk = kb * 16 + 8 * (rf >> 1) + 2 * q + (rf & 1);
            SUM4[(wid * 16 + cl) * 64 + jblk] = acc4; LAST[(wid * 16 + cl) * 64 + jblk] = accl;
        }
        __syncthreads();
    }
    {
        const int qi = tid >> 2, jg = tid & 3;
        const int jlim = (jbc + 1) * 16;
        for (int jj = 0; jj < 16; ++jj) {
            const int j = jg * 16 + jj;
            float v = (j < jlim) ? SUM4[qi * 64 + j] : 0.f;
            if (j >= 1 && j - 1 < jlim) v += LAST[qi * 64 + j - 1];
            IMP2[qi * 64 + j] = v;
        }
    }
    __syncthreads();
    {
        const int qi = tid >> 2, jg = tid & 3;
        const float* row = IMP2 + qi * 64;
        float kk[64];
#pragma unroll
        for (int j4 = 0; j4 < 16; ++j4) {
            const f32x4 v = *(const f32x4*)(row + j4 * 4);
#pragma unroll
            for (int e = 0; e < 4; ++e) {
                const int j2 = j4 * 4 + e;
                const bool f2 = (j2 == 0) || (j2 == i) || (j2 == i - 1);
                kk[j2] = (j2 > i) ? -__builtin_inff() : (f2 ? __builtin_inff() : v[e]);
            }
        }
        unsigned lo = 0u;
#pragma unroll 1
        for (int jj = 0; jj < 16; ++jj) {
            const int j = jg * 16 + jj;
            float kj = -__builtin_inff();
#pragma unroll
            for (int j2 = 0; j2 < 64; ++j2) kj = (j2 == j) ? kk[j2] : kj;
            int rank = 0;
#pragma unroll
            for (int j2 = 0; j2 < 64; ++j2) rank += (kk[j2] > kj || (kk[j2] == kj && j2 < j)) ? 1 : 0;
            if (j <= i && rank < 16) lo |= (1u << jj);
        }
        unsigned long long bits = (unsigned long long)lo << (jg * 16);
        bits |= __shfl_xor(bits, 1); bits |= __shfl_xor(bits, 2);
        if (jg == 0) MSKG[((size_t)(b * 2 + k)) * 4096 + U.t0 + qi] = bits;
    }
    __syncthreads();
}

template <int MODE>
DEVI void nsa_kv_unit(const Params& P, rsrc_t rs, int uu, unsigned char* lds, int tid) {
    const int lane = tid & 63, q = lane >> 4;
    const NsaUnit U = nsa_unit(uu, tid);
    const int i = U.i, b = U.b, k = U.k, tq = U.tq;
    AttnState st;
    bf16x8 qf[4][2];
#pragma unroll
    for (int cf = 0; cf < 4; ++cf)
#pragma unroll
        for (int ks = 0; ks < 2; ++ks) qf[cf][ks] = __builtin_bit_cast(bf16x8, bload16(rs, U.qoff, (unsigned)OFF_QBR + U.sQ + cf * 128 + ks * 64));
    const unsigned sK = (unsigned)(OFF_KV + (MODE == 1 ? 2 : 4) * KV_STRIDE) + (unsigned)(b * 2 + k) * 4096u * 128u;
    const unsigned sV = (unsigned)(OFF_KV + (MODE == 1 ? 3 : 5) * KV_STRIDE) + (unsigned)(b * 2 + k) * 64u * 8192u;
    unsigned long long mymask = 0ull;
    int j0 = 0;
    if (MODE == 1) mymask = ((const unsigned long long*)(P.ws + OFF_MASK))[((size_t)(b * 2 + k)) * 4096 + tq];
    else j0 = (i >= 8) ? i - 8 : 0;
    attn_blocks<MODE>(rs, sK, sV, 4096, j0, i, qf, st, tq, mymask, lds, tid);
#pragma unroll
    for (int cf = 0; cf < 4; ++cf) {
        const float l = rows_sum(st.l[cf]);
        const float sc = ((l > 0.f) ? __builtin_amdgcn_rcpf(l) : 0.f) * bload4f(rs, U.goff, U.sG + (MODE == 1 ? 32 : 64) + cf * 4);
#pragma unroll
        for (int d = 0; d < 4; ++d) {
            const u32x2 pw = __builtin_bit_cast(u32x2, __builtin_amdgcn_raw_buffer_load_b64(rs, (int)U.ooff, (int)(U.sO + cf * 128 + d * 32), 0));
            f32x4 v = st.O[d][cf] * sc;
            v[0] += bf2f(pw.x & 0xffffu); v[1] += bf2f(pw.x >> 16); v[2] += bf2f(pw.y & 0xffffu); v[3] += bf2f(pw.y >> 16);
            u32x2 w; w.x = pk2(v[0], v[1]); w.y = pk2(v[2], v[3]);
            __builtin_amdgcn_raw_buffer_store_b64(w, rs, (int)U.ooff, (int)(U.sO + cf * 128 + d * 32), 0);
        }
    }
}

DEVI void phase_nsa(const Params& P, unsigned char* lds, int tid) {
    const rsrc_t rs = __builtin_amdgcn_make_buffer_rsrc((void*)P.ws, (short)0, (int)0x7fffffff, 0x00020000);
    for (int uu = blockIdx.x; uu < 1024; uu += gridDim.x) { int t = tid; asm volatile("" : "+v"(t)); nsa_cmp_unit(P, rs, uu, lds, t); }
    __syncthreads();
    for (int uu = blockIdx.x; uu < 1024; uu += gridDim.x) { int t = tid; asm volatile("" : "+v"(t)); nsa_kv_unit<1>(P, rs, uu, lds, t); }
    __syncthreads();
    for (int uu = blockIdx.x; uu < 1024; uu += gridDim.x) { int t = tid; asm volatile("" : "+v"(t)); nsa_kv_unit<2>(P, rs, uu, lds, t); }
}

DEVI void phase_merge(const Params& P, unsigned char* lds, int tid) {
    unsigned char* ws = P.ws;
    const rsrc_t rs = __builtin_amdgcn_make_buffer_rsrc((void*)P.ws, (short)0, (int)0x7fffffff, 0x00020000);
    const bf16_t* ga = (const bf16_t*)(ws + OFF_GA);
    const bf16_t* gb = (const bf16_t*)(ws + OFF_GB);
    bf16_t* mg = (bf16_t*)(ws + OFF_MERGED);
    const int lane = tid & 63, wid = __builtin_amdgcn_readfirstlane(tid >> 6), wr = wid >> 1, wc = wid & 1, q = lane >> 4, cl = lane & 15;
    for (int kk = 0;; ++kk) {
        int mt, nt;
        if (!tile_map(kk, 8, mt, nt)) break;
        f32x4 acc[4][4];
        unsigned t[4][4][2];
        gemm128(acc, rs, (unsigned)(OFF_OA + (size_t)mt * 128 * 1024), RowLin{1024}, (unsigned)(OFF_WBRA + (size_t)nt * 128 * 1024), RowLin{1024}, 8, lds, tid);
        const size_t e0 = (size_t)(mt * 128 + wr * 64 + cl) * 1024 + nt * 128 + wc * 64 + q * 4;
#pragma unroll
        for (int m = 0; m < 4; ++m)
#pragma unroll
            for (int n = 0; n < 4; ++n) {
                const u32x2 gv = *(const u32x2*)(ga + e0 + (size_t)m * 16 * 1024 + n * 16);
                t[m][n][0] = pk2(acc[m][n][0] * bf2f(gv.x & 0xffffu), acc[m][n][1] * bf2f(gv.x >> 16));
                t[m][n][1] = pk2(acc[m][n][2] * bf2f(gv.y & 0xffffu), acc[m][n][3] * bf2f(gv.y >> 16));
            }
        gemm128(acc, rs, (unsigned)(OFF_OB + (size_t)mt * 128 * 1024), RowLin{1024}, (unsigned)(OFF_WBRB + (size_t)nt * 128 * 1024), RowLin{1024}, 8, lds, tid);
#pragma unroll
        for (int m = 0; m < 4; ++m)
#pragma unroll
            for (int n = 0; n < 4; ++n) {
                const size_t o = e0 + (size_t)m * 16 * 1024 + n * 16;
                const u32x2 gv = *(const u32x2*)(gb + o);
                u32x2 w;
                w.x = pk2(bf2f(t[m][n][0] & 0xffffu) + acc[m][n][0] * bf2f(gv.x & 0xffffu), bf2f(t[m][n][0] >> 16) + acc[m][n][1] * bf2f(gv.x >> 16));
                w.y = pk2(bf2f(t[m][n][1] & 0xffffu) + acc[m][n][2] * bf2f(gv.y & 0xffffu), bf2f(t[m][n][1] >> 16) + acc[m][n][3] * bf2f(gv.y >> 16));
                *(u32x2*)(mg + o) = w;
            }
    }
}

DEVI void phase_outproj(const Params& P, unsigned char* lds, int tid) {
    unsigned char* ws = P.ws;
    const rsrc_t rs = __builtin_amdgcn_make_buffer_rsrc((void*)P.ws, (short)0, (int)0x7fffffff, 0x00020000);
    const bf16_t* mg = (const bf16_t*)(ws + OFF_MERGED);
    const bf16_t* wo = (const bf16_t*)(ws + OFF_WOUT);
    const float* x = P.in[0];
    float* x1 = P.out;
    const int lane = tid & 63, wid = __builtin_amdgcn_readfirstlane(tid >> 6), wr = wid >> 1, wc = wid & 1, q = lane >> 4, cl = lane & 15;
    for (int kk = 0;; ++kk) {
        int mt, nt;
        if (!tile_map(kk, 8, mt, nt, 128)) break;
        f32x4 acc[8][4];
        gemm256(acc, rs, (unsigned)(OFF_MERGED + (size_t)mt * 256 * 2048), 2048u, (unsigned)(OFF_WOUT + (size_t)nt * 128 * 2048), 2048u, 32, lds, tid);
#pragma unroll
        for (int m = 0; m < 8; ++m)
#pragma unroll
            for (int n = 0; n < 4; ++n) {
                const size_t o = (size_t)(mt * 256 + wr * 128 + m * 16 + cl) * 1024 + nt * 128 + wc * 64 + n * 16 + q * 4;
                *(f32x4*)(x1 + o) = *(const f32x4*)(x + o) + acc[m][n];
            }
    }
}

DEVI void phase_router(const Params& P, unsigned char* lds, int tid) {
    unsigned char* ws = P.ws;
    const int lane = tid & 63, wid = __builtin_amdgcn_readfirstlane(tid >> 6), q = lane >> 4, cl = lane & 15;
    const float* x1 = P.out; const float* g = P.in[13];
    const float* bg = P.in[15]; const float* be = P.in[17];
    const float* WR = (const float*)(ws + OFF_WR);
    bf16_t* h2 = (bf16_t*)(ws + OFF_HN);
    unsigned* cnt = (unsigned*)(ws + OFF_CTL);
    int* list = (int*)(ws + OFF_LIST);
    float* wt = (float*)(ws + OFF_WT);
    float* WL = (float*)lds;
    float* LG = (float*)(lds + 50688);
    float* RS = (float*)(lds + 50688 + 12288);
    for (int u = blockIdx.x; u < NTOK / 64; u += gridDim.x) {
        const int row0 = u * 64 + wid * 16;
        const float* xa = x1 + (size_t)(row0 + cl) * 1024 + 4 * q;
        f32x4 acc[3];
#pragma unroll
        for (int ct = 0; ct < 3; ++ct) acc[ct] = (f32x4){0.f, 0.f, 0.f, 0.f};
        float ss = 0.f;
        for (int kc = 0; kc < 4; ++kc) {
            __syncthreads();
#pragma unroll
            for (int i = 0; i < 12; ++i) {
                const int idx = tid + 256 * i, r = idx >> 6, c4 = idx & 63;
                *(f32x4*)(WL + r * 264 + c4 * 4) = *(const f32x4*)(WR + (size_t)r * 1024 + kc * 256 + c4 * 4);
            }
            __syncthreads();
#pragma unroll
            for (int jh = 0; jh < 2; ++jh) {
                f32x4 av[8];
#pragma unroll
                for (int j = 0; j < 8; ++j) av[j] = *(const f32x4*)(xa + kc * 256 + (jh * 8 + j) * 16);
#pragma unroll
                for (int j = 0; j < 8; ++j) {
                    {
                        const int kx = kc * 256 + (jh * 8 + j) * 16 + 4 * q;
                        const f32x4 gg = *(const f32x4*)(g + kx);
                        u32x2 w; w.x = pk2(av[j][0] * gg[0], av[j][1] * gg[1]); w.y = pk2(av[j][2] * gg[2], av[j][3] * gg[3]);
                        *(u32x2*)(h2 + (size_t)(row0 + cl) * 1024 + kx) = w;
                    }
                    ss += av[j][0] * av[j][0] + av[j][1] * av[j][1] + av[j][2] * av[j][2] + av[j][3] * av[j][3];
#pragma unroll
                    for (int ct = 0; ct < 3; ++ct) {
                        const f32x4 bv = *(const f32x4*)(WL + (ct * 16 + cl) * 264 + (jh * 8 + j) * 16 + 4 * q);
#pragma unroll
                        for (int e = 0; e < 4; ++e) acc[ct] = __builtin_amdgcn_mfma_f32_16x16x4f32(av[j][e], bv[e], acc[ct], 0, 0, 0);
                    }
                }
            }
        }
        ss += __shfl_xor(ss, 16); ss += __shfl_xor(ss, 32);
        const float rs = rsqrtf(ss * (1.0f / 1024.0f) + RMS_EPS);
        if (q == 0) { RS[wid * 16 + cl] = rs; ((float*)(ws + OFF_RS))[row0 + cl] = rs; }
        __syncthreads();
#pragma unroll
        for (int j = 0; j < 4; ++j) {
            const float rj = RS[wid * 16 + 4 * q + j];
#pragma unroll
            for (int ct = 0; ct < 3; ++ct) LG[(wid * 16 + 4 * q + j) * 48 + ct * 16 + cl] = acc[ct][j] * rj;
        }
        __syncthreads();
        if (tid < 64) {
            const int r = u * 64 + tid;
            const float* lg = LG + tid * 48;
            float gl[4];
#pragma unroll
            for (int e = 0; e < 4; ++e) gl[e] = lg[e] + bg[e];
            int gs = 0; float gm = gl[0];
#pragma unroll
            for (int e = 1; e < 4; ++e) if (gl[e] > gm) { gm = gl[e]; gs = e; }
            float den = 0.f;
#pragma unroll
            for (int e = 0; e < 4; ++e) den += __expf(gl[e] - gm);
            const float gp = 1.0f / den;
            float el[8];
#pragma unroll
            for (int e = 0; e < 8; ++e) el[e] = lg[4 + gs * 8 + e] + be[gs * 8 + e];
            int i0 = 0; float v0 = el[0];
#pragma unroll
            for (int e = 1; e < 8; ++e) if (el[e] > v0) { v0 = el[e]; i0 = e; }
            int i1 = -1; float v1 = -__builtin_inff();
#pragma unroll
            for (int e = 0; e < 8; ++e) if (e != i0 && el[e] > v1) { v1 = el[e]; i1 = e; }
            const float e1 = __expf(v1 - v0);
            const float w0 = gp / (1.0f + e1), w1 = gp * e1 / (1.0f + e1);
            const int ex0 = gs * 8 + i0, ex1 = gs * 8 + i1;
            const unsigned p0 = atomicAdd(&cnt[ex0], 1u);
            list[(size_t)ex0 * NTOK + p0] = r * 2 + 0;
            const unsigned p1 = atomicAdd(&cnt[ex1], 1u);
            list[(size_t)ex1 * NTOK + p1] = r * 2 + 1;
            wt[(size_t)r * 2 + 0] = w0; wt[(size_t)r * 2 + 1] = w1;
        }
    }
}

struct RowGather { const int* idx; DEVI unsigned operator()(int r) const { return (unsigned)idx[r] * 2048u; } };
struct RowGU { int c0; DEVI unsigned operator()(int r) const {
    const int wcx = r >> 6, w = r & 63; const int col = (w < 32) ? (c0 + wcx * 32 + w) : (256 + c0 + wcx * 32 + (w - 32)); return (unsigned)col * 2048u; } };

DEVI int moe_find_tile(const unsigned* cnt, int u, int& e, int& tl) {
    int t = u, ee = 0, ce = 0;
    for (; ee < 32; ++ee) { ce = (int)cnt[ee]; const int nt = (ce + 127) >> 7; if (t < nt) break; t -= nt; }
    e = ee; tl = t; return ce;
}
DEVI void phase_moe_a(const Params& P, unsigned char* lds, int tid) {
    unsigned char* ws = P.ws;
    const rsrc_t rs = __builtin_amdgcn_make_buffer_rsrc((void*)P.ws, (short)0, (int)0x7fffffff, 0x00020000);
    const int lane = tid & 63, wid = __builtin_amdgcn_readfirstlane(tid >> 6), wr = wid >> 1, wc = wid & 1, q = lane >> 4, cl = lane & 15;
    const unsigned* cnt = (const unsigned*)(ws + OFF_CTL);
    const int* list = (const int*)(ws + OFF_LIST);
    bf16_t* act = (bf16_t*)(ws + OFF_ACT);
    int* rowtok = (int*)(lds + 65536);
    const float* RSG = (const float*)(ws + OFF_RS);
    int total = 0;
    for (int e = 0; e < 32; ++e) total += ((int)cnt[e] + 127) >> 7;
    for (int v = blockIdx.x; v < total * 4; v += gridDim.x) {
        const int u = v >> 2, nt = v & 3;
        int e, tl; const int ce = moe_find_tile(cnt, u, e, tl);
        if (tid < 128) { const int r = tl * 128 + tid; rowtok[tid] = (r < ce) ? (list[(size_t)e * NTOK + r] >> 1) : 0; }
        __syncthreads();
        bf16_t* au = act + (size_t)u * 128 * 256;
        f32x4 acc[4][4];
        gemm128(acc, rs, (unsigned)OFF_HN, RowGather{rowtok}, (unsigned)(OFF_WGU + (size_t)e * 512 * 2048), RowGU{nt * 64}, 16, lds, tid);
#pragma unroll
        for (int m = 0; m < 4; ++m)
#pragma unroll
            for (int n = 0; n < 2; ++n) {
                const int row = wr * 64 + m * 16 + cl, col = nt * 64 + wc * 32 + n * 16 + q * 4;
                const float rsv = RSG[rowtok[row]];
                const f32x4 gt = acc[m][n] * rsv, up = acc[m][n + 2] * rsv;
                u32x2 w;
                w.x = pk2(siluf_(gt[0]) * up[0], siluf_(gt[1]) * up[1]);
                w.y = pk2(siluf_(gt[2]) * up[2], siluf_(gt[3]) * up[3]);
                *(u32x2*)(au + (size_t)row * 256 + col) = w;
            }
        __syncthreads();
    }
}
DEVI void phase_moe_b(const Params& P, unsigned char* lds, int tid) {
    unsigned char* ws = P.ws;
    const rsrc_t rs = __builtin_amdgcn_make_buffer_rsrc((void*)P.ws, (short)0, (int)0x7fffffff, 0x00020000);
    const int lane = tid & 63, wid = __builtin_amdgcn_readfirstlane(tid >> 6), wr = wid >> 1, wc = wid & 1, q = lane >> 4, cl = lane & 15;
    const unsigned* cnt = (const unsigned*)(ws + OFF_CTL);
    const int* list = (const int*)(ws + OFF_LIST);
    bf16_t* Y = (bf16_t*)(ws + OFF_Y);
    int* rowas = (int*)(lds + 65536);
    int total = 0;
    for (int e = 0; e < 32; ++e) total += ((int)cnt[e] + 127) >> 7;
    for (int v = blockIdx.x; v < total * 4; v += gridDim.x) {
        const int u = v >> 2, np = v & 3;
        int e, tl; const int ce = moe_find_tile(cnt, u, e, tl);
        if (tid < 128) { const int r = tl * 128 + tid; rowas[tid] = (r < ce) ? list[(size_t)e * NTOK + r] : -1; }
        __syncthreads();
        for (int h = 0; h < 2; ++h) {
            const int nt = np * 2 + h;
            f32x4 acc[4][4];
            gemm128(acc, rs, (unsigned)(OFF_ACT + (size_t)u * 128 * 512), RowLin{512}, (unsigned)(OFF_WDN + (size_t)e * 1024 * 512 + (size_t)nt * 128 * 512), RowLin{512}, 4, lds, tid);
#pragma unroll
            for (int m = 0; m < 4; ++m) {
                const int row = wr * 64 + m * 16 + cl;
                const int as = rowas[row];
                if (as >= 0) {
                    bf16_t* yr = Y + ((size_t)(as & 1) * NTOK + (as >> 1)) * 1024 + nt * 128 + wc * 64 + q * 4;
#pragma unroll
                    for (int n = 0; n < 4; ++n) { u32x2 w; w.x = pk2(acc[m][n][0], acc[m][n][1]); w.y = pk2(acc[m][n][2], acc[m][n][3]); *(u32x2*)(yr + n * 16) = w; }
                }
            }
        }
        __syncthreads();
    }
}

DEVI void phase_final(const Params& P, int tid, bool with_moe) {
    unsigned char* ws = P.ws;
    const int lane = tid & 63, wid = __builtin_amdgcn_readfirstlane(tid >> 6);
    const bf16_t* Y = (const bf16_t*)(ws + OFF_Y);
    const float* wt = (const float*)(ws + OFF_WT);
    const float* g = P.in[20];
    float* out = P.out;
    for (int r = blockIdx.x * 4 + wid; r < NTOK; r += gridDim.x * 4) {
        float* xr = out + (size_t)r * 1024;
        const float w0 = with_moe ? wt[(size_t)r * 2] : 0.f, w1 = with_moe ? wt[(size_t)r * 2 + 1] : 0.f;
        f32x4 v[4]; float ss = 0.f;
#pragma unroll
        for (int i = 0; i < 4; ++i) {
            v[i] = *(const f32x4*)(xr + i * 256 + lane * 4);
            if (with_moe) {
                const u32x2 a = *(const u32x2*)(Y + (size_t)r * 1024 + i * 256 + lane * 4);
                const u32x2 b = *(const u32x2*)(Y + ((size_t)NTOK + r) * 1024 + i * 256 + lane * 4);
                v[i][0] += w0 * bf2f(a.x & 0xffffu) + w1 * bf2f(b.x & 0xffffu); v[i][1] += w0 * bf2f(a.x >> 16) + w1 * bf2f(b.x >> 16);
                v[i][2] += w0 * bf2f(a.y & 0xffffu) + w1 * bf2f(b.y & 0xffffu); v[i][3] += w0 * bf2f(a.y >> 16) + w1 * bf2f(b.y >> 16);
            }
            ss += v[i][0] * v[i][0] + v[i][1] * v[i][1] + v[i][2] * v[i][2] + v[i][3] * v[i][3];
        }
        ss = wave_sum(ss);
        const float rs = rsqrtf(ss * (1.0f / 1024.0f) + RMS_EPS);
#pragma unroll
        for (int i = 0; i < 4; ++i) {
            const f32x4 gg = *(const f32x4*)(g + i * 256 + lane * 4);
            f32x4 o; o[0] = v[i][0] * rs * gg[0]; o[1] = v[i][1] * rs * gg[1]; o[2] = v[i][2] * rs * gg[2]; o[3] = v[i][3] * rs * gg[3];
            *(f32x4*)(xr + i * 256 + lane * 4) = o;
        }
    }
}

#define LAUNDER_TID() do { tid = wave_id * 64 + (int)__builtin_amdgcn_mbcnt_hi(~0u, __builtin_amdgcn_mbcnt_lo(~0u, 0u)); asm volatile("" : "+v"(tid)); } while (0)
__global__ void __launch_bounds__(NTHREADS, 2) fwd_megakernel(Params P) {
    extern __shared__ __attribute__((aligned(16))) unsigned char lds[];
    cg::grid_group grid = cg::this_grid();
    int tid;
    const int wave_id = __builtin_amdgcn_readfirstlane((int)(threadIdx.x >> 6));
    volatile LAS unsigned* bst = (volatile LAS unsigned*)(LAS unsigned char*)(lds + LDS_BYTES - 16);
    if (threadIdx.x < 4) bst[threadIdx.x] = 0u;
    __syncthreads();
    (void)xcd_barrier_post((unsigned*)(P.ws + OFF_BAR), bst);
#define GRID_BARRIER() do { XcdBarrier b_; b_.bar = (unsigned*)(P.ws + OFF_BAR); b_.x = xb_xcc_id(); b_.st = (volatile LAS unsigned*)(LAS unsigned char*)(lds + LDS_BYTES - 16); xcd_barrier(b_); } while (0)
    if (P.ph_lo != 0) grid.sync();
    LAUNDER_TID(); phase_prep(P, lds, tid, 0); __syncthreads();
    GRID_BARRIER();
    {
        const int first_idx = (blockIdx.x >> 8) & 1;
        for (int step = 0; step < 3; ++step) {
            const int what = (step == 0) ? 0 : 1 + ((step - 1) ^ first_idx);
            if (what <= 1) { LAUNDER_TID(); phase_gemm1(P, lds, tid, what); }
            else {
                LAUNDER_TID(); phase_prep(P, lds, tid, 1); __syncthreads();
                LAUNDER_TID(); phase_compress(P, lds, tid); __syncthreads();
                LAUNDER_TID(); phase_index(P, lds, tid);
            }
            __syncthreads();
            if (step == 0) GRID_BARRIER();
        }
    }
    GRID_BARRIER();
    if (((blockIdx.x >> 8) & 1) == 0) { LAUNDER_TID(); phase_dsa(P, lds, tid); __syncthreads(); }
    LAUNDER_TID(); phase_nsa(P, lds, tid); __syncthreads();
    if (((blockIdx.x >> 8) & 1) != 0) { LAUNDER_TID(); phase_dsa(P, lds, tid); __syncthreads(); }
    GRID_BARRIER();
    LAUNDER_TID(); phase_merge(P, lds, tid);
    GRID_BARRIER();
    LAUNDER_TID(); phase_outproj(P, lds, tid);
    GRID_BARRIER();
    LAUNDER_TID(); phase_router(P, lds, tid);
    GRID_BARRIER();
    LAUNDER_TID(); phase_moe_a(P, lds, tid);
    GRID_BARRIER();
    LAUNDER_TID(); phase_moe_b(P, lds, tid);
    GRID_BARRIER();
    LAUNDER_TID(); phase_final(P, tid, true);
}

extern "C" void kernel_launch(void* const* d_in, const int* in_sizes, int n_in, void* d_out, int out_size, void* d_ws, size_t ws_size,
                              hipStream_t stream) {
    static int grid_blocks = 0;
    if (!grid_blocks) {
        int dev = 0, cus = 0, per_cu = 0;
        hipGetDevice(&dev);
        hipDeviceGetAttribute(&cus, hipDeviceAttributeMultiprocessorCount, dev);
        hipFuncSetAttribute((const void*)fwd_megakernel, hipFuncAttributeMaxDynamicSharedMemorySize, LDS_BYTES);
        hipOccupancyMaxActiveBlocksPerMultiprocessor(&per_cu, (const void*)fwd_megakernel, NTHREADS, LDS_BYTES);
        if (per_cu < 1) per_cu = 1;
        if (per_cu > 2) per_cu = 2;
        grid_blocks = cus * per_cu;
        if (ws_size < WS_END) fprintf(stderr, "kernel_launch: workspace too small: %zu < %zu\n", ws_size, (size_t)WS_END);
    }
    Params p{};
    for (int i = 0; i < 21; ++i) p.in[i] = (const float*)d_in[i];
    p.pos = (const int*)d_in[1];
    p.out = (float*)d_out;
    p.ws = (unsigned char*)d_ws;
    for (int i = 0; i < 32; ++i) p.inv_freq[i] = (double)powf(10000.0f, -(float)i / 32.0f);
    p.ph_lo = 0; p.ph_hi = 0;
    (void)hipMemsetAsync(d_ws, 0, OFF_WIN_T, stream);
    void* args[] = {&p};
    hipError_t e = hipLaunchCooperativeKernel((const void*)fwd_megakernel, dim3(grid_blocks), dim3(NTHREADS), args, LDS_BYTES, stream);
    if (e != hipSuccess) fprintf(stderr, "cooperative launch failed: %s (grid %d)\n", hipGetErrorString(e), grid_blocks);
}
```

```cpp
#include <hip/hip_runtime.h>
#include <hip/hip_cooperative_groups.h>
#include <cstdint>
#include <cstdio>
#include <cmath>
namespace cg = cooperative_groups;

#define DEVI __device__ __forceinline__
#ifndef PROBE_TWICE
#define PROBE_TWICE 0
#endif
#define REPS(k) ((PROBE_TWICE == (k)) ? 2 : 1)
typedef unsigned short bf16_t;
typedef short bf16x8 __attribute__((ext_vector_type(8)));
typedef short s16x4 __attribute__((ext_vector_type(4)));
typedef float f32x4 __attribute__((ext_vector_type(4)));
typedef float f32x2 __attribute__((ext_vector_type(2)));
typedef unsigned u32x4 __attribute__((ext_vector_type(4)));
typedef unsigned u32x2 __attribute__((ext_vector_type(2)));
#define LAS __attribute__((address_space(3)))

constexpr int NB = 8, SL = 4096, DM = 1024, NTOK = NB * SL;
constexpr int INW = 4288;
constexpr int NTHREADS = 256;
constexpr int LDS_BYTES = 81920;
constexpr float RMS_EPS = 1e-6f;
constexpr float LOG2E = 1.4426950408889634f;

constexpr int WIN_ROWS = 4352;
constexpr int G1_COLS = 4352;

constexpr size_t al256(size_t x) { return (x + 255) & ~(size_t)255; }
constexpr size_t OFF_CTL   = 0;
constexpr size_t OFF_BAR   = 4096;
constexpr size_t OFF_WIN_T = 32768;
constexpr size_t OFF_WBRA  = OFF_WIN_T + (size_t)WIN_ROWS * 1024 * 2;
constexpr size_t OFF_WBRB  = OFF_WBRA + (size_t)1024 * 512 * 2;
constexpr size_t OFF_WOUT  = OFF_WBRB + (size_t)1024 * 512 * 2;
constexpr size_t OFF_W1K   = OFF_WOUT + (size_t)1024 * 1024 * 2;
constexpr size_t OFF_W1V   = OFF_W1K + (size_t)128 * 2048 * 2;
constexpr size_t OFF_W2K   = OFF_W1V + (size_t)128 * 2048 * 2;
constexpr size_t OFF_W2V   = OFF_W2K + (size_t)64 * 128 * 2;
constexpr size_t OFF_WGU   = OFF_W2V + (size_t)64 * 128 * 2;
constexpr size_t OFF_WDN   = OFF_WGU + (size_t)32 * 512 * 1024 * 2;
constexpr size_t OFF_BIAS1 = OFF_WDN + (size_t)32 * 1024 * 256 * 2;
constexpr size_t OFF_WR    = OFF_BIAS1 + 1024;
constexpr size_t OFF_CS    = OFF_WR + (size_t)48 * 1024 * 4;
constexpr size_t OFF_HN    = OFF_CS + (size_t)NTOK * 32 * 8;
constexpr size_t OFF_QA    = OFF_HN + (size_t)NTOK * 1024 * 2;
constexpr size_t OFF_KA    = OFF_QA + (size_t)NTOK * 512 * 2;
constexpr size_t OFF_VA    = OFF_KA + (size_t)NTOK * 64 * 2;
constexpr size_t OFF_QI    = OFF_VA + (size_t)NTOK * 64 * 2;
constexpr size_t OFF_KI    = OFF_QI + (size_t)NTOK * 256 * 2;
constexpr size_t OFF_WI    = OFF_KI + (size_t)NTOK * 32 * 2;
constexpr size_t OFF_QBN   = OFF_WI + (size_t)NTOK * 8 * 4;
constexpr size_t OFF_QBR   = OFF_QBN + (size_t)NTOK * 512 * 2;
constexpr size_t KV_STRIDE = (size_t)NTOK * 128 * 2 + 65536 * 4;
constexpr size_t OFF_KV    = OFF_QBR + (size_t)NTOK * 512 * 2;
constexpr size_t OFF_GATES = OFF_KV + 6 * KV_STRIDE;
constexpr size_t OFF_QKV_END = OFF_GATES + (size_t)NTOK * 24 * 4;
constexpr size_t OFF_KC    = al256(OFF_QKV_END);
constexpr size_t OFF_VCT   = OFF_KC + (size_t)16 * 256 * 64 * 2;
constexpr size_t OFF_SEL   = OFF_VCT + (size_t)16 * 256 * 64 * 2;
constexpr size_t OFF_OA    = OFF_HN;
constexpr size_t OFF_OB    = OFF_OA + (size_t)NTOK * 512 * 2;
constexpr size_t OFF_GA    = OFF_SEL + (size_t)NTOK * 256 * 2;
constexpr size_t OFF_GB    = OFF_GA + (size_t)NTOK * 1024 * 2;
constexpr size_t OFF_MASK  = OFF_GB + (size_t)NTOK * 1024 * 2;
constexpr size_t OFF_LIST  = OFF_MASK + (size_t)16 * 4096 * 8;
constexpr size_t OFF_WT    = OFF_LIST + (size_t)32 * NTOK * 4;
constexpr size_t OFF_RS    = OFF_WT + (size_t)NTOK * 2 * 4;
constexpr size_t WS_END    = OFF_RS + (size_t)NTOK * 4;
constexpr size_t OFF_MERGED = OFF_QA;
constexpr size_t OFF_ACT    = OFF_QA;
constexpr size_t OFF_Y      = OFF_QA + (size_t)40 * 1024 * 1024;
static_assert(OFF_Y + (size_t)2 * NTOK * 1024 * 2 <= OFF_QKV_END, "Y overlay");
static_assert((size_t)544 * 128 * 256 * 2 <= (size_t)40 * 1024 * 1024, "ACT overlay");

struct Params {
    const float* in[21];
    const int* pos;
    float* out;
    unsigned char* ws;
    double inv_freq[32];
    int ph_lo, ph_hi;
};

DEVI unsigned f2bf(float f) { unsigned u = __float_as_uint(f); return (u + 0x7fffu + ((u >> 16) & 1u)) >> 16; }
typedef __bf16 bf16v2_t __attribute__((ext_vector_type(2)));
DEVI unsigned pk2(float lo, float hi) { const f32x2 v = {lo, hi}; return __builtin_bit_cast(unsigned, __builtin_convertvector(v, bf16v2_t)); }
DEVI float rows_max(float x) {
    float a = x, b = x;
    asm volatile("v_nop\n\tv_nop\n\tv_permlane16_swap_b32 %0, %1" : "+v"(a), "+v"(b));
    x = fmaxf(a, b); a = x; b = x;
    asm volatile("v_nop\n\tv_nop\n\tv_permlane32_swap_b32 %0, %1" : "+v"(a), "+v"(b));
    return fmaxf(a, b);
}
DEVI float rows_sum(float x) {
    float a = x, b = x;
    asm volatile("v_nop\n\tv_nop\n\tv_permlane16_swap_b32 %0, %1" : "+v"(a), "+v"(b));
    x = a + b; a = x; b = x;
    asm volatile("v_nop\n\tv_nop\n\tv_permlane32_swap_b32 %0, %1" : "+v"(a), "+v"(b));
    return a + b;
}
DEVI float bf2f(unsigned h) { return __uint_as_float(h << 16); }
DEVI float sigmoidf_(float x) { return __builtin_amdgcn_rcpf(1.0f + __builtin_amdgcn_exp2f(-x * 1.4426950408889634f)); }
DEVI float wave_sum(float v) {
#pragma unroll
    for (int o = 32; o > 0; o >>= 1) v += __shfl_xor(v, o);
    return v;
}
DEVI int wave_sum_i32(int v) {
    v += __builtin_amdgcn_update_dpp(0, v, 0xB1, 0xF, 0xF, true);
    v += __builtin_amdgcn_update_dpp(0, v, 0x4E, 0xF, 0xF, true);
    v += __builtin_amdgcn_update_dpp(0, v, 0x141, 0xF, 0xF, true);
    v += __builtin_amdgcn_update_dpp(0, v, 0x140, 0xF, 0xF, true);
    return __builtin_amdgcn_readlane(v, 0) + __builtin_amdgcn_readlane(v, 16) + __builtin_amdgcn_readlane(v, 32) + __builtin_amdgcn_readlane(v, 48);
}
DEVI float wave_sum_f32_dpp(float v) {
    v += __builtin_bit_cast(float, __builtin_amdgcn_update_dpp(0, __builtin_bit_cast(int, v), 0xB1, 0xF, 0xF, true));
    v += __builtin_bit_cast(float, __builtin_amdgcn_update_dpp(0, __builtin_bit_cast(int, v), 0x4E, 0xF, 0xF, true));
    v += __builtin_bit_cast(float, __builtin_amdgcn_update_dpp(0, __builtin_bit_cast(int, v), 0x141, 0xF, 0xF, true));
    v += __builtin_bit_cast(float, __builtin_amdgcn_update_dpp(0, __builtin_bit_cast(int, v), 0x140, 0xF, 0xF, true));
    const int iv = __builtin_bit_cast(int, v);
    return (__builtin_bit_cast(float, __builtin_amdgcn_readlane(iv, 0)) + __builtin_bit_cast(float, __builtin_amdgcn_readlane(iv, 16))) +
           (__builtin_bit_cast(float, __builtin_amdgcn_readlane(iv, 32)) + __builtin_bit_cast(float, __builtin_amdgcn_readlane(iv, 48)));
}
DEVI bf16x8 pack8(const f32x4& a, const f32x4& b) {
    u32x4 w; w.x = pk2(a[0], a[1]); w.y = pk2(a[2], a[3]); w.z = pk2(b[0], b[1]); w.w = pk2(b[2], b[3]);
    return __builtin_bit_cast(bf16x8, w);
}
#define MFMA16(a, b, c) __builtin_amdgcn_mfma_f32_16x16x32_bf16((a), (b), (c), 0, 0, 0)


#define XB_TMO      128
#define XB_XCNT(j)  (256  + 64 * (j))
#define XB_XSUB(j)  (1280 + 64 * (j))
#define XB_XGEN(j)  (2304 + 64 * (j))
#define XB_TOP      3328
#define XB_TOPGEN   3392
#define XCD_BAR_WORDS 3456
#define XB_SPIN_CAP (1u << 22)
DEVI unsigned xb_ld(unsigned* p)              { return __hip_atomic_load(p, __ATOMIC_RELAXED, __HIP_MEMORY_SCOPE_AGENT); }
DEVI unsigned xb_add(unsigned* p, unsigned v) { return __hip_atomic_fetch_add(p, v, __ATOMIC_RELAXED, __HIP_MEMORY_SCOPE_AGENT); }
DEVI unsigned xb_xcc_id() { return (unsigned)__builtin_amdgcn_s_getreg((3 << 11) | 20) & 0xFu; }
#define XB_SPIN(cond, bar) do { unsigned _sp = 0; while (cond) { __builtin_amdgcn_s_sleep(1); \
    if ((++_sp & 255u) == 0u) { if (xb_ld(&(bar)[XB_TMO])) break; if (_sp > XB_SPIN_CAP) { atomicAdd(&(bar)[XB_TMO], 1u); break; } } } } while (0)
struct XcdBarrier { unsigned* bar; unsigned x; volatile LAS unsigned* st; };
DEVI XcdBarrier xcd_barrier_post(unsigned* bar, volatile LAS unsigned* st) {
    XcdBarrier b; b.bar = bar; b.x = xb_xcc_id(); b.st = st;
    if (threadIdx.x == 0) (void)xb_add(&bar[XB_XCNT(b.x)], 1u);
    return b;
}
DEVI void xcd_barrier_complete(unsigned* bar, unsigned x, unsigned& nloc, unsigned& nx) {
    const unsigned G = gridDim.x * gridDim.y * gridDim.z;
    unsigned sum, cnt, mine, sp = 0u;
    for (;;) {
        sum = 0u; cnt = 0u; mine = 0u;
#pragma unroll
        for (unsigned j = 0; j < 16; ++j) { const unsigned c = xb_ld(&bar[XB_XCNT(j)]); sum += c; cnt += (c > 0u) ? 1u : 0u; mine = (j == x) ? c : mine; }
        if (sum == G) break;
        __builtin_amdgcn_s_sleep(1);
        if ((++sp & 255u) == 0u) { if (xb_ld(&bar[XB_TMO])) break; if (sp > XB_SPIN_CAP) { atomicAdd(&bar[XB_TMO], 1u); break; } }
    }
    nloc = mine > 0u ? mine : 1u; nx = cnt > 0u ? cnt : 1u;
}
DEVI void xcd_barrier(const XcdBarrier& b) {
    asm volatile("s_waitcnt vmcnt(0)" ::: "memory");
    __syncthreads();
    if (threadIdx.x == 0) {
        unsigned* bar = b.bar;
        __builtin_amdgcn_s_waitcnt(0);
        unsigned nloc = b.st[0], nx = b.st[1];
        if (nloc == 0u) { xcd_barrier_complete(bar, b.x, nloc, nx); b.st[0] = nloc; b.st[1] = nx; }
        const unsigned old = xb_add(&bar[XB_XSUB(b.x)], 1u);
        const unsigned gen = old / nloc;
        if (old + 1u == (gen + 1u) * nloc) {
            __builtin_amdgcn_fence(__ATOMIC_RELEASE, "agent");
            asm volatile("s_waitcnt vmcnt(0)" ::: "memory");
            const unsigned og = xb_add(&bar[XB_TOP], 1u);
            const unsigned tg = og / nx;
            if (og + 1u == (tg + 1u) * nx) xb_add(&bar[XB_TOPGEN], 1u);
            else XB_SPIN(xb_ld(&bar[XB_TOPGEN]) == tg, bar);
            __builtin_amdgcn_fence(__ATOMIC_ACQUIRE, "agent");
            xb_add(&bar[XB_XGEN(b.x)], 1u);
            asm volatile("s_waitcnt vmcnt(0)" ::: "memory");
        } else {
            XB_SPIN(xb_ld(&bar[XB_XGEN(b.x)]) == gen, bar);
            __builtin_amdgcn_fence(__ATOMIC_ACQUIRE, "agent");
            asm volatile("s_waitcnt vmcnt(0)" ::: "memory");
        }
    }
    __syncthreads();
}

typedef __amdgpu_buffer_rsrc_t rsrc_t;
DEVI u32x4 bload16(rsrc_t r, unsigned voff, unsigned soff) { return __builtin_bit_cast(u32x4, __builtin_amdgcn_raw_buffer_load_b128(r, (int)voff, (int)soff, 0)); }
DEVI void glds16(rsrc_t r, unsigned char* lds_dst_uniform, unsigned voff, unsigned soff) {
    __builtin_amdgcn_raw_ptr_buffer_load_lds(r, (LAS void*)lds_dst_uniform, 16, (int)voff, (int)soff, 0, 0);
}
template <class FA, class FB>
DEVI void gemm128(f32x4 (&acc)[4][4], rsrc_t rs, unsigned sA, const FA& offA, unsigned sB, const FB& offB, int nk, unsigned char* lds, int tid) {
    const int lane = tid & 63, wid = __builtin_amdgcn_readfirstlane(tid >> 6), wr = wid >> 1, wc = wid & 1;
    const int lr = tid >> 3;
    const unsigned csrc = (unsigned)(((lane & 7) ^ ((lane >> 3) & 7)) << 4);
    unsigned oa[4], ob[4];
#pragma unroll
    for (int i = 0; i < 4; ++i) { oa[i] = offA(lr + 32 * i) + csrc; ob[i] = offB(lr + 32 * i) + csrc; }
#pragma unroll
    for (int m = 0; m < 4; ++m)
#pragma unroll
        for (int n = 0; n < 4; ++n) acc[m][n] = (f32x4){0.f, 0.f, 0.f, 0.f};
    const int q = lane >> 4, r16 = lane & 15;
    const int roffA0 = (wr * 64 + r16) * 128 + (((0 + q) ^ (lane & 7)) << 4);
    const int roffA1 = (wr * 64 + r16) * 128 + (((4 + q) ^ (lane & 7)) << 4);
    const int roffB0 = 16384 + (wc * 64 + r16) * 128 + (((0 + q) ^ (lane & 7)) << 4);
    const int roffB1 = 16384 + (wc * 64 + r16) * 128 + (((4 + q) ^ (lane & 7)) << 4);
    unsigned char* wbase = lds + wid * 1024;
#pragma unroll
    for (int i = 0; i < 4; ++i) { glds16(rs, wbase + i * 4096, oa[i], sA); glds16(rs, wbase + 16384 + i * 4096, ob[i], sB); }
    for (int kt = 0; kt < nk; ++kt) {
        unsigned char* cur = lds + (kt & 1) * 32768;
        __syncthreads();
        if (kt + 1 < nk) {
            unsigned char* nb = wbase + ((kt + 1) & 1) * 32768;
#pragma unroll
            for (int i = 0; i < 4; ++i) { glds16(rs, nb + i * 4096, oa[i], sA + (kt + 1) * 128); glds16(rs, nb + 16384 + i * 4096, ob[i], sB + (kt + 1) * 128); }
        }
        bf16x8 a0[4], b0[4], a1[4], b1[4];
#pragma unroll
        for (int m = 0; m < 4; ++m) a0[m] = *(const bf16x8*)(cur + roffA0 + m * 2048);
#pragma unroll
        for (int n = 0; n < 4; ++n) b0[n] = *(const bf16x8*)(cur + roffB0 + n * 2048);
#pragma unroll
        for (int m = 0; m < 4; ++m) a1[m] = *(const bf16x8*)(cur + roffA1 + m * 2048);
#pragma unroll
        for (int n = 0; n < 4; ++n) b1[n] = *(const bf16x8*)(cur + roffB1 + n * 2048);
#pragma unroll
        for (int m = 0; m < 4; ++m)
#pragma unroll
            for (int n = 0; n < 4; ++n) acc[m][n] = MFMA16(b0[n], a0[m], acc[m][n]);
#pragma unroll
        for (int m = 0; m < 4; ++m)
#pragma unroll
            for (int n = 0; n < 4; ++n) acc[m][n] = MFMA16(b1[n], a1[m], acc[m][n]);
    }
    __syncthreads();
}

DEVI int swzF(int row) { return (0x78 >> (((row >> 2) & 3) * 2)) & 3; }
DEVI void gemm256(f32x4 (&acc)[8][4], rsrc_t rs, unsigned sA, unsigned ldaB, unsigned sB, unsigned ldbB, int nk32, unsigned char* lds, int tid) {
    const int lane = tid & 63, wid = __builtin_amdgcn_readfirstlane(tid >> 6), wr = wid >> 1, wc = wid & 1;
    const int q = lane >> 4, r16 = lane & 15;
    unsigned oa[4], ob[2];
#pragma unroll
    for (int i = 0; i < 4; ++i) { const int row = (wid * 4 + i) * 16 + (lane >> 2); oa[i] = (unsigned)row * ldaB + (unsigned)(((lane & 3) ^ swzF(row)) << 4); }
#pragma unroll
    for (int i = 0; i < 2; ++i) { const int row = (wid * 2 + i) * 16 + (lane >> 2); ob[i] = (unsigned)row * ldbB + (unsigned)(((lane & 3) ^ swzF(row)) << 4); }
#pragma unroll
    for (int m = 0; m < 8; ++m)
#pragma unroll
        for (int n = 0; n < 4; ++n) acc[m][n] = (f32x4){0.f, 0.f, 0.f, 0.f};
    const int roffA = (wr * 128 + r16) * 64 + ((q ^ swzF(r16)) << 4);
    const int roffB = 16384 + (wc * 64 + r16) * 64 + ((q ^ swzF(r16)) << 4);
    unsigned char* wA = lds + wid * 4096;
    unsigned char* wB = lds + 16384 + wid * 2048;
#pragma unroll
    for (int i = 0; i < 4; ++i) glds16(rs, wA + i * 1024, oa[i], sA);
#pragma unroll
    for (int i = 0; i < 2; ++i) glds16(rs, wB + i * 1024, ob[i], sB);
    for (int kt = 0; kt < nk32; ++kt) {
        const unsigned char* cur = lds + (kt & 1) * 24576;
        __syncthreads();
        if (kt + 1 < nk32) {
            const int so = ((kt + 1) & 1) * 24576;
#pragma unroll
            for (int i = 0; i < 4; ++i) glds16(rs, wA + so + i * 1024, oa[i], sA + (kt + 1) * 64);
#pragma unroll
            for (int i = 0; i < 2; ++i) glds16(rs, wB + so + i * 1024, ob[i], sB + (kt + 1) * 64);
        }
        bf16x8 a[8], b[4];
#pragma unroll
        for (int n = 0; n < 4; ++n) b[n] = *(const bf16x8*)(cur + roffB + n * 1024);
#pragma unroll
        for (int m = 0; m < 8; ++m) a[m] = *(const bf16x8*)(cur + roffA + m * 1024);
#pragma unroll
        for (int m = 0; m < 8; ++m)
#pragma unroll
            for (int n = 0; n < 4; ++n) acc[m][n] = MFMA16(b[n], a[m], acc[m][n]);
    }
    __syncthreads();
}

DEVI bool tile_map(int k, int ncol, int& mt, int& nt, int nrow = 256) {
    if (gridDim.x == 512) {
        const int x = blockIdx.x & 7, j = blockIdx.x >> 3;
        const int v = j + 64 * k;
        if (v >= (nrow >> 3) * ncol) return false;
        const int nfull = ncol >> 3, rem = ncol & 7;
        int mtl;
        const int pcg = nrow;
        if (v < nfull * pcg) { const int cg = v / pcg, w = v % pcg; mtl = (w >> 6) * 8 + ((w & 63) >> 3); nt = cg * 8 + (w & 7); }
        else { const int v2 = v - nfull * pcg, per = 8 * rem; const int rg = v2 / per, w = v2 % per; mtl = rg * 8 + w / rem; nt = nfull * 8 + w % rem; }
        mt = x * (nrow >> 3) + mtl;
        return true;
    }
    const int u = blockIdx.x + gridDim.x * k;
    if (u >= nrow * ncol) return false;
    mt = u / ncol; nt = u % ncol;
    return true;
}
struct RowLin { unsigned ldb; DEVI unsigned operator()(int r) const { return (unsigned)r * ldb; } };

DEVI int win_map(int j) {
    if (j < 896) return j;
    if (j < 1408) return j - 896 + 936;
    if (j < 2176) return j - 1408 + 1448;
    if (j < 2208) return j - 2176 + 896;
    if (j < 2216) return j - 2208 + 928;
    if (j < 2240) return j;
    if (j < 2304) return -1;
    return j - 64;
}

struct TJob { const float* src; bf16_t* dst; int K, ld, nrows, perm, nb; size_t sb, db; };
DEVI TJob get_tjob(const Params& P, int j) {
    unsigned char* ws = P.ws;
    switch (j) {
        case 0: return TJob{P.in[3], (bf16_t*)(ws + OFF_WIN_T), 1024, INW, WIN_ROWS, 1, 1, 0, 0};
        case 1: return TJob{P.in[10], (bf16_t*)(ws + OFF_WBRA), 512, 1024, 1024, 0, 1, 0, 0};
        case 2: return TJob{P.in[11], (bf16_t*)(ws + OFF_WBRB), 512, 1024, 1024, 0, 1, 0, 0};
        case 3: return TJob{P.in[12], (bf16_t*)(ws + OFF_WOUT), 1024, 1024, 1024, 0, 1, 0, 0};
        case 4: return TJob{P.in[5], (bf16_t*)(ws + OFF_W1K), 2048, 128, 128, 0, 1, 0, 0};
        case 5: return TJob{P.in[8], (bf16_t*)(ws + OFF_W1V), 2048, 128, 128, 0, 1, 0, 0};
        case 6: return TJob{P.in[6], (bf16_t*)(ws + OFF_W2K), 128, 64, 64, 0, 1, 0, 0};
        case 7: return TJob{P.in[9], (bf16_t*)(ws + OFF_W2V), 128, 64, 64, 0, 1, 0, 0};
        case 8: return TJob{P.in[18], (bf16_t*)(ws + OFF_WGU), 1024, 512, 512, 0, 32, (size_t)1024 * 512, (size_t)512 * 1024};
        default: return TJob{P.in[19], (bf16_t*)(ws + OFF_WDN), 256, 1024, 1024, 0, 32, (size_t)256 * 1024, (size_t)1024 * 256};
    }
}
DEVI int tjob_tiles(int j) {
    switch (j) {
        case 0: return (WIN_ROWS / 64) * 16;
        case 1: case 2: return 16 * 8;
        case 3: return 16 * 16;
        case 4: case 5: return 2 * 32;
        case 6: case 7: return 1 * 2;
        case 8: return 32 * 8 * 16;
        default: return 32 * 16 * 4;
    }
}

DEVI void transpose_tile(const TJob& J, int tile, unsigned char* lds, int tid) {
    float* T = (float*)lds;
    const int kt = J.K / 64, rt = J.nrows / 64;
    const int b = tile / (kt * rt), rem = tile % (kt * rt);
    const int r0 = (rem / kt) * 64, k0 = (rem % kt) * 64;
    const float* src = J.src + (size_t)b * J.sb;
    bf16_t* dst = J.dst + (size_t)b * J.db;
    const int n4 = (tid & 15) * 4;
    int col = r0 + n4; if (J.perm) col = win_map(col);
    f32x4 ld4[4];
#pragma unroll
    for (int i = 0; i < 4; ++i) {
        const int kk = (tid >> 4) + 16 * i;
        ld4[i] = (col >= 0) ? *(const f32x4*)(src + (size_t)(k0 + kk) * J.ld + col) : (f32x4){0.f, 0.f, 0.f, 0.f};
    }
#pragma unroll
    for (int i = 0; i < 4; ++i) {
        const int kk = (tid >> 4) + 16 * i;
#pragma unroll
        for (int e = 0; e < 4; ++e) T[kk * 65 + n4 + e] = ld4[i][e];
    }
    __syncthreads();
    const int r2 = tid >> 2, ks = (tid & 3) * 16;
    u32x4 w0, w1;
    w0.x = pk2(T[(ks + 0) * 65 + r2], T[(ks + 1) * 65 + r2]); w0.y = pk2(T[(ks + 2) * 65 + r2], T[(ks + 3) * 65 + r2]);
    w0.z = pk2(T[(ks + 4) * 65 + r2], T[(ks + 5) * 65 + r2]); w0.w = pk2(T[(ks + 6) * 65 + r2], T[(ks + 7) * 65 + r2]);
    w1.x = pk2(T[(ks + 8) * 65 + r2], T[(ks + 9) * 65 + r2]); w1.y = pk2(T[(ks + 10) * 65 + r2], T[(ks + 11) * 65 + r2]);
    w1.z = pk2(T[(ks + 12) * 65 + r2], T[(ks + 13) * 65 + r2]); w1.w = pk2(T[(ks + 14) * 65 + r2], T[(ks + 15) * 65 + r2]);
    bf16_t* d = dst + (size_t)(r0 + r2) * J.K + k0 + ks;
    *(u32x4*)d = w0; *(u32x4*)(d + 8) = w1;
    __syncthreads();
}

DEVI void rms_row_bf16(const float* xr, const float* g, bf16_t* o, int lane) {
    f32x4 v[4]; float ss = 0.f;
#pragma unroll
    for (int i = 0; i < 4; ++i) { v[i] = *(const f32x4*)(xr + i * 256 + lane * 4); ss += v[i][0] * v[i][0] + v[i][1] * v[i][1] + v[i][2] * v[i][2] + v[i][3] * v[i][3]; }
    ss = wave_sum(ss);
    const float rs = rsqrtf(ss * (1.0f / 1024.0f) + RMS_EPS);
#pragma unroll
    for (int i = 0; i < 4; ++i) {
        const f32x4 gg = *(const f32x4*)(g + i * 256 + lane * 4);
        u32x2 w; w.x = pk2(v[i][0] * rs * gg[0], v[i][1] * rs * gg[1]); w.y = pk2(v[i][2] * rs * gg[2], v[i][3] * rs * gg[3]);
        *(u32x2*)(o + i * 256 + lane * 4) = w;
    }
}

DEVI void phase_prep(const Params& P, unsigned char* lds, int tid, int part) {
    unsigned char* ws = P.ws;
    const int lane = tid & 63, wid = __builtin_amdgcn_readfirstlane(tid >> 6);
    int base = 0;
#pragma unroll
    for (int j = 0; j < 10; ++j) {
        const bool early = (j == 0) || (j >= 4 && j <= 7);
        if (early == (part == 0)) {
            const int nt = tjob_tiles(j);
            const TJob J = get_tjob(P, j);
            for (int t = blockIdx.x; t < nt; t += gridDim.x) transpose_tile(J, t, lds, tid);
        }
    }
    (void)base;
    if (part == 1) {
        float* wr = (float*)(ws + OFF_WR);
        const float* g = P.in[13]; const float* wg = P.in[14]; const float* we = P.in[16];
        for (int e = blockIdx.x * NTHREADS + tid; e < 48 * 1024; e += gridDim.x * NTHREADS) {
            const int c = e >> 10, k = e & 1023;
            float v = 0.f;
            if (c < 4) v = wg[k * 4 + c]; else if (c < 36) v = we[k * 32 + (c - 4)];
            wr[e] = v * g[k];
        }
        return;
    }
    {
        const float* x = P.in[0]; const float* g = P.in[2]; bf16_t* hn = (bf16_t*)(ws + OFF_HN);
        for (int r = blockIdx.x * 4 + wid; r < NTOK; r += gridDim.x * 4) rms_row_bf16(x + (size_t)r * 1024, g, hn + (size_t)r * 1024, lane);
    }
    {
        f32x2* cs = (f32x2*)(ws + OFF_CS);
        for (int e = blockIdx.x * NTHREADS + tid; e < NTOK * 32; e += gridDim.x * NTHREADS) {
            const int tok = e >> 5, i = e & 31;
            const double a = (double)P.pos[tok] * P.inv_freq[i];
            double t = a * 0.15915494309189535;
            t -= floor(t);
            const float tf = (float)t;
            cs[e] = (f32x2){__builtin_amdgcn_cosf(tf), __builtin_amdgcn_sinf(tf)};
        }
    }
    {
        float* red = (float*)lds;
        for (int job = blockIdx.x; job < 32; job += gridDim.x) {
            const int kv = job >> 4, cg8 = job & 15;
            const float* pe = P.in[kv ? 7 : 4]; const float* w1 = P.in[kv ? 8 : 5];
            const int cc = tid & 7, jj = tid >> 3;
            float s = 0.f;
            for (int j = jj; j < 2048; j += 32) s += pe[j] * w1[(size_t)j * 128 + cg8 * 8 + cc];
            red[tid] = s;
            __syncthreads();
            if (tid < 8) { float t = 0.f; for (int u = 0; u < 32; ++u) t += red[u * 8 + tid]; ((float*)(ws + OFF_BIAS1))[kv * 128 + cg8 * 8 + tid] = t; }
            __syncthreads();
        }
    }
}

DEVI void st_bf16(bf16_t* p, float v) { *p = (bf16_t)f2bf(v); }

DEVI int gemm1_col_tile(int part, int i) {
    if (part == 0) return (i < 3) ? 4 + i : ((i < 5) ? 8 + i : 17);
    return (i < 4) ? i : ((i < 8) ? i + 3 : ((i < 12) ? i + 5 : i + 6));
}
template <int MR>
DEVI void gemm1_epilogue(const Params& P, const f32x4 (&acc)[MR][4], int c64, int tok0, int q, int cl) {
    unsigned char* ws = P.ws;
    const f32x2* cs = (const f32x2*)(ws + OFF_CS);
    if (c64 < 10 || (c64 >= 14 && c64 < 34)) {
        bool do_rope; float scale = 1.f; int kind;
        int g = 0, hk = 0;
        if (c64 < 8) { kind = 0; do_rope = true; scale = 0.125f * LOG2E; }
        else if (c64 == 8) { kind = 1; do_rope = true; }
        else if (c64 == 9) { kind = 2; do_rope = false; }
        else if (c64 < 22) { kind = 3; do_rope = true; scale = 0.125f * LOG2E; }
        else { kind = 4; g = (c64 - 22) >> 1; hk = (c64 - 22) & 1; do_rope = (g == 2 || g == 4); }
#pragma unroll
        for (int m = 0; m < MR; ++m) {
            const int tok = tok0 + m * 16;
            f32x4 o[4], nr[4];
#pragma unroll
            for (int n = 0; n < 4; ++n) { nr[n] = acc[m][n] * scale; o[n] = nr[n]; }
            if (do_rope) {
#pragma unroll
                for (int n = 0; n < 2; ++n) {
                    const f32x4 c01 = *(const f32x4*)(cs + (size_t)tok * 32 + n * 16 + q * 4);
                    const f32x4 c23 = *(const f32x4*)(cs + (size_t)tok * 32 + n * 16 + q * 4 + 2);
                    const float cc[4] = {c01[0], c01[2], c23[0], c23[2]}, sn[4] = {c01[1], c01[3], c23[1], c23[3]};
#pragma unroll
                    for (int j = 0; j < 4; ++j) {
                        const float x1 = nr[n][j], x2 = nr[n + 2][j];
                        o[n][j] = x1 * cc[j] - x2 * sn[j]; o[n + 2][j] = x1 * sn[j] + x2 * cc[j];
                    }
                }
            }
            if (kind == 0 || kind == 1 || kind == 2) {
                bf16_t* d = (kind == 0) ? (bf16_t*)(ws + OFF_QA) + (size_t)tok * 512 + c64 * 64 : (bf16_t*)(ws + (kind == 1 ? OFF_KA : OFF_VA)) + (size_t)tok * 64;
#pragma unroll
                for (int n = 0; n < 4; ++n) { u32x2 w; w.x = pk2(o[n][0], o[n][1]); w.y = pk2(o[n][2], o[n][3]); *(u32x2*)(d + n * 16 + q * 4) = w; }
            } else if (kind == 3) {
                const int h = c64 - 14;
                bf16_t* dn = (bf16_t*)(ws + OFF_QBN) + (size_t)tok * 512 + h * 64; bf16_t* dr = (bf16_t*)(ws + OFF_QBR) + (size_t)tok * 512 + h * 64;
#pragma unroll
                for (int n = 0; n < 4; ++n) {
                    u32x2 w; w.x = pk2(nr[n][0], nr[n][1]); w.y = pk2(nr[n][2], nr[n][3]); *(u32x2*)(dn + n * 16 + q * 4) = w;
                    u32x2 v; v.x = pk2(o[n][0], o[n][1]); v.y = pk2(o[n][2], o[n][3]); *(u32x2*)(dr + n * 16 + q * 4) = v;
                }
            } else {
                bf16_t* d = (bf16_t*)(ws + OFF_KV + (size_t)g * KV_STRIDE);
                const int b = tok >> 12, tl = tok & 4095;
                if (g == 3 || g == 5) {
#pragma unroll
                    for (int n = 0; n < 4; ++n)
#pragma unroll
                        for (int j = 0; j < 4; ++j) st_bf16(d + ((size_t)((b * 2 + hk) * 64 + n * 16 + q * 4 + j)) * 4096 + tl, o[n][j]);
                } else {
#pragma unroll
                    for (int n = 0; n < 4; ++n) { u32x2 w; w.x = pk2(o[n][0], o[n][1]); w.y = pk2(o[n][2], o[n][3]);
                        *(u32x2*)(d + ((size_t)((b * 2 + hk) * 4096 + tl)) * 64 + n * 16 + q * 4) = w; }
                }
            }
        }
    } else if (c64 >= 10 && c64 < 14) {
        bf16_t* d = (bf16_t*)(ws + OFF_QI);
#pragma unroll
        for (int m = 0; m < MR; ++m) {
            const int tok = tok0 + m * 16;
            float cc[4], sn[4];
#pragma unroll
            for (int j = 0; j < 4; ++j) { const f32x2 c = cs[(size_t)tok * 32 + 2 * (4 * q + j)]; cc[j] = c.x; sn[j] = c.y; }
#pragma unroll
            for (int hh = 0; hh < 2; ++hh) {
                const int head = 2 * (c64 - 10) + hh;
                f32x4 r1, r2;
#pragma unroll
                for (int j = 0; j < 4; ++j) { const float x1 = acc[m][2 * hh][j], x2 = acc[m][2 * hh + 1][j]; r1[j] = x1 * cc[j] - x2 * sn[j]; r2[j] = x1 * sn[j] + x2 * cc[j]; }
                u32x2 w; w.x = pk2(r1[0], r1[1]); w.y = pk2(r1[2], r1[3]); *(u32x2*)(d + (size_t)tok * 256 + head * 32 + q * 4) = w;
                u32x2 v; v.x = pk2(r2[0], r2[1]); v.y = pk2(r2[2], r2[3]); *(u32x2*)(d + (size_t)tok * 256 + head * 32 + 16 + q * 4) = v;
            }
        }
    } else if (c64 >= 36) {
        bf16_t* d = (bf16_t*)(ws + (c64 < 52 ? OFF_GA : OFF_GB));
        const int cb = (c64 < 52 ? c64 - 36 : c64 - 52) * 64;
#pragma unroll
        for (int m = 0; m < MR; ++m)
#pragma unroll
            for (int n = 0; n < 4; ++n) {
                u32x2 w; w.x = pk2(sigmoidf_(acc[m][n][0]), sigmoidf_(acc[m][n][1])); w.y = pk2(sigmoidf_(acc[m][n][2]), sigmoidf_(acc[m][n][3]));
                *(u32x2*)(d + (size_t)(tok0 + m * 16) * 1024 + cb + n * 16 + q * 4) = w;
            }
    } else if (c64 == 34) {
        bf16_t* dki = (bf16_t*)(ws + OFF_KI); float* dwi = (float*)(ws + OFF_WI); float* dg = (float*)(ws + OFF_GATES);
#pragma unroll
        for (int m = 0; m < MR; ++m) {
            const int tok = tok0 + m * 16;
            f32x4 r1, r2;
#pragma unroll
            for (int j = 0; j < 4; ++j) {
                const f32x2 c = cs[(size_t)tok * 32 + 2 * (4 * q + j)];
                const float x1 = acc[m][0][j], x2 = acc[m][1][j];
                r1[j] = x1 * c.x - x2 * c.y; r2[j] = x1 * c.y + x2 * c.x;
            }
            u32x2 w; w.x = pk2(r1[0], r1[1]); w.y = pk2(r1[2], r1[3]); *(u32x2*)(dki + (size_t)tok * 32 + q * 4) = w;
            u32x2 v; v.x = pk2(r2[0], r2[1]); v.y = pk2(r2[2], r2[3]); *(u32x2*)(dki + (size_t)tok * 32 + 16 + q * 4) = v;
            if (q < 2) *(f32x4*)(dwi + (size_t)tok * 8 + q * 4) = acc[m][2];
            else { f32x4 sv; for (int j = 0; j < 4; ++j) sv[j] = sigmoidf_(acc[m][2][j]); *(f32x4*)(dg + (size_t)tok * 24 + (q * 4 - 8)) = sv; }
            { f32x4 sv; for (int j = 0; j < 4; ++j) sv[j] = sigmoidf_(acc[m][3][j]); *(f32x4*)(dg + (size_t)tok * 24 + 8 + q * 4) = sv; }
        }
    }
}

DEVI void phase_gemm1(const Params& P, unsigned char* lds, int tid, int part) {
    const rsrc_t rs = __builtin_amdgcn_make_buffer_rsrc((void*)P.ws, (short)0, (int)0x7fffffff, 0x00020000);
    const int lane = tid & 63, wid = __builtin_amdgcn_readfirstlane(tid >> 6), wr = wid >> 1, wc = wid & 1, q = lane >> 4, cl = lane & 15;
    constexpr int NT_N = G1_COLS / 128;
    if (part == 0) {
        for (int kk = 0;; ++kk) {
            int mt, nti;
            if (!tile_map(kk, 6, mt, nti)) break;
            const int nt = gemm1_col_tile(0, nti);
            f32x4 acc[4][4];
            gemm128(acc, rs, (unsigned)(OFF_HN + (size_t)mt * 128 * 2048), RowLin{2048}, (unsigned)(OFF_WIN_T + (size_t)nt * 128 * 2048), RowLin{2048}, 16, lds, tid);
            gemm1_epilogue<4>(P, acc, nt * 2 + wc, mt * 128 + wr * 64 + cl, q, cl);
        }
    } else {
        for (int kk = 0;; ++kk) {
            int mt, nti;
            if (!tile_map(kk, NT_N - 6, mt, nti, 128)) break;
            const int nt = gemm1_col_tile(1, nti);
            f32x4 acc[8][4];
            gemm256(acc, rs, (unsigned)(OFF_HN + (size_t)mt * 256 * 2048), 2048u, (unsigned)(OFF_WIN_T + (size_t)nt * 128 * 2048), 2048u, 32, lds, tid);
            gemm1_epilogue<8>(P, acc, nt * 2 + wc, mt * 256 + wr * 128 + cl, q, cl);
        }
    }
}

DEVI float siluf_(float x) { return x * __builtin_amdgcn_rcpf(1.0f + __builtin_amdgcn_exp2f(-x * 1.4426950408889634f)); }

DEVI void phase_compress(const Params& P, unsigned char* lds, int tid) {
    unsigned char* ws = P.ws;
    const rsrc_t rs = __builtin_amdgcn_make_buffer_rsrc((void*)P.ws, (short)0, (int)0x7fffffff, 0x00020000);
    const int lane = tid & 63, wid = __builtin_amdgcn_readfirstlane(tid >> 6), wr = wid >> 1, wc = wid & 1, q = lane >> 4, cl = lane & 15;
    for (int u = blockIdx.x; u < 64; u += gridDim.x) {
        const int kv = u >> 5, mt = u & 31;
        const bf16_t* A = (const bf16_t*)(ws + OFF_KV + (size_t)kv * KV_STRIDE) + (size_t)mt * 128 * 1024;
        const bf16_t* W1 = (const bf16_t*)(ws + (kv ? OFF_W1V : OFF_W1K));
        const bf16_t* W2 = (const bf16_t*)(ws + (kv ? OFF_W2V : OFF_W2K));
        const float* bias = (const float*)(ws + OFF_BIAS1) + kv * 128;
        f32x4 acc[4][4];
        gemm128(acc, rs, (unsigned)(OFF_KV + (size_t)kv * KV_STRIDE + (size_t)mt * 128 * 2048), RowLin{2048}, (unsigned)(kv ? OFF_W1V : OFF_W1K), RowLin{4096}, 32, lds, tid);
#pragma unroll
        for (int m = 0; m < 4; ++m)
#pragma unroll
            for (int n = 0; n < 4; ++n) {
                const int col = wc * 64 + n * 16 + q * 4, row = wr * 64 + m * 16 + cl;
                const f32x4 bb = *(const f32x4*)(bias + col);
                const int ktile = col >> 6, ch = (col & 63) >> 3, wi = col & 7;
                u32x2 w; w.x = pk2(siluf_(acc[m][n][0] + bb[0]), siluf_(acc[m][n][1] + bb[1])); w.y = pk2(siluf_(acc[m][n][2] + bb[2]), siluf_(acc[m][n][3] + bb[3]));
                *(u32x2*)(lds + ktile * 16384 + row * 128 + ((ch ^ (row & 7)) << 4) + wi * 2) = w;
            }
#pragma unroll
        for (int i = 0; i < 4; ++i) {
            const int idx = tid + 256 * i;
            const int row = idx >> 4, ch16 = idx & 15, ktile = ch16 >> 3, ch = ch16 & 7;
            *(u32x4*)(lds + 32768 + ktile * 8192 + row * 128 + ((ch ^ (row & 7)) << 4)) = *(const u32x4*)(W2 + (size_t)row * 128 + ch16 * 8);
        }
        __syncthreads();
        f32x4 a2[4][2];
#pragma unroll
        for (int m = 0; m < 4; ++m) { a2[m][0] = (f32x4){0.f, 0.f, 0.f, 0.f}; a2[m][1] = (f32x4){0.f, 0.f, 0.f, 0.f}; }
#pragma unroll
        for (int kk = 0; kk < 4; ++kk) {
            const int ktile = kk >> 1, ks = kk & 1;
            bf16x8 a[4], b[2];
#pragma unroll
            for (int m = 0; m < 4; ++m) { const int row = wr * 64 + m * 16 + cl; a[m] = *(const bf16x8*)(lds + ktile * 16384 + row * 128 + (((ks * 4 + q) ^ (row & 7)) << 4)); }
#pragma unroll
            for (int n = 0; n < 2; ++n) { const int row = wc * 32 + n * 16 + cl; b[n] = *(const bf16x8*)(lds + 32768 + ktile * 8192 + row * 128 + (((ks * 4 + q) ^ (row & 7)) << 4)); }
#pragma unroll
            for (int m = 0; m < 4; ++m)
#pragma unroll
                for (int n = 0; n < 2; ++n) a2[m][n] = MFMA16(b[n], a[m], a2[m][n]);
        }
#pragma unroll
        for (int m = 0; m < 4; ++m)
#pragma unroll
            for (int n = 0; n < 2; ++n) {
                const int d = wc * 32 + n * 16 + q * 4;
                const int r = mt * 128 + wr * 64 + m * 16 + cl;
                const bool dead = ((r & 255) == 255);
                float v[4];
#pragma unroll
                for (int j = 0; j < 4; ++j) v[j] = dead ? 0.f : a2[m][n][j];
                if (kv == 0) {
                    bf16_t* kc = (bf16_t*)(ws + OFF_KC);
                    u32x2 w; w.x = pk2(v[0], v[1]); w.y = pk2(v[2], v[3]);
                    *(u32x2*)(kc + (size_t)r * 64 + d) = w;
                } else {
                    bf16_t* vct = (bf16_t*)(ws + OFF_VCT);
#pragma unroll
                    for (int j = 0; j < 4; ++j) st_bf16(vct + ((size_t)((r >> 8) * 64 + d + j)) * 256 + (r & 255), v[j]);
                }
            }
        __syncthreads();
    }
}

DEVI void phase_index(const Params& P, unsigned char* lds, int tid) {
    unsigned char* ws = P.ws;
    const bf16_t* QI = (const bf16_t*)(ws + OFF_QI);
    const bf16_t* KI = (const bf16_t*)(ws + OFF_KI);
    const float* WI = (const float*)(ws + OFF_WI);
    bf16_t* SEL = (bf16_t*)(ws + OFF_SEL);
    float* S = (float*)lds;
    const int lane = tid & 63, wid = __builtin_amdgcn_readfirstlane(tid >> 6), q = lane >> 4, cl = lane & 15;
    for (int u = blockIdx.x; u < NTOK / 4; u += gridDim.x) {
        const int b = u >> 10, w10 = u & 1023, s10 = (w10 < 512) ? w10 : 1535 - w10;
        const int t0 = s10 * 4, tok0 = b * 4096 + t0;
        const int t = t0 + wid;
        const int tok = tok0 + wid;
        if (t0 + 3 < 256) {
            for (int i = lane; i < 256; i += 64) SEL[(size_t)tok * 256 + i] = (bf16_t)(i <= t ? i : 0);
            continue;
        }
        {
            bf16x8 a[2];
#pragma unroll
            for (int hg = 0; hg < 2; ++hg) a[hg] = *(const bf16x8*)(QI + (size_t)(tok0 + (cl >> 2)) * 256 + (4 * hg + (cl & 3)) * 32 + q * 8);
            const f32x4 w0 = *(const f32x4*)(WI + (size_t)(tok0 + q) * 8), w1 = *(const f32x4*)(WI + (size_t)(tok0 + q) * 8 + 4);
            const int ktmax = (t0 + 3) >> 4;
            const bf16_t* kb = KI + (size_t)b * 4096 * 32 + cl * 32 + q * 8;
            for (int kt0 = wid; kt0 <= ktmax; kt0 += 16) {
                bf16x8 bk[4];
#pragma unroll
                for (int uu = 0; uu < 4; ++uu) { const int kt = (kt0 + 4 * uu <= ktmax) ? kt0 + 4 * uu : kt0; bk[uu] = *(const bf16x8*)(kb + (size_t)kt * 16 * 32); }
#pragma unroll
                for (int uu = 0; uu < 4; ++uu) {
                    const int kt = kt0 + 4 * uu;
                    f32x4 c0 = {0.f, 0.f, 0.f, 0.f}, c1 = {0.f, 0.f, 0.f, 0.f};
                    c0 = MFMA16(a[0], bk[uu], c0); c1 = MFMA16(a[1], bk[uu], c1);
                    float sc = 0.f;
#pragma unroll
                    for (int j = 0; j < 4; ++j) { sc += w0[j] * fmaxf(c0[j], 0.f); sc += w1[j] * fmaxf(c1[j], 0.f); }
                    if (kt <= ktmax) S[q * 4096 + kt * 16 + cl] = sc;
                }
            }
        }
        __syncthreads();
        {
            const int n = t + 1;
            const float* Sq = S + wid * 4096;
            if (n <= 256) {
                for (int i = lane; i < 256; i += 64) SEL[(size_t)tok * 256 + i] = (bf16_t)(i <= t ? i : 0);
            } else {
                const int nr = (n + 63) >> 6;
                float x[64];
                const float NINF = -__builtin_inff();
                float mx = NINF, mn = __builtin_inff();
#pragma unroll
                for (int r = 0; r < 64; ++r) {
                    const int key = r * 64 + lane;
                    const float v = Sq[key];
                    x[r] = (key < n) ? v : NINF;
                    mn = fminf(mn, (key < n) ? v : __builtin_inff());
                    mx = fmaxf(mx, x[r]);
                }
#pragma unroll
                for (int o = 32; o > 0; o >>= 1) { mx = fmaxf(mx, __shfl_xor(mx, o)); mn = fminf(mn, __shfl_xor(mn, o)); }
                float lo = mn, hi = mx, T; int need;
                int chi = 0, clo = n;
#define COUNT_GE(dst, thr) do { int c_ = 0; _Pragma("unroll") for (int g8 = 0; g8 < 8; ++g8) if (g8 * 8 < nr) { \
        _Pragma("unroll") for (int r = g8 * 8; r < g8 * 8 + 8; ++r) c_ += __popcll(__ballot(x[r] >= (thr))); } (dst) = c_; } while (0)
                COUNT_GE(chi, hi);
                if (chi >= 256) { T = hi; need = 256;   }
                else {
                    float s1 = 0.f, s2 = 0.f;
#pragma unroll
                    for (int g8 = 0; g8 < 8; ++g8) if (g8 * 8 < nr) {
#pragma unroll
                        for (int r = g8 * 8; r < g8 * 8 + 8; ++r) { const float v = (x[r] == NINF) ? 0.f : x[r]; s1 += v; s2 += v * v; }
                    }
                    s1 = wave_sum_f32_dpp(s1); s2 = wave_sum_f32_dpp(s2);
                    const float fn = (float)n, mu = s1 / fn;
                    const float sg = sqrtf(fmaxf(s2 / fn - mu * mu, 1e-20f));
                    float vg;
                    {
                        const float pq = 256.0f / fn, pp = fminf(pq, 1.0f - pq);
                        const float tt = sqrtf(-2.0f * __logf(fmaxf(pp, 1e-6f)));
                        const float zz = tt - (2.515517f + 0.802853f * tt + 0.010328f * tt * tt) / (1.0f + 1.432788f * tt + 0.189269f * tt * tt + 0.001308f * tt * tt * tt);
                        vg = mu + ((pq <= 0.5f) ? zz : -zz) * sg;
                    }
                    bool found = false, adjacent = false; float thr = 0.f;
                    for (int it = 0; it < 160; ++it) {
                        if (clo - chi <= 64) break;
                        const float mid = 0.5f * lo + 0.5f * hi;
                        if (!(mid > lo && mid < hi)) { adjacent = true; break; }
                        float v = vg;
                        if (!(v > lo && v < hi) || (it & 3) == 3) v = mid;
                        int c; COUNT_GE(c, v);
                        if (c == 256) { found = true; thr = v; break; }
                        if (c > 256) { lo = v; clo = c; } else { hi = v; chi = c; }
                        const float zv = (v - mu) / sg;
                        const float dens = fmaxf(fn * 0.39894228f * __expf(-0.5f * zv * zv), 0.5f) / sg;
                        vg = v + ((float)c - ((c > 256) ? 244.0f : 268.0f)) / dens;
                    }
                    if (found) { T = thr; need = -1; }
                    else if (adjacent) { T = lo; need = 256 - chi; }
                    else {
                        float* cand = (float*)(lds + 65536) + wid * 64;
                        cand[lane] = NINF;
                        int cb = 0;
                        const unsigned long long ltm = (1ull << lane) - 1ull;
#pragma unroll
                        for (int g8 = 0; g8 < 8; ++g8) if (g8 * 8 < nr) {
#pragma unroll
                            for (int r = g8 * 8; r < g8 * 8 + 8; ++r) {
                                const bool isc = (x[r] >= lo) && (x[r] < hi);
                                const unsigned long long bm = __ballot(isc);
                                if (bm != 0ull) {
                                    if (isc) cand[cb + __popcll(bm & ltm)] = x[r];
                                    cb += __popcll(bm);
                                }
                            }
                        }
                        const float y = cand[lane];
                        int cgt = 0, cge = 0;
#pragma unroll
                        for (int k = 0; k < 64; ++k) { const float yk = __builtin_bit_cast(float, __builtin_amdgcn_readlane(__builtin_bit_cast(int, y), k)); cgt += (yk > y) ? 1 : 0; cge += (yk >= y) ? 1 : 0; }
                        const int nd = 256 - chi;
                        const bool isT = (y != NINF) && (cgt <= nd - 1) && (cge >= nd);
                        const unsigned long long tm = __ballot(isT);
                        const int tl = (tm != 0ull) ? (int)__builtin_ctzll(tm) : 0;
                        T = __shfl(y, tl);
                        need = nd - __shfl(cgt, tl);
                    }
                }
                bf16_t* selb = (bf16_t*)(lds + 65536 + 1024) + wid * 256;
                int wlo = 0, whi = 0, tot = 0;
#pragma unroll
                for (int g8 = 0; g8 < 8; ++g8) if (g8 * 8 < nr) {
#pragma unroll
                    for (int r = g8 * 8; r < g8 * 8 + 8; ++r) {
                        const unsigned long long m = __ballot(x[r] >= T);
                        tot += __popcll(m);
                        asm volatile("v_writelane_b32 %0, %1, %2" : "+v"(wlo) : "s"((unsigned)m), "n"(r));
                        asm volatile("v_writelane_b32 %0, %1, %2" : "+v"(whi) : "s"((unsigned)(m >> 32)), "n"(r));
                    }
                }
                if (tot == 256) {
                    const int cw = __popc((unsigned)wlo) + __popc((unsigned)whi);
                    int pos = 0;
#pragma unroll
                    for (int bb = 0; bb < 7; ++bb) {
                        const unsigned long long bmk = __ballot(((cw >> bb) & 1) != 0);
                        pos += (int)__builtin_amdgcn_mbcnt_hi((unsigned)(bmk >> 32), __builtin_amdgcn_mbcnt_lo((unsigned)bmk, 0u)) << bb;
                    }
                    unsigned long long w = ((unsigned long long)(unsigned)whi << 32) | (unsigned long long)(unsigned)wlo;
                    while (w != 0ull) {
                        const int bpos = (int)__builtin_ctzll(w);
                        selb[pos++] = (bf16_t)(lane * 64 + bpos);
                        w &= w - 1ull;
                    }
                } else {
                    if (need < 0) need = 0x7fffffff;
                    int base = 0, eqc = 0;
                    const unsigned long long lt = (1ull << lane) - 1ull;
#pragma unroll
                    for (int g8 = 0; g8 < 8; ++g8) if (g8 * 8 < nr) {
#pragma unroll
                        for (int r = g8 * 8; r < g8 * 8 + 8; ++r) {
                            const bool eq = (x[r] == T);
                            const unsigned long long em = __ballot(eq);
                            const bool sel = (x[r] > T) || (eq && (eqc + __popcll(em & lt) < need));
                            eqc += __popcll(em);
                            const unsigned long long sm = __ballot(sel);
                            if (sel) { const int pp = base + __popcll(sm & lt); if (pp < 256) selb[pp] = (bf16_t)(r * 64 + lane); }
                            base += __popcll(sm);
                        }
                    }
                }
                __builtin_amdgcn_wave_barrier();
                if (lane < 32) *(u32x4*)(SEL + (size_t)tok * 256 + lane * 8) = *(const u32x4*)(selb + lane * 8);
                __builtin_amdgcn_wave_barrier();
            }
        }
        __syncthreads();
    }
}

DEVI int dsa_vswz(int row) { return (((row >> 1) & 1) << 1) | (((row >> 3) & 1) << 2); }
DEVI void phase_dsa(const Params& P, unsigned char* lds, int tid) {
    unsigned char* ws = P.ws;
    const bf16_t* QA = (const bf16_t*)(ws + OFF_QA);
    const bf16_t* KA = (const bf16_t*)(ws + OFF_KA);
    const bf16_t* VA = (const bf16_t*)(ws + OFF_VA);
    const bf16_t* SEL = (const bf16_t*)(ws + OFF_SEL);
    bf16_t* OA = (bf16_t*)(ws + OFF_OA);
    const int lane = tid & 63, wid = __builtin_amdgcn_readfirstlane(tid >> 6), q = lane >> 4, cl = lane & 15;
    unsigned char* vl = lds + wid * 8192;
    const float NINF = -__builtin_inff();
    const int stride = gridDim.x * 4;
    int tok = blockIdx.x * 4 + wid;
    if (tok >= NTOK) return;
    int kidx[16], mk[4]; bf16x8 bq[2];
    {
        const bf16_t* sel = SEL + (size_t)tok * 256;
#pragma unroll
        for (int rf = 0; rf < 16; ++rf) kidx[rf] = sel[32 * (rf >> 1) + 8 * (cl >> 2) + 4 * (rf & 1) + (cl & 3)];
#pragma unroll
        for (int cc = 0; cc < 4; ++cc) mk[cc] = sel[cc * 64 + lane];
#pragma unroll
        for (int ks = 0; ks < 2; ++ks) bq[ks] = *(const bf16x8*)(QA + (size_t)tok * 512 + (cl & 7) * 64 + ks * 32 + q * 8);
    }
    const int wrow = lane >> 3;
    for (; tok < NTOK; tok += stride) {
        const int b = tok >> 12, t = tok & 4095;
        const int cnt = (t + 1 < 256) ? t + 1 : 256;
        const int nc64 = (cnt + 63) >> 6;
        const bf16_t* kb = KA + (size_t)b * 4096 * 64;
        const bf16_t* vb = VA + (size_t)b * 4096 * 64;
        const bf16x8 zero8 = {0, 0, 0, 0, 0, 0, 0, 0};
        const bf16x8 bq0 = (cl < 8) ? bq[0] : zero8, bq1 = (cl < 8) ? bq[1] : zero8;
        u32x4 vr[8];
#pragma unroll
        for (int i = 0; i < 8; ++i) { const int key = __shfl(mk[0], wrow + 8 * i); vr[i] = *(const u32x4*)(vb + (size_t)key * 64 + (lane & 7) * 8); }
        f32x4 s[16];
#pragma unroll
        for (int rf = 0; rf < 16; ++rf) {
            s[rf] = (f32x4){0.f, 0.f, 0.f, 0.f};
            if ((rf >> 2) < nc64) {
                const bf16_t* kr = kb + (size_t)kidx[rf] * 64 + q * 8;
                const bf16x8 a0 = *(const bf16x8*)(kr), a1 = *(const bf16x8*)(kr + 32);
                s[rf] = MFMA16(a0, bq0, s[rf]); s[rf] = MFMA16(a1, bq1, s[rf]);
            }
            if ((rf & 3) == 3) asm volatile("" ::: "memory");
        }
        int mkc[4];
#pragma unroll
        for (int cc = 0; cc < 4; ++cc) mkc[cc] = mk[cc];
        {
            const int tn = (tok + stride < NTOK) ? tok + stride : tok;
            const bf16_t* sel = SEL + (size_t)tn * 256;
#pragma unroll
            for (int rf = 0; rf < 16; ++rf) kidx[rf] = sel[32 * (rf >> 1) + 8 * (cl >> 2) + 4 * (rf & 1) + (cl & 3)];
#pragma unroll
            for (int cc = 0; cc < 4; ++cc) mk[cc] = sel[cc * 64 + lane];
#pragma unroll
            for (int ks = 0; ks < 2; ++ks) bq[ks] = *(const bf16x8*)(QA + (size_t)tn * 512 + (cl & 7) * 64 + ks * 32 + q * 8);
        }
        float mx = NINF;
#pragma unroll
        for (int rf = 0; rf < 16; ++rf)
#pragma unroll
            for (int j = 0; j < 4; ++j) {
                const int p = 32 * (rf >> 1) + 8 * q + 4 * (rf & 1) + j;
                if (p >= cnt) s[rf][j] = NINF;
                mx = fmaxf(mx, s[rf][j]);
            }
        mx = rows_max(mx);
        float ls = 0.f;
#pragma unroll
        for (int rf = 0; rf < 16; ++rf)
#pragma unroll
            for (int j = 0; j < 4; ++j) { const float pv = __builtin_amdgcn_exp2f(s[rf][j] - mx); s[rf][j] = pv; ls += pv; }
        ls = rows_sum(ls);
        const float inv = __builtin_amdgcn_rcpf(ls);
        bf16x8 pbs[8];
#pragma unroll
        for (int c8 = 0; c8 < 8; ++c8) pbs[c8] = pack8(s[2 * c8], s[2 * c8 + 1]);
        f32x4 o[4];
#pragma unroll
        for (int d = 0; d < 4; ++d) o[d] = (f32x4){0.f, 0.f, 0.f, 0.f};
#pragma unroll
        for (int cc = 0; cc < 4; ++cc) {
            if (cc < nc64) {
                __builtin_amdgcn_wave_barrier();
#pragma unroll
                for (int i = 0; i < 8; ++i) { const int row = wrow + 8 * i; *(u32x4*)(vl + row * 128 + (((lane & 7) ^ dsa_vswz(row)) << 4)) = vr[i]; }
                __builtin_amdgcn_wave_barrier();
                if (cc + 1 < 4 && cc + 1 < nc64) {
#pragma unroll
                    for (int i = 0; i < 8; ++i) { const int key = __shfl(mkc[(cc + 1) & 3], wrow + 8 * i); vr[i] = *(const u32x4*)(vb + (size_t)key * 64 + (lane & 7) * 8); }
                }
#pragma unroll
                for (int c2 = 0; c2 < 2; ++c2) {
                    const bf16x8 pb = pbs[cc * 2 + c2];
#pragma unroll
                    for (int d = 0; d < 4; ++d) {
                        const int r0 = c2 * 32 + 8 * q + (cl >> 2), r1 = r0 + 4;
                        const int ch = d * 2 + ((cl & 3) >> 1), wb = 8 * (cl & 1);
                        const s16x4 lo4 = __builtin_amdgcn_ds_read_tr16_b64_v4i16((LAS s16x4*)((LAS unsigned char*)(vl) + r0 * 128 + ((ch ^ dsa_vswz(r0)) << 4) + wb));
                        const s16x4 hi4 = __builtin_amdgcn_ds_read_tr16_b64_v4i16((LAS s16x4*)((LAS unsigned char*)(vl) + r1 * 128 + ((ch ^ dsa_vswz(r1)) << 4) + wb));
                        const bf16x8 av = {lo4[0], lo4[1], lo4[2], lo4[3], hi4[0], hi4[1], hi4[2], hi4[3]};
                        o[d] = MFMA16(av, pb, o[d]);
                    }
                }
            }
        }
        if (cl < 8) {
#pragma unroll
            for (int d = 0; d < 4; ++d) {
                u32x2 w; w.x = pk2(o[d][0] * inv, o[d][1] * inv); w.y = pk2(o[d][2] * inv, o[d][3] * inv);
                *(u32x2*)(OA + (size_t)tok * 512 + cl * 64 + d * 16 + q * 4) = w;
            }
        }
    }
}

DEVI int fK(int row) { return (row & 3) | (((row >> 3) & 1) << 2); }

struct AttnState { f32x4 O[4][4]; float m[4]; float l[4]; };

template <int MODE>
DEVI void attn_blocks(rsrc_t rs, unsigned sK, unsigned sV, int ldv, int jb0, int jb1, const bf16x8 (&qf)[4][2], AttnState& st,
                      int tq, unsigned long long selmask, unsigned char* lds, int tid) {
    const int lane = tid & 63, q = lane >> 4, cl = lane & 15;
    const float NINF = -__builtin_inff();
#pragma unroll
    for (int cf = 0; cf < 4; ++cf) { st.m[cf] = NINF; st.l[cf] = 0.f;
#pragma unroll
        for (int d = 0; d < 4; ++d) st.O[d][cf] = (f32x4){0.f, 0.f, 0.f, 0.f}; }
    if (jb1 < jb0) return;
    const int wid_ = __builtin_amdgcn_readfirstlane(tid >> 6);
    unsigned kro[2], vro[2];
#pragma unroll
    for (int i = 0; i < 2; ++i) {
        const int row = (wid_ * 2 + i) * 8 + (lane >> 3);
        kro[i] = (unsigned)(row * 64 + (((lane & 7) ^ fK(row)) << 3)) * 2u;
        vro[i] = (unsigned)(row * ldv + (((lane & 7) ^ (row & 7)) << 3)) * 2u;
    }
    unsigned char* wk = lds + wid_ * 2048;
#pragma unroll
    for (int i = 0; i < 2; ++i) { glds16(rs, wk + i * 1024, kro[i], sK + (unsigned)jb0 * 8192u); glds16(rs, wk + 8192 + i * 1024, vro[i], sV + (unsigned)jb0 * 128u); }
    __syncthreads();
    const int nmax = (tq >= 31) ? ((tq - 31) >> 4) : -1;
    for (int jb = jb0; jb <= jb1; ++jb) {
        unsigned char* cur = lds + ((jb - jb0) & 1) * 16384;
        const bool more = jb < jb1;
        if (more) {
            unsigned char* wn = wk + ((jb - jb0 + 1) & 1) * 16384;
#pragma unroll
            for (int i = 0; i < 2; ++i) { glds16(rs, wn + i * 1024, kro[i], sK + (unsigned)(jb + 1) * 8192u); glds16(rs, wn + 8192 + i * 1024, vro[i], sV + (unsigned)(jb + 1) * 128u); }
        }
        bool lane_on = true;
        if (MODE == 1) lane_on = ((selmask >> jb) & 1ull) != 0ull;
        if (MODE == 0) lane_on = (jb * 64 <= nmax);
        if (MODE == 2) lane_on = (jb * 64 + 63 > tq - 512);
        if (__ballot(lane_on) != 0ull) {
#pragma unroll
            for (int c = 0; c < 2; ++c) {
                f32x4 S[2][4];
#pragma unroll
                for (int r2 = 0; r2 < 2; ++r2)
#pragma unroll
                    for (int cf = 0; cf < 4; ++cf) S[r2][cf] = (f32x4){0.f, 0.f, 0.f, 0.f};
#pragma unroll
                for (int r2 = 0; r2 < 2; ++r2) {
                    const int kl = 32 * c + 8 * (cl >> 2) + 4 * r2 + (cl & 3);
#pragma unroll
                    for (int ks = 0; ks < 2; ++ks) {
                        const bf16x8 a = *(const bf16x8*)(cur + kl * 128 + (((ks * 4 + q) ^ (cl & 7)) << 4));
#pragma unroll
                        for (int cf = 0; cf < 4; ++cf) S[r2][cf] = MFMA16(a, qf[cf][ks], S[r2][cf]);
                    }
                }
                bool edge;
                if (MODE == 0) edge = (jb * 64 + 63 > nmax);
                else if (MODE == 1) edge = (jb * 64 + 63 > tq) || !lane_on;
                else edge = (jb * 64 + 63 > tq) || (jb * 64 <= tq - 512);
                const bool need_mask = __ballot(edge) != 0ull;
                bf16x8 pb[4];
#pragma unroll
                for (int cf = 0; cf < 4; ++cf) {
                    if (need_mask) {
#pragma unroll
                        for (int r2 = 0; r2 < 2; ++r2)
#pragma unroll
                            for (int j = 0; j < 4; ++j) {
                                const int key = jb * 64 + 32 * c + 8 * q + 4 * r2 + j;
                                bool v;
                                if (MODE == 0) v = key <= nmax;
                                else if (MODE == 1) v = lane_on && key <= tq;
                                else v = key <= tq && key > tq - 512;
                                if (!v) S[r2][cf][j] = NINF;
                            }
                    }
                    const float bml = fmaxf(fmaxf(fmaxf(S[0][cf][0], S[0][cf][1]), fmaxf(S[0][cf][2], S[0][cf][3])), fmaxf(fmaxf(S[1][cf][0], S[1][cf][1]), fmaxf(S[1][cf][2], S[1][cf][3])));
                    if (__ballot(bml > st.m[cf] + 8.0f) != 0ull) {
                        const float bm = rows_max(bml);
                        const float mnew = fmaxf(st.m[cf], bm);
                        const float mr0 = (mnew == NINF) ? 0.f : mnew;
                        const float alpha = __builtin_amdgcn_exp2f(st.m[cf] - mr0);
                        st.m[cf] = mnew;
                        st.l[cf] *= alpha;
#pragma unroll
                        for (int d = 0; d < 4; ++d) st.O[d][cf] *= alpha;
                    }
                    const float mref = (st.m[cf] == NINF) ? 0.f : st.m[cf];
                    float ps = 0.f;
#pragma unroll
                    for (int r2 = 0; r2 < 2; ++r2)
#pragma unroll
                        for (int j = 0; j < 4; ++j) { const float pv = __builtin_amdgcn_exp2f(S[r2][cf][j] - mref); S[r2][cf][j] = pv; ps += pv; }
                    st.l[cf] += ps;
                    pb[cf] = pack8(S[0][cf], S[1][cf]);
                }
#pragma unroll
                for (int d = 0; d < 4; ++d) {
                    const int row = d * 16 + cl;
                    const bf16x8 av = *(const bf16x8*)(cur + 8192 + row * 128 + (((c * 4 + q) ^ (row & 7)) << 4));
#pragma unroll
                    for (int cf = 0; cf < 4; ++cf) st.O[d][cf] = MFMA16(av, pb[cf], st.O[d][cf]);
                }
            }
        }
        __syncthreads();
    }
}

DEVI f32x4 bload16f(rsrc_t r, unsigned voff, unsigned soff) { return __builtin_bit_cast(f32x4, __builtin_amdgcn_raw_buffer_load_b128(r, (int)voff, (int)soff, 0)); }
DEVI void bstore16f(rsrc_t r, f32x4 v, unsigned voff, unsigned soff) { __builtin_amdgcn_raw_buffer_store_b128(__builtin_bit_cast(u32x4, v), r, (int)voff, (int)soff, 0); }
DEVI float bload4f(rsrc_t r, unsigned voff, unsigned soff) { return __builtin_bit_cast(float, __builtin_amdgcn_raw_buffer_load_b32(r, (int)voff, (int)soff, 0)); }

struct NsaUnit { int i, b, k, t0, tq; unsigned tokw, tokb, qoff, goff, ooff, sQ, sG, sO; };
DEVI NsaUnit nsa_unit(int uu, int tid) {
    NsaUnit U;
    const int lane = tid & 63, wid = __builtin_amdgcn_readfirstlane(tid >> 6), q = lane >> 4, cl = lane & 15;
    const int half = uu >> 9, r = uu & 511, bk = r & 15, ii = r >> 4;
    U.i = half ? ii : 63 - ii; U.b = bk >> 1; U.k = bk & 1;
    U.t0 = U.i * 64; U.tq = U.t0 + wid * 16 + cl;
    U.tokw = (unsigned)(wid * 16 + cl);
    U.tokb = (unsigned)(U.b * 4096 + U.t0);
    U.qoff = U.tokw * 1024u + (unsigned)q * 16u;
    U.goff = U.tokw * 96u;
    U.ooff = U.tokw * 1024u + (unsigned)q * 8u;
    U.sQ = U.tokb * 1024u + (unsigned)U.k * 512u;
    U.sG = (unsigned)OFF_GATES + U.tokb * 96u + (unsigned)U.k * 16u;
    U.sO = (unsigned)OFF_OB + U.tokb * 1024u + (unsigned)U.k * 512u;
    return U;
}

DEVI void nsa_cmp_unit(const Params& P, rsrc_t rs, int uu, unsigned char* lds, int tid) {
    const int lane = tid & 63, wid = __builtin_amdgcn_readfirstlane(tid >> 6), q = lane >> 4, cl = lane & 15;
    const NsaUnit U = nsa_unit(uu, tid);
    const int i = U.i, b = U.b, k = U.k, tq = U.tq;
    AttnState st;
    bf16x8 qf[4][2];
#pragma unroll
    for (int cf = 0; cf < 4; ++cf)
#pragma unroll
        for (int ks = 0; ks < 2; ++ks) qf[cf][ks] = __builtin_bit_cast(bf16x8, bload16(rs, U.qoff, (unsigned)OFF_QBN + U.sQ + cf * 128 + ks * 64));
    const unsigned sKC = (unsigned)OFF_KC + (unsigned)(b * 2 + k) * 256u * 128u;
    const unsigned sVC = (unsigned)OFF_VCT + (unsigned)(b * 2 + k) * 64u * 512u;
    const int nmax_blk = (U.t0 + 63 - 31) >> 4;
    const int jbc = (nmax_blk >> 6) < 3 ? (nmax_blk >> 6) : 3;
    attn_blocks<0>(rs, sKC, sVC, 256, 0, jbc, qf, st, tq, 0ull, lds, tid);
    float linv[4], mfin[4];
#pragma unroll
    for (int cf = 0; cf < 4; ++cf) {
        const float l = rows_sum(st.l[cf]);
        linv[cf] = (l > 0.f) ? __builtin_amdgcn_rcpf(l) : 0.f; mfin[cf] = st.m[cf];
        const float sc = linv[cf] * bload4f(rs, U.goff, U.sG + cf * 4);
#pragma unroll
        for (int d = 0; d < 4; ++d) { const f32x4 v = st.O[d][cf] * sc; u32x2 w; w.x = pk2(v[0], v[1]); w.y = pk2(v[2], v[3]);
            __builtin_amdgcn_raw_buffer_store_b64(w, rs, (int)U.ooff, (int)(U.sO + cf * 128 + d * 32), 0); }
    }
    unsigned long long* MSKG = (unsigned long long*)(P.ws + OFF_MASK);
    if (i < 16) {
        if (q == 0) MSKG[((size_t)(b * 2 + k)) * 4096 + tq] = (2ull << i) - 1ull;
        return;
    }
    float* SUM4 = (float*)(lds + 16384);
    float* LAST = (float*)(lds + 32768);
    float* IMP2 = (float*)(lds + 49152);
    const int nmax = (tq >= 31) ? ((tq - 31) >> 4) : -1;
    for (int kb = 0; kb <= jbc; ++kb) {
#pragma unroll
        for (int ii = 0; ii < 2; ++ii) {
            const int idx = tid + 256 * ii, row = idx >> 3, ch = idx & 7;
            *(u32x4*)(lds + row * 128 + ((ch ^ fK(row)) << 4)) = bload16(rs, (unsigned)(row * 64 + ch * 8) * 2u, sKC + (unsigned)kb * 8192u);
        }
        __syncthreads();
#pragma unroll
        for (int rf = 0; rf < 4; ++rf) {
            f32x4 S[4];
#pragma unroll
            for (int cf = 0; cf < 4; ++cf) S[cf] = (f32x4){0.f, 0.f, 0.f, 0.f};
            const int kl = 32 * (rf >> 1) + 8 * (cl >> 2) + 4 * (rf & 1) + (cl & 3);
#pragma unroll
            for (int ks = 0; ks < 2; ++ks) {
                const bf16x8 a = *(const bf16x8*)(lds + kl * 128 + (((ks * 4 + q) ^ (cl & 7)) << 4));
#pragma unroll
                for (int cf = 0; cf < 4; ++cf) S[cf] = MFMA16(a, qf[cf][ks], S[cf]);
            }
            float acc4 = 0.f, accl = 0.f;
#pragma unroll
            for (int j = 0; j < 4; ++j) {
                const int key = kb * 64 + 32 * (rf >> 1) + 8 * q + 4 * (rf & 1) + j;
                float pj = 0.f;
#pragma unroll
                for (int cf = 0; cf < 4; ++cf) pj += __builtin_amdgcn_exp2f(S[cf][j] - mfin[cf]) * linv[cf];
                pj = (key <= nmax) ? pj : 0.f;
                acc4 += pj; if (j == 3) accl = pj;
            }
            const int jblk = kb * 16 + 8 * (rf >> 1) + 2 * q + (rf & 1);
            SUM4[(wid * 16 + cl) * 64 + jblk] = acc4; LAST[(wid * 16 + cl) * 64 + jblk] = accl;
        }
        __syncthreads();
    }
    {
        const int qi = tid >> 2, jg = tid & 3;
        const int jlim = (jbc + 1) * 16;
        for (int jj = 0; jj < 16; ++jj) {
            const int j = jg * 16 + jj;
            float v = (j < jlim) ? SUM4[qi * 64 + j] : 0.f;
            if (j >= 1 && j - 1 < jlim) v += LAST[qi * 64 + j - 1];
            IMP2[qi * 64 + j] = v;
        }
    }
    __syncthreads();
    {
        const int qi = tid >> 2, jg = tid & 3;
        const float* row = IMP2 + qi * 64;
        float kk[64];
#pragma unroll
        for (int j4 = 0; j4 < 16; ++j4) {
            const f32x4 v = *(const f32x4*)(row + j4 * 4);
#pragma unroll
            for (int e = 0; e < 4; ++e) {
                const int j2 = j4 * 4 + e;
                const bool f2 = (j2 == 0) || (j2 == i) || (j2 == i - 1);
                kk[j2] = (j2 > i) ? -__builtin_inff() : (f2 ? __builtin_inff() : v[e]);
            }
        }
        unsigned lo = 0u;
#pragma unroll 1
        for (int jj = 0; jj < 16; ++jj) {
            const int j = jg * 16 + jj;
            float kj = -__builtin_inff();
#pragma unroll
            for (int j2 = 0; j2 < 64; ++j2) kj = (j2 == j) ? kk[j2] : kj;
            int rank = 0;
#pragma unroll
            for (int j2 = 0; j2 < 64; ++j2) rank += (kk[j2] > kj || (kk[j2] == kj && j2 < j)) ? 1 : 0;
            if (j <= i && rank < 16) lo |= (1u << jj);
        }
        unsigned long long bits = (unsigned long long)lo << (jg * 16);
        bits |= __shfl_xor(bits, 1); bits |= __shfl_xor(bits, 2);
        if (jg == 0) MSKG[((size_t)(b * 2 + k)) * 4096 + U.t0 + qi] = bits;
    }
    __syncthreads();
}

template <int MODE>
DEVI void nsa_kv_unit(const Params& P, rsrc_t rs, int uu, unsigned char* lds, int tid) {
    const int lane = tid & 63, q = lane >> 4;
    const NsaUnit U = nsa_unit(uu, tid);
    const int i = U.i, b = U.b, k = U.k, tq = U.tq;
    AttnState st;
    bf16x8 qf[4][2];
#pragma unroll
    for (int cf = 0; cf < 4; ++cf)
#pragma unroll
        for (int ks = 0; ks < 2; ++ks) qf[cf][ks] = __builtin_bit_cast(bf16x8, bload16(rs, U.qoff, (unsigned)OFF_QBR + U.sQ + cf * 128 + ks * 64));
    const unsigned sK = (unsigned)(OFF_KV + (MODE == 1 ? 2 : 4) * KV_STRIDE) + (unsigned)(b * 2 + k) * 4096u * 128u;
    const unsigned sV = (unsigned)(OFF_KV + (MODE == 1 ? 3 : 5) * KV_STRIDE) + (unsigned)(b * 2 + k) * 64u * 8192u;
    unsigned long long mymask = 0ull;
    int j0 = 0;
    if (MODE == 1) mymask = ((const unsigned long long*)(P.ws + OFF_MASK))[((size_t)(b * 2 + k)) * 4096 + tq];
    else j0 = (i >= 8) ? i - 8 : 0;
    attn_blocks<MODE>(rs, sK, sV, 4096, j0, i, qf, st, tq, mymask, lds, tid);
#pragma unroll
    for (int cf = 0; cf < 4; ++cf) {
        const float l = rows_sum(st.l[cf]);
        const float sc = ((l > 0.f) ? __builtin_amdgcn_rcpf(l) : 0.f) * bload4f(rs, U.goff, U.sG + (MODE == 1 ? 32 : 64) + cf * 4);
#pragma unroll
        for (int d = 0; d < 4; ++d) {
            const u32x2 pw = __builtin_bit_cast(u32x2, __builtin_amdgcn_raw_buffer_load_b64(rs, (int)U.ooff, (int)(U.sO + cf * 128 + d * 32), 0));
            f32x4 v = st.O[d][cf] * sc;
            v[0] += bf2f(pw.x & 0xffffu); v[1] += bf2f(pw.x >> 16); v[2] += bf2f(pw.y & 0xffffu); v[3] += bf2f(pw.y >> 16);
            u32x2 w; w.x = pk2(v[0], v[1]); w.y = pk2(v[2], v[3]);
            __builtin_amdgcn_raw_buffer_store_b64(w, rs, (int)U.ooff, (int)(U.sO + cf * 128 + d * 32), 0);
        }
    }
}

DEVI void phase_nsa(const Params& P, unsigned char* lds, int tid) {
    const rsrc_t rs = __builtin_amdgcn_make_buffer_rsrc((void*)P.ws, (short)0, (int)0x7fffffff, 0x00020000);
    for (int uu = blockIdx.x; uu < 1024; uu += gridDim.x) { int t = tid; asm volatile("" : "+v"(t)); nsa_cmp_unit(P, rs, uu, lds, t); }
    __syncthreads();
    for (int uu = blockIdx.x; uu < 1024; uu += gridDim.x) { int t = tid; asm volatile("" : "+v"(t)); nsa_kv_unit<1>(P, rs, uu, lds, t); }
    __syncthreads();
    for (int uu = blockIdx.x; uu < 1024; uu += gridDim.x) { int t = tid; asm volatile("" : "+v"(t)); nsa_kv_unit<2>(P, rs, uu, lds, t); }
}

DEVI void phase_merge(const Params& P, unsigned char* lds, int tid) {
    unsigned char* ws = P.ws;
    const rsrc_t rs = __builtin_amdgcn_make_buffer_rsrc((void*)P.ws, (short)0, (int)0x7fffffff, 0x00020000);
    const bf16_t* ga = (const bf16_t*)(ws + OFF_GA);
    const bf16_t* gb = (const bf16_t*)(ws + OFF_GB);
    bf16_t* mg = (bf16_t*)(ws + OFF_MERGED);
    const int lane = tid & 63, wid = __builtin_amdgcn_readfirstlane(tid >> 6), wr = wid >> 1, wc = wid & 1, q = lane >> 4, cl = lane & 15;
    for (int kk = 0;; ++kk) {
        int mt, nt;
        if (!tile_map(kk, 8, mt, nt)) break;
        f32x4 acc[4][4];
        unsigned t[4][4][2];
        gemm128(acc, rs, (unsigned)(OFF_OA + (size_t)mt * 128 * 1024), RowLin{1024}, (unsigned)(OFF_WBRA + (size_t)nt * 128 * 1024), RowLin{1024}, 8, lds, tid);
        const size_t e0 = (size_t)(mt * 128 + wr * 64 + cl) * 1024 + nt * 128 + wc * 64 + q * 4;
#pragma unroll
        for (int m = 0; m < 4; ++m)
#pragma unroll
            for (int n = 0; n < 4; ++n) {
                const u32x2 gv = *(const u32x2*)(ga + e0 + (size_t)m * 16 * 1024 + n * 16);
                t[m][n][0] = pk2(acc[m][n][0] * bf2f(gv.x & 0xffffu), acc[m][n][1] * bf2f(gv.x >> 16));
                t[m][n][1] = pk2(acc[m][n][2] * bf2f(gv.y & 0xffffu), acc[m][n][3] * bf2f(gv.y >> 16));
            }
        gemm128(acc, rs, (unsigned)(OFF_OB + (size_t)mt * 128 * 1024), RowLin{1024}, (unsigned)(OFF_WBRB + (size_t)nt * 128 * 1024), RowLin{1024}, 8, lds, tid);
#pragma unroll
        for (int m = 0; m < 4; ++m)
#pragma unroll
            for (int n = 0; n < 4; ++n) {
                const size_t o = e0 + (size_t)m * 16 * 1024 + n * 16;
                const u32x2 gv = *(const u32x2*)(gb + o);
                u32x2 w;
                w.x = pk2(bf2f(t[m][n][0] & 0xffffu) + acc[m][n][0] * bf2f(gv.x & 0xffffu), bf2f(t[m][n][0] >> 16) + acc[m][n][1] * bf2f(gv.x >> 16));
                w.y = pk2(bf2f(t[m][n][1] & 0xffffu) + acc[m][n][2] * bf2f(gv.y & 0xffffu), bf2f(t[m][n][1] >> 16) + acc[m][n][3] * bf2f(gv.y >> 16));
                *(u32x2*)(mg + o) = w;
            }
    }
}

DEVI void phase_outproj(const Params& P, unsigned char* lds, int tid) {
    unsigned char* ws = P.ws;
    const rsrc_t rs = __builtin_amdgcn_make_buffer_rsrc((void*)P.ws, (short)0, (int)0x7fffffff, 0x00020000);
    const bf16_t* mg = (const bf16_t*)(ws + OFF_MERGED);
    const bf16_t* wo = (const bf16_t*)(ws + OFF_WOUT);
    const float* x = P.in[0];
    float* x1 = P.out;
    const int lane = tid & 63, wid = __builtin_amdgcn_readfirstlane(tid >> 6), wr = wid >> 1, wc = wid & 1, q = lane >> 4, cl = lane & 15;
    for (int kk = 0;; ++kk) {
        int mt, nt;
        if (!tile_map(kk, 8, mt, nt, 128)) break;
        f32x4 acc[8][4];
        gemm256(acc, rs, (unsigned)(OFF_MERGED + (size_t)mt * 256 * 2048), 2048u, (unsigned)(OFF_WOUT + (size_t)nt * 128 * 2048), 2048u, 32, lds, tid);
#pragma unroll
        for (int m = 0; m < 8; ++m)
#pragma unroll
            for (int n = 0; n < 4; ++n) {
                const size_t o = (size_t)(mt * 256 + wr * 128 + m * 16 + cl) * 1024 + nt * 128 + wc * 64 + n * 16 + q * 4;
                *(f32x4*)(x1 + o) = *(const f32x4*)(x + o) + acc[m][n];
            }
    }
}

DEVI void phase_router(const Params& P, unsigned char* lds, int tid) {
    unsigned char* ws = P.ws;
    const int lane = tid & 63, wid = __builtin_amdgcn_readfirstlane(tid >> 6), q = lane >> 4, cl = lane & 15;
    const float* x1 = P.out; const float* g = P.in[13];
    const float* bg = P.in[15]; const float* be = P.in[17];
    const float* WR = (const float*)(ws + OFF_WR);
    bf16_t* h2 = (bf16_t*)(ws + OFF_HN);
    unsigned* cnt = (unsigned*)(ws + OFF_CTL);
    int* list = (int*)(ws + OFF_LIST);
    float* wt = (float*)(ws + OFF_WT);
    float* WL = (float*)lds;
    float* LG = (float*)(lds + 50688);
    float* RS = (float*)(lds + 50688 + 12288);
    for (int u = blockIdx.x; u < NTOK / 64; u += gridDim.x) {
        const int row0 = u * 64 + wid * 16;
        const float* xa = x1 + (size_t)(row0 + cl) * 1024 + 4 * q;
        f32x4 acc[3];
#pragma unroll
        for (int ct = 0; ct < 3; ++ct) acc[ct] = (f32x4){0.f, 0.f, 0.f, 0.f};
        float ss = 0.f;
        for (int kc = 0; kc < 4; ++kc) {
            __syncthreads();
#pragma unroll
            for (int i = 0; i < 12; ++i) {
                const int idx = tid + 256 * i, r = idx >> 6, c4 = idx & 63;
                *(f32x4*)(WL + r * 264 + c4 * 4) = *(const f32x4*)(WR + (size_t)r * 1024 + kc * 256 + c4 * 4);
            }
            __syncthreads();
#pragma unroll
            for (int jh = 0; jh < 2; ++jh) {
                f32x4 av[8];
#pragma unroll
                for (int j = 0; j < 8; ++j) av[j] = *(const f32x4*)(xa + kc * 256 + (jh * 8 + j) * 16);
#pragma unroll
                for (int j = 0; j < 8; ++j) {
                    {
                        const int kx = kc * 256 + (jh * 8 + j) * 16 + 4 * q;
                        const f32x4 gg = *(const f32x4*)(g + kx);
                        u32x2 w; w.x = pk2(av[j][0] * gg[0], av[j][1] * gg[1]); w.y = pk2(av[j][2] * gg[2], av[j][3] * gg[3]);
                        *(u32x2*)(h2 + (size_t)(row0 + cl) * 1024 + kx) = w;
                    }
                    ss += av[j][0] * av[j][0] + av[j][1] * av[j][1] + av[j][2] * av[j][2] + av[j][3] * av[j][3];
#pragma unroll
                    for (int ct = 0; ct < 3; ++ct) {
                        const f32x4 bv = *(const f32x4*)(WL + (ct * 16 + cl) * 264 + (jh * 8 + j) * 16 + 4 * q);
#pragma unroll
                        for (int e = 0; e < 4; ++e) acc[ct] = __builtin_amdgcn_mfma_f32_16x16x4f32(av[j][e], bv[e], acc[ct], 0, 0, 0);
                    }
                }
            }
        }
        ss += __shfl_xor(ss, 16); ss += __shfl_xor(ss, 32);
        const float rs = rsqrtf(ss * (1.0f / 1024.0f) + RMS_EPS);
        if (q == 0) { RS[wid * 16 + cl] = rs; ((float*)(ws + OFF_RS))[row0 + cl] = rs; }
        __syncthreads();
#pragma unroll
        for (int j = 0; j < 4; ++j) {
            const float rj = RS[wid * 16 + 4 * q + j];
#pragma unroll
            for (int ct = 0; ct < 3; ++ct) LG[(wid * 16 + 4 * q + j) * 48 + ct * 16 + cl] = acc[ct][j] * rj;
        }
        __syncthreads();
        if (tid < 64) {
            const int r = u * 64 + tid;
            const float* lg = LG + tid * 48;
            float gl[4];
#pragma unroll
            for (int e = 0; e < 4; ++e) gl[e] = lg[e] + bg[e];
            int gs = 0; float gm = gl[0];
#pragma unroll
            for (int e = 1; e < 4; ++e) if (gl[e] > gm) { gm = gl[e]; gs = e; }
            float den = 0.f;
#pragma unroll
            for (int e = 0; e < 4; ++e) den += __expf(gl[e] - gm);
            const float gp = 1.0f / den;
            float el[8];
#pragma unroll
            for (int e = 0; e < 8; ++e) el[e] = lg[4 + gs * 8 + e] + be[gs * 8 + e];
            int i0 = 0; float v0 = el[0];
#pragma unroll
            for (int e = 1; e < 8; ++e) if (el[e] > v0) { v0 = el[e]; i0 = e; }
            int i1 = -1; float v1 = -__builtin_inff();
#pragma unroll
            for (int e = 0; e < 8; ++e) if (e != i0 && el[e] > v1) { v1 = el[e]; i1 = e; }
            const float e1 = __expf(v1 - v0);
            const float w0 = gp / (1.0f + e1), w1 = gp * e1 / (1.0f + e1);
            const int ex0 = gs * 8 + i0, ex1 = gs * 8 + i1;
            const unsigned p0 = atomicAdd(&cnt[ex0], 1u);
            list[(size_t)ex0 * NTOK + p0] = r * 2 + 0;
            const unsigned p1 = atomicAdd(&cnt[ex1], 1u);
            list[(size_t)ex1 * NTOK + p1] = r * 2 + 1;
            wt[(size_t)r * 2 + 0] = w0; wt[(size_t)r * 2 + 1] = w1;
        }
    }
}

struct RowGather { const int* idx; DEVI unsigned operator()(int r) const { return (unsigned)idx[r] * 2048u; } };
struct RowGU { int c0; DEVI unsigned operator()(int r) const {
    const int wcx = r >> 6, w = r & 63; const int col = (w < 32) ? (c0 + wcx * 32 + w) : (256 + c0 + wcx * 32 + (w - 32)); return (unsigned)col * 2048u; } };

DEVI int moe_find_tile(const unsigned* cnt, int u, int& e, int& tl) {
    int t = u, ee = 0, ce = 0;
    for (; ee < 32; ++ee) { ce = (int)cnt[ee]; const int nt = (ce + 127) >> 7; if (t < nt) break; t -= nt; }
    e = ee; tl = t; return ce;
}
DEVI void phase_moe_a(const Params& P, unsigned char* lds, int tid) {
    unsigned char* ws = P.ws;
    const rsrc_t rs = __builtin_amdgcn_make_buffer_rsrc((void*)P.ws, (short)0, (int)0x7fffffff, 0x00020000);
    const int lane = tid & 63, wid = __builtin_amdgcn_readfirstlane(tid >> 6), wr = wid >> 1, wc = wid & 1, q = lane >> 4, cl = lane & 15;
    const unsigned* cnt = (const unsigned*)(ws + OFF_CTL);
    const int* list = (const int*)(ws + OFF_LIST);
    bf16_t* act = (bf16_t*)(ws + OFF_ACT);
    int* rowtok = (int*)(lds + 65536);
    const float* RSG = (const float*)(ws + OFF_RS);
    int total = 0;
    for (int e = 0; e < 32; ++e) total += ((int)cnt[e] + 127) >> 7;
    for (int v = blockIdx.x; v < total * 4; v += gridDim.x) {
        const int u = v >> 2, nt = v & 3;
        int e, tl; const int ce = moe_find_tile(cnt, u, e, tl);
        if (tid < 128) { const int r = tl * 128 + tid; rowtok[tid] = (r < ce) ? (list[(size_t)e * NTOK + r] >> 1) : 0; }
        __syncthreads();
        bf16_t* au = act + (size_t)u * 128 * 256;
        f32x4 acc[4][4];
        gemm128(acc, rs, (unsigned)OFF_HN, RowGather{rowtok}, (unsigned)(OFF_WGU + (size_t)e * 512 * 2048), RowGU{nt * 64}, 16, lds, tid);
#pragma unroll
        for (int m = 0; m < 4; ++m)
#pragma unroll
            for (int n = 0; n < 2; ++n) {
                const int row = wr * 64 + m * 16 + cl, col = nt * 64 + wc * 32 + n * 16 + q * 4;
                const float rsv = RSG[rowtok[row]];
                const f32x4 gt = acc[m][n] * rsv, up = acc[m][n + 2] * rsv;
                u32x2 w;
                w.x = pk2(siluf_(gt[0]) * up[0], siluf_(gt[1]) * up[1]);
                w.y = pk2(siluf_(gt[2]) * up[2], siluf_(gt[3]) * up[3]);
                *(u32x2*)(au + (size_t)row * 256 + col) = w;
            }
        __syncthreads();
    }
}
DEVI void phase_moe_b(const Params& P, unsigned char* lds, int tid) {
    unsigned char* ws = P.ws;
    const rsrc_t rs = __builtin_amdgcn_make_buffer_rsrc((void*)P.ws, (short)0, (int)0x7fffffff, 0x00020000);
    const int lane = tid & 63, wid = __builtin_amdgcn_readfirstlane(tid >> 6), wr = wid >> 1, wc = wid & 1, q = lane >> 4, cl = lane & 15;
    const unsigned* cnt = (const unsigned*)(ws + OFF_CTL);
    const int* list = (const int*)(ws + OFF_LIST);
    bf16_t* Y = (bf16_t*)(ws + OFF_Y);
    int* rowas = (int*)(lds + 65536);
    int total = 0;
    for (int e = 0; e < 32; ++e) total += ((int)cnt[e] + 127) >> 7;
    for (int v = blockIdx.x; v < total * 4; v += gridDim.x) {
        const int u = v >> 2, np = v & 3;
        int e, tl; const int ce = moe_find_tile(cnt, u, e, tl);
        if (tid < 128) { const int r = tl * 128 + tid; rowas[tid] = (r < ce) ? list[(size_t)e * NTOK + r] : -1; }
        __syncthreads();
        for (int h = 0; h < 2; ++h) {
            const int nt = np * 2 + h;
            f32x4 acc[4][4];
            gemm128(acc, rs, (unsigned)(OFF_ACT + (size_t)u * 128 * 512), RowLin{512}, (unsigned)(OFF_WDN + (size_t)e * 1024 * 512 + (size_t)nt * 128 * 512), RowLin{512}, 4, lds, tid);
#pragma unroll
            for (int m = 0; m < 4; ++m) {
                const int row = wr * 64 + m * 16 + cl;
                const int as = rowas[row];
                if (as >= 0) {
                    bf16_t* yr = Y + ((size_t)(as & 1) * NTOK + (as >> 1)) * 1024 + nt * 128 + wc * 64 + q * 4;
#pragma unroll
                    for (int n = 0; n < 4; ++n) { u32x2 w; w.x = pk2(acc[m][n][0], acc[m][n][1]); w.y = pk2(acc[m][n][2], acc[m][n][3]); *(u32x2*)(yr + n * 16) = w; }
                }
            }
        }
        __syncthreads();
    }
}

DEVI void phase_final(const Params& P, int tid, bool with_moe) {
    unsigned char* ws = P.ws;
    const int lane = tid & 63, wid = __builtin_amdgcn_readfirstlane(tid >> 6);
    const bf16_t* Y = (const bf16_t*)(ws + OFF_Y);
    const float* wt = (const float*)(ws + OFF_WT);
    const float* g = P.in[20];
    float* out = P.out;
    for (int r = blockIdx.x * 4 + wid; r < NTOK; r += gridDim.x * 4) {
        float* xr = out + (size_t)r * 1024;
        const float w0 = with_moe ? wt[(size_t)r * 2] : 0.f, w1 = with_moe ? wt[(size_t)r * 2 + 1] : 0.f;
        f32x4 v[4]; float ss = 0.f;
#pragma unroll
        for (int i = 0; i < 4; ++i) {
            v[i] = *(const f32x4*)(xr + i * 256 + lane * 4);
            if (with_moe) {
                const u32x2 a = *(const u32x2*)(Y + (size_t)r * 1024 + i * 256 + lane * 4);
                const u32x2 b = *(const u32x2*)(Y + ((size_t)NTOK + r) * 1024 + i * 256 + lane * 4);
                v[i][0] += w0 * bf2f(a.x & 0xffffu) + w1 * bf2f(b.x & 0xffffu); v[i][1] += w0 * bf2f(a.x >> 16) + w1 * bf2f(b.x >> 16);
                v[i][2] += w0 * bf2f(a.y & 0xffffu) + w1 * bf2f(b.y & 0xffffu); v[i][3] += w0 * bf2f(a.y >> 16) + w1 * bf2f(b.y >> 16);
            }
            ss += v[i][0] * v[i][0] + v[i][1] * v[i][1] + v[i][2] * v[i][2] + v[i][3] * v[i][3];
        }
        ss = wave_sum(ss);
        const float rs = rsqrtf(ss * (1.0f / 1024.0f) + RMS_EPS);
#pragma unroll
        for (int i = 0; i < 4; ++i) {
            const f32x4 gg = *(const f32x4*)(g + i * 256 + lane * 4);
            f32x4 o; o[0] = v[i][0] * rs * gg[0]; o[1] = v[i][1] * rs * gg[1]; o[2] = v[i][2] * rs * gg[2]; o[3] = v[i][3] * rs * gg[3];
            *(f32x4*)(xr + i * 256 + lane * 4) = o;
        }
    }
}

#define LAUNDER_TID() do { tid = wave_id * 64 + (int)__builtin_amdgcn_mbcnt_hi(~0u, __builtin_amdgcn_mbcnt_lo(~0u, 0u)); asm volatile("" : "+v"(tid)); } while (0)
__global__ void __launch_bounds__(NTHREADS, 2) fwd_megakernel(Params P) {
    extern __shared__ __attribute__((aligned(16))) unsigned char lds[];
    cg::grid_group grid = cg::this_grid();
    int tid;
    const int wave_id = __builtin_amdgcn_readfirstlane((int)(threadIdx.x >> 6));
    volatile LAS unsigned* bst = (volatile LAS unsigned*)(LAS unsigned char*)(lds + LDS_BYTES - 16);
    if (threadIdx.x < 4) bst[threadIdx.x] = 0u;
    __syncthreads();
    (void)xcd_barrier_post((unsigned*)(P.ws + OFF_BAR), bst);
#define GRID_BARRIER() do { XcdBarrier b_; b_.bar = (unsigned*)(P.ws + OFF_BAR); b_.x = xb_xcc_id(); b_.st = (volatile LAS unsigned*)(LAS unsigned char*)(lds + LDS_BYTES - 16); xcd_barrier(b_); } while (0)
    if (P.ph_lo != 0) grid.sync();
    LAUNDER_TID(); phase_prep(P, lds, tid, 0); __syncthreads();
    GRID_BARRIER();
    {
        const int first_idx = (blockIdx.x >> 8) & 1;
        for (int step = 0; step < 3; ++step) {
            const int what = (step == 0) ? 0 : 1 + ((step - 1) ^ first_idx);
            if (what <= 1) { LAUNDER_TID(); phase_gemm1(P, lds, tid, what); }
            else {
                LAUNDER_TID(); phase_prep(P, lds, tid, 1); __syncthreads();
                LAUNDER_TID(); phase_compress(P, lds, tid); __syncthreads();
                LAUNDER_TID(); phase_index(P, lds, tid);
            }
            __syncthreads();
            if (step == 0) GRID_BARRIER();
        }
    }
    GRID_BARRIER();
    if (((blockIdx.x >> 8) & 1) == 0) { LAUNDER_TID(); phase_dsa(P, lds, tid); __syncthreads(); }
    LAUNDER_TID(); phase_nsa(P, lds, tid); __syncthreads();
    if (((blockIdx.x >> 8) & 1) != 0) { LAUNDER_TID(); phase_dsa(P, lds, tid); __syncthreads(); }
    GRID_BARRIER();
    LAUNDER_TID(); phase_merge(P, lds, tid);
    GRID_BARRIER();
    LAUNDER_TID(); phase_outproj(P, lds, tid);
    GRID_BARRIER();
    LAUNDER_TID(); phase_router(P, lds, tid);
    GRID_BARRIER();
    LAUNDER_TID(); phase_moe_a(P, lds, tid);
    GRID_BARRIER();
    LAUNDER_TID(); phase_moe_b(P, lds, tid);
    GRID_BARRIER();
    LAUNDER_TID(); phase_final(P, tid, true);
}

extern "C" void kernel_launch(void* const* d_in, const int* in_sizes, int n_in, void* d_out, int out_size, void* d_ws, size_t ws_size,
                              hipStream_t stream) {
    static int grid_blocks = 0;
    if (!grid_blocks) {
        int dev = 0, cus = 0, per_cu = 0;
        hipGetDevice(&dev);
        hipDeviceGetAttribute(&cus, hipDeviceAttributeMultiprocessorCount, dev);
        hipFuncSetAttribute((const void*)fwd_megakernel, hipFuncAttributeMaxDynamicSharedMemorySize, LDS_BYTES);
        hipOccupancyMaxActiveBlocksPerMultiprocessor(&per_cu, (const void*)fwd_megakernel, NTHREADS, LDS_BYTES);
        if (per_cu < 1) per_cu = 1;
        if (per_cu > 2) per_cu = 2;
        grid_blocks = cus * per_cu;
        if (ws_size < WS_END) fprintf(stderr, "kernel_launch: workspace too small: %zu < %zu\n", ws_size, (size_t)WS_END);
    }
    Params p{};
    for (int i = 0; i < 21; ++i) p.in[i] = (const float*)d_in[i];
    p.pos = (const int*)d_in[1];
    p.out = (float*)d_out;
    p.ws = (unsigned char*)d_ws;
    for (int i = 0; i < 32; ++i) p.inv_freq[i] = (double)powf(10000.0f, -(float)i / 32.0f);
    p.ph_lo = 0; p.ph_hi = 0;
    (void)hipMemsetAsync(d_ws, 0, OFF_WIN_T, stream);
    void* args[] = {&p};
    hipError_t e = hipLaunchCooperativeKernel((const void*)fwd_megakernel, dim3(grid_blocks), dim3(NTHREADS), args, LDS_BYTES, stream);
    if (e != hipSuccess) fprintf(stderr, "cooperative launch failed: %s (grid %d)\n", hipGetErrorString(e), grid_blocks);
}
```

```cpp
#include <hip/hip_runtime.h>
#include <hip/hip_cooperative_groups.h>
#include <cstdint>
#include <cstdio>
#include <cmath>
namespace cg = cooperative_groups;

#define DEVI __device__ __forceinline__
#ifndef PROBE_TWICE
#define PROBE_TWICE 0
#endif
#define REPS(k) ((PROBE_TWICE == (k)) ? 2 : 1)
typedef unsigned short bf16_t;
typedef short bf16x8 __attribute__((ext_vector_type(8)));
typedef short s16x4 __attribute__((ext_vector_type(4)));
typedef float f32x4 __attribute__((ext_vector_type(4)));
typedef float f32x2 __attribute__((ext_vector_type(2)));
typedef unsigned u32x4 __attribute__((ext_vector_type(4)));
typedef unsigned u32x2 __attribute__((ext_vector_type(2)));
#define LAS __attribute__((address_space(3)))

constexpr int NB = 8, SL = 4096, DM = 1024, NTOK = NB * SL;
constexpr int INW = 4288;
constexpr int NTHREADS = 256;
constexpr int LDS_BYTES = 81920;
constexpr float RMS_EPS = 1e-6f;
constexpr float LOG2E = 1.4426950408889634f;

constexpr int WIN_ROWS = 4352;
constexpr int G1_COLS = 4352;

constexpr size_t al256(size_t x) { return (x + 255) & ~(size_t)255; }
constexpr size_t OFF_CTL   = 0;
constexpr size_t OFF_BAR   = 4096;
constexpr size_t OFF_WIN_T = 32768;
constexpr size_t OFF_WBRA  = OFF_WIN_T + (size_t)WIN_ROWS * 1024 * 2;
constexpr size_t OFF_WBRB  = OFF_WBRA + (size_t)1024 * 512 * 2;
constexpr size_t OFF_WOUT  = OFF_WBRB + (size_t)1024 * 512 * 2;
constexpr size_t OFF_W1K   = OFF_WOUT + (size_t)1024 * 1024 * 2;
constexpr size_t OFF_W1V   = OFF_W1K + (size_t)128 * 2048 * 2;
constexpr size_t OFF_W2K   = OFF_W1V + (size_t)128 * 2048 * 2;
constexpr size_t OFF_W2V   = OFF_W2K + (size_t)64 * 128 * 2;
constexpr size_t OFF_WGU   = OFF_W2V + (size_t)64 * 128 * 2;
constexpr size_t OFF_WDN   = OFF_WGU + (size_t)32 * 512 * 1024 * 2;
constexpr size_t OFF_BIAS1 = OFF_WDN + (size_t)32 * 1024 * 256 * 2;
constexpr size_t OFF_WR    = OFF_BIAS1 + 1024;
constexpr size_t OFF_CS    = OFF_WR + (size_t)48 * 1024 * 4;
constexpr size_t OFF_HN    = OFF_CS + (size_t)NTOK * 32 * 8;
constexpr size_t OFF_QA    = OFF_HN + (size_t)NTOK * 1024 * 2;
constexpr size_t OFF_KA    = OFF_QA + (size_t)NTOK * 512 * 2;
constexpr size_t OFF_VA    = OFF_KA + (size_t)NTOK * 64 * 2;
constexpr size_t OFF_QI    = OFF_VA + (size_t)NTOK * 64 * 2;
constexpr size_t OFF_KI    = OFF_QI + (size_t)NTOK * 256 * 2;
constexpr size_t OFF_WI    = OFF_KI + (size_t)NTOK * 32 * 2;
constexpr size_t OFF_QBN   = OFF_WI + (size_t)NTOK * 8 * 4;
constexpr size_t OFF_QBR   = OFF_QBN + (size_t)NTOK * 512 * 2;
constexpr size_t KV_STRIDE = (size_t)NTOK * 128 * 2 + 65536 * 4;
constexpr size_t OFF_KV    = OFF_QBR + (size_t)NTOK * 512 * 2;
constexpr size_t OFF_GATES = OFF_KV + 6 * KV_STRIDE;
constexpr size_t OFF_QKV_END = OFF_GATES + (size_t)NTOK * 24 * 4;
constexpr size_t OFF_KC    = al256(OFF_QKV_END);
constexpr size_t OFF_VCT   = OFF_KC + (size_t)16 * 256 * 64 * 2;
constexpr size_t OFF_SEL   = OFF_VCT + (size_t)16 * 256 * 64 * 2;
constexpr size_t OFF_OA    = OFF_HN;
constexpr size_t OFF_OB    = OFF_OA + (size_t)NTOK * 512 * 2;
constexpr size_t OFF_GA    = OFF_SEL + (size_t)NTOK * 256 * 2;
constexpr size_t OFF_GB    = OFF_GA + (size_t)NTOK * 1024 * 2;
constexpr size_t OFF_MASK  = OFF_GB + (size_t)NTOK * 1024 * 2;
constexpr size_t OFF_LIST  = OFF_MASK + (size_t)16 * 4096 * 8;
constexpr size_t OFF_WT    = OFF_LIST + (size_t)32 * NTOK * 4;
constexpr size_t OFF_RS    = OFF_WT + (size_t)NTOK * 2 * 4;
constexpr size_t WS_END    = OFF_RS + (size_t)NTOK * 4;
constexpr size_t OFF_MERGED = OFF_QA;
constexpr size_t OFF_ACT    = OFF_QA;
constexpr size_t OFF_Y      = OFF_QA + (size_t)40 * 1024 * 1024;
static_assert(OFF_Y + (size_t)2 * NTOK * 1024 * 2 <= OFF_QKV_END, "Y overlay");
static_assert((size_t)544 * 128 * 256 * 2 <= (size_t)40 * 1024 * 1024, "ACT overlay");

struct Params {
    const float* in[21];
    const int* pos;
    float* out;
    unsigned char* ws;
    double inv_freq[32];
    int ph_lo, ph_hi;
};

DEVI unsigned f2bf(float f) { unsigned u = __float_as_uint(f); return (u + 0x7fffu + ((u >> 16) & 1u)) >> 16; }
typedef __bf16 bf16v2_t __attribute__((ext_vector_type(2)));
DEVI unsigned pk2(float lo, float hi) { const f32x2 v = {lo, hi}; return __builtin_bit_cast(unsigned, __builtin_convertvector(v, bf16v2_t)); }
DEVI float rows_max(float x) {
    float a = x, b = x;
    asm volatile("v_nop\n\tv_nop\n\tv_permlane16_swap_b32 %0, %1" : "+v"(a), "+v"(b));
    x = fmaxf(a, b); a = x; b = x;
    asm volatile("v_nop\n\tv_nop\n\tv_permlane32_swap_b32 %0, %1" : "+v"(a), "+v"(b));
    return fmaxf(a, b);
}
DEVI float rows_sum(float x) {
    float a = x, b = x;
    asm volatile("v_nop\n\tv_nop\n\tv_permlane16_swap_b32 %0, %1" : "+v"(a), "+v"(b));
    x = a + b; a = x; b = x;
    asm volatile("v_nop\n\tv_nop\n\tv_permlane32_swap_b32 %0, %1" : "+v"(a), "+v"(b));
    return a + b;
}
DEVI float bf2f(unsigned h) { return __uint_as_float(h << 16); }
DEVI float sigmoidf_(float x) { return __builtin_amdgcn_rcpf(1.0f + __builtin_amdgcn_exp2f(-x * 1.4426950408889634f)); }
DEVI float wave_sum(float v) {
#pragma unroll
    for (int o = 32; o > 0; o >>= 1) v += __shfl_xor(v, o);
    return v;
}
DEVI int wave_sum_i32(int v) {
    v += __builtin_amdgcn_update_dpp(0, v, 0xB1, 0xF, 0xF, true);
    v += __builtin_amdgcn_update_dpp(0, v, 0x4E, 0xF, 0xF, true);
    v += __builtin_amdgcn_update_dpp(0, v, 0x141, 0xF, 0xF, true);
    v += __builtin_amdgcn_update_dpp(0, v, 0x140, 0xF, 0xF, true);
    return __builtin_amdgcn_readlane(v, 0) + __builtin_amdgcn_readlane(v, 16) + __builtin_amdgcn_readlane(v, 32) + __builtin_amdgcn_readlane(v, 48);
}
DEVI float wave_sum_f32_dpp(float v) {
    v += __builtin_bit_cast(float, __builtin_amdgcn_update_dpp(0, __builtin_bit_cast(int, v), 0xB1, 0xF, 0xF, true));
    v += __builtin_bit_cast(float, __builtin_amdgcn_update_dpp(0, __builtin_bit_cast(int, v), 0x4E, 0xF, 0xF, true));
    v += __builtin_bit_cast(float, __builtin_amdgcn_update_dpp(0, __builtin_bit_cast(int, v), 0x141, 0xF, 0xF, true));
    v += __builtin_bit_cast(float, __builtin_amdgcn_update_dpp(0, __builtin_bit_cast(int, v), 0x140, 0xF, 0xF, true));
    const int iv = __builtin_bit_cast(int, v);
    return (__builtin_bit_cast(float, __builtin_amdgcn_readlane(iv, 0)) + __builtin_bit_cast(float, __builtin_amdgcn_readlane(iv, 16))) +
           (__builtin_bit_cast(float, __builtin_amdgcn_readlane(iv, 32)) + __builtin_bit_cast(float, __builtin_amdgcn_readlane(iv, 48)));
}
DEVI bf16x8 pack8(const f32x4& a, const f32x4& b) {
    u32x4 w; w.x = pk2(a[0], a[1]); w.y = pk2(a[2], a[3]); w.z = pk2(b[0], b[1]); w.w = pk2(b[2], b[3]);
    return __builtin_bit_cast(bf16x8, w);
}
#define MFMA16(a, b, c) __builtin_amdgcn_mfma_f32_16x16x32_bf16((a), (b), (c), 0, 0, 0)


#define XB_TMO      128
#define XB_XCNT(j)  (256  + 64 * (j))
#define XB_XSUB(j)  (1280 + 64 * (j))
#define XB_XGEN(j)  (2304 + 64 * (j))
#define XB_TOP      3328
#define XB_TOPGEN   3392
#define XCD_BAR_WORDS 3456
#define XB_SPIN_CAP (1u << 22)
DEVI unsigned xb_ld(unsigned* p)              { return __hip_atomic_load(p, __ATOMIC_RELAXED, __HIP_MEMORY_SCOPE_AGENT); }
DEVI unsigned xb_add(unsigned* p, unsigned v) { return __hip_atomic_fetch_add(p, v, __ATOMIC_RELAXED, __HIP_MEMORY_SCOPE_AGENT); }
DEVI unsigned xb_xcc_id() { return (unsigned)__builtin_amdgcn_s_getreg((3 << 11) | 20) & 0xFu; }
#define XB_SPIN(cond, bar) do { unsigned _sp = 0; while (cond) { __builtin_amdgcn_s_sleep(1); \
    if ((++_sp & 255u) == 0u) { if (xb_ld(&(bar)[XB_TMO])) break; if (_sp > XB_SPIN_CAP) { atomicAdd(&(bar)[XB_TMO], 1u); break; } } } } while (0)
struct XcdBarrier { unsigned* bar; unsigned x; volatile LAS unsigned* st; };
DEVI XcdBarrier xcd_barrier_post(unsigned* bar, volatile LAS unsigned* st) {
    XcdBarrier b; b.bar = bar; b.x = xb_xcc_id(); b.st = st;
    if (threadIdx.x == 0) (void)xb_add(&bar[XB_XCNT(b.x)], 1u);
    return b;
}
DEVI void xcd_barrier_complete(unsigned* bar, unsigned x, unsigned& nloc, unsigned& nx) {
    const unsigned G = gridDim.x * gridDim.y * gridDim.z;
    unsigned sum, cnt, mine, sp = 0u;
    for (;;) {
        sum = 0u; cnt = 0u; mine = 0u;
#pragma unroll
        for (unsigned j = 0; j < 16; ++j) { const unsigned c = xb_ld(&bar[XB_XCNT(j)]); sum += c; cnt += (c > 0u) ? 1u : 0u; mine = (j == x) ? c : mine; }
        if (sum == G) break;
        __builtin_amdgcn_s_sleep(1);
        if ((++sp & 255u) == 0u) { if (xb_ld(&bar[XB_TMO])) break; if (sp > XB_SPIN_CAP) { atomicAdd(&bar[XB_TMO], 1u); break; } }
    }
    nloc = mine > 0u ? mine : 1u; nx = cnt > 0u ? cnt : 1u;
}
DEVI void xcd_barrier(const XcdBarrier& b) {
    asm volatile("s_waitcnt vmcnt(0)" ::: "memory");
    __syncthreads();
    if (threadIdx.x == 0) {
        unsigned* bar = b.bar;
        __builtin_amdgcn_s_waitcnt(0);
        unsigned nloc = b.st[0], nx = b.st[1];
        if (nloc == 0u) { xcd_barrier_complete(bar, b.x, nloc, nx); b.st[0] = nloc; b.st[1] = nx; }
        const unsigned old = xb_add(&bar[XB_XSUB(b.x)], 1u);
        const unsigned gen = old / nloc;
        if (old + 1u == (gen + 1u) * nloc) {
            __builtin_amdgcn_fence(__ATOMIC_RELEASE, "agent");
            asm volatile("s_waitcnt vmcnt(0)" ::: "memory");
            const unsigned og = xb_add(&bar[XB_TOP], 1u);
            const unsigned tg = og / nx;
            if (og + 1u == (tg + 1u) * nx) xb_add(&bar[XB_TOPGEN], 1u);
            else XB_SPIN(xb_ld(&bar[XB_TOPGEN]) == tg, bar);
            __builtin_amdgcn_fence(__ATOMIC_ACQUIRE, "agent");
            xb_add(&bar[XB_XGEN(b.x)], 1u);
            asm volatile("s_waitcnt vmcnt(0)" ::: "memory");
        } else {
            XB_SPIN(xb_ld(&bar[XB_XGEN(b.x)]) == gen, bar);
            __builtin_amdgcn_fence(__ATOMIC_ACQUIRE, "agent");
            asm volatile("s_waitcnt vmcnt(0)" ::: "memory");
        }
    }
    __syncthreads();
}

typedef __amdgpu_buffer_rsrc_t rsrc_t;
DEVI u32x4 bload16(rsrc_t r, unsigned voff, unsigned soff) { return __builtin_bit_cast(u32x4, __builtin_amdgcn_raw_buffer_load_b128(r, (int)voff, (int)soff, 0)); }
DEVI void glds16(rsrc_t r, unsigned char* lds_dst_uniform, unsigned voff, unsigned soff) {
    __builtin_amdgcn_raw_ptr_buffer_load_lds(r, (LAS void*)lds_dst_uniform, 16, (int)voff, (int)soff, 0, 0);
}
template <class FA, class FB>
DEVI void gemm128(f32x4 (&acc)[4][4], rsrc_t rs, unsigned sA, const FA& offA, unsigned sB, const FB& offB, int nk, unsigned char* lds, int tid) {
    const int lane = tid & 63, wid = __builtin_amdgcn_readfirstlane(tid >> 6), wr = wid >> 1, wc = wid & 1;
    const int lr = tid >> 3;
    const unsigned csrc = (unsigned)(((lane & 7) ^ ((lane >> 3) & 7)) << 4);
    unsigned oa[4], ob[4];
#pragma unroll
    for (int i = 0; i < 4; ++i) { oa[i] = offA(lr + 32 * i) + csrc; ob[i] = offB(lr + 32 * i) + csrc; }
#pragma unroll
    for (int m = 0; m < 4; ++m)
#pragma unroll
        for (int n = 0; n < 4; ++n) acc[m][n] = (f32x4){0.f, 0.f, 0.f, 0.f};
    const int q = lane >> 4, r16 = lane & 15;
    const int roffA0 = (wr * 64 + r16) * 128 + (((0 + q) ^ (lane & 7)) << 4);
    const int roffA1 = (wr * 64 + r16) * 128 + (((4 + q) ^ (lane & 7)) << 4);
    const int roffB0 = 16384 + (wc * 64 + r16) * 128 + (((0 + q) ^ (lane & 7)) << 4);
    const int roffB1 = 16384 + (wc * 64 + r16) * 128 + (((4 + q) ^ (lane & 7)) << 4);
    unsigned char* wbase = lds + wid * 1024;
#pragma unroll
    for (int i = 0; i < 4; ++i) { glds16(rs, wbase + i * 4096, oa[i], sA); glds16(rs, wbase + 16384 + i * 4096, ob[i], sB); }
    for (int kt = 0; kt < nk; ++kt) {
        unsigned char* cur = lds + (kt & 1) * 32768;
        __syncthreads();
        if (kt + 1 < nk) {
            unsigned char* nb = wbase + ((kt + 1) & 1) * 32768;
#pragma unroll
            for (int i = 0; i < 4; ++i) { glds16(rs, nb + i * 4096, oa[i], sA + (kt + 1) * 128); glds16(rs, nb + 16384 + i * 4096, ob[i], sB + (kt + 1) * 128); }
        }
        bf16x8 a0[4], b0[4], a1[4], b1[4];
#pragma unroll
        for (int m = 0; m < 4; ++m) a0[m] = *(const bf16x8*)(cur + roffA0 + m * 2048);
#pragma unroll
        for (int n = 0; n < 4; ++n) b0[n] = *(const bf16x8*)(cur + roffB0 + n * 2048);
#pragma unroll
        for (int m = 0; m < 4; ++m) a1[m] = *(const bf16x8*)(cur + roffA1 + m * 2048);
#pragma unroll
        for (int n = 0; n < 4; ++n) b1[n] = *(const bf16x8*)(cur + roffB1 + n * 2048);
#pragma unroll
        for (int m = 0; m < 4; ++m)
#pragma unroll
            for (int n = 0; n < 4; ++n) acc[m][n] = MFMA16(b0[n], a0[m], acc[m][n]);
#pragma unroll
        for (int m = 0; m < 4; ++m)
#pragma unroll
            for (int n = 0; n < 4; ++n) acc[m][n] = MFMA16(b1[n], a1[m], acc[m][n]);
    }
    __syncthreads();
}

DEVI int swzF(int row) { return (0x78 >> (((row >> 2) & 3) * 2)) & 3; }
DEVI void gemm256(f32x4 (&acc)[8][4], rsrc_t rs, unsigned sA, unsigned ldaB, unsigned sB, unsigned ldbB, int nk32, unsigned char* lds, int tid) {
    const int lane = tid & 63, wid = __builtin_amdgcn_readfirstlane(tid >> 6), wr = wid >> 1, wc = wid & 1;
    const int q = lane >> 4, r16 = lane & 15;
    unsigned oa[4], ob[2];
#pragma unroll
    for (int i = 0; i < 4; ++i) { const int row = (wid * 4 + i) * 16 + (lane >> 2); oa[i] = (unsigned)row * ldaB + (unsigned)(((lane & 3) ^ swzF(row)) << 4); }
#pragma unroll
    for (int i = 0; i < 2; ++i) { const int row = (wid * 2 + i) * 16 + (lane >> 2); ob[i] = (unsigned)row * ldbB + (unsigned)(((lane & 3) ^ swzF(row)) << 4); }
#pragma unroll
    for (int m = 0; m < 8; ++m)
#pragma unroll
        for (int n = 0; n < 4; ++n) acc[m][n] = (f32x4){0.f, 0.f, 0.f, 0.f};
    const int roffA = (wr * 128 + r16) * 64 + ((q ^ swzF(r16)) << 4);
    const int roffB = 16384 + (wc * 64 + r16) * 64 + ((q ^ swzF(r16)) << 4);
    unsigned char* wA = lds + wid * 4096;
    unsigned char* wB = lds + 16384 + wid * 2048;
#pragma unroll
    for (int i = 0; i < 4; ++i) glds16(rs, wA + i * 1024, oa[i], sA);
#pragma unroll
    for (int i = 0; i < 2; ++i) glds16(rs, wB + i * 1024, ob[i], sB);
    for (int kt = 0; kt < nk32; ++kt) {
        const unsigned char* cur = lds + (kt & 1) * 24576;
        __syncthreads();
        if (kt + 1 < nk32) {
            const int so = ((kt + 1) & 1) * 24576;
#pragma unroll
            for (int i = 0; i < 4; ++i) glds16(rs, wA + so + i * 1024, oa[i], sA + (kt + 1) * 64);
#pragma unroll
            for (int i = 0; i < 2; ++i) glds16(rs, wB + so + i * 1024, ob[i], sB + (kt + 1) * 64);
        }
        bf16x8 a[8], b[4];
#pragma unroll
        for (int n = 0; n < 4; ++n) b[n] = *(const bf16x8*)(cur + roffB + n * 1024);
#pragma unroll
        for (int m = 0; m < 8; ++m) a[m] = *(const bf16x8*)(cur + roffA + m * 1024);
#pragma unroll
        for (int m = 0; m < 8; ++m)
#pragma unroll
            for (int n = 0; n < 4; ++n) acc[m][n] = MFMA16(b[n], a[m], acc[m][n]);
    }
    __syncthreads();
}

DEVI bool tile_map(int k, int ncol, int& mt, int& nt, int nrow = 256) {
    if (gridDim.x == 512) {
        const int x = blockIdx.x & 7, j = blockIdx.x >> 3;
        const int v = j + 64 * k;
        if (v >= (nrow >> 3) * ncol) return false;
        const int nfull = ncol >> 3, rem = ncol & 7;
        int mtl;
        const int pcg = nrow;
        if (v < nfull * pcg) { const int cg = v / pcg, w = v % pcg; mtl = (w >> 6) * 8 + ((w & 63) >> 3); nt = cg * 8 + (w & 7); }
        else { const int v2 = v - nfull * pcg, per = 8 * rem; const int rg = v2 / per, w = v2 % per; mtl = rg * 8 + w / rem; nt = nfull * 8 + w % rem; }
        mt = x * (nrow >> 3) + mtl;
        return true;
    }
    const int u = blockIdx.x + gridDim.x * k;
    if (u >= nrow * ncol) return false;
    mt = u / ncol; nt = u % ncol;
    return true;
}
struct RowLin { unsigned ldb; DEVI unsigned operator()(int r) const { return (unsigned)r * ldb; } };

DEVI int win_map(int j) {
    if (j < 896) return j;
    if (j < 1408) return j - 896 + 936;
    if (j < 2176) return j - 1408 + 1448;
    if (j < 2208) return j - 2176 + 896;
    if (j < 2216) return j - 2208 + 928;
    if (j < 2240) return j;
    if (j < 2304) return -1;
    return j - 64;
}

struct TJob { const float* src; bf16_t* dst; int K, ld, nrows, perm, nb; size_t sb, db; };
DEVI TJob get_tjob(const Params& P, int j) {
    unsigned char* ws = P.ws;
    switch (j) {
        case 0: return TJob{P.in[3], (bf16_t*)(ws + OFF_WIN_T), 1024, INW, WIN_ROWS, 1, 1, 0, 0};
        case 1: return TJob{P.in[10], (bf16_t*)(ws + OFF_WBRA), 512, 1024, 1024, 0, 1, 0, 0};
        case 2: return TJob{P.in[11], (bf16_t*)(ws + OFF_WBRB), 512, 1024, 1024, 0, 1, 0, 0};
        case 3: return TJob{P.in[12], (bf16_t*)(ws + OFF_WOUT), 1024, 1024, 1024, 0, 1, 0, 0};
        case 4: return TJob{P.in[5], (bf16_t*)(ws + OFF_W1K), 2048, 128, 128, 0, 1, 0, 0};
        case 5: return TJob{P.in[8], (bf16_t*)(ws + OFF_W1V), 2048, 128, 128, 0, 1, 0, 0};
        case 6: return TJob{P.in[6], (bf16_t*)(ws + OFF_W2K), 128, 64, 64, 0, 1, 0, 0};
        case 7: return TJob{P.in[9], (bf16_t*)(ws + OFF_W2V), 128, 64, 64, 0, 1, 0, 0};
        case 8: return TJob{P.in[18], (bf16_t*)(ws + OFF_WGU), 1024, 512, 512, 0, 32, (size_t)1024 * 512, (size_t)512 * 1024};
        default: return TJob{P.in[19], (bf16_t*)(ws + OFF_WDN), 256, 1024, 1024, 0, 32, (size_t)256 * 1024, (size_t)1024 * 256};
    }
}
DEVI int tjob_tiles(int j) {
    switch (j) {
        case 0: return (WIN_ROWS / 64) * 16;
        case 1: case 2: return 16 * 8;
        case 3: return 16 * 16;
        case 4: case 5: return 2 * 32;
        case 6: case 7: return 1 * 2;
        case 8: return 32 * 8 * 16;
        default: return 32 * 16 * 4;
    }
}

DEVI void transpose_tile(const TJob& J, int tile, unsigned char* lds, int tid) {
    float* T = (float*)lds;
    const int kt = J.K / 64, rt = J.nrows / 64;
    const int b = tile / (kt * rt), rem = tile % (kt * rt);
    const int r0 = (rem / kt) * 64, k0 = (rem % kt) * 64;
    const float* src = J.src + (size_t)b * J.sb;
    bf16_t* dst = J.dst + (size_t)b * J.db;
    const int n4 = (tid & 15) * 4;
    int col = r0 + n4; if (J.perm) col = win_map(col);
    f32x4 ld4[4];
#pragma unroll
    for (int i = 0; i < 4; ++i) {
        const int kk = (tid >> 4) + 16 * i;
        ld4[i] = (col >= 0) ? *(const f32x4*)(src + (size_t)(k0 + kk) * J.ld + col) : (f32x4){0.f, 0.f, 0.f, 0.f};
    }
#pragma unroll
    for (int i = 0; i < 4; ++i) {
        const int kk = (tid >> 4) + 16 * i;
#pragma unroll
        for (int e = 0; e < 4; ++e) T[kk * 65 + n4 + e] = ld4[i][e];
    }
    __syncthreads();
    const int r2 = tid >> 2, ks = (tid & 3) * 16;
    u32x4 w0, w1;
    w0.x = pk2(T[(ks + 0) * 65 + r2], T[(ks + 1) * 65 + r2]); w0.y = pk2(T[(ks + 2) * 65 + r2], T[(ks + 3) * 65 + r2]);
    w0.z = pk2(T[(ks + 4) * 65 + r2], T[(ks + 5) * 65 + r2]); w0.w = pk2(T[(ks + 6) * 65 + r2], T[(ks + 7) * 65 + r2]);
    w1.x = pk2(T[(ks + 8) * 65 + r2], T[(ks + 9) * 65 + r2]); w1.y = pk2(T[(ks + 10) * 65 + r2], T[(ks + 11) * 65 + r2]);
    w1.z = pk2(T[(ks + 12) * 65 + r2], T[(ks + 13) * 65 + r2]); w1.w = pk2(T[(ks + 14) * 65 + r2], T[(ks + 15) * 65 + r2]);
    bf16_t* d = dst + (size_t)(r0 + r2) * J.K + k0 + ks;
    *(u32x4*)d = w0; *(u32x4*)(d + 8) = w1;
    __syncthreads();
}

DEVI void rms_row_bf16(const float* xr, const float* g, bf16_t* o, int lane) {
    f32x4 v[4]; float ss = 0.f;
#pragma unroll
    for (int i = 0; i < 4; ++i) { v[i] = *(const f32x4*)(xr + i * 256 + lane * 4); ss += v[i][0] * v[i][0] + v[i][1] * v[i][1] + v[i][2] * v[i][2] + v[i][3] * v[i][3]; }
    ss = wave_sum(ss);
    const float rs = rsqrtf(ss * (1.0f / 1024.0f) + RMS_EPS);
#pragma unroll
    for (int i = 0; i < 4; ++i) {
        const f32x4 gg = *(const f32x4*)(g + i * 256 + lane * 4);
        u32x2 w; w.x = pk2(v[i][0] * rs * gg[0], v[i][1] * rs * gg[1]); w.y = pk2(v[i][2] * rs * gg[2], v[i][3] * rs * gg[3]);
        *(u32x2*)(o + i * 256 + lane * 4) = w;
    }
}

DEVI void phase_prep(const Params& P, unsigned char* lds, int tid, int part) {
    unsigned char* ws = P.ws;
    const int lane = tid & 63, wid = __builtin_amdgcn_readfirstlane(tid >> 6);
    int base = 0;
#pragma unroll
    for (int j = 0; j < 10; ++j) {
        const bool early = (j == 0) || (j >= 4 && j <= 7);
        if (early == (part == 0)) {
            const int nt = tjob_tiles(j);
            const TJob J = get_tjob(P, j);
            for (int t = blockIdx.x; t < nt; t += gridDim.x) transpose_tile(J, t, lds, tid);
        }
    }
    (void)base;
    if (part == 1) {
        float* wr = (float*)(ws + OFF_WR);
        const float* g = P.in[13]; const float* wg = P.in[14]; const float* we = P.in[16];
        for (int e = blockIdx.x * NTHREADS + tid; e < 48 * 1024; e += gridDim.x * NTHREADS) {
            const int c = e >> 10, k = e & 1023;
            float v = 0.f;
            if (c < 4) v = wg[k * 4 + c]; else if (c < 36) v = we[k * 32 + (c - 4)];
            wr[e] = v * g[k];
        }
        return;
    }
    {
        const float* x = P.in[0]; const float* g = P.in[2]; bf16_t* hn = (bf16_t*)(ws + OFF_HN);
        for (int r = blockIdx.x * 4 + wid; r < NTOK; r += gridDim.x * 4) rms_row_bf16(x + (size_t)r * 1024, g, hn + (size_t)r * 1024, lane);
    }
    {
        f32x2* cs = (f32x2*)(ws + OFF_CS);
        for (int e = blockIdx.x * NTHREADS + tid; e < NTOK * 32; e += gridDim.x * NTHREADS) {
            const int tok = e >> 5, i = e & 31;
            const double a = (double)P.pos[tok] * P.inv_freq[i];
            double t = a * 0.15915494309189535;
            t -= floor(t);
            const float tf = (float)t;
            cs[e] = (f32x2){__builtin_amdgcn_cosf(tf), __builtin_amdgcn_sinf(tf)};
        }
    }
    {
        float* red = (float*)lds;
        for (int job = blockIdx.x; job < 32; job += gridDim.x) {
            const int kv = job >> 4, cg8 = job & 15;
            const float* pe = P.in[kv ? 7 : 4]; const float* w1 = P.in[kv ? 8 : 5];
            const int cc = tid & 7, jj = tid >> 3;
            float s = 0.f;
            for (int j = jj; j < 2048; j += 32) s += pe[j] * w1[(size_t)j * 128 + cg8 * 8 + cc];
            red[tid] = s;
            __syncthreads();
            if (tid < 8) { float t = 0.f; for (int u = 0; u < 32; ++u) t += red[u * 8 + tid]; ((float*)(ws + OFF_BIAS1))[kv * 128 + cg8 * 8 + tid] = t; }
            __syncthreads();
        }
    }
}

DEVI void st_bf16(bf16_t* p, float v) { *p = (bf16_t)f2bf(v); }

DEVI int gemm1_col_tile(int part, int i) {
    if (part == 0) return (i < 3) ? 4 + i : ((i < 5) ? 8 + i : 17);
    return (i < 4) ? i : ((i < 8) ? i + 3 : ((i < 12) ? i + 5 : i + 6));
}
template <int MR>
DEVI void gemm1_epilogue(const Params& P, const f32x4 (&acc)[MR][4], int c64, int tok0, int q, int cl) {
    unsigned char* ws = P.ws;
    const f32x2* cs = (const f32x2*)(ws + OFF_CS);
    if (c64 < 10 || (c64 >= 14 && c64 < 34)) {
        bool do_rope; float scale = 1.f; int kind;
        int g = 0, hk = 0;
        if (c64 < 8) { kind = 0; do_rope = true; scale = 0.125f * LOG2E; }
        else if (c64 == 8) { kind = 1; do_rope = true; }
        else if (c64 == 9) { kind = 2; do_rope = false; }
        else if (c64 < 22) { kind = 3; do_rope = true; scale = 0.125f * LOG2E; }
        else { kind = 4; g = (c64 - 22) >> 1; hk = (c64 - 22) & 1; do_rope = (g == 2 || g == 4); }
#pragma unroll
        for (int m = 0; m < MR; ++m) {
            const int tok = tok0 + m * 16;
            f32x4 o[4], nr[4];
#pragma unroll
            for (int n = 0; n < 4; ++n) { nr[n] = acc[m][n] * scale; o[n] = nr[n]; }
            if (do_rope) {
#pragma unroll
                for (int n = 0; n < 2; ++n) {
                    const f32x4 c01 = *(const f32x4*)(cs + (size_t)tok * 32 + n * 16 + q * 4);
                    const f32x4 c23 = *(const f32x4*)(cs + (size_t)tok * 32 + n * 16 + q * 4 + 2);
                    const float cc[4] = {c01[0], c01[2], c23[0], c23[2]}, sn[4] = {c01[1], c01[3], c23[1], c23[3]};
#pragma unroll
                    for (int j = 0; j < 4; ++j) {
                        const float x1 = nr[n][j], x2 = nr[n + 2][j];
                        o[n][j] = x1 * cc[j] - x2 * sn[j]; o[n + 2][j] = x1 * sn[j] + x2 * cc[j];
                    }
                }
            }
            if (kind == 0 || kind == 1 || kind == 2) {
                bf16_t* d = (kind == 0) ? (bf16_t*)(ws + OFF_QA) + (size_t)tok * 512 + c64 * 64 : (bf16_t*)(ws + (kind == 1 ? OFF_KA : OFF_VA)) + (size_t)tok * 64;
#pragma unroll
                for (int n = 0; n < 4; ++n) { u32x2 w; w.x = pk2(o[n][0], o[n][1]); w.y = pk2(o[n][2], o[n][3]); *(u32x2*)(d + n * 16 + q * 4) = w; }
            } else if (kind == 3) {
                const int h = c64 - 14;
                bf16_t* dn = (bf16_t*)(ws + OFF_QBN) + (size_t)tok * 512 + h * 64; bf16_t* dr = (bf16_t*)(ws + OFF_QBR) + (size_t)tok * 512 + h * 64;
#pragma unroll
                for (int n = 0; n < 4; ++n) {
                    u32x2 w; w.x = pk2(nr[n][0], nr[n][1]); w.y = pk2(nr[n][2], nr[n][3]); *(u32x2*)(dn + n * 16 + q * 4) = w;
                    u32x2 v; v.x = pk2(o[n][0], o[n][1]); v.y = pk2(o[n][2], o[n][3]); *(u32x2*)(dr + n * 16 + q * 4) = v;
                }
            } else {
                bf16_t* d = (bf16_t*)(ws + OFF_KV + (size_t)g * KV_STRIDE);
                const int b = tok >> 12, tl = tok & 4095;
                if (g == 3 || g == 5) {
#pragma unroll
                    for (int n = 0; n < 4; ++n)
#pragma unroll
                        for (int j = 0; j < 4; ++j) st_bf16(d + ((size_t)((b * 2 + hk) * 64 + n * 16 + q * 4 + j)) * 4096 + tl, o[n][j]);
                } else {
#pragma unroll
                    for (int n = 0; n < 4; ++n) { u32x2 w; w.x = pk2(o[n][0], o[n][1]); w.y = pk2(o[n][2], o[n][3]);
                        *(u32x2*)(d + ((size_t)((b * 2 + hk) * 4096 + tl)) * 64 + n * 16 + q * 4) = w; }
                }
            }
        }
    } else if (c64 >= 10 && c64 < 14) {
        bf16_t* d = (bf16_t*)(ws + OFF_QI);
#pragma unroll
        for (int m = 0; m < MR; ++m) {
            const int tok = tok0 + m * 16;
            float cc[4], sn[4];
#pragma unroll
            for (int j = 0; j < 4; ++j) { const f32x2 c = cs[(size_t)tok * 32 + 2 * (4 * q + j)]; cc[j] = c.x; sn[j] = c.y; }
#pragma unroll
            for (int hh = 0; hh < 2; ++hh) {
                const int head = 2 * (c64 - 10) + hh;
                f32x4 r1, r2;
#pragma unroll
                for (int j = 0; j < 4; ++j) { const float x1 = acc[m][2 * hh][j], x2 = acc[m][2 * hh + 1][j]; r1[j] = x1 * cc[j] - x2 * sn[j]; r2[j] = x1 * sn[j] + x2 * cc[j]; }
                u32x2 w; w.x = pk2(r1[0], r1[1]); w.y = pk2(r1[2], r1[3]); *(u32x2*)(d + (size_t)tok * 256 + head * 32 + q * 4) = w;
                u32x2 v; v.x = pk2(r2[0], r2[1]); v.y = pk2(r2[2], r2[3]); *(u32x2*)(d + (size_t)tok * 256 + head * 32 + 16 + q * 4) = v;
            }
        }
    } else if (c64 >= 36) {
        bf16_t* d = (bf16_t*)(ws + (c64 < 52 ? OFF_GA : OFF_GB));
        const int cb = (c64 < 52 ? c64 - 36 : c64 - 52) * 64;
#pragma unroll
        for (int m = 0; m < MR; ++m)
#pragma unroll
            for (int n = 0; n < 4; ++n) {
                u32x2 w; w.x = pk2(sigmoidf_(acc[m][n][0]), sigmoidf_(acc[m][n][1])); w.y = pk2(sigmoidf_(acc[m][n][2]), sigmoidf_(acc[m][n][3]));
                *(u32x2*)(d + (size_t)(tok0 + m * 16) * 1024 + cb + n * 16 + q * 4) = w;
            }
    } else if (c64 == 34) {
        bf16_t* dki = (bf16_t*)(ws + OFF_KI); float* dwi = (float*)(ws + OFF_WI); float* dg = (float*)(ws + OFF_GATES);
#pragma unroll
        for (int m = 0; m < MR; ++m) {
            const int tok = tok0 + m * 16;
            f32x4 r1, r2;
#pragma unroll
            for (int j = 0; j < 4; ++j) {
                const f32x2 c = cs[(size_t)tok * 32 + 2 * (4 * q + j)];
                const float x1 = acc[m][0][j], x2 = acc[m][1][j];
                r1[j] = x1 * c.x - x2 * c.y; r2[j] = x1 * c.y + x2 * c.x;
            }
            u32x2 w; w.x = pk2(r1[0], r1[1]); w.y = pk2(r1[2], r1[3]); *(u32x2*)(dki + (size_t)tok * 32 + q * 4) = w;
            u32x2 v; v.x = pk2(r2[0], r2[1]); v.y = pk2(r2[2], r2[3]); *(u32x2*)(dki + (size_t)tok * 32 + 16 + q * 4) = v;
            if (q < 2) *(f32x4*)(dwi + (size_t)tok * 8 + q * 4) = acc[m][2];
            else { f32x4 sv; for (int j = 0; j < 4; ++j) sv[j] = sigmoidf_(acc[m][2][j]); *(f32x4*)(dg + (size_t)tok * 24 + (q * 4 - 8)) = sv; }
            { f32x4 sv; for (int j = 0; j < 4; ++j) sv[j] = sigmoidf_(acc[m][3][j]); *(f32x4*)(dg + (size_t)tok * 24 + 8 + q * 4) = sv; }
        }
    }
}

DEVI void phase_gemm1(const Params& P, unsigned char* lds, int tid, int part) {
    const rsrc_t rs = __builtin_amdgcn_make_buffer_rsrc((void*)P.ws, (short)0, (int)0x7fffffff, 0x00020000);
    const int lane = tid & 63, wid = __builtin_amdgcn_readfirstlane(tid >> 6), wr = wid >> 1, wc = wid & 1, q = lane >> 4, cl = lane & 15;
    constexpr int NT_N = G1_COLS / 128;
    if (part == 0) {
        for (int kk = 0;; ++kk) {
            int mt, nti;
            if (!tile_map(kk, 6, mt, nti)) break;
            const int nt = gemm1_col_tile(0, nti);
            f32x4 acc[4][4];
            gemm128(acc, rs, (unsigned)(OFF_HN + (size_t)mt * 128 * 2048), RowLin{2048}, (unsigned)(OFF_WIN_T + (size_t)nt * 128 * 2048), RowLin{2048}, 16, lds, tid);
            gemm1_epilogue<4>(P, acc, nt * 2 + wc, mt * 128 + wr * 64 + cl, q, cl);
        }
    } else {
        for (int kk = 0;; ++kk) {
            int mt, nti;
            if (!tile_map(kk, NT_N - 6, mt, nti, 128)) break;
            const int nt = gemm1_col_tile(1, nti);
            f32x4 acc[8][4];
            gemm256(acc, rs, (unsigned)(OFF_HN + (size_t)mt * 256 * 2048), 2048u, (unsigned)(OFF_WIN_T + (size_t)nt * 128 * 2048), 2048u, 32, lds, tid);
            gemm1_epilogue<8>(P, acc, nt * 2 + wc, mt * 256 + wr * 128 + cl, q, cl);
        }
    }
}

DEVI float siluf_(float x) { return x * __builtin_amdgcn_rcpf(1.0f + __builtin_amdgcn_exp2f(-x * 1.4426950408889634f)); }

DEVI void phase_compress(const Params& P, unsigned char* lds, int tid) {
    unsigned char* ws = P.ws;
    const rsrc_t rs = __builtin_amdgcn_make_buffer_rsrc((void*)P.ws, (short)0, (int)0x7fffffff, 0x00020000);
    const int lane = tid & 63, wid = __builtin_amdgcn_readfirstlane(tid >> 6), wr = wid >> 1, wc = wid & 1, q = lane >> 4, cl = lane & 15;
    for (int u = blockIdx.x; u < 64; u += gridDim.x) {
        const int kv = u >> 5, mt = u & 31;
        const bf16_t* A = (const bf16_t*)(ws + OFF_KV + (size_t)kv * KV_STRIDE) + (size_t)mt * 128 * 1024;
        const bf16_t* W1 = (const bf16_t*)(ws + (kv ? OFF_W1V : OFF_W1K));
        const bf16_t* W2 = (const bf16_t*)(ws + (kv ? OFF_W2V : OFF_W2K));
        const float* bias = (const float*)(ws + OFF_BIAS1) + kv * 128;
        f32x4 acc[4][4];
        gemm128(acc, rs, (unsigned)(OFF_KV + (size_t)kv * KV_STRIDE + (size_t)mt * 128 * 2048), RowLin{2048}, (unsigned)(kv ? OFF_W1V : OFF_W1K), RowLin{4096}, 32, lds, tid);
#pragma unroll
        for (int m = 0; m < 4; ++m)
#pragma unroll
            for (int n = 0; n < 4; ++n) {
                const int col = wc * 64 + n * 16 + q * 4, row = wr * 64 + m * 16 + cl;
                const f32x4 bb = *(const f32x4*)(bias + col);
                const int ktile = col >> 6, ch = (col & 63) >> 3, wi = col & 7;
                u32x2 w; w.x = pk2(siluf_(acc[m][n][0] + bb[0]), siluf_(acc[m][n][1] + bb[1])); w.y = pk2(siluf_(acc[m][n][2] + bb[2]), siluf_(acc[m][n][3] + bb[3]));
                *(u32x2*)(lds + ktile * 16384 + row * 128 + ((ch ^ (row & 7)) << 4) + wi * 2) = w;
            }
#pragma unroll
        for (int i = 0; i < 4; ++i) {
            const int idx = tid + 256 * i;
            const int row = idx >> 4, ch16 = idx & 15, ktile = ch16 >> 3, ch = ch16 & 7;
            *(u32x4*)(lds + 32768 + ktile * 8192 + row * 128 + ((ch ^ (row & 7)) << 4)) = *(const u32x4*)(W2 + (size_t)row * 128 + ch16 * 8);
        }
        __syncthreads();
        f32x4 a2[4][2];
#pragma unroll
        for (int m = 0; m < 4; ++m) { a2[m][0] = (f32x4){0.f, 0.f, 0.f, 0.f}; a2[m][1] = (f32x4){0.f, 0.f, 0.f, 0.f}; }
#pragma unroll
        for (int kk = 0; kk < 4; ++kk) {
            const int ktile = kk >> 1, ks = kk & 1;
            bf16x8 a[4], b[2];
#pragma unroll
            for (int m = 0; m < 4; ++m) { const int row = wr * 64 + m * 16 + cl; a[m] = *(const bf16x8*)(lds + ktile * 16384 + row * 128 + (((ks * 4 + q) ^ (row & 7)) << 4)); }
#pragma unroll
            for (int n = 0; n < 2; ++n) { const int row = wc * 32 + n * 16 + cl; b[n] = *(const bf16x8*)(lds + 32768 + ktile * 8192 + row * 128 + (((ks * 4 + q) ^ (row & 7)) << 4)); }
#pragma unroll
            for (int m = 0; m < 4; ++m)
#pragma unroll
                for (int n = 0; n < 2; ++n) a2[m][n] = MFMA16(b[n], a[m], a2[m][n]);
        }
#pragma unroll
        for (int m = 0; m < 4; ++m)
#pragma unroll
            for (int n = 0; n < 2; ++n) {
                const int d = wc * 32 + n * 16 + q * 4;
                const int r = mt * 128 + wr * 64 + m * 16 + cl;
                const bool dead = ((r & 255) == 255);
                float v[4];
#pragma unroll
                for (int j = 0; j < 4; ++j) v[j] = dead ? 0.f : a2[m][n][j];
                if (kv == 0) {
                    bf16_t* kc = (bf16_t*)(ws + OFF_KC);
                    u32x2 w; w.x = pk2(v[0], v[1]); w.y = pk2(v[2], v[3]);
                    *(u32x2*)(kc + (size_t)r * 64 + d) = w;
                } else {
                    bf16_t* vct = (bf16_t*)(ws + OFF_VCT);
#pragma unroll
                    for (int j = 0; j < 4; ++j) st_bf16(vct + ((size_t)((r >> 8) * 64 + d + j)) * 256 + (r & 255), v[j]);
                }
            }
        __syncthreads();
    }
}

DEVI void phase_index(const Params& P, unsigned char* lds, int tid) {
    unsigned char* ws = P.ws;
    const bf16_t* QI = (const bf16_t*)(ws + OFF_QI);
    const bf16_t* KI = (const bf16_t*)(ws + OFF_KI);
    const float* WI = (const float*)(ws + OFF_WI);
    bf16_t* SEL = (bf16_t*)(ws + OFF_SEL);
    float* S = (float*)lds;
    const int lane = tid & 63, wid = __builtin_amdgcn_readfirstlane(tid >> 6), q = lane >> 4, cl = lane & 15;
    for (int u = blockIdx.x; u < NTOK / 4; u += gridDim.x) {
        const int b = u >> 10, w10 = u & 1023, s10 = (w10 < 512) ? w10 : 1535 - w10;
        const int t0 = s10 * 4, tok0 = b * 4096 + t0;
        const int t = t0 + wid;
        const int tok = tok0 + wid;
        if (t0 + 3 < 256) {
            for (int i = lane; i < 256; i += 64) SEL[(size_t)tok * 256 + i] = (bf16_t)(i <= t ? i : 0);
            continue;
        }
        {
            bf16x8 a[2];
#pragma unroll
            for (int hg = 0; hg < 2; ++hg) a[hg] = *(const bf16x8*)(QI + (size_t)(tok0 + (cl >> 2)) * 256 + (4 * hg + (cl & 3)) * 32 + q * 8);
            const f32x4 w0 = *(const f32x4*)(WI + (size_t)(tok0 + q) * 8), w1 = *(const f32x4*)(WI + (size_t)(tok0 + q) * 8 + 4);
            const int ktmax = (t0 + 3) >> 4;
            const bf16_t* kb = KI + (size_t)b * 4096 * 32 + cl * 32 + q * 8;
            for (int kt0 = wid; kt0 <= ktmax; kt0 += 16) {
                bf16x8 bk[4];
#pragma unroll
                for (int uu = 0; uu < 4; ++uu) { const int kt = (kt0 + 4 * uu <= ktmax) ? kt0 + 4 * uu : kt0; bk[uu] = *(const bf16x8*)(kb + (size_t)kt * 16 * 32); }
#pragma unroll
                for (int uu = 0; uu < 4; ++uu) {
                    const int kt = kt0 + 4 * uu;
                    f32x4 c0 = {0.f, 0.f, 0.f, 0.f}, c1 = {0.f, 0.f, 0.f, 0.f};
                    c0 = MFMA16(a[0], bk[uu], c0); c1 = MFMA16(a[1], bk[uu], c1);
                    float sc = 0.f;
#pragma unroll
                    for (int j = 0; j < 4; ++j) { sc += w0[j] * fmaxf(c0[j], 0.f); sc += w1[j] * fmaxf(c1[j], 0.f); }
                    if (kt <= ktmax) S[q * 4096 + kt * 16 + cl] = sc;
                }
            }
        }
        __syncthreads();
        {
            const int n = t + 1;
            const float* Sq = S + wid * 4096;
            if (n <= 256) {
                for (int i = lane; i < 256; i += 64) SEL[(size_t)tok * 256 + i] = (bf16_t)(i <= t ? i : 0);
            } else {
                const int nr = (n + 63) >> 6;
                float x[64];
                const float NINF = -__builtin_inff();
                float mx = NINF, mn = __builtin_inff();
#pragma unroll
                for (int r = 0; r < 64; ++r) {
                    const int key = r * 64 + lane;
                    const float v = Sq[key];
                    x[r] = (key < n) ? v : NINF;
                    mn = fminf(mn, (key < n) ? v : __builtin_inff());
                    mx = fmaxf(mx, x[r]);
                }
#pragma unroll
                for (int o = 32; o > 0; o >>= 1) { mx = fmaxf(mx, __shfl_xor(mx, o)); mn = fminf(mn, __shfl_xor(mn, o)); }
                float lo = mn, hi = mx, T; int need;
                int chi = 0, clo = n;
#define COUNT_GE(dst, thr) do { int c_ = 0; _Pragma("unroll") for (int g8 = 0; g8 < 8; ++g8) if (g8 * 8 < nr) { \
        _Pragma("unroll") for (int r = g8 * 8; r < g8 * 8 + 8; ++r) c_ += __popcll(__ballot(x[r] >= (thr))); } (dst) = c_; } while (0)
                COUNT_GE(chi, hi);
                if (chi >= 256) { T = hi; need = 256;   }
                else {
                    float s1 = 0.f, s2 = 0.f;
#pragma unroll
                    for (int g8 = 0; g8 < 8; ++g8) if (g8 * 8 < nr) {
#pragma unroll
                        for (int r = g8 * 8; r < g8 * 8 + 8; ++r) { const float v = (x[r] == NINF) ? 0.f : x[r]; s1 += v; s2 += v * v; }
                    }
                    s1 = wave_sum_f32_dpp(s1); s2 = wave_sum_f32_dpp(s2);
                    const float fn = (float)n, mu = s1 / fn;
                    const float sg = sqrtf(fmaxf(s2 / fn - mu * mu, 1e-20f));
                    float vg;
                    {
                        const float pq = 256.0f / fn, pp = fminf(pq, 1.0f - pq);
                        const float tt = sqrtf(-2.0f * __logf(fmaxf(pp, 1e-6f)));
                        const float zz = tt - (2.515517f + 0.802853f * tt + 0.010328f * tt * tt) / (1.0f + 1.432788f * tt + 0.189269f * tt * tt + 0.001308f * tt * tt * tt);
                        vg = mu + ((pq <= 0.5f) ? zz : -zz) * sg;
                    }
                    bool found = false, adjacent = false; float thr = 0.f;
                    for (int it = 0; it < 160; ++it) {
                        if (clo - chi <= 64) break;
                        const float mid = 0.5f * lo + 0.5f * hi;
                        if (!(mid > lo && mid < hi)) { adjacent = true; break; }
                        float v = vg;
                        if (!(v > lo && v < hi) || (it & 3) == 3) v = mid;
                        int c; COUNT_GE(c, v);
                        if (c == 256) { found = true; thr = v; break; }
                        if (c > 256) { lo = v; clo = c; } else { hi = v; chi = c; }
                        const float zv = (v - mu) / sg;
                        const float dens = fmaxf(fn * 0.39894228f * __expf(-0.5f * zv * zv), 0.5f) / sg;
                        vg = v + ((float)c - ((c > 256) ? 244.0f : 268.0f)) / dens;
                    }
                    if (found) { T = thr; need = -1; }
                    else if (adjacent) { T = lo; need = 256 - chi; }
                    else {
                        float* cand = (float*)(lds + 65536) + wid * 64;
                        cand[lane] = NINF;
                        int cb = 0;
                        const unsigned long long ltm = (1ull << lane) - 1ull;
#pragma unroll
                        for (int g8 = 0; g8 < 8; ++g8) if (g8 * 8 < nr) {
#pragma unroll
                            for (int r = g8 * 8; r < g8 * 8 + 8; ++r) {
                                const bool isc = (x[r] >= lo) && (x[r] < hi);
                                const unsigned long long bm = __ballot(isc);
                                if (bm != 0ull) {
                                    if (isc) cand[cb + __popcll(bm & ltm)] = x[r];
                                    cb += __popcll(bm);
                                }
                            }
                        }
                        const float y = cand[lane];
                        int cgt = 0, cge = 0;
#pragma unroll
                        for (int k = 0; k < 64; ++k) { const float yk = __builtin_bit_cast(float, __builtin_amdgcn_readlane(__builtin_bit_cast(int, y), k)); cgt += (yk > y) ? 1 : 0; cge += (yk >= y) ? 1 : 0; }
                        const int nd = 256 - chi;
                        const bool isT = (y != NINF) && (cgt <= nd - 1) && (cge >= nd);
                        const unsigned long long tm = __ballot(isT);
                        const int tl = (tm != 0ull) ? (int)__builtin_ctzll(tm) : 0;
                        T = __shfl(y, tl);
                        need = nd - __shfl(cgt, tl);
                    }
                }
                bf16_t* selb = (bf16_t*)(lds + 65536 + 1024) + wid * 256;
                int wlo = 0, whi = 0, tot = 0;
#pragma unroll
                for (int g8 = 0; g8 < 8; ++g8) if (g8 * 8 < nr) {
#pragma unroll
                    for (int r = g8 * 8; r < g8 * 8 + 8; ++r) {
                        const unsigned long long m = __ballot(x[r] >= T);
                        tot += __popcll(m);
                        asm volatile("v_writelane_b32 %0, %1, %2" : "+v"(wlo) : "s"((unsigned)m), "n"(r));
                        asm volatile("v_writelane_b32 %0, %1, %2" : "+v"(whi) : "s"((unsigned)(m >> 32)), "n"(r));
                    }
                }
                if (tot == 256) {
                    const int cw = __popc((unsigned)wlo) + __popc((unsigned)whi);
                    int pos = 0;
#pragma unroll
                    for (int bb = 0; bb < 7; ++bb) {
                        const unsigned long long bmk = __ballot(((cw >> bb) & 1) != 0);
                        pos += (int)__builtin_amdgcn_mbcnt_hi((unsigned)(bmk >> 32), __builtin_amdgcn_mbcnt_lo((unsigned)bmk, 0u)) << bb;
                    }
                    unsigned long long w = ((unsigned long long)(unsigned)whi << 32) | (unsigned long long)(unsigned)wlo;
                    while (w != 0ull) {
                        const int bpos = (int)__builtin_ctzll(w);
                        selb[pos++] = (bf16_t)(lane * 64 + bpos);
                        w &= w - 1ull;
                    }
                } else {
                    if (need < 0) need = 0x7fffffff;
                    int base = 0, eqc = 0;
                    const unsigned long long lt = (1ull << lane) - 1ull;
#pragma unroll
                    for (int g8 = 0; g8 < 8; ++g8) if (g8 * 8 < nr) {
#pragma unroll
                        for (int r = g8 * 8; r < g8 * 8 + 8; ++r) {
                            const bool eq = (x[r] == T);
                            const unsigned long long em = __ballot(eq);
                            const bool sel = (x[r] > T) || (eq && (eqc + __popcll(em & lt) < need));
                            eqc += __popcll(em);
                            const unsigned long long sm = __ballot(sel);
                            if (sel) { const int pp = base + __popcll(sm & lt); if (pp < 256) selb[pp] = (bf16_t)(r * 64 + lane); }
                            base += __popcll(sm);
                        }
                    }
                }
                __builtin_amdgcn_wave_barrier();
                if (lane < 32) *(u32x4*)(SEL + (size_t)tok * 256 + lane * 8) = *(const u32x4*)(selb + lane * 8);
                __builtin_amdgcn_wave_barrier();
            }
        }
        __syncthreads();
    }
}

DEVI int dsa_vswz(int row) { return (((row >> 1) & 1) << 1) | (((row >> 3) & 1) << 2); }
DEVI void phase_dsa(const Params& P, unsigned char* lds, int tid) {
    unsigned char* ws = P.ws;
    const bf16_t* QA = (const bf16_t*)(ws + OFF_QA);
    const bf16_t* KA = (const bf16_t*)(ws + OFF_KA);
    const bf16_t* VA = (const bf16_t*)(ws + OFF_VA);
    const bf16_t* SEL = (const bf16_t*)(ws + OFF_SEL);
    bf16_t* OA = (bf16_t*)(ws + OFF_OA);
    const int lane = tid & 63, wid = __builtin_amdgcn_readfirstlane(tid >> 6), q = lane >> 4, cl = lane & 15;
    unsigned char* vl0 = lds + wid * 16384;
    const rsrc_t rsd = __builtin_amdgcn_make_buffer_rsrc((void*)P.ws, (short)0, (int)0x7fffffff, 0x00020000);
    const float NINF = -__builtin_inff();
    const int stride = gridDim.x * 4;
    int tok = blockIdx.x * 4 + wid;
    if (tok >= NTOK) return;
    int kidx[16], mk[4]; bf16x8 bq[2];
    {
        const bf16_t* sel = SEL + (size_t)tok * 256;
#pragma unroll
        for (int rf = 0; rf < 16; ++rf) kidx[rf] = sel[32 * (rf >> 1) + 8 * (cl >> 2) + 4 * (rf & 1) + (cl & 3)];
#pragma unroll
        for (int cc = 0; cc < 4; ++cc) mk[cc] = sel[cc * 64 + lane];
#pragma unroll
        for (int ks = 0; ks < 2; ++ks) bq[ks] = *(const bf16x8*)(QA + (size_t)tok * 512 + (cl & 7) * 64 + ks * 32 + q * 8);
    }
    const int wrow = lane >> 3;
    for (; tok < NTOK; tok += stride) {
        const int b = tok >> 12, t = tok & 4095;
        const int cnt = (t + 1 < 256) ? t + 1 : 256;
        const int nc64 = (cnt + 63) >> 6;
        const bf16_t* kb = KA + (size_t)b * 4096 * 64;
        const bf16_t* vb = VA + (size_t)b * 4096 * 64;
        const bf16x8 zero8 = {0, 0, 0, 0, 0, 0, 0, 0};
        const bf16x8 bq0 = (cl < 8) ? bq[0] : zero8, bq1 = (cl < 8) ? bq[1] : zero8;
        const unsigned sVb = (unsigned)OFF_VA + (unsigned)b * 4096u * 128u;
#pragma unroll
        for (int i = 0; i < 8; ++i) {
            const int row = wrow + 8 * i; const int key = __shfl(mk[0], row);
            glds16(rsd, vl0 + i * 1024, (unsigned)key * 128u + (unsigned)(((lane & 7) ^ dsa_vswz(row)) << 4), sVb);
        }
        f32x4 s[16];
#pragma unroll
        for (int rf = 0; rf < 16; ++rf) {
            s[rf] = (f32x4){0.f, 0.f, 0.f, 0.f};
            if ((rf >> 2) < nc64) {
                const bf16_t* kr = kb + (size_t)kidx[rf] * 64 + q * 8;
                const bf16x8 a0 = *(const bf16x8*)(kr), a1 = *(const bf16x8*)(kr + 32);
                s[rf] = MFMA16(a0, bq0, s[rf]); s[rf] = MFMA16(a1, bq1, s[rf]);
            }
            if ((rf & 3) == 3) asm volatile("" ::: "memory");
        }
        int mkc[4];
#pragma unroll
        for (int cc = 0; cc < 4; ++cc) mkc[cc] = mk[cc];
        {
            const int tn = (tok + stride < NTOK) ? tok + stride : tok;
            const bf16_t* sel = SEL + (size_t)tn * 256;
#pragma unroll
            for (int rf = 0; rf < 16; ++rf) kidx[rf] = sel[32 * (rf >> 1) + 8 * (cl >> 2) + 4 * (rf & 1) + (cl & 3)];
#pragma unroll
            for (int cc = 0; cc < 4; ++cc) mk[cc] = sel[cc * 64 + lane];
#pragma unroll
            for (int ks = 0; ks < 2; ++ks) bq[ks] = *(const bf16x8*)(QA + (size_t)tn * 512 + (cl & 7) * 64 + ks * 32 + q * 8);
        }
        float mx = NINF;
#pragma unroll
        for (int rf = 0; rf < 16; ++rf)
#pragma unroll
            for (int j = 0; j < 4; ++j) {
                const int p = 32 * (rf >> 1) + 8 * q + 4 * (rf & 1) + j;
                if (p >= cnt) s[rf][j] = NINF;
                mx = fmaxf(mx, s[rf][j]);
            }
        mx = rows_max(mx);
        float ls = 0.f;
#pragma unroll
        for (int rf = 0; rf < 16; ++rf)
#pragma unroll
            for (int j = 0; j < 4; ++j) { const float pv = __builtin_amdgcn_exp2f(s[rf][j] - mx); s[rf][j] = pv; ls += pv; }
        ls = rows_sum(ls);
        const float inv = __builtin_amdgcn_rcpf(ls);
        bf16x8 pbs[8];
#pragma unroll
        for (int c8 = 0; c8 < 8; ++c8) pbs[c8] = pack8(s[2 * c8], s[2 * c8 + 1]);
        f32x4 o[4];
#pragma unroll
        for (int d = 0; d < 4; ++d) o[d] = (f32x4){0.f, 0.f, 0.f, 0.f};
#pragma unroll
        for (int cc = 0; cc < 4; ++cc) {
            if (cc < nc64) {
                unsigned char* vl = vl0 + (cc & 1) * 8192;
                asm volatile("s_waitcnt vmcnt(0)" ::: "memory");
                __builtin_amdgcn_wave_barrier();
                if (cc + 1 < 4 && cc + 1 < nc64) {
                    unsigned char* vn = vl0 + ((cc + 1) & 1) * 8192;
#pragma unroll
                    for (int i = 0; i < 8; ++i) {
                        const int row = wrow + 8 * i; const int key = __shfl(mkc[(cc + 1) & 3], row);
                        glds16(rsd, vn + i * 1024, (unsigned)key * 128u + (unsigned)(((lane & 7) ^ dsa_vswz(row)) << 4), sVb);
                    }
                }
#pragma unroll
                for (int c2 = 0; c2 < 2; ++c2) {
                    const bf16x8 pb = pbs[cc * 2 + c2];
#pragma unroll
                    for (int d = 0; d < 4; ++d) {
                        const int r0 = c2 * 32 + 8 * q + (cl >> 2), r1 = r0 + 4;
                        const int ch = d * 2 + ((cl & 3) >> 1), wb = 8 * (cl & 1);
                        const s16x4 lo4 = __builtin_amdgcn_ds_read_tr16_b64_v4i16((LAS s16x4*)((LAS unsigned char*)(vl) + r0 * 128 + ((ch ^ dsa_vswz(r0)) << 4) + wb));
                        const s16x4 hi4 = __builtin_amdgcn_ds_read_tr16_b64_v4i16((LAS s16x4*)((LAS unsigned char*)(vl) + r1 * 128 + ((ch ^ dsa_vswz(r1)) << 4) + wb));
                        const bf16x8 av = {lo4[0], lo4[1], lo4[2], lo4[3], hi4[0], hi4[1], hi4[2], hi4[3]};
                        o[d] = MFMA16(av, pb, o[d]);
                    }
                }
            }
        }
        if (cl < 8) {
#pragma unroll
            for (int d = 0; d < 4; ++d) {
                u32x2 w; w.x = pk2(o[d][0] * inv, o[d][1] * inv); w.y = pk2(o[d][2] * inv, o[d][3] * inv);
                *(u32x2*)(OA + (size_t)tok * 512 + cl * 64 + d * 16 + q * 4) = w;
            }
        }
    }
}

DEVI int fK(int row) { return (row & 3) | (((row >> 3) & 1) << 2); }

struct AttnState { f32x4 O[4][4]; float m[4]; float l[4]; };

template <int MODE>
DEVI void attn_blocks(rsrc_t rs, unsigned sK, unsigned sV, int ldv, int jb0, int jb1, const bf16x8 (&qf)[4][2], AttnState& st,
                      int tq, unsigned long long selmask, unsigned char* lds, int tid) {
    const int lane = tid & 63, q = lane >> 4, cl = lane & 15;
    const float NINF = -__builtin_inff();
#pragma unroll
    for (int cf = 0; cf < 4; ++cf) { st.m[cf] = NINF; st.l[cf] = 0.f;
#pragma unroll
        for (int d = 0; d < 4; ++d) st.O[d][cf] = (f32x4){0.f, 0.f, 0.f, 0.f}; }
    if (jb1 < jb0) return;
    const int wid_ = __builtin_amdgcn_readfirstlane(tid >> 6);
    unsigned kro[2], vro[2];
#pragma unroll
    for (int i = 0; i < 2; ++i) {
        const int row = (wid_ * 2 + i) * 8 + (lane >> 3);
        kro[i] = (unsigned)(row * 64 + (((lane & 7) ^ fK(row)) << 3)) * 2u;
        vro[i] = (unsigned)(row * ldv + (((lane & 7) ^ (row & 7)) << 3)) * 2u;
    }
    unsigned char* wk = lds + wid_ * 2048;
#pragma unroll
    for (int i = 0; i < 2; ++i) { glds16(rs, wk + i * 1024, kro[i], sK + (unsigned)jb0 * 8192u); glds16(rs, wk + 8192 + i * 1024, vro[i], sV + (unsigned)jb0 * 128u); }
    __syncthreads();
    const int nmax = (tq >= 31) ? ((tq - 31) >> 4) : -1;
    for (int jb = jb0; jb <= jb1; ++jb) {
        unsigned char* cur = lds + ((jb - jb0) & 1) * 16384;
        const bool more = jb < jb1;
        if (more) {
            unsigned char* wn = wk + ((jb - jb0 + 1) & 1) * 16384;
#pragma unroll
            for (int i = 0; i < 2; ++i) { glds16(rs, wn + i * 1024, kro[i], sK + (unsigned)(jb + 1) * 8192u); glds16(rs, wn + 8192 + i * 1024, vro[i], sV + (unsigned)(jb + 1) * 128u); }
        }
        bool lane_on = true;
        if (MODE == 1) lane_on = ((selmask >> jb) & 1ull) != 0ull;
        if (MODE == 0) lane_on = (jb * 64 <= nmax);
        if (MODE == 2) lane_on = (jb * 64 + 63 > tq - 512);
        if (__ballot(lane_on) != 0ull) {
#pragma unroll
            for (int c = 0; c < 2; ++c) {
                f32x4 S[2][4];
#pragma unroll
                for (int r2 = 0; r2 < 2; ++r2)
#pragma unroll
                    for (int cf = 0; cf < 4; ++cf) S[r2][cf] = (f32x4){0.f, 0.f, 0.f, 0.f};
#pragma unroll
                for (int r2 = 0; r2 < 2; ++r2) {
                    const int kl = 32 * c + 8 * (cl >> 2) + 4 * r2 + (cl & 3);
#pragma unroll
                    for (int ks = 0; ks < 2; ++ks) {
                        const bf16x8 a = *(const bf16x8*)(cur + kl * 128 + (((ks * 4 + q) ^ (cl & 7)) << 4));
#pragma unroll
                        for (int cf = 0; cf < 4; ++cf) S[r2][cf] = MFMA16(a, qf[cf][ks], S[r2][cf]);
                    }
                }
                bool edge;
                if (MODE == 0) edge = (jb * 64 + 63 > nmax);
                else if (MODE == 1) edge = (jb * 64 + 63 > tq) || !lane_on;
                else edge = (jb * 64 + 63 > tq) || (jb * 64 <= tq - 512);
                const bool need_mask = __ballot(edge) != 0ull;
                bf16x8 pb[4];
#pragma unroll
                for (int cf = 0; cf < 4; ++cf) {
                    if (need_mask) {
#pragma unroll
                        for (int r2 = 0; r2 < 2; ++r2)
#pragma unroll
                            for (int j = 0; j < 4; ++j) {
                                const int key = jb * 64 + 32 * c + 8 * q + 4 * r2 + j;
                                bool v;
                                if (MODE == 0) v = key <= nmax;
                                else if (MODE == 1) v = lane_on && key <= tq;
                                else v = key <= tq && key > tq - 512;
                                if (!v) S[r2][cf][j] = NINF;
                            }
                    }
                    const float bml = fmaxf(fmaxf(fmaxf(S[0][cf][0], S[0][cf][1]), fmaxf(S[0][cf][2], S[0][cf][3])), fmaxf(fmaxf(S[1][cf][0], S[1][cf][1]), fmaxf(S[1][cf][2], S[1][cf][3])));
                    if (__ballot(bml > st.m[cf] + 8.0f) != 0ull) {
                        const float bm = rows_max(bml);
                        const float mnew = fmaxf(st.m[cf], bm);
                        const float mr0 = (mnew == NINF) ? 0.f : mnew;
                        const float alpha = __builtin_amdgcn_exp2f(st.m[cf] - mr0);
                        st.m[cf] = mnew;
                        st.l[cf] *= alpha;
#pragma unroll
                        for (int d = 0; d < 4; ++d) st.O[d][cf] *= alpha;
                    }
                    const float mref = (st.m[cf] == NINF) ? 0.f : st.m[cf];
                    float ps = 0.f;
#pragma unroll
                    for (int r2 = 0; r2 < 2; ++r2)
#pragma unroll
                        for (int j = 0; j < 4; ++j) { const float pv = __builtin_amdgcn_exp2f(S[r2][cf][j] - mref); S[r2][cf][j] = pv; ps += pv; }
                    st.l[cf] += ps;
                    pb[cf] = pack8(S[0][cf], S[1][cf]);
                }
#pragma unroll
                for (int d = 0; d < 4; ++d) {
                    const int row = d * 16 + cl;
                    const bf16x8 av = *(const bf16x8*)(cur + 8192 + row * 128 + (((c * 4 + q) ^ (row & 7)) << 4));
#pragma unroll
                    for (int cf = 0; cf < 4; ++cf) st.O[d][cf] = MFMA16(av, pb[cf], st.O[d][cf]);
                }
            }
        }
        __syncthreads();
    }
}

DEVI f32x4 bload16f(rsrc_t r, unsigned voff, unsigned soff) { return __builtin_bit_cast(f32x4, __builtin_amdgcn_raw_buffer_load_b128(r, (int)voff, (int)soff, 0)); }
DEVI void bstore16f(rsrc_t r, f32x4 v, unsigned voff, unsigned soff) { __builtin_amdgcn_raw_buffer_store_b128(__builtin_bit_cast(u32x4, v), r, (int)voff, (int)soff, 0); }
DEVI float bload4f(rsrc_t r, unsigned voff, unsigned soff) { return __builtin_bit_cast(float, __builtin_amdgcn_raw_buffer_load_b32(r, (int)voff, (int)soff, 0)); }

struct NsaUnit { int i, b, k, t0, tq; unsigned tokw, tokb, qoff, goff, ooff, sQ, sG, sO; };
DEVI NsaUnit nsa_unit(int uu, int tid) {
    NsaUnit U;
    const int lane = tid & 63, wid = __builtin_amdgcn_readfirstlane(tid >> 6), q = lane >> 4, cl = lane & 15;
    const int half = uu >> 9, r = uu & 511, bk = r & 15, ii = r >> 4;
    U.i = half ? ii : 63 - ii; U.b = bk >> 1; U.k = bk & 1;
    U.t0 = U.i * 64; U.tq = U.t0 + wid * 16 + cl;
    U.tokw = (unsigned)(wid * 16 + cl);
    U.tokb = (unsigned)(U.b * 4096 + U.t0);
    U.qoff = U.tokw * 1024u + (unsigned)q * 16u;
    U.goff = U.tokw * 96u;
    U.ooff = U.tokw * 1024u + (unsigned)q * 8u;
    U.sQ = U.tokb * 1024u + (unsigned)U.k * 512u;
    U.sG = (unsigned)OFF_GATES + U.tokb * 96u + (unsigned)U.k * 16u;
    U.sO = (unsigned)OFF_OB + U.tokb * 1024u + (unsigned)U.k * 512u;
    return U;
}

DEVI void nsa_cmp_unit(const Params& P, rsrc_t rs, int uu, unsigned char* lds, int tid) {
    const int lane = tid & 63, wid = __builtin_amdgcn_readfirstlane(tid >> 6), q = lane >> 4, cl = lane & 15;
    const NsaUnit U = nsa_unit(uu, tid);
    const int i = U.i, b = U.b, k = U.k, tq = U.tq;
    AttnState st;
    bf16x8 qf[4][2];
#pragma unroll
    for (int cf = 0; cf < 4; ++cf)
#pragma unroll
        for (int ks = 0; ks < 2; ++ks) qf[cf][ks] = __builtin_bit_cast(bf16x8, bload16(rs, U.qoff, (unsigned)OFF_QBN + U.sQ + cf * 128 + ks * 64));
    const unsigned sKC = (unsigned)OFF_KC + (unsigned)(b * 2 + k) * 256u * 128u;
    const unsigned sVC = (unsigned)OFF_VCT + (unsigned)(b * 2 + k) * 64u * 512u;
    const int nmax_blk = (U.t0 + 63 - 31) >> 4;
    const int jbc = (nmax_blk >> 6) < 3 ? (nmax_blk >> 6) : 3;
    attn_blocks<0>(rs, sKC, sVC, 256, 0, jbc, qf, st, tq, 0ull, lds, tid);
    float linv[4], mfin[4];
#pragma unroll
    for (int cf = 0; cf < 4; ++cf) {
        const float l = rows_sum(st.l[cf]);
        linv[cf] = (l > 0.f) ? __builtin_amdgcn_rcpf(l) : 0.f; mfin[cf] = st.m[cf];
        const float sc = linv[cf] * bload4f(rs, U.goff, U.sG + cf * 4);
#pragma unroll
        for (int d = 0; d < 4; ++d) { const f32x4 v = st.O[d][cf] * sc; u32x2 w; w.x = pk2(v[0], v[1]); w.y = pk2(v[2], v[3]);
            __builtin_amdgcn_raw_buffer_store_b64(w, rs, (int)U.ooff, (int)(U.sO + cf * 128 + d * 32), 0); }
    }
    unsigned long long* MSKG = (unsigned long long*)(P.ws + OFF_MASK);
    if (i < 16) {
        if (q == 0) MSKG[((size_t)(b * 2 + k)) * 4096 + tq] = (2ull << i) - 1ull;
        return;
    }
    float* SUM4 = (float*)(lds + 16384);
    float* LAST = (float*)(lds + 32768);
    float* IMP2 = (float*)(lds + 49152);
    const int nmax = (tq >= 31) ? ((tq - 31) >> 4) : -1;
    for (int kb = 0; kb <= jbc; ++kb) {
#pragma unroll
        for (int ii = 0; ii < 2; ++ii) {
            const int idx = tid + 256 * ii, row = idx >> 3, ch = idx & 7;
            *(u32x4*)(lds + row * 128 + ((ch ^ fK(row)) << 4)) = bload16(rs, (unsigned)(row * 64 + ch * 8) * 2u, sKC + (unsigned)kb * 8192u);
        }
        __syncthreads();
#pragma unroll
        for (int rf = 0; rf < 4; ++rf) {
            f32x4 S[4];
#pragma unroll
            for (int cf = 0; cf < 4; ++cf) S[cf] = (f32x4){0.f, 0.f, 0.f, 0.f};
            const int kl = 32 * (rf >> 1) + 8 * (cl >> 2) + 4 * (rf & 1) + (cl & 3);
#pragma unroll
            for (int ks = 0; ks < 2; ++ks) {
                const bf16x8 a = *(const bf16x8*)(lds + kl * 128 + (((ks * 4 + q) ^ (cl & 7)) << 4));
#pragma unroll
                for (int cf = 0; cf < 4; ++cf) S[cf] = MFMA16(a, qf[cf][ks], S[cf]);
            }
            float acc4 = 0.f, accl = 0.f;
#pragma unroll
            for (int j = 0; j < 4; ++j) {
                const int key = kb * 64 + 32 * (rf >> 1) + 8 * q + 4 * (rf & 1) + j;
                float pj = 0.f;
#pragma unroll
                for (int cf = 0; cf < 4; ++cf) pj += __builtin_amdgcn_exp2f(S[cf][j] - mfin[cf]) * linv[cf];
                pj = (key <= nmax) ? pj : 0.f;
                acc4 += pj; if (j == 3) accl = pj;
            }
            const int jblk = kb * 16 + 8 * (rf >> 1) + 2 * q + (rf & 1);
            SUM4[(wid * 16 + cl) * 64 + jblk] = acc4; LAST[(wid * 16 + cl) * 64 + jblk] = accl;
        }
        __syncthreads();
    }
    {
        const int qi = tid >> 2, jg = tid & 3;
        const int jlim = (jbc + 1) * 16;
        for (int jj = 0; jj < 16; ++jj) {
            const int j = jg * 16 + jj;
            float v = (j < jlim) ? SUM4[qi * 64 + j] : 0.f;
            if (j >= 1 && j - 1 < jlim) v += LAST[qi * 64 + j - 1];
            IMP2[qi * 64 + j] = v;
        }
    }
    __syncthreads();
    {
        const int qi = tid >> 2, jg = tid & 3;
        const float* row = IMP2 + qi * 64;
        float kk[64];
#pragma unroll
        for (int j4 = 0; j4 < 16; ++j4) {
            const f32x4 v = *(const f32x4*)(row + j4 * 4);
#pragma unroll
            for (int e = 0; e < 4; ++e) {
                const int j2 = j4 * 4 + e;
                const bool f2 = (j2 == 0) || (j2 == i) || (j2 == i - 1);
                kk[j2] = (j2 > i) ? -__builtin_inff() : (f2 ? __builtin_inff() : v[e]);
            }
        }
        unsigned lo = 0u;
#pragma unroll 1
        for (int jj = 0; jj < 16; ++jj) {
            const int j = jg * 16 + jj;
            float kj = -__builtin_inff();
#pragma unroll
            for (int j2 = 0; j2 < 64; ++j2) kj = (j2 == j) ? kk[j2] : kj;
            int rank = 0;
#pragma unroll
            for (int j2 = 0; j2 < 64; ++j2) rank += (kk[j2] > kj || (kk[j2] == kj && j2 < j)) ? 1 : 0;
            if (j <= i && rank < 16) lo |= (1u << jj);
        }
        unsigned long long bits = (unsigned long long)lo << (jg * 16);
        bits |= __shfl_xor(bits, 1); bits |= __shfl_xor(bits, 2);
        if (jg == 0) MSKG[((size_t)(b * 2 + k)) * 4096 + U.t0 + qi] = bits;
    }
    __syncthreads();
}

template <int MODE>
DEVI void nsa_kv_unit(const Params& P, rsrc_t rs, int uu, unsigned char* lds, int tid) {
    const int lane = tid & 63, q = lane >> 4;
    const NsaUnit U = nsa_unit(uu, tid);
    const int i = U.i, b = U.b, k = U.k, tq = U.tq;
    AttnState st;
    bf16x8 qf[4][2];
#pragma unroll
    for (int cf = 0; cf < 4; ++cf)
#pragma unroll
        for (int ks = 0; ks < 2; ++ks) qf[cf][ks] = __builtin_bit_cast(bf16x8, bload16(rs, U.qoff, (unsigned)OFF_QBR + U.sQ + cf * 128 + ks * 64));
    const unsigned sK = (unsigned)(OFF_KV + (MODE == 1 ? 2 : 4) * KV_STRIDE) + (unsigned)(b * 2 + k) * 4096u * 128u;
    const unsigned sV = (unsigned)(OFF_KV + (MODE == 1 ? 3 : 5) * KV_STRIDE) + (unsigned)(b * 2 + k) * 64u * 8192u;
    unsigned long long mymask = 0ull;
    int j0 = 0;
    if (MODE == 1) mymask = ((const unsigned long long*)(P.ws + OFF_MASK))[((size_t)(b * 2 + k)) * 4096 + tq];
    else j0 = (i >= 8) ? i - 8 : 0;
    attn_blocks<MODE>(rs, sK, sV, 4096, j0, i, qf, st, tq, mymask, lds, tid);
#pragma unroll
    for (int cf = 0; cf < 4; ++cf) {
        const float l = rows_sum(st.l[cf]);
        const float sc = ((l > 0.f) ? __builtin_amdgcn_rcpf(l) : 0.f) * bload4f(rs, U.goff, U.sG + (MODE == 1 ? 32 : 64) + cf * 4);
#pragma unroll
        for (int d = 0; d < 4; ++d) {
            const u32x2 pw = __builtin_bit_cast(u32x2, __builtin_amdgcn_raw_buffer_load_b64(rs, (int)U.ooff, (int)(U.sO + cf * 128 + d * 32), 0));
            f32x4 v = st.O[d][cf] * sc;
            v[0] += bf2f(pw.x & 0xffffu); v[1] += bf2f(pw.x >> 16); v[2] += bf2f(pw.y & 0xffffu); v[3] += bf2f(pw.y >> 16);
            u32x2 w; w.x = pk2(v[0], v[1]); w.y = pk2(v[2], v[3]);
            __builtin_amdgcn_raw_buffer_store_b64(w, rs, (int)U.ooff, (int)(U.sO + cf * 128 + d * 32), 0);
        }
    }
}

DEVI void phase_nsa(const Params& P, unsigned char* lds, int tid) {
    const rsrc_t rs = __builtin_amdgcn_make_buffer_rsrc((void*)P.ws, (short)0, (int)0x7fffffff, 0x00020000);
    for (int uu = blockIdx.x; uu < 1024; uu += gridDim.x) { int t = tid; asm volatile("" : "+v"(t)); nsa_cmp_unit(P, rs, uu, lds, t); }
    __syncthreads();
    for (int uu = blockIdx.x; uu < 1024; uu += gridDim.x) { int t = tid; asm volatile("" : "+v"(t)); nsa_kv_unit<1>(P, rs, uu, lds, t); }
    __syncthreads();
    for (int uu = blockIdx.x; uu < 1024; uu += gridDim.x) { int t = tid; asm volatile("" : "+v"(t)); nsa_kv_unit<2>(P, rs, uu, lds, t); }
}

DEVI void phase_merge(const Params& P, unsigned char* lds, int tid) {
    unsigned char* ws = P.ws;
    const rsrc_t rs = __builtin_amdgcn_make_buffer_rsrc((void*)P.ws, (short)0, (int)0x7fffffff, 0x00020000);
    const bf16_t* ga = (const bf16_t*)(ws + OFF_GA);
    const bf16_t* gb = (const bf16_t*)(ws + OFF_GB);
    bf16_t* mg = (bf16_t*)(ws + OFF_MERGED);
    const int lane = tid & 63, wid = __builtin_amdgcn_readfirstlane(tid >> 6), wr = wid >> 1, wc = wid & 1, q = lane >> 4, cl = lane & 15;
    for (int kk = 0;; ++kk) {
        int mt, nt;
        if (!tile_map(kk, 8, mt, nt)) break;
        f32x4 acc[4][4];
        unsigned t[4][4][2];
        gemm128(acc, rs, (unsigned)(OFF_OA + (size_t)mt * 128 * 1024), RowLin{1024}, (unsigned)(OFF_WBRA + (size_t)nt * 128 * 1024), RowLin{1024}, 8, lds, tid);
        const size_t e0 = (size_t)(mt * 128 + wr * 64 + cl) * 1024 + nt * 128 + wc * 64 + q * 4;
#pragma unroll
        for (int m = 0; m < 4; ++m)
#pragma unroll
            for (int n = 0; n < 4; ++n) {
                const u32x2 gv = *(const u32x2*)(ga + e0 + (size_t)m * 16 * 1024 + n * 16);
                t[m][n][0] = pk2(acc[m][n][0] * bf2f(gv.x & 0xffffu), acc[m][n][1] * bf2f(gv.x >> 16));
                t[m][n][1] = pk2(acc[m][n][2] * bf2f(gv.y & 0xffffu), acc[m][n][3] * bf2f(gv.y >> 16));
            }
        gemm128(acc, rs, (unsigned)(OFF_OB + (size_t)mt * 128 * 1024), RowLin{1024}, (unsigned)(OFF_WBRB + (size_t)nt * 128 * 1024), RowLin{1024}, 8, lds, tid);
#pragma unroll
        for (int m = 0; m < 4; ++m)
#pragma unroll
            for (int n = 0; n < 4; ++n) {
                const size_t o = e0 + (size_t)m * 16 * 1024 + n * 16;
                const u32x2 gv = *(const u32x2*)(gb + o);
                u32x2 w;
                w.x = pk2(bf2f(t[m][n][0] & 0xffffu) + acc[m][n][0] * bf2f(gv.x & 0xffffu), bf2f(t[m][n][0] >> 16) + acc[m][n][1] * bf2f(gv.x >> 16));
                w.y = pk2(bf2f(t[m][n][1] & 0xffffu) + acc[m][n][2] * bf2f(gv.y & 0xffffu), bf2f(t[m][n][1] >> 16) + acc[m][n][3] * bf2f(gv.y >> 16));
                *(u32x2*)(mg + o) = w;
            }
    }
}

DEVI void phase_outproj(const Params& P, unsigned char* lds, int tid) {
    unsigned char* ws = P.ws;
    const rsrc_t rs = __builtin_amdgcn_make_buffer_rsrc((void*)P.ws, (short)0, (int)0x7fffffff, 0x00020000);
    const bf16_t* mg = (const bf16_t*)(ws + OFF_MERGED);
    const bf16_t* wo = (const bf16_t*)(ws + OFF_WOUT);
    const float* x = P.in[0];
    float* x1 = P.out;
    const int lane = tid & 63, wid = __builtin_amdgcn_readfirstlane(tid >> 6), wr = wid >> 1, wc = wid & 1, q = lane >> 4, cl = lane & 15;
    for (int kk = 0;; ++kk) {
        int mt, nt;
        if (!tile_map(kk, 8, mt, nt, 128)) break;
        f32x4 acc[8][4];
        gemm256(acc, rs, (unsigned)(OFF_MERGED + (size_t)mt * 256 * 2048), 2048u, (unsigned)(OFF_WOUT + (size_t)nt * 128 * 2048), 2048u, 32, lds, tid);
#pragma unroll
        for (int m = 0; m < 8; ++m)
#pragma unroll
            for (int n = 0; n < 4; ++n) {
                const size_t o = (size_t)(mt * 256 + wr * 128 + m * 16 + cl) * 1024 + nt * 128 + wc * 64 + n * 16 + q * 4;
                *(f32x4*)(x1 + o) = *(const f32x4*)(x + o) + acc[m][n];
            }
    }
}

DEVI void phase_router(const Params& P, unsigned char* lds, int tid) {
    unsigned char* ws = P.ws;
    const int lane = tid & 63, wid = __builtin_amdgcn_readfirstlane(tid >> 6), q = lane >> 4, cl = lane & 15;
    const float* x1 = P.out; const float* g = P.in[13];
    const float* bg = P.in[15]; const float* be = P.in[17];
    const float* WR = (const float*)(ws + OFF_WR);
    bf16_t* h2 = (bf16_t*)(ws + OFF_HN);
    unsigned* cnt = (unsigned*)(ws + OFF_CTL);
    int* list = (int*)(ws + OFF_LIST);
    float* wt = (float*)(ws + OFF_WT);
    float* WL = (float*)lds;
    float* LG = (float*)(lds + 50688);
    float* RS = (float*)(lds + 50688 + 12288);
    for (int u = blockIdx.x; u < NTOK / 64; u += gridDim.x) {
        const int row0 = u * 64 + wid * 16;
        const float* xa = x1 + (size_t)(row0 + cl) * 1024 + 4 * q;
        f32x4 acc[3];
#pragma unroll
        for (int ct = 0; ct < 3; ++ct) acc[ct] = (f32x4){0.f, 0.f, 0.f, 0.f};
        float ss = 0.f;
        for (int kc = 0; kc < 4; ++kc) {
            __syncthreads();
#pragma unroll
            for (int i = 0; i < 12; ++i) {
                const int idx = tid + 256 * i, r = idx >> 6, c4 = idx & 63;
                *(f32x4*)(WL + r * 264 + c4 * 4) = *(const f32x4*)(WR + (size_t)r * 1024 + kc * 256 + c4 * 4);
            }
            __syncthreads();
#pragma unroll
            for (int jh = 0; jh < 2; ++jh) {
                f32x4 av[8];
#pragma unroll
                for (int j = 0; j < 8; ++j) av[j] = *(const f32x4*)(xa + kc * 256 + (jh * 8 + j) * 16);
#pragma unroll
                for (int j = 0; j < 8; ++j) {
                    {
                        const int kx = kc * 256 + (jh * 8 + j) * 16 + 4 * q;
                        const f32x4 gg = *(const f32x4*)(g + kx);
                        u32x2 w; w.x = pk2(av[j][0] * gg[0], av[j][1] * gg[1]); w.y = pk2(av[j][2] * gg[2], av[j][3] * gg[3]);
                        *(u32x2*)(h2 + (size_t)(row0 + cl) * 1024 + kx) = w;
                    }
                    ss += av[j][0] * av[j][0] + av[j][1] * av[j][1] + av[j][2] * av[j][2] + av[j][3] * av[j][3];
#pragma unroll
                    for (int ct = 0; ct < 3; ++ct) {
                        const f32x4 bv = *(const f32x4*)(WL + (ct * 16 + cl) * 264 + (jh * 8 + j) * 16 + 4 * q);
#pragma unroll
                        for (int e = 0; e < 4; ++e) acc[ct] = __builtin_amdgcn_mfma_f32_16x16x4f32(av[j][e], bv[e], acc[ct], 0, 0, 0);
                    }
                }
            }
        }
        ss += __shfl_xor(ss, 16); ss += __shfl_xor(ss, 32);
        const float rs = rsqrtf(ss * (1.0f / 1024.0f) + RMS_EPS);
        if (q == 0) { RS[wid * 16 + cl] = rs; ((float*)(ws + OFF_RS))[row0 + cl] = rs; }
        __syncthreads();
#pragma unroll
        for (int j = 0; j < 4; ++j) {
            const float rj = RS[wid * 16 + 4 * q + j];
#pragma unroll
            for (int ct = 0; ct < 3; ++ct) LG[(wid * 16 + 4 * q + j) * 48 + ct * 16 + cl] = acc[ct][j] * rj;
        }
        __syncthreads();
        if (tid < 64) {
            const int r = u * 64 + tid;
            const float* lg = LG + tid * 48;
            float gl[4];
#pragma unroll
            for (int e = 0; e < 4; ++e) gl[e] = lg[e] + bg[e];
            int gs = 0; float gm = gl[0];
#pragma unroll
            for (int e = 1; e < 4; ++e) if (gl[e] > gm) { gm = gl[e]; gs = e; }
            float den = 0.f;
#pragma unroll
            for (int e = 0; e < 4; ++e) den += __expf(gl[e] - gm);
            const float gp = 1.0f / den;
            float el[8];
#pragma unroll
            for (int e = 0; e < 8; ++e) el[e] = lg[4 + gs * 8 + e] + be[gs * 8 + e];
            int i0 = 0; float v0 = el[0];
#pragma unroll
            for (int e = 1; e < 8; ++e) if (el[e] > v0) { v0 = el[e]; i0 = e; }
            int i1 = -1; float v1 = -__builtin_inff();
#pragma unroll
            for (int e = 0; e < 8; ++e) if (e != i0 && el[e] > v1) { v1 = el[e]; i1 = e; }
            const float e1 = __expf(v1 - v0);
            const float w0 = gp / (1.0f + e1), w1 = gp * e1 / (1.0f + e1);
            const int ex0 = gs * 8 + i0, ex1 = gs * 8 + i1;
            const unsigned p0 = atomicAdd(&cnt[ex0], 1u);
            list[(size_t)ex0 * NTOK + p0] = r * 2 + 0;
            const unsigned p1 = atomicAdd(&cnt[ex1], 1u);
            list[(size_t)ex1 * NTOK + p1] = r * 2 + 1;
            wt[(size_t)r * 2 + 0] = w0; wt[(size_t)r * 2 + 1] = w1;
        }
    }
}

struct RowGather { const int* idx; DEVI unsigned operator()(int r) const { return (unsigned)idx[r] * 2048u; } };
struct RowGU { int c0; DEVI unsigned operator()(int r) const {
    const int wcx = r >> 6, w = r & 63; const int col = (w < 32) ? (c0 + wcx * 32 + w) : (256 + c0 + wcx * 32 + (w - 32)); return (unsigned)col * 2048u; } };

DEVI int moe_find_tile(const unsigned* cnt, int u, int& e, int& tl) {
    int t = u, ee = 0, ce = 0;
    for (; ee < 32; ++ee) { ce = (int)cnt[ee]; const int nt = (ce + 127) >> 7; if (t < nt) break; t -= nt; }
    e = ee; tl = t; return ce;
}
DEVI void phase_moe_a(const Params& P, unsigned char* lds, int tid) {
    unsigned char* ws = P.ws;
    const rsrc_t rs = __builtin_amdgcn_make_buffer_rsrc((void*)P.ws, (short)0, (int)0x7fffffff, 0x00020000);
    const int lane = tid & 63, wid = __builtin_amdgcn_readfirstlane(tid >> 6), wr = wid >> 1, wc = wid & 1, q = lane >> 4, cl = lane & 15;
    const unsigned* cnt = (const unsigned*)(ws + OFF_CTL);
    const int* list = (const int*)(ws + OFF_LIST);
    bf16_t* act = (bf16_t*)(ws + OFF_ACT);
    int* rowtok = (int*)(lds + 65536);
    const float* RSG = (const float*)(ws + OFF_RS);
    int total = 0;
    for (int e = 0; e < 32; ++e) total += ((int)cnt[e] + 127) >> 7;
    for (int v = blockIdx.x; v < total * 4; v += gridDim.x) {
        const int u = v >> 2, nt = v & 3;
        int e, tl; const int ce = moe_find_tile(cnt, u, e, tl);
        if (tid < 128) { const int r = tl * 128 + tid; rowtok[tid] = (r < ce) ? (list[(size_t)e * NTOK + r] >> 1) : 0; }
        __syncthreads();
        bf16_t* au = act + (size_t)u * 128 * 256;
        f32x4 acc[4][4];
        gemm128(acc, rs, (unsigned)OFF_HN, RowGather{rowtok}, (unsigned)(OFF_WGU + (size_t)e * 512 * 2048), RowGU{nt * 64}, 16, lds, tid);
#pragma unroll
        for (int m = 0; m < 4; ++m)
#pragma unroll
            for (int n = 0; n < 2; ++n) {
                const int row = wr * 64 + m * 16 + cl, col = nt * 64 + wc * 32 + n * 16 + q * 4;
                const float rsv = RSG[rowtok[row]];
                const f32x4 gt = acc[m][n] * rsv, up = acc[m][n + 2] * rsv;
                u32x2 w;
                w.x = pk2(siluf_(gt[0]) * up[0], siluf_(gt[1]) * up[1]);
                w.y = pk2(siluf_(gt[2]) * up[2], siluf_(gt[3]) * up[3]);
                *(u32x2*)(au + (size_t)row * 256 + col) = w;
            }
        __syncthreads();
    }
}
DEVI void phase_moe_b(const Params& P, unsigned char* lds, int tid) {
    unsigned char* ws = P.ws;
    const rsrc_t rs = __builtin_amdgcn_make_buffer_rsrc((void*)P.ws, (short)0, (int)0x7fffffff, 0x00020000);
    const int lane = tid & 63, wid = __builtin_amdgcn_readfirstlane(tid >> 6), wr = wid >> 1, wc = wid & 1, q = lane >> 4, cl = lane & 15;
    const unsigned* cnt = (const unsigned*)(ws + OFF_CTL);
    const int* list = (const int*)(ws + OFF_LIST);
    bf16_t* Y = (bf16_t*)(ws + OFF_Y);
    int* rowas = (int*)(lds + 65536);
    int total = 0;
    for (int e = 0; e < 32; ++e) total += ((int)cnt[e] + 127) >> 7;
    for (int v = blockIdx.x; v < total * 4; v += gridDim.x) {
        const int u = v >> 2, np = v & 3;
        int e, tl; const int ce = moe_find_tile(cnt, u, e, tl);
        if (tid < 128) { const int r = tl * 128 + tid; rowas[tid] = (r < ce) ? list[(size_t)e * NTOK + r] : -1; }
        __syncthreads();
        for (int h = 0; h < 2; ++h) {
            const int nt = np * 2 + h;
            f32x4 acc[4][4];
            gemm128(acc, rs, (unsigned)(OFF_ACT + (size_t)u * 128 * 512), RowLin{512}, (unsigned)(OFF_WDN + (size_t)e * 1024 * 512 + (size_t)nt * 128 * 512), RowLin{512}, 4, lds, tid);
#pragma unroll
            for (int m = 0; m < 4; ++m) {
                const int row = wr * 64 + m * 16 + cl;
                const int as = rowas[row];
                if (as >= 0) {
                    bf16_t* yr = Y + ((size_t)(as & 1) * NTOK + (as >> 1)) * 1024 + nt * 128 + wc * 64 + q * 4;
#pragma unroll
                    for (int n = 0; n < 4; ++n) { u32x2 w; w.x = pk2(acc[m][n][0], acc[m][n][1]); w.y = pk2(acc[m][n][2], acc[m][n][3]); *(u32x2*)(yr + n * 16) = w; }
                }
            }
        }
        __syncthreads();
    }
}

DEVI void phase_final(const Params& P, int tid, bool with_moe) {
    unsigned char* ws = P.ws;
    const int lane = tid & 63, wid = __builtin_amdgcn_readfirstlane(tid >> 6);
    const bf16_t* Y = (const bf16_t*)(ws + OFF_Y);
    const float* wt = (const float*)(ws + OFF_WT);
    const float* g = P.in[20];
    float* out = P.out;
    for (int r = blockIdx.x * 4 + wid; r < NTOK; r += gridDim.x * 4) {
        float* xr = out + (size_t)r * 1024;
        const float w0 = with_moe ? wt[(size_t)r * 2] : 0.f, w1 = with_moe ? wt[(size_t)r * 2 + 1] : 0.f;
        f32x4 v[4]; float ss = 0.f;
#pragma unroll
        for (int i = 0; i < 4; ++i) {
            v[i] = *(const f32x4*)(xr + i * 256 + lane * 4);
            if (with_moe) {
                const u32x2 a = *(const u32x2*)(Y + (size_t)r * 1024 + i * 256 + lane * 4);
                const u32x2 b = *(const u32x2*)(Y + ((size_t)NTOK + r) * 1024 + i * 256 + lane * 4);
                v[i][0] += w0 * bf2f(a.x & 0xffffu) + w1 * bf2f(b.x & 0xffffu); v[i][1] += w0 * bf2f(a.x >> 16) + w1 * bf2f(b.x >> 16);
                v[i][2] += w0 * bf2f(a.y & 0xffffu) + w1 * bf2f(b.y & 0xffffu); v[i][3] += w0 * bf2f(a.y >> 16) + w1 * bf2f(b.y >> 16);
            }
            ss += v[i][0] * v[i][0] + v[i][1] * v[i][1] + v[i][2] * v[i][2] + v[i][3] * v[i][3];
        }
        ss = wave_sum(ss);
        const float rs = rsqrtf(ss * (1.0f / 1024.0f) + RMS_EPS);
#pragma unroll
        for (int i = 0; i < 4; ++i) {
            const f32x4 gg = *(const f32x4*)(g + i * 256 + lane * 4);
            f32x4 o; o[0] = v[i][0] * rs * gg[0]; o[1] = v[i][1] * rs * gg[1]; o[2] = v[i][2] * rs * gg[2]; o[3] = v[i][3] * rs * gg[3];
            *(f32x4*)(xr + i * 256 + lane * 4) = o;
        }
    }
}

#define LAUNDER_TID() do { tid = wave_id * 64 + (int)__builtin_amdgcn_mbcnt_hi(~0u, __builtin_amdgcn_mbcnt_lo(~0u, 0u)); asm volatile("" : "+v"(tid)); } while (0)
__global__ void __launch_bounds__(NTHREADS, 2) fwd_megakernel(Params P) {
    extern __shared__ __attribute__((aligned(16))) unsigned char lds[];
    cg::grid_group grid = cg::this_grid();
    int tid;
    const int wave_id = __builtin_amdgcn_readfirstlane((int)(threadIdx.x >> 6));
    volatile LAS unsigned* bst = (volatile LAS unsigned*)(LAS unsigned char*)(lds + LDS_BYTES - 16);
    if (threadIdx.x < 4) bst[threadIdx.x] = 0u;
    __syncthreads();
    (void)xcd_barrier_post((unsigned*)(P.ws + OFF_BAR), bst);
#define GRID_BARRIER() do { XcdBarrier b_; b_.bar = (unsigned*)(P.ws + OFF_BAR); b_.x = xb_xcc_id(); b_.st = (volatile LAS unsigned*)(LAS unsigned char*)(lds + LDS_BYTES - 16); xcd_barrier(b_); } while (0)
    if (P.ph_lo != 0) grid.sync();
    LAUNDER_TID(); phase_prep(P, lds, tid, 0); __syncthreads();
    GRID_BARRIER();
    {
        const int first_idx = (blockIdx.x >> 8) & 1;
        for (int step = 0; step < 3; ++step) {
            const int what = (step == 0) ? 0 : 1 + ((step - 1) ^ first_idx);
            if (what <= 1) { LAUNDER_TID(); phase_gemm1(P, lds, tid, what); }
            else {
                LAUNDER_TID(); phase_prep(P, lds, tid, 1); __syncthreads();
                LAUNDER_TID(); phase_compress(P, lds, tid); __syncthreads();
                LAUNDER_TID(); phase_index(P, lds, tid);
            }
            __syncthreads();
            if (step == 0) GRID_BARRIER();
        }
    }
    GRID_BARRIER();
    if (((blockIdx.x >> 8) & 1) == 0) { LAUNDER_TID(); phase_dsa(P, lds, tid); __syncthreads(); }
    LAUNDER_TID(); phase_nsa(P, lds, tid); __syncthreads();
    if (((blockIdx.x >> 8) & 1) != 0) { LAUNDER_TID(); phase_dsa(P, lds, tid); __syncthreads(); }
    GRID_BARRIER();
    LAUNDER_TID(); phase_merge(P, lds, tid);
    GRID_BARRIER();
    LAUNDER_TID(); phase_outproj(P, lds, tid);
    GRID_BARRIER();
    LAUNDER_TID(); phase_router(P, lds, tid);
    GRID_BARRIER();
    LAUNDER_TID(); phase_moe_a(P, lds, tid);
    GRID_BARRIER();
    LAUNDER_TID(); phase_moe_b(P, lds, tid);
    GRID_BARRIER();
    LAUNDER_TID(); phase_final(P, tid, true);
}

extern "C" void kernel_launch(void* const* d_in, const int* in_sizes, int n_in, void* d_out, int out_size, void* d_ws, size_t ws_size,
                              hipStream_t stream) {
    static int grid_blocks = 0;
    if (!grid_blocks) {
        int dev = 0, cus = 0, per_cu = 0;
        hipGetDevice(&dev);
        hipDeviceGetAttribute(&cus, hipDeviceAttributeMultiprocessorCount, dev);
        hipFuncSetAttribute((const void*)fwd_megakernel, hipFuncAttributeMaxDynamicSharedMemorySize, LDS_BYTES);
        hipOccupancyMaxActiveBlocksPerMultiprocessor(&per_cu, (const void*)fwd_megakernel, NTHREADS, LDS_BYTES);
        if (per_cu < 1) per_cu = 1;
        if (per_cu > 2) per_cu = 2;
        grid_blocks = cus * per_cu;
        if (ws_size < WS_END) fprintf(stderr, "kernel_launch: workspace too small: %zu < %zu\n", ws_size, (size_t)WS_END);
    }
    Params p{};
    for (int i = 0; i < 21; ++i) p.in[i] = (const float*)d_in[i];
    p.pos = (const int*)d_in[1];
    p.out = (float*)d_out;
    p.ws = (unsigned char*)d_ws;
    for (int i = 0; i < 32; ++i) p.inv_freq[i] = (double)powf(10000.0f, -(float)i / 32.0f);
    p.ph_lo = 0; p.ph_hi = 0;
    (void)hipMemsetAsync(d_ws, 0, OFF_WIN_T, stream);
    void* args[] = {&p};
    hipError_t e = hipLaunchCooperativeKernel((const void*)fwd_megakernel, dim3(grid_blocks), dim3(NTHREADS), args, LDS_BYTES, stream);
    if (e != hipSuccess) fprintf(stderr, "cooperative launch failed: %s (grid %d)\n", hipGetErrorString(e), grid_blocks);
}
```

```cpp
#include <hip/hip_runtime.h>
#include <hip/hip_cooperative_groups.h>
#include <cstdint>
#include <cstdio>
#include <cmath>
namespace cg = cooperative_groups;

#define DEVI __device__ __forceinline__
#ifndef PROBE_TWICE
#define PROBE_TWICE 0
#endif
#define REPS(k) ((PROBE_TWICE == (k)) ? 2 : 1)
typedef unsigned short bf16_t;
typedef short bf16x8 __attribute__((ext_vector_type(8)));
typedef short s16x4 __attribute__((ext_vector_type(4)));
typedef float f32x4 __attribute__((ext_vector_type(4)));
typedef float f32x2 __attribute__((ext_vector_type(2)));
typedef unsigned u32x4 __attribute__((ext_vector_type(4)));
typedef unsigned u32x2 __attribute__((ext_vector_type(2)));
#define LAS __attribute__((address_space(3)))

constexpr int NB = 8, SL = 4096, DM = 1024, NTOK = NB * SL;
constexpr int INW = 4288;
constexpr int NTHREADS = 256;
constexpr int LDS_BYTES = 81920;
constexpr float RMS_EPS = 1e-6f;
constexpr float LOG2E = 1.4426950408889634f;

constexpr int WIN_ROWS = 4352;
constexpr int G1_COLS = 4352;

constexpr size_t al256(size_t x) { return (x + 255) & ~(size_t)255; }
constexpr size_t OFF_CTL   = 0;
constexpr size_t OFF_BAR   = 4096;
constexpr size_t OFF_WIN_T = 32768;
constexpr size_t OFF_WBRA  = OFF_WIN_T + (size_t)WIN_ROWS * 1024 * 2;
constexpr size_t OFF_WBRB  = OFF_WBRA + (size_t)1024 * 512 * 2;
constexpr size_t OFF_WOUT  = OFF_WBRB + (size_t)1024 * 512 * 2;
constexpr size_t OFF_W1K   = OFF_WOUT + (size_t)1024 * 1024 * 2;
constexpr size_t OFF_W1V   = OFF_W1K + (size_t)128 * 2048 * 2;
constexpr size_t OFF_W2K   = OFF_W1V + (size_t)128 * 2048 * 2;
constexpr size_t OFF_W2V   = OFF_W2K + (size_t)64 * 128 * 2;
constexpr size_t OFF_WGU   = OFF_W2V + (size_t)64 * 128 * 2;
constexpr size_t OFF_WDN   = OFF_WGU + (size_t)32 * 512 * 1024 * 2;
constexpr size_t OFF_BIAS1 = OFF_WDN + (size_t)32 * 1024 * 256 * 2;
constexpr size_t OFF_WR    = OFF_BIAS1 + 1024;
constexpr size_t OFF_CS    = OFF_WR + (size_t)48 * 1024 * 4;
constexpr size_t OFF_HN    = OFF_CS + (size_t)NTOK * 32 * 8;
constexpr size_t OFF_QA    = OFF_HN + (size_t)NTOK * 1024 * 2;
constexpr size_t OFF_KA    = OFF_QA + (size_t)NTOK * 512 * 2;
constexpr size_t OFF_VA    = OFF_KA + (size_t)NTOK * 64 * 2;
constexpr size_t OFF_QI    = OFF_VA + (size_t)NTOK * 64 * 2;
constexpr size_t OFF_KI    = OFF_QI + (size_t)NTOK * 256 * 2;
constexpr size_t OFF_WI    = OFF_KI + (size_t)NTOK * 32 * 2;
constexpr size_t OFF_QBN   = OFF_WI + (size_t)NTOK * 8 * 4;
constexpr size_t OFF_QBR   = OFF_QBN + (size_t)NTOK * 512 * 2;
constexpr size_t KV_STRIDE = (size_t)NTOK * 128 * 2 + 65536 * 4;
constexpr size_t OFF_KV    = OFF_QBR + (size_t)NTOK * 512 * 2;
constexpr size_t OFF_GATES = OFF_KV + 6 * KV_STRIDE;
constexpr size_t OFF_QKV_END = OFF_GATES + (size_t)NTOK * 24 * 4;
constexpr size_t OFF_KC    = al256(OFF_QKV_END);
constexpr size_t OFF_VCT   = OFF_KC + (size_t)16 * 256 * 64 * 2;
constexpr size_t OFF_SEL   = OFF_VCT + (size_t)16 * 256 * 64 * 2;
constexpr size_t OFF_OA    = OFF_HN;
constexpr size_t OFF_OB    = OFF_OA + (size_t)NTOK * 512 * 2;
constexpr size_t OFF_GA    = OFF_SEL + (size_t)NTOK * 256 * 2;
constexpr size_t OFF_GB    = OFF_GA + (size_t)NTOK * 1024 * 2;
constexpr size_t OFF_MASK  = OFF_GB + (size_t)NTOK * 1024 * 2;
constexpr size_t OFF_LIST  = OFF_MASK + (size_t)16 * 4096 * 8;
constexpr size_t OFF_WT    = OFF_LIST + (size_t)32 * NTOK * 4;
constexpr size_t OFF_RS    = OFF_WT + (size_t)NTOK * 2 * 4;
constexpr size_t WS_END    = OFF_RS + (size_t)NTOK * 4;
constexpr size_t OFF_MERGED = OFF_QA;
constexpr size_t OFF_ACT    = OFF_QA;
constexpr size_t OFF_Y      = OFF_QA + (size_t)40 * 1024 * 1024;
static_assert(OFF_Y + (size_t)2 * NTOK * 1024 * 2 <= OFF_QKV_END, "Y overlay");
static_assert((size_t)544 * 128 * 256 * 2 <= (size_t)40 * 1024 * 1024, "ACT overlay");

struct Params {
    const float* in[21];
    const int* pos;
    float* out;
    unsigned char* ws;
    double inv_freq[32];
    int ph_lo, ph_hi;
};

DEVI unsigned f2bf(float f) { unsigned u = __float_as_uint(f); return (u + 0x7fffu + ((u >> 16) & 1u)) >> 16; }
typedef __bf16 bf16v2_t __attribute__((ext_vector_type(2)));
DEVI unsigned pk2(float lo, float hi) { const f32x2 v = {lo, hi}; return __builtin_bit_cast(unsigned, __builtin_convertvector(v, bf16v2_t)); }
DEVI float rows_max(float x) {
    float a = x, b = x;
    asm volatile("v_nop\n\tv_nop\n\tv_permlane16_swap_b32 %0, %1" : "+v"(a), "+v"(b));
    x = fmaxf(a, b); a = x; b = x;
    asm volatile("v_nop\n\tv_nop\n\tv_permlane32_swap_b32 %0, %1" : "+v"(a), "+v"(b));
    return fmaxf(a, b);
}
DEVI float rows_sum(float x) {
    float a = x, b = x;
    asm volatile("v_nop\n\tv_nop\n\tv_permlane16_swap_b32 %0, %1" : "+v"(a), "+v"(b));
    x = a + b; a = x; b = x;
    asm volatile("v_nop\n\tv_nop\n\tv_permlane32_swap_b32 %0, %1" : "+v"(a), "+v"(b));
    return a + b;
}
DEVI float bf2f(unsigned h) { return __uint_as_float(h << 16); }
DEVI float sigmoidf_(float x) { return __builtin_amdgcn_rcpf(1.0f + __builtin_amdgcn_exp2f(-x * 1.4426950408889634f)); }
DEVI float wave_sum(float v) {
#pragma unroll
    for (int o = 32; o > 0; o >>= 1) v += __shfl_xor(v, o);
    return v;
}
DEVI int wave_sum_i32(int v) {
    v += __builtin_amdgcn_update_dpp(0, v, 0xB1, 0xF, 0xF, true);
    v += __builtin_amdgcn_update_dpp(0, v, 0x4E, 0xF, 0xF, true);
    v += __builtin_amdgcn_update_dpp(0, v, 0x141, 0xF, 0xF, true);
    v += __builtin_amdgcn_update_dpp(0, v, 0x140, 0xF, 0xF, true);
    return __builtin_amdgcn_readlane(v, 0) + __builtin_amdgcn_readlane(v, 16) + __builtin_amdgcn_readlane(v, 32) + __builtin_amdgcn_readlane(v, 48);
}
DEVI int fkey(float f) { const int b = __builtin_bit_cast(int, f); return b ^ ((b >> 31) & 0x7fffffff); }
DEVI float wave_min_f32_dpp(float v) {
    v = fminf(v, __builtin_bit_cast(float, __builtin_amdgcn_update_dpp(0, __builtin_bit_cast(int, v), 0xB1, 0xF, 0xF, true)));
    v = fminf(v, __builtin_bit_cast(float, __builtin_amdgcn_update_dpp(0, __builtin_bit_cast(int, v), 0x4E, 0xF, 0xF, true)));
    v = fminf(v, __builtin_bit_cast(float, __builtin_amdgcn_update_dpp(0, __builtin_bit_cast(int, v), 0x141, 0xF, 0xF, true)));
    v = fminf(v, __builtin_bit_cast(float, __builtin_amdgcn_update_dpp(0, __builtin_bit_cast(int, v), 0x140, 0xF, 0xF, true)));
    const int iv = __builtin_bit_cast(int, v);
    return fminf(fminf(__builtin_bit_cast(float, __builtin_amdgcn_readlane(iv, 0)), __builtin_bit_cast(float, __builtin_amdgcn_readlane(iv, 16))),
                 fminf(__builtin_bit_cast(float, __builtin_amdgcn_readlane(iv, 32)), __builtin_bit_cast(float, __builtin_amdgcn_readlane(iv, 48))));
}
DEVI float wave_sum_f32_dpp(float v) {
    v += __builtin_bit_cast(float, __builtin_amdgcn_update_dpp(0, __builtin_bit_cast(int, v), 0xB1, 0xF, 0xF, true));
    v += __builtin_bit_cast(float, __builtin_amdgcn_update_dpp(0, __builtin_bit_cast(int, v), 0x4E, 0xF, 0xF, true));
    v += __builtin_bit_cast(float, __builtin_amdgcn_update_dpp(0, __builtin_bit_cast(int, v), 0x141, 0xF, 0xF, true));
    v += __builtin_bit_cast(float, __builtin_amdgcn_update_dpp(0, __builtin_bit_cast(int, v), 0x140, 0xF, 0xF, true));
    const int iv = __builtin_bit_cast(int, v);
    return (__builtin_bit_cast(float, __builtin_amdgcn_readlane(iv, 0)) + __builtin_bit_cast(float, __builtin_amdgcn_readlane(iv, 16))) +
           (__builtin_bit_cast(float, __builtin_amdgcn_readlane(iv, 32)) + __builtin_bit_cast(float, __builtin_amdgcn_readlane(iv, 48)));
}
DEVI bf16x8 pack8(const f32x4& a, const f32x4& b) {
    u32x4 w; w.x = pk2(a[0], a[1]); w.y = pk2(a[2], a[3]); w.z = pk2(b[0], b[1]); w.w = pk2(b[2], b[3]);
    return __builtin_bit_cast(bf16x8, w);
}
#define MFMA16(a, b, c) __builtin_amdgcn_mfma_f32_16x16x32_bf16((a), (b), (c), 0, 0, 0)


#define XB_TMO      128
#define XB_XCNT(j)  (256  + 64 * (j))
#define XB_XSUB(j)  (1280 + 64 * (j))
#define XB_XGEN(j)  (2304 + 64 * (j))
#define XB_TOP      3328
#define XB_TOPGEN   3392
#define XCD_BAR_WORDS 3456
#define XB_SPIN_CAP (1u << 22)
DEVI unsigned xb_ld(unsigned* p)              { return __hip_atomic_load(p, __ATOMIC_RELAXED, __HIP_MEMORY_SCOPE_AGENT); }
DEVI unsigned xb_add(unsigned* p, unsigned v) { return __hip_atomic_fetch_add(p, v, __ATOMIC_RELAXED, __HIP_MEMORY_SCOPE_AGENT); }
DEVI unsigned xb_xcc_id() { return (unsigned)__builtin_amdgcn_s_getreg((3 << 11) | 20) & 0xFu; }
#define XB_SPIN(cond, bar) do { unsigned _sp = 0; while (cond) { __builtin_amdgcn_s_sleep(1); \
    if ((++_sp & 255u) == 0u) { if (xb_ld(&(bar)[XB_TMO])) break; if (_sp > XB_SPIN_CAP) { atomicAdd(&(bar)[XB_TMO], 1u); break; } } } } while (0)
struct XcdBarrier { unsigned* bar; unsigned x; volatile LAS unsigned* st; };
DEVI XcdBarrier xcd_barrier_post(unsigned* bar, volatile LAS unsigned* st) {
    XcdBarrier b; b.bar = bar; b.x = xb_xcc_id(); b.st = st;
    if (threadIdx.x == 0) (void)xb_add(&bar[XB_XCNT(b.x)], 1u);
    return b;
}
DEVI void xcd_barrier_complete(unsigned* bar, unsigned x, unsigned& nloc, unsigned& nx) {
    const unsigned G = gridDim.x * gridDim.y * gridDim.z;
    unsigned sum, cnt, mine, sp = 0u;
    for (;;) {
        sum = 0u; cnt = 0u; mine = 0u;
#pragma unroll
        for (unsigned j = 0; j < 16; ++j) { const unsigned c = xb_ld(&bar[XB_XCNT(j)]); sum += c; cnt += (c > 0u) ? 1u : 0u; mine = (j == x) ? c : mine; }
        if (sum == G) break;
        __builtin_amdgcn_s_sleep(1);
        if ((++sp & 255u) == 0u) { if (xb_ld(&bar[XB_TMO])) break; if (sp > XB_SPIN_CAP) { atomicAdd(&bar[XB_TMO], 1u); break; } }
    }
    nloc = mine > 0u ? mine : 1u; nx = cnt > 0u ? cnt : 1u;
}
DEVI void xcd_barrier(const XcdBarrier& b) {
    asm volatile("s_waitcnt vmcnt(0)" ::: "memory");
    __syncthreads();
    if (threadIdx.x == 0) {
        unsigned* bar = b.bar;
        __builtin_amdgcn_s_waitcnt(0);
        unsigned nloc = b.st[0], nx = b.st[1];
        if (nloc == 0u) { xcd_barrier_complete(bar, b.x, nloc, nx); b.st[0] = nloc; b.st[1] = nx; }
        const unsigned old = xb_add(&bar[XB_XSUB(b.x)], 1u);
        const unsigned gen = old / nloc;
        if (old + 1u == (gen + 1u) * nloc) {
            __builtin_amdgcn_fence(__ATOMIC_RELEASE, "agent");
            asm volatile("s_waitcnt vmcnt(0)" ::: "memory");
            const unsigned og = xb_add(&bar[XB_TOP], 1u);
            const unsigned tg = og / nx;
            if (og + 1u == (tg + 1u) * nx) xb_add(&bar[XB_TOPGEN], 1u);
            else XB_SPIN(xb_ld(&bar[XB_TOPGEN]) == tg, bar);
            __builtin_amdgcn_fence(__ATOMIC_ACQUIRE, "agent");
            xb_add(&bar[XB_XGEN(b.x)], 1u);
            asm volatile("s_waitcnt vmcnt(0)" ::: "memory");
        } else {
            XB_SPIN(xb_ld(&bar[XB_XGEN(b.x)]) == gen, bar);
            __builtin_amdgcn_fence(__ATOMIC_ACQUIRE, "agent");
            asm volatile("s_waitcnt vmcnt(0)" ::: "memory");
        }
    }
    __syncthreads();
}

typedef __amdgpu_buffer_rsrc_t rsrc_t;
DEVI u32x4 bload16(rsrc_t r, unsigned voff, unsigned soff) { return __builtin_bit_cast(u32x4, __builtin_amdgcn_raw_buffer_load_b128(r, (int)voff, (int)soff, 0)); }
DEVI void glds16(rsrc_t r, unsigned char* lds_dst_uniform, unsigned voff, unsigned soff) {
    __builtin_amdgcn_raw_ptr_buffer_load_lds(r, (LAS void*)lds_dst_uniform, 16, (int)voff, (int)soff, 0, 0);
}
template <class FA, class FB>
DEVI void gemm128(f32x4 (&acc)[4][4], rsrc_t rs, unsigned sA, const FA& offA, unsigned sB, const FB& offB, int nk, unsigned char* lds, int tid) {
    const int lane = tid & 63, wid = __builtin_amdgcn_readfirstlane(tid >> 6), wr = wid >> 1, wc = wid & 1;
    const int lr = tid >> 3;
    const unsigned csrc = (unsigned)(((lane & 7) ^ ((lane >> 3) & 7)) << 4);
    unsigned oa[4], ob[4];
#pragma unroll
    for (int i = 0; i < 4; ++i) { oa[i] = offA(lr + 32 * i) + csrc; ob[i] = offB(lr + 32 * i) + csrc; }
#pragma unroll
    for (int m = 0; m < 4; ++m)
#pragma unroll
        for (int n = 0; n < 4; ++n) acc[m][n] = (f32x4){0.f, 0.f, 0.f, 0.f};
    const int q = lane >> 4, r16 = lane & 15;
    const int roffA0 = (wr * 64 + r16) * 128 + (((0 + q) ^ (lane & 7)) << 4);
    const int roffA1 = (wr * 64 + r16) * 128 + (((4 + q) ^ (lane & 7)) << 4);
    const int roffB0 = 16384 + (wc * 64 + r16) * 128 + (((0 + q) ^ (lane & 7)) << 4);
    const int roffB1 = 16384 + (wc * 64 + r16) * 128 + (((4 + q) ^ (lane & 7)) << 4);
    unsigned char* wbase = lds + wid * 1024;
#pragma unroll
    for (int i = 0; i < 4; ++i) { glds16(rs, wbase + i * 4096, oa[i], sA); glds16(rs, wbase + 16384 + i * 4096, ob[i], sB); }
    for (int kt = 0; kt < nk; ++kt) {
        unsigned char* cur = lds + (kt & 1) * 32768;
        __syncthreads();
        if (kt + 1 < nk) {
            unsigned char* nb = wbase + ((kt + 1) & 1) * 32768;
#pragma unroll
            for (int i = 0; i < 4; ++i) { glds16(rs, nb + i * 4096, oa[i], sA + (kt + 1) * 128); glds16(rs, nb + 16384 + i * 4096, ob[i], sB + (kt + 1) * 128); }
        }
        bf16x8 a0[4], b0[4], a1[4], b1[4];
#pragma unroll
        for (int m = 0; m < 4; ++m) a0[m] = *(const bf16x8*)(cur + roffA0 + m * 2048);
#pragma unroll
        for (int n = 0; n < 4; ++n) b0[n] = *(const bf16x8*)(cur + roffB0 + n * 2048);
#pragma unroll
        for (int m = 0; m < 4; ++m) a1[m] = *(const bf16x8*)(cur + roffA1 + m * 2048);
#pragma unroll
        for (int n = 0; n < 4; ++n) b1[n] = *(const bf16x8*)(cur + roffB1 + n * 2048);
#pragma unroll
        for (int m = 0; m < 4; ++m)
#pragma unroll
            for (int n = 0; n < 4; ++n) acc[m][n] = MFMA16(b0[n], a0[m], acc[m][n]);
#pragma unroll
        for (int m = 0; m < 4; ++m)
#pragma unroll
            for (int n = 0; n < 4; ++n) acc[m][n] = MFMA16(b1[n], a1[m], acc[m][n]);
    }
    __syncthreads();
}

DEVI int swzF(int row) { return (0x78 >> (((row >> 2) & 3) * 2)) & 3; }
DEVI int perm32(int rho) { const int n = rho >> 4, i = rho & 15; return 8 * (i >> 2) + 4 * n + (i & 3); }
template <bool SWAP = false, bool PERM = false, bool PERMB = false>
DEVI void gemm256(f32x4 (&acc)[8][4], rsrc_t rs, unsigned sA, unsigned ldaB, unsigned sB, unsigned ldbB, int nk32, unsigned char* lds, int tid) {
    const int lane = tid & 63, wid = __builtin_amdgcn_readfirstlane(tid >> 6), wr = wid >> 1, wc = wid & 1;
    const int q = lane >> 4, r16 = lane & 15;
    unsigned oa[4], ob[2];
#pragma unroll
    for (int i = 0; i < 4; ++i) { const int row = (wid * 4 + i) * 16 + (lane >> 2); const int grow = PERM ? ((row & ~31) + perm32(row & 31)) : row;
        oa[i] = (unsigned)grow * ldaB + (unsigned)(((lane & 3) ^ swzF(row)) << 4); }
#pragma unroll
    for (int i = 0; i < 2; ++i) { const int row = (wid * 2 + i) * 16 + (lane >> 2); const int grow = PERMB ? ((row & ~31) + perm32(row & 31)) : row;
        ob[i] = (unsigned)grow * ldbB + (unsigned)(((lane & 3) ^ swzF(row)) << 4); }
#pragma unroll
    for (int m = 0; m < 8; ++m)
#pragma unroll
        for (int n = 0; n < 4; ++n) acc[m][n] = (f32x4){0.f, 0.f, 0.f, 0.f};
    const int roffA = (wr * 128 + r16) * 64 + ((q ^ swzF(r16)) << 4);
    const int roffB = 16384 + (wc * 64 + r16) * 64 + ((q ^ swzF(r16)) << 4);
    unsigned char* wA = lds + wid * 4096;
    unsigned char* wB = lds + 16384 + wid * 2048;
#pragma unroll
    for (int i = 0; i < 4; ++i) glds16(rs, wA + i * 1024, oa[i], sA);
#pragma unroll
    for (int i = 0; i < 2; ++i) glds16(rs, wB + i * 1024, ob[i], sB);
    for (int kt = 0; kt < nk32; ++kt) {
        const unsigned char* cur = lds + (kt & 1) * 24576;
        __syncthreads();
        if (kt + 1 < nk32) {
            const int so = ((kt + 1) & 1) * 24576;
#pragma unroll
            for (int i = 0; i < 4; ++i) glds16(rs, wA + so + i * 1024, oa[i], sA + (kt + 1) * 64);
#pragma unroll
            for (int i = 0; i < 2; ++i) glds16(rs, wB + so + i * 1024, ob[i], sB + (kt + 1) * 64);
        }
        bf16x8 a[8], b[4];
#pragma unroll
        for (int n = 0; n < 4; ++n) b[n] = *(const bf16x8*)(cur + roffB + n * 1024);
#pragma unroll
        for (int m = 0; m < 8; ++m) a[m] = *(const bf16x8*)(cur + roffA + m * 1024);
#pragma unroll
        for (int m = 0; m < 8; ++m)
#pragma unroll
            for (int n = 0; n < 4; ++n) acc[m][n] = SWAP ? MFMA16(a[m], b[n], acc[m][n]) : MFMA16(b[n], a[m], acc[m][n]);
    }
    __syncthreads();
}

DEVI bool tile_map(int k, int ncol, int& mt, int& nt, int nrow = 256) {
    if (gridDim.x == 512) {
        const int x = blockIdx.x & 7, j = blockIdx.x >> 3;
        const int v = j + 64 * k;
        if (v >= (nrow >> 3) * ncol) return false;
        const int nfull = ncol >> 3, rem = ncol & 7;
        int mtl;
        const int pcg = nrow;
        if (v < nfull * pcg) { const int cg = v / pcg, w = v % pcg; mtl = (w >> 6) * 8 + ((w & 63) >> 3); nt = cg * 8 + (w & 7); }
        else { const int v2 = v - nfull * pcg, per = 8 * rem; const int rg = v2 / per, w = v2 % per; mtl = rg * 8 + w / rem; nt = nfull * 8 + w % rem; }
        mt = x * (nrow >> 3) + mtl;
        return true;
    }
    const int u = blockIdx.x + gridDim.x * k;
    if (u >= nrow * ncol) return false;
    mt = u / ncol; nt = u % ncol;
    return true;
}
struct RowLin { unsigned ldb; DEVI unsigned operator()(int r) const { return (unsigned)r * ldb; } };
struct RowLinPerm { unsigned ldb; DEVI unsigned operator()(int r) const { return (unsigned)((r & ~31) + perm32(r & 31)) * ldb; } };

DEVI int win_map(int j) {
    if (j < 896) return j;
    if (j < 1408) return j - 896 + 936;
    if (j < 2176) return j - 1408 + 1448;
    if (j < 2208) return j - 2176 + 896;
    if (j < 2216) return j - 2208 + 928;
    if (j < 2240) return j;
    if (j < 2304) return -1;
    return j - 64;
}

struct TJob { const float* src; bf16_t* dst; int K, ld, nrows, perm, nb; size_t sb, db; };
DEVI TJob get_tjob(const Params& P, int j) {
    unsigned char* ws = P.ws;
    switch (j) {
        case 0: return TJob{P.in[3], (bf16_t*)(ws + OFF_WIN_T), 1024, INW, WIN_ROWS, 1, 1, 0, 0};
        case 1: return TJob{P.in[10], (bf16_t*)(ws + OFF_WBRA), 512, 1024, 1024, 0, 1, 0, 0};
        case 2: return TJob{P.in[11], (bf16_t*)(ws + OFF_WBRB), 512, 1024, 1024, 0, 1, 0, 0};
        case 3: return TJob{P.in[12], (bf16_t*)(ws + OFF_WOUT), 1024, 1024, 1024, 0, 1, 0, 0};
        case 4: return TJob{P.in[5], (bf16_t*)(ws + OFF_W1K), 2048, 128, 128, 0, 1, 0, 0};
        case 5: return TJob{P.in[8], (bf16_t*)(ws + OFF_W1V), 2048, 128, 128, 0, 1, 0, 0};
        case 6: return TJob{P.in[6], (bf16_t*)(ws + OFF_W2K), 128, 64, 64, 0, 1, 0, 0};
        case 7: return TJob{P.in[9], (bf16_t*)(ws + OFF_W2V), 128, 64, 64, 0, 1, 0, 0};
        case 8: return TJob{P.in[18], (bf16_t*)(ws + OFF_WGU), 1024, 512, 512, 0, 32, (size_t)1024 * 512, (size_t)512 * 1024};
        default: return TJob{P.in[19], (bf16_t*)(ws + OFF_WDN), 256, 1024, 1024, 0, 32, (size_t)256 * 1024, (size_t)1024 * 256};
    }
}
DEVI int tjob_tiles(int j) {
    switch (j) {
        case 0: return (WIN_ROWS / 64) * 16;
        case 1: case 2: return 16 * 8;
        case 3: return 16 * 16;
        case 4: case 5: return 2 * 32;
        case 6: case 7: return 1 * 2;
        case 8: return 32 * 8 * 16;
        default: return 32 * 16 * 4;
    }
}

DEVI void transpose_tile(const TJob& J, int tile, unsigned char* lds, int tid) {
    float* T = (float*)lds;
    const int kt = J.K / 64, rt = J.nrows / 64;
    const int b = tile / (kt * rt), rem = tile % (kt * rt);
    const int r0 = (rem / kt) * 64, k0 = (rem % kt) * 64;
    const float* src = J.src + (size_t)b * J.sb;
    bf16_t* dst = J.dst + (size_t)b * J.db;
    const int n4 = (tid & 15) * 4;
    int col = r0 + n4; if (J.perm) col = win_map(col);
    f32x4 ld4[4];
#pragma unroll
    for (int i = 0; i < 4; ++i) {
        const int kk = (tid >> 4) + 16 * i;
        ld4[i] = (col >= 0) ? *(const f32x4*)(src + (size_t)(k0 + kk) * J.ld + col) : (f32x4){0.f, 0.f, 0.f, 0.f};
    }
#pragma unroll
    for (int i = 0; i < 4; ++i) {
        const int kk = (tid >> 4) + 16 * i;
#pragma unroll
        for (int e = 0; e < 4; ++e) T[kk * 65 + n4 + e] = ld4[i][e];
    }
    __syncthreads();
    const int r2 = tid >> 2, ks = (tid & 3) * 16;
    u32x4 w0, w1;
    w0.x = pk2(T[(ks + 0) * 65 + r2], T[(ks + 1) * 65 + r2]); w0.y = pk2(T[(ks + 2) * 65 + r2], T[(ks + 3) * 65 + r2]);
    w0.z = pk2(T[(ks + 4) * 65 + r2], T[(ks + 5) * 65 + r2]); w0.w = pk2(T[(ks + 6) * 65 + r2], T[(ks + 7) * 65 + r2]);
    w1.x = pk2(T[(ks + 8) * 65 + r2], T[(ks + 9) * 65 + r2]); w1.y = pk2(T[(ks + 10) * 65 + r2], T[(ks + 11) * 65 + r2]);
    w1.z = pk2(T[(ks + 12) * 65 + r2], T[(ks + 13) * 65 + r2]); w1.w = pk2(T[(ks + 14) * 65 + r2], T[(ks + 15) * 65 + r2]);
    bf16_t* d = dst + (size_t)(r0 + r2) * J.K + k0 + ks;
    *(u32x4*)d = w0; *(u32x4*)(d + 8) = w1;
    __syncthreads();
}

DEVI void rms_row_bf16(const float* xr, const float* g, bf16_t* o, int lane) {
    f32x4 v[4]; float ss = 0.f;
#pragma unroll
    for (int i = 0; i < 4; ++i) { v[i] = *(const f32x4*)(xr + i * 256 + lane * 4); ss += v[i][0] * v[i][0] + v[i][1] * v[i][1] + v[i][2] * v[i][2] + v[i][3] * v[i][3]; }
    ss = wave_sum(ss);
    const float rs = rsqrtf(ss * (1.0f / 1024.0f) + RMS_EPS);
#pragma unroll
    for (int i = 0; i < 4; ++i) {
        const f32x4 gg = *(const f32x4*)(g + i * 256 + lane * 4);
        u32x2 w; w.x = pk2(v[i][0] * rs * gg[0], v[i][1] * rs * gg[1]); w.y = pk2(v[i][2] * rs * gg[2], v[i][3] * rs * gg[3]);
        *(u32x2*)(o + i * 256 + lane * 4) = w;
    }
}

DEVI void phase_prep(const Params& P, unsigned char* lds, int tid, int part) {
    unsigned char* ws = P.ws;
    const int lane = tid & 63, wid = __builtin_amdgcn_readfirstlane(tid >> 6);
    int base = 0;
#pragma unroll
    for (int j = 0; j < 10; ++j) {
        const bool early = (j == 0) || (j >= 4 && j <= 7);
        if (early == (part == 0)) {
            const int nt = tjob_tiles(j);
            const TJob J = get_tjob(P, j);
            if (part == 1 && gridDim.x == 512) {
                const int pr = blockIdx.x & 255; const bool isA = blockIdx.x < 256;
                for (int k = 0; pr + 256 * k < nt; ++k) if (isA) transpose_tile(J, pr + 256 * k, lds, tid);
            } else
            for (int t = blockIdx.x; t < nt; t += gridDim.x) transpose_tile(J, t, lds, tid);
        }
    }
    (void)base;
    if (part == 1) {
        float* wr = (float*)(ws + OFF_WR);
        const float* g = P.in[13]; const float* wg = P.in[14]; const float* we = P.in[16];
        for (int e = blockIdx.x * NTHREADS + tid; e < 48 * 1024; e += gridDim.x * NTHREADS) {
            const int c = e >> 10, k = e & 1023;
            float v = 0.f;
            if (c < 4) v = wg[k * 4 + c]; else if (c < 36) v = we[k * 32 + (c - 4)];
            wr[e] = v * g[k];
        }
        return;
    }
    {
        const float* x = P.in[0]; const float* g = P.in[2]; bf16_t* hn = (bf16_t*)(ws + OFF_HN);
        for (int r = blockIdx.x * 4 + wid; r < NTOK; r += gridDim.x * 4) rms_row_bf16(x + (size_t)r * 1024, g, hn + (size_t)r * 1024, lane);
    }
    {
        f32x2* cs = (f32x2*)(ws + OFF_CS);
        for (int e = blockIdx.x * NTHREADS + tid; e < NTOK * 32; e += gridDim.x * NTHREADS) {
            const int tok = e >> 5, i = e & 31;
            const double a = (double)P.pos[tok] * P.inv_freq[i];
            double t = a * 0.15915494309189535;
            t -= floor(t);
            const float tf = (float)t;
            cs[e] = (f32x2){__builtin_amdgcn_cosf(tf), __builtin_amdgcn_sinf(tf)};
        }
    }
    {
        float* red = (float*)lds;
        for (int job = blockIdx.x; job < 32; job += gridDim.x) {
            const int kv = job >> 4, cg8 = job & 15;
            const float* pe = P.in[kv ? 7 : 4]; const float* w1 = P.in[kv ? 8 : 5];
            const int cc = tid & 7, jj = tid >> 3;
            float s = 0.f;
            for (int j = jj; j < 2048; j += 32) s += pe[j] * w1[(size_t)j * 128 + cg8 * 8 + cc];
            red[tid] = s;
            __syncthreads();
            if (tid < 8) { float t = 0.f; for (int u = 0; u < 32; ++u) t += red[u * 8 + tid]; ((float*)(ws + OFF_BIAS1))[kv * 128 + cg8 * 8 + tid] = t; }
            __syncthreads();
        }
    }
}

DEVI void st_bf16(bf16_t* p, float v) { *p = (bf16_t)f2bf(v); }

DEVI int gemm1_col_tile(int part, int i) {
    if (part == 0) return (i < 3) ? 4 + i : ((i < 5) ? 8 + i : 17);
    return (i < 4) ? i : ((i < 8) ? i + 3 : ((i < 12) ? i + 5 : i + 6));
}
template <bool PERM>
DEVI void st_row64(bf16_t* d, const f32x4 (&o)[4], int q) {
    if (PERM) {
#pragma unroll
        for (int g2 = 0; g2 < 2; ++g2) {
            u32x4 w; w.x = pk2(o[2 * g2][0], o[2 * g2][1]); w.y = pk2(o[2 * g2][2], o[2 * g2][3]); w.z = pk2(o[2 * g2 + 1][0], o[2 * g2 + 1][1]); w.w = pk2(o[2 * g2 + 1][2], o[2 * g2 + 1][3]);
            *(u32x4*)(d + g2 * 32 + q * 8) = w;
        }
    } else {
#pragma unroll
        for (int n = 0; n < 4; ++n) { u32x2 w; w.x = pk2(o[n][0], o[n][1]); w.y = pk2(o[n][2], o[n][3]); *(u32x2*)(d + n * 16 + q * 4) = w; }
    }
}
template <int MR, bool PERM = false>
DEVI void gemm1_epilogue(const Params& P, const f32x4 (&acc)[MR][4], int c64, int tok0, int q, int cl) {
    unsigned char* ws = P.ws;
    const f32x2* cs = (const f32x2*)(ws + OFF_CS);
    if (c64 < 10 || (c64 >= 14 && c64 < 34)) {
        bool do_rope; float scale = 1.f; int kind;
        int g = 0, hk = 0;
        if (c64 < 8) { kind = 0; do_rope = true; scale = 0.125f * LOG2E; }
        else if (c64 == 8) { kind = 1; do_rope = true; }
        else if (c64 == 9) { kind = 2; do_rope = false; }
        else if (c64 < 22) { kind = 3; do_rope = true; scale = 0.125f * LOG2E; }
        else { kind = 4; g = (c64 - 22) >> 1; hk = (c64 - 22) & 1; do_rope = (g == 2 || g == 4); }
#pragma unroll
        for (int m = 0; m < MR; ++m) {
            const int tok = tok0 + m * 16;
            f32x4 o[4], nr[4];
#pragma unroll
            for (int n = 0; n < 4; ++n) { nr[n] = acc[m][n] * scale; o[n] = nr[n]; }
            if (do_rope) {
#pragma unroll
                for (int n = 0; n < 2; ++n) {
                    const int c0 = PERM ? 8 * q + 4 * n : n * 16 + q * 4;
                    const f32x4 c01 = *(const f32x4*)(cs + (size_t)tok * 32 + c0);
                    const f32x4 c23 = *(const f32x4*)(cs + (size_t)tok * 32 + c0 + 2);
                    const float cc[4] = {c01[0], c01[2], c23[0], c23[2]}, sn[4] = {c01[1], c01[3], c23[1], c23[3]};
#pragma unroll
                    for (int j = 0; j < 4; ++j) {
                        const float x1 = nr[n][j], x2 = nr[n + 2][j];
                        o[n][j] = x1 * cc[j] - x2 * sn[j]; o[n + 2][j] = x1 * sn[j] + x2 * cc[j];
                    }
                }
            }
            if (kind == 0 || kind == 1 || kind == 2) {
                bf16_t* d = (kind == 0) ? (bf16_t*)(ws + OFF_QA) + (size_t)tok * 512 + c64 * 64 : (bf16_t*)(ws + (kind == 1 ? OFF_KA : OFF_VA)) + (size_t)tok * 64;
                st_row64<PERM>(d, o, q);
            } else if (kind == 3) {
                const int h = c64 - 14;
                bf16_t* dn = (bf16_t*)(ws + OFF_QBN) + (size_t)tok * 512 + h * 64; bf16_t* dr = (bf16_t*)(ws + OFF_QBR) + (size_t)tok * 512 + h * 64;
                st_row64<PERM>(dn, nr, q); st_row64<PERM>(dr, o, q);
            } else {
                bf16_t* d = (bf16_t*)(ws + OFF_KV + (size_t)g * KV_STRIDE);
                const int b = tok >> 12, tl = tok & 4095;
                if (g == 3 || g == 5) {
#pragma unroll
                    for (int n = 0; n < 4; ++n)
#pragma unroll
                        for (int j = 0; j < 4; ++j) st_bf16(d + ((size_t)((b * 2 + hk) * 64 + (PERM ? (n >> 1) * 32 + 8 * q + 4 * (n & 1) : n * 16 + q * 4) + j)) * 4096 + tl, o[n][j]);
                } else {
                    st_row64<PERM>(d + ((size_t)((b * 2 + hk) * 4096 + tl)) * 64, o, q);
                }
            }
        }
    } else if (!PERM && c64 >= 10 && c64 < 14) {
        bf16_t* d = (bf16_t*)(ws + OFF_QI);
#pragma unroll
        for (int m = 0; m < MR; ++m) {
            const int tok = tok0 + m * 16;
            float cc[4], sn[4];
#pragma unroll
            for (int j = 0; j < 4; ++j) { const f32x2 c = cs[(size_t)tok * 32 + 2 * (4 * q + j)]; cc[j] = c.x; sn[j] = c.y; }
#pragma unroll
            for (int hh = 0; hh < 2; ++hh) {
                const int head = 2 * (c64 - 10) + hh;
                f32x4 r1, r2;
#pragma unroll
                for (int j = 0; j < 4; ++j) { const float x1 = acc[m][2 * hh][j], x2 = acc[m][2 * hh + 1][j]; r1[j] = x1 * cc[j] - x2 * sn[j]; r2[j] = x1 * sn[j] + x2 * cc[j]; }
                u32x2 w; w.x = pk2(r1[0], r1[1]); w.y = pk2(r1[2], r1[3]); *(u32x2*)(d + (size_t)tok * 256 + head * 32 + q * 4) = w;
                u32x2 v; v.x = pk2(r2[0], r2[1]); v.y = pk2(r2[2], r2[3]); *(u32x2*)(d + (size_t)tok * 256 + head * 32 + 16 + q * 4) = v;
            }
        }
    } else if (c64 >= 36) {
        bf16_t* d = (bf16_t*)(ws + (c64 < 52 ? OFF_GA : OFF_GB));
        const int cb = (c64 < 52 ? c64 - 36 : c64 - 52) * 64;
#pragma unroll
        for (int m = 0; m < MR; ++m) {
            f32x4 sg[4];
#pragma unroll
            for (int n = 0; n < 4; ++n)
#pragma unroll
                for (int j = 0; j < 4; ++j) sg[n][j] = sigmoidf_(acc[m][n][j]);
            st_row64<PERM>(d + (size_t)(tok0 + m * 16) * 1024 + cb, sg, q);
        }
    } else if (!PERM && c64 == 34) {
        bf16_t* dki = (bf16_t*)(ws + OFF_KI); float* dwi = (float*)(ws + OFF_WI); float* dg = (float*)(ws + OFF_GATES);
#pragma unroll
        for (int m = 0; m < MR; ++m) {
            const int tok = tok0 + m * 16;
            f32x4 r1, r2;
#pragma unroll
            for (int j = 0; j < 4; ++j) {
                const f32x2 c = cs[(size_t)tok * 32 + 2 * (4 * q + j)];
                const float x1 = acc[m][0][j], x2 = acc[m][1][j];
                r1[j] = x1 * c.x - x2 * c.y; r2[j] = x1 * c.y + x2 * c.x;
            }
            u32x2 w; w.x = pk2(r1[0], r1[1]); w.y = pk2(r1[2], r1[3]); *(u32x2*)(dki + (size_t)tok * 32 + q * 4) = w;
            u32x2 v; v.x = pk2(r2[0], r2[1]); v.y = pk2(r2[2], r2[3]); *(u32x2*)(dki + (size_t)tok * 32 + 16 + q * 4) = v;
            if (q < 2) *(f32x4*)(dwi + (size_t)tok * 8 + q * 4) = acc[m][2];
            else { f32x4 sv; for (int j = 0; j < 4; ++j) sv[j] = sigmoidf_(acc[m][2][j]); *(f32x4*)(dg + (size_t)tok * 24 + (q * 4 - 8)) = sv; }
            { f32x4 sv; for (int j = 0; j < 4; ++j) sv[j] = sigmoidf_(acc[m][3][j]); *(f32x4*)(dg + (size_t)tok * 24 + 8 + q * 4) = sv; }
        }
    }
}

DEVI void phase_gemm1(const Params& P, unsigned char* lds, int tid, int part) {
    const rsrc_t rs = __builtin_amdgcn_make_buffer_rsrc((void*)P.ws, (short)0, (int)0x7fffffff, 0x00020000);
    const int lane = tid & 63, wid = __builtin_amdgcn_readfirstlane(tid >> 6), wr = wid >> 1, wc = wid & 1, q = lane >> 4, cl = lane & 15;
    constexpr int NT_N = G1_COLS / 128;
    if (part == 0) {
        for (int kk = 0;; ++kk) {
            int mt, nti;
            if (!tile_map(kk, 6, mt, nti)) break;
            const int nt = gemm1_col_tile(0, nti);
            f32x4 acc[4][4];
            gemm128(acc, rs, (unsigned)(OFF_HN + (size_t)mt * 128 * 2048), RowLin{2048}, (unsigned)(OFF_WIN_T + (size_t)nt * 128 * 2048), RowLin{2048}, 16, lds, tid);
            gemm1_epilogue<4>(P, acc, nt * 2 + wc, mt * 128 + wr * 64 + cl, q, cl);
        }
    } else {
        for (int kk = 0;; ++kk) {
            int mt, nti;
            if (!tile_map(kk, NT_N - 6, mt, nti, 128)) break;
            const int nt = gemm1_col_tile(1, nti);
            f32x4 acc[8][4];
            gemm256<false, false, true>(acc, rs, (unsigned)(OFF_HN + (size_t)mt * 256 * 2048), 2048u, (unsigned)(OFF_WIN_T + (size_t)nt * 128 * 2048), 2048u, 32, lds, tid);
            gemm1_epilogue<8, true>(P, acc, nt * 2 + wc, mt * 256 + wr * 128 + cl, q, cl);
        }
    }
}

DEVI float siluf_(float x) { return x * __builtin_amdgcn_rcpf(1.0f + __builtin_amdgcn_exp2f(-x * 1.4426950408889634f)); }

DEVI void phase_compress(const Params& P, unsigned char* lds, int tid) {
    unsigned char* ws = P.ws;
    const rsrc_t rs = __builtin_amdgcn_make_buffer_rsrc((void*)P.ws, (short)0, (int)0x7fffffff, 0x00020000);
    const int lane = tid & 63, wid = __builtin_amdgcn_readfirstlane(tid >> 6), wr = wid >> 1, wc = wid & 1, q = lane >> 4, cl = lane & 15;
    for (int u = blockIdx.x; u < 64; u += gridDim.x) {
        const int kv = u >> 5, mt = u & 31;
        const bf16_t* A = (const bf16_t*)(ws + OFF_KV + (size_t)kv * KV_STRIDE) + (size_t)mt * 128 * 1024;
        const bf16_t* W1 = (const bf16_t*)(ws + (kv ? OFF_W1V : OFF_W1K));
        const bf16_t* W2 = (const bf16_t*)(ws + (kv ? OFF_W2V : OFF_W2K));
        const float* bias = (const float*)(ws + OFF_BIAS1) + kv * 128;
        f32x4 acc[4][4];
        gemm128(acc, rs, (unsigned)(OFF_KV + (size_t)kv * KV_STRIDE + (size_t)mt * 128 * 2048), RowLin{2048}, (unsigned)(kv ? OFF_W1V : OFF_W1K), RowLin{4096}, 32, lds, tid);
#pragma unroll
        for (int m = 0; m < 4; ++m)
#pragma unroll
            for (int n = 0; n < 4; ++n) {
                const int col = wc * 64 + n * 16 + q * 4, row = wr * 64 + m * 16 + cl;
                const f32x4 bb = *(const f32x4*)(bias + col);
                const int ktile = col >> 6, ch = (col & 63) >> 3, wi = col & 7;
                u32x2 w; w.x = pk2(siluf_(acc[m][n][0] + bb[0]), siluf_(acc[m][n][1] + bb[1])); w.y = pk2(siluf_(acc[m][n][2] + bb[2]), siluf_(acc[m][n][3] + bb[3]));
                *(u32x2*)(lds + ktile * 16384 + row * 128 + ((ch ^ (row & 7)) << 4) + wi * 2) = w;
            }
#pragma unroll
        for (int i = 0; i < 4; ++i) {
            const int idx = tid + 256 * i;
            const int row = idx >> 4, ch16 = idx & 15, ktile = ch16 >> 3, ch = ch16 & 7;
            *(u32x4*)(lds + 32768 + ktile * 8192 + row * 128 + ((ch ^ (row & 7)) << 4)) = *(const u32x4*)(W2 + (size_t)row * 128 + ch16 * 8);
        }
        __syncthreads();
        f32x4 a2[4][2];
#pragma unroll
        for (int m = 0; m < 4; ++m) { a2[m][0] = (f32x4){0.f, 0.f, 0.f, 0.f}; a2[m][1] = (f32x4){0.f, 0.f, 0.f, 0.f}; }
#pragma unroll
        for (int kk = 0; kk < 4; ++kk) {
            const int ktile = kk >> 1, ks = kk & 1;
            bf16x8 a[4], b[2];
#pragma unroll
            for (int m = 0; m < 4; ++m) { const int row = wr * 64 + m * 16 + cl; a[m] = *(const bf16x8*)(lds + ktile * 16384 + row * 128 + (((ks * 4 + q) ^ (row & 7)) << 4)); }
#pragma unroll
            for (int n = 0; n < 2; ++n) { const int row = wc * 32 + n * 16 + cl; b[n] = *(const bf16x8*)(lds + 32768 + ktile * 8192 + row * 128 + (((ks * 4 + q) ^ (row & 7)) << 4)); }
#pragma unroll
            for (int m = 0; m < 4; ++m)
#pragma unroll
                for (int n = 0; n < 2; ++n) a2[m][n] = MFMA16(b[n], a[m], a2[m][n]);
        }
#pragma unroll
        for (int m = 0; m < 4; ++m)
#pragma unroll
            for (int n = 0; n < 2; ++n) {
                const int d = wc * 32 + n * 16 + q * 4;
                const int r = mt * 128 + wr * 64 + m * 16 + cl;
                const bool dead = ((r & 255) == 255);
                float v[4];
#pragma unroll
                for (int j = 0; j < 4; ++j) v[j] = dead ? 0.f : a2[m][n][j];
                if (kv == 0) {
                    bf16_t* kc = (bf16_t*)(ws + OFF_KC);
                    u32x2 w; w.x = pk2(v[0], v[1]); w.y = pk2(v[2], v[3]);
                    *(u32x2*)(kc + (size_t)r * 64 + d) = w;
                } else {
                    bf16_t* vct = (bf16_t*)(ws + OFF_VCT);
#pragma unroll
                    for (int j = 0; j < 4; ++j) st_bf16(vct + ((size_t)((r >> 8) * 64 + d + j)) * 256 + (r & 255), v[j]);
                }
            }
        __syncthreads();
    }
}

DEVI void phase_index(const Params& P, unsigned char* lds, int tid) {
    unsigned char* ws = P.ws;
    const bf16_t* QI = (const bf16_t*)(ws + OFF_QI);
    const bf16_t* KI = (const bf16_t*)(ws + OFF_KI);
    const float* WI = (const float*)(ws + OFF_WI);
    bf16_t* SEL = (bf16_t*)(ws + OFF_SEL);
    float* S = (float*)lds;
    const int lane = tid & 63, wid = __builtin_amdgcn_readfirstlane(tid >> 6), q = lane >> 4, cl = lane & 15;
    for (int u = blockIdx.x; u < NTOK / 4; u += gridDim.x) {
        const int b = u >> 10, w10 = u & 1023, s10 = (w10 < 512) ? w10 : 1535 - w10;
        const int t0 = s10 * 4, tok0 = b * 4096 + t0;
        const int t = t0 + wid;
        const int tok = tok0 + wid;
        if (t0 + 3 < 256) {
            for (int i = lane; i < 256; i += 64) SEL[(size_t)tok * 256 + i] = (bf16_t)(i <= t ? i : 0);
            continue;
        }
        {
            bf16x8 a[2];
#pragma unroll
            for (int hg = 0; hg < 2; ++hg) a[hg] = *(const bf16x8*)(QI + (size_t)(tok0 + (cl >> 2)) * 256 + (4 * hg + (cl & 3)) * 32 + q * 8);
            const f32x4 w0 = *(const f32x4*)(WI + (size_t)(tok0 + q) * 8), w1 = *(const f32x4*)(WI + (size_t)(tok0 + q) * 8 + 4);
            const int ktmax = (t0 + 3) >> 4;
            const bf16_t* kb = KI + (size_t)b * 4096 * 32 + cl * 32 + q * 8;
            float rz = 0.f, rinf = __builtin_inff();
            asm volatile("" : "+v"(rz), "+v"(rinf));
            bf16x8 bk[8], bn[8];
#pragma unroll
            for (int uu = 0; uu < 8; ++uu) { const int kt = (wid + 4 * uu <= ktmax) ? wid + 4 * uu : wid; bk[uu] = *(const bf16x8*)(kb + (size_t)kt * 16 * 32); }
            for (int kt0 = wid; kt0 <= ktmax; kt0 += 32) {
                if (kt0 + 32 <= ktmax) {
#pragma unroll
                    for (int uu = 0; uu < 8; ++uu) { const int kt = (kt0 + 32 + 4 * uu <= ktmax) ? kt0 + 32 + 4 * uu : kt0 + 32; bn[uu] = *(const bf16x8*)(kb + (size_t)kt * 16 * 32); }
                }
#pragma unroll
                for (int uu = 0; uu < 8; ++uu) {
                    const int kt = (kt0 + 4 * uu <= ktmax) ? kt0 + 4 * uu : kt0;
                    f32x4 c0 = {0.f, 0.f, 0.f, 0.f}, c1 = {0.f, 0.f, 0.f, 0.f};
                    c0 = MFMA16(a[0], bk[uu], c0); c1 = MFMA16(a[1], bk[uu], c1);
                    float sc = 0.f;
#pragma unroll
                    for (int j = 0; j < 4; ++j) sc = __builtin_fmaf(w0[j], __builtin_amdgcn_fmed3f(c0[j], rz, rinf), sc);
#pragma unroll
                    for (int j = 0; j < 4; ++j) sc = __builtin_fmaf(w1[j], __builtin_amdgcn_fmed3f(c1[j], rz, rinf), sc);
                    S[q * 4096 + kt * 16 + cl] = sc;
                }
#pragma unroll
                for (int uu = 0; uu < 8; ++uu) bk[uu] = bn[uu];
            }
        }
        __syncthreads();
        {
            const int n = t + 1;
            const float* Sq = S + wid * 4096;
            if (n <= 256) {
                for (int i = lane; i < 256; i += 64) SEL[(size_t)tok * 256 + i] = (bf16_t)(i <= t ? i : 0);
            } else {
                const int nr = (n + 63) >> 6;
                float x[64];
                const float NINF = -__builtin_inff(), PINF = __builtin_inff();
#pragma unroll
                for (int g8 = 0; g8 < 8; ++g8) {
                    if ((g8 * 8 + 8) * 64 <= n) {
#pragma unroll
                        for (int r = g8 * 8; r < g8 * 8 + 8; ++r) x[r] = Sq[r * 64 + lane];
                    } else if (g8 * 8 < nr) {
#pragma unroll
                        for (int r = g8 * 8; r < g8 * 8 + 8; ++r) { const int key = r * 64 + lane; const float v = Sq[key]; x[r] = (key < n) ? v : NINF; }
                    } else {
#pragma unroll
                        for (int r = g8 * 8; r < g8 * 8 + 8; ++r) x[r] = NINF;
                    }
                }
#define COUNT_GE(dst, thr) do { int c_ = 0; _Pragma("unroll") for (int g8 = 0; g8 < 8; ++g8) if (g8 * 8 < nr) { \
        _Pragma("unroll") for (int r = g8 * 8; r < g8 * 8 + 8; ++r) c_ += __popcll(__ballot(x[r] >= (thr))); } (dst) = c_; } while (0)
#define COUNT_GE_S(dst, thr) do { int c_ = 0; _Pragma("unroll") for (int g8 = 0; g8 < 8; ++g8) if (g8 * 8 < nr) { \
        c_ += __popcll(__ballot(x[g8 * 8] >= (thr))) + __popcll(__ballot(x[g8 * 8 + 4] >= (thr))); } (dst) = c_; } while (0)
                float T; int need;
                {
                    const bool samp = nr >= 16;
                    float s1 = 0.f, s2 = 0.f;
                    if (samp) {
#pragma unroll
                        for (int g8 = 0; g8 < 8; ++g8) if (g8 * 8 < nr) {
#pragma unroll
                            for (int r = g8 * 8; r < g8 * 8 + 8; r += 4) { const float v = (x[r] == NINF) ? 0.f : x[r]; s1 += v; s2 += v * v; }
                        }
                    } else {
#pragma unroll
                        for (int g8 = 0; g8 < 2; ++g8) if (g8 * 8 < nr) {
#pragma unroll
                            for (int r = g8 * 8; r < g8 * 8 + 8; ++r) { const float v = (x[r] == NINF) ? 0.f : x[r]; s1 += v; s2 += v * v; }
                        }
                    }
                    s1 = wave_sum_f32_dpp(s1); s2 = wave_sum_f32_dpp(s2);
                    const int nsi = samp ? 64 * ((nr + 2) >> 2) + ((((nr - 1) & 3) == 0) ? n - (nr - 1) * 64 : 0) : n;
                    const float fn = (float)n, fns = (float)nsi, mu = s1 / fns;
                    const float sg = sqrtf(fmaxf(s2 / fns - mu * mu, 1e-20f));
                    float vg;
                    {
                        const float pq = 256.0f / fn, pp = fminf(pq, 1.0f - pq);
                        const float tt = sqrtf(-2.0f * __logf(fmaxf(pp, 1e-6f)));
                        const float zz = tt - (2.515517f + 0.802853f * tt + 0.010328f * tt * tt) / (1.0f + 1.432788f * tt + 0.189269f * tt * tt + 0.001308f * tt * tt * tt);
                        vg = mu + ((pq <= 0.5f) ? zz : -zz) * sg;
                    }
                    if (samp) {
                        const float tgs = 256.0f * fns / fn;
                        for (int it = 0; it < 3; ++it) {
                            int cs; COUNT_GE_S(cs, vg);
                            const float zv = (vg - mu) / sg;
                            const float dens = fmaxf(fns * 0.39894228f * __expf(-0.5f * zv * zv), 0.5f) / sg;
                            const float dc = (float)cs - tgs;
                            vg += dc / dens;
                            if (fabsf(dc) <= 2.0f) break;
                        }
                    }
                    float lo = NINF, hi = PINF; int clo = n, chi = 0;
                    bool found = false, adjacent = false; float thr = 0.f;
                    for (int it = 0; it < 256; ++it) {
                        if (clo - chi <= 64) break;
                        float v = vg;
                        if (!(v > lo && v < hi) || (it & 3) == 3) {
                            const int kl = fkey(lo), kh = fkey(hi);
                            const int km = (kl >> 1) + (kh >> 1) + (kl & kh & 1);
                            if (km == kl) { adjacent = true; break; }
                            v = __builtin_bit_cast(float, fkey(__builtin_bit_cast(float, km)));
                        }
                        int c; COUNT_GE(c, v);
                        if (c == 256) { found = true; thr = v; break; }
                        if (c > 256) { lo = v; clo = c; } else { hi = v; chi = c; }
                        const float zv = (v - mu) / sg;
                        const float dens = fmaxf(fn * 0.39894228f * __expf(-0.5f * zv * zv), 0.5f) / sg;
                        vg = v + ((float)c - ((c > 256) ? 244.0f : 268.0f)) / dens;
                    }
                    if (found) { T = thr; need = -1; }
                    else if (adjacent) { T = lo; need = 256 - chi; }
                    else {
                        if (lo == NINF) lo = -3.4028234e38f;
                        float* cand = (float*)(lds + 65536) + wid * 64;
                        cand[lane] = NINF;
                        int cb = 0;
                        const unsigned long long ltm = (1ull << lane) - 1ull;
#pragma unroll
                        for (int g8 = 0; g8 < 8; ++g8) if (g8 * 8 < nr) {
#pragma unroll
                            for (int r = g8 * 8; r < g8 * 8 + 8; ++r) {
                                const bool isc = (x[r] >= lo) && (x[r] < hi);
                                const unsigned long long bm = __ballot(isc);
                                if (bm != 0ull) {
                                    const int pos = cb + __popcll(bm & ltm);
                                    if (isc && pos < 64) cand[pos] = x[r];
                                    cb += __popcll(bm);
                                }
                            }
                        }
                        const float y = cand[lane];
                        int cgt = 0;
#pragma unroll
                        for (int k4 = 0; k4 < 16; ++k4) {
                            const f32x4 c4 = *(const f32x4*)(cand + 4 * k4);
                            cgt += (c4[0] > y ? 1 : 0) + (c4[1] > y ? 1 : 0) + (c4[2] > y ? 1 : 0) + (c4[3] > y ? 1 : 0);
                        }
                        const int nd = 256 - chi;
                        T = wave_min_f32_dpp((cgt <= nd - 1) ? y : PINF);
                        need = nd - (int)__popcll(__ballot(y > T));
                    }
                }
                bf16_t* selb = (bf16_t*)(lds + 65536 + 1024) + wid * 256;
                int wlo = 0, whi = 0, tot = 0;
#pragma unroll
                for (int g8 = 0; g8 < 8; ++g8) if (g8 * 8 < nr) {
#pragma unroll
                    for (int r = g8 * 8; r < g8 * 8 + 8; ++r) {
                        const unsigned long long m = __ballot(x[r] >= T);
                        tot += __popcll(m);
                        asm volatile("v_writelane_b32 %0, %1, %2" : "+v"(wlo) : "s"((unsigned)m), "n"(r));
                        asm volatile("v_writelane_b32 %0, %1, %2" : "+v"(whi) : "s"((unsigned)(m >> 32)), "n"(r));
                    }
                }
                if (tot == 256) {
                    const int cw = __popc((unsigned)wlo) + __popc((unsigned)whi);
                    int pos = 0;
#pragma unroll
                    for (int bb = 0; bb < 7; ++bb) {
                        const unsigned long long bmk = __ballot(((cw >> bb) & 1) != 0);
                        pos += (int)__builtin_amdgcn_mbcnt_hi((unsigned)(bmk >> 32), __builtin_amdgcn_mbcnt_lo((unsigned)bmk, 0u)) << bb;
                    }
                    unsigned long long w = ((unsigned long long)(unsigned)whi << 32) | (unsigned long long)(unsigned)wlo;
                    while (w != 0ull) {
                        const int bpos = (int)__builtin_ctzll(w);
                        selb[pos++] = (bf16_t)(lane * 64 + bpos);
                        w &= w - 1ull;
                    }
                } else {
                    if (need < 0) need = 0x7fffffff;
                    int base = 0, eqc = 0;
                    const unsigned long long lt = (1ull << lane) - 1ull;
#pragma unroll
                    for (int g8 = 0; g8 < 8; ++g8) if (g8 * 8 < nr) {
#pragma unroll
                        for (int r = g8 * 8; r < g8 * 8 + 8; ++r) {
                            const bool eq = (x[r] == T);
                            const unsigned long long em = __ballot(eq);
                            const bool sel = (x[r] > T) || (eq && (eqc + __popcll(em & lt) < need));
                            eqc += __popcll(em);
                            const unsigned long long sm = __ballot(sel);
                            if (sel) { const int pp = base + __popcll(sm & lt); if (pp < 256) selb[pp] = (bf16_t)(r * 64 + lane); }
                            base += __popcll(sm);
                        }
                    }
                }
                __builtin_amdgcn_wave_barrier();
                if (lane < 32) *(u32x4*)(SEL + (size_t)tok * 256 + lane * 8) = *(const u32x4*)(selb + lane * 8);
                __builtin_amdgcn_wave_barrier();
            }
        }
        __syncthreads();
    }
}

DEVI int dsa_vswz(int row) { return (((row >> 1) & 1) << 1) | (((row >> 3) & 1) << 2); }
DEVI void phase_dsa(const Params& P, unsigned char* lds, int tid) {
    unsigned char* ws = P.ws;
    const bf16_t* QA = (const bf16_t*)(ws + OFF_QA);
    const bf16_t* KA = (const bf16_t*)(ws + OFF_KA);
    const bf16_t* VA = (const bf16_t*)(ws + OFF_VA);
    const bf16_t* SEL = (const bf16_t*)(ws + OFF_SEL);
    bf16_t* OA = (bf16_t*)(ws + OFF_OA);
    const int lane = tid & 63, wid = __builtin_amdgcn_readfirstlane(tid >> 6), q = lane >> 4, cl = lane & 15;
    unsigned char* vl0 = lds + wid * 16384;
    const rsrc_t rsd = __builtin_amdgcn_make_buffer_rsrc((void*)P.ws, (short)0, (int)0x7fffffff, 0x00020000);
    const float NINF = -__builtin_inff();
    const bool xl = (gridDim.x == 512);
    const int stride = xl ? 256 : gridDim.x * 4;
    int tok = xl ? ((blockIdx.x & 7) * 4096 + (blockIdx.x >> 3) * 4 + wid) : blockIdx.x * 4 + wid;
    const int tend = xl ? ((blockIdx.x & 7) + 1) * 4096 : NTOK;
    if (tok >= tend) return;
    int kidx[16], mk[4]; bf16x8 bq[2];
    {
        const bf16_t* sel = SEL + (size_t)tok * 256;
#pragma unroll
        for (int rf = 0; rf < 16; ++rf) kidx[rf] = sel[32 * (rf >> 1) + 8 * (cl >> 2) + 4 * (rf & 1) + (cl & 3)];
#pragma unroll
        for (int cc = 0; cc < 4; ++cc) mk[cc] = sel[cc * 64 + lane];
#pragma unroll
        for (int ks = 0; ks < 2; ++ks) bq[ks] = *(const bf16x8*)(QA + (size_t)tok * 512 + (cl & 7) * 64 + ks * 32 + q * 8);
    }
    const int wrow = lane >> 3;
    for (; tok < tend; tok += stride) {
        const int b = tok >> 12, t = tok & 4095;
        const int cnt = (t + 1 < 256) ? t + 1 : 256;
        const int nc64 = (cnt + 63) >> 6;
        const bf16_t* kb = KA + (size_t)b * 4096 * 64;
        const bf16_t* vb = VA + (size_t)b * 4096 * 64;
        const bf16x8 zero8 = {0, 0, 0, 0, 0, 0, 0, 0};
        const bf16x8 bq0 = (cl < 8) ? bq[0] : zero8, bq1 = (cl < 8) ? bq[1] : zero8;
        const unsigned sVb = (unsigned)OFF_VA + (unsigned)b * 4096u * 128u;
#pragma unroll
        for (int i = 0; i < 8; ++i) {
            const int row = wrow + 8 * i; const int key = __shfl(mk[0], row);
            glds16(rsd, vl0 + i * 1024, (unsigned)key * 128u + (unsigned)(((lane & 7) ^ dsa_vswz(row)) << 4), sVb);
        }
        f32x4 s[16];
#pragma unroll
        for (int rf = 0; rf < 16; ++rf) {
            s[rf] = (f32x4){0.f, 0.f, 0.f, 0.f};
            if ((rf >> 2) < nc64) {
                const bf16_t* kr = kb + (size_t)kidx[rf] * 64 + q * 8;
                const bf16x8 a0 = *(const bf16x8*)(kr), a1 = *(const bf16x8*)(kr + 32);
                s[rf] = MFMA16(a0, bq0, s[rf]); s[rf] = MFMA16(a1, bq1, s[rf]);
            }
            if ((rf & 3) == 3) asm volatile("" ::: "memory");
        }
        int mkc[4];
#pragma unroll
        for (int cc = 0; cc < 4; ++cc) mkc[cc] = mk[cc];
        {
            const int tn = (tok + stride < tend) ? tok + stride : tok;
            const bf16_t* sel = SEL + (size_t)tn * 256;
#pragma unroll
            for (int rf = 0; rf < 16; ++rf) kidx[rf] = sel[32 * (rf >> 1) + 8 * (cl >> 2) + 4 * (rf & 1) + (cl & 3)];
#pragma unroll
            for (int cc = 0; cc < 4; ++cc) mk[cc] = sel[cc * 64 + lane];
#pragma unroll
            for (int ks = 0; ks < 2; ++ks) bq[ks] = *(const bf16x8*)(QA + (size_t)tn * 512 + (cl & 7) * 64 + ks * 32 + q * 8);
        }
        float mx = NINF;
#pragma unroll
        for (int rf = 0; rf < 16; ++rf)
#pragma unroll
            for (int j = 0; j < 4; ++j) {
                const int p = 32 * (rf >> 1) + 8 * q + 4 * (rf & 1) + j;
                if (p >= cnt) s[rf][j] = NINF;
                mx = fmaxf(mx, s[rf][j]);
            }
        mx = rows_max(mx);
        float ls = 0.f;
#pragma unroll
        for (int rf = 0; rf < 16; ++rf)
#pragma unroll
            for (int j = 0; j < 4; ++j) { const float pv = __builtin_amdgcn_exp2f(s[rf][j] - mx); s[rf][j] = pv; ls += pv; }
        ls = rows_sum(ls);
        const float inv = __builtin_amdgcn_rcpf(ls);
        bf16x8 pbs[8];
#pragma unroll
        for (int c8 = 0; c8 < 8; ++c8) pbs[c8] = pack8(s[2 * c8], s[2 * c8 + 1]);
        f32x4 o[4];
#pragma unroll
        for (int d = 0; d < 4; ++d) o[d] = (f32x4){0.f, 0.f, 0.f, 0.f};
#pragma unroll
        for (int cc = 0; cc < 4; ++cc) {
            if (cc < nc64) {
                unsigned char* vl = vl0 + (cc & 1) * 8192;
                asm volatile("s_waitcnt vmcnt(0)" ::: "memory");
                __builtin_amdgcn_wave_barrier();
                if (cc + 1 < 4 && cc + 1 < nc64) {
                    unsigned char* vn = vl0 + ((cc + 1) & 1) * 8192;
#pragma unroll
                    for (int i = 0; i < 8; ++i) {
                        const int row = wrow + 8 * i; const int key = __shfl(mkc[(cc + 1) & 3], row);
                        glds16(rsd, vn + i * 1024, (unsigned)key * 128u + (unsigned)(((lane & 7) ^ dsa_vswz(row)) << 4), sVb);
                    }
                }
#pragma unroll
                for (int c2 = 0; c2 < 2; ++c2) {
                    const bf16x8 pb = pbs[cc * 2 + c2];
#pragma unroll
                    for (int d = 0; d < 4; ++d) {
                        const int r0 = c2 * 32 + 8 * q + (cl >> 2), r1 = r0 + 4;
                        const int ch = d * 2 + ((cl & 3) >> 1), wb = 8 * (cl & 1);
                        const s16x4 lo4 = __builtin_amdgcn_ds_read_tr16_b64_v4i16((LAS s16x4*)((LAS unsigned char*)(vl) + r0 * 128 + ((ch ^ dsa_vswz(r0)) << 4) + wb));
                        const s16x4 hi4 = __builtin_amdgcn_ds_read_tr16_b64_v4i16((LAS s16x4*)((LAS unsigned char*)(vl) + r1 * 128 + ((ch ^ dsa_vswz(r1)) << 4) + wb));
                        const bf16x8 av = {lo4[0], lo4[1], lo4[2], lo4[3], hi4[0], hi4[1], hi4[2], hi4[3]};
                        o[d] = MFMA16(av, pb, o[d]);
                    }
                }
            }
        }
        if (cl < 8) {
#pragma unroll
            for (int d = 0; d < 4; ++d) {
                u32x2 w; w.x = pk2(o[d][0] * inv, o[d][1] * inv); w.y = pk2(o[d][2] * inv, o[d][3] * inv);
                *(u32x2*)(OA + (size_t)tok * 512 + cl * 64 + d * 16 + q * 4) = w;
            }
        }
    }
}

DEVI int fK(int row) { return (row & 3) | (((row >> 3) & 1) << 2); }

struct AttnState { f32x4 O[4][4]; float m[4]; f32x4 L[4]; f32x4 negm[4]; bool uninit; };
DEVI void attn_init(AttnState& st) {
#pragma unroll
    for (int cf = 0; cf < 4; ++cf) {
        st.m[cf] = -__builtin_inff(); st.L[cf] = (f32x4){0.f, 0.f, 0.f, 0.f};
        f32x4 z = (f32x4){0.f, 0.f, 0.f, 0.f}; asm volatile("" : "+v"(z)); st.negm[cf] = z;
#pragma unroll
        for (int d = 0; d < 4; ++d) st.O[d][cf] = (f32x4){0.f, 0.f, 0.f, 0.f};
    }
    st.uninit = true;
}
DEVI int imax(int a, int b) { return a > b ? a : b; }
DEVI int f2i(float x) { return __builtin_bit_cast(int, x); }

template <int MODE>
DEVI void attn_tile(const unsigned char* ktile, const unsigned char* vtile, int jb, const bf16x8 (&qf)[4][2], AttnState& st,
                    int tq, int nmax, bool lane_on, const bf16x8& ones_frag, int q, int cl) {
    const float NINF = -__builtin_inff();
    bool edge;
    if (MODE == 0) edge = (jb * 64 + 63 > nmax);
    else if (MODE == 1) edge = (jb * 64 + 63 > tq);
    else edge = (jb * 64 + 63 > tq) || (jb * 64 <= tq - 512);
    const bool need_mask = __ballot(edge) != 0ull;
    const unsigned lanemask = (MODE == 1 && !lane_on) ? 0u : 0xffffffffu;
#pragma unroll
        for (int c = 0; c < 2; ++c) {
            f32x4 S[2][4];
#pragma unroll
            for (int r2 = 0; r2 < 2; ++r2) {
                const int kl = 32 * c + 8 * (cl >> 2) + 4 * r2 + (cl & 3);
#pragma unroll
                for (int ks = 0; ks < 2; ++ks) {
                    const bf16x8 a = *(const bf16x8*)(ktile + kl * 128 + (((ks * 4 + q) ^ (cl & 7)) << 4));
#pragma unroll
                    for (int cf = 0; cf < 4; ++cf) S[r2][cf] = MFMA16(a, qf[cf][ks], ks == 0 ? st.negm[cf] : S[r2][cf]);
                }
            }
            if (need_mask) {
#pragma unroll
                for (int cf = 0; cf < 4; ++cf)
#pragma unroll
                    for (int r2 = 0; r2 < 2; ++r2)
#pragma unroll
                        for (int j = 0; j < 4; ++j) {
                            const int key = jb * 64 + 32 * c + 8 * q + 4 * r2 + j;
                            bool v;
                            if (MODE == 0) v = key <= nmax;
                            else if (MODE == 1) v = lane_on && key <= tq;
                            else v = key <= tq && key > tq - 512;
                            if (!v) S[r2][cf][j] = NINF;
                        }
            }
            int ball;
            {
                int bi[4];
#pragma unroll
                for (int cf = 0; cf < 4; ++cf) {
                    const int x0 = f2i(S[0][cf][0]), x1 = f2i(S[0][cf][1]), x2 = f2i(S[0][cf][2]), x3 = f2i(S[0][cf][3]);
                    const int y0 = f2i(S[1][cf][0]), y1 = f2i(S[1][cf][1]), y2 = f2i(S[1][cf][2]), y3 = f2i(S[1][cf][3]);
                    bi[cf] = imax(imax(imax(x0, x1), x2), imax(imax(imax(x3, y0), y1), imax(y2, y3)));
                }
                ball = imax(imax(bi[0], bi[1]), imax(bi[2], bi[3]));
            }
            bool trig = ball > 0x41000000;
            if (MODE == 1) trig = trig && lane_on;
            if (st.uninit || __ballot(trig) != 0ull) {
                bool un = false;
#pragma unroll
                for (int cf = 0; cf < 4; ++cf) {
                    float bml = fmaxf(fmaxf(fmaxf(S[0][cf][0], S[0][cf][1]), fmaxf(S[0][cf][2], S[0][cf][3])), fmaxf(fmaxf(S[1][cf][0], S[1][cf][1]), fmaxf(S[1][cf][2], S[1][cf][3])));
                    if (MODE == 1) bml = lane_on ? bml : NINF;
                    const float bm = rows_max(bml);
                    const float oldref = (st.m[cf] == NINF) ? 0.f : st.m[cf];
                    const float mnew = fmaxf(st.m[cf], bm + oldref);
                    const float newref = (mnew == NINF) ? 0.f : mnew;
                    const float alpha = __builtin_amdgcn_exp2f(st.m[cf] - newref);
                    const float delta = newref - oldref;
#pragma unroll
                    for (int r2 = 0; r2 < 2; ++r2)
#pragma unroll
                        for (int j = 0; j < 4; ++j) S[r2][cf][j] -= delta;
                    st.m[cf] = mnew;
                    f32x4 nm = (f32x4){-newref, -newref, -newref, -newref}; asm volatile("" : "+v"(nm)); st.negm[cf] = nm;
                    st.L[cf] *= alpha;
#pragma unroll
                    for (int d = 0; d < 4; ++d) st.O[d][cf] *= alpha;
                    un = un || (__ballot(mnew == NINF) != 0ull);
                }
                st.uninit = un;
            }
            bf16x8 pb[4];
#pragma unroll
            for (int cf = 0; cf < 4; ++cf) {
#pragma unroll
                for (int r2 = 0; r2 < 2; ++r2)
#pragma unroll
                    for (int j = 0; j < 4; ++j) S[r2][cf][j] = __builtin_amdgcn_exp2f(S[r2][cf][j]);
                pb[cf] = pack8(S[0][cf], S[1][cf]);
                if (MODE == 1) { u32x4 w = __builtin_bit_cast(u32x4, pb[cf]); w.x &= lanemask; w.y &= lanemask; w.z &= lanemask; w.w &= lanemask; pb[cf] = __builtin_bit_cast(bf16x8, w); }
                st.L[cf] = MFMA16(ones_frag, pb[cf], st.L[cf]);
            }
#pragma unroll
            for (int d = 0; d < 4; ++d) {
                const int row = d * 16 + cl;
                const bf16x8 av = *(const bf16x8*)(vtile + row * 128 + (((c * 4 + q) ^ (row & 7)) << 4));
#pragma unroll
                for (int cf = 0; cf < 4; ++cf) st.O[d][cf] = MFMA16(av, pb[cf], st.O[d][cf]);
            }
        }
}

template <int MODE>
DEVI void attn_blocks(rsrc_t rs, unsigned sK, unsigned sV, int ldv, int jb0, int jb1, const bf16x8 (&qf)[4][2], AttnState& st,
                      int tq, unsigned long long selmask, unsigned char* lds, int tid) {
    const int lane = tid & 63, q = lane >> 4, cl = lane & 15;
    const float NINF = -__builtin_inff();
    const short one_bf = (cl == 0) ? (short)0x3F80 : (short)0;
    const bf16x8 ones_frag = {one_bf, one_bf, one_bf, one_bf, one_bf, one_bf, one_bf, one_bf};
    attn_init(st);
    if (jb1 < jb0) return;
    const int wid_ = __builtin_amdgcn_readfirstlane(tid >> 6);
    unsigned kro[2], vro[2];
#pragma unroll
    for (int i = 0; i < 2; ++i) {
        const int row = (wid_ * 2 + i) * 8 + (lane >> 3);
        kro[i] = (unsigned)(row * 64 + (((lane & 7) ^ fK(row)) << 3)) * 2u;
        vro[i] = (unsigned)(((row & ~31) + perm32(row & 31)) * ldv + (((lane & 7) ^ (row & 7)) << 3)) * 2u;
    }
    unsigned char* wk = lds + wid_ * 2048;
#pragma unroll
    for (int i = 0; i < 2; ++i) { glds16(rs, wk + i * 1024, kro[i], sK + (unsigned)jb0 * 8192u); glds16(rs, wk + 8192 + i * 1024, vro[i], sV + (unsigned)jb0 * 128u); }
    __syncthreads();
    const int nmax = (tq >= 31) ? ((tq - 31) >> 4) : -1;
    for (int jb = jb0; jb <= jb1; ++jb) {
        unsigned char* cur = lds + ((jb - jb0) & 1) * 16384;
        const bool more = jb < jb1;
        if (more) {
            unsigned char* wn = wk + ((jb - jb0 + 1) & 1) * 16384;
#pragma unroll
            for (int i = 0; i < 2; ++i) { glds16(rs, wn + i * 1024, kro[i], sK + (unsigned)(jb + 1) * 8192u); glds16(rs, wn + 8192 + i * 1024, vro[i], sV + (unsigned)(jb + 1) * 128u); }
        }
        bool lane_on = true;
        if (MODE == 1) lane_on = ((selmask >> jb) & 1ull) != 0ull;
        if (MODE == 0) lane_on = (jb * 64 <= nmax);
        if (MODE == 2) lane_on = (jb * 64 + 63 > tq - 512);
        if (__ballot(lane_on) != 0ull) attn_tile<MODE>(cur, cur + 8192, jb, qf, st, tq, nmax, lane_on, ones_frag, q, cl);
        __syncthreads();
    }
}

DEVI f32x4 bload16f(rsrc_t r, unsigned voff, unsigned soff) { return __builtin_bit_cast(f32x4, __builtin_amdgcn_raw_buffer_load_b128(r, (int)voff, (int)soff, 0)); }
DEVI void bstore16f(rsrc_t r, f32x4 v, unsigned voff, unsigned soff) { __builtin_amdgcn_raw_buffer_store_b128(__builtin_bit_cast(u32x4, v), r, (int)voff, (int)soff, 0); }
DEVI float bload4f(rsrc_t r, unsigned voff, unsigned soff) { return __builtin_bit_cast(float, __builtin_amdgcn_raw_buffer_load_b32(r, (int)voff, (int)soff, 0)); }

struct NsaUnit { int i, b, k, t0, tq; unsigned tokw, tokb, qoff, goff, ooff, sQ, sG, sO; };
DEVI NsaUnit nsa_unit(int uu, int tid) {
    NsaUnit U;
    const int lane = tid & 63, wid = __builtin_amdgcn_readfirstlane(tid >> 6), q = lane >> 4, cl = lane & 15;
    const int half = uu >> 9, r = uu & 511, bk = r & 15, ii = r >> 4;
    U.i = half ? ii : 63 - ii; U.b = bk >> 1; U.k = bk & 1;
    U.t0 = U.i * 64; U.tq = U.t0 + wid * 16 + cl;
    U.tokw = (unsigned)(wid * 16 + cl);
    U.tokb = (unsigned)(U.b * 4096 + U.t0);
    U.qoff = U.tokw * 1024u + (unsigned)q * 16u;
    U.goff = U.tokw * 96u;
    U.ooff = U.tokw * 1024u + (unsigned)q * 16u;
    U.sQ = U.tokb * 1024u + (unsigned)U.k * 512u;
    U.sG = (unsigned)OFF_GATES + U.tokb * 96u + (unsigned)U.k * 16u;
    U.sO = (unsigned)OFF_OB + U.tokb * 1024u + (unsigned)U.k * 512u;
    return U;
}

DEVI void nsa_cmp_unit(const Params& P, rsrc_t rs, int uu, unsigned char* lds, int tid) {
    const int lane = tid & 63, wid = __builtin_amdgcn_readfirstlane(tid >> 6), q = lane >> 4, cl = lane & 15;
    const NsaUnit U = nsa_unit(uu, tid);
    const int i = U.i, b = U.b, k = U.k, tq = U.tq;
    const float NINF = -__builtin_inff();
    AttnState st;
    bf16x8 qf[4][2];
#pragma unroll
    for (int cf = 0; cf < 4; ++cf)
#pragma unroll
        for (int ks = 0; ks < 2; ++ks) qf[cf][ks] = __builtin_bit_cast(bf16x8, bload16(rs, U.qoff, (unsigned)OFF_QBN + U.sQ + cf * 128 + ks * 64));
    const unsigned sKC = (unsigned)OFF_KC + (unsigned)(b * 2 + k) * 256u * 128u;
    const unsigned sVC = (unsigned)OFF_VCT + (unsigned)(b * 2 + k) * 64u * 512u;
    const int nmax_blk = (U.t0 + 63 - 31) >> 4;
    const int jbc = (nmax_blk >> 6) < 3 ? (nmax_blk >> 6) : 3;
    {
        unsigned kro[2], vro[2];
#pragma unroll
        for (int ii = 0; ii < 2; ++ii) {
            const int row = (wid * 2 + ii) * 8 + (lane >> 3);
            kro[ii] = (unsigned)(row * 64 + (((lane & 7) ^ fK(row)) << 3)) * 2u;
            vro[ii] = (unsigned)(((row & ~31) + perm32(row & 31)) * 256 + (((lane & 7) ^ (row & 7)) << 3)) * 2u;
        }
        for (int kb = 0; kb <= jbc; ++kb) {
#pragma unroll
            for (int ii = 0; ii < 2; ++ii) {
                glds16(rs, lds + kb * 8192 + wid * 2048 + ii * 1024, kro[ii], sKC + (unsigned)kb * 8192u);
                glds16(rs, lds + 32768 + kb * 8192 + wid * 2048 + ii * 1024, vro[ii], sVC + (unsigned)kb * 128u);
            }
        }
    }
    const short one_bf = (cl == 0) ? (short)0x3F80 : (short)0;
    const bf16x8 ones_frag = {one_bf, one_bf, one_bf, one_bf, one_bf, one_bf, one_bf, one_bf};
    attn_init(st);
    const int nmax = (tq >= 31) ? ((tq - 31) >> 4) : -1;
    __syncthreads();
    for (int kb = 0; kb <= jbc; ++kb) {
        const bool lane_on = (kb * 64 <= nmax);
        if (__ballot(lane_on) != 0ull) attn_tile<0>(lds + kb * 8192, lds + 32768 + kb * 8192, kb, qf, st, tq, nmax, lane_on, ones_frag, q, cl);
    }
    float linv[4], mfin[4];
#pragma unroll
    for (int cf = 0; cf < 4; ++cf) {
        const float l = rows_sum(st.L[cf][0]);
        linv[cf] = (l > 0.f) ? __builtin_amdgcn_rcpf(l) : 0.f; mfin[cf] = st.m[cf];
        const float sc = linv[cf] * bload4f(rs, U.goff, U.sG + cf * 4);
#pragma unroll
        for (int g2 = 0; g2 < 2; ++g2) { const f32x4 v0 = st.O[2 * g2][cf] * sc, v1 = st.O[2 * g2 + 1][cf] * sc;
            u32x4 w; w.x = pk2(v0[0], v0[1]); w.y = pk2(v0[2], v0[3]); w.z = pk2(v1[0], v1[1]); w.w = pk2(v1[2], v1[3]);
            __builtin_amdgcn_raw_buffer_store_b128(w, rs, (int)U.ooff, (int)(U.sO + cf * 128 + g2 * 64), 0); }
    }
    unsigned long long* MSKG = (unsigned long long*)(P.ws + OFF_MASK);
    if (i < 16) {
        if (q == 0) MSKG[((size_t)(b * 2 + k)) * 4096 + tq] = (2ull << i) - 1ull;
        __syncthreads();
        return;
    }
    float* SUM4 = (float*)(lds + 32768);
    float* LAST = (float*)(lds + 49152);
    float* IMP2 = (float*)(lds);
    __syncthreads();
    for (int kb = 0; kb <= jbc; ++kb) {
        const unsigned char* ktile = lds + kb * 8192;
#pragma unroll
        for (int rf = 0; rf < 4; ++rf) {
            f32x4 S[4];
#pragma unroll
            for (int cf = 0; cf < 4; ++cf) S[cf] = (f32x4){0.f, 0.f, 0.f, 0.f};
            const int kl = 32 * (rf >> 1) + 8 * (cl >> 2) + 4 * (rf & 1) + (cl & 3);
#pragma unroll
            for (int ks = 0; ks < 2; ++ks) {
                const bf16x8 a = *(const bf16x8*)(ktile + kl * 128 + (((ks * 4 + q) ^ (cl & 7)) << 4));
#pragma unroll
                for (int cf = 0; cf < 4; ++cf) S[cf] = MFMA16(a, qf[cf][ks], S[cf]);
            }
            float acc4 = 0.f, accl = 0.f;
#pragma unroll
            for (int j = 0; j < 4; ++j) {
                const int key = kb * 64 + 32 * (rf >> 1) + 8 * q + 4 * (rf & 1) + j;
                float pj = 0.f;
#pragma unroll
                for (int cf = 0; cf < 4; ++cf) pj += __builtin_amdgcn_exp2f(S[cf][j] - mfin[cf]) * linv[cf];
                pj = (key <= nmax) ? pj : 0.f;
                acc4 += pj; if (j == 3) accl = pj;
            }
            const int jblk = kb * 16 + 8 * (rf >> 1) + 2 * q + (rf & 1);
            SUM4[(wid * 16 + cl) * 64 + jblk] = acc4; LAST[(wid * 16 + cl) * 64 + jblk] = accl;
        }
    }
    __syncthreads();
    const int qi = tid >> 2, jg = tid & 3;
    {
        const int jlim = (jbc + 1) * 16;
        for (int jj = 0; jj < 16; ++jj) {
            const int j = jg * 16 + jj;
            float v = (j < jlim) ? SUM4[qi * 64 + j] : 0.f;
            if (j >= 1 && j - 1 < jlim) v += LAST[qi * 64 + j - 1];
            IMP2[qi * 64 + j] = v;
        }
    }
    __syncthreads();
    {
        float key16[16];
#pragma unroll
        for (int j4 = 0; j4 < 4; ++j4) {
            const f32x4 v = *(const f32x4*)(IMP2 + qi * 64 + jg * 16 + j4 * 4);
#pragma unroll
            for (int e = 0; e < 4; ++e) {
                const int j = jg * 16 + j4 * 4 + e;
                const bool forced = (j == 0) || (j == i) || (j == i - 1);
                key16[j4 * 4 + e] = (j > i || forced) ? NINF : v[e];
            }
        }
        unsigned lo = 0u;
#pragma unroll
        for (int jj = 0; jj < 16; ++jj) { const int j = jg * 16 + jj; if (j == 0 || j == i || j == i - 1) lo |= (1u << jj); }
        for (int round = 0; round < 13; ++round) {
            float lm = key16[0];
#pragma unroll
            for (int jj = 1; jj < 16; ++jj) lm = fmaxf(lm, key16[jj]);
            float qm = fmaxf(lm, __shfl_xor(lm, 1)); qm = fmaxf(qm, __shfl_xor(qm, 2));
            const unsigned mine = (lm == qm && qm > NINF) ? (1u << jg) : 0u;
            unsigned qb = mine | __shfl_xor(mine, 1); qb |= __shfl_xor(qb, 2);
            const bool iswin = (qb != 0u) && ((int)__builtin_ctz(qb | 16u) == jg);
            int f = 16;
#pragma unroll
            for (int jj = 15; jj >= 0; --jj) f = (key16[jj] == qm) ? jj : f;
            if (iswin) lo |= (1u << f);
#pragma unroll
            for (int jj = 0; jj < 16; ++jj) key16[jj] = (iswin && jj == f) ? NINF : key16[jj];
        }
        unsigned long long bits = (unsigned long long)lo << (jg * 16);
        bits |= __shfl_xor(bits, 1); bits |= __shfl_xor(bits, 2);
        if (jg == 0) MSKG[((size_t)(b * 2 + k)) * 4096 + U.t0 + qi] = bits;
    }
    __syncthreads();
}

template <int MODE>
DEVI void nsa_kv_unit(const Params& P, rsrc_t rs, int uu, unsigned char* lds, int tid) {
    const int lane = tid & 63, q = lane >> 4;
    const NsaUnit U = nsa_unit(uu, tid);
    const int i = U.i, b = U.b, k = U.k, tq = U.tq;
    AttnState st;
    bf16x8 qf[4][2];
#pragma unroll
    for (int cf = 0; cf < 4; ++cf)
#pragma unroll
        for (int ks = 0; ks < 2; ++ks) qf[cf][ks] = __builtin_bit_cast(bf16x8, bload16(rs, U.qoff, (unsigned)OFF_QBR + U.sQ + cf * 128 + ks * 64));
    const unsigned sK = (unsigned)(OFF_KV + (MODE == 1 ? 2 : 4) * KV_STRIDE) + (unsigned)(b * 2 + k) * 4096u * 128u;
    const unsigned sV = (unsigned)(OFF_KV + (MODE == 1 ? 3 : 5) * KV_STRIDE) + (unsigned)(b * 2 + k) * 64u * 8192u;
    unsigned long long mymask = 0ull;
    int j0 = 0;
    if (MODE == 1) mymask = ((const unsigned long long*)(P.ws + OFF_MASK))[((size_t)(b * 2 + k)) * 4096 + tq];
    else j0 = (i >= 8) ? i - 8 : 0;
    attn_blocks<MODE>(rs, sK, sV, 4096, j0, i, qf, st, tq, mymask, lds, tid);
#pragma unroll
    for (int cf = 0; cf < 4; ++cf) {
        const float l = rows_sum(st.L[cf][0]);
        const float sc = ((l > 0.f) ? __builtin_amdgcn_rcpf(l) : 0.f) * bload4f(rs, U.goff, U.sG + (MODE == 1 ? 32 : 64) + cf * 4);
#pragma unroll
        for (int g2 = 0; g2 < 2; ++g2) {
            const u32x4 pw = __builtin_bit_cast(u32x4, __builtin_amdgcn_raw_buffer_load_b128(rs, (int)U.ooff, (int)(U.sO + cf * 128 + g2 * 64), 0));
            f32x4 v0 = st.O[2 * g2][cf] * sc, v1 = st.O[2 * g2 + 1][cf] * sc;
            v0[0] += bf2f(pw.x & 0xffffu); v0[1] += bf2f(pw.x >> 16); v0[2] += bf2f(pw.y & 0xffffu); v0[3] += bf2f(pw.y >> 16);
            v1[0] += bf2f(pw.z & 0xffffu); v1[1] += bf2f(pw.z >> 16); v1[2] += bf2f(pw.w & 0xffffu); v1[3] += bf2f(pw.w >> 16);
            u32x4 w; w.x = pk2(v0[0], v0[1]); w.y = pk2(v0[2], v0[3]); w.z = pk2(v1[0], v1[1]); w.w = pk2(v1[2], v1[3]);
            __builtin_amdgcn_raw_buffer_store_b128(w, rs, (int)U.ooff, (int)(U.sO + cf * 128 + g2 * 64), 0);
        }
    }
}

DEVI void phase_nsa(const Params& P, unsigned char* lds, int tid) {
    const rsrc_t rs = __builtin_amdgcn_make_buffer_rsrc((void*)P.ws, (short)0, (int)0x7fffffff, 0x00020000);
    for (int uu = blockIdx.x; uu < 1024; uu += gridDim.x) { int t = tid; asm volatile("" : "+v"(t)); nsa_cmp_unit(P, rs, uu, lds, t); }
    __syncthreads();
    for (int uu = blockIdx.x; uu < 1024; uu += gridDim.x) { int t = tid; asm volatile("" : "+v"(t)); nsa_kv_unit<1>(P, rs, uu, lds, t); }
    __syncthreads();
    for (int uu = blockIdx.x; uu < 1024; uu += gridDim.x) { int t = tid; asm volatile("" : "+v"(t)); nsa_kv_unit<2>(P, rs, uu, lds, t); }
}

DEVI void phase_merge(const Params& P, unsigned char* lds, int tid) {
    unsigned char* ws = P.ws;
    const rsrc_t rs = __builtin_amdgcn_make_buffer_rsrc((void*)P.ws, (short)0, (int)0x7fffffff, 0x00020000);
    const bf16_t* ga = (const bf16_t*)(ws + OFF_GA);
    const bf16_t* gb = (const bf16_t*)(ws + OFF_GB);
    bf16_t* mg = (bf16_t*)(ws + OFF_MERGED);
    const int lane = tid & 63, wid = __builtin_amdgcn_readfirstlane(tid >> 6), wr = wid >> 1, wc = wid & 1, q = lane >> 4, cl = lane & 15;
    for (int kk = 0;; ++kk) {
        int mt, nt;
        if (!tile_map(kk, 8, mt, nt)) break;
        f32x4 acc[4][4];
        unsigned t[4][4][2];
        gemm128(acc, rs, (unsigned)(OFF_OA + (size_t)mt * 128 * 1024), RowLin{1024}, (unsigned)(OFF_WBRA + (size_t)nt * 128 * 1024), RowLinPerm{1024}, 8, lds, tid);
        const size_t e0 = (size_t)(mt * 128 + wr * 64 + cl) * 1024 + nt * 128 + wc * 64 + q * 8;
#pragma unroll
        for (int m = 0; m < 4; ++m)
#pragma unroll
            for (int g2 = 0; g2 < 2; ++g2) {
                const u32x4 gv = *(const u32x4*)(ga + e0 + (size_t)m * 16 * 1024 + g2 * 32);
                t[m][2 * g2][0] = pk2(acc[m][2 * g2][0] * bf2f(gv.x & 0xffffu), acc[m][2 * g2][1] * bf2f(gv.x >> 16));
                t[m][2 * g2][1] = pk2(acc[m][2 * g2][2] * bf2f(gv.y & 0xffffu), acc[m][2 * g2][3] * bf2f(gv.y >> 16));
                t[m][2 * g2 + 1][0] = pk2(acc[m][2 * g2 + 1][0] * bf2f(gv.z & 0xffffu), acc[m][2 * g2 + 1][1] * bf2f(gv.z >> 16));
                t[m][2 * g2 + 1][1] = pk2(acc[m][2 * g2 + 1][2] * bf2f(gv.w & 0xffffu), acc[m][2 * g2 + 1][3] * bf2f(gv.w >> 16));
            }
        gemm128(acc, rs, (unsigned)(OFF_OB + (size_t)mt * 128 * 1024), RowLin{1024}, (unsigned)(OFF_WBRB + (size_t)nt * 128 * 1024), RowLinPerm{1024}, 8, lds, tid);
#pragma unroll
        for (int m = 0; m < 4; ++m)
#pragma unroll
            for (int g2 = 0; g2 < 2; ++g2) {
                const size_t o = e0 + (size_t)m * 16 * 1024 + g2 * 32;
                const u32x4 gv = *(const u32x4*)(gb + o);
                const int n0 = 2 * g2, n1 = 2 * g2 + 1;
                u32x4 w;
                w.x = pk2(bf2f(t[m][n0][0] & 0xffffu) + acc[m][n0][0] * bf2f(gv.x & 0xffffu), bf2f(t[m][n0][0] >> 16) + acc[m][n0][1] * bf2f(gv.x >> 16));
                w.y = pk2(bf2f(t[m][n0][1] & 0xffffu) + acc[m][n0][2] * bf2f(gv.y & 0xffffu), bf2f(t[m][n0][1] >> 16) + acc[m][n0][3] * bf2f(gv.y >> 16));
                w.z = pk2(bf2f(t[m][n1][0] & 0xffffu) + acc[m][n1][0] * bf2f(gv.z & 0xffffu), bf2f(t[m][n1][0] >> 16) + acc[m][n1][1] * bf2f(gv.z >> 16));
                w.w = pk2(bf2f(t[m][n1][1] & 0xffffu) + acc[m][n1][2] * bf2f(gv.w & 0xffffu), bf2f(t[m][n1][1] >> 16) + acc[m][n1][3] * bf2f(gv.w >> 16));
                *(u32x4*)(mg + o) = w;
            }
    }
}

DEVI void phase_outproj(const Params& P, unsigned char* lds, int tid) {
    unsigned char* ws = P.ws;
    const rsrc_t rs = __builtin_amdgcn_make_buffer_rsrc((void*)P.ws, (short)0, (int)0x7fffffff, 0x00020000);
    const bf16_t* mg = (const bf16_t*)(ws + OFF_MERGED);
    const bf16_t* wo = (const bf16_t*)(ws + OFF_WOUT);
    const float* x = P.in[0];
    float* x1 = P.out;
    const int lane = tid & 63, wid = __builtin_amdgcn_readfirstlane(tid >> 6), wr = wid >> 1, wc = wid & 1, q = lane >> 4, cl = lane & 15;
    for (int kk = 0;; ++kk) {
        int mt, nt;
        if (!tile_map(kk, 8, mt, nt, 128)) break;
        f32x4 acc[8][4];
        gemm256<false, false, true>(acc, rs, (unsigned)(OFF_MERGED + (size_t)mt * 256 * 2048), 2048u, (unsigned)(OFF_WOUT + (size_t)nt * 128 * 2048), 2048u, 32, lds, tid);
#pragma unroll
        for (int m = 0; m < 8; ++m)
#pragma unroll
            for (int n = 0; n < 4; ++n) {
                const size_t o = (size_t)(mt * 256 + wr * 128 + m * 16 + cl) * 1024 + nt * 128 + wc * 64 + (n >> 1) * 32 + q * 8 + (n & 1) * 4;
                *(f32x4*)(x1 + o) = *(const f32x4*)(x + o) + acc[m][n];
            }
    }
}

DEVI void phase_router(const Params& P, unsigned char* lds, int tid) {
    unsigned char* ws = P.ws;
    const int lane = tid & 63, wid = __builtin_amdgcn_readfirstlane(tid >> 6), q = lane >> 4, cl = lane & 15;
    const float* x1 = P.out; const float* g = P.in[13];
    const float* bg = P.in[15]; const float* be = P.in[17];
    const float* WR = (const float*)(ws + OFF_WR);
    bf16_t* h2 = (bf16_t*)(ws + OFF_HN);
    unsigned* cnt = (unsigned*)(ws + OFF_CTL);
    int* list = (int*)(ws + OFF_LIST);
    float* wt = (float*)(ws + OFF_WT);
    float* WL = (float*)lds;
    float* LG = (float*)(lds + 50688);
    float* RS = (float*)(lds + 50688 + 12288);
    for (int u = blockIdx.x; u < NTOK / 64; u += gridDim.x) {
        const int row0 = u * 64 + wid * 16;
        const float* xa = x1 + (size_t)(row0 + cl) * 1024 + 4 * q;
        f32x4 acc[3];
#pragma unroll
        for (int ct = 0; ct < 3; ++ct) acc[ct] = (f32x4){0.f, 0.f, 0.f, 0.f};
        float ss = 0.f;
        for (int kc = 0; kc < 4; ++kc) {
            __syncthreads();
#pragma unroll
            for (int i = 0; i < 12; ++i) {
                const int idx = tid + 256 * i, r = idx >> 6, c4 = idx & 63;
                *(f32x4*)(WL + r * 264 + c4 * 4) = *(const f32x4*)(WR + (size_t)r * 1024 + kc * 256 + c4 * 4);
            }
            __syncthreads();
#pragma unroll
            for (int jh = 0; jh < 2; ++jh) {
                f32x4 av[8];
#pragma unroll
                for (int j = 0; j < 8; ++j) av[j] = *(const f32x4*)(xa + kc * 256 + (jh * 8 + j) * 16);
#pragma unroll
                for (int j = 0; j < 8; ++j) {
                    {
                        const int kx = kc * 256 + (jh * 8 + j) * 16 + 4 * q;
                        const f32x4 gg = *(const f32x4*)(g + kx);
                        u32x2 w; w.x = pk2(av[j][0] * gg[0], av[j][1] * gg[1]); w.y = pk2(av[j][2] * gg[2], av[j][3] * gg[3]);
                        *(u32x2*)(h2 + (size_t)(row0 + cl) * 1024 + kx) = w;
                    }
                    ss += av[j][0] * av[j][0] + av[j][1] * av[j][1] + av[j][2] * av[j][2] + av[j][3] * av[j][3];
#pragma unroll
                    for (int ct = 0; ct < 3; ++ct) {
                        const f32x4 bv = *(const f32x4*)(WL + (ct * 16 + cl) * 264 + (jh * 8 + j) * 16 + 4 * q);
#pragma unroll
                        for (int e = 0; e < 4; ++e) acc[ct] = __builtin_amdgcn_mfma_f32_16x16x4f32(av[j][e], bv[e], acc[ct], 0, 0, 0);
                    }
                }
            }
        }
        ss += __shfl_xor(ss, 16); ss += __shfl_xor(ss, 32);
        const float rs = rsqrtf(ss * (1.0f / 1024.0f) + RMS_EPS);
        if (q == 0) { RS[wid * 16 + cl] = rs; ((float*)(ws + OFF_RS))[row0 + cl] = rs; }
        __syncthreads();
#pragma unroll
        for (int j = 0; j < 4; ++j) {
            const float rj = RS[wid * 16 + 4 * q + j];
#pragma unroll
            for (int ct = 0; ct < 3; ++ct) LG[(wid * 16 + 4 * q + j) * 48 + ct * 16 + cl] = acc[ct][j] * rj;
        }
        __syncthreads();
        if (tid < 64) {
            const int r = u * 64 + tid;
            const float* lg = LG + tid * 48;
            float gl[4];
#pragma unroll
            for (int e = 0; e < 4; ++e) gl[e] = lg[e] + bg[e];
            int gs = 0; float gm = gl[0];
#pragma unroll
            for (int e = 1; e < 4; ++e) if (gl[e] > gm) { gm = gl[e]; gs = e; }
            float den = 0.f;
#pragma unroll
            for (int e = 0; e < 4; ++e) den += __expf(gl[e] - gm);
            const float gp = 1.0f / den;
            float el[8];
#pragma unroll
            for (int e = 0; e < 8; ++e) el[e] = lg[4 + gs * 8 + e] + be[gs * 8 + e];
            int i0 = 0; float v0 = el[0];
#pragma unroll
            for (int e = 1; e < 8; ++e) if (el[e] > v0) { v0 = el[e]; i0 = e; }
            int i1 = -1; float v1 = -__builtin_inff();
#pragma unroll
            for (int e = 0; e < 8; ++e) if (e != i0 && el[e] > v1) { v1 = el[e]; i1 = e; }
            const float e1 = __expf(v1 - v0);
            const float w0 = gp / (1.0f + e1), w1 = gp * e1 / (1.0f + e1);
            const int ex0 = gs * 8 + i0, ex1 = gs * 8 + i1;
            const unsigned p0 = atomicAdd(&cnt[ex0], 1u);
            list[(size_t)ex0 * NTOK + p0] = r * 2 + 0;
            const unsigned p1 = atomicAdd(&cnt[ex1], 1u);
            list[(size_t)ex1 * NTOK + p1] = r * 2 + 1;
            wt[(size_t)r * 2 + 0] = w0; wt[(size_t)r * 2 + 1] = w1;
        }
    }
}

struct RowGather { const int* idx; DEVI unsigned operator()(int r) const { return (unsigned)idx[r] * 2048u; } };
struct RowGU { int c0; DEVI unsigned operator()(int r) const {
    const int wcx = r >> 6, w = r & 63; const int pw = perm32(w & 31);
    const int col = (w < 32) ? (c0 + wcx * 32 + pw) : (256 + c0 + wcx * 32 + pw); return (unsigned)col * 2048u; } };

struct MoeTiles { int cnt, incl, total; };
DEVI MoeTiles moe_tiles(const unsigned* cnt, int lane) {
    MoeTiles M;
    M.cnt = (lane < 32) ? (int)cnt[lane] : 0;
    int v = (M.cnt + 127) >> 7;
#pragma unroll
    for (int o = 1; o < 32; o <<= 1) { const int u = __shfl_up(v, o); if ((lane & 31) >= o) v += u; }
    M.incl = (lane < 32) ? v : 0x7fffffff;
    M.total = __builtin_amdgcn_readlane(v, 31);
    return M;
}
DEVI int moe_find_tile(const MoeTiles& M, int u, int& e, int& tl) {
    const int ee = (int)__popcll(__ballot(M.incl <= u));
    const int ntl = (M.cnt + 127) >> 7;
    e = ee;
    tl = u - (__builtin_amdgcn_readlane(M.incl, ee) - __builtin_amdgcn_readlane(ntl, ee));
    return __builtin_amdgcn_readlane(M.cnt, ee);
}
DEVI void phase_moe_a(const Params& P, unsigned char* lds, int tid) {
    unsigned char* ws = P.ws;
    const rsrc_t rs = __builtin_amdgcn_make_buffer_rsrc((void*)P.ws, (short)0, (int)0x7fffffff, 0x00020000);
    const int lane = tid & 63, wid = __builtin_amdgcn_readfirstlane(tid >> 6), wr = wid >> 1, wc = wid & 1, q = lane >> 4, cl = lane & 15;
    const unsigned* cnt = (const unsigned*)(ws + OFF_CTL);
    const int* list = (const int*)(ws + OFF_LIST);
    bf16_t* act = (bf16_t*)(ws + OFF_ACT);
    int* rowtok = (int*)(lds + 65536);
    const float* RSG = (const float*)(ws + OFF_RS);
    const MoeTiles MT = moe_tiles(cnt, lane);
    const int total = MT.total;
    for (int v = blockIdx.x; v < total * 4; v += gridDim.x) {
        const int u = v >> 2, nt = v & 3;
        int e, tl; const int ce = moe_find_tile(MT, u, e, tl);
        if (tid < 128) { const int r = tl * 128 + tid; rowtok[tid] = (r < ce) ? (list[(size_t)e * NTOK + r] >> 1) : 0; }
        __syncthreads();
        bf16_t* au = act + (size_t)u * 128 * 256;
        f32x4 acc[4][4];
        gemm128(acc, rs, (unsigned)OFF_HN, RowGather{rowtok}, (unsigned)(OFF_WGU + (size_t)e * 512 * 2048), RowGU{nt * 64}, 16, lds, tid);
#pragma unroll
        for (int m = 0; m < 4; ++m) {
            const int row = wr * 64 + m * 16 + cl, col = nt * 64 + wc * 32 + q * 8;
            const float rsv = RSG[rowtok[row]];
            const f32x4 g0 = acc[m][0] * rsv, u0 = acc[m][2] * rsv, g1 = acc[m][1] * rsv, u1 = acc[m][3] * rsv;
            u32x4 w;
            w.x = pk2(siluf_(g0[0]) * u0[0], siluf_(g0[1]) * u0[1]); w.y = pk2(siluf_(g0[2]) * u0[2], siluf_(g0[3]) * u0[3]);
            w.z = pk2(siluf_(g1[0]) * u1[0], siluf_(g1[1]) * u1[1]); w.w = pk2(siluf_(g1[2]) * u1[2], siluf_(g1[3]) * u1[3]);
            *(u32x4*)(au + (size_t)row * 256 + col) = w;
        }
        __syncthreads();
    }
}
DEVI void phase_moe_b(const Params& P, unsigned char* lds, int tid) {
    unsigned char* ws = P.ws;
    const rsrc_t rs = __builtin_amdgcn_make_buffer_rsrc((void*)P.ws, (short)0, (int)0x7fffffff, 0x00020000);
    const int lane = tid & 63, wid = __builtin_amdgcn_readfirstlane(tid >> 6), wr = wid >> 1, wc = wid & 1, q = lane >> 4, cl = lane & 15;
    const unsigned* cnt = (const unsigned*)(ws + OFF_CTL);
    const int* list = (const int*)(ws + OFF_LIST);
    bf16_t* Y = (bf16_t*)(ws + OFF_Y);
    int* rowas = (int*)(lds + 65536);
    const MoeTiles MT = moe_tiles(cnt, lane);
    const int total = MT.total;
    for (int v = blockIdx.x; v < total * 4; v += gridDim.x) {
        const int u = v >> 2, np = v & 3;
        int e, tl; const int ce = moe_find_tile(MT, u, e, tl);
        if (tid < 128) { const int r = tl * 128 + tid; rowas[tid] = (r < ce) ? list[(size_t)e * NTOK + r] : -1; }
        f32x4 acc[8][4];
        gemm256<true, true>(acc, rs, (unsigned)(OFF_WDN + (size_t)e * 1024 * 512 + (size_t)np * 256 * 512), 512u, (unsigned)(OFF_ACT + (size_t)u * 128 * 512), 512u, 8, lds, tid);
#pragma unroll
        for (int n = 0; n < 4; ++n) {
            const int as = rowas[wc * 64 + n * 16 + cl];
            const unsigned voff = (as >= 0) ? (unsigned)((as & 1) * NTOK + (as >> 1)) * 2048u + (unsigned)(wr * 256 + q * 16) : 0x80000000u;
#pragma unroll
            for (int pp = 0; pp < 4; ++pp) {
                u32x4 w;
                w.x = pk2(acc[2 * pp][n][0], acc[2 * pp][n][1]); w.y = pk2(acc[2 * pp][n][2], acc[2 * pp][n][3]);
                w.z = pk2(acc[2 * pp + 1][n][0], acc[2 * pp + 1][n][1]); w.w = pk2(acc[2 * pp + 1][n][2], acc[2 * pp + 1][n][3]);
                __builtin_amdgcn_raw_buffer_store_b128(w, rs, (int)voff, (int)((unsigned)OFF_Y + (unsigned)(np * 512 + pp * 64)), 0);
            }
            asm volatile("" ::: "memory");
        }
        __syncthreads();
    }
}

DEVI void phase_final(const Params& P, int tid, bool with_moe) {
    unsigned char* ws = P.ws;
    const int lane = tid & 63, wid = __builtin_amdgcn_readfirstlane(tid >> 6);
    const bf16_t* Y = (const bf16_t*)(ws + OFF_Y);
    const float* wt = (const float*)(ws + OFF_WT);
    const float* g = P.in[20];
    float* out = P.out;
    for (int r = blockIdx.x * 4 + wid; r < NTOK; r += gridDim.x * 4) {
        float* xr = out + (size_t)r * 1024;
        const float w0 = with_moe ? wt[(size_t)r * 2] : 0.f, w1 = with_moe ? wt[(size_t)r * 2 + 1] : 0.f;
        f32x4 v[4]; float ss = 0.f;
#pragma unroll
        for (int i = 0; i < 4; ++i) {
            v[i] = *(const f32x4*)(xr + i * 256 + lane * 4);
            if (with_moe) {
                const u32x2 a = *(const u32x2*)(Y + (size_t)r * 1024 + i * 256 + lane * 4);
                const u32x2 b = *(const u32x2*)(Y + ((size_t)NTOK + r) * 1024 + i * 256 + lane * 4);
                v[i][0] += w0 * bf2f(a.x & 0xffffu) + w1 * bf2f(b.x & 0xffffu); v[i][1] += w0 * bf2f(a.x >> 16) + w1 * bf2f(b.x >> 16);
                v[i][2] += w0 * bf2f(a.y & 0xffffu) + w1 * bf2f(b.y & 0xffffu); v[i][3] += w0 * bf2f(a.y >> 16) + w1 * bf2f(b.y >> 16);
            }
            ss += v[i][0] * v[i][0] + v[i][1] * v[i][1] + v[i][2] * v[i][2] + v[i][3] * v[i][3];
        }
        ss = wave_sum(ss);
        const float rs = rsqrtf(ss * (1.0f / 1024.0f) + RMS_EPS);
#pragma unroll
        for (int i = 0; i < 4; ++i) {
            const f32x4 gg = *(const f32x4*)(g + i * 256 + lane * 4);
            f32x4 o; o[0] = v[i][0] * rs * gg[0]; o[1] = v[i][1] * rs * gg[1]; o[2] = v[i][2] * rs * gg[2]; o[3] = v[i][3] * rs * gg[3];
            *(f32x4*)(xr + i * 256 + lane * 4) = o;
        }
    }
}

#define LAUNDER_TID() do { tid = wave_id * 64 + (int)__builtin_amdgcn_mbcnt_hi(~0u, __builtin_amdgcn_mbcnt_lo(~0u, 0u)); asm volatile("" : "+v"(tid)); } while (0)
__global__ void __launch_bounds__(NTHREADS, 2) fwd_megakernel(Params P) {
    extern __shared__ __attribute__((aligned(16))) unsigned char lds[];
    cg::grid_group grid = cg::this_grid();
    int tid;
    const int wave_id = __builtin_amdgcn_readfirstlane((int)(threadIdx.x >> 6));
    volatile LAS unsigned* bst = (volatile LAS unsigned*)(LAS unsigned char*)(lds + LDS_BYTES - 16);
    if (threadIdx.x < 4) bst[threadIdx.x] = 0u;
    __syncthreads();
    (void)xcd_barrier_post((unsigned*)(P.ws + OFF_BAR), bst);
#define GRID_BARRIER() do { XcdBarrier b_; b_.bar = (unsigned*)(P.ws + OFF_BAR); b_.x = xb_xcc_id(); b_.st = (volatile LAS unsigned*)(LAS unsigned char*)(lds + LDS_BYTES - 16); xcd_barrier(b_); } while (0)
    if (P.ph_lo != 0) grid.sync();
    LAUNDER_TID(); phase_prep(P, lds, tid, 0); __syncthreads();
    GRID_BARRIER();
    {
        const int first_idx = (blockIdx.x >> 8) & 1;
        for (int step = 0; step < 3; ++step) {
            const int what = (step == 0) ? 0 : 1 + ((step - 1) ^ first_idx);
            if (what <= 1) { LAUNDER_TID(); phase_gemm1(P, lds, tid, what); }
            else {
                LAUNDER_TID(); phase_prep(P, lds, tid, 1); __syncthreads();
                LAUNDER_TID(); phase_compress(P, lds, tid); __syncthreads();
                LAUNDER_TID(); phase_index(P, lds, tid);
            }
            __syncthreads();
            if (step == 0) GRID_BARRIER();
        }
    }
    GRID_BARRIER();
    if (((blockIdx.x >> 8) & 1) == 0) { LAUNDER_TID(); phase_dsa(P, lds, tid); __syncthreads(); }
    LAUNDER_TID(); phase_nsa(P, lds, tid); __syncthreads();
    if (((blockIdx.x >> 8) & 1) != 0) { LAUNDER_TID(); phase_dsa(P, lds, tid); __syncthreads(); }
    GRID_BARRIER();
    LAUNDER_TID(); phase_merge(P, lds, tid);
    GRID_BARRIER();
    LAUNDER_TID(); phase_outproj(P, lds, tid);
    GRID_BARRIER();
    LAUNDER_TID(); phase_router(P, lds, tid);
    GRID_BARRIER();
    LAUNDER_TID(); phase_moe_a(P, lds, tid);
    GRID_BARRIER();
    LAUNDER_TID(); phase_moe_b(P, lds, tid);
    GRID_BARRIER();
    LAUNDER_TID(); phase_final(P, tid, true);
}

extern "C" void kernel_launch(void* const* d_in, const int* in_sizes, int n_in, void* d_out, int out_size, void* d_ws, size_t ws_size,
                              hipStream_t stream) {
    static int grid_blocks = 0;
    if (!grid_blocks) {
        int dev = 0, cus = 0, per_cu = 0;
        hipGetDevice(&dev);
        hipDeviceGetAttribute(&cus, hipDeviceAttributeMultiprocessorCount, dev);
        hipFuncSetAttribute((const void*)fwd_megakernel, hipFuncAttributeMaxDynamicSharedMemorySize, LDS_BYTES);
        hipOccupancyMaxActiveBlocksPerMultiprocessor(&per_cu, (const void*)fwd_megakernel, NTHREADS, LDS_BYTES);
        if (per_cu < 1) per_cu = 1;
        if (per_cu > 2) per_cu = 2;
        grid_blocks = cus * per_cu;
        if (ws_size < WS_END) fprintf(stderr, "kernel_launch: workspace too small: %zu < %zu\n", ws_size, (size_t)WS_END);
    }
    Params p{};
    for (int i = 0; i < 21; ++i) p.in[i] = (const float*)d_in[i];
    p.pos = (const int*)d_in[1];
    p.out = (float*)d_out;
    p.ws = (unsigned char*)d_ws;
    for (int i = 0; i < 32; ++i) p.inv_freq[i] = (double)powf(10000.0f, -(float)i / 32.0f);
    p.ph_lo = 0; p.ph_hi = 0;
    (void)hipMemsetAsync(d_ws, 0, OFF_WIN_T, stream);
    void* args[] = {&p};
    hipError_t e = hipLaunchCooperativeKernel((const void*)fwd_megakernel, dim3(grid_blocks), dim3(NTHREADS), args, LDS_BYTES, stream);
    if (e != hipSuccess) fprintf(stderr, "cooperative launch failed: %s (grid %d)\n", hipGetErrorString(e), grid_blocks);
}
```

```cpp
#include <hip/hip_runtime.h>
#include <hip/hip_cooperative_groups.h>
#include <cstdint>
#include <cstdio>
#include <cmath>
namespace cg = cooperative_groups;

#define DEVI __device__ __forceinline__
#ifndef PROBE_TWICE
#define PROBE_TWICE 0
#endif
#define REPS(k) ((PROBE_TWICE == (k)) ? 2 : 1)
typedef unsigned short bf16_t;
typedef short bf16x8 __attribute__((ext_vector_type(8)));
typedef short s16x4 __attribute__((ext_vector_type(4)));
typedef float f32x4 __attribute__((ext_vector_type(4)));
typedef float f32x2 __attribute__((ext_vector_type(2)));
typedef unsigned u32x4 __attribute__((ext_vector_type(4)));
typedef unsigned u32x2 __attribute__((ext_vector_type(2)));
#define LAS __attribute__((address_space(3)))

constexpr int NB = 8, SL = 4096, DM = 1024, NTOK = NB * SL;
constexpr int INW = 4288;
constexpr int NTHREADS = 256;
constexpr int LDS_BYTES = 81920;
constexpr float RMS_EPS = 1e-6f;
constexpr float LOG2E = 1.4426950408889634f;

constexpr int WIN_ROWS = 4352;
constexpr int G1_COLS = 4352;

constexpr size_t al256(size_t x) { return (x + 255) & ~(size_t)255; }
constexpr size_t OFF_CTL   = 20480;
constexpr size_t OFF_BAR   = 4096;
constexpr size_t OFF_WIN_T = 32768;
constexpr size_t OFF_WBRA  = OFF_WIN_T + (size_t)WIN_ROWS * 1024 * 2;
constexpr size_t OFF_WBRB  = OFF_WBRA + (size_t)1024 * 512 * 2;
constexpr size_t OFF_WOUT  = OFF_WBRB + (size_t)1024 * 512 * 2;
constexpr size_t OFF_W1K   = OFF_WOUT + (size_t)1024 * 1024 * 2;
constexpr size_t OFF_W1V   = OFF_W1K + (size_t)128 * 2048 * 2;
constexpr size_t OFF_W2K   = OFF_W1V + (size_t)128 * 2048 * 2;
constexpr size_t OFF_W2V   = OFF_W2K + (size_t)64 * 128 * 2;
constexpr size_t OFF_WGU   = OFF_W2V + (size_t)64 * 128 * 2;
constexpr size_t OFF_WDN   = OFF_WGU + (size_t)32 * 512 * 1024 * 2;
constexpr size_t OFF_BIAS1 = OFF_WDN + (size_t)32 * 1024 * 256 * 2;
constexpr size_t OFF_WR    = OFF_BIAS1 + 1024;
constexpr size_t OFF_CS    = OFF_WR + (size_t)48 * 1024 * 4;
constexpr size_t OFF_HN    = OFF_CS + (size_t)NTOK * 32 * 8;
constexpr size_t OFF_QA    = OFF_HN + (size_t)NTOK * 1024 * 2;
constexpr size_t OFF_KA    = OFF_QA + (size_t)NTOK * 512 * 2;
constexpr size_t OFF_VA    = OFF_KA + (size_t)NTOK * 64 * 2;
constexpr size_t OFF_QI    = OFF_VA + (size_t)NTOK * 64 * 2;
constexpr size_t OFF_KI    = OFF_QI + (size_t)NTOK * 256 * 2;
constexpr size_t OFF_WI    = OFF_KI + (size_t)NTOK * 32 * 2;
constexpr size_t OFF_QBN   = OFF_WI + (size_t)NTOK * 8 * 4;
constexpr size_t OFF_QBR   = OFF_QBN + (size_t)NTOK * 512 * 2;
constexpr size_t KV_STRIDE = (size_t)NTOK * 128 * 2 + 65536 * 4;
constexpr size_t OFF_KV    = OFF_QBR + (size_t)NTOK * 512 * 2;
constexpr size_t OFF_GATES = OFF_KV + 6 * KV_STRIDE;
constexpr size_t OFF_QKV_END = OFF_GATES + (size_t)NTOK * 24 * 4;
constexpr size_t OFF_KC    = al256(OFF_QKV_END);
constexpr size_t OFF_VCT   = OFF_KC + (size_t)16 * 256 * 64 * 2;
constexpr size_t OFF_SEL   = OFF_VCT + (size_t)16 * 256 * 64 * 2;
constexpr size_t OFF_OA    = OFF_HN;
constexpr size_t OFF_OB    = OFF_OA + (size_t)NTOK * 512 * 2;
constexpr size_t OFF_GA    = OFF_SEL + (size_t)NTOK * 256 * 2;
constexpr size_t OFF_GB    = OFF_GA + (size_t)NTOK * 1024 * 2;
constexpr size_t OFF_MASK  = OFF_GB + (size_t)NTOK * 1024 * 2;
constexpr size_t OFF_LIST  = OFF_MASK + (size_t)16 * 4096 * 8;
constexpr size_t OFF_WT    = OFF_LIST + (size_t)32 * NTOK * 4;
constexpr size_t OFF_RS    = OFF_WT + (size_t)NTOK * 2 * 4;
constexpr size_t WS_END    = OFF_RS + (size_t)NTOK * 4;
constexpr size_t OFF_MERGED = OFF_QA;
constexpr size_t OFF_ACT    = OFF_QA;
constexpr size_t OFF_Y      = OFF_QA + (size_t)40 * 1024 * 1024;
static_assert(OFF_Y + (size_t)2 * NTOK * 1024 * 2 <= OFF_QKV_END, "Y overlay");
static_assert((size_t)544 * 128 * 256 * 2 <= (size_t)40 * 1024 * 1024, "ACT overlay");

struct Params {
    const float* in[21];
    const int* pos;
    float* out;
    unsigned char* ws;
    double inv_freq[32];
    int ph_lo, ph_hi;
};

DEVI unsigned f2bf(float f) { unsigned u = __float_as_uint(f); return (u + 0x7fffu + ((u >> 16) & 1u)) >> 16; }
typedef __bf16 bf16v2_t __attribute__((ext_vector_type(2)));
DEVI unsigned pk2(float lo, float hi) { const f32x2 v = {lo, hi}; return __builtin_bit_cast(unsigned, __builtin_convertvector(v, bf16v2_t)); }
DEVI float rows_max(float x) {
    float a = x, b = x;
    asm volatile("v_nop\n\tv_nop\n\tv_permlane16_swap_b32 %0, %1" : "+v"(a), "+v"(b));
    x = fmaxf(a, b); a = x; b = x;
    asm volatile("v_nop\n\tv_nop\n\tv_permlane32_swap_b32 %0, %1" : "+v"(a), "+v"(b));
    return fmaxf(a, b);
}
DEVI float rows_sum(float x) {
    float a = x, b = x;
    asm volatile("v_nop\n\tv_nop\n\tv_permlane16_swap_b32 %0, %1" : "+v"(a), "+v"(b));
    x = a + b; a = x; b = x;
    asm volatile("v_nop\n\tv_nop\n\tv_permlane32_swap_b32 %0, %1" : "+v"(a), "+v"(b));
    return a + b;
}
DEVI float bf2f(unsigned h) { return __uint_as_float(h << 16); }
DEVI float sigmoidf_(float x) { return __builtin_amdgcn_rcpf(1.0f + __builtin_amdgcn_exp2f(-x * 1.4426950408889634f)); }
DEVI float wave_sum(float v) {
#pragma unroll
    for (int o = 32; o > 0; o >>= 1) v += __shfl_xor(v, o);
    return v;
}
DEVI int wave_sum_i32(int v) {
    v += __builtin_amdgcn_update_dpp(0, v, 0xB1, 0xF, 0xF, true);
    v += __builtin_amdgcn_update_dpp(0, v, 0x4E, 0xF, 0xF, true);
    v += __builtin_amdgcn_update_dpp(0, v, 0x141, 0xF, 0xF, true);
    v += __builtin_amdgcn_update_dpp(0, v, 0x140, 0xF, 0xF, true);
    return __builtin_amdgcn_readlane(v, 0) + __builtin_amdgcn_readlane(v, 16) + __builtin_amdgcn_readlane(v, 32) + __builtin_amdgcn_readlane(v, 48);
}
DEVI int fkey(float f) { const int b = __builtin_bit_cast(int, f); return b ^ ((b >> 31) & 0x7fffffff); }
DEVI float wave_min_f32_dpp(float v) {
    v = fminf(v, __builtin_bit_cast(float, __builtin_amdgcn_update_dpp(0, __builtin_bit_cast(int, v), 0xB1, 0xF, 0xF, true)));
    v = fminf(v, __builtin_bit_cast(float, __builtin_amdgcn_update_dpp(0, __builtin_bit_cast(int, v), 0x4E, 0xF, 0xF, true)));
    v = fminf(v, __builtin_bit_cast(float, __builtin_amdgcn_update_dpp(0, __builtin_bit_cast(int, v), 0x141, 0xF, 0xF, true)));
    v = fminf(v, __builtin_bit_cast(float, __builtin_amdgcn_update_dpp(0, __builtin_bit_cast(int, v), 0x140, 0xF, 0xF, true)));
    const int iv = __builtin_bit_cast(int, v);
    return fminf(fminf(__builtin_bit_cast(float, __builtin_amdgcn_readlane(iv, 0)), __builtin_bit_cast(float, __builtin_amdgcn_readlane(iv, 16))),
                 fminf(__builtin_bit_cast(float, __builtin_amdgcn_readlane(iv, 32)), __builtin_bit_cast(float, __builtin_amdgcn_readlane(iv, 48))));
}
DEVI float wave_sum_f32_dpp(float v) {
    v += __builtin_bit_cast(float, __builtin_amdgcn_update_dpp(0, __builtin_bit_cast(int, v), 0xB1, 0xF, 0xF, true));
    v += __builtin_bit_cast(float, __builtin_amdgcn_update_dpp(0, __builtin_bit_cast(int, v), 0x4E, 0xF, 0xF, true));
    v += __builtin_bit_cast(float, __builtin_amdgcn_update_dpp(0, __builtin_bit_cast(int, v), 0x141, 0xF, 0xF, true));
    v += __builtin_bit_cast(float, __builtin_amdgcn_update_dpp(0, __builtin_bit_cast(int, v), 0x140, 0xF, 0xF, true));
    const int iv = __builtin_bit_cast(int, v);
    return (__builtin_bit_cast(float, __builtin_amdgcn_readlane(iv, 0)) + __builtin_bit_cast(float, __builtin_amdgcn_readlane(iv, 16))) +
           (__builtin_bit_cast(float, __builtin_amdgcn_readlane(iv, 32)) + __builtin_bit_cast(float, __builtin_amdgcn_readlane(iv, 48)));
}
DEVI bf16x8 pack8(const f32x4& a, const f32x4& b) {
    u32x4 w; w.x = pk2(a[0], a[1]); w.y = pk2(a[2], a[3]); w.z = pk2(b[0], b[1]); w.w = pk2(b[2], b[3]);
    return __builtin_bit_cast(bf16x8, w);
}
#define MFMA16(a, b, c) __builtin_amdgcn_mfma_f32_16x16x32_bf16((a), (b), (c), 0, 0, 0)


#define XB_TMO      128
#define XB_XCNT(j)  (256  + 64 * (j))
#define XB_XSUB(j)  (1280 + 64 * (j))
#define XB_XGEN(j)  (2304 + 64 * (j))
#define XB_TOP      3328
#define XB_TOPGEN   3392
#define XCD_BAR_WORDS 3456
#define XB_SPIN_CAP (1u << 22)
DEVI unsigned xb_ld(unsigned* p)              { return __hip_atomic_load(p, __ATOMIC_RELAXED, __HIP_MEMORY_SCOPE_AGENT); }
DEVI unsigned xb_add(unsigned* p, unsigned v) { return __hip_atomic_fetch_add(p, v, __ATOMIC_RELAXED, __HIP_MEMORY_SCOPE_AGENT); }
DEVI unsigned xb_xcc_id() { return (unsigned)__builtin_amdgcn_s_getreg((3 << 11) | 20) & 0xFu; }
#define XB_SPIN(cond, bar) do { unsigned _sp = 0; while (cond) { __builtin_amdgcn_s_sleep(1); \
    if ((++_sp & 255u) == 0u) { if (xb_ld(&(bar)[XB_TMO])) break; if (_sp > XB_SPIN_CAP) { atomicAdd(&(bar)[XB_TMO], 1u); break; } } } } while (0)
struct XcdBarrier { unsigned* bar; unsigned x; volatile LAS unsigned* st; };
DEVI XcdBarrier xcd_barrier_post(unsigned* bar, volatile LAS unsigned* st) {
    XcdBarrier b; b.bar = bar; b.x = xb_xcc_id(); b.st = st;
    if (threadIdx.x == 0) (void)xb_add(&bar[XB_XCNT(b.x)], 1u);
    return b;
}
DEVI void xcd_barrier_complete(unsigned* bar, unsigned x, unsigned& nloc, unsigned& nx) {
    const unsigned G = gridDim.x * gridDim.y * gridDim.z;
    unsigned sum, cnt, mine, sp = 0u;
    for (;;) {
        sum = 0u; cnt = 0u; mine = 0u;
#pragma unroll
        for (unsigned j = 0; j < 16; ++j) { const unsigned c = xb_ld(&bar[XB_XCNT(j)]); sum += c; cnt += (c > 0u) ? 1u : 0u; mine = (j == x) ? c : mine; }
        if (sum == G) break;
        __builtin_amdgcn_s_sleep(1);
        if ((++sp & 255u) == 0u) { if (xb_ld(&bar[XB_TMO])) break; if (sp > XB_SPIN_CAP) { atomicAdd(&bar[XB_TMO], 1u); break; } }
    }
    nloc = mine > 0u ? mine : 1u; nx = cnt > 0u ? cnt : 1u;
}
DEVI void xcd_barrier(const XcdBarrier& b) {
    asm volatile("s_waitcnt vmcnt(0)" ::: "memory");
    __syncthreads();
    if (threadIdx.x == 0) {
        unsigned* bar = b.bar;
        __builtin_amdgcn_s_waitcnt(0);
        unsigned nloc = b.st[0], nx = b.st[1];
        if (nloc == 0u) { xcd_barrier_complete(bar, b.x, nloc, nx); b.st[0] = nloc; b.st[1] = nx; }
        const unsigned old = xb_add(&bar[XB_XSUB(b.x)], 1u);
        const unsigned gen = old / nloc;
        if (old + 1u == (gen + 1u) * nloc) {
            __builtin_amdgcn_fence(__ATOMIC_RELEASE, "agent");
            asm volatile("s_waitcnt vmcnt(0)" ::: "memory");
            const unsigned og = xb_add(&bar[XB_TOP], 1u);
            const unsigned tg = og / nx;
            if (og + 1u == (tg + 1u) * nx) xb_add(&bar[XB_TOPGEN], 1u);
            else XB_SPIN(xb_ld(&bar[XB_TOPGEN]) == tg, bar);
            __builtin_amdgcn_fence(__ATOMIC_ACQUIRE, "agent");
            xb_add(&bar[XB_XGEN(b.x)], 1u);
            asm volatile("s_waitcnt vmcnt(0)" ::: "memory");
        } else {
            XB_SPIN(xb_ld(&bar[XB_XGEN(b.x)]) == gen, bar);
            __builtin_amdgcn_fence(__ATOMIC_ACQUIRE, "agent");
            asm volatile("s_waitcnt vmcnt(0)" ::: "memory");
        }
    }
    __syncthreads();
}

typedef __amdgpu_buffer_rsrc_t rsrc_t;
DEVI u32x4 bload16(rsrc_t r, unsigned voff, unsigned soff) { return __builtin_bit_cast(u32x4, __builtin_amdgcn_raw_buffer_load_b128(r, (int)voff, (int)soff, 0)); }
DEVI void glds16(rsrc_t r, unsigned char* lds_dst_uniform, unsigned voff, unsigned soff) {
    __builtin_amdgcn_raw_ptr_buffer_load_lds(r, (LAS void*)lds_dst_uniform, 16, (int)voff, (int)soff, 0, 0);
}
template <class FA, class FB>
DEVI void gemm128(f32x4 (&acc)[4][4], rsrc_t rs, unsigned sA, const FA& offA, unsigned sB, const FB& offB, int nk, unsigned char* lds, int tid) {
    const int lane = tid & 63, wid = __builtin_amdgcn_readfirstlane(tid >> 6), wr = wid >> 1, wc = wid & 1;
    const int lr = tid >> 3;
    const unsigned csrc = (unsigned)(((lane & 7) ^ ((lane >> 3) & 7)) << 4);
    unsigned oa[4], ob[4];
#pragma unroll
    for (int i = 0; i < 4; ++i) { oa[i] = offA(lr + 32 * i) + csrc; ob[i] = offB(lr + 32 * i) + csrc; }
#pragma unroll
    for (int m = 0; m < 4; ++m)
#pragma unroll
        for (int n = 0; n < 4; ++n) acc[m][n] = (f32x4){0.f, 0.f, 0.f, 0.f};
    const int q = lane >> 4, r16 = lane & 15;
    const int roffA0 = (wr * 64 + r16) * 128 + (((0 + q) ^ (lane & 7)) << 4);
    const int roffA1 = (wr * 64 + r16) * 128 + (((4 + q) ^ (lane & 7)) << 4);
    const int roffB0 = 16384 + (wc * 64 + r16) * 128 + (((0 + q) ^ (lane & 7)) << 4);
    const int roffB1 = 16384 + (wc * 64 + r16) * 128 + (((4 + q) ^ (lane & 7)) << 4);
    unsigned char* wbase = lds + wid * 1024;
#pragma unroll
    for (int i = 0; i < 4; ++i) { glds16(rs, wbase + i * 4096, oa[i], sA); glds16(rs, wbase + 16384 + i * 4096, ob[i], sB); }
    for (int kt = 0; kt < nk; ++kt) {
        unsigned char* cur = lds + (kt & 1) * 32768;
        __syncthreads();
        if (kt + 1 < nk) {
            unsigned char* nb = wbase + ((kt + 1) & 1) * 32768;
#pragma unroll
            for (int i = 0; i < 4; ++i) { glds16(rs, nb + i * 4096, oa[i], sA + (kt + 1) * 128); glds16(rs, nb + 16384 + i * 4096, ob[i], sB + (kt + 1) * 128); }
        }
        bf16x8 a0[4], b0[4], a1[4], b1[4];
#pragma unroll
        for (int m = 0; m < 4; ++m) a0[m] = *(const bf16x8*)(cur + roffA0 + m * 2048);
#pragma unroll
        for (int n = 0; n < 4; ++n) b0[n] = *(const bf16x8*)(cur + roffB0 + n * 2048);
#pragma unroll
        for (int m = 0; m < 4; ++m) a1[m] = *(const bf16x8*)(cur + roffA1 + m * 2048);
#pragma unroll
        for (int n = 0; n < 4; ++n) b1[n] = *(const bf16x8*)(cur + roffB1 + n * 2048);
#pragma unroll
        for (int m = 0; m < 4; ++m)
#pragma unroll
            for (int n = 0; n < 4; ++n) acc[m][n] = MFMA16(b0[n], a0[m], acc[m][n]);
#pragma unroll
        for (int m = 0; m < 4; ++m)
#pragma unroll
            for (int n = 0; n < 4; ++n) acc[m][n] = MFMA16(b1[n], a1[m], acc[m][n]);
    }
    __syncthreads();
}

DEVI int swzF(int row) { return (0x78 >> (((row >> 2) & 3) * 2)) & 3; }
DEVI int perm32(int rho) { const int n = rho >> 4, i = rho & 15; return 8 * (i >> 2) + 4 * n + (i & 3); }
template <bool SWAP = false, bool PERM = false, bool PERMB = false>
DEVI void gemm256(f32x4 (&acc)[8][4], rsrc_t rs, unsigned sA, unsigned ldaB, unsigned sB, unsigned ldbB, int nk32, unsigned char* lds, int tid) {
    const int lane = tid & 63, wid = __builtin_amdgcn_readfirstlane(tid >> 6), wr = wid >> 1, wc = wid & 1;
    const int q = lane >> 4, r16 = lane & 15;
    unsigned oa[4], ob[2];
#pragma unroll
    for (int i = 0; i < 4; ++i) { const int row = (wid * 4 + i) * 16 + (lane >> 2); const int grow = PERM ? ((row & ~31) + perm32(row & 31)) : row;
        oa[i] = (unsigned)grow * ldaB + (unsigned)(((lane & 3) ^ swzF(row)) << 4); }
#pragma unroll
    for (int i = 0; i < 2; ++i) { const int row = (wid * 2 + i) * 16 + (lane >> 2); const int grow = PERMB ? ((row & ~31) + perm32(row & 31)) : row;
        ob[i] = (unsigned)grow * ldbB + (unsigned)(((lane & 3) ^ swzF(row)) << 4); }
#pragma unroll
    for (int m = 0; m < 8; ++m)
#pragma unroll
        for (int n = 0; n < 4; ++n) acc[m][n] = (f32x4){0.f, 0.f, 0.f, 0.f};
    const int roffA = (wr * 128 + r16) * 64 + ((q ^ swzF(r16)) << 4);
    const int roffB = 16384 + (wc * 64 + r16) * 64 + ((q ^ swzF(r16)) << 4);
    unsigned char* wA = lds + wid * 4096;
    unsigned char* wB = lds + 16384 + wid * 2048;
#pragma unroll
    for (int i = 0; i < 4; ++i) glds16(rs, wA + i * 1024, oa[i], sA);
#pragma unroll
    for (int i = 0; i < 2; ++i) glds16(rs, wB + i * 1024, ob[i], sB);
    for (int kt = 0; kt < nk32; ++kt) {
        const unsigned char* cur = lds + (kt & 1) * 24576;
        __syncthreads();
        if (kt + 1 < nk32) {
            const int so = ((kt + 1) & 1) * 24576;
#pragma unroll
            for (int i = 0; i < 4; ++i) glds16(rs, wA + so + i * 1024, oa[i], sA + (kt + 1) * 64);
#pragma unroll
            for (int i = 0; i < 2; ++i) glds16(rs, wB + so + i * 1024, ob[i], sB + (kt + 1) * 64);
        }
        bf16x8 a[8], b[4];
#pragma unroll
        for (int n = 0; n < 4; ++n) b[n] = *(const bf16x8*)(cur + roffB + n * 1024);
#pragma unroll
        for (int m = 0; m < 8; ++m) a[m] = *(const bf16x8*)(cur + roffA + m * 1024);
#pragma unroll
        for (int m = 0; m < 8; ++m)
#pragma unroll
            for (int n = 0; n < 4; ++n) acc[m][n] = SWAP ? MFMA16(a[m], b[n], acc[m][n]) : MFMA16(b[n], a[m], acc[m][n]);
    }
    __syncthreads();
}

DEVI bool tile_map(int k, int ncol, int& mt, int& nt, int nrow = 256) {
    if (gridDim.x == 512) {
        const int x = blockIdx.x & 7, j0 = blockIdx.x >> 3, j = ((j0 & 31) << 1) | (j0 >> 5);
        const int v = j + 64 * k;
        if (v >= (nrow >> 3) * ncol) return false;
        const int nfull = ncol >> 3, rem = ncol & 7;
        int mtl;
        const int pcg = nrow;
        if (v < nfull * pcg) { const int cg = v / pcg, w = v % pcg; mtl = (w >> 6) * 8 + ((w & 63) >> 3); nt = cg * 8 + (w & 7); }
        else { const int v2 = v - nfull * pcg, per = 8 * rem; const int rg = v2 / per, w = v2 % per; mtl = rg * 8 + w / rem; nt = nfull * 8 + w % rem; }
        mt = x * (nrow >> 3) + mtl;
        return true;
    }
    const int u = blockIdx.x + gridDim.x * k;
    if (u >= nrow * ncol) return false;
    mt = u / ncol; nt = u % ncol;
    return true;
}
struct RowLin { unsigned ldb; DEVI unsigned operator()(int r) const { return (unsigned)r * ldb; } };
struct RowLinPerm { unsigned ldb; DEVI unsigned operator()(int r) const { return (unsigned)((r & ~31) + perm32(r & 31)) * ldb; } };

DEVI int win_map(int j) {
    if (j < 896) return j;
    if (j < 1408) return j - 896 + 936;
    if (j < 2176) return j - 1408 + 1448;
    if (j < 2208) return j - 2176 + 896;
    if (j < 2216) return j - 2208 + 928;
    if (j < 2240) return j;
    if (j < 2304) return -1;
    return j - 64;
}

struct TJob { const float* src; bf16_t* dst; int K, ld, nrows, perm, nb; size_t sb, db; };
DEVI TJob get_tjob(const Params& P, int j) {
    unsigned char* ws = P.ws;
    switch (j) {
        case 0: return TJob{P.in[3], (bf16_t*)(ws + OFF_WIN_T), 1024, INW, WIN_ROWS, 1, 1, 0, 0};
        case 1: return TJob{P.in[10], (bf16_t*)(ws + OFF_WBRA), 512, 1024, 1024, 0, 1, 0, 0};
        case 2: return TJob{P.in[11], (bf16_t*)(ws + OFF_WBRB), 512, 1024, 1024, 0, 1, 0, 0};
        case 3: return TJob{P.in[12], (bf16_t*)(ws + OFF_WOUT), 1024, 1024, 1024, 0, 1, 0, 0};
        case 4: return TJob{P.in[5], (bf16_t*)(ws + OFF_W1K), 2048, 128, 128, 0, 1, 0, 0};
        case 5: return TJob{P.in[8], (bf16_t*)(ws + OFF_W1V), 2048, 128, 128, 0, 1, 0, 0};
        case 6: return TJob{P.in[6], (bf16_t*)(ws + OFF_W2K), 128, 64, 64, 0, 1, 0, 0};
        case 7: return TJob{P.in[9], (bf16_t*)(ws + OFF_W2V), 128, 64, 64, 0, 1, 0, 0};
        case 8: return TJob{P.in[18], (bf16_t*)(ws + OFF_WGU), 1024, 512, 512, 0, 32, (size_t)1024 * 512, (size_t)512 * 1024};
        default: return TJob{P.in[19], (bf16_t*)(ws + OFF_WDN), 256, 1024, 1024, 0, 32, (size_t)256 * 1024, (size_t)1024 * 256};
    }
}
DEVI int tjob_tiles(int j) {
    switch (j) {
        case 0: return (WIN_ROWS / 64) * 16;
        case 1: case 2: return 16 * 8;
        case 3: return 16 * 16;
        case 4: case 5: return 2 * 32;
        case 6: case 7: return 1 * 2;
        case 8: return 32 * 8 * 16;
        default: return 32 * 16 * 4;
    }
}

DEVI void transpose_tile(const TJob& J, int tile, unsigned char* lds, int tid) {
    float* T = (float*)lds;
    const int kt = J.K / 64, rt = J.nrows / 64;
    const int b = tile / (kt * rt), rem = tile % (kt * rt);
    const int r0 = (rem / kt) * 64, k0 = (rem % kt) * 64;
    const float* src = J.src + (size_t)b * J.sb;
    bf16_t* dst = J.dst + (size_t)b * J.db;
    const int n4 = (tid & 15) * 4;
    int col = r0 + n4; if (J.perm) col = win_map(col);
    f32x4 ld4[4];
#pragma unroll
    for (int i = 0; i < 4; ++i) {
        const int kk = (tid >> 4) + 16 * i;
        ld4[i] = (col >= 0) ? *(const f32x4*)(src + (size_t)(k0 + kk) * J.ld + col) : (f32x4){0.f, 0.f, 0.f, 0.f};
    }
#pragma unroll
    for (int i = 0; i < 4; ++i) {
        const int kk = (tid >> 4) + 16 * i;
#pragma unroll
        for (int e = 0; e < 4; ++e) T[kk * 65 + n4 + e] = ld4[i][e];
    }
    __syncthreads();
    const int r2 = tid >> 2, ks = (tid & 3) * 16;
    u32x4 w0, w1;
    w0.x = pk2(T[(ks + 0) * 65 + r2], T[(ks + 1) * 65 + r2]); w0.y = pk2(T[(ks + 2) * 65 + r2], T[(ks + 3) * 65 + r2]);
    w0.z = pk2(T[(ks + 4) * 65 + r2], T[(ks + 5) * 65 + r2]); w0.w = pk2(T[(ks + 6) * 65 + r2], T[(ks + 7) * 65 + r2]);
    w1.x = pk2(T[(ks + 8) * 65 + r2], T[(ks + 9) * 65 + r2]); w1.y = pk2(T[(ks + 10) * 65 + r2], T[(ks + 11) * 65 + r2]);
    w1.z = pk2(T[(ks + 12) * 65 + r2], T[(ks + 13) * 65 + r2]); w1.w = pk2(T[(ks + 14) * 65 + r2], T[(ks + 15) * 65 + r2]);
    bf16_t* d = dst + (size_t)(r0 + r2) * J.K + k0 + ks;
    *(u32x4*)d = w0; *(u32x4*)(d + 8) = w1;
    __syncthreads();
}

DEVI void rms_row_bf16(const float* xr, const float* g, bf16_t* o, int lane) {
    f32x4 v[4]; float ss = 0.f;
#pragma unroll
    for (int i = 0; i < 4; ++i) { v[i] = *(const f32x4*)(xr + i * 256 + lane * 4); ss += v[i][0] * v[i][0] + v[i][1] * v[i][1] + v[i][2] * v[i][2] + v[i][3] * v[i][3]; }
    ss = wave_sum(ss);
    const float rs = rsqrtf(ss * (1.0f / 1024.0f) + RMS_EPS);
#pragma unroll
    for (int i = 0; i < 4; ++i) {
        const f32x4 gg = *(const f32x4*)(g + i * 256 + lane * 4);
        u32x2 w; w.x = pk2(v[i][0] * rs * gg[0], v[i][1] * rs * gg[1]); w.y = pk2(v[i][2] * rs * gg[2], v[i][3] * rs * gg[3]);
        *(u32x2*)(o + i * 256 + lane * 4) = w;
    }
}

DEVI void phase_prep(const Params& P, unsigned char* lds, int tid, int part) {
    unsigned char* ws = P.ws;
    const int lane = tid & 63, wid = __builtin_amdgcn_readfirstlane(tid >> 6);
    int base = 0;
#pragma unroll
    for (int j = 0; j < 10; ++j) {
        const bool early = (j == 0) || (j >= 4 && j <= 7);
        if (early == (part == 0)) {
            const int nt = tjob_tiles(j);
            const TJob J = get_tjob(P, j);
            if (j >= 8 && gridDim.x == 512) {
                const int pr = blockIdx.x & 255; const bool isA = blockIdx.x < 256;
                for (int k = 0; pr + 256 * k < nt; ++k) if (isA) transpose_tile(J, pr + 256 * k, lds, tid);
            } else
            for (int t = blockIdx.x; t < nt; t += gridDim.x) transpose_tile(J, t, lds, tid);
        }
    }
    (void)base;
    if (part == 1) {
        float* wr = (float*)(ws + OFF_WR);
        const float* g = P.in[13]; const float* wg = P.in[14]; const float* we = P.in[16];
        for (int e = blockIdx.x * NTHREADS + tid; e < 48 * 1024; e += gridDim.x * NTHREADS) {
            const int c = e >> 10, k = e & 1023;
            float v = 0.f;
            if (c < 4) v = wg[k * 4 + c]; else if (c < 36) v = we[k * 32 + (c - 4)];
            wr[e] = v * g[k];
        }
        return;
    }
    {
        const float* x = P.in[0]; const float* g = P.in[2]; bf16_t* hn = (bf16_t*)(ws + OFF_HN);
        for (int r = blockIdx.x * 4 + wid; r < NTOK; r += gridDim.x * 4) rms_row_bf16(x + (size_t)r * 1024, g, hn + (size_t)r * 1024, lane);
    }
    {
        f32x2* cs = (f32x2*)(ws + OFF_CS);
        for (int e = blockIdx.x * NTHREADS + tid; e < NTOK * 32; e += gridDim.x * NTHREADS) {
            const int tok = e >> 5, i = e & 31;
            const double a = (double)P.pos[tok] * P.inv_freq[i];
            double t = a * 0.15915494309189535;
            t -= floor(t);
            const float tf = (float)t;
            cs[e] = (f32x2){__builtin_amdgcn_cosf(tf), __builtin_amdgcn_sinf(tf)};
        }
    }
    {
        float* red = (float*)lds;
        for (int job = blockIdx.x; job < 32; job += gridDim.x) {
            const int kv = job >> 4, cg8 = job & 15;
            const float* pe = P.in[kv ? 7 : 4]; const float* w1 = P.in[kv ? 8 : 5];
            const int cc = tid & 7, jj = tid >> 3;
            float s = 0.f;
            for (int j = jj; j < 2048; j += 32) s += pe[j] * w1[(size_t)j * 128 + cg8 * 8 + cc];
            red[tid] = s;
            __syncthreads();
            if (tid < 8) { float t = 0.f; for (int u = 0; u < 32; ++u) t += red[u * 8 + tid]; ((float*)(ws + OFF_BIAS1))[kv * 128 + cg8 * 8 + tid] = t; }
            __syncthreads();
        }
    }
}

DEVI void st_bf16(bf16_t* p, float v) { *p = (bf16_t)f2bf(v); }

DEVI int gemm1_col_tile(int part, int i) {
    if (part == 0) return (i < 3) ? 4 + i : ((i < 5) ? 8 + i : 17);
    return (i < 4) ? i : ((i < 8) ? i + 3 : ((i < 12) ? i + 5 : i + 6));
}
template <bool PERM>
DEVI void st_row64(bf16_t* d, const f32x4 (&o)[4], int q) {
    if (PERM) {
#pragma unroll
        for (int g2 = 0; g2 < 2; ++g2) {
            u32x4 w; w.x = pk2(o[2 * g2][0], o[2 * g2][1]); w.y = pk2(o[2 * g2][2], o[2 * g2][3]); w.z = pk2(o[2 * g2 + 1][0], o[2 * g2 + 1][1]); w.w = pk2(o[2 * g2 + 1][2], o[2 * g2 + 1][3]);
            *(u32x4*)(d + g2 * 32 + q * 8) = w;
        }
    } else {
#pragma unroll
        for (int n = 0; n < 4; ++n) { u32x2 w; w.x = pk2(o[n][0], o[n][1]); w.y = pk2(o[n][2], o[n][3]); *(u32x2*)(d + n * 16 + q * 4) = w; }
    }
}
template <int MR, bool PERM = false>
DEVI void gemm1_epilogue(const Params& P, const f32x4 (&acc)[MR][4], int c64, int tok0, int q, int cl) {
    unsigned char* ws = P.ws;
    const f32x2* cs = (const f32x2*)(ws + OFF_CS);
    if (c64 < 10 || (c64 >= 14 && c64 < 34)) {
        bool do_rope; float scale = 1.f; int kind;
        int g = 0, hk = 0;
        if (c64 < 8) { kind = 0; do_rope = true; scale = 0.125f * LOG2E; }
        else if (c64 == 8) { kind = 1; do_rope = true; }
        else if (c64 == 9) { kind = 2; do_rope = false; }
        else if (c64 < 22) { kind = 3; do_rope = true; scale = 0.125f * LOG2E; }
        else { kind = 4; g = (c64 - 22) >> 1; hk = (c64 - 22) & 1; do_rope = (g == 2 || g == 4); }
#pragma unroll
        for (int m = 0; m < MR; ++m) {
            const int tok = tok0 + m * 16;
            f32x4 o[4], nr[4];
#pragma unroll
            for (int n = 0; n < 4; ++n) { nr[n] = acc[m][n] * scale; o[n] = nr[n]; }
            if (do_rope) {
#pragma unroll
                for (int n = 0; n < 2; ++n) {
                    const int c0 = PERM ? 8 * q + 4 * n : n * 16 + q * 4;
                    const f32x4 c01 = *(const f32x4*)(cs + (size_t)tok * 32 + c0);
                    const f32x4 c23 = *(const f32x4*)(cs + (size_t)tok * 32 + c0 + 2);
                    const float cc[4] = {c01[0], c01[2], c23[0], c23[2]}, sn[4] = {c01[1], c01[3], c23[1], c23[3]};
#pragma unroll
                    for (int j = 0; j < 4; ++j) {
                        const float x1 = nr[n][j], x2 = nr[n + 2][j];
                        o[n][j] = x1 * cc[j] - x2 * sn[j]; o[n + 2][j] = x1 * sn[j] + x2 * cc[j];
                    }
                }
            }
            if (kind == 0 || kind == 1 || kind == 2) {
                bf16_t* d = (kind == 0) ? (bf16_t*)(ws + OFF_QA) + (size_t)tok * 512 + c64 * 64 : (bf16_t*)(ws + (kind == 1 ? OFF_KA : OFF_VA)) + (size_t)tok * 64;
                st_row64<PERM>(d, o, q);
            } else if (kind == 3) {
                const int h = c64 - 14;
                bf16_t* dn = (bf16_t*)(ws + OFF_QBN) + (size_t)tok * 512 + h * 64; bf16_t* dr = (bf16_t*)(ws + OFF_QBR) + (size_t)tok * 512 + h * 64;
                st_row64<PERM>(dn, nr, q); st_row64<PERM>(dr, o, q);
            } else {
                bf16_t* d = (bf16_t*)(ws + OFF_KV + (size_t)g * KV_STRIDE);
                const int b = tok >> 12, tl = tok & 4095;
                if (g == 3 || g == 5) {
#pragma unroll
                    for (int n = 0; n < 4; ++n)
#pragma unroll
                        for (int j = 0; j < 4; ++j) st_bf16(d + ((size_t)((b * 2 + hk) * 64 + (PERM ? (n >> 1) * 32 + 8 * q + 4 * (n & 1) : n * 16 + q * 4) + j)) * 4096 + tl, o[n][j]);
                } else {
                    st_row64<PERM>(d + ((size_t)((b * 2 + hk) * 4096 + tl)) * 64, o, q);
                }
            }
        }
    } else if (!PERM && c64 >= 10 && c64 < 14) {
        bf16_t* d = (bf16_t*)(ws + OFF_QI);
#pragma unroll
        for (int m = 0; m < MR; ++m) {
            const int tok = tok0 + m * 16;
            float cc[4], sn[4];
#pragma unroll
            for (int j = 0; j < 4; ++j) { const f32x2 c = cs[(size_t)tok * 32 + 2 * (4 * q + j)]; cc[j] = c.x; sn[j] = c.y; }
#pragma unroll
            for (int hh = 0; hh < 2; ++hh) {
                const int head = 2 * (c64 - 10) + hh;
                f32x4 r1, r2;
#pragma unroll
                for (int j = 0; j < 4; ++j) { const float x1 = acc[m][2 * hh][j], x2 = acc[m][2 * hh + 1][j]; r1[j] = x1 * cc[j] - x2 * sn[j]; r2[j] = x1 * sn[j] + x2 * cc[j]; }
                u32x2 w; w.x = pk2(r1[0], r1[1]); w.y = pk2(r1[2], r1[3]); *(u32x2*)(d + (size_t)tok * 256 + head * 32 + q * 4) = w;
                u32x2 v; v.x = pk2(r2[0], r2[1]); v.y = pk2(r2[2], r2[3]); *(u32x2*)(d + (size_t)tok * 256 + head * 32 + 16 + q * 4) = v;
            }
        }
    } else if (c64 >= 36) {
        bf16_t* d = (bf16_t*)(ws + (c64 < 52 ? OFF_GA : OFF_GB));
        const int cb = (c64 < 52 ? c64 - 36 : c64 - 52) * 64;
#pragma unroll
        for (int m = 0; m < MR; ++m) {
            f32x4 sg[4];
#pragma unroll
            for (int n = 0; n < 4; ++n)
#pragma unroll
                for (int j = 0; j < 4; ++j) sg[n][j] = sigmoidf_(acc[m][n][j]);
            st_row64<PERM>(d + (size_t)(tok0 + m * 16) * 1024 + cb, sg, q);
        }
    } else if (!PERM && c64 == 34) {
        bf16_t* dki = (bf16_t*)(ws + OFF_KI); float* dwi = (float*)(ws + OFF_WI); float* dg = (float*)(ws + OFF_GATES);
#pragma unroll
        for (int m = 0; m < MR; ++m) {
            const int tok = tok0 + m * 16;
            f32x4 r1, r2;
#pragma unroll
            for (int j = 0; j < 4; ++j) {
                const f32x2 c = cs[(size_t)tok * 32 + 2 * (4 * q + j)];
                const float x1 = acc[m][0][j], x2 = acc[m][1][j];
                r1[j] = x1 * c.x - x2 * c.y; r2[j] = x1 * c.y + x2 * c.x;
            }
            u32x2 w; w.x = pk2(r1[0], r1[1]); w.y = pk2(r1[2], r1[3]); *(u32x2*)(dki + (size_t)tok * 32 + q * 4) = w;
            u32x2 v; v.x = pk2(r2[0], r2[1]); v.y = pk2(r2[2], r2[3]); *(u32x2*)(dki + (size_t)tok * 32 + 16 + q * 4) = v;
            if (q < 2) *(f32x4*)(dwi + (size_t)tok * 8 + q * 4) = acc[m][2];
            else { f32x4 sv; for (int j = 0; j < 4; ++j) sv[j] = sigmoidf_(acc[m][2][j]); *(f32x4*)(dg + (size_t)tok * 24 + (q * 4 - 8)) = sv; }
            { f32x4 sv; for (int j = 0; j < 4; ++j) sv[j] = sigmoidf_(acc[m][3][j]); *(f32x4*)(dg + (size_t)tok * 24 + 8 + q * 4) = sv; }
        }
    }
}

DEVI void phase_gemm1(const Params& P, unsigned char* lds, int tid, int part) {
    const rsrc_t rs = __builtin_amdgcn_make_buffer_rsrc((void*)P.ws, (short)0, (int)0x7fffffff, 0x00020000);
    const int lane = tid & 63, wid = __builtin_amdgcn_readfirstlane(tid >> 6), wr = wid >> 1, wc = wid & 1, q = lane >> 4, cl = lane & 15;
    constexpr int NT_N = G1_COLS / 128;
    if (part == 0) {
        for (int kk = 0;; ++kk) {
            int mt, nti;
            if (!tile_map(kk, 6, mt, nti)) break;
            const int nt = gemm1_col_tile(0, nti);
            f32x4 acc[4][4];
            gemm128(acc, rs, (unsigned)(OFF_HN + (size_t)mt * 128 * 2048), RowLin{2048}, (unsigned)(OFF_WIN_T + (size_t)nt * 128 * 2048), RowLin{2048}, 16, lds, tid);
            gemm1_epilogue<4>(P, acc, nt * 2 + wc, mt * 128 + wr * 64 + cl, q, cl);
        }
    } else {
        for (int kk = 0;; ++kk) {
            int mt, nti;
            if (!tile_map(kk, NT_N - 6, mt, nti, 128)) break;
            const int nt = gemm1_col_tile(1, nti);
            f32x4 acc[8][4];
            gemm256<false, false, true>(acc, rs, (unsigned)(OFF_HN + (size_t)mt * 256 * 2048), 2048u, (unsigned)(OFF_WIN_T + (size_t)nt * 128 * 2048), 2048u, 32, lds, tid);
            gemm1_epilogue<8, true>(P, acc, nt * 2 + wc, mt * 256 + wr * 128 + cl, q, cl);
        }
    }
}

DEVI float siluf_(float x) { return x * __builtin_amdgcn_rcpf(1.0f + __builtin_amdgcn_exp2f(-x * 1.4426950408889634f)); }

DEVI void phase_compress(const Params& P, unsigned char* lds, int tid) {
    unsigned char* ws = P.ws;
    const rsrc_t rs = __builtin_amdgcn_make_buffer_rsrc((void*)P.ws, (short)0, (int)0x7fffffff, 0x00020000);
    const int lane = tid & 63, wid = __builtin_amdgcn_readfirstlane(tid >> 6), wr = wid >> 1, wc = wid & 1, q = lane >> 4, cl = lane & 15;
    for (int u = blockIdx.x; u < 64; u += gridDim.x) {
        const int kv = u >> 5, mt = u & 31;
        const bf16_t* A = (const bf16_t*)(ws + OFF_KV + (size_t)kv * KV_STRIDE) + (size_t)mt * 128 * 1024;
        const bf16_t* W1 = (const bf16_t*)(ws + (kv ? OFF_W1V : OFF_W1K));
        const bf16_t* W2 = (const bf16_t*)(ws + (kv ? OFF_W2V : OFF_W2K));
        const float* bias = (const float*)(ws + OFF_BIAS1) + kv * 128;
        f32x4 acc[4][4];
        gemm128(acc, rs, (unsigned)(OFF_KV + (size_t)kv * KV_STRIDE + (size_t)mt * 128 * 2048), RowLin{2048}, (unsigned)(kv ? OFF_W1V : OFF_W1K), RowLin{4096}, 32, lds, tid);
#pragma unroll
        for (int m = 0; m < 4; ++m)
#pragma unroll
            for (int n = 0; n < 4; ++n) {
                const int col = wc * 64 + n * 16 + q * 4, row = wr * 64 + m * 16 + cl;
                const f32x4 bb = *(const f32x4*)(bias + col);
                const int ktile = col >> 6, ch = (col & 63) >> 3, wi = col & 7;
                u32x2 w; w.x = pk2(siluf_(acc[m][n][0] + bb[0]), siluf_(acc[m][n][1] + bb[1])); w.y = pk2(siluf_(acc[m][n][2] + bb[2]), siluf_(acc[m][n][3] + bb[3]));
                *(u32x2*)(lds + ktile * 16384 + row * 128 + ((ch ^ (row & 7)) << 4) + wi * 2) = w;
            }
#pragma unroll
        for (int i = 0; i < 4; ++i) {
            const int idx = tid + 256 * i;
            const int row = idx >> 4, ch16 = idx & 15, ktile = ch16 >> 3, ch = ch16 & 7;
            *(u32x4*)(lds + 32768 + ktile * 8192 + row * 128 + ((ch ^ (row & 7)) << 4)) = *(const u32x4*)(W2 + (size_t)row * 128 + ch16 * 8);
        }
        __syncthreads();
        f32x4 a2[4][2];
#pragma unroll
        for (int m = 0; m < 4; ++m) { a2[m][0] = (f32x4){0.f, 0.f, 0.f, 0.f}; a2[m][1] = (f32x4){0.f, 0.f, 0.f, 0.f}; }
#pragma unroll
        for (int kk = 0; kk < 4; ++kk) {
            const int ktile = kk >> 1, ks = kk & 1;
            bf16x8 a[4], b[2];
#pragma unroll
            for (int m = 0; m < 4; ++m) { const int row = wr * 64 + m * 16 + cl; a[m] = *(const bf16x8*)(lds + ktile * 16384 + row * 128 + (((ks * 4 + q) ^ (row & 7)) << 4)); }
#pragma unroll
            for (int n = 0; n < 2; ++n) { const int row = wc * 32 + n * 16 + cl; b[n] = *(const bf16x8*)(lds + 32768 + ktile * 8192 + row * 128 + (((ks * 4 + q) ^ (row & 7)) << 4)); }
#pragma unroll
            for (int m = 0; m < 4; ++m)
#pragma unroll
                for (int n = 0; n < 2; ++n) a2[m][n] = MFMA16(b[n], a[m], a2[m][n]);
        }
#pragma unroll
        for (int m = 0; m < 4; ++m)
#pragma unroll
            for (int n = 0; n < 2; ++n) {
                const int d = wc * 32 + n * 16 + q * 4;
                const int r = mt * 128 + wr * 64 + m * 16 + cl;
                const bool dead = ((r & 255) == 255);
                float v[4];
#pragma unroll
                for (int j = 0; j < 4; ++j) v[j] = dead ? 0.f : a2[m][n][j];
                if (kv == 0) {
                    bf16_t* kc = (bf16_t*)(ws + OFF_KC);
                    u32x2 w; w.x = pk2(v[0], v[1]); w.y = pk2(v[2], v[3]);
                    *(u32x2*)(kc + (size_t)r * 64 + d) = w;
                } else {
                    bf16_t* vct = (bf16_t*)(ws + OFF_VCT);
#pragma unroll
                    for (int j = 0; j < 4; ++j) st_bf16(vct + ((size_t)((r >> 8) * 64 + d + j)) * 256 + (r & 255), v[j]);
                }
            }
        __syncthreads();
    }
}

DEVI void phase_index(const Params& P, unsigned char* lds, int tid) {
    unsigned char* ws = P.ws;
    const bf16_t* QI = (const bf16_t*)(ws + OFF_QI);
    const bf16_t* KI = (const bf16_t*)(ws + OFF_KI);
    const float* WI = (const float*)(ws + OFF_WI);
    bf16_t* SEL = (bf16_t*)(ws + OFF_SEL);
    float* S = (float*)lds;
    const int lane = tid & 63, wid = __builtin_amdgcn_readfirstlane(tid >> 6), q = lane >> 4, cl = lane & 15;
    for (int u = blockIdx.x; u < NTOK / 4; u += gridDim.x) {
        const int b = u >> 10, w10 = u & 1023, s10 = (w10 < 512) ? w10 : 1535 - w10;
        const int t0 = s10 * 4, tok0 = b * 4096 + t0;
        const int t = t0 + wid;
        const int tok = tok0 + wid;
        if (t0 + 3 < 256) {
            for (int i = lane; i < 256; i += 64) SEL[(size_t)tok * 256 + i] = (bf16_t)(i <= t ? i : 0);
            continue;
        }
        {
            bf16x8 a[2];
#pragma unroll
            for (int hg = 0; hg < 2; ++hg) a[hg] = *(const bf16x8*)(QI + (size_t)(tok0 + (cl >> 2)) * 256 + (4 * hg + (cl & 3)) * 32 + q * 8);
            const f32x4 w0 = *(const f32x4*)(WI + (size_t)(tok0 + q) * 8), w1 = *(const f32x4*)(WI + (size_t)(tok0 + q) * 8 + 4);
            const int ktmax = (t0 + 3) >> 4;
            const bf16_t* kb = KI + (size_t)b * 4096 * 32 + cl * 32 + q * 8;
            float rz = 0.f, rinf = __builtin_inff();
            asm volatile("" : "+v"(rz), "+v"(rinf));
            bf16x8 bk[8], bn[8];
#pragma unroll
            for (int uu = 0; uu < 8; ++uu) { const int kt = (wid + 4 * uu <= ktmax) ? wid + 4 * uu : wid; bk[uu] = *(const bf16x8*)(kb + (size_t)kt * 16 * 32); }
            for (int kt0 = wid; kt0 <= ktmax; kt0 += 32) {
                if (kt0 + 32 <= ktmax) {
#pragma unroll
                    for (int uu = 0; uu < 8; ++uu) { const int kt = (kt0 + 32 + 4 * uu <= ktmax) ? kt0 + 32 + 4 * uu : kt0 + 32; bn[uu] = *(const bf16x8*)(kb + (size_t)kt * 16 * 32); }
                }
#pragma unroll
                for (int uu = 0; uu < 8; ++uu) {
                    const int kt = (kt0 + 4 * uu <= ktmax) ? kt0 + 4 * uu : kt0;
                    f32x4 c0 = {0.f, 0.f, 0.f, 0.f}, c1 = {0.f, 0.f, 0.f, 0.f};
                    c0 = MFMA16(a[0], bk[uu], c0); c1 = MFMA16(a[1], bk[uu], c1);
                    float sc = 0.f;
#pragma unroll
                    for (int j = 0; j < 4; ++j) sc = __builtin_fmaf(w0[j], __builtin_amdgcn_fmed3f(c0[j], rz, rinf), sc);
#pragma unroll
                    for (int j = 0; j < 4; ++j) sc = __builtin_fmaf(w1[j], __builtin_amdgcn_fmed3f(c1[j], rz, rinf), sc);
                    S[q * 4096 + kt * 16 + cl] = sc;
                }
#pragma unroll
                for (int uu = 0; uu < 8; ++uu) bk[uu] = bn[uu];
            }
        }
        __syncthreads();
        {
            const int n = t + 1;
            const float* Sq = S + wid * 4096;
            if (n <= 256) {
                for (int i = lane; i < 256; i += 64) SEL[(size_t)tok * 256 + i] = (bf16_t)(i <= t ? i : 0);
            } else {
                const int nr = (n + 63) >> 6;
                float x[64];
                const float NINF = -__builtin_inff(), PINF = __builtin_inff();
#pragma unroll
                for (int g8 = 0; g8 < 8; ++g8) {
                    if ((g8 * 8 + 8) * 64 <= n) {
#pragma unroll
                        for (int r = g8 * 8; r < g8 * 8 + 8; ++r) x[r] = Sq[r * 64 + lane];
                    } else if (g8 * 8 < nr) {
#pragma unroll
                        for (int r = g8 * 8; r < g8 * 8 + 8; ++r) { const int key = r * 64 + lane; const float v = Sq[key]; x[r] = (key < n) ? v : NINF; }
                    } else {
#pragma unroll
                        for (int r = g8 * 8; r < g8 * 8 + 8; ++r) x[r] = NINF;
                    }
                }
#define COUNT_GE(dst, thr) do { int c_ = 0; _Pragma("unroll") for (int g8 = 0; g8 < 8; ++g8) if (g8 * 8 < nr) { \
        _Pragma("unroll") for (int r = g8 * 8; r < g8 * 8 + 8; ++r) c_ += __popcll(__ballot(x[r] >= (thr))); } (dst) = c_; } while (0)
#define COUNT_GE_S(dst, thr) do { int c_ = 0; _Pragma("unroll") for (int g8 = 0; g8 < 8; ++g8) if (g8 * 8 < nr) { \
        c_ += __popcll(__ballot(x[g8 * 8] >= (thr))) + __popcll(__ballot(x[g8 * 8 + 4] >= (thr))); } (dst) = c_; } while (0)
                float T; int need;
                {
                    const bool samp = nr >= 16;
                    float s1 = 0.f, s2 = 0.f;
                    if (samp) {
#pragma unroll
                        for (int g8 = 0; g8 < 8; ++g8) if (g8 * 8 < nr) {
#pragma unroll
                            for (int r = g8 * 8; r < g8 * 8 + 8; r += 4) { const float v = (x[r] == NINF) ? 0.f : x[r]; s1 += v; s2 += v * v; }
                        }
                    } else {
#pragma unroll
                        for (int g8 = 0; g8 < 2; ++g8) if (g8 * 8 < nr) {
#pragma unroll
                            for (int r = g8 * 8; r < g8 * 8 + 8; ++r) { const float v = (x[r] == NINF) ? 0.f : x[r]; s1 += v; s2 += v * v; }
                        }
                    }
                    s1 = wave_sum_f32_dpp(s1); s2 = wave_sum_f32_dpp(s2);
                    const int nsi = samp ? 64 * ((nr + 2) >> 2) + ((((nr - 1) & 3) == 0) ? n - (nr - 1) * 64 : 0) : n;
                    const float fn = (float)n, fns = (float)nsi, mu = s1 / fns;
                    const float sg = sqrtf(fmaxf(s2 / fns - mu * mu, 1e-20f));
                    float vg;
                    {
                        const float pq = 256.0f / fn, pp = fminf(pq, 1.0f - pq);
                        const float tt = sqrtf(-2.0f * __logf(fmaxf(pp, 1e-6f)));
                        const float zz = tt - (2.515517f + 0.802853f * tt + 0.010328f * tt * tt) / (1.0f + 1.432788f * tt + 0.189269f * tt * tt + 0.001308f * tt * tt * tt);
                        vg = mu + ((pq <= 0.5f) ? zz : -zz) * sg;
                    }
                    if (samp) {
                        const float tgs = 256.0f * fns / fn;
                        for (int it = 0; it < 3; ++it) {
                            int cs; COUNT_GE_S(cs, vg);
                            const float zv = (vg - mu) / sg;
                            const float dens = fmaxf(fns * 0.39894228f * __expf(-0.5f * zv * zv), 0.5f) / sg;
                            const float dc = (float)cs - tgs;
                            vg += dc / dens;
                            if (fabsf(dc) <= 2.0f) break;
                        }
                    }
                    float lo = NINF, hi = PINF; int clo = n, chi = 0;
                    bool found = false, adjacent = false; float thr = 0.f;
                    for (int it = 0; it < 256; ++it) {
                        if (clo - chi <= 64) break;
                        float v = vg;
                        if (!(v > lo && v < hi) || (it & 3) == 3) {
                            const int kl = fkey(lo), kh = fkey(hi);
                            const int km = (kl >> 1) + (kh >> 1) + (kl & kh & 1);
                            if (km == kl) { adjacent = true; break; }
                            v = __builtin_bit_cast(float, fkey(__builtin_bit_cast(float, km)));
                        }
                        int c; COUNT_GE(c, v);
                        if (c == 256) { found = true; thr = v; break; }
                        if (c > 256) { lo = v; clo = c; } else { hi = v; chi = c; }
                        const float zv = (v - mu) / sg;
                        const float dens = fmaxf(fn * 0.39894228f * __expf(-0.5f * zv * zv), 0.5f) / sg;
                        vg = v + ((float)c - ((c > 256) ? 244.0f : 268.0f)) / dens;
                    }
                    if (found) { T = thr; need = -1; }
                    else if (adjacent) { T = lo; need = 256 - chi; }
                    else {
                        if (lo == NINF) lo = -3.4028234e38f;
                        float* cand = (float*)(lds + 65536) + wid * 64;
                        cand[lane] = NINF;
                        int cb = 0;
                        const unsigned long long ltm = (1ull << lane) - 1ull;
#pragma unroll
                        for (int g8 = 0; g8 < 8; ++g8) if (g8 * 8 < nr) {
#pragma unroll
                            for (int r = g8 * 8; r < g8 * 8 + 8; ++r) {
                                const bool isc = (x[r] >= lo) && (x[r] < hi);
                                const unsigned long long bm = __ballot(isc);
                                if (bm != 0ull) {
                                    const int pos = cb + __popcll(bm & ltm);
                                    if (isc && pos < 64) cand[pos] = x[r];
                                    cb += __popcll(bm);
                                }
                            }
                        }
                        const float y = cand[lane];
                        int cgt = 0;
#pragma unroll
                        for (int k4 = 0; k4 < 16; ++k4) {
                            const f32x4 c4 = *(const f32x4*)(cand + 4 * k4);
                            cgt += (c4[0] > y ? 1 : 0) + (c4[1] > y ? 1 : 0) + (c4[2] > y ? 1 : 0) + (c4[3] > y ? 1 : 0);
                        }
                        const int nd = 256 - chi;
                        T = wave_min_f32_dpp((cgt <= nd - 1) ? y : PINF);
                        need = nd - (int)__popcll(__ballot(y > T));
                    }
                }
                bf16_t* selb = (bf16_t*)(lds + 65536 + 1024) + wid * 256;
                int wlo = 0, whi = 0, tot = 0;
#pragma unroll
                for (int g8 = 0; g8 < 8; ++g8) if (g8 * 8 < nr) {
#pragma unroll
                    for (int r = g8 * 8; r < g8 * 8 + 8; ++r) {
                        const unsigned long long m = __ballot(x[r] >= T);
                        tot += __popcll(m);
                        asm volatile("v_writelane_b32 %0, %1, %2" : "+v"(wlo) : "s"((unsigned)m), "n"(r));
                        asm volatile("v_writelane_b32 %0, %1, %2" : "+v"(whi) : "s"((unsigned)(m >> 32)), "n"(r));
                    }
                }
                if (tot == 256) {
                    const int cw = __popc((unsigned)wlo) + __popc((unsigned)whi);
                    int pos = 0;
#pragma unroll
                    for (int bb = 0; bb < 7; ++bb) {
                        const unsigned long long bmk = __ballot(((cw >> bb) & 1) != 0);
                        pos += (int)__builtin_amdgcn_mbcnt_hi((unsigned)(bmk >> 32), __builtin_amdgcn_mbcnt_lo((unsigned)bmk, 0u)) << bb;
                    }
                    unsigned long long w = ((unsigned long long)(unsigned)whi << 32) | (unsigned long long)(unsigned)wlo;
                    while (w != 0ull) {
                        const int bpos = (int)__builtin_ctzll(w);
                        selb[pos++] = (bf16_t)(lane * 64 + bpos);
                        w &= w - 1ull;
                    }
                } else {
                    if (need < 0) need = 0x7fffffff;
                    int base = 0, eqc = 0;
                    const unsigned long long lt = (1ull << lane) - 1ull;
#pragma unroll
                    for (int g8 = 0; g8 < 8; ++g8) if (g8 * 8 < nr) {
#pragma unroll
                        for (int r = g8 * 8; r < g8 * 8 + 8; ++r) {
                            const bool eq = (x[r] == T);
                            const unsigned long long em = __ballot(eq);
                            const bool sel = (x[r] > T) || (eq && (eqc + __popcll(em & lt) < need));
                            eqc += __popcll(em);
                            const unsigned long long sm = __ballot(sel);
                            if (sel) { const int pp = base + __popcll(sm & lt); if (pp < 256) selb[pp] = (bf16_t)(r * 64 + lane); }
                            base += __popcll(sm);
                        }
                    }
                }
                __builtin_amdgcn_wave_barrier();
                if (lane < 32) *(u32x4*)(SEL + (size_t)tok * 256 + lane * 8) = *(const u32x4*)(selb + lane * 8);
                __builtin_amdgcn_wave_barrier();
            }
        }
        __syncthreads();
    }
}

DEVI int dsa_vswz(int row) { return (((row >> 1) & 1) << 1) | (((row >> 3) & 1) << 2); }
DEVI void phase_dsa(const Params& P, unsigned char* lds, int tid) {
    unsigned char* ws = P.ws;
    const bf16_t* QA = (const bf16_t*)(ws + OFF_QA);
    const bf16_t* KA = (const bf16_t*)(ws + OFF_KA);
    const bf16_t* VA = (const bf16_t*)(ws + OFF_VA);
    const bf16_t* SEL = (const bf16_t*)(ws + OFF_SEL);
    bf16_t* OA = (bf16_t*)(ws + OFF_OA);
    const int lane = tid & 63, wid = __builtin_amdgcn_readfirstlane(tid >> 6), q = lane >> 4, cl = lane & 15;
    unsigned char* vl0 = lds + wid * 16384;
    const rsrc_t rsd = __builtin_amdgcn_make_buffer_rsrc((void*)P.ws, (short)0, (int)0x7fffffff, 0x00020000);
    const float NINF = -__builtin_inff();
    const bool xl = (gridDim.x == 512);
    constexpr int DSA_A = 21;
    const bool halfA = blockIdx.x < 256;
    const int stride = xl ? 128 : gridDim.x * 4;
    int tok = xl ? ((blockIdx.x & 7) * 4096 + (halfA ? 0 : 128 * DSA_A) + ((blockIdx.x >> 3) & 31) * 4 + wid) : blockIdx.x * 4 + wid;
    const int tend = xl ? ((blockIdx.x & 7) * 4096 + (halfA ? 128 * DSA_A : 4096)) : NTOK;
    if (tok >= tend) return;
    int kidx[16], mk[4]; bf16x8 bq[2];
    {
        const bf16_t* sel = SEL + (size_t)tok * 256;
#pragma unroll
        for (int rf = 0; rf < 16; ++rf) kidx[rf] = sel[32 * (rf >> 1) + 8 * (cl >> 2) + 4 * (rf & 1) + (cl & 3)];
#pragma unroll
        for (int cc = 0; cc < 4; ++cc) mk[cc] = sel[cc * 64 + lane];
#pragma unroll
        for (int ks = 0; ks < 2; ++ks) bq[ks] = *(const bf16x8*)(QA + (size_t)tok * 512 + (cl & 7) * 64 + ks * 32 + q * 8);
    }
    const int wrow = lane >> 3;
    for (; tok < tend; tok += stride) {
        const int b = tok >> 12, t = tok & 4095;
        const int cnt = (t + 1 < 256) ? t + 1 : 256;
        const int nc64 = (cnt + 63) >> 6;
        const bf16_t* kb = KA + (size_t)b * 4096 * 64;
        const bf16_t* vb = VA + (size_t)b * 4096 * 64;
        const bf16x8 zero8 = {0, 0, 0, 0, 0, 0, 0, 0};
        const bf16x8 bq0 = (cl < 8) ? bq[0] : zero8, bq1 = (cl < 8) ? bq[1] : zero8;
        const unsigned sVb = (unsigned)OFF_VA + (unsigned)b * 4096u * 128u;
#pragma unroll
        for (int i = 0; i < 8; ++i) {
            const int row = wrow + 8 * i; const int key = __shfl(mk[0], row);
            glds16(rsd, vl0 + i * 1024, (unsigned)key * 128u + (unsigned)(((lane & 7) ^ dsa_vswz(row)) << 4), sVb);
        }
        f32x4 s[16];
#pragma unroll
        for (int rf = 0; rf < 16; ++rf) {
            s[rf] = (f32x4){0.f, 0.f, 0.f, 0.f};
            if ((rf >> 2) < nc64) {
                const bf16_t* kr = kb + (size_t)kidx[rf] * 64 + q * 8;
                const bf16x8 a0 = *(const bf16x8*)(kr), a1 = *(const bf16x8*)(kr + 32);
                s[rf] = MFMA16(a0, bq0, s[rf]); s[rf] = MFMA16(a1, bq1, s[rf]);
            }
            if ((rf & 3) == 3) asm volatile("" ::: "memory");
        }
        int mkc[4];
#pragma unroll
        for (int cc = 0; cc < 4; ++cc) mkc[cc] = mk[cc];
        {
            const int tn = (tok + stride < tend) ? tok + stride : tok;
            const bf16_t* sel = SEL + (size_t)tn * 256;
#pragma unroll
            for (int rf = 0; rf < 16; ++rf) kidx[rf] = sel[32 * (rf >> 1) + 8 * (cl >> 2) + 4 * (rf & 1) + (cl & 3)];
#pragma unroll
            for (int cc = 0; cc < 4; ++cc) mk[cc] = sel[cc * 64 + lane];
#pragma unroll
            for (int ks = 0; ks < 2; ++ks) bq[ks] = *(const bf16x8*)(QA + (size_t)tn * 512 + (cl & 7) * 64 + ks * 32 + q * 8);
        }
        if (cnt < 256) {
#pragma unroll
            for (int rf = 0; rf < 16; ++rf)
#pragma unroll
                for (int j = 0; j < 4; ++j) {
                    const int p = 32 * (rf >> 1) + 8 * q + 4 * (rf & 1) + j;
                    if (p >= cnt) s[rf][j] = NINF;
                }
        }
        float pinf = __builtin_inff();
        asm volatile("" : "+v"(pinf));
        float mx = NINF;
#pragma unroll
        for (int rf = 0; rf < 16; ++rf)
#pragma unroll
            for (int j = 0; j < 4; ++j) mx = __builtin_amdgcn_fmed3f(mx, s[rf][j], pinf);
        mx = rows_max(mx);
        float ls = 0.f;
#pragma unroll
        for (int rf = 0; rf < 16; ++rf)
#pragma unroll
            for (int j = 0; j < 4; ++j) { const float pv = __builtin_amdgcn_exp2f(s[rf][j] - mx); s[rf][j] = pv; ls += pv; }
        ls = rows_sum(ls);
        const float inv = __builtin_amdgcn_rcpf(ls);
        bf16x8 pbs[8];
#pragma unroll
        for (int c8 = 0; c8 < 8; ++c8) pbs[c8] = pack8(s[2 * c8], s[2 * c8 + 1]);
        f32x4 o[4];
#pragma unroll
        for (int d = 0; d < 4; ++d) o[d] = (f32x4){0.f, 0.f, 0.f, 0.f};
#pragma unroll
        for (int cc = 0; cc < 4; ++cc) {
            if (cc < nc64) {
                unsigned char* vl = vl0 + (cc & 1) * 8192;
                asm volatile("s_waitcnt vmcnt(0)" ::: "memory");
                __builtin_amdgcn_wave_barrier();
                if (cc + 1 < 4 && cc + 1 < nc64) {
                    unsigned char* vn = vl0 + ((cc + 1) & 1) * 8192;
#pragma unroll
                    for (int i = 0; i < 8; ++i) {
                        const int row = wrow + 8 * i; const int key = __shfl(mkc[(cc + 1) & 3], row);
                        glds16(rsd, vn + i * 1024, (unsigned)key * 128u + (unsigned)(((lane & 7) ^ dsa_vswz(row)) << 4), sVb);
                    }
                }
#pragma unroll
                for (int c2 = 0; c2 < 2; ++c2) {
                    const bf16x8 pb = pbs[cc * 2 + c2];
#pragma unroll
                    for (int d = 0; d < 4; ++d) {
                        const int r0 = c2 * 32 + 8 * q + (cl >> 2), r1 = r0 + 4;
                        const int ch = d * 2 + ((cl & 3) >> 1), wb = 8 * (cl & 1);
                        const s16x4 lo4 = __builtin_amdgcn_ds_read_tr16_b64_v4i16((LAS s16x4*)((LAS unsigned char*)(vl) + r0 * 128 + ((ch ^ dsa_vswz(r0)) << 4) + wb));
                        const s16x4 hi4 = __builtin_amdgcn_ds_read_tr16_b64_v4i16((LAS s16x4*)((LAS unsigned char*)(vl) + r1 * 128 + ((ch ^ dsa_vswz(r1)) << 4) + wb));
                        const bf16x8 av = {lo4[0], lo4[1], lo4[2], lo4[3], hi4[0], hi4[1], hi4[2], hi4[3]};
                        o[d] = MFMA16(av, pb, o[d]);
                    }
                }
            }
        }
        if (cl < 8) {
#pragma unroll
            for (int d = 0; d < 4; ++d) {
                u32x2 w; w.x = pk2(o[d][0] * inv, o[d][1] * inv); w.y = pk2(o[d][2] * inv, o[d][3] * inv);
                *(u32x2*)(OA + (size_t)tok * 512 + cl * 64 + d * 16 + q * 4) = w;
            }
        }
    }
}

DEVI int fK(int row) { return (row & 3) | (((row >> 3) & 1) << 2); }

struct AttnState { f32x4 O[4][4]; float m[4]; f32x4 L[4]; f32x4 negm[4]; bool uninit; };
DEVI void attn_init(AttnState& st) {
#pragma unroll
    for (int cf = 0; cf < 4; ++cf) {
        st.m[cf] = -__builtin_inff(); st.L[cf] = (f32x4){0.f, 0.f, 0.f, 0.f};
        f32x4 z = (f32x4){0.f, 0.f, 0.f, 0.f}; asm volatile("" : "+v"(z)); st.negm[cf] = z;
#pragma unroll
        for (int d = 0; d < 4; ++d) st.O[d][cf] = (f32x4){0.f, 0.f, 0.f, 0.f};
    }
    st.uninit = true;
}
DEVI int imax(int a, int b) { return a > b ? a : b; }
DEVI int f2i(float x) { return __builtin_bit_cast(int, x); }

template <int MODE>
DEVI void attn_tile(const unsigned char* ktile, const unsigned char* vtile, int jb, const bf16x8 (&qf)[4][2], AttnState& st,
                    int tq, int nmax, bool lane_on, const bf16x8& ones_frag, int q, int cl, bool track) {
    const float NINF = -__builtin_inff();
    bool edge;
    if (MODE == 0) edge = (jb * 64 + 63 > nmax);
    else if (MODE == 1) edge = (jb * 64 + 63 > tq);
    else edge = (jb * 64 + 63 > tq) || (jb * 64 <= tq - 512);
    const bool need_mask = __ballot(edge) != 0ull;
    const unsigned lanemask = (MODE == 1 && !lane_on) ? 0u : 0xffffffffu;
#pragma unroll
        for (int c = 0; c < 2; ++c) {
            f32x4 S[2][4];
#pragma unroll
            for (int r2 = 0; r2 < 2; ++r2) {
                const int kl = 32 * c + 8 * (cl >> 2) + 4 * r2 + (cl & 3);
#pragma unroll
                for (int ks = 0; ks < 2; ++ks) {
                    const bf16x8 a = *(const bf16x8*)(ktile + kl * 128 + (((ks * 4 + q) ^ (cl & 7)) << 4));
#pragma unroll
                    for (int cf = 0; cf < 4; ++cf) S[r2][cf] = MFMA16(a, qf[cf][ks], ks == 0 ? st.negm[cf] : S[r2][cf]);
                }
            }
            if (need_mask) {
#pragma unroll
                for (int cf = 0; cf < 4; ++cf)
#pragma unroll
                    for (int r2 = 0; r2 < 2; ++r2)
#pragma unroll
                        for (int j = 0; j < 4; ++j) {
                            const int key = jb * 64 + 32 * c + 8 * q + 4 * r2 + j;
                            bool v;
                            if (MODE == 0) v = key <= nmax;
                            else if (MODE == 1) v = lane_on && key <= tq;
                            else v = key <= tq && key > tq - 512;
                            if (!v) S[r2][cf][j] = NINF;
                        }
            }
            if (track || st.uninit) {
            int ball;
            {
                int bi[4];
#pragma unroll
                for (int cf = 0; cf < 4; ++cf) {
                    const int x0 = f2i(S[0][cf][0]), x1 = f2i(S[0][cf][1]), x2 = f2i(S[0][cf][2]), x3 = f2i(S[0][cf][3]);
                    const int y0 = f2i(S[1][cf][0]), y1 = f2i(S[1][cf][1]), y2 = f2i(S[1][cf][2]), y3 = f2i(S[1][cf][3]);
                    bi[cf] = imax(imax(imax(x0, x1), x2), imax(imax(imax(x3, y0), y1), imax(y2, y3)));
                }
                ball = imax(imax(bi[0], bi[1]), imax(bi[2], bi[3]));
            }
            bool trig = ball > 0x41000000;
            if (MODE == 1) trig = trig && lane_on;
            if (st.uninit || __ballot(trig) != 0ull) {
                bool un = false;
#pragma unroll
                for (int cf = 0; cf < 4; ++cf) {
                    float bml = fmaxf(fmaxf(fmaxf(S[0][cf][0], S[0][cf][1]), fmaxf(S[0][cf][2], S[0][cf][3])), fmaxf(fmaxf(S[1][cf][0], S[1][cf][1]), fmaxf(S[1][cf][2], S[1][cf][3])));
                    if (MODE == 1) bml = lane_on ? bml : NINF;
                    const float bm = rows_max(bml);
                    const float oldref = (st.m[cf] == NINF) ? 0.f : st.m[cf];
                    const float mnew = fmaxf(st.m[cf], bm + oldref);
                    const float newref = (mnew == NINF) ? 0.f : mnew;
                    const float alpha = __builtin_amdgcn_exp2f(st.m[cf] - newref);
                    const float delta = newref - oldref;
#pragma unroll
                    for (int r2 = 0; r2 < 2; ++r2)
#pragma unroll
                        for (int j = 0; j < 4; ++j) S[r2][cf][j] -= delta;
                    st.m[cf] = mnew;
                    f32x4 nm = (f32x4){-newref, -newref, -newref, -newref}; asm volatile("" : "+v"(nm)); st.negm[cf] = nm;
                    st.L[cf] *= alpha;
#pragma unroll
                    for (int d = 0; d < 4; ++d) st.O[d][cf] *= alpha;
                    un = un || (__ballot(mnew == NINF) != 0ull);
                }
                st.uninit = un;
            }
            }
            bf16x8 pb[4];
#pragma unroll
            for (int cf = 0; cf < 4; ++cf) {
#pragma unroll
                for (int r2 = 0; r2 < 2; ++r2)
#pragma unroll
                    for (int j = 0; j < 4; ++j) S[r2][cf][j] = __builtin_amdgcn_exp2f(S[r2][cf][j]);
                pb[cf] = pack8(S[0][cf], S[1][cf]);
                if (MODE == 1) { u32x4 w = __builtin_bit_cast(u32x4, pb[cf]); w.x &= lanemask; w.y &= lanemask; w.z &= lanemask; w.w &= lanemask; pb[cf] = __builtin_bit_cast(bf16x8, w); }
                st.L[cf] = MFMA16(ones_frag, pb[cf], st.L[cf]);
            }
#pragma unroll
            for (int d = 0; d < 4; ++d) {
                const int row = d * 16 + cl;
                const bf16x8 av = *(const bf16x8*)(vtile + row * 128 + (((c * 4 + q) ^ (row & 7)) << 4));
#pragma unroll
                for (int cf = 0; cf < 4; ++cf) st.O[d][cf] = MFMA16(av, pb[cf], st.O[d][cf]);
            }
        }
}

template <int MODE>
DEVI void attn_blocks(rsrc_t rs, unsigned sK, unsigned sV, int ldv, int jb0, int jb1, const bf16x8 (&qf)[4][2], AttnState& st,
                      int tq, unsigned long long selmask, unsigned char* lds, int tid, bool track) {
    const int lane = tid & 63, q = lane >> 4, cl = lane & 15;
    const float NINF = -__builtin_inff();
    const short one_bf = (cl == 0) ? (short)0x3F80 : (short)0;
    const bf16x8 ones_frag = {one_bf, one_bf, one_bf, one_bf, one_bf, one_bf, one_bf, one_bf};
    attn_init(st);
    if (jb1 < jb0) return;
    const int wid_ = __builtin_amdgcn_readfirstlane(tid >> 6);
    unsigned kro[2], vro[2];
#pragma unroll
    for (int i = 0; i < 2; ++i) {
        const int row = (wid_ * 2 + i) * 8 + (lane >> 3);
        kro[i] = (unsigned)(row * 64 + (((lane & 7) ^ fK(row)) << 3)) * 2u;
        vro[i] = (unsigned)(((row & ~31) + perm32(row & 31)) * ldv + (((lane & 7) ^ (row & 7)) << 3)) * 2u;
    }
    unsigned char* wk = lds + wid_ * 2048;
#pragma unroll
    for (int i = 0; i < 2; ++i) { glds16(rs, wk + i * 1024, kro[i], sK + (unsigned)jb0 * 8192u); glds16(rs, wk + 8192 + i * 1024, vro[i], sV + (unsigned)jb0 * 128u); }
    __syncthreads();
    const int nmax = (tq >= 31) ? ((tq - 31) >> 4) : -1;
    for (int jb = jb0; jb <= jb1; ++jb) {
        unsigned char* cur = lds + ((jb - jb0) & 1) * 16384;
        const bool more = jb < jb1;
        if (more) {
            unsigned char* wn = wk + ((jb - jb0 + 1) & 1) * 16384;
#pragma unroll
            for (int i = 0; i < 2; ++i) { glds16(rs, wn + i * 1024, kro[i], sK + (unsigned)(jb + 1) * 8192u); glds16(rs, wn + 8192 + i * 1024, vro[i], sV + (unsigned)(jb + 1) * 128u); }
        }
        bool lane_on = true;
        if (MODE == 1) lane_on = ((selmask >> jb) & 1ull) != 0ull;
        if (MODE == 0) lane_on = (jb * 64 <= nmax);
        if (MODE == 2) lane_on = (jb * 64 + 63 > tq - 512);
        if (__ballot(lane_on) != 0ull) attn_tile<MODE>(cur, cur + 8192, jb, qf, st, tq, nmax, lane_on, ones_frag, q, cl, track);
        __syncthreads();
    }
}

DEVI f32x4 bload16f(rsrc_t r, unsigned voff, unsigned soff) { return __builtin_bit_cast(f32x4, __builtin_amdgcn_raw_buffer_load_b128(r, (int)voff, (int)soff, 0)); }
DEVI void bstore16f(rsrc_t r, f32x4 v, unsigned voff, unsigned soff) { __builtin_amdgcn_raw_buffer_store_b128(__builtin_bit_cast(u32x4, v), r, (int)voff, (int)soff, 0); }
DEVI float bload4f(rsrc_t r, unsigned voff, unsigned soff) { return __builtin_bit_cast(float, __builtin_amdgcn_raw_buffer_load_b32(r, (int)voff, (int)soff, 0)); }

DEVI bool attn_overflowed(const AttnState& st) {
    float mx = 0.f;
#pragma unroll
    for (int cf = 0; cf < 4; ++cf) {
        mx = fmaxf(mx, fabsf(st.L[cf][0]));
#pragma unroll
        for (int d = 0; d < 4; ++d) mx = fmaxf(mx, fmaxf(fmaxf(fabsf(st.O[d][cf][0]), fabsf(st.O[d][cf][1])), fmaxf(fabsf(st.O[d][cf][2]), fabsf(st.O[d][cf][3]))));
    }
    return !(mx < 1e37f);
}
DEVI bool block_any(bool v, unsigned char* lds, int tid) {
    volatile LAS unsigned* flag = (volatile LAS unsigned*)(LAS unsigned char*)(lds + LDS_BYTES - 32);
    __syncthreads();
    if (v) *flag = 1u;
    __syncthreads();
    const bool any = (*flag != 0u);
    __syncthreads();
    if (tid == 0) *flag = 0u;
    return any;
}

struct NsaUnit { int i, b, k, t0, tq; unsigned tokw, tokb, qoff, goff, ooff, sQ, sG, sO; };
DEVI NsaUnit nsa_unit(int uu, int tid) {
    NsaUnit U;
    const int lane = tid & 63, wid = __builtin_amdgcn_readfirstlane(tid >> 6), q = lane >> 4, cl = lane & 15;
    const int half = uu >> 9, r = uu & 511, bk = r & 15, ii = r >> 4;
    U.i = half ? ii : 63 - ii; U.b = bk >> 1; U.k = bk & 1;
    U.t0 = U.i * 64; U.tq = U.t0 + wid * 16 + cl;
    U.tokw = (unsigned)(wid * 16 + cl);
    U.tokb = (unsigned)(U.b * 4096 + U.t0);
    U.qoff = U.tokw * 1024u + (unsigned)q * 16u;
    U.goff = U.tokw * 96u;
    U.ooff = U.tokw * 1024u + (unsigned)q * 16u;
    U.sQ = U.tokb * 1024u + (unsigned)U.k * 512u;
    U.sG = (unsigned)OFF_GATES + U.tokb * 96u + (unsigned)U.k * 16u;
    U.sO = (unsigned)OFF_OB + U.tokb * 1024u + (unsigned)U.k * 512u;
    return U;
}

DEVI void nsa_cmp_unit(const Params& P, rsrc_t rs, int uu, unsigned char* lds, int tid) {
    const int lane = tid & 63, wid = __builtin_amdgcn_readfirstlane(tid >> 6), q = lane >> 4, cl = lane & 15;
    const NsaUnit U = nsa_unit(uu, tid);
    const int i = U.i, b = U.b, k = U.k, tq = U.tq;
    const float NINF = -__builtin_inff();
    AttnState st;
    bf16x8 qf[4][2];
#pragma unroll
    for (int cf = 0; cf < 4; ++cf)
#pragma unroll
        for (int ks = 0; ks < 2; ++ks) qf[cf][ks] = __builtin_bit_cast(bf16x8, bload16(rs, U.qoff, (unsigned)OFF_QBN + U.sQ + cf * 128 + ks * 64));
    const unsigned sKC = (unsigned)OFF_KC + (unsigned)(b * 2 + k) * 256u * 128u;
    const unsigned sVC = (unsigned)OFF_VCT + (unsigned)(b * 2 + k) * 64u * 512u;
    const int nmax_blk = (U.t0 + 63 - 31) >> 4;
    const int jbc = (nmax_blk >> 6) < 3 ? (nmax_blk >> 6) : 3;
    {
        unsigned kro[2], vro[2];
#pragma unroll
        for (int ii = 0; ii < 2; ++ii) {
            const int row = (wid * 2 + ii) * 8 + (lane >> 3);
            kro[ii] = (unsigned)(row * 64 + (((lane & 7) ^ fK(row)) << 3)) * 2u;
            vro[ii] = (unsigned)(((row & ~31) + perm32(row & 31)) * 256 + (((lane & 7) ^ (row & 7)) << 3)) * 2u;
        }
        for (int kb = 0; kb <= jbc; ++kb) {
#pragma unroll
            for (int ii = 0; ii < 2; ++ii) {
                glds16(rs, lds + kb * 8192 + wid * 2048 + ii * 1024, kro[ii], sKC + (unsigned)kb * 8192u);
                glds16(rs, lds + 32768 + kb * 8192 + wid * 2048 + ii * 1024, vro[ii], sVC + (unsigned)kb * 128u);
            }
        }
    }
    const short one_bf = (cl == 0) ? (short)0x3F80 : (short)0;
    const bf16x8 ones_frag = {one_bf, one_bf, one_bf, one_bf, one_bf, one_bf, one_bf, one_bf};
    const int nmax = (tq >= 31) ? ((tq - 31) >> 4) : -1;
    __syncthreads();
    for (int pass = 0; pass < 2; ++pass) {
        attn_init(st);
        for (int kb = 0; kb <= jbc; ++kb) {
            const bool lane_on = (kb * 64 <= nmax);
            if (__ballot(lane_on) != 0ull) attn_tile<0>(lds + kb * 8192, lds + 32768 + kb * 8192, kb, qf, st, tq, nmax, lane_on, ones_frag, q, cl, pass != 0);
        }
        if (pass != 0 || !block_any(attn_overflowed(st), lds, tid)) break;
    }
    float linv[4], mfin[4];
#pragma unroll
    for (int cf = 0; cf < 4; ++cf) {
        const float l = rows_sum(st.L[cf][0]);
        linv[cf] = (l > 0.f) ? __builtin_amdgcn_rcpf(l) : 0.f; mfin[cf] = st.m[cf];
        const float sc = linv[cf] * bload4f(rs, U.goff, U.sG + cf * 4);
#pragma unroll
        for (int g2 = 0; g2 < 2; ++g2) { const f32x4 v0 = st.O[2 * g2][cf] * sc, v1 = st.O[2 * g2 + 1][cf] * sc;
            u32x4 w; w.x = pk2(v0[0], v0[1]); w.y = pk2(v0[2], v0[3]); w.z = pk2(v1[0], v1[1]); w.w = pk2(v1[2], v1[3]);
            __builtin_amdgcn_raw_buffer_store_b128(w, rs, (int)U.ooff, (int)(U.sO + cf * 128 + g2 * 64), 0); }
    }
    unsigned long long* MSKG = (unsigned long long*)(P.ws + OFF_MASK);
    if (i < 16) {
        if (q == 0) MSKG[((size_t)(b * 2 + k)) * 4096 + tq] = (2ull << i) - 1ull;
        __syncthreads();
        return;
    }
    float* SUM4 = (float*)(lds + 32768);
    float* LAST = (float*)(lds + 49152);
    float* IMP2 = (float*)(lds);
    __syncthreads();
    for (int kb = 0; kb <= jbc; ++kb) {
        const unsigned char* ktile = lds + kb * 8192;
#pragma unroll
        for (int rf = 0; rf < 4; ++rf) {
            f32x4 S[4];
#pragma unroll
            for (int cf = 0; cf < 4; ++cf) S[cf] = (f32x4){0.f, 0.f, 0.f, 0.f};
            const int kl = 32 * (rf >> 1) + 8 * (cl >> 2) + 4 * (rf & 1) + (cl & 3);
#pragma unroll
            for (int ks = 0; ks < 2; ++ks) {
                const bf16x8 a = *(const bf16x8*)(ktile + kl * 128 + (((ks * 4 + q) ^ (cl & 7)) << 4));
#pragma unroll
                for (int cf = 0; cf < 4; ++cf) S[cf] = MFMA16(a, qf[cf][ks], S[cf]);
            }
            float acc4 = 0.f, accl = 0.f;
#pragma unroll
            for (int j = 0; j < 4; ++j) {
                const int key = kb * 64 + 32 * (rf >> 1) + 8 * q + 4 * (rf & 1) + j;
                float pj = 0.f;
#pragma unroll
                for (int cf = 0; cf < 4; ++cf) pj += __builtin_amdgcn_exp2f(S[cf][j] - mfin[cf]) * linv[cf];
                pj = (key <= nmax) ? pj : 0.f;
                acc4 += pj; if (j == 3) accl = pj;
            }
            const int jblk = kb * 16 + 8 * (rf >> 1) + 2 * q + (rf & 1);
            SUM4[(wid * 16 + cl) * 64 + jblk] = acc4; LAST[(wid * 16 + cl) * 64 + jblk] = accl;
        }
    }
    __syncthreads();
    const int qi = tid >> 2, jg = tid & 3;
    {
        const int jlim = (jbc + 1) * 16;
        for (int jj = 0; jj < 16; ++jj) {
            const int j = jg * 16 + jj;
            float v = (j < jlim) ? SUM4[qi * 64 + j] : 0.f;
            if (j >= 1 && j - 1 < jlim) v += LAST[qi * 64 + j - 1];
            IMP2[qi * 64 + j] = v;
        }
    }
    __syncthreads();
    {
        float key16[16];
#pragma unroll
        for (int j4 = 0; j4 < 4; ++j4) {
            const f32x4 v = *(const f32x4*)(IMP2 + qi * 64 + jg * 16 + j4 * 4);
#pragma unroll
            for (int e = 0; e < 4; ++e) {
                const int j = jg * 16 + j4 * 4 + e;
                const bool forced = (j == 0) || (j == i) || (j == i - 1);
                key16[j4 * 4 + e] = (j > i || forced) ? NINF : v[e];
            }
        }
        unsigned lo = 0u;
#pragma unroll
        for (int jj = 0; jj < 16; ++jj) { const int j = jg * 16 + jj; if (j == 0 || j == i || j == i - 1) lo |= (1u << jj); }
        for (int round = 0; round < 13; ++round) {
            float lm = key16[0];
#pragma unroll
            for (int jj = 1; jj < 16; ++jj) lm = fmaxf(lm, key16[jj]);
            float qm = fmaxf(lm, __shfl_xor(lm, 1)); qm = fmaxf(qm, __shfl_xor(qm, 2));
            const unsigned mine = (lm == qm && qm > NINF) ? (1u << jg) : 0u;
            unsigned qb = mine | __shfl_xor(mine, 1); qb |= __shfl_xor(qb, 2);
            const bool iswin = (qb != 0u) && ((int)__builtin_ctz(qb | 16u) == jg);
            int f = 16;
#pragma unroll
            for (int jj = 15; jj >= 0; --jj) f = (key16[jj] == qm) ? jj : f;
            if (iswin) lo |= (1u << f);
#pragma unroll
            for (int jj = 0; jj < 16; ++jj) key16[jj] = (iswin && jj == f) ? NINF : key16[jj];
        }
        unsigned long long bits = (unsigned long long)lo << (jg * 16);
        bits |= __shfl_xor(bits, 1); bits |= __shfl_xor(bits, 2);
        if (jg == 0) MSKG[((size_t)(b * 2 + k)) * 4096 + U.t0 + qi] = bits;
    }
    __syncthreads();
}

template <int MODE>
DEVI void nsa_kv_unit(const Params& P, rsrc_t rs, int uu, unsigned char* lds, int tid) {
    const int lane = tid & 63, q = lane >> 4;
    const NsaUnit U = nsa_unit(uu, tid);
    const int i = U.i, b = U.b, k = U.k, tq = U.tq;
    AttnState st;
    bf16x8 qf[4][2];
#pragma unroll
    for (int cf = 0; cf < 4; ++cf)
#pragma unroll
        for (int ks = 0; ks < 2; ++ks) qf[cf][ks] = __builtin_bit_cast(bf16x8, bload16(rs, U.qoff, (unsigned)OFF_QBR + U.sQ + cf * 128 + ks * 64));
    const unsigned sK = (unsigned)(OFF_KV + (MODE == 1 ? 2 : 4) * KV_STRIDE) + (unsigned)(b * 2 + k) * 4096u * 128u;
    const unsigned sV = (unsigned)(OFF_KV + (MODE == 1 ? 3 : 5) * KV_STRIDE) + (unsigned)(b * 2 + k) * 64u * 8192u;
    unsigned long long mymask = 0ull;
    int j0 = 0;
    if (MODE == 1) mymask = ((const unsigned long long*)(P.ws + OFF_MASK))[((size_t)(b * 2 + k)) * 4096 + tq];
    else j0 = (i >= 8) ? i - 8 : 0;
    for (int pass = 0; pass < 2; ++pass) {
        attn_blocks<MODE>(rs, sK, sV, 4096, j0, i, qf, st, tq, mymask, lds, tid, pass != 0);
        if (pass != 0 || !block_any(attn_overflowed(st), lds, tid)) break;
    }
#pragma unroll
    for (int cf = 0; cf < 4; ++cf) {
        const float l = rows_sum(st.L[cf][0]);
        const float sc = ((l > 0.f) ? __builtin_amdgcn_rcpf(l) : 0.f) * bload4f(rs, U.goff, U.sG + (MODE == 1 ? 32 : 64) + cf * 4);
#pragma unroll
        for (int g2 = 0; g2 < 2; ++g2) {
            const u32x4 pw = __builtin_bit_cast(u32x4, __builtin_amdgcn_raw_buffer_load_b128(rs, (int)U.ooff, (int)(U.sO + cf * 128 + g2 * 64), 0));
            f32x4 v0 = st.O[2 * g2][cf] * sc, v1 = st.O[2 * g2 + 1][cf] * sc;
            v0[0] += bf2f(pw.x & 0xffffu); v0[1] += bf2f(pw.x >> 16); v0[2] += bf2f(pw.y & 0xffffu); v0[3] += bf2f(pw.y >> 16);
            v1[0] += bf2f(pw.z & 0xffffu); v1[1] += bf2f(pw.z >> 16); v1[2] += bf2f(pw.w & 0xffffu); v1[3] += bf2f(pw.w >> 16);
            u32x4 w; w.x = pk2(v0[0], v0[1]); w.y = pk2(v0[2], v0[3]); w.z = pk2(v1[0], v1[1]); w.w = pk2(v1[2], v1[3]);
            __builtin_amdgcn_raw_buffer_store_b128(w, rs, (int)U.ooff, (int)(U.sO + cf * 128 + g2 * 64), 0);
        }
    }
}

DEVI void phase_nsa(const Params& P, unsigned char* lds, int tid) {
    const rsrc_t rs = __builtin_amdgcn_make_buffer_rsrc((void*)P.ws, (short)0, (int)0x7fffffff, 0x00020000);
    for (int uu = blockIdx.x; uu < 1024; uu += gridDim.x) { int t = tid; asm volatile("" : "+v"(t)); nsa_cmp_unit(P, rs, uu, lds, t); }
    __syncthreads();
    for (int uu = blockIdx.x; uu < 1024; uu += gridDim.x) { int t = tid; asm volatile("" : "+v"(t)); nsa_kv_unit<1>(P, rs, uu, lds, t); }
    __syncthreads();
    for (int uu = blockIdx.x; uu < 1024; uu += gridDim.x) { int t = tid; asm volatile("" : "+v"(t)); nsa_kv_unit<2>(P, rs, uu, lds, t); }
}

DEVI void phase_merge(const Params& P, unsigned char* lds, int tid) {
    unsigned char* ws = P.ws;
    const rsrc_t rs = __builtin_amdgcn_make_buffer_rsrc((void*)P.ws, (short)0, (int)0x7fffffff, 0x00020000);
    const bf16_t* ga = (const bf16_t*)(ws + OFF_GA);
    const bf16_t* gb = (const bf16_t*)(ws + OFF_GB);
    bf16_t* mg = (bf16_t*)(ws + OFF_MERGED);
    const int lane = tid & 63, wid = __builtin_amdgcn_readfirstlane(tid >> 6), wr = wid >> 1, wc = wid & 1, q = lane >> 4, cl = lane & 15;
    for (int kk = 0;; ++kk) {
        int mt, nt;
        if (!tile_map(kk, 8, mt, nt)) break;
        f32x4 acc[4][4];
        unsigned t[4][4][2];
        gemm128(acc, rs, (unsigned)(OFF_OA + (size_t)mt * 128 * 1024), RowLin{1024}, (unsigned)(OFF_WBRA + (size_t)nt * 128 * 1024), RowLinPerm{1024}, 8, lds, tid);
        const size_t e0 = (size_t)(mt * 128 + wr * 64 + cl) * 1024 + nt * 128 + wc * 64 + q * 8;
#pragma unroll
        for (int m = 0; m < 4; ++m)
#pragma unroll
            for (int g2 = 0; g2 < 2; ++g2) {
                const u32x4 gv = *(const u32x4*)(ga + e0 + (size_t)m * 16 * 1024 + g2 * 32);
                t[m][2 * g2][0] = pk2(acc[m][2 * g2][0] * bf2f(gv.x & 0xffffu), acc[m][2 * g2][1] * bf2f(gv.x >> 16));
                t[m][2 * g2][1] = pk2(acc[m][2 * g2][2] * bf2f(gv.y & 0xffffu), acc[m][2 * g2][3] * bf2f(gv.y >> 16));
                t[m][2 * g2 + 1][0] = pk2(acc[m][2 * g2 + 1][0] * bf2f(gv.z & 0xffffu), acc[m][2 * g2 + 1][1] * bf2f(gv.z >> 16));
                t[m][2 * g2 + 1][1] = pk2(acc[m][2 * g2 + 1][2] * bf2f(gv.w & 0xffffu), acc[m][2 * g2 + 1][3] * bf2f(gv.w >> 16));
            }
        gemm128(acc, rs, (unsigned)(OFF_OB + (size_t)mt * 128 * 1024), RowLin{1024}, (unsigned)(OFF_WBRB + (size_t)nt * 128 * 1024), RowLinPerm{1024}, 8, lds, tid);
#pragma unroll
        for (int m = 0; m < 4; ++m)
#pragma unroll
            for (int g2 = 0; g2 < 2; ++g2) {
                const size_t o = e0 + (size_t)m * 16 * 1024 + g2 * 32;
                const u32x4 gv = *(const u32x4*)(gb + o);
                const int n0 = 2 * g2, n1 = 2 * g2 + 1;
                u32x4 w;
                w.x = pk2(bf2f(t[m][n0][0] & 0xffffu) + acc[m][n0][0] * bf2f(gv.x & 0xffffu), bf2f(t[m][n0][0] >> 16) + acc[m][n0][1] * bf2f(gv.x >> 16));
                w.y = pk2(bf2f(t[m][n0][1] & 0xffffu) + acc[m][n0][2] * bf2f(gv.y & 0xffffu), bf2f(t[m][n0][1] >> 16) + acc[m][n0][3] * bf2f(gv.y >> 16));
                w.z = pk2(bf2f(t[m][n1][0] & 0xffffu) + acc[m][n1][0] * bf2f(gv.z & 0xffffu), bf2f(t[m][n1][0] >> 16) + acc[m][n1][1] * bf2f(gv.z >> 16));
                w.w = pk2(bf2f(t[m][n1][1] & 0xffffu) + acc[m][n1][2] * bf2f(gv.w & 0xffffu), bf2f(t[m][n1][1] >> 16) + acc[m][n1][3] * bf2f(gv.w >> 16));
                *(u32x4*)(mg + o) = w;
            }
    }
}

DEVI void phase_outproj(const Params& P, unsigned char* lds, int tid) {
    unsigned char* ws = P.ws;
    const rsrc_t rs = __builtin_amdgcn_make_buffer_rsrc((void*)P.ws, (short)0, (int)0x7fffffff, 0x00020000);
    const bf16_t* mg = (const bf16_t*)(ws + OFF_MERGED);
    const bf16_t* wo = (const bf16_t*)(ws + OFF_WOUT);
    const float* x = P.in[0];
    float* x1 = P.out;
    const int lane = tid & 63, wid = __builtin_amdgcn_readfirstlane(tid >> 6), wr = wid >> 1, wc = wid & 1, q = lane >> 4, cl = lane & 15;
    for (int kk = 0;; ++kk) {
        int mt, nt;
        if (!tile_map(kk, 8, mt, nt, 128)) break;
        f32x4 acc[8][4];
        gemm256<false, false, true>(acc, rs, (unsigned)(OFF_MERGED + (size_t)mt * 256 * 2048), 2048u, (unsigned)(OFF_WOUT + (size_t)nt * 128 * 2048), 2048u, 32, lds, tid);
#pragma unroll
        for (int m = 0; m < 8; ++m)
#pragma unroll
            for (int n = 0; n < 4; ++n) {
                const size_t o = (size_t)(mt * 256 + wr * 128 + m * 16 + cl) * 1024 + nt * 128 + wc * 64 + (n >> 1) * 32 + q * 8 + (n & 1) * 4;
                *(f32x4*)(x1 + o) = *(const f32x4*)(x + o) + acc[m][n];
            }
    }
}

DEVI void phase_router(const Params& P, unsigned char* lds, int tid) {
    unsigned char* ws = P.ws;
    const int lane = tid & 63, wid = __builtin_amdgcn_readfirstlane(tid >> 6), q = lane >> 4, cl = lane & 15;
    const float* x1 = P.out; const float* g = P.in[13];
    const float* bg = P.in[15]; const float* be = P.in[17];
    const float* WR = (const float*)(ws + OFF_WR);
    bf16_t* h2 = (bf16_t*)(ws + OFF_HN);
    unsigned* cnt = (unsigned*)(ws + OFF_CTL);
    int* list = (int*)(ws + OFF_LIST);
    float* wt = (float*)(ws + OFF_WT);
    float* WL = (float*)lds;
    float* LG = (float*)(lds + 50688);
    float* RS = (float*)(lds + 50688 + 12288);
    unsigned* HC = (unsigned*)(lds + 50688 + 12288 + 512);
    for (int u = blockIdx.x; u < NTOK / 64; u += gridDim.x) {
        const int row0 = u * 64 + wid * 16;
        const float* xa = x1 + (size_t)(row0 + cl) * 1024 + 4 * q;
        f32x4 acc[3];
#pragma unroll
        for (int ct = 0; ct < 3; ++ct) acc[ct] = (f32x4){0.f, 0.f, 0.f, 0.f};
        float ss = 0.f;
        f32x4 avA[8], avB[8];
#pragma unroll
        for (int j = 0; j < 8; ++j) avA[j] = *(const f32x4*)(xa + j * 16);
        auto half = [&](const f32x4 (&av)[8], int kc, int jh) {
#pragma unroll
            for (int j = 0; j < 8; ++j) {
                {
                    const int kx = kc * 256 + (jh * 8 + j) * 16 + 4 * q;
                    const f32x4 gg = *(const f32x4*)(g + kx);
                    u32x2 w; w.x = pk2(av[j][0] * gg[0], av[j][1] * gg[1]); w.y = pk2(av[j][2] * gg[2], av[j][3] * gg[3]);
                    *(u32x2*)(h2 + (size_t)(row0 + cl) * 1024 + kx) = w;
                }
                ss += av[j][0] * av[j][0] + av[j][1] * av[j][1] + av[j][2] * av[j][2] + av[j][3] * av[j][3];
#pragma unroll
                for (int ct = 0; ct < 3; ++ct) {
                    const f32x4 bv = *(const f32x4*)(WL + (ct * 16 + cl) * 264 + (jh * 8 + j) * 16 + 4 * q);
#pragma unroll
                    for (int e = 0; e < 4; ++e) acc[ct] = __builtin_amdgcn_mfma_f32_16x16x4f32(av[j][e], bv[e], acc[ct], 0, 0, 0);
                }
            }
        };
        f32x4 wr[12];
#pragma unroll
        for (int i = 0; i < 12; ++i) {
            const int idx = tid + 256 * i, r = idx >> 6, c4 = idx & 63;
            wr[i] = *(const f32x4*)(WR + (size_t)r * 1024 + c4 * 4);
        }
        for (int kc = 0; kc < 4; ++kc) {
            __syncthreads();
#pragma unroll
            for (int i = 0; i < 12; ++i) {
                const int idx = tid + 256 * i, r = idx >> 6, c4 = idx & 63;
                *(f32x4*)(WL + r * 264 + c4 * 4) = wr[i];
            }
            __syncthreads();
            const int kn = (kc < 3) ? (kc + 1) * 256 : 0;
#pragma unroll
            for (int j = 0; j < 8; ++j) avB[j] = *(const f32x4*)(xa + kc * 256 + 128 + j * 16);
#pragma unroll
            for (int i = 0; i < 12; ++i) {
                const int idx = tid + 256 * i, r = idx >> 6, c4 = idx & 63;
                wr[i] = *(const f32x4*)(WR + (size_t)r * 1024 + kn + c4 * 4);
            }
            half(avA, kc, 0);
#pragma unroll
            for (int j = 0; j < 8; ++j) avA[j] = *(const f32x4*)(xa + kn + j * 16);
            half(avB, kc, 1);
        }
        ss += __shfl_xor(ss, 16); ss += __shfl_xor(ss, 32);
        const float rs = rsqrtf(ss * (1.0f / 1024.0f) + RMS_EPS);
        if (q == 0) { RS[wid * 16 + cl] = rs; ((float*)(ws + OFF_RS))[row0 + cl] = rs; }
        if (tid < 32) HC[tid] = 0u;
        __syncthreads();
#pragma unroll
        for (int j = 0; j < 4; ++j) {
            const float rj = RS[wid * 16 + 4 * q + j];
#pragma unroll
            for (int ct = 0; ct < 3; ++ct) LG[(wid * 16 + 4 * q + j) * 48 + ct * 16 + cl] = acc[ct][j] * rj;
        }
        __syncthreads();
        if (tid < 64) {
            const int r = u * 64 + tid;
            const float* lg = LG + tid * 48;
            float gl[4];
#pragma unroll
            for (int e = 0; e < 4; ++e) gl[e] = lg[e] + bg[e];
            int gs = 0; float gm = gl[0];
#pragma unroll
            for (int e = 1; e < 4; ++e) if (gl[e] > gm) { gm = gl[e]; gs = e; }
            float den = 0.f;
#pragma unroll
            for (int e = 0; e < 4; ++e) den += __expf(gl[e] - gm);
            const float gp = 1.0f / den;
            float el[8];
#pragma unroll
            for (int e = 0; e < 8; ++e) el[e] = lg[4 + gs * 8 + e] + be[gs * 8 + e];
            int i0 = 0; float v0 = el[0];
#pragma unroll
            for (int e = 1; e < 8; ++e) if (el[e] > v0) { v0 = el[e]; i0 = e; }
            int i1 = -1; float v1 = -__builtin_inff();
#pragma unroll
            for (int e = 0; e < 8; ++e) if (e != i0 && el[e] > v1) { v1 = el[e]; i1 = e; }
            const float e1 = __expf(v1 - v0);
            const float w0 = gp / (1.0f + e1), w1 = gp * e1 / (1.0f + e1);
            const int ex0 = gs * 8 + i0, ex1 = gs * 8 + i1;
            wt[(size_t)r * 2 + 0] = w0; wt[(size_t)r * 2 + 1] = w1;
            const unsigned l0 = atomicAdd(&HC[ex0], 1u);
            const unsigned l1 = atomicAdd(&HC[ex1], 1u);
            __builtin_amdgcn_fence(__ATOMIC_RELEASE, "wavefront");
            __builtin_amdgcn_wave_barrier();
            const unsigned hc = (tid < 32) ? *(volatile unsigned*)&HC[tid] : 0u;
            unsigned base = 0u;
            if (hc != 0u) base = atomicAdd(&cnt[tid * 64], hc);
            const unsigned p0 = (unsigned)__shfl((int)base, ex0) + l0;
            const unsigned p1 = (unsigned)__shfl((int)base, ex1) + l1;
            list[(size_t)ex0 * NTOK + p0] = r * 2 + 0;
            list[(size_t)ex1 * NTOK + p1] = r * 2 + 1;
        }
    }
}

struct RowGather { const int* idx; DEVI unsigned operator()(int r) const { return (unsigned)idx[r] * 2048u; } };
struct RowGU { int c0; DEVI unsigned operator()(int r) const {
    const int wcx = r >> 6, w = r & 63; const int pw = perm32(w & 31);
    const int col = (w < 32) ? (c0 + wcx * 32 + pw) : (256 + c0 + wcx * 32 + pw); return (unsigned)col * 2048u; } };

struct MoeTiles { int cnt, incl, total; };
DEVI MoeTiles moe_tiles(const unsigned* cnt, int lane) {
    MoeTiles M;
    M.cnt = (lane < 32) ? (int)cnt[lane * 64] : 0;
    int v = (M.cnt + 127) >> 7;
#pragma unroll
    for (int o = 1; o < 32; o <<= 1) { const int u = __shfl_up(v, o); if ((lane & 31) >= o) v += u; }
    M.incl = (lane < 32) ? v : 0x7fffffff;
    M.total = __builtin_amdgcn_readlane(v, 31);
    return M;
}
DEVI int moe_find_tile(const MoeTiles& M, int u, int& e, int& tl) {
    const int ee = (int)__popcll(__ballot(M.incl <= u));
    const int ntl = (M.cnt + 127) >> 7;
    e = ee;
    tl = u - (__builtin_amdgcn_readlane(M.incl, ee) - __builtin_amdgcn_readlane(ntl, ee));
    return __builtin_amdgcn_readlane(M.cnt, ee);
}
DEVI void phase_moe_a(const Params& P, unsigned char* lds, int tid) {
    unsigned char* ws = P.ws;
    const rsrc_t rs = __builtin_amdgcn_make_buffer_rsrc((void*)P.ws, (short)0, (int)0x7fffffff, 0x00020000);
    const int lane = tid & 63, wid = __builtin_amdgcn_readfirstlane(tid >> 6), wr = wid >> 1, wc = wid & 1, q = lane >> 4, cl = lane & 15;
    const unsigned* cnt = (const unsigned*)(ws + OFF_CTL);
    const int* list = (const int*)(ws + OFF_LIST);
    bf16_t* act = (bf16_t*)(ws + OFF_ACT);
    int* rowtok = (int*)(lds + 65536);
    const float* RSG = (const float*)(ws + OFF_RS);
    const MoeTiles MT = moe_tiles(cnt, lane);
    const int total = MT.total;
    const bool xloc = (gridDim.x == 512);
    for (int y = xloc ? (int)(blockIdx.x >> 3) : (int)blockIdx.x; ; y += xloc ? 64 : (int)gridDim.x) {
        const int u = xloc ? ((y >> 2) * 8 + (int)(blockIdx.x & 7)) : (y >> 2), nt = y & 3;
        if (u >= total) break;
        int e, tl; const int ce = moe_find_tile(MT, u, e, tl);
        if (tid < 128) { const int r = tl * 128 + tid; rowtok[tid] = (r < ce) ? (list[(size_t)e * NTOK + r] >> 1) : 0; }
        __syncthreads();
        bf16_t* au = act + (size_t)u * 128 * 256;
        f32x4 acc[4][4];
        gemm128(acc, rs, (unsigned)OFF_HN, RowGather{rowtok}, (unsigned)(OFF_WGU + (size_t)e * 512 * 2048), RowGU{nt * 64}, 16, lds, tid);
#pragma unroll
        for (int m = 0; m < 4; ++m) {
            const int row = wr * 64 + m * 16 + cl, col = nt * 64 + wc * 32 + q * 8;
            const float rsv = RSG[rowtok[row]];
            const f32x4 g0 = acc[m][0] * rsv, u0 = acc[m][2] * rsv, g1 = acc[m][1] * rsv, u1 = acc[m][3] * rsv;
            u32x4 w;
            w.x = pk2(siluf_(g0[0]) * u0[0], siluf_(g0[1]) * u0[1]); w.y = pk2(siluf_(g0[2]) * u0[2], siluf_(g0[3]) * u0[3]);
            w.z = pk2(siluf_(g1[0]) * u1[0], siluf_(g1[1]) * u1[1]); w.w = pk2(siluf_(g1[2]) * u1[2], siluf_(g1[3]) * u1[3]);
            *(u32x4*)(au + (size_t)row * 256 + col) = w;
        }
        __syncthreads();
    }
}
DEVI void phase_moe_b(const Params& P, unsigned char* lds, int tid) {
    unsigned char* ws = P.ws;
    const rsrc_t rs = __builtin_amdgcn_make_buffer_rsrc((void*)P.ws, (short)0, (int)0x7fffffff, 0x00020000);
    const int lane = tid & 63, wid = __builtin_amdgcn_readfirstlane(tid >> 6), wr = wid >> 1, wc = wid & 1, q = lane >> 4, cl = lane & 15;
    const unsigned* cnt = (const unsigned*)(ws + OFF_CTL);
    const int* list = (const int*)(ws + OFF_LIST);
    bf16_t* Y = (bf16_t*)(ws + OFF_Y);
    int* rowas = (int*)(lds + 65536);
    const MoeTiles MT = moe_tiles(cnt, lane);
    const int total = MT.total;
    const bool xloc = (gridDim.x == 512);
    for (int y = xloc ? (int)(blockIdx.x >> 3) : (int)blockIdx.x; ; y += xloc ? 64 : (int)gridDim.x) {
        const int u = xloc ? ((y >> 2) * 8 + (int)(blockIdx.x & 7)) : (y >> 2), np = y & 3;
        if (u >= total) break;
        int e, tl; const int ce = moe_find_tile(MT, u, e, tl);
        if (tid < 128) { const int r = tl * 128 + tid; rowas[tid] = (r < ce) ? list[(size_t)e * NTOK + r] : -1; }
        f32x4 acc[8][4];
        gemm256<true, true>(acc, rs, (unsigned)(OFF_WDN + (size_t)e * 1024 * 512 + (size_t)np * 256 * 512), 512u, (unsigned)(OFF_ACT + (size_t)u * 128 * 512), 512u, 8, lds, tid);
#pragma unroll
        for (int n = 0; n < 4; ++n) {
            const int as = rowas[wc * 64 + n * 16 + cl];
            const unsigned voff = (as >= 0) ? (unsigned)((as & 1) * NTOK + (as >> 1)) * 2048u + (unsigned)(wr * 256 + q * 16) : 0x80000000u;
#pragma unroll
            for (int pp = 0; pp < 4; ++pp) {
                u32x4 w;
                w.x = pk2(acc[2 * pp][n][0], acc[2 * pp][n][1]); w.y = pk2(acc[2 * pp][n][2], acc[2 * pp][n][3]);
                w.z = pk2(acc[2 * pp + 1][n][0], acc[2 * pp + 1][n][1]); w.w = pk2(acc[2 * pp + 1][n][2], acc[2 * pp + 1][n][3]);
                __builtin_amdgcn_raw_buffer_store_b128(w, rs, (int)voff, (int)((unsigned)OFF_Y + (unsigned)(np * 512 + pp * 64)), 0);
            }
            asm volatile("" ::: "memory");
        }
        __syncthreads();
    }
}

DEVI void phase_final(const Params& P, int tid, bool with_moe) {
    unsigned char* ws = P.ws;
    const int lane = tid & 63, wid = __builtin_amdgcn_readfirstlane(tid >> 6);
    const bf16_t* Y = (const bf16_t*)(ws + OFF_Y);
    const float* wt = (const float*)(ws + OFF_WT);
    const float* g = P.in[20];
    float* out = P.out;
    f32x4 v[4]; u32x2 ya[4], yb[4]; float w0 = 0.f, w1 = 0.f;
    f32x4 ggv[4];
#pragma unroll
    for (int i = 0; i < 4; ++i) ggv[i] = *(const f32x4*)(g + i * 256 + lane * 4);
    int r = blockIdx.x * 4 + wid;
    if (r < NTOK) {
        if (with_moe) { w0 = wt[(size_t)r * 2]; w1 = wt[(size_t)r * 2 + 1]; }
#pragma unroll
        for (int i = 0; i < 4; ++i) {
            v[i] = *(const f32x4*)(out + (size_t)r * 1024 + i * 256 + lane * 4);
            if (with_moe) {
                ya[i] = *(const u32x2*)(Y + (size_t)r * 1024 + i * 256 + lane * 4);
                yb[i] = *(const u32x2*)(Y + ((size_t)NTOK + r) * 1024 + i * 256 + lane * 4);
            }
        }
    }
    while (r < NTOK) {
        float* xr = out + (size_t)r * 1024;
        const int rn = r + gridDim.x * 4;
        const int rp = rn < NTOK ? rn : r;
        f32x4 vn[4]; u32x2 yan[4], ybn[4]; float w0n = 0.f, w1n = 0.f;
        if (with_moe) { w0n = wt[(size_t)rp * 2]; w1n = wt[(size_t)rp * 2 + 1]; }
#pragma unroll
        for (int i = 0; i < 4; ++i) {
            vn[i] = *(const f32x4*)(out + (size_t)rp * 1024 + i * 256 + lane * 4);
            if (with_moe) {
                yan[i] = *(const u32x2*)(Y + (size_t)rp * 1024 + i * 256 + lane * 4);
                ybn[i] = *(const u32x2*)(Y + ((size_t)NTOK + rp) * 1024 + i * 256 + lane * 4);
            }
        }
        float ss = 0.f;
#pragma unroll
        for (int i = 0; i < 4; ++i) {
            if (with_moe) {
                const u32x2 a = ya[i], b = yb[i];
                v[i][0] += w0 * bf2f(a.x & 0xffffu) + w1 * bf2f(b.x & 0xffffu); v[i][1] += w0 * bf2f(a.x >> 16) + w1 * bf2f(b.x >> 16);
                v[i][2] += w0 * bf2f(a.y & 0xffffu) + w1 * bf2f(b.y & 0xffffu); v[i][3] += w0 * bf2f(a.y >> 16) + w1 * bf2f(b.y >> 16);
            }
            ss += v[i][0] * v[i][0] + v[i][1] * v[i][1] + v[i][2] * v[i][2] + v[i][3] * v[i][3];
        }
        ss = wave_sum(ss);
        const float rs = rsqrtf(ss * (1.0f / 1024.0f) + RMS_EPS);
#pragma unroll
        for (int i = 0; i < 4; ++i) {
            const f32x4 gg = ggv[i];
            f32x4 o; o[0] = v[i][0] * rs * gg[0]; o[1] = v[i][1] * rs * gg[1]; o[2] = v[i][2] * rs * gg[2]; o[3] = v[i][3] * rs * gg[3];
            *(f32x4*)(xr + i * 256 + lane * 4) = o;
        }
#pragma unroll
        for (int i = 0; i < 4; ++i) { v[i] = vn[i]; ya[i] = yan[i]; yb[i] = ybn[i]; }
        w0 = w0n; w1 = w1n;
        r = rn;
    }
}

#define LAUNDER_TID() do { tid = wave_id * 64 + (int)__builtin_amdgcn_mbcnt_hi(~0u, __builtin_amdgcn_mbcnt_lo(~0u, 0u)); asm volatile("" : "+v"(tid)); } while (0)
__global__ void __launch_bounds__(NTHREADS, 2) fwd_megakernel(Params P) {
    extern __shared__ __attribute__((aligned(16))) unsigned char lds[];
    cg::grid_group grid = cg::this_grid();
    int tid;
    const int wave_id = __builtin_amdgcn_readfirstlane((int)(threadIdx.x >> 6));
    volatile LAS unsigned* bst = (volatile LAS unsigned*)(LAS unsigned char*)(lds + LDS_BYTES - 16);
    if (threadIdx.x < 4) bst[threadIdx.x] = 0u;
    if (threadIdx.x == 4) *(volatile LAS unsigned*)(LAS unsigned char*)(lds + LDS_BYTES - 32) = 0u;
    __syncthreads();
    (void)xcd_barrier_post((unsigned*)(P.ws + OFF_BAR), bst);
#define GRID_BARRIER() do { XcdBarrier b_; b_.bar = (unsigned*)(P.ws + OFF_BAR); b_.x = xb_xcc_id(); b_.st = (volatile LAS unsigned*)(LAS unsigned char*)(lds + LDS_BYTES - 16); xcd_barrier(b_); } while (0)
    if (P.ph_lo != 0) grid.sync();
    LAUNDER_TID(); phase_prep(P, lds, tid, 0); __syncthreads();
    GRID_BARRIER();
    {
        const int first_idx = (blockIdx.x >> 8) & 1;
        for (int step = 0; step < 3; ++step) {
            const int what = (step == 0) ? 0 : 1 + ((step - 1) ^ first_idx);
            if (what <= 1) { LAUNDER_TID(); phase_gemm1(P, lds, tid, what); }
            else {
                LAUNDER_TID(); phase_prep(P, lds, tid, 1); __syncthreads();
                LAUNDER_TID(); phase_compress(P, lds, tid); __syncthreads();
                LAUNDER_TID(); phase_index(P, lds, tid);
            }
            __syncthreads();
            if (step == 0) GRID_BARRIER();
        }
    }
    GRID_BARRIER();
    if (((blockIdx.x >> 8) & 1) == 0) { LAUNDER_TID(); phase_dsa(P, lds, tid); __syncthreads(); }
    LAUNDER_TID(); phase_nsa(P, lds, tid); __syncthreads();
    if (((blockIdx.x >> 8) & 1) != 0) { LAUNDER_TID(); phase_dsa(P, lds, tid); __syncthreads(); }
    GRID_BARRIER();
    LAUNDER_TID(); phase_merge(P, lds, tid);
    GRID_BARRIER();
    LAUNDER_TID(); phase_outproj(P, lds, tid);
    GRID_BARRIER();
    LAUNDER_TID(); phase_router(P, lds, tid);
    GRID_BARRIER();
    LAUNDER_TID(); phase_moe_a(P, lds, tid);
    GRID_BARRIER();
    LAUNDER_TID(); phase_moe_b(P, lds, tid);
    GRID_BARRIER();
    LAUNDER_TID(); phase_final(P, tid, true);
}

extern "C" void kernel_launch(void* const* d_in, const int* in_sizes, int n_in, void* d_out, int out_size, void* d_ws, size_t ws_size,
                              hipStream_t stream) {
    static int grid_blocks = 0;
    if (!grid_blocks) {
        int dev = 0, cus = 0, per_cu = 0;
        hipGetDevice(&dev);
        hipDeviceGetAttribute(&cus, hipDeviceAttributeMultiprocessorCount, dev);
        hipFuncSetAttribute((const void*)fwd_megakernel, hipFuncAttributeMaxDynamicSharedMemorySize, LDS_BYTES);
        hipOccupancyMaxActiveBlocksPerMultiprocessor(&per_cu, (const void*)fwd_megakernel, NTHREADS, LDS_BYTES);
        if (per_cu < 1) per_cu = 1;
        if (per_cu > 2) per_cu = 2;
        grid_blocks = cus * per_cu;
        if (ws_size < WS_END) fprintf(stderr, "kernel_launch: workspace too small: %zu < %zu\n", ws_size, (size_t)WS_END);
    }
    Params p{};
    for (int i = 0; i < 21; ++i) p.in[i] = (const float*)d_in[i];
    p.pos = (const int*)d_in[1];
    p.out = (float*)d_out;
    p.ws = (unsigned char*)d_ws;
    for (int i = 0; i < 32; ++i) p.inv_freq[i] = (double)powf(10000.0f, -(float)i / 32.0f);
    p.ph_lo = 0; p.ph_hi = 0;
    (void)hipMemsetAsync(d_ws, 0, OFF_WIN_T, stream);
    void* args[] = {&p};
    hipError_t e = hipLaunchCooperativeKernel((const void*)fwd_megakernel, dim3(grid_blocks), dim3(NTHREADS), args, LDS_BYTES, stream);
    if (e != hipSuccess) fprintf(stderr, "cooperative launch failed: %s (grid %d)\n", hipGetErrorString(e), grid_blocks);
}
```
